# Optimizing an MI355X kernel written in HIP

```python
import math
import jax
import jax.numpy as jnp
from jax import lax
import numpy as np


D_MODEL = 2048
BATCH = 1
SEQ = 16384
DEPTH = 2

NSA_HEADS = 8
NSA_KV_HEADS = 2
NSA_HEAD_DIM = 64
NSA_GROUP = NSA_HEADS // NSA_KV_HEADS
NSA_WIDTH = NSA_HEADS * NSA_HEAD_DIM
NSA_KV_WIDTH = NSA_KV_HEADS * NSA_HEAD_DIM
CMP_LEN = 32
CMP_STRIDE = 16
CMP_HIDDEN = 256
SLC_BLOCK = 64
SLC_TOPK = 16
WINDOW = 512
Q_BLOCK = 128
ROPE_THETA = 500000.0
ROPE_DIMS = NSA_HEAD_DIM // 4

S5_WIDTH = 512
S5_GROUP_CH = 16
S5_GROUPS = S5_WIDTH // S5_GROUP_CH
S5_STATE = 64

GDN_HEADS = 8
GDN_HEAD_DIM = 128
GDN_WIDTH = GDN_HEADS * GDN_HEAD_DIM
GDN_CONV = 4
GDN_CHUNK = 64

MIX_WIDTH = NSA_WIDTH + S5_WIDTH + GDN_WIDTH
D_FF = 5504
FFN_CONV = 3
EPS = 1e-6
NEG_BIG = -1e30

IN_SPLITS = (NSA_WIDTH,) + (NSA_KV_WIDTH,) * 6 + (3 * NSA_HEADS, S5_WIDTH, 3 * GDN_WIDTH, GDN_WIDTH, GDN_HEADS, GDN_HEADS)
IN_COLS = sum(IN_SPLITS)

kernel_name = 'hymba_nsa_s5_gdn_convffn'


def rmsnorm(x, g):
    xf = x.astype(jnp.float32)
    y = xf * lax.rsqrt(jnp.mean(xf * xf, axis=-1, keepdims=True) + EPS)
    return (y * g.astype(jnp.float32)).astype(x.dtype)


def l2norm(x):
    xf = x.astype(jnp.float32)
    return xf * lax.rsqrt(jnp.sum(xf * xf, axis=-1, keepdims=True) + EPS)


def rope_partial(x, pos):
    half = ROPE_DIMS // 2
    inv = ROPE_THETA ** (-jnp.arange(half, dtype=jnp.float32) / half)
    ang = pos.astype(jnp.float32)[:, None] * inv[None, :]
    cos = jnp.cos(ang)[:, None, :]
    sin = jnp.sin(ang)[:, None, :]
    xr = x[..., :ROPE_DIMS].astype(jnp.float32)
    x1, x2 = xr[..., :half], xr[..., half:]
    rot = jnp.concatenate([x1 * cos - x2 * sin, x2 * cos + x1 * sin], axis=-1)
    return jnp.concatenate([rot.astype(x.dtype), x[..., ROPE_DIMS:]], axis=-1)


def causal_dwconv(x, w):
    width = w.shape[0]
    L = x.shape[1]
    xp = jnp.pad(x, ((0, 0), (width - 1, 0), (0, 0)))
    return sum(xp[:, j:j + L] * w[j] for j in range(width))


def masked_softmax(s, mask):
    s = jnp.where(mask, s.astype(jnp.float32), NEG_BIG)
    p = jnp.where(mask, jnp.exp(s - jnp.max(s, axis=-1, keepdims=True)), 0.0)
    return p / jnp.maximum(jnp.sum(p, axis=-1, keepdims=True), 1e-30)


def compress_blocks(win, pe, w1, w2):
    h = win.astype(jnp.float32) + pe[:, None, :]
    h = jnp.einsum('bnlhd,ldf->bnhf', h, w1)
    return jnp.einsum('bnhf,fd->bnhd', jax.nn.gelu(h), w2)


def nsa_mixer(q, kc_raw, vc_raw, ks, vs, kw, vw, gate_logits,
              q_norm, kc_norm, ks_norm, kw_norm, cmp_pe, cmp_k_w1, cmp_k_w2, cmp_v_w1, cmp_v_w2):
    B_, L, _ = q.shape
    H, HK, G, DH = NSA_HEADS, NSA_KV_HEADS, NSA_GROUP, NSA_HEAD_DIM
    scale = DH ** -0.5
    pos = jnp.arange(L, dtype=jnp.float32)
    heads = lambda t, h: t.reshape(B_, L, h, DH)
    q = rope_partial(rmsnorm(heads(q, H), q_norm), pos)
    ks = rope_partial(rmsnorm(heads(ks, HK), ks_norm), pos)
    kw = rope_partial(rmsnorm(heads(kw, HK), kw_norm), pos)
    vs = heads(vs, HK)
    vw = heads(vw, HK)

    n_cmp = (L - CMP_LEN) // CMP_STRIDE + 1
    cmp_start = jnp.arange(n_cmp) * CMP_STRIDE
    win_idx = cmp_start[:, None] + jnp.arange(CMP_LEN)[None, :]
    kc = compress_blocks(heads(kc_raw, HK)[:, win_idx], cmp_pe, cmp_k_w1, cmp_k_w2)
    vc = compress_blocks(heads(vc_raw, HK)[:, win_idx], cmp_pe, cmp_v_w1, cmp_v_w2)
    kc = rope_partial(rmsnorm(kc, kc_norm), (cmp_start + CMP_LEN // 2).astype(jnp.float32))
    cmp_end = cmp_start + CMP_LEN - 1

    n_slc = L // SLC_BLOCK
    slc_start = jnp.arange(n_slc) * SLC_BLOCK
    sel_map = ((cmp_start[:, None] <= slc_start[None, :] + SLC_BLOCK - 1)
               & (cmp_end[:, None] >= slc_start[None, :])).astype(jnp.float32)
    n_sel = min(SLC_TOPK, n_slc)
    ks_blocks = ks.reshape(B_, n_slc, SLC_BLOCK, HK, DH).transpose(0, 3, 1, 2, 4)
    vs_blocks = vs.reshape(B_, n_slc, SLC_BLOCK, HK, DH).transpose(0, 3, 1, 2, 4)
    kw_pad = jnp.pad(kw, ((0, 0), (WINDOW, 0), (0, 0), (0, 0)))
    vw_pad = jnp.pad(vw, ((0, 0), (WINDOW, 0), (0, 0), (0, 0)))
    gates = jax.nn.sigmoid(gate_logits.astype(jnp.float32)).reshape(B_, L, HK, G, 3)
    b_idx = jnp.arange(B_)[:, None, None, None]
    h_idx = jnp.arange(HK)[None, None, :, None]
    j_idx = jnp.arange(n_slc)

    def query_block(qb_i):
        s = qb_i * Q_BLOCK
        t = s + jnp.arange(Q_BLOCK)
        qg = lax.dynamic_slice_in_dim(q, s, Q_BLOCK, axis=1).reshape(B_, Q_BLOCK, HK, G, DH)
        gb = lax.dynamic_slice_in_dim(gates, s, Q_BLOCK, axis=1)

        sc = jnp.einsum('bqhgd,bnhd->bhgqn', qg, kc) * scale
        pc = masked_softmax(sc, cmp_end[None, :] <= t[:, None])
        o_c = jnp.einsum('bhgqn,bnhd->bqhgd', pc, vc)

        imp = jnp.einsum('bhgqn,nj->bqhj', pc, sel_map)
        cur = t // SLC_BLOCK
        forced = (j_idx[None, :] == 0) | (j_idx[None, :] == cur[:, None]) | (j_idx[None, :] == cur[:, None] - 1)
        valid = j_idx[None, :] <= cur[:, None]
        imp = jnp.where(valid[None, :, None, :], jnp.where(forced[None, :, None, :], jnp.inf, imp), -jnp.inf)
        _, sel = lax.top_k(imp, n_sel)
        kb = ks_blocks[b_idx, h_idx, sel].reshape(B_, Q_BLOCK, HK, n_sel * SLC_BLOCK, DH)
        vb = vs_blocks[b_idx, h_idx, sel].reshape(B_, Q_BLOCK, HK, n_sel * SLC_BLOCK, DH)
        kpos = (sel[..., None] * SLC_BLOCK + jnp.arange(SLC_BLOCK)).reshape(B_, Q_BLOCK, HK, n_sel * SLC_BLOCK)
        mask_s = (kpos <= t[None, :, None, None]).transpose(0, 2, 1, 3)[:, :, None]
        ss = jnp.einsum('bqhgd,bqhkd->bhgqk', qg, kb) * scale
        o_s = jnp.einsum('bhgqk,bqhkd->bqhgd', masked_softmax(ss, mask_s), vb)

        kwb = lax.dynamic_slice_in_dim(kw_pad, s, Q_BLOCK + WINDOW, axis=1)
        vwb = lax.dynamic_slice_in_dim(vw_pad, s, Q_BLOCK + WINDOW, axis=1)
        kpos_w = s - WINDOW + jnp.arange(Q_BLOCK + WINDOW)
        mask_w = ((kpos_w[None, :] <= t[:, None]) & (kpos_w[None, :] > t[:, None] - WINDOW)
                  & (kpos_w[None, :] >= 0))
        sw = jnp.einsum('bqhgd,bkhd->bhgqk', qg, kwb) * scale
        o_w = jnp.einsum('bhgqk,bkhd->bqhgd', masked_softmax(sw, mask_w), vwb)

        out = gb[..., 0, None] * o_c + gb[..., 1, None] * o_s + gb[..., 2, None] * o_w
        return out.reshape(B_, Q_BLOCK, NSA_WIDTH)

    out = lax.map(query_block, jnp.arange(L // Q_BLOCK))
    return out.transpose(1, 0, 2, 3).reshape(B_, L, NSA_WIDTH).astype(q.dtype)


def s5_mixer(u, lam_re, lam_im, log_dt, b_re, b_im, c_re, c_im, d_skip, w_glu):
    B_, L, _ = u.shape
    f32 = lambda t: t.astype(jnp.float32)
    lam_re, lam_im, b_re, b_im, c_re, c_im = map(f32, (lam_re, lam_im, b_re, b_im, c_re, c_im))
    ug = f32(u).reshape(B_, L, S5_GROUPS, S5_GROUP_CH)
    dt = jnp.exp(f32(log_dt))[:, None]
    mag = jnp.exp(lam_re * dt)
    lb_re = mag * jnp.cos(lam_im * dt)
    lb_im = mag * jnp.sin(lam_im * dt)
    den = lam_re * lam_re + lam_im * lam_im
    nr, ni = lb_re - 1.0, lb_im
    coef_re = (nr * lam_re + ni * lam_im) / den
    coef_im = (ni * lam_re - nr * lam_im) / den
    bb_re = coef_re[..., None] * b_re - coef_im[..., None] * b_im
    bb_im = coef_re[..., None] * b_im + coef_im[..., None] * b_re
    bu_re = jnp.einsum('blgh,gph->blgp', ug, bb_re)
    bu_im = jnp.einsum('blgh,gph->blgp', ug, bb_im)
    a_re = jnp.broadcast_to(lb_re, bu_re.shape)
    a_im = jnp.broadcast_to(lb_im, bu_im.shape)

    def combine(e1, e2):
        a1r, a1i, b1r, b1i = e1
        a2r, a2i, b2r, b2i = e2
        return (a2r * a1r - a2i * a1i, a2r * a1i + a2i * a1r,
                a2r * b1r - a2i * b1i + b2r, a2r * b1i + a2i * b1r + b2i)

    _, _, xr, xi = lax.associative_scan(combine, (a_re, a_im, bu_re, bu_im), axis=1)
    y = jnp.einsum('blgp,ghp->blgh', xr, c_re) - jnp.einsum('blgp,ghp->blgh', xi, c_im)
    y = y + f32(d_skip).reshape(S5_GROUPS, S5_GROUP_CH) * ug
    y = jax.nn.gelu(y.reshape(B_, L, S5_WIDTH))
    y = y * jax.nn.sigmoid(y @ f32(w_glu))
    return y.astype(u.dtype)


def chunk_gated_delta_rule(q, k, v, g, beta):
    B_, L, H, DK = q.shape
    DV = v.shape[-1]
    C = GDN_CHUNK
    N = L // C

    def chunks(t):
        return t.astype(jnp.float32).reshape(B_, N, C, H, -1).transpose(1, 0, 3, 2, 4)

    q, k, v = chunks(q), chunks(k), chunks(v)
    beta = chunks(beta[..., None])[..., 0]
    gc = jnp.cumsum(chunks(g[..., None])[..., 0], axis=-1)
    causal = jnp.tril(jnp.ones((C, C), bool))
    strict = jnp.tril(jnp.ones((C, C), bool), -1)
    diff = gc[..., :, None] - gc[..., None, :]
    decay = jnp.where(causal, jnp.exp(jnp.where(causal, diff, 0.0)), 0.0)
    k_beta = k * beta[..., None]
    a_mat = jnp.where(strict, jnp.einsum('nbhcd,nbhed->nbhce', k_beta, k) * decay, 0.0)
    eye = jnp.broadcast_to(jnp.eye(C, dtype=jnp.float32), a_mat.shape)
    t_mat = lax.linalg.triangular_solve(a_mat, eye, left_side=True, lower=True, unit_diagonal=True)
    value = t_mat @ (v * beta[..., None])
    k_cum = t_mat @ (k_beta * jnp.exp(gc)[..., None])
    qk = jnp.einsum('nbhcd,nbhed->nbhce', q, k) * decay

    def step(state, inp):
        q_i, k_i, val_i, kc_i, qk_i, g_i = inp
        v_new = val_i - kc_i @ state
        o_i = (q_i * jnp.exp(g_i)[..., None]) @ state + qk_i @ v_new
        g_last = g_i[..., -1:]
        state = state * jnp.exp(g_last)[..., None] + jnp.einsum(
            'bhcd,bhce->bhde', k_i * jnp.exp(g_last - g_i)[..., None], v_new)
        return state, o_i

    state0 = jnp.zeros((B_, H, DK, DV), jnp.float32)
    _, o = lax.scan(step, state0, (q, k, value, k_cum, qk, gc))
    return o.transpose(1, 0, 3, 2, 4).reshape(B_, L, H, DV)


def gdn_mixer(qkv, z, a, b, conv_w, a_log, dt_bias, out_norm):
    B_, L, _ = qkv.shape
    qkv = jax.nn.silu(causal_dwconv(qkv, conv_w))
    q, k, v = jnp.split(qkv, 3, axis=-1)
    q = l2norm(q.reshape(B_, L, GDN_HEADS, GDN_HEAD_DIM)) * (GDN_HEAD_DIM ** -0.5)
    k = l2norm(k.reshape(B_, L, GDN_HEADS, GDN_HEAD_DIM))
    v = v.reshape(B_, L, GDN_HEADS, GDN_HEAD_DIM)
    beta = jax.nn.sigmoid(b.astype(jnp.float32))
    g = -jnp.exp(a_log.astype(jnp.float32)) * jax.nn.softplus(a.astype(jnp.float32) + dt_bias.astype(jnp.float32))
    o = chunk_gated_delta_rule(q, k, v, g, beta)
    o = rmsnorm(o, out_norm) * jax.nn.silu(z.astype(jnp.float32).reshape(B_, L, GDN_HEADS, GDN_HEAD_DIM))
    return o.reshape(B_, L, GDN_WIDTH).astype(qkv.dtype)


def conv_ffn(x, w_in, conv_w, conv_b, w_out):
    h = causal_dwconv(x @ w_in, conv_w) + conv_b
    gate, up = jnp.split(h, 2, axis=-1)
    return (jax.nn.silu(gate) * up) @ w_out


def setup_inputs(seed: int = 0) -> dict:
    key = jax.random.key(seed)
    keys = iter(jax.random.split(key, 48))

    def normal(shape, scale):
        return jax.random.normal(next(keys), shape, jnp.float32) * scale

    def gain(shape):
        return 1.0 + 0.02 * jax.random.normal(next(keys), shape, jnp.float32)

    def uniform(shape, lo, hi):
        return jax.random.uniform(next(keys), shape, jnp.float32, lo, hi)

    Ly, dh = DEPTH, NSA_HEAD_DIM
    n_idx = jnp.arange(S5_STATE, dtype=jnp.float32)
    dt_gdn = jnp.exp(uniform((Ly, GDN_HEADS), math.log(1e-3), math.log(1e-1)))
    return {
        'x': normal((BATCH, SEQ, D_MODEL), 1.0),
        'attn_norm': gain((Ly, D_MODEL)),
        'w_in': normal((Ly, D_MODEL, IN_COLS), D_MODEL ** -0.5),
        'nsa_q_norm': gain((Ly, dh)),
        'nsa_kc_norm': gain((Ly, dh)),
        'nsa_ks_norm': gain((Ly, dh)),
        'nsa_kw_norm': gain((Ly, dh)),
        'cmp_pe': normal((Ly, CMP_LEN, dh), 0.5),
        'cmp_k_w1': normal((Ly, CMP_LEN, dh, CMP_HIDDEN), (CMP_LEN * dh) ** -0.5),
        'cmp_k_w2': normal((Ly, CMP_HIDDEN, dh), CMP_HIDDEN ** -0.5),
        'cmp_v_w1': normal((Ly, CMP_LEN, dh, CMP_HIDDEN), (CMP_LEN * dh) ** -0.5),
        'cmp_v_w2': normal((Ly, CMP_HIDDEN, dh), CMP_HIDDEN ** -0.5),
        'nsa_out_norm': gain((Ly, NSA_WIDTH)),
        's5_lam_re': -0.5 + normal((Ly, S5_GROUPS, S5_STATE), 0.01),
        's5_lam_im': jnp.pi * n_idx + normal((Ly, S5_GROUPS, S5_STATE), 0.01),
        's5_log_dt': uniform((Ly, S5_GROUPS), math.log(1e-3), math.log(1e-1)),
        's5_b_re': normal((Ly, S5_GROUPS, S5_STATE, S5_GROUP_CH), (2 * S5_GROUP_CH) ** -0.5),
        's5_b_im': normal((Ly, S5_GROUPS, S5_STATE, S5_GROUP_CH), (2 * S5_GROUP_CH) ** -0.5),
        's5_c_re': normal((Ly, S5_GROUPS, S5_GROUP_CH, S5_STATE), S5_STATE ** -0.5),
        's5_c_im': normal((Ly, S5_GROUPS, S5_GROUP_CH, S5_STATE), S5_STATE ** -0.5),
        's5_d': normal((Ly, S5_WIDTH), 0.5),
        's5_w_glu': normal((Ly, S5_WIDTH, S5_WIDTH), S5_WIDTH ** -0.5),
        's5_out_norm': gain((Ly, S5_WIDTH)),
        'gdn_conv': normal((Ly, GDN_CONV, 3 * GDN_WIDTH), GDN_CONV ** -0.5),
        'gdn_a_log': jnp.log(uniform((Ly, GDN_HEADS), 1.0, 16.0)),
        'gdn_dt_bias': dt_gdn + jnp.log(-jnp.expm1(-dt_gdn)),
        'gdn_norm': gain((Ly, GDN_HEAD_DIM)),
        'w_out': normal((Ly, MIX_WIDTH, D_MODEL), MIX_WIDTH ** -0.5),
        'ffn_norm': gain((Ly, D_MODEL)),
        'ffn_w_in': normal((Ly, D_MODEL, 2 * D_FF), D_MODEL ** -0.5),
        'ffn_conv': normal((Ly, FFN_CONV, 2 * D_FF), FFN_CONV ** -0.5),
        'ffn_conv_b': normal((Ly, 2 * D_FF), 0.02),
        'ffn_w_out': normal((Ly, D_FF, D_MODEL), D_FF ** -0.5),
    }


def reference(x, attn_norm, w_in, nsa_q_norm, nsa_kc_norm, nsa_ks_norm, nsa_kw_norm, cmp_pe,
              cmp_k_w1, cmp_k_w2, cmp_v_w1, cmp_v_w2, nsa_out_norm, s5_lam_re, s5_lam_im, s5_log_dt,
              s5_b_re, s5_b_im, s5_c_re, s5_c_im, s5_d, s5_w_glu, s5_out_norm, gdn_conv, gdn_a_log,
              gdn_dt_bias, gdn_norm, w_out, ffn_norm, ffn_w_in, ffn_conv, ffn_conv_b, ffn_w_out):
    split_points = [int(p) for p in np.cumsum(IN_SPLITS)[:-1]]
    for l in range(DEPTH):
        h = rmsnorm(x, attn_norm[l])
        (q, kc, vc, ks, vs, kw, vw, nsa_gates, u, qkv, z, a, b) = jnp.split(h @ w_in[l], split_points, axis=-1)
        y_a = nsa_mixer(q, kc, vc, ks, vs, kw, vw, nsa_gates,
                        nsa_q_norm[l], nsa_kc_norm[l], nsa_ks_norm[l], nsa_kw_norm[l], cmp_pe[l],
                        cmp_k_w1[l], cmp_k_w2[l], cmp_v_w1[l], cmp_v_w2[l])
        y_b = s5_mixer(u, s5_lam_re[l], s5_lam_im[l], s5_log_dt[l], s5_b_re[l], s5_b_im[l],
                       s5_c_re[l], s5_c_im[l], s5_d[l], s5_w_glu[l])
        y_c = gdn_mixer(qkv, z, a, b, gdn_conv[l], gdn_a_log[l], gdn_dt_bias[l], gdn_norm[l])
        mix = jnp.concatenate([rmsnorm(y_a, nsa_out_norm[l]), rmsnorm(y_b, s5_out_norm[l]), y_c], axis=-1)
        x = x + (mix @ w_out[l]).astype(x.dtype)
        x = x + conv_ffn(rmsnorm(x, ffn_norm[l]), ffn_w_in[l], ffn_conv[l], ffn_conv_b[l], ffn_w_out[l]).astype(x.dtype)
    return x
```

```cpp
#include <hip/hip_runtime.h>
#include <hip/hip_cooperative_groups.h>
#include <cstdio>
namespace cg = cooperative_groups;
namespace pg8 {
#define PG8_LAS __attribute__((address_space(3)))
typedef unsigned short bf16_t;
typedef short bf16x8 __attribute__((ext_vector_type(8)));
typedef float f32x4 __attribute__((ext_vector_type(4)));
typedef unsigned u32x4 __attribute__((ext_vector_type(4)));
constexpr int BM = 256, BK = 64, HALF = 128, HTB = HALF * BK * 2  , STAGE_BYTES = 8 * HTB, NXCD = 8, WGM = 8;

__host__ __device__ __forceinline__ int lds_byte(int r, int c) { const int st = (r >> 4) * 2 + (c >> 5), rr = r & 15, cc = c & 31, ob = rr * 64 + cc * 2; return st * 1024 + (ob ^ (((ob >> 9) & 1) << 5)); }
__host__ __device__ __forceinline__ void stage_rc(int b, int& R, int& C) { const int st = b / 1024, sb = b % 1024, swz = sb ^ (((sb >> 9) & 1) << 5); R = (st >> 1) * 16 + swz / 64; C = (st & 1) * 32 + (swz % 64) / 2; }
__host__ __device__ __forceinline__ int perm32(int rho) { const int n = rho >> 4, i = rho & 15; return 8 * (i >> 2) + 4 * n + (i & 3); }

struct Unit { int pm, pn; };
struct Gemm { const bf16_t* A; const bf16_t* Bt; int M, N, K; };

struct StaticOrder {
    int nM, nN, nwg, G, c;
    __host__ __device__ void init(int M, int N, int G_, int c_) { nM = M / BM; nN = N / BM; nwg = nM * nN; G = G_; c = c_; }
    __host__ __device__ bool next(int i, Unit& u) const {
        const long L = (long)i * G + c; if (L >= nwg) return false;
        int wgid = (int)L; { const int q = nwg / NXCD, r = nwg % NXCD, xcd = wgid % NXCD, off = wgid / NXCD; wgid = (xcd < r ? xcd * (q + 1) : r * (q + 1) + (xcd - r) * q) + off; }
        const int nig = WGM * nN, gid = wgid / nig, fm = gid * WGM, gsz = (nM - fm) < WGM ? (nM - fm) : WGM;
        u.pm = fm + ((wgid % nig) % gsz); u.pn = (wgid % nig) / gsz; return true;
    }
    __device__ __forceinline__ void a_ready(const Unit&) const {}
    __device__ __forceinline__ void done(const Unit&) const {}
};
__device__ __forceinline__ unsigned cvt_pk_bf16(float lo, float hi) { unsigned r; asm volatile("v_cvt_pk_bf16_f32 %0, %1, %2" : "=v"(r) : "v"(lo), "v"(hi)); return r; }
template <class Epi, class Sched, bool STAMP = false>
__device__ __forceinline__ void gemm_phase(PG8_LAS unsigned char* lds, const Gemm g, const Sched& S, const Epi& E, unsigned long long* stamps) {
    const int tid = threadIdx.x, wid = __builtin_amdgcn_readfirstlane(tid >> 6), lane = tid & 63, wr = wid >> 2, wc = wid & 3, fr = lane & 15, fq = lane >> 4;
    const int K = g.K, nt = K / BK;
    int ts_lo = 0, ts_hi = 0, nts = 0; const unsigned long long rt_entry = STAMP ? (unsigned long long)wall_clock64() : 0ull;
#define PG8_STAMP() do { if (STAMP && wid == 0 && nts < 64) { const unsigned long long _c = (unsigned long long)clock64(); \
        ts_lo = (lane == nts) ? (int)(unsigned)_c : ts_lo; ts_hi = (lane == nts) ? (int)(unsigned)(_c >> 32) : ts_hi; ++nts; } } while (0)
    PG8_STAMP();
    unsigned voffA[2], voffB[2];
#pragma unroll
    for (int i = 0; i < 2; ++i) { int R, C; stage_rc(tid * 16 + i * 8192, R, C); const int Rb = Epi::PERM ? ((R & ~31) + perm32(R & 31)) : R;
        voffA[i] = (unsigned)(R * K + C) * 2u; voffB[i] = (unsigned)(Rb * K + C) * 2u; }
    const size_t kstep = (size_t)(BK * 2);
    const size_t hstep = (size_t)HALF * K * 2;
    const size_t tstep = 2 * hstep;
    const unsigned ldsw = (unsigned)wid * 1024u;
    const int aoff = lds_byte(wr * 64 + fr, fq * 8), boff = lds_byte(wc * 32 + fr, fq * 8);
#define PG8_SA(b, h) (((b) * 2 + (h)) * HTB)
#define PG8_SB(b, h) ((4 + (b) * 2 + (h)) * HTB)
#define PG8_STAGE(bufoff, gbase, voff) do { _Pragma("unroll") for (int _i = 0; _i < 2; ++_i) \
        __builtin_amdgcn_global_load_lds((const unsigned*)((const char*)(gbase) + (voff)[_i]), (PG8_LAS unsigned*)(lds + (bufoff) + ldsw + _i * 8192), 16, 0, 0); } while (0)
#define PG8_LDA(dst, b, h) do { _Pragma("unroll") for (int m = 0; m < 4; ++m) _Pragma("unroll") for (int k = 0; k < 2; ++k) dst[m][k] = *(const PG8_LAS bf16x8*)(lds + PG8_SA(b, h) + aoff + m * 2048 + k * 1024); } while (0)
#define PG8_LDB(dst, b, h) do { _Pragma("unroll") for (int n = 0; n < 2; ++n) _Pragma("unroll") for (int k = 0; k < 2; ++k) dst[n][k] = *(const PG8_LAS bf16x8*)(lds + PG8_SB(b, h) + boff + n * 2048 + k * 1024); } while (0)
#define PG8_MMA(ai, bj, At, Bt) do { __builtin_amdgcn_s_setprio(1); _Pragma("unroll") for (int m = 0; m < 4; ++m) _Pragma("unroll") for (int n = 0; n < 2; ++n) _Pragma("unroll") for (int k = 0; k < 2; ++k) \
        acc[ai][bj][m][n] = __builtin_amdgcn_mfma_f32_16x16x32_bf16(Bt[n][k], At[m][k], acc[ai][bj][m][n], 0, 0, 0); __builtin_amdgcn_s_setprio(0); } while (0)
#define PG8_WAIT_V(n) asm volatile("s_waitcnt vmcnt(" #n ")" ::: "memory")
#define PG8_WAIT_L(n) asm volatile("s_waitcnt lgkmcnt(" #n ")" ::: "memory")
#define PG8_BAR __builtin_amdgcn_s_barrier()
#define PG8_SCHED __builtin_amdgcn_sched_barrier(0)
    Unit cur, nxt; int ui = 0;
    if (!S.next(0, cur)) return;
    f32x4 acc[2][2][4][2];
#pragma unroll
    for (int a = 0; a < 2; ++a)
#pragma unroll
        for (int b = 0; b < 2; ++b)
#pragma unroll
            for (int m = 0; m < 4; ++m)
#pragma unroll
                for (int n = 0; n < 2; ++n) acc[a][b][m][n] = (f32x4){0.f, 0.f, 0.f, 0.f};
    bf16x8 At[4][2], B0[2][2], B1[2][2];
    const char* cA = (const char*)g.A + (size_t)cur.pm * tstep; const char* cB = (const char*)g.Bt + (size_t)cur.pn * tstep;
    S.a_ready(cur);
    PG8_STAGE(PG8_SB(0, 0), cB, voffB); PG8_STAGE(PG8_SA(0, 0), cA, voffA); PG8_STAGE(PG8_SB(0, 1), cB + hstep, voffB); PG8_STAGE(PG8_SA(0, 1), cA + hstep, voffA);
    if (wr == 1) PG8_BAR;
    PG8_WAIT_V(4); PG8_BAR;
    PG8_STAGE(PG8_SB(1, 0), cB + kstep, voffB); PG8_STAGE(PG8_SA(1, 0), cA + kstep, voffA); PG8_STAGE(PG8_SB(1, 1), cB + hstep + kstep, voffB);
    PG8_WAIT_V(6); PG8_BAR;
    PG8_STAMP();
    for (;;) {
        const bool has_next = S.next(ui + 1, nxt);
        const char* nA = has_next ? (const char*)g.A + (size_t)nxt.pm * tstep : cA; const char* nB = has_next ? (const char*)g.Bt + (size_t)nxt.pn * tstep : cB;
        for (int t = 0; t < nt; t += 2) {
            const bool last = (t == nt - 2);
            const char* a1 = cA + (size_t)(t + 1) * kstep;
            const char* a2 = last ? nA : cA + (size_t)(t + 2) * kstep; const char* b2 = last ? nB : cB + (size_t)(t + 2) * kstep;
            const char* a3 = a2 + kstep; const char* b3 = b2 + kstep;
            if (last && has_next) S.a_ready(nxt);
            PG8_LDB(B0, 0, 0); PG8_SCHED; PG8_LDA(At, 0, 0); PG8_STAGE(PG8_SA(1, 1), a1 + hstep, voffA);
            PG8_WAIT_L(8); PG8_BAR; PG8_WAIT_L(0); PG8_MMA(0, 0, At, B0); PG8_BAR; PG8_SCHED;
            PG8_LDB(B1, 0, 1); PG8_STAGE(PG8_SB(0, 0), b2, voffB);
            PG8_BAR; PG8_WAIT_L(0); PG8_MMA(0, 1, At, B1); PG8_BAR;
            PG8_LDA(At, 0, 1); PG8_STAGE(PG8_SA(0, 0), a2, voffA);
            PG8_BAR; PG8_WAIT_L(0); PG8_MMA(1, 0, At, B0); PG8_BAR; PG8_SCHED;
            PG8_STAGE(PG8_SB(0, 1), b2 + hstep, voffB);
            PG8_WAIT_V(6); PG8_BAR; PG8_MMA(1, 1, At, B1); PG8_BAR;
            PG8_LDB(B0, 1, 0); PG8_SCHED; PG8_LDA(At, 1, 0); PG8_STAGE(PG8_SA(0, 1), a2 + hstep, voffA);
            PG8_WAIT_L(8); PG8_BAR; PG8_WAIT_L(0); PG8_MMA(0, 0, At, B0); PG8_BAR; PG8_SCHED;
            PG8_LDB(B1, 1, 1); PG8_STAGE(PG8_SB(1, 0), b3, voffB);
            PG8_BAR; PG8_WAIT_L(0); PG8_MMA(0, 1, At, B1); PG8_BAR;
            PG8_LDA(At, 1, 1); PG8_STAGE(PG8_SA(1, 0), a3, voffA);
            PG8_BAR; PG8_WAIT_L(0); PG8_MMA(1, 0, At, B0); PG8_BAR; PG8_SCHED;
            PG8_STAGE(PG8_SB(1, 1), b3 + hstep, voffB);
            PG8_WAIT_V(6); PG8_BAR; PG8_MMA(1, 1, At, B1); PG8_BAR;
        }
        PG8_STAMP();
        if constexpr (!Epi::AFTER_DRAIN) { E(acc, cur, wr, wc, fr, fq); S.done(cur); }
        PG8_STAMP();
        if (!has_next) break;
#pragma unroll
        for (int a = 0; a < 2; ++a)
#pragma unroll
            for (int b = 0; b < 2; ++b)
#pragma unroll
                for (int m = 0; m < 4; ++m)
#pragma unroll
                    for (int n = 0; n < 2; ++n) acc[a][b][m][n] = (f32x4){0.f, 0.f, 0.f, 0.f};
        cur = nxt; cA = nA; cB = nB; ++ui;
    }
    PG8_WAIT_V(0);
    if (wr == 0) PG8_BAR;
    PG8_BAR;
    if constexpr (Epi::AFTER_DRAIN) { E.fused(acc, cur, wr, wc, fr, fq, lds, wid, lane); S.done(cur); }
    PG8_STAMP();
    if (STAMP && wid == 0) { stamps[lane] = lane < nts ? (((unsigned long long)(unsigned)ts_hi << 32) | (unsigned)ts_lo) : 0ull;
        if (lane == 62) stamps[62] = rt_entry; if (lane == 63) stamps[63] = (unsigned long long)wall_clock64(); }
#undef PG8_STAMP
#undef PG8_SA
#undef PG8_SB
#undef PG8_STAGE
#undef PG8_LDA
#undef PG8_LDB
#undef PG8_MMA
#undef PG8_WAIT_V
#undef PG8_WAIT_L
#undef PG8_BAR
#undef PG8_SCHED
}
}
using pg8::bf16_t; using pg8::bf16x8; using pg8::f32x4; using pg8::u32x4; using pg8::Unit;
typedef unsigned u32x2 __attribute__((ext_vector_type(2)));
#define MFMA16(a, b, c) __builtin_amdgcn_mfma_f32_16x16x32_bf16((a), (b), (c), 0, 0, 0)

constexpr int T_ = 16384, DM = 2048, NIN = 6144, DFF = 5504, NFF = 11008;
constexpr int LDS_BYTES = 144 * 1024;
constexpr int NPH = 11;

constexpr size_t O_CTR   = 0;
constexpr size_t O_WIN   = 4096;
constexpr size_t O_WOUT  = O_WIN   + (size_t)NIN * DM * 2;
constexpr size_t O_WFIN  = O_WOUT  + (size_t)DM * DM * 2;
constexpr size_t O_WFOUT = O_WFIN  + (size_t)NFF * DM * 2;
constexpr size_t O_WCK   = O_WFOUT + (size_t)DM * DFF * 2;
constexpr size_t O_WCV   = O_WCK   + (size_t)256 * 2048 * 2;
constexpr size_t O_WGLU  = O_WCV   + (size_t)256 * 2048 * 2;
constexpr size_t O_HN    = O_WGLU  + (size_t)512 * 512 * 2;
constexpr size_t O_R     = O_HN    + (size_t)T_ * DM * 2;
constexpr size_t O_P32   = O_R;
constexpr size_t O_PU    = O_P32   + (size_t)T_ * 1536 * 4;
constexpr size_t O_PQKV  = O_PU    + (size_t)T_ * 512 * 2;
constexpr size_t O_PZ    = O_PQKV  + (size_t)T_ * 3072 * 2;
constexpr size_t O_QN    = O_PZ    + (size_t)T_ * 1024 * 2;
constexpr size_t O_KSN   = O_QN    + (size_t)T_ * 512 * 2;
constexpr size_t O_KWN   = O_KSN   + (size_t)T_ * 128 * 2;
constexpr size_t O_VST   = O_KWN   + (size_t)T_ * 128 * 2;
constexpr size_t O_VWT   = O_VST   + (size_t)T_ * 128 * 2;
constexpr size_t O_KC    = O_VWT   + (size_t)T_ * 128 * 2;
constexpr size_t O_VCT   = O_KC    + (size_t)2 * 1024 * 64 * 2;
constexpr size_t O_HCMP  = O_VCT   + (size_t)2 * 64 * 1024 * 2;
constexpr size_t O_GKC   = O_HCMP  + (size_t)2 * 2048 * 256 * 4;
constexpr size_t O_GQG   = O_GKC   + (size_t)2048 * 64 * 128 * 2;
constexpr size_t O_GQK   = O_GQG   + (size_t)2048 * 64 * 128 * 2;
constexpr size_t O_GKD   = O_GQK   + (size_t)2048 * 64 * 64 * 2;
constexpr size_t O_GVAL  = O_GKD   + (size_t)2048 * 64 * 128 * 2;
constexpr size_t O_GEGL  = O_GVAL  + (size_t)2048 * 64 * 128 * 4;
constexpr size_t O_XEND  = O_GEGL  + 8192;
constexpr size_t O_YGELU = O_XEND  + (size_t)64 * 32 * 64 * 2 * 4;
constexpr size_t O_YGLU  = O_YGELU + (size_t)T_ * 512 * 2;
constexpr size_t O_ATT_END = O_YGLU + (size_t)T_ * 512 * 4;
constexpr size_t O_HF    = O_R;
constexpr size_t O_ACT   = O_HF    + (size_t)T_ * NFF * 2;
constexpr size_t O_FFN_END = O_ACT + (size_t)T_ * DFF * 2;
constexpr size_t WS_NEED = O_ATT_END > O_FFN_END ? O_ATT_END : O_FFN_END;

struct Params { const float* in[33]; float* out; unsigned char* ws; int ph_lo, ph_hi; };

__device__ __forceinline__ int tidx() { int t = threadIdx.x; asm volatile("" : "+v"(t)); return t; }
__device__ __forceinline__ unsigned short f2bf(float f) { unsigned u = __float_as_uint(f); u += 0x7FFFu + ((u >> 16) & 1u); return (unsigned short)(u >> 16); }
__device__ __forceinline__ float bf2f(unsigned short b) { return __uint_as_float(((unsigned)b) << 16); }
__device__ __forceinline__ unsigned pk2(float lo, float hi) { return pg8::cvt_pk_bf16(lo, hi); }
__device__ __forceinline__ float bflo(unsigned w) { return __uint_as_float(w << 16); }
__device__ __forceinline__ float bfhi(unsigned w) { return __uint_as_float(w & 0xFFFF0000u); }
__device__ __forceinline__ float sigmoidf_(float x) { return 1.0f / (1.0f + __expf(-x)); }
__device__ __forceinline__ float siluf_(float x) { return x / (1.0f + __expf(-x)); }
__device__ __forceinline__ float gelu_tanh(float x) { const float u = 0.7978845608028654f * (x + 0.044715f * x * x * x); const float th = 1.0f - 2.0f / (__expf(2.0f * u) + 1.0f); return 0.5f * x * (1.0f + th); }
__device__ __forceinline__ float softplusf_(float x) { return x > 20.f ? x : log1pf(expf(x)); }
__device__ __forceinline__ float wave_sum(float v) { for (int o = 32; o >= 1; o >>= 1) v += __shfl_xor(v, o); return v; }
__device__ __forceinline__ bf16x8 pack8f(f32x4 a, f32x4 b) { u32x4 w; w.x = pk2(a[0], a[1]); w.y = pk2(a[2], a[3]); w.z = pk2(b[0], b[1]); w.w = pk2(b[2], b[3]); return __builtin_bit_cast(bf16x8, w); }
__device__ __forceinline__ float rdlane(float v, int l) { return __int_as_float(__builtin_amdgcn_readlane(__float_as_int(v), l)); }

struct EpiProj {
    static constexpr bool PERM = false, AFTER_DRAIN = false;
    float* P32; bf16_t* Pu; bf16_t* Pqkv; bf16_t* Pz;
    static __device__ __forceinline__ void st_bf(const f32x4 (&acc)[2][2][4][2], bf16_t* base, int ld) {
#pragma unroll
        for (int ai = 0; ai < 2; ++ai)
#pragma unroll
            for (int m = 0; m < 4; ++m) { bf16_t* rp = base + (size_t)(ai * 128 + m * 16) * ld;
#pragma unroll
                for (int bj = 0; bj < 2; ++bj)
#pragma unroll
                    for (int n = 0; n < 2; ++n) { const f32x4 v = acc[ai][bj][m][n]; u32x2 w; w.x = pk2(v[0], v[1]); w.y = pk2(v[2], v[3]); *(u32x2*)(rp + bj * 128 + n * 16) = w; } }
    }
    __device__ __forceinline__ void operator()(const f32x4 (&acc)[2][2][4][2], const Unit& u, int wr, int wc, int fr, int fq) const {
        const int row0 = u.pm * 256 + wr * 64 + fr, colt = wc * 32 + 4 * fq;
        if (u.pn < 6) {
            float* base = P32 + (size_t)row0 * 1536 + u.pn * 256 + colt;
#pragma unroll
            for (int ai = 0; ai < 2; ++ai)
#pragma unroll
                for (int m = 0; m < 4; ++m) { float* rp = base + (size_t)(ai * 128 + m * 16) * 1536;
#pragma unroll
                    for (int bj = 0; bj < 2; ++bj)
#pragma unroll
                        for (int n = 0; n < 2; ++n) *(f32x4*)(rp + bj * 128 + n * 16) = acc[ai][bj][m][n]; }
        } else if (u.pn < 8)  st_bf(acc, Pu   + (size_t)row0 * 512  + (u.pn - 6)  * 256 + colt, 512);
        else if (u.pn < 20)   st_bf(acc, Pqkv + (size_t)row0 * 3072 + (u.pn - 8)  * 256 + colt, 3072);
        else                  st_bf(acc, Pz   + (size_t)row0 * 1024 + (u.pn - 20) * 256 + colt, 1024);
    }
};
struct EpiResid {
    static constexpr bool PERM = false, AFTER_DRAIN = false;
    float* X; int ld;
    __device__ __forceinline__ void operator()(const f32x4 (&acc)[2][2][4][2], const Unit& u, int wr, int wc, int fr, int fq) const {
        float* base = X + (size_t)(u.pm * 256 + wr * 64 + fr) * ld + u.pn * 256 + wc * 32 + 4 * fq;
#pragma unroll
        for (int ai = 0; ai < 2; ++ai)
#pragma unroll
            for (int m = 0; m < 4; ++m) { float* rp = base + (size_t)(ai * 128 + m * 16) * ld;
#pragma unroll
                for (int bj = 0; bj < 2; ++bj)
#pragma unroll
                    for (int n = 0; n < 2; ++n) { f32x4* q = (f32x4*)(rp + bj * 128 + n * 16); *q = *q + acc[ai][bj][m][n]; } }
    }
};
struct EpiBf {
    static constexpr bool PERM = false, AFTER_DRAIN = false;
    bf16_t* O; int ld;
    __device__ __forceinline__ void operator()(const f32x4 (&acc)[2][2][4][2], const Unit& u, int wr, int wc, int fr, int fq) const {
        bf16_t* base = O + (size_t)(u.pm * 256 + wr * 64 + fr) * ld + u.pn * 256 + wc * 32 + 4 * fq;
#pragma unroll
        for (int ai = 0; ai < 2; ++ai)
#pragma unroll
            for (int m = 0; m < 4; ++m) { bf16_t* rp = base + (size_t)(ai * 128 + m * 16) * ld;
#pragma unroll
                for (int bj = 0; bj < 2; ++bj)
#pragma unroll
                    for (int n = 0; n < 2; ++n) { const f32x4 v = acc[ai][bj][m][n]; u32x2 w; w.x = pk2(v[0], v[1]); w.y = pk2(v[2], v[3]); *(u32x2*)(rp + bj * 128 + n * 16) = w; } }
    }
};
struct EpiGlu {
    static constexpr bool PERM = false, AFTER_DRAIN = false;
    const bf16_t* Y; float* O;
    __device__ __forceinline__ void operator()(const f32x4 (&acc)[2][2][4][2], const Unit& u, int wr, int wc, int fr, int fq) const {
        const size_t off0 = (size_t)(u.pm * 256 + wr * 64 + fr) * 512 + u.pn * 256 + wc * 32 + 4 * fq;
#pragma unroll
        for (int ai = 0; ai < 2; ++ai)
#pragma unroll
            for (int m = 0; m < 4; ++m) { const size_t ro = off0 + (size_t)(ai * 128 + m * 16) * 512;
#pragma unroll
                for (int bj = 0; bj < 2; ++bj)
#pragma unroll
                    for (int n = 0; n < 2; ++n) { const size_t o = ro + bj * 128 + n * 16; const u32x2 yw = *(const u32x2*)(Y + o); const f32x4 a = acc[ai][bj][m][n];
                        f32x4 r; r[0] = bflo(yw.x) * sigmoidf_(a[0]); r[1] = bfhi(yw.x) * sigmoidf_(a[1]); r[2] = bflo(yw.y) * sigmoidf_(a[2]); r[3] = bfhi(yw.y) * sigmoidf_(a[3]); *(f32x4*)(O + o) = r; } }
    }
};
__device__ __forceinline__ int map_in_col(int n) { return n < 1304 ? n : (n < 1312 ? 5912 + (n - 1304) : (n < 1320 ? 5920 + (n - 1312) : (n < 1536 ? -1 : 1304 + (n - 1536)))); }
__device__ void convT_tile(const float* __restrict__ src, int srcN, int K, bf16_t* __restrict__ dst, int tile, bool inmap, float* sm) {
    const int nk = K >> 6, tk = tile % nk, tn = tile / nk, k0 = tk * 64, n0 = tn * 64;
    const int tx = tidx() & 63, ty = tidx() >> 6;
    const int n = n0 + tx, sc = inmap ? map_in_col(n) : n;
#pragma unroll
    for (int i = 0; i < 8; ++i) { const int k = ty + 8 * i; sm[k * 65 + tx] = (sc >= 0) ? src[(size_t)(k0 + k) * srcN + sc] : 0.f; }
    __syncthreads();
#pragma unroll
    for (int i = 0; i < 8; ++i) { const int nn = ty + 8 * i; dst[(size_t)(n0 + nn) * K + k0 + tx] = f2bf(sm[tx * 65 + nn]); }
    __syncthreads();
}
__device__ void phase_convert(const Params& p, int layer, float* sm) {
    unsigned char* ws = p.ws;
    const int G = gridDim.x, b = blockIdx.x;
    const int n0 = 32 * 96, n1 = n0 + 32 * 32, n2 = n1 + 32 * 172, n3 = n2 + 86 * 32, n4 = n3 + 128, n5 = n4 + 128, n6 = n5 + 64;
    for (int it = b; it < n6; it += G) {
        if (it < n0)      convT_tile(p.in[2]  + (size_t)layer * DM * 5928, 5928, DM, (bf16_t*)(ws + O_WIN), it, true, sm);
        else if (it < n1) convT_tile(p.in[27] + (size_t)layer * DM * DM, DM, DM, (bf16_t*)(ws + O_WOUT), it - n0, false, sm);
        else if (it < n2) convT_tile(p.in[29] + (size_t)layer * DM * NFF, NFF, DM, (bf16_t*)(ws + O_WFIN), it - n1, false, sm);
        else if (it < n3) convT_tile(p.in[32] + (size_t)layer * DFF * DM, DM, DFF, (bf16_t*)(ws + O_WFOUT), it - n2, false, sm);
        else if (it < n4) convT_tile(p.in[8]  + (size_t)layer * 2048 * 256, 256, 2048, (bf16_t*)(ws + O_WCK), it - n3, false, sm);
        else if (it < n5) convT_tile(p.in[10] + (size_t)layer * 2048 * 256, 256, 2048, (bf16_t*)(ws + O_WCV), it - n4, false, sm);
        else              convT_tile(p.in[21] + (size_t)layer * 512 * 512, 512, 512, (bf16_t*)(ws + O_WGLU), it - n5, false, sm);
    }
}
__device__ void phase_rmsnorm(const float* __restrict__ x, const float* __restrict__ gain, bf16_t* __restrict__ hn, float* __restrict__ xcopy) {
    const int wave = tidx() >> 6, lane = tidx() & 63;
    for (int r = blockIdx.x * 8 + wave; r < T_; r += gridDim.x * 8) {
        const f32x4* xr = (const f32x4*)(x + (size_t)r * DM);
        f32x4 v[8]; float ss = 0.f;
#pragma unroll
        for (int i = 0; i < 8; ++i) { v[i] = xr[lane + 64 * i]; ss += v[i][0] * v[i][0] + v[i][1] * v[i][1] + v[i][2] * v[i][2] + v[i][3] * v[i][3]; }
        ss = wave_sum(ss);
        const float rs = rsqrtf(ss * (1.0f / DM) + 1e-6f);
#pragma unroll
        for (int i = 0; i < 8; ++i) { const f32x4 g = ((const f32x4*)gain)[lane + 64 * i]; u32x2 w; w.x = pk2(v[i][0] * rs * g[0], v[i][1] * rs * g[1]); w.y = pk2(v[i][2] * rs * g[2], v[i][3] * rs * g[3]);
            *(u32x2*)(hn + (size_t)r * DM + (lane + 64 * i) * 4) = w; if (xcopy) ((f32x4*)(xcopy + (size_t)r * DM))[lane + 64 * i] = v[i]; }
    }
}

__device__ void nsa_prep_item(const Params& p, int layer, int item, float* sm) {
    unsigned char* ws = p.ws;
    const float* P32 = (const float*)(ws + O_P32);
    bf16_t* qn = (bf16_t*)(ws + O_QN); bf16_t* ksn = (bf16_t*)(ws + O_KSN); bf16_t* kwn = (bf16_t*)(ws + O_KWN);
    const int wave = tidx() >> 6, lane = tidx() & 63, tid = tidx();
    const int t0 = item * 64;
    const float gq = p.in[3][layer * 64 + lane], gks = p.in[5][layer * 64 + lane], gkw = p.in[6][layer * 64 + lane];
    const float inv = powf(500000.0f, -(float)(lane & 7) * 0.125f);
    for (int tt = 0; tt < 8; ++tt) {
        const int t = t0 + wave * 8 + tt;
        float sn, cs; sincosf((float)t * inv, &sn, &cs);
        const float* row = P32 + (size_t)t * 1536;
#pragma unroll
        for (int hv = 0; hv < 12; ++hv) {
            const int col = hv < 8 ? hv * 64 : (hv < 10 ? 768 + (hv - 8) * 64 : 1024 + (hv - 10) * 64);
            const float g = hv < 8 ? gq : (hv < 10 ? gks : gkw);
            const float x = row[col + lane];
            const float ss = wave_sum(x * x);
            float y = x * rsqrtf(ss * (1.0f / 64.0f) + 1e-6f) * g;
            const float yp = __shfl(y, lane ^ 8);
            if (lane < 8) y = y * cs - yp * sn; else if (lane < 16) y = y * cs + yp * sn;
            if (hv < 8) qn[(size_t)t * 512 + hv * 64 + lane] = f2bf(y * 0.125f);
            else if (hv < 10) ksn[(size_t)t * 128 + (hv - 8) * 64 + lane] = f2bf(y);
            else kwn[(size_t)t * 128 + (hv - 10) * 64 + lane] = f2bf(y);
        }
    }
    for (int e = tid; e < 64 * 256; e += 512) { const int tk = e >> 8, c = e & 255; sm[tk * 257 + c] = P32[(size_t)(t0 + tk) * 1536 + (c < 128 ? 896 + c : 1152 + (c - 128))]; }
    __syncthreads();
    bf16_t* vsT = (bf16_t*)(ws + O_VST); bf16_t* vwT = (bf16_t*)(ws + O_VWT);
#pragma unroll
    for (int i = 0; i < 4; ++i) {
        const int rowid = (tid >> 3) + 64 * i, ts = tid & 7;
        u32x4 w; float f[8];
#pragma unroll
        for (int k = 0; k < 8; ++k) f[k] = sm[(ts * 8 + k) * 257 + rowid];
        w.x = pk2(f[0], f[1]); w.y = pk2(f[2], f[3]); w.z = pk2(f[4], f[5]); w.w = pk2(f[6], f[7]);
        bf16_t* dst = (rowid < 128 ? vsT + (size_t)rowid * T_ : vwT + (size_t)(rowid - 128) * T_) + t0 + ts * 8;
        *(u32x4*)dst = w;
    }
    __syncthreads();
}

__device__ void cmp1_wave_tile(const Params& p, int layer, int tile) {
    unsigned char* ws = p.ws;
    const float* P32 = (const float*)(ws + O_P32);
    const int lane = tidx() & 63, fr = lane & 15, fq = lane >> 4;
    const int nt = tile & 15, mt = (tile >> 4) & 127, which = tile >> 11;
    const bf16_t* Wt = (const bf16_t*)(ws + (which ? O_WCV : O_WCK)) + (size_t)(nt * 16 + fr) * 2048 + fq * 8;
    const float* pe = p.in[7] + (size_t)layer * 2048;
    const int r = mt * 16 + fr, n = r >> 1, hk = r & 1;
    const bool rv = n < 1023;
    const float* arow = P32 + (size_t)(16 * (rv ? n : 0)) * 1536 + (which ? 640 : 512) + hk * 64 + fq * 8;
    f32x4 acc = {0.f, 0.f, 0.f, 0.f};
#pragma unroll 4
    for (int ks = 0; ks < 64; ++ks) {
        const int l = ks >> 1, d = (ks & 1) * 32;
        const f32x4* ap = (const f32x4*)(arow + (size_t)l * 1536 + d);
        const f32x4* pp = (const f32x4*)(pe + l * 64 + d + fq * 8);
        f32x4 a0 = ap[0] + pp[0], a1 = ap[1] + pp[1];
        if (!rv) { a0 = (f32x4){0.f, 0.f, 0.f, 0.f}; a1 = a0; }
        const bf16x8 af = pack8f(a0, a1);
        const bf16x8 bf = *(const bf16x8*)(Wt + ks * 32);
        acc = MFMA16(af, bf, acc);
    }
    float* H = (float*)(ws + O_HCMP) + (size_t)which * 2048 * 256;
#pragma unroll
    for (int j = 0; j < 4; ++j) H[(size_t)(mt * 16 + fq * 4 + j) * 256 + nt * 16 + fr] = gelu_tanh(acc[j]);
}
__device__ void cmp2_wave_row(const Params& p, int layer, int idx) {
    unsigned char* ws = p.ws;
    const int lane = tidx() & 63;
    const int which = idx >> 11, r = idx & 2047, n = r >> 1, hk = r & 1;
    const float* H = (const float*)(ws + O_HCMP) + ((size_t)which * 2048 + r) * 256;
    const float* w2 = p.in[which ? 11 : 9] + (size_t)layer * 256 * 64;
    float acc = 0.f;
    if (n < 1023) {
#pragma unroll 8
        for (int f = 0; f < 256; ++f) acc += H[f] * w2[f * 64 + lane];
    }
    if (which == 0) {
        const float ss = wave_sum(acc * acc);
        float y = acc * rsqrtf(ss * (1.0f / 64.0f) + 1e-6f) * p.in[4][layer * 64 + lane];
        const float inv = powf(500000.0f, -(float)(lane & 7) * 0.125f);
        float sn, cs; sincosf((float)(16 * n + 16) * inv, &sn, &cs);
        const float yp = __shfl(y, lane ^ 8);
        if (lane < 8) y = y * cs - yp * sn; else if (lane < 16) y = y * cs + yp * sn;
        if (n >= 1023) y = 0.f;
        ((bf16_t*)(ws + O_KC))[((size_t)hk * 1024 + n) * 64 + lane] = f2bf(y);
    } else {
        ((bf16_t*)(ws + O_VCT))[((size_t)hk * 64 + lane) * 1024 + n] = f2bf(acc);
    }
}

struct S5Coef { float ar, ai; float bbr[16], bbi[16]; };
__device__ __forceinline__ void s5_setup(const Params& p, int layer, int g, int lane, S5Coef& c) {
    const int gp = layer * 2048 + g * 64 + lane;
    const float dt = expf(p.in[15][layer * 32 + g]);
    const float lr = p.in[13][gp], li = p.in[14][gp];
    const float mag = expf(lr * dt); float sn, cs; sincosf(li * dt, &sn, &cs);
    c.ar = mag * cs; c.ai = mag * sn;
    const float den = lr * lr + li * li, nr = c.ar - 1.0f, ni = c.ai;
    const float cr = (nr * lr + ni * li) / den, ci = (ni * lr - nr * li) / den;
    const f32x4* br = (const f32x4*)(p.in[16] + (size_t)gp * 16); const f32x4* bi = (const f32x4*)(p.in[17] + (size_t)gp * 16);
#pragma unroll
    for (int q = 0; q < 4; ++q) { const f32x4 a = br[q], b = bi[q];
#pragma unroll
        for (int e = 0; e < 4; ++e) { c.bbr[q * 4 + e] = cr * a[e] - ci * b[e]; c.bbi[q * 4 + e] = cr * b[e] + ci * a[e]; } }
}
__device__ __forceinline__ void s5_load_u(const bf16_t* Pu, int tok, int g, float (&ur)[16]) {
    const u32x4* s = (const u32x4*)(Pu + (size_t)tok * 512 + g * 16); const u32x4 a = s[0], b = s[1];
    ur[0] = bflo(a.x); ur[1] = bfhi(a.x); ur[2] = bflo(a.y); ur[3] = bfhi(a.y); ur[4] = bflo(a.z); ur[5] = bfhi(a.z); ur[6] = bflo(a.w); ur[7] = bfhi(a.w);
    ur[8] = bflo(b.x); ur[9] = bfhi(b.x); ur[10] = bflo(b.y); ur[11] = bfhi(b.y); ur[12] = bflo(b.z); ur[13] = bfhi(b.z); ur[14] = bflo(b.w); ur[15] = bfhi(b.w);
}
__device__ void s5_passA_wave(const Params& p, int layer, int item) {
    unsigned char* ws = p.ws; const bf16_t* Pu = (const bf16_t*)(ws + O_PU);
    const int lane = tidx() & 63, c = item >> 5, g = item & 31;
    S5Coef k; s5_setup(p, layer, g, lane, k);
    float xr = 0.f, xi = 0.f;
    for (int sub = 0; sub < 4; ++sub) {
        float ur[16]; s5_load_u(Pu, c * 256 + sub * 64 + lane, g, ur);
        for (int j = 0; j < 64; ++j) {
            float bur = 0.f, bui = 0.f;
#pragma unroll
            for (int h = 0; h < 16; ++h) { const float u = rdlane(ur[h], j); bur += k.bbr[h] * u; bui += k.bbi[h] * u; }
            const float nxr = k.ar * xr - k.ai * xi + bur, nxi = k.ar * xi + k.ai * xr + bui; xr = nxr; xi = nxi;
        }
    }
    float* xe = (float*)(ws + O_XEND) + ((size_t)(c * 32 + g) * 64 + lane) * 2; xe[0] = xr; xe[1] = xi;
}
__device__ void s5_passB_wave(const Params& p, int layer, int item, bf16_t* xl) {
    unsigned char* ws = p.ws; const bf16_t* Pu = (const bf16_t*)(ws + O_PU); bf16_t* yg = (bf16_t*)(ws + O_YGELU);
    const int lane = tidx() & 63, fr = lane & 15, fq = lane >> 4, c = item >> 5, g = item & 31;
    S5Coef k; s5_setup(p, layer, g, lane, k);
    float pr = k.ar, pi = k.ai;
#pragma unroll
    for (int s = 0; s < 8; ++s) { const float nr = pr * pr - pi * pi, ni = 2.f * pr * pi; pr = nr; pi = ni; }
    float xr = 0.f, xi = 0.f;
    const float* xe = (const float*)(ws + O_XEND) + ((size_t)g * 64 + lane) * 2;
    for (int cc = 0; cc < c; ++cc) { const float er = xe[(size_t)cc * 32 * 64 * 2], ei = xe[(size_t)cc * 32 * 64 * 2 + 1]; const float nr = pr * xr - pi * xi + er, ni = pr * xi + pi * xr + ei; xr = nr; xi = ni; }
    bf16x8 cf[4];
    {
        const float* cre = p.in[18] + (size_t)layer * 32 * 16 * 64 + ((size_t)g * 16 + fr) * 64; const float* cim = p.in[19] + (size_t)layer * 32 * 16 * 64 + ((size_t)g * 16 + fr) * 64;
#pragma unroll
        for (int ks = 0; ks < 4; ++ks) { const float* s = (ks < 2 ? cre : cim) + (ks & 1) * 32 + fq * 8; f32x4 a = ((const f32x4*)s)[0], b = ((const f32x4*)s)[1]; if (ks >= 2) { a = -a; b = -b; } cf[ks] = pack8f(a, b); }
    }
    const float dsk = p.in[20][layer * 512 + g * 16 + fr];
    for (int sub = 0; sub < 4; ++sub) {
        const int tb = c * 256 + sub * 64;
        float ur[16]; s5_load_u(Pu, tb + lane, g, ur);
        for (int jb = 0; jb < 4; ++jb) {
            for (int jj = 0; jj < 16; ++jj) {
                const int j = jb * 16 + jj;
                float bur = 0.f, bui = 0.f;
#pragma unroll
                for (int h = 0; h < 16; ++h) { const float u = rdlane(ur[h], j); bur += k.bbr[h] * u; bui += k.bbi[h] * u; }
                const float nxr = k.ar * xr - k.ai * xi + bur, nxi = k.ar * xi + k.ai * xr + bui; xr = nxr; xi = nxi;
                xl[jj * 136 + lane] = f2bf(xr); xl[jj * 136 + 64 + lane] = f2bf(xi);
            }
            asm volatile("s_waitcnt lgkmcnt(0)" ::: "memory");
            f32x4 y = {0.f, 0.f, 0.f, 0.f};
#pragma unroll
            for (int ks = 0; ks < 4; ++ks) { const bf16x8 af = *(const bf16x8*)(xl + fr * 136 + ks * 32 + fq * 8); y = MFMA16(af, cf[ks], y); }
            asm volatile("s_waitcnt lgkmcnt(0)" ::: "memory");
#pragma unroll
            for (int q = 0; q < 4; ++q) { const int tok = tb + jb * 16 + fq * 4 + q; const float u = bf2f(Pu[(size_t)tok * 512 + g * 16 + fr]); yg[(size_t)tok * 512 + g * 16 + fr] = f2bf(gelu_tanh(y[q] + dsk * u)); }
        }
    }
}
__device__ void gdn_prep_item(const Params& p, int layer, int item, unsigned char* lds) {
    unsigned char* ws = p.ws;
    const int tid = tidx(), wave = tid >> 6, lane = tid & 63, fr = lane & 15, fq = lane >> 4;
    const int n = item >> 3, h = item & 7, t0 = n * 64;
    bf16_t* qs = (bf16_t*)(lds); bf16_t* ks = (bf16_t*)(lds + 17408); bf16_t* vbT = (bf16_t*)(lds + 34816); bf16_t* kgT = (bf16_t*)(lds + 53248); bf16_t* kdT = (bf16_t*)(lds + 71680);
    float* Am = (float*)(lds + 90112); bf16_t* Tb = (bf16_t*)(lds + 107520); float* gcs = (float*)(lds + 116736); float* bts = (float*)(lds + 116992);
    const float* P32 = (const float*)(ws + O_P32); const bf16_t* Pqkv = (const bf16_t*)(ws + O_PQKV);
    if (wave == 0) {
        const int t = t0 + lane;
        const float a = P32[(size_t)t * 1536 + 1304 + h], b = P32[(size_t)t * 1536 + 1312 + h];
        const float g = -expf(p.in[24][layer * 8 + h]) * softplusf_(a + p.in[25][layer * 8 + h]);
        float s = g;
#pragma unroll
        for (int off = 1; off < 64; off <<= 1) { const float o = __shfl_up(s, off); if (lane >= off) s += o; }
        gcs[lane] = s; bts[lane] = sigmoidf_(b);
    }
    __syncthreads();
    {
        const int r = tid >> 3, c0 = (tid & 7) * 16;
        const float gcr = gcs[r], btr = bts[r], eg = expf(gcr), ed = expf(gcs[63] - gcr);
        const float* cw = p.in[23] + (size_t)layer * 4 * 3072;
#pragma unroll
        for (int which = 0; which < 3; ++which) {
            const int col = which * 1024 + h * 128 + c0;
            float acc[16];
#pragma unroll
            for (int e = 0; e < 16; ++e) acc[e] = 0.f;
#pragma unroll
            for (int j = 0; j < 4; ++j) {
                const int tr = t0 + r - 3 + j;
                if (tr >= 0) {
                    const u32x4* s = (const u32x4*)(Pqkv + (size_t)tr * 3072 + col); const u32x4 a = s[0], b = s[1];
                    const f32x4* wp = (const f32x4*)(cw + j * 3072 + col); const f32x4 w0 = wp[0], w1 = wp[1], w2 = wp[2], w3 = wp[3];
                    acc[0] += w0[0] * bflo(a.x); acc[1] += w0[1] * bfhi(a.x); acc[2] += w0[2] * bflo(a.y); acc[3] += w0[3] * bfhi(a.y);
                    acc[4] += w1[0] * bflo(a.z); acc[5] += w1[1] * bfhi(a.z); acc[6] += w1[2] * bflo(a.w); acc[7] += w1[3] * bfhi(a.w);
                    acc[8] += w2[0] * bflo(b.x); acc[9] += w2[1] * bfhi(b.x); acc[10] += w2[2] * bflo(b.y); acc[11] += w2[3] * bfhi(b.y);
                    acc[12] += w3[0] * bflo(b.z); acc[13] += w3[1] * bfhi(b.z); acc[14] += w3[2] * bflo(b.w); acc[15] += w3[3] * bfhi(b.w);
                }
            }
            float ss = 0.f;
#pragma unroll
            for (int e = 0; e < 16; ++e) { acc[e] = siluf_(acc[e]); ss += acc[e] * acc[e]; }
            ss += __shfl_xor(ss, 1); ss += __shfl_xor(ss, 2); ss += __shfl_xor(ss, 4);
            const float rn = rsqrtf(ss + 1e-6f);
            if (which == 0) {
                bf16_t* qg = (bf16_t*)(ws + O_GQG) + (size_t)item * 8192 + r * 128 + c0;
                float v[16];
#pragma unroll
                for (int e = 0; e < 16; ++e) v[e] = acc[e] * rn * 0.08838834764831845f;
                u32x4 w0, w1; w0.x = pk2(v[0], v[1]); w0.y = pk2(v[2], v[3]); w0.z = pk2(v[4], v[5]); w0.w = pk2(v[6], v[7]); w1.x = pk2(v[8], v[9]); w1.y = pk2(v[10], v[11]); w1.z = pk2(v[12], v[13]); w1.w = pk2(v[14], v[15]);
                *(u32x4*)(qs + r * 136 + c0) = w0; *(u32x4*)(qs + r * 136 + c0 + 8) = w1;
                u32x4 g0, g1; g0.x = pk2(v[0] * eg, v[1] * eg); g0.y = pk2(v[2] * eg, v[3] * eg); g0.z = pk2(v[4] * eg, v[5] * eg); g0.w = pk2(v[6] * eg, v[7] * eg);
                g1.x = pk2(v[8] * eg, v[9] * eg); g1.y = pk2(v[10] * eg, v[11] * eg); g1.z = pk2(v[12] * eg, v[13] * eg); g1.w = pk2(v[14] * eg, v[15] * eg);
                *(u32x4*)qg = g0; *(u32x4*)(qg + 8) = g1;
            } else if (which == 1) {
                float v[16];
#pragma unroll
                for (int e = 0; e < 16; ++e) v[e] = acc[e] * rn;
                u32x4 w0, w1; w0.x = pk2(v[0], v[1]); w0.y = pk2(v[2], v[3]); w0.z = pk2(v[4], v[5]); w0.w = pk2(v[6], v[7]); w1.x = pk2(v[8], v[9]); w1.y = pk2(v[10], v[11]); w1.z = pk2(v[12], v[13]); w1.w = pk2(v[14], v[15]);
                *(u32x4*)(ks + r * 136 + c0) = w0; *(u32x4*)(ks + r * 136 + c0 + 8) = w1;
#pragma unroll
                for (int e = 0; e < 16; ++e) { kgT[(c0 + e) * 72 + r] = f2bf(v[e] * btr * eg); kdT[(c0 + e) * 72 + r] = f2bf(v[e] * ed); }
            } else {
#pragma unroll
                for (int e = 0; e < 16; ++e) vbT[(c0 + e) * 72 + r] = f2bf(acc[e] * btr);
            }
        }
    }
    __syncthreads();
    {
        const int d = tid >> 2, sg = tid & 3;
        const u32x4 a = *(const u32x4*)(kdT + d * 72 + sg * 16), b = *(const u32x4*)(kdT + d * 72 + sg * 16 + 8);
        bf16_t* dst = (bf16_t*)(ws + O_GKD) + (size_t)item * 8192 + d * 64 + sg * 16; *(u32x4*)dst = a; *(u32x4*)(dst + 8) = b;
    }
    {
        const int mi = wave >> 1;
        bf16_t* qko = (bf16_t*)(ws + O_GQK) + (size_t)item * 4096;
#pragma unroll
        for (int q = 0; q < 2; ++q) {
            const int nj = (wave & 1) * 2 + q;
            f32x4 kk = {0.f, 0.f, 0.f, 0.f}, qk = {0.f, 0.f, 0.f, 0.f};
            if (nj <= mi) {
#pragma unroll
                for (int s = 0; s < 4; ++s) {
                    const bf16x8 bk = *(const bf16x8*)(ks + (nj * 16 + fr) * 136 + s * 32 + fq * 8);
                    const bf16x8 ak = *(const bf16x8*)(ks + (mi * 16 + fr) * 136 + s * 32 + fq * 8);
                    const bf16x8 aq = *(const bf16x8*)(qs + (mi * 16 + fr) * 136 + s * 32 + fq * 8);
                    kk = MFMA16(ak, bk, kk); qk = MFMA16(aq, bk, qk);
                }
            }
            const int j = nj * 16 + fr; const float gj = gcs[j];
#pragma unroll
            for (int e = 0; e < 4; ++e) {
                const int i = mi * 16 + fq * 4 + e;
                const float dec = (j <= i) ? expf(gcs[i] - gj) : 0.f;
                Am[i * 68 + j] = (j < i) ? bts[i] * kk[e] * dec : 0.f;
                qko[i * 64 + j] = f2bf((j <= i) ? qk[e] * dec : 0.f);
            }
        }
    }
    __syncthreads();
    if (wave == 0) {
        float* Tm = (float*)(lds + 117248);
        for (int i = 0; i < 64; ++i) {
            float s = (i == lane) ? 1.f : 0.f;
            int j = 0;
            for (; j + 4 <= i; j += 4) { const f32x4 a = *(const f32x4*)(Am + i * 68 + j); s -= a[0] * Tm[j * 64 + lane]; s -= a[1] * Tm[(j + 1) * 64 + lane]; s -= a[2] * Tm[(j + 2) * 64 + lane]; s -= a[3] * Tm[(j + 3) * 64 + lane]; }
            for (; j < i; ++j) s -= Am[i * 68 + j] * Tm[j * 64 + lane];
            Tm[i * 64 + lane] = s;
            Tb[i * 72 + lane] = f2bf(s);
        }
    }
    __syncthreads();
    {
        const int mi = wave & 3;
        const bf16x8 a0 = *(const bf16x8*)(Tb + (mi * 16 + fr) * 72 + fq * 8), a1 = *(const bf16x8*)(Tb + (mi * 16 + fr) * 72 + 32 + fq * 8);
        float* vo = (float*)(ws + O_GVAL) + (size_t)item * 8192; bf16_t* ko = (bf16_t*)(ws + O_GKC) + (size_t)item * 8192;
#pragma unroll
        for (int q = 0; q < 4; ++q) {
            const int nt = (wave >> 2) * 4 + q;
            f32x4 v = {0.f, 0.f, 0.f, 0.f}, kc = {0.f, 0.f, 0.f, 0.f};
            v = MFMA16(a0, *(const bf16x8*)(vbT + (nt * 16 + fr) * 72 + fq * 8), v); v = MFMA16(a1, *(const bf16x8*)(vbT + (nt * 16 + fr) * 72 + 32 + fq * 8), v);
            kc = MFMA16(a0, *(const bf16x8*)(kgT + (nt * 16 + fr) * 72 + fq * 8), kc); kc = MFMA16(a1, *(const bf16x8*)(kgT + (nt * 16 + fr) * 72 + 32 + fq * 8), kc);
#pragma unroll
            for (int e = 0; e < 4; ++e) { const int i = mi * 16 + fq * 4 + e, d = nt * 16 + fr; vo[i * 128 + d] = v[e]; ko[i * 128 + d] = f2bf(kc[e]); }
        }
    }
    if (tid == 0) ((float*)(ws + O_GEGL))[item] = expf(gcs[63]);
    __syncthreads();
}

struct GdnFrag { bf16x8 kc[4], qg[4], qk[2], kd[2][2]; float val[4]; float egl; };
__device__ __forceinline__ void gdn_load(const unsigned char* ws, int item, int mt, int fr, int fq, int dv0, GdnFrag& f) {
    const bf16_t* kc = (const bf16_t*)(ws + O_GKC) + (size_t)item * 8192 + (mt * 16 + fr) * 128 + fq * 8;
    const bf16_t* qg = (const bf16_t*)(ws + O_GQG) + (size_t)item * 8192 + (mt * 16 + fr) * 128 + fq * 8;
    const bf16_t* qk = (const bf16_t*)(ws + O_GQK) + (size_t)item * 4096 + (mt * 16 + fr) * 64 + fq * 8;
    const bf16_t* kd = (const bf16_t*)(ws + O_GKD) + (size_t)item * 8192 + (2 * mt * 16 + fr) * 64 + fq * 8;
    const float* vl = (const float*)(ws + O_GVAL) + (size_t)item * 8192 + (mt * 16 + fq * 4) * 128 + dv0 + fr;
#pragma unroll
    for (int s = 0; s < 4; ++s) { f.kc[s] = *(const bf16x8*)(kc + s * 32); f.qg[s] = *(const bf16x8*)(qg + s * 32); }
#pragma unroll
    for (int s = 0; s < 2; ++s) { f.qk[s] = *(const bf16x8*)(qk + s * 32); f.kd[0][s] = *(const bf16x8*)(kd + s * 32); f.kd[1][s] = *(const bf16x8*)(kd + 16 * 64 + s * 32); }
#pragma unroll
    for (int e = 0; e < 4; ++e) f.val[e] = vl[e * 128];
    f.egl = ((const float*)(ws + O_GEGL))[item];
}
__device__ void gdn_recurrence(const Params& p, int b, unsigned char* lds) {
    const unsigned char* ws = p.ws;
    const int tid = tidx(), wave = tid >> 6, lane = tid & 63, fr = lane & 15, fq = lane >> 4;
    const int h = b >> 2, quad = wave >> 2, mt = wave & 3, dv0 = (b & 3) * 32 + quad * 16;
    bf16_t* Sl = (bf16_t*)lds + quad * (16 * 136); bf16_t* vn = (bf16_t*)(lds + 2 * 16 * 136 * 2) + quad * (16 * 72);
    float* go = (float*)(p.ws + O_PQKV);
    for (int e = tid; e < 2 * 16 * 136; e += 512) ((bf16_t*)lds)[e] = 0;
    __syncthreads();
    f32x4 St[2] = {{0.f, 0.f, 0.f, 0.f}, {0.f, 0.f, 0.f, 0.f}};
    GdnFrag cur, nxt; gdn_load(ws, h, mt, fr, fq, dv0, cur); nxt = cur;
    for (int n = 0; n < 256; ++n) {
        if (n + 1 < 256) gdn_load(ws, (n + 1) * 8 + h, mt, fr, fq, dv0, nxt);
        bf16x8 Sb[4];
#pragma unroll
        for (int s = 0; s < 4; ++s) Sb[s] = *(const bf16x8*)(Sl + fr * 136 + s * 32 + fq * 8);
        f32x4 U = {0.f, 0.f, 0.f, 0.f};
#pragma unroll
        for (int s = 0; s < 4; ++s) U = MFMA16(cur.kc[s], Sb[s], U);
        { u32x2 w; w.x = pk2(cur.val[0] - U[0], cur.val[1] - U[1]); w.y = pk2(cur.val[2] - U[2], cur.val[3] - U[3]); *(u32x2*)(vn + fr * 72 + mt * 16 + fq * 4) = w; }
        __syncthreads();
        const bf16x8 V0 = *(const bf16x8*)(vn + fr * 72 + fq * 8), V1 = *(const bf16x8*)(vn + fr * 72 + 32 + fq * 8);
        f32x4 O = {0.f, 0.f, 0.f, 0.f};
#pragma unroll
        for (int s = 0; s < 4; ++s) O = MFMA16(cur.qg[s], Sb[s], O);
        O = MFMA16(cur.qk[0], V0, O); O = MFMA16(cur.qk[1], V1, O);
#pragma unroll
        for (int e = 0; e < 4; ++e) go[(size_t)(n * 64 + mt * 16 + fq * 4 + e) * 1024 + h * 128 + dv0 + fr] = O[e];
#pragma unroll
        for (int q = 0; q < 2; ++q) {
            St[q] = St[q] * cur.egl;
            St[q] = MFMA16(V0, cur.kd[q][0], St[q]); St[q] = MFMA16(V1, cur.kd[q][1], St[q]);
#pragma unroll
            for (int e = 0; e < 4; ++e) Sl[(fq * 4 + e) * 136 + (2 * mt + q) * 16 + fr] = f2bf(St[q][e]);
        }
        __syncthreads();
        cur = nxt;
    }
}
__device__ __forceinline__ void flash_tile(const bf16x8 (&Qf)[2], const bf16_t* kp, int ldk, const bf16_t* vp, int ldv, unsigned vmask,
                                           float (&m)[4], float (&l)[4], f32x4 (&O)[4], bf16_t* Pt, int fr, int fq) {
    f32x4 S[4];
#pragma unroll
    for (int s = 0; s < 4; ++s) { const bf16x8 k0 = *(const bf16x8*)(kp + (size_t)(s * 16) * ldk), k1 = *(const bf16x8*)(kp + (size_t)(s * 16) * ldk + 32);
        S[s] = (f32x4){0.f, 0.f, 0.f, 0.f}; S[s] = MFMA16(Qf[0], k0, S[s]); S[s] = MFMA16(Qf[1], k1, S[s]); }
    bf16x8 Vf[4][2];
#pragma unroll
    for (int dt = 0; dt < 4; ++dt) { Vf[dt][0] = *(const bf16x8*)(vp + (size_t)(dt * 16) * ldv); Vf[dt][1] = *(const bf16x8*)(vp + (size_t)(dt * 16) * ldv + 32); }
    float mx[4];
#pragma unroll
    for (int j = 0; j < 4; ++j) { float v = -1e30f;
#pragma unroll
        for (int s = 0; s < 4; ++s) v = ((vmask >> s) & 1u) ? fmaxf(v, S[s][j]) : v;
        v = fmaxf(v, __shfl_xor(v, 1)); v = fmaxf(v, __shfl_xor(v, 2)); v = fmaxf(v, __shfl_xor(v, 4)); v = fmaxf(v, __shfl_xor(v, 8)); mx[j] = v; }
#pragma unroll
    for (int j = 0; j < 4; ++j) { const float mn = fmaxf(m[j], mx[j]); const float a = __expf(m[j] - mn); m[j] = mn; l[j] *= a;
#pragma unroll
        for (int dt = 0; dt < 4; ++dt) O[dt][j] *= a; }
#pragma unroll
    for (int s = 0; s < 4; ++s)
#pragma unroll
        for (int j = 0; j < 4; ++j) { const float pv = ((vmask >> s) & 1u) ? __expf(S[s][j] - m[j]) : 0.f; l[j] += pv; Pt[(fq * 4 + j) * 72 + s * 16 + fr] = f2bf(pv); }
    asm volatile("s_waitcnt lgkmcnt(0)" ::: "memory");
    const bf16x8 P0 = *(const bf16x8*)(Pt + fr * 72 + fq * 8), P1 = *(const bf16x8*)(Pt + fr * 72 + 32 + fq * 8);
    asm volatile("s_waitcnt lgkmcnt(0)" ::: "memory");
#pragma unroll
    for (int dt = 0; dt < 4; ++dt) { O[dt] = MFMA16(P0, Vf[dt][0], O[dt]); O[dt] = MFMA16(P1, Vf[dt][1], O[dt]); }
}
__device__ __forceinline__ void branch_finish(float (&l)[4], f32x4 (&O)[4], const float* grow, int br, int hk, f32x4 (&Y)[4]) {
#pragma unroll
    for (int j = 0; j < 4; ++j) { float s = l[j]; s += __shfl_xor(s, 1); s += __shfl_xor(s, 2); s += __shfl_xor(s, 4); s += __shfl_xor(s, 8);
        const float g = sigmoidf_(grow[(hk * 4 + j) * 3 + br]) / fmaxf(s, 1e-30f);
#pragma unroll
        for (int dt = 0; dt < 4; ++dt) Y[dt][j] += g * O[dt][j]; }
}
constexpr int NSA_WLDS = 15680;
__device__ void nsa_wave_task(const Params& p, int layer, int t0, unsigned char* wl) {
    unsigned char* ws = p.ws;
    const int lane = tidx() & 63, fr = lane & 15, fq = lane >> 4;
    float* imp = (float*)wl; unsigned* flg = (unsigned*)(wl + 4160); bf16_t* Pt = (bf16_t*)(wl + 5184); float* yb = (float*)(wl + 7488);
    const bf16_t* qn = (const bf16_t*)(ws + O_QN); const bf16_t* ksn = (const bf16_t*)(ws + O_KSN); const bf16_t* kwn = (const bf16_t*)(ws + O_KWN);
    const bf16_t* vsT = (const bf16_t*)(ws + O_VST); const bf16_t* vwT = (const bf16_t*)(ws + O_VWT); const bf16_t* kc = (const bf16_t*)(ws + O_KC); const bf16_t* vcT = (const bf16_t*)(ws + O_VCT);
    const int trow = t0 + fq;
    const float* grow = (const float*)(ws + O_P32) + (size_t)trow * 1536 + 1280;
    const int tmax = t0 + 3;
    for (int hk = 0; hk < 2; ++hk) {
        bf16x8 Qf[2];
        { const bf16_t* qp = qn + (size_t)(t0 + (fr >> 2)) * 512 + (hk * 4 + (fr & 3)) * 64 + fq * 8; Qf[0] = *(const bf16x8*)qp; Qf[1] = *(const bf16x8*)(qp + 32); }
        f32x4 Y[4];
#pragma unroll
        for (int dt = 0; dt < 4; ++dt) Y[dt] = (f32x4){0.f, 0.f, 0.f, 0.f};
        float m[4], l[4]; f32x4 O[4];
#pragma unroll
        for (int j = 0; j < 4; ++j) { m[j] = -1e30f; l[j] = 0.f; O[j] = (f32x4){0.f, 0.f, 0.f, 0.f}; }
        const int ncmp_t = tmax >= 31 ? ((((tmax - 31) >> 4) >> 6) + 1) : 0;
        for (int kt = 0; kt < ncmp_t; ++kt) {
            const int key0 = kt * 64; unsigned vm = 0;
#pragma unroll
            for (int s = 0; s < 4; ++s) vm |= ((16 * (key0 + s * 16 + fr) + 31 <= trow) ? 1u : 0u) << s;
            flash_tile(Qf, kc + ((size_t)hk * 1024 + key0 + fr) * 64 + fq * 8, 64, vcT + ((size_t)hk * 64 + fr) * 1024 + key0 + fq * 8, 1024, vm, m, l, O, Pt, fr, fq);
        }
        float linv[4];
#pragma unroll
        for (int j = 0; j < 4; ++j) { float s = l[j]; s += __shfl_xor(s, 1); s += __shfl_xor(s, 2); s += __shfl_xor(s, 4); s += __shfl_xor(s, 8); linv[j] = s > 0.f ? 1.0f / s : 0.f; }
        branch_finish(l, O, grow, 0, hk, Y);
        for (int e = lane; e < 4 * 260; e += 64) imp[e] = 0.f;
        for (int e = lane; e < 256; e += 64) flg[e] = 0u;
        asm volatile("s_waitcnt lgkmcnt(0)" ::: "memory");
        for (int kt = 0; kt < ncmp_t; ++kt) {
            const int key0 = kt * 64;
            const bf16_t* kp = kc + ((size_t)hk * 1024 + key0 + fr) * 64 + fq * 8;
#pragma unroll
            for (int s = 0; s < 4; ++s) {
                const bf16x8 k0 = *(const bf16x8*)(kp + (size_t)(s * 16) * 64), k1 = *(const bf16x8*)(kp + (size_t)(s * 16) * 64 + 32);
                f32x4 S = {0.f, 0.f, 0.f, 0.f}; S = MFMA16(Qf[0], k0, S); S = MFMA16(Qf[1], k1, S);
                const int nn = key0 + s * 16 + fr; const bool valid = 16 * nn + 31 <= trow;
                float ps = 0.f;
#pragma unroll
                for (int j = 0; j < 4; ++j) ps += valid ? __expf(S[j] - m[j]) * linv[j] : 0.f;
                float p4 = ps; p4 += __shfl_xor(p4, 1); p4 += __shfl_xor(p4, 2);
                if ((fr & 3) == 0) imp[fq * 260 + (nn >> 2)] += p4;
                asm volatile("s_waitcnt lgkmcnt(0)" ::: "memory");
                if ((fr & 3) == 3) imp[fq * 260 + (nn >> 2) + 1] += ps;
                asm volatile("s_waitcnt lgkmcnt(0)" ::: "memory");
            }
        }
        for (int tok = 0; tok < 4; ++tok) {
            const int t = t0 + tok, cur = t >> 6, nsel = cur + 1 < 16 ? cur + 1 : 16;
            unsigned long long key[4];
#pragma unroll
            for (int i = 0; i < 4; ++i) { const int j = lane + 64 * i; unsigned long long k = 0ull;
                if (j <= cur) { const bool forced = (j == 0) || (j == cur) || (j == cur - 1); const unsigned vb = forced ? 0x7F800000u : __float_as_uint(imp[tok * 260 + j]); k = ((unsigned long long)vb << 32) | (unsigned)(0xFFFF - j); }
                key[i] = k; }
            for (int it = 0; it < nsel; ++it) {
                unsigned long long best = key[0]; best = key[1] > best ? key[1] : best; best = key[2] > best ? key[2] : best; best = key[3] > best ? key[3] : best;
#pragma unroll
                for (int o = 32; o >= 1; o >>= 1) { const unsigned lo = __shfl_xor((unsigned)best, o), hi = __shfl_xor((unsigned)(best >> 32), o); const unsigned long long ob = ((unsigned long long)hi << 32) | lo; best = ob > best ? ob : best; }
                const int jsel = 0xFFFF - (int)(best & 0xFFFFu);
#pragma unroll
                for (int i = 0; i < 4; ++i) if (key[i] == best) key[i] = 0ull;
                if (lane == 0) flg[jsel] |= (1u << tok);
            }
        }
        asm volatile("s_waitcnt lgkmcnt(0)" ::: "memory");
#pragma unroll
        for (int j = 0; j < 4; ++j) { m[j] = -1e30f; l[j] = 0.f; O[j] = (f32x4){0.f, 0.f, 0.f, 0.f}; }
        const int curmax = tmax >> 6;
        for (int jb = 0; jb <= curmax; ++jb) {
            const unsigned fw = flg[jb];
            if (fw == 0u) continue;
            const int key0 = jb * 64; const bool rowsel = (fw >> fq) & 1u; unsigned vm = 0;
#pragma unroll
            for (int s = 0; s < 4; ++s) vm |= ((rowsel && (key0 + s * 16 + fr <= trow)) ? 1u : 0u) << s;
            flash_tile(Qf, ksn + (size_t)(key0 + fr) * 128 + hk * 64 + fq * 8, 128, vsT + ((size_t)hk * 64 + fr) * T_ + key0 + fq * 8, T_, vm, m, l, O, Pt, fr, fq);
        }
        branch_finish(l, O, grow, 1, hk, Y);
#pragma unroll
        for (int j = 0; j < 4; ++j) { m[j] = -1e30f; l[j] = 0.f; O[j] = (f32x4){0.f, 0.f, 0.f, 0.f}; }
        const int wlo = t0 - 511 > 0 ? ((t0 - 511) & ~63) : 0;
        for (int key0 = wlo; key0 <= tmax; key0 += 64) {
            unsigned vm = 0;
#pragma unroll
            for (int s = 0; s < 4; ++s) { const int kpos = key0 + s * 16 + fr; vm |= ((kpos <= trow && kpos > trow - 512) ? 1u : 0u) << s; }
            flash_tile(Qf, kwn + (size_t)(key0 + fr) * 128 + hk * 64 + fq * 8, 128, vwT + ((size_t)hk * 64 + fr) * T_ + key0 + fq * 8, T_, vm, m, l, O, Pt, fr, fq);
        }
        branch_finish(l, O, grow, 2, hk, Y);
#pragma unroll
        for (int dt = 0; dt < 4; ++dt)
#pragma unroll
            for (int j = 0; j < 4; ++j) yb[fq * 512 + (hk * 4 + j) * 64 + dt * 16 + fr] = Y[dt][j];
    }
    asm volatile("s_waitcnt lgkmcnt(0)" ::: "memory");
    bf16_t* mix = (bf16_t*)(ws + O_HN);
    const float* gn = p.in[12] + (size_t)layer * 512;
    for (int tok = 0; tok < 4; ++tok) {
        const f32x4 a = *(const f32x4*)(yb + tok * 512 + lane * 8), b = *(const f32x4*)(yb + tok * 512 + lane * 8 + 4);
        float ss = a[0] * a[0] + a[1] * a[1] + a[2] * a[2] + a[3] * a[3] + b[0] * b[0] + b[1] * b[1] + b[2] * b[2] + b[3] * b[3];
        ss = wave_sum(ss);
        const float rs = rsqrtf(ss * (1.0f / 512.0f) + 1e-6f);
        const f32x4 g0 = *(const f32x4*)(gn + lane * 8), g1 = *(const f32x4*)(gn + lane * 8 + 4);
        u32x4 w; w.x = pk2(a[0] * rs * g0[0], a[1] * rs * g0[1]); w.y = pk2(a[2] * rs * g0[2], a[3] * rs * g0[3]); w.z = pk2(b[0] * rs * g1[0], b[1] * rs * g1[1]); w.w = pk2(b[2] * rs * g1[2], b[3] * rs * g1[3]);
        *(u32x4*)(mix + (size_t)(t0 + tok) * DM + lane * 8) = w;
    }
    asm volatile("s_waitcnt lgkmcnt(0)" ::: "memory");
}

__device__ void phase_finalize(const Params& p, int layer) {
    unsigned char* ws = p.ws;
    const int wave = tidx() >> 6, lane = tidx() & 63;
    const float* yglu = (const float*)(ws + O_YGLU); const float* go = (const float*)(ws + O_PQKV); const bf16_t* Pz = (const bf16_t*)(ws + O_PZ); bf16_t* mix = (bf16_t*)(ws + O_HN);
    const float* gs = p.in[22] + (size_t)layer * 512 + lane * 8; const float* gg = p.in[26] + (size_t)layer * 128 + (lane & 7) * 16;
    for (int t = blockIdx.x * 8 + wave; t < T_; t += gridDim.x * 8) {
        {
            const f32x4 a = *(const f32x4*)(yglu + (size_t)t * 512 + lane * 8), b = *(const f32x4*)(yglu + (size_t)t * 512 + lane * 8 + 4);
            float ss = a[0] * a[0] + a[1] * a[1] + a[2] * a[2] + a[3] * a[3] + b[0] * b[0] + b[1] * b[1] + b[2] * b[2] + b[3] * b[3];
            ss = wave_sum(ss); const float rs = rsqrtf(ss * (1.0f / 512.0f) + 1e-6f);
            const f32x4 g0 = *(const f32x4*)gs, g1 = *(const f32x4*)(gs + 4);
            u32x4 w; w.x = pk2(a[0] * rs * g0[0], a[1] * rs * g0[1]); w.y = pk2(a[2] * rs * g0[2], a[3] * rs * g0[3]); w.z = pk2(b[0] * rs * g1[0], b[1] * rs * g1[1]); w.w = pk2(b[2] * rs * g1[2], b[3] * rs * g1[3]);
            *(u32x4*)(mix + (size_t)t * DM + 512 + lane * 8) = w;
        }
        {
            f32x4 o[4]; float ss = 0.f;
#pragma unroll
            for (int q = 0; q < 4; ++q) { o[q] = *(const f32x4*)(go + (size_t)t * 1024 + lane * 16 + q * 4); ss += o[q][0] * o[q][0] + o[q][1] * o[q][1] + o[q][2] * o[q][2] + o[q][3] * o[q][3]; }
            ss += __shfl_xor(ss, 1); ss += __shfl_xor(ss, 2); ss += __shfl_xor(ss, 4);
            const float rs = rsqrtf(ss * (1.0f / 128.0f) + 1e-6f);
            const u32x4 z0 = *(const u32x4*)(Pz + (size_t)t * 1024 + lane * 16), z1 = *(const u32x4*)(Pz + (size_t)t * 1024 + lane * 16 + 8);
            float zz[16] = {bflo(z0.x), bfhi(z0.x), bflo(z0.y), bfhi(z0.y), bflo(z0.z), bfhi(z0.z), bflo(z0.w), bfhi(z0.w), bflo(z1.x), bfhi(z1.x), bflo(z1.y), bfhi(z1.y), bflo(z1.z), bfhi(z1.z), bflo(z1.w), bfhi(z1.w)};
            float r[16];
#pragma unroll
            for (int q = 0; q < 4; ++q) { const f32x4 g = *(const f32x4*)(gg + q * 4);
#pragma unroll
                for (int e = 0; e < 4; ++e) r[q * 4 + e] = o[q][e] * rs * g[e] * siluf_(zz[q * 4 + e]); }
            u32x4 w0, w1; w0.x = pk2(r[0], r[1]); w0.y = pk2(r[2], r[3]); w0.z = pk2(r[4], r[5]); w0.w = pk2(r[6], r[7]); w1.x = pk2(r[8], r[9]); w1.y = pk2(r[10], r[11]); w1.z = pk2(r[12], r[13]); w1.w = pk2(r[14], r[15]);
            *(u32x4*)(mix + (size_t)t * DM + 1024 + lane * 16) = w0; *(u32x4*)(mix + (size_t)t * DM + 1024 + lane * 16 + 8) = w1;
        }
    }
}

__device__ void phase_ffn_act(const Params& p, int layer) {
    unsigned char* ws = p.ws;
    const bf16_t* hf = (const bf16_t*)(ws + O_HF); bf16_t* act = (bf16_t*)(ws + O_ACT);
    const float* cw = p.in[30] + (size_t)layer * 3 * NFF; const float* cb = p.in[31] + (size_t)layer * NFF;
    const int nitems = 512 * 688;
    for (int it = blockIdx.x * 512 + tidx(); it < nitems; it += gridDim.x * 512) {
        const int seg = it / 688, cg8 = it - seg * 688, c = cg8 * 8, t0 = seg * 32;
        float w[2][3][8], bb[2][8];
#pragma unroll
        for (int hh = 0; hh < 2; ++hh) {
#pragma unroll
            for (int j = 0; j < 3; ++j) { const f32x4 a = *(const f32x4*)(cw + j * NFF + hh * DFF + c), b = *(const f32x4*)(cw + j * NFF + hh * DFF + c + 4);
                w[hh][j][0] = a[0]; w[hh][j][1] = a[1]; w[hh][j][2] = a[2]; w[hh][j][3] = a[3]; w[hh][j][4] = b[0]; w[hh][j][5] = b[1]; w[hh][j][6] = b[2]; w[hh][j][7] = b[3]; }
            const f32x4 a = *(const f32x4*)(cb + hh * DFF + c), b = *(const f32x4*)(cb + hh * DFF + c + 4);
            bb[hh][0] = a[0]; bb[hh][1] = a[1]; bb[hh][2] = a[2]; bb[hh][3] = a[3]; bb[hh][4] = b[0]; bb[hh][5] = b[1]; bb[hh][6] = b[2]; bb[hh][7] = b[3];
        }
        u32x4 r0[2], r1[2];
#pragma unroll
        for (int hh = 0; hh < 2; ++hh) {
            r0[hh] = (t0 >= 2) ? *(const u32x4*)(hf + (size_t)(t0 - 2) * NFF + hh * DFF + c) : (u32x4){0u, 0u, 0u, 0u};
            r1[hh] = (t0 >= 1) ? *(const u32x4*)(hf + (size_t)(t0 - 1) * NFF + hh * DFF + c) : (u32x4){0u, 0u, 0u, 0u};
        }
        for (int tt = 0; tt < 32; ++tt) {
            const int t = t0 + tt;
            u32x4 r2[2]; float v[2][8];
#pragma unroll
            for (int hh = 0; hh < 2; ++hh) {
                r2[hh] = *(const u32x4*)(hf + (size_t)t * NFF + hh * DFF + c);
                const unsigned a0[4] = {r0[hh].x, r0[hh].y, r0[hh].z, r0[hh].w}, a1[4] = {r1[hh].x, r1[hh].y, r1[hh].z, r1[hh].w}, a2[4] = {r2[hh].x, r2[hh].y, r2[hh].z, r2[hh].w};
#pragma unroll
                for (int e = 0; e < 4; ++e) {
                    v[hh][2 * e]     = bb[hh][2 * e]     + w[hh][0][2 * e]     * bflo(a0[e]) + w[hh][1][2 * e]     * bflo(a1[e]) + w[hh][2][2 * e]     * bflo(a2[e]);
                    v[hh][2 * e + 1] = bb[hh][2 * e + 1] + w[hh][0][2 * e + 1] * bfhi(a0[e]) + w[hh][1][2 * e + 1] * bfhi(a1[e]) + w[hh][2][2 * e + 1] * bfhi(a2[e]);
                }
                r0[hh] = r1[hh]; r1[hh] = r2[hh];
            }
            u32x4 o; o.x = pk2(siluf_(v[0][0]) * v[1][0], siluf_(v[0][1]) * v[1][1]); o.y = pk2(siluf_(v[0][2]) * v[1][2], siluf_(v[0][3]) * v[1][3]);
            o.z = pk2(siluf_(v[0][4]) * v[1][4], siluf_(v[0][5]) * v[1][5]); o.w = pk2(siluf_(v[0][6]) * v[1][6], siluf_(v[0][7]) * v[1][7]);
            *(u32x4*)(act + (size_t)t * DFF + c) = o;
        }
    }
}
#ifndef MULTI_LAUNCH
#define MULTI_LAUNCH 0
#endif
__global__ void __launch_bounds__(512) mega(Params p) {
    extern __shared__ __attribute__((aligned(16))) unsigned char smem[];
    cg::grid_group grid = cg::this_grid();
    const int b = blockIdx.x, G = gridDim.x;
    PG8_LAS unsigned char* glds = (PG8_LAS unsigned char*)smem;
    for (int ph = p.ph_lo; ph < p.ph_hi; ++ph) {
        unsigned long long wsl = (unsigned long long)p.ws; asm volatile("" : "+s"(wsl));
        unsigned char* ws = (unsigned char*)wsl;
        int tid = threadIdx.x; asm volatile("" : "+v"(tid));
        const int wave = tid >> 6;
        bf16_t* hn = (bf16_t*)(ws + O_HN);
        Params q = p; q.ws = ws;
        const int layer = ph / NPH; int k = ph % NPH;
#ifdef DBG_ONLY
        if (k != DBG_ONLY) k = 99;
#endif
        if (k == 0) {
            if (ph == 0 && b == 0 && tid < 64) ((unsigned*)(ws + O_CTR))[tid * 16] = 0u;
            phase_convert(q, layer, (float*)smem);
            phase_rmsnorm(layer == 0 ? p.in[0] : p.out, p.in[1] + (size_t)layer * DM, hn, layer == 0 ? p.out : nullptr);
        } else if (k == 1) {
            pg8::Gemm g{hn, (const bf16_t*)(ws + O_WIN), T_, NIN, DM}; pg8::StaticOrder S; S.init(T_, NIN, G, b);
            EpiProj E{(float*)(ws + O_P32), (bf16_t*)(ws + O_PU), (bf16_t*)(ws + O_PQKV), (bf16_t*)(ws + O_PZ)};
            pg8::gemm_phase<EpiProj, pg8::StaticOrder, false>(glds, g, S, E, nullptr);
        } else if (k == 2) {
            for (int it = b; it < 3072; it += G) {
                if (it < 2048) gdn_prep_item(q, layer, it, smem);
                else if (it < 2304) nsa_prep_item(q, layer, it - 2048, (float*)smem);
                else if (it < 2560) s5_passA_wave(q, layer, (it - 2304) * 8 + wave);
                else cmp1_wave_tile(q, layer, (it - 2560) * 8 + wave);
            }
        } else if (k == 3) {
            for (int idx = b * 8 + wave; idx < 4096; idx += G * 8) cmp2_wave_row(q, layer, idx);
            for (int it = b * 8 + wave; it < 2048; it += G * 8) s5_passB_wave(q, layer, it, (bf16_t*)(smem + wave * 4352));
        } else if (k == 4) {
            if (b < 32) gdn_recurrence(q, b, smem);
            else if (b < 160) {
                pg8::Gemm g{(const bf16_t*)(ws + O_YGELU), (const bf16_t*)(ws + O_WGLU), T_, 512, 512}; pg8::StaticOrder S; S.init(T_, 512, 128, b - 32);
                EpiGlu E{(const bf16_t*)(ws + O_YGELU), (float*)(ws + O_YGLU)};
                pg8::gemm_phase<EpiGlu, pg8::StaticOrder, false>(glds, g, S, E, nullptr);
            }
            __syncthreads();
            unsigned* ctr = (unsigned*)(ws + O_CTR) + layer * 16;
            volatile int* sidx = (volatile int*)(smem + LDS_BYTES - 16);
            for (;;) {
                if (tid == 0) *sidx = (int)atomicAdd(ctr, 1u);
                __syncthreads();
                const int idx = *sidx;
                __syncthreads();
                if (idx >= 512) break;
                nsa_wave_task(q, layer, (511 - idx) * 32 + wave * 4, smem + wave * NSA_WLDS);
            }
        } else if (k == 5) {
            phase_finalize(q, layer);
        } else if (k == 6) {
            pg8::Gemm g{hn, (const bf16_t*)(ws + O_WOUT), T_, DM, DM}; pg8::StaticOrder S; S.init(T_, DM, G, b);
            EpiResid E{p.out, DM};
            pg8::gemm_phase<EpiResid, pg8::StaticOrder, false>(glds, g, S, E, nullptr);
        } else if (k == 7) {
            phase_rmsnorm(p.out, p.in[28] + (size_t)layer * DM, hn, nullptr);
        } else if (k == 8) {
            pg8::Gemm g{hn, (const bf16_t*)(ws + O_WFIN), T_, NFF, DM}; pg8::StaticOrder S; S.init(T_, NFF, G, b);
            EpiBf E{(bf16_t*)(ws + O_HF), NFF};
            pg8::gemm_phase<EpiBf, pg8::StaticOrder, false>(glds, g, S, E, nullptr);
        } else if (k == 9) {
            phase_ffn_act(q, layer);
        } else if (k == 10) {
            pg8::Gemm g{(const bf16_t*)(ws + O_ACT), (const bf16_t*)(ws + O_WFOUT), T_, DM, DFF}; pg8::StaticOrder S; S.init(T_, DM, G, b);
            EpiResid E{p.out, DM};
            pg8::gemm_phase<EpiResid, pg8::StaticOrder, false>(glds, g, S, E, nullptr);
        }
        __syncthreads();
        if (ph + 1 < p.ph_hi) grid.sync();
    }
}

extern "C" void kernel_launch(void* const* d_in, const int* in_sizes, int n_in, void* d_out, int out_size, void* d_ws, size_t ws_size, hipStream_t stream) {
    static int grid_blocks = 0;
    if (!grid_blocks) {
        if (n_in != 33 || out_size != T_ * DM || ws_size < WS_NEED) { fprintf(stderr, "kernel_launch: unexpected shapes or workspace (%d inputs, out %d, ws %zu < %zu)\n", n_in, out_size, ws_size, (size_t)WS_NEED); grid_blocks = -1; return; }
        int dev = 0, cus = 0, per_cu = 0;
        hipGetDevice(&dev);
        hipDeviceGetAttribute(&cus, hipDeviceAttributeMultiprocessorCount, dev);
        if (hipFuncSetAttribute((const void*)mega, hipFuncAttributeMaxDynamicSharedMemorySize, LDS_BYTES) != hipSuccess) { fprintf(stderr, "kernel_launch: hipFuncSetAttribute failed\n"); grid_blocks = -1; return; }
        hipOccupancyMaxActiveBlocksPerMultiprocessor(&per_cu, (const void*)mega, 512, LDS_BYTES);
        (void)hipGetLastError();
        if (per_cu < 1) per_cu = 1;
        grid_blocks = cus * per_cu; if (grid_blocks > 256) grid_blocks = 256;
        if (grid_blocks < 160) { fprintf(stderr, "kernel_launch: grid %d too small\n", grid_blocks); grid_blocks = -1; return; }
    }
    if (grid_blocks < 0) return;
    Params p{};
    for (int i = 0; i < 33; ++i) p.in[i] = (const float*)d_in[i];
    p.out = (float*)d_out; p.ws = (unsigned char*)d_ws;
#if MULTI_LAUNCH
    for (int ph = 0; ph < 2 * NPH; ++ph) { p.ph_lo = ph; p.ph_hi = ph + 1; hipLaunchKernelGGL(mega, dim3(grid_blocks), dim3(512), LDS_BYTES, stream, p); }
#else
    p.ph_lo = 0; p.ph_hi = 2 * NPH;
    void* args[] = {&p};
    hipError_t e = hipLaunchCooperativeKernel((const void*)mega, dim3(grid_blocks), dim3(512), args, LDS_BYTES, stream);
    if (e != hipSuccess) fprintf(stderr, "cooperative launch failed: %s (grid %d)\n", hipGetErrorString(e), grid_blocks);
#endif
}
```

```cpp
#include <hip/hip_runtime.h>
#include <hip/hip_cooperative_groups.h>
#include <cstdio>
namespace cg = cooperative_groups;
__device__ __forceinline__ int tidx() { int t = threadIdx.x; asm volatile("" : "+v"(t)); return t; }
namespace pg8 {
#define PG8_LAS __attribute__((address_space(3)))
typedef unsigned short bf16_t;
typedef short bf16x8 __attribute__((ext_vector_type(8)));
typedef float f32x4 __attribute__((ext_vector_type(4)));
typedef unsigned u32x4 __attribute__((ext_vector_type(4)));
constexpr int BM = 256, BK = 64, HALF = 128, HTB = HALF * BK * 2  , STAGE_BYTES = 8 * HTB, NXCD = 8, WGM = 8;

__host__ __device__ __forceinline__ int lds_byte(int r, int c) { const int st = (r >> 4) * 2 + (c >> 5), rr = r & 15, cc = c & 31, ob = rr * 64 + cc * 2; return st * 1024 + (ob ^ (((ob >> 9) & 1) << 5)); }
__host__ __device__ __forceinline__ void stage_rc(int b, int& R, int& C) { const int st = b / 1024, sb = b % 1024, swz = sb ^ (((sb >> 9) & 1) << 5); R = (st >> 1) * 16 + swz / 64; C = (st & 1) * 32 + (swz % 64) / 2; }
__host__ __device__ __forceinline__ int perm32(int rho) { const int n = rho >> 4, i = rho & 15; return 8 * (i >> 2) + 4 * n + (i & 3); }

struct Unit { int pm, pn; };
struct Gemm { const bf16_t* A; const bf16_t* Bt; int M, N, K; };

struct StaticOrder {
    int nM, nN, nwg, G, c;
    __host__ __device__ void init(int M, int N, int G_, int c_) { nM = M / BM; nN = N / BM; nwg = nM * nN; G = G_; c = c_; }
    __host__ __device__ bool next(int i, Unit& u) const {
        const long L = (long)i * G + c; if (L >= nwg) return false;
        int wgid = (int)L; { const int q = nwg / NXCD, r = nwg % NXCD, xcd = wgid % NXCD, off = wgid / NXCD; wgid = (xcd < r ? xcd * (q + 1) : r * (q + 1) + (xcd - r) * q) + off; }
        const int nig = WGM * nN, gid = wgid / nig, fm = gid * WGM, gsz = (nM - fm) < WGM ? (nM - fm) : WGM;
        u.pm = fm + ((wgid % nig) % gsz); u.pn = (wgid % nig) / gsz; return true;
    }
    __device__ __forceinline__ void a_ready(const Unit&) const {}
    __device__ __forceinline__ void done(const Unit&) const {}
};
__device__ __forceinline__ unsigned cvt_pk_bf16(float lo, float hi) { unsigned r; asm volatile("v_cvt_pk_bf16_f32 %0, %1, %2" : "=v"(r) : "v"(lo), "v"(hi)); return r; }
template <class Epi, class Sched, bool STAMP = false>
__device__ __forceinline__ void gemm_phase(PG8_LAS unsigned char* lds, const Gemm g, const Sched& S, const Epi& E, unsigned long long* stamps) {
    const int tid = tidx(), wid = __builtin_amdgcn_readfirstlane(tid >> 6), lane = tid & 63, wr = wid >> 2, wc = wid & 3, fr = lane & 15, fq = lane >> 4;
    const int K = g.K, nt = K / BK;
    int ts_lo = 0, ts_hi = 0, nts = 0; const unsigned long long rt_entry = STAMP ? (unsigned long long)wall_clock64() : 0ull;
#define PG8_STAMP() do { if (STAMP && wid == 0 && nts < 64) { const unsigned long long _c = (unsigned long long)clock64(); \
        ts_lo = (lane == nts) ? (int)(unsigned)_c : ts_lo; ts_hi = (lane == nts) ? (int)(unsigned)(_c >> 32) : ts_hi; ++nts; } } while (0)
    PG8_STAMP();
    unsigned voffA[2], voffB[2];
#pragma unroll
    for (int i = 0; i < 2; ++i) { int R, C; stage_rc(tid * 16 + i * 8192, R, C); const int Rb = Epi::PERM ? ((R & ~31) + perm32(R & 31)) : R;
        voffA[i] = (unsigned)(R * K + C) * 2u; voffB[i] = (unsigned)(Rb * K + C) * 2u; }
    const size_t kstep = (size_t)(BK * 2);
    const size_t hstep = (size_t)HALF * K * 2;
    const size_t tstep = 2 * hstep;
    const unsigned ldsw = (unsigned)wid * 1024u;
    const int aoff = lds_byte(wr * 64 + fr, fq * 8), boff = lds_byte(wc * 32 + fr, fq * 8);
#define PG8_SA(b, h) (((b) * 2 + (h)) * HTB)
#define PG8_SB(b, h) ((4 + (b) * 2 + (h)) * HTB)
#define PG8_STAGE(bufoff, gbase, voff) do { _Pragma("unroll") for (int _i = 0; _i < 2; ++_i) \
        __builtin_amdgcn_global_load_lds((const unsigned*)((const char*)(gbase) + (voff)[_i]), (PG8_LAS unsigned*)(lds + (bufoff) + ldsw + _i * 8192), 16, 0, 0); } while (0)
#define PG8_LDA(dst, b, h) do { _Pragma("unroll") for (int m = 0; m < 4; ++m) _Pragma("unroll") for (int k = 0; k < 2; ++k) dst[m][k] = *(const PG8_LAS bf16x8*)(lds + PG8_SA(b, h) + aoff + m * 2048 + k * 1024); } while (0)
#define PG8_LDB(dst, b, h) do { _Pragma("unroll") for (int n = 0; n < 2; ++n) _Pragma("unroll") for (int k = 0; k < 2; ++k) dst[n][k] = *(const PG8_LAS bf16x8*)(lds + PG8_SB(b, h) + boff + n * 2048 + k * 1024); } while (0)
#define PG8_MMA(ai, bj, At, Bt) do { __builtin_amdgcn_s_setprio(1); _Pragma("unroll") for (int m = 0; m < 4; ++m) _Pragma("unroll") for (int n = 0; n < 2; ++n) _Pragma("unroll") for (int k = 0; k < 2; ++k) \
        acc[ai][bj][m][n] = __builtin_amdgcn_mfma_f32_16x16x32_bf16(Bt[n][k], At[m][k], acc[ai][bj][m][n], 0, 0, 0); __builtin_amdgcn_s_setprio(0); } while (0)
#define PG8_WAIT_V(n) asm volatile("s_waitcnt vmcnt(" #n ")" ::: "memory")
#define PG8_WAIT_L(n) asm volatile("s_waitcnt lgkmcnt(" #n ")" ::: "memory")
#define PG8_BAR __builtin_amdgcn_s_barrier()
#define PG8_SCHED __builtin_amdgcn_sched_barrier(0)
    Unit cur, nxt; int ui = 0;
    if (!S.next(0, cur)) return;
    f32x4 acc[2][2][4][2];
#pragma unroll
    for (int a = 0; a < 2; ++a)
#pragma unroll
        for (int b = 0; b < 2; ++b)
#pragma unroll
            for (int m = 0; m < 4; ++m)
#pragma unroll
                for (int n = 0; n < 2; ++n) acc[a][b][m][n] = (f32x4){0.f, 0.f, 0.f, 0.f};
    bf16x8 At[4][2], B0[2][2], B1[2][2];
    const char* cA = (const char*)g.A + (size_t)cur.pm * tstep; const char* cB = (const char*)g.Bt + (size_t)cur.pn * tstep;
    S.a_ready(cur);
    PG8_STAGE(PG8_SB(0, 0), cB, voffB); PG8_STAGE(PG8_SA(0, 0), cA, voffA); PG8_STAGE(PG8_SB(0, 1), cB + hstep, voffB); PG8_STAGE(PG8_SA(0, 1), cA + hstep, voffA);
    if (wr == 1) PG8_BAR;
    PG8_WAIT_V(4); PG8_BAR;
    PG8_STAGE(PG8_SB(1, 0), cB + kstep, voffB); PG8_STAGE(PG8_SA(1, 0), cA + kstep, voffA); PG8_STAGE(PG8_SB(1, 1), cB + hstep + kstep, voffB);
    PG8_WAIT_V(6); PG8_BAR;
    PG8_STAMP();
    for (;;) {
        const bool has_next = S.next(ui + 1, nxt);
        const char* nA = has_next ? (const char*)g.A + (size_t)nxt.pm * tstep : cA; const char* nB = has_next ? (const char*)g.Bt + (size_t)nxt.pn * tstep : cB;
        for (int t = 0; t < nt; t += 2) {
            const bool last = (t == nt - 2);
            const char* a1 = cA + (size_t)(t + 1) * kstep;
            const char* a2 = last ? nA : cA + (size_t)(t + 2) * kstep; const char* b2 = last ? nB : cB + (size_t)(t + 2) * kstep;
            const char* a3 = a2 + kstep; const char* b3 = b2 + kstep;
            if (last && has_next) S.a_ready(nxt);
            PG8_LDB(B0, 0, 0); PG8_SCHED; PG8_LDA(At, 0, 0); PG8_STAGE(PG8_SA(1, 1), a1 + hstep, voffA);
            PG8_WAIT_L(8); PG8_BAR; PG8_WAIT_L(0); PG8_MMA(0, 0, At, B0); PG8_BAR; PG8_SCHED;
            PG8_LDB(B1, 0, 1); PG8_STAGE(PG8_SB(0, 0), b2, voffB);
            PG8_BAR; PG8_WAIT_L(0); PG8_MMA(0, 1, At, B1); PG8_BAR;
            PG8_LDA(At, 0, 1); PG8_STAGE(PG8_SA(0, 0), a2, voffA);
            PG8_BAR; PG8_WAIT_L(0); PG8_MMA(1, 0, At, B0); PG8_BAR; PG8_SCHED;
            PG8_STAGE(PG8_SB(0, 1), b2 + hstep, voffB);
            PG8_WAIT_V(6); PG8_BAR; PG8_MMA(1, 1, At, B1); PG8_BAR;
            PG8_LDB(B0, 1, 0); PG8_SCHED; PG8_LDA(At, 1, 0); PG8_STAGE(PG8_SA(0, 1), a2 + hstep, voffA);
            PG8_WAIT_L(8); PG8_BAR; PG8_WAIT_L(0); PG8_MMA(0, 0, At, B0); PG8_BAR; PG8_SCHED;
            PG8_LDB(B1, 1, 1); PG8_STAGE(PG8_SB(1, 0), b3, voffB);
            PG8_BAR; PG8_WAIT_L(0); PG8_MMA(0, 1, At, B1); PG8_BAR;
            PG8_LDA(At, 1, 1); PG8_STAGE(PG8_SA(1, 0), a3, voffA);
            PG8_BAR; PG8_WAIT_L(0); PG8_MMA(1, 0, At, B0); PG8_BAR; PG8_SCHED;
            PG8_STAGE(PG8_SB(1, 1), b3 + hstep, voffB);
            PG8_WAIT_V(6); PG8_BAR; PG8_MMA(1, 1, At, B1); PG8_BAR;
        }
        PG8_STAMP();
        if constexpr (!Epi::AFTER_DRAIN) { E(acc, cur, wr, wc, fr, fq); S.done(cur); }
        PG8_STAMP();
        if (!has_next) break;
#pragma unroll
        for (int a = 0; a < 2; ++a)
#pragma unroll
            for (int b = 0; b < 2; ++b)
#pragma unroll
                for (int m = 0; m < 4; ++m)
#pragma unroll
                    for (int n = 0; n < 2; ++n) acc[a][b][m][n] = (f32x4){0.f, 0.f, 0.f, 0.f};
        cur = nxt; cA = nA; cB = nB; ++ui;
    }
    PG8_WAIT_V(0);
    if (wr == 0) PG8_BAR;
    PG8_BAR;
    if constexpr (Epi::AFTER_DRAIN) { E.fused(acc, cur, wr, wc, fr, fq, lds, wid, lane); S.done(cur); }
    PG8_STAMP();
    if (STAMP && wid == 0) { stamps[lane] = lane < nts ? (((unsigned long long)(unsigned)ts_hi << 32) | (unsigned)ts_lo) : 0ull;
        if (lane == 62) stamps[62] = rt_entry; if (lane == 63) stamps[63] = (unsigned long long)wall_clock64(); }
#undef PG8_STAMP
#undef PG8_SA
#undef PG8_SB
#undef PG8_STAGE
#undef PG8_LDA
#undef PG8_LDB
#undef PG8_MMA
#undef PG8_WAIT_V
#undef PG8_WAIT_L
#undef PG8_BAR
#undef PG8_SCHED
}
}
using pg8::bf16_t; using pg8::bf16x8; using pg8::f32x4; using pg8::u32x4; using pg8::Unit;
typedef unsigned u32x2 __attribute__((ext_vector_type(2)));
#define MFMA16(a, b, c) __builtin_amdgcn_mfma_f32_16x16x32_bf16((a), (b), (c), 0, 0, 0)

constexpr int T_ = 16384, DM = 2048, NIN = 6144, DFF = 5504, NFF = 11008;
constexpr int LDS_BYTES = 144 * 1024;
constexpr int NPH = 11;

constexpr size_t O_CTR   = 0;
constexpr size_t O_WIN   = 4096;
constexpr size_t O_WOUT  = O_WIN   + (size_t)NIN * DM * 2;
constexpr size_t O_WFIN  = O_WOUT  + (size_t)DM * DM * 2;
constexpr size_t O_WFOUT = O_WFIN  + (size_t)NFF * DM * 2;
constexpr size_t O_WCK   = O_WFOUT + (size_t)DM * DFF * 2;
constexpr size_t O_WCV   = O_WCK   + (size_t)256 * 2048 * 2;
constexpr size_t O_WGLU  = O_WCV   + (size_t)256 * 2048 * 2;
constexpr size_t O_HN    = O_WGLU  + (size_t)512 * 512 * 2;
constexpr size_t O_R     = O_HN    + (size_t)T_ * DM * 2;
constexpr size_t O_P32   = O_R;
constexpr size_t O_PU    = O_P32   + (size_t)T_ * 1536 * 4;
constexpr size_t O_PQKV  = O_PU    + (size_t)T_ * 512 * 2;
constexpr size_t O_PZ    = O_PQKV  + (size_t)T_ * 3072 * 2;
constexpr size_t O_QN    = O_PZ    + (size_t)T_ * 1024 * 2;
constexpr size_t O_KSN   = O_QN    + (size_t)T_ * 512 * 2;
constexpr size_t O_KWN   = O_KSN   + (size_t)T_ * 128 * 2;
constexpr size_t O_VST   = O_KWN   + (size_t)T_ * 128 * 2;
constexpr size_t O_VWT   = O_VST   + (size_t)T_ * 128 * 2;
constexpr size_t O_KC    = O_VWT   + (size_t)T_ * 128 * 2;
constexpr size_t O_VCT   = O_KC    + (size_t)2 * 1024 * 64 * 2;
constexpr size_t O_HCMP  = O_VCT   + (size_t)2 * 64 * 1024 * 2;
constexpr size_t O_GKC   = O_HCMP  + (size_t)2 * 2048 * 256 * 4;
constexpr size_t O_GQG   = O_GKC   + (size_t)2048 * 64 * 128 * 2;
constexpr size_t O_GQK   = O_GQG   + (size_t)2048 * 64 * 128 * 2;
constexpr size_t O_GKD   = O_GQK   + (size_t)2048 * 64 * 64 * 2;
constexpr size_t O_GVAL  = O_GKD   + (size_t)2048 * 64 * 128 * 2;
constexpr size_t O_GEGL  = O_GVAL  + (size_t)2048 * 64 * 128 * 4;
constexpr size_t O_XEND  = O_GEGL  + 8192;
constexpr size_t O_YGELU = O_XEND  + (size_t)64 * 32 * 64 * 2 * 4;
constexpr size_t O_YGLU  = O_YGELU + (size_t)T_ * 512 * 2;
constexpr size_t O_ATT_END = O_YGLU + (size_t)T_ * 512 * 4;
constexpr size_t O_HF    = O_R;
constexpr size_t O_ACT   = O_HF    + (size_t)T_ * NFF * 2;
constexpr size_t O_FFN_END = O_ACT + (size_t)T_ * DFF * 2;
constexpr size_t WS_NEED = O_ATT_END > O_FFN_END ? O_ATT_END : O_FFN_END;

struct Params { const float* in[33]; float* out; unsigned char* ws; int ph_lo, ph_hi; };

__device__ __forceinline__ unsigned short f2bf(float f) { unsigned u = __float_as_uint(f); u += 0x7FFFu + ((u >> 16) & 1u); return (unsigned short)(u >> 16); }
__device__ __forceinline__ float bf2f(unsigned short b) { return __uint_as_float(((unsigned)b) << 16); }
__device__ __forceinline__ unsigned pk2(float lo, float hi) { return pg8::cvt_pk_bf16(lo, hi); }
__device__ __forceinline__ float bflo(unsigned w) { return __uint_as_float(w << 16); }
__device__ __forceinline__ float bfhi(unsigned w) { return __uint_as_float(w & 0xFFFF0000u); }
__device__ __forceinline__ float sigmoidf_(float x) { return 1.0f / (1.0f + __expf(-x)); }
__device__ __forceinline__ float siluf_(float x) { return x / (1.0f + __expf(-x)); }
__device__ __forceinline__ float gelu_tanh(float x) { const float u = 0.7978845608028654f * (x + 0.044715f * x * x * x); const float th = 1.0f - 2.0f / (__expf(2.0f * u) + 1.0f); return 0.5f * x * (1.0f + th); }
__device__ __forceinline__ float softplusf_(float x) { return x > 20.f ? x : log1pf(expf(x)); }
__device__ __forceinline__ float wave_sum(float v) { for (int o = 32; o >= 1; o >>= 1) v += __shfl_xor(v, o); return v; }
__device__ __forceinline__ bf16x8 pack8f(f32x4 a, f32x4 b) { u32x4 w; w.x = pk2(a[0], a[1]); w.y = pk2(a[2], a[3]); w.z = pk2(b[0], b[1]); w.w = pk2(b[2], b[3]); return __builtin_bit_cast(bf16x8, w); }
__device__ __forceinline__ float rdlane(float v, int l) { return __int_as_float(__builtin_amdgcn_readlane(__float_as_int(v), l)); }

struct EpiProj {
    static constexpr bool PERM = false, AFTER_DRAIN = false;
    float* P32; bf16_t* Pu; bf16_t* Pqkv; bf16_t* Pz;
    static __device__ __forceinline__ void st_bf(const f32x4 (&acc)[2][2][4][2], bf16_t* base, int ld) {
#pragma unroll
        for (int ai = 0; ai < 2; ++ai)
#pragma unroll
            for (int m = 0; m < 4; ++m) { bf16_t* rp = base + (size_t)(ai * 128 + m * 16) * ld;
#pragma unroll
                for (int bj = 0; bj < 2; ++bj)
#pragma unroll
                    for (int n = 0; n < 2; ++n) { const f32x4 v = acc[ai][bj][m][n]; u32x2 w; w.x = pk2(v[0], v[1]); w.y = pk2(v[2], v[3]); *(u32x2*)(rp + bj * 128 + n * 16) = w; } }
    }
    __device__ __forceinline__ void operator()(const f32x4 (&acc)[2][2][4][2], const Unit& u, int wr, int wc, int fr, int fq) const {
        const int row0 = u.pm * 256 + wr * 64 + fr, colt = wc * 32 + 4 * fq;
        if (u.pn < 6) {
            float* base = P32 + (size_t)row0 * 1536 + u.pn * 256 + colt;
#pragma unroll
            for (int ai = 0; ai < 2; ++ai)
#pragma unroll
                for (int m = 0; m < 4; ++m) { float* rp = base + (size_t)(ai * 128 + m * 16) * 1536;
#pragma unroll
                    for (int bj = 0; bj < 2; ++bj)
#pragma unroll
                        for (int n = 0; n < 2; ++n) *(f32x4*)(rp + bj * 128 + n * 16) = acc[ai][bj][m][n]; }
        } else if (u.pn < 8)  st_bf(acc, Pu   + (size_t)row0 * 512  + (u.pn - 6)  * 256 + colt, 512);
        else if (u.pn < 20)   st_bf(acc, Pqkv + (size_t)row0 * 3072 + (u.pn - 8)  * 256 + colt, 3072);
        else                  st_bf(acc, Pz   + (size_t)row0 * 1024 + (u.pn - 20) * 256 + colt, 1024);
    }
};
struct EpiResid {
    static constexpr bool PERM = false, AFTER_DRAIN = false;
    float* X; int ld;
    __device__ __forceinline__ void operator()(const f32x4 (&acc)[2][2][4][2], const Unit& u, int wr, int wc, int fr, int fq) const {
        float* base = X + (size_t)(u.pm * 256 + wr * 64 + fr) * ld + u.pn * 256 + wc * 32 + 4 * fq;
#pragma unroll
        for (int ai = 0; ai < 2; ++ai)
#pragma unroll
            for (int m = 0; m < 4; ++m) { float* rp = base + (size_t)(ai * 128 + m * 16) * ld;
#pragma unroll
                for (int bj = 0; bj < 2; ++bj)
#pragma unroll
                    for (int n = 0; n < 2; ++n) { f32x4* q = (f32x4*)(rp + bj * 128 + n * 16); *q = *q + acc[ai][bj][m][n]; } }
    }
};
struct EpiBf {
    static constexpr bool PERM = false, AFTER_DRAIN = false;
    bf16_t* O; int ld;
    __device__ __forceinline__ void operator()(const f32x4 (&acc)[2][2][4][2], const Unit& u, int wr, int wc, int fr, int fq) const {
        bf16_t* base = O + (size_t)(u.pm * 256 + wr * 64 + fr) * ld + u.pn * 256 + wc * 32 + 4 * fq;
#pragma unroll
        for (int ai = 0; ai < 2; ++ai)
#pragma unroll
            for (int m = 0; m < 4; ++m) { bf16_t* rp = base + (size_t)(ai * 128 + m * 16) * ld;
#pragma unroll
                for (int bj = 0; bj < 2; ++bj)
#pragma unroll
                    for (int n = 0; n < 2; ++n) { const f32x4 v = acc[ai][bj][m][n]; u32x2 w; w.x = pk2(v[0], v[1]); w.y = pk2(v[2], v[3]); *(u32x2*)(rp + bj * 128 + n * 16) = w; } }
    }
};
struct EpiGlu {
    static constexpr bool PERM = false, AFTER_DRAIN = false;
    const bf16_t* Y; float* O;
    __device__ __forceinline__ void operator()(const f32x4 (&acc)[2][2][4][2], const Unit& u, int wr, int wc, int fr, int fq) const {
        const size_t off0 = (size_t)(u.pm * 256 + wr * 64 + fr) * 512 + u.pn * 256 + wc * 32 + 4 * fq;
#pragma unroll
        for (int ai = 0; ai < 2; ++ai)
#pragma unroll
            for (int m = 0; m < 4; ++m) { const size_t ro = off0 + (size_t)(ai * 128 + m * 16) * 512;
#pragma unroll
                for (int bj = 0; bj < 2; ++bj)
#pragma unroll
                    for (int n = 0; n < 2; ++n) { const size_t o = ro + bj * 128 + n * 16; const u32x2 yw = *(const u32x2*)(Y + o); const f32x4 a = acc[ai][bj][m][n];
                        f32x4 r; r[0] = bflo(yw.x) * sigmoidf_(a[0]); r[1] = bfhi(yw.x) * sigmoidf_(a[1]); r[2] = bflo(yw.y) * sigmoidf_(a[2]); r[3] = bfhi(yw.y) * sigmoidf_(a[3]); *(f32x4*)(O + o) = r; } }
    }
};
__device__ __forceinline__ int map_in_col(int n) { return n < 1304 ? n : (n < 1312 ? 5912 + (n - 1304) : (n < 1320 ? 5920 + (n - 1312) : (n < 1536 ? -1 : 1304 + (n - 1536)))); }
__device__ void convT_tile(const float* __restrict__ src, int srcN, int K, bf16_t* __restrict__ dst, int tile, bool inmap, float* sm) {
    const int nk = K >> 6, tk = tile % nk, tn = tile / nk, k0 = tk * 64, n0 = tn * 64;
    const int tx = tidx() & 63, ty = tidx() >> 6;
    const int n = n0 + tx, sc = inmap ? map_in_col(n) : n;
#pragma unroll
    for (int i = 0; i < 8; ++i) { const int k = ty + 8 * i; sm[k * 65 + tx] = (sc >= 0) ? src[(size_t)(k0 + k) * srcN + sc] : 0.f; }
    __syncthreads();
#pragma unroll
    for (int i = 0; i < 8; ++i) { const int nn = ty + 8 * i; dst[(size_t)(n0 + nn) * K + k0 + tx] = f2bf(sm[tx * 65 + nn]); }
    __syncthreads();
}
__device__ void phase_convert(const Params& p, int layer, float* sm) {
    unsigned char* ws = p.ws;
    const int G = gridDim.x, b = blockIdx.x;
    const int n0 = 32 * 96, n1 = n0 + 32 * 32, n2 = n1 + 32 * 172, n3 = n2 + 86 * 32, n4 = n3 + 128, n5 = n4 + 128, n6 = n5 + 64;
    for (int it = b; it < n6; it += G) {
        if (it < n0)      convT_tile(p.in[2]  + (size_t)layer * DM * 5928, 5928, DM, (bf16_t*)(ws + O_WIN), it, true, sm);
        else if (it < n1) convT_tile(p.in[27] + (size_t)layer * DM * DM, DM, DM, (bf16_t*)(ws + O_WOUT), it - n0, false, sm);
        else if (it < n2) convT_tile(p.in[29] + (size_t)layer * DM * NFF, NFF, DM, (bf16_t*)(ws + O_WFIN), it - n1, false, sm);
        else if (it < n3) convT_tile(p.in[32] + (size_t)layer * DFF * DM, DM, DFF, (bf16_t*)(ws + O_WFOUT), it - n2, false, sm);
        else if (it < n4) convT_tile(p.in[8]  + (size_t)layer * 2048 * 256, 256, 2048, (bf16_t*)(ws + O_WCK), it - n3, false, sm);
        else if (it < n5) convT_tile(p.in[10] + (size_t)layer * 2048 * 256, 256, 2048, (bf16_t*)(ws + O_WCV), it - n4, false, sm);
        else              convT_tile(p.in[21] + (size_t)layer * 512 * 512, 512, 512, (bf16_t*)(ws + O_WGLU), it - n5, false, sm);
    }
}
__device__ void phase_rmsnorm(const float* __restrict__ x, const float* __restrict__ gain, bf16_t* __restrict__ hn, float* __restrict__ xcopy) {
    const int wave = tidx() >> 6, lane = tidx() & 63;
    for (int r = blockIdx.x * 8 + wave; r < T_; r += gridDim.x * 8) {
        const f32x4* xr = (const f32x4*)(x + (size_t)r * DM);
        f32x4 v[8]; float ss = 0.f;
#pragma unroll
        for (int i = 0; i < 8; ++i) { v[i] = xr[lane + 64 * i]; ss += v[i][0] * v[i][0] + v[i][1] * v[i][1] + v[i][2] * v[i][2] + v[i][3] * v[i][3]; }
        ss = wave_sum(ss);
        const float rs = rsqrtf(ss * (1.0f / DM) + 1e-6f);
#pragma unroll
        for (int i = 0; i < 8; ++i) { const f32x4 g = ((const f32x4*)gain)[lane + 64 * i]; u32x2 w; w.x = pk2(v[i][0] * rs * g[0], v[i][1] * rs * g[1]); w.y = pk2(v[i][2] * rs * g[2], v[i][3] * rs * g[3]);
            *(u32x2*)(hn + (size_t)r * DM + (lane + 64 * i) * 4) = w; if (xcopy) ((f32x4*)(xcopy + (size_t)r * DM))[lane + 64 * i] = v[i]; }
    }
}

__device__ void nsa_prep_item(const Params& p, int layer, int item, float* sm) {
    unsigned char* ws = p.ws;
    const float* P32 = (const float*)(ws + O_P32);
    bf16_t* qn = (bf16_t*)(ws + O_QN); bf16_t* ksn = (bf16_t*)(ws + O_KSN); bf16_t* kwn = (bf16_t*)(ws + O_KWN);
    const int wave = tidx() >> 6, lane = tidx() & 63, tid = tidx();
    const int t0 = item * 64;
    const float gq = p.in[3][layer * 64 + lane], gks = p.in[5][layer * 64 + lane], gkw = p.in[6][layer * 64 + lane];
    const float inv = powf(500000.0f, -(float)(lane & 7) * 0.125f);
    for (int tt = 0; tt < 8; ++tt) {
        const int t = t0 + wave * 8 + tt;
        float sn, cs; sincosf((float)t * inv, &sn, &cs);
        const float* row = P32 + (size_t)t * 1536;
#pragma unroll
        for (int hv = 0; hv < 12; ++hv) {
            const int col = hv < 8 ? hv * 64 : (hv < 10 ? 768 + (hv - 8) * 64 : 1024 + (hv - 10) * 64);
            const float g = hv < 8 ? gq : (hv < 10 ? gks : gkw);
            const float x = row[col + lane];
            const float ss = wave_sum(x * x);
            float y = x * rsqrtf(ss * (1.0f / 64.0f) + 1e-6f) * g;
            const float yp = __shfl(y, lane ^ 8);
            if (lane < 8) y = y * cs - yp * sn; else if (lane < 16) y = y * cs + yp * sn;
            if (hv < 8) qn[(size_t)t * 512 + hv * 64 + lane] = f2bf(y * 0.125f);
            else if (hv < 10) ksn[(size_t)t * 128 + (hv - 8) * 64 + lane] = f2bf(y);
            else kwn[(size_t)t * 128 + (hv - 10) * 64 + lane] = f2bf(y);
        }
    }
    for (int e = tid; e < 64 * 256; e += 512) { const int tk = e >> 8, c = e & 255; sm[tk * 257 + c] = P32[(size_t)(t0 + tk) * 1536 + (c < 128 ? 896 + c : 1152 + (c - 128))]; }
    __syncthreads();
    bf16_t* vsT = (bf16_t*)(ws + O_VST); bf16_t* vwT = (bf16_t*)(ws + O_VWT);
#pragma unroll
    for (int i = 0; i < 4; ++i) {
        const int rowid = (tid >> 3) + 64 * i, ts = tid & 7;
        u32x4 w; float f[8];
#pragma unroll
        for (int k = 0; k < 8; ++k) f[k] = sm[(ts * 8 + k) * 257 + rowid];
        w.x = pk2(f[0], f[1]); w.y = pk2(f[2], f[3]); w.z = pk2(f[4], f[5]); w.w = pk2(f[6], f[7]);
        bf16_t* dst = (rowid < 128 ? vsT + (size_t)rowid * T_ : vwT + (size_t)(rowid - 128) * T_) + t0 + ts * 8;
        *(u32x4*)dst = w;
    }
    __syncthreads();
}

__device__ void cmp1_wave_tile(const Params& p, int layer, int tile) {
    unsigned char* ws = p.ws;
    const float* P32 = (const float*)(ws + O_P32);
    const int lane = tidx() & 63, fr = lane & 15, fq = lane >> 4;
    const int nt = tile & 15, mt = (tile >> 4) & 127, which = tile >> 11;
    const bf16_t* Wt = (const bf16_t*)(ws + (which ? O_WCV : O_WCK)) + (size_t)(nt * 16 + fr) * 2048 + fq * 8;
    const float* pe = p.in[7] + (size_t)layer * 2048;
    const int r = mt * 16 + fr, n = r >> 1, hk = r & 1;
    const bool rv = n < 1023;
    const float* arow = P32 + (size_t)(16 * (rv ? n : 0)) * 1536 + (which ? 640 : 512) + hk * 64 + fq * 8;
    f32x4 acc = {0.f, 0.f, 0.f, 0.f};
#pragma unroll 4
    for (int ks = 0; ks < 64; ++ks) {
        const int l = ks >> 1, d = (ks & 1) * 32;
        const f32x4* ap = (const f32x4*)(arow + (size_t)l * 1536 + d);
        const f32x4* pp = (const f32x4*)(pe + l * 64 + d + fq * 8);
        f32x4 a0 = ap[0] + pp[0], a1 = ap[1] + pp[1];
        if (!rv) { a0 = (f32x4){0.f, 0.f, 0.f, 0.f}; a1 = a0; }
        const bf16x8 af = pack8f(a0, a1);
        const bf16x8 bf = *(const bf16x8*)(Wt + ks * 32);
        acc = MFMA16(af, bf, acc);
    }
    float* H = (float*)(ws + O_HCMP) + (size_t)which * 2048 * 256;
#pragma unroll
    for (int j = 0; j < 4; ++j) H[(size_t)(mt * 16 + fq * 4 + j) * 256 + nt * 16 + fr] = gelu_tanh(acc[j]);
}
__device__ void cmp2_wave_row(const Params& p, int layer, int idx) {
    unsigned char* ws = p.ws;
    const int lane = tidx() & 63;
    const int which = idx >> 11, r = idx & 2047, n = r >> 1, hk = r & 1;
    const float* H = (const float*)(ws + O_HCMP) + ((size_t)which * 2048 + r) * 256;
    const float* w2 = p.in[which ? 11 : 9] + (size_t)layer * 256 * 64;
    float acc = 0.f;
    if (n < 1023) {
#pragma unroll 8
        for (int f = 0; f < 256; ++f) acc += H[f] * w2[f * 64 + lane];
    }
    if (which == 0) {
        const float ss = wave_sum(acc * acc);
        float y = acc * rsqrtf(ss * (1.0f / 64.0f) + 1e-6f) * p.in[4][layer * 64 + lane];
        const float inv = powf(500000.0f, -(float)(lane & 7) * 0.125f);
        float sn, cs; sincosf((float)(16 * n + 16) * inv, &sn, &cs);
        const float yp = __shfl(y, lane ^ 8);
        if (lane < 8) y = y * cs - yp * sn; else if (lane < 16) y = y * cs + yp * sn;
        if (n >= 1023) y = 0.f;
        ((bf16_t*)(ws + O_KC))[((size_t)hk * 1024 + n) * 64 + lane] = f2bf(y);
    } else {
        ((bf16_t*)(ws + O_VCT))[((size_t)hk * 64 + lane) * 1024 + n] = f2bf(acc);
    }
}

struct S5Coef { float ar, ai; float bbr[16], bbi[16]; };
__device__ __forceinline__ void s5_setup(const Params& p, int layer, int g, int lane, S5Coef& c) {
    const int gp = layer * 2048 + g * 64 + lane;
    const float dt = expf(p.in[15][layer * 32 + g]);
    const float lr = p.in[13][gp], li = p.in[14][gp];
    const float mag = expf(lr * dt); float sn, cs; sincosf(li * dt, &sn, &cs);
    c.ar = mag * cs; c.ai = mag * sn;
    const float den = lr * lr + li * li, nr = c.ar - 1.0f, ni = c.ai;
    const float cr = (nr * lr + ni * li) / den, ci = (ni * lr - nr * li) / den;
    const f32x4* br = (const f32x4*)(p.in[16] + (size_t)gp * 16); const f32x4* bi = (const f32x4*)(p.in[17] + (size_t)gp * 16);
#pragma unroll
    for (int q = 0; q < 4; ++q) { const f32x4 a = br[q], b = bi[q];
#pragma unroll
        for (int e = 0; e < 4; ++e) { c.bbr[q * 4 + e] = cr * a[e] - ci * b[e]; c.bbi[q * 4 + e] = cr * b[e] + ci * a[e]; } }
}
__device__ __forceinline__ void s5_load_u(const bf16_t* Pu, int tok, int g, float (&ur)[16]) {
    const u32x4* s = (const u32x4*)(Pu + (size_t)tok * 512 + g * 16); const u32x4 a = s[0], b = s[1];
    ur[0] = bflo(a.x); ur[1] = bfhi(a.x); ur[2] = bflo(a.y); ur[3] = bfhi(a.y); ur[4] = bflo(a.z); ur[5] = bfhi(a.z); ur[6] = bflo(a.w); ur[7] = bfhi(a.w);
    ur[8] = bflo(b.x); ur[9] = bfhi(b.x); ur[10] = bflo(b.y); ur[11] = bfhi(b.y); ur[12] = bflo(b.z); ur[13] = bfhi(b.z); ur[14] = bflo(b.w); ur[15] = bfhi(b.w);
}
__device__ void s5_passA_wave(const Params& p, int layer, int item) {
    unsigned char* ws = p.ws; const bf16_t* Pu = (const bf16_t*)(ws + O_PU);
    const int lane = tidx() & 63, c = item >> 5, g = item & 31;
    S5Coef k; s5_setup(p, layer, g, lane, k);
    float xr = 0.f, xi = 0.f;
    for (int sub = 0; sub < 4; ++sub) {
        float ur[16]; s5_load_u(Pu, c * 256 + sub * 64 + lane, g, ur);
        for (int j = 0; j < 64; ++j) {
            float bur = 0.f, bui = 0.f;
#pragma unroll
            for (int h = 0; h < 16; ++h) { const float u = rdlane(ur[h], j); bur += k.bbr[h] * u; bui += k.bbi[h] * u; }
            const float nxr = k.ar * xr - k.ai * xi + bur, nxi = k.ar * xi + k.ai * xr + bui; xr = nxr; xi = nxi;
        }
    }
    float* xe = (float*)(ws + O_XEND) + ((size_t)(c * 32 + g) * 64 + lane) * 2; xe[0] = xr; xe[1] = xi;
}
__device__ void s5_passB_wave(const Params& p, int layer, int item, bf16_t* xl) {
    unsigned char* ws = p.ws; const bf16_t* Pu = (const bf16_t*)(ws + O_PU); bf16_t* yg = (bf16_t*)(ws + O_YGELU);
    const int lane = tidx() & 63, fr = lane & 15, fq = lane >> 4, c = item >> 5, g = item & 31;
    S5Coef k; s5_setup(p, layer, g, lane, k);
    float pr = k.ar, pi = k.ai;
#pragma unroll
    for (int s = 0; s < 8; ++s) { const float nr = pr * pr - pi * pi, ni = 2.f * pr * pi; pr = nr; pi = ni; }
    float xr = 0.f, xi = 0.f;
    const float* xe = (const float*)(ws + O_XEND) + ((size_t)g * 64 + lane) * 2;
    for (int cc = 0; cc < c; ++cc) { const float er = xe[(size_t)cc * 32 * 64 * 2], ei = xe[(size_t)cc * 32 * 64 * 2 + 1]; const float nr = pr * xr - pi * xi + er, ni = pr * xi + pi * xr + ei; xr = nr; xi = ni; }
    bf16x8 cf[4];
    {
        const float* cre = p.in[18] + (size_t)layer * 32 * 16 * 64 + ((size_t)g * 16 + fr) * 64; const float* cim = p.in[19] + (size_t)layer * 32 * 16 * 64 + ((size_t)g * 16 + fr) * 64;
#pragma unroll
        for (int ks = 0; ks < 4; ++ks) { const float* s = (ks < 2 ? cre : cim) + (ks & 1) * 32 + fq * 8; f32x4 a = ((const f32x4*)s)[0], b = ((const f32x4*)s)[1]; if (ks >= 2) { a = -a; b = -b; } cf[ks] = pack8f(a, b); }
    }
    const float dsk = p.in[20][layer * 512 + g * 16 + fr];
    for (int sub = 0; sub < 4; ++sub) {
        const int tb = c * 256 + sub * 64;
        float ur[16]; s5_load_u(Pu, tb + lane, g, ur);
        for (int jb = 0; jb < 4; ++jb) {
            for (int jj = 0; jj < 16; ++jj) {
                const int j = jb * 16 + jj;
                float bur = 0.f, bui = 0.f;
#pragma unroll
                for (int h = 0; h < 16; ++h) { const float u = rdlane(ur[h], j); bur += k.bbr[h] * u; bui += k.bbi[h] * u; }
                const float nxr = k.ar * xr - k.ai * xi + bur, nxi = k.ar * xi + k.ai * xr + bui; xr = nxr; xi = nxi;
                xl[jj * 136 + lane] = f2bf(xr); xl[jj * 136 + 64 + lane] = f2bf(xi);
            }
            asm volatile("s_waitcnt lgkmcnt(0)" ::: "memory");
            f32x4 y = {0.f, 0.f, 0.f, 0.f};
#pragma unroll
            for (int ks = 0; ks < 4; ++ks) { const bf16x8 af = *(const bf16x8*)(xl + fr * 136 + ks * 32 + fq * 8); y = MFMA16(af, cf[ks], y); }
            asm volatile("s_waitcnt lgkmcnt(0)" ::: "memory");
#pragma unroll
            for (int q = 0; q < 4; ++q) { const int tok = tb + jb * 16 + fq * 4 + q; const float u = bf2f(Pu[(size_t)tok * 512 + g * 16 + fr]); yg[(size_t)tok * 512 + g * 16 + fr] = f2bf(gelu_tanh(y[q] + dsk * u)); }
        }
    }
}
__device__ void gdn_prep_item(const Params& p, int layer, int item, unsigned char* lds) {
    unsigned char* ws = p.ws;
    const int tid = tidx(), wave = tid >> 6, lane = tid & 63, fr = lane & 15, fq = lane >> 4;
    const int n = item >> 3, h = item & 7, t0 = n * 64;
    bf16_t* qs = (bf16_t*)(lds); bf16_t* ks = (bf16_t*)(lds + 17408); bf16_t* vbT = (bf16_t*)(lds + 34816); bf16_t* kgT = (bf16_t*)(lds + 53248); bf16_t* kdT = (bf16_t*)(lds + 71680);
    float* Am = (float*)(lds + 90112); bf16_t* Tb = (bf16_t*)(lds + 107520); float* gcs = (float*)(lds + 116736); float* bts = (float*)(lds + 116992);
    const float* P32 = (const float*)(ws + O_P32); const bf16_t* Pqkv = (const bf16_t*)(ws + O_PQKV);
    if (wave == 0) {
        const int t = t0 + lane;
        const float a = P32[(size_t)t * 1536 + 1304 + h], b = P32[(size_t)t * 1536 + 1312 + h];
        const float g = -expf(p.in[24][layer * 8 + h]) * softplusf_(a + p.in[25][layer * 8 + h]);
        float s = g;
#pragma unroll
        for (int off = 1; off < 64; off <<= 1) { const float o = __shfl_up(s, off); if (lane >= off) s += o; }
        gcs[lane] = s; bts[lane] = sigmoidf_(b);
    }
    __syncthreads();
    {
        const int r = tid >> 3, c0 = (tid & 7) * 16;
        const float gcr = gcs[r], btr = bts[r], eg = expf(gcr), ed = expf(gcs[63] - gcr);
        const float* cw = p.in[23] + (size_t)layer * 4 * 3072;
#pragma unroll
        for (int which = 0; which < 3; ++which) {
            const int col = which * 1024 + h * 128 + c0;
            float acc[16];
#pragma unroll
            for (int e = 0; e < 16; ++e) acc[e] = 0.f;
#pragma unroll
            for (int j = 0; j < 4; ++j) {
                const int tr = t0 + r - 3 + j;
                if (tr >= 0) {
                    const u32x4* s = (const u32x4*)(Pqkv + (size_t)tr * 3072 + col); const u32x4 a = s[0], b = s[1];
                    const f32x4* wp = (const f32x4*)(cw + j * 3072 + col); const f32x4 w0 = wp[0], w1 = wp[1], w2 = wp[2], w3 = wp[3];
                    acc[0] += w0[0] * bflo(a.x); acc[1] += w0[1] * bfhi(a.x); acc[2] += w0[2] * bflo(a.y); acc[3] += w0[3] * bfhi(a.y);
                    acc[4] += w1[0] * bflo(a.z); acc[5] += w1[1] * bfhi(a.z); acc[6] += w1[2] * bflo(a.w); acc[7] += w1[3] * bfhi(a.w);
                    acc[8] += w2[0] * bflo(b.x); acc[9] += w2[1] * bfhi(b.x); acc[10] += w2[2] * bflo(b.y); acc[11] += w2[3] * bfhi(b.y);
                    acc[12] += w3[0] * bflo(b.z); acc[13] += w3[1] * bfhi(b.z); acc[14] += w3[2] * bflo(b.w); acc[15] += w3[3] * bfhi(b.w);
                }
            }
            float ss = 0.f;
#pragma unroll
            for (int e = 0; e < 16; ++e) { acc[e] = siluf_(acc[e]); ss += acc[e] * acc[e]; }
            ss += __shfl_xor(ss, 1); ss += __shfl_xor(ss, 2); ss += __shfl_xor(ss, 4);
            const float rn = rsqrtf(ss + 1e-6f);
            if (which == 0) {
                bf16_t* qg = (bf16_t*)(ws + O_GQG) + (size_t)item * 8192 + r * 128 + c0;
                float v[16];
#pragma unroll
                for (int e = 0; e < 16; ++e) v[e] = acc[e] * rn * 0.08838834764831845f;
                u32x4 w0, w1; w0.x = pk2(v[0], v[1]); w0.y = pk2(v[2], v[3]); w0.z = pk2(v[4], v[5]); w0.w = pk2(v[6], v[7]); w1.x = pk2(v[8], v[9]); w1.y = pk2(v[10], v[11]); w1.z = pk2(v[12], v[13]); w1.w = pk2(v[14], v[15]);
                *(u32x4*)(qs + r * 136 + c0) = w0; *(u32x4*)(qs + r * 136 + c0 + 8) = w1;
                u32x4 g0, g1; g0.x = pk2(v[0] * eg, v[1] * eg); g0.y = pk2(v[2] * eg, v[3] * eg); g0.z = pk2(v[4] * eg, v[5] * eg); g0.w = pk2(v[6] * eg, v[7] * eg);
                g1.x = pk2(v[8] * eg, v[9] * eg); g1.y = pk2(v[10] * eg, v[11] * eg); g1.z = pk2(v[12] * eg, v[13] * eg); g1.w = pk2(v[14] * eg, v[15] * eg);
                *(u32x4*)qg = g0; *(u32x4*)(qg + 8) = g1;
            } else if (which == 1) {
                float v[16];
#pragma unroll
                for (int e = 0; e < 16; ++e) v[e] = acc[e] * rn;
                u32x4 w0, w1; w0.x = pk2(v[0], v[1]); w0.y = pk2(v[2], v[3]); w0.z = pk2(v[4], v[5]); w0.w = pk2(v[6], v[7]); w1.x = pk2(v[8], v[9]); w1.y = pk2(v[10], v[11]); w1.z = pk2(v[12], v[13]); w1.w = pk2(v[14], v[15]);
                *(u32x4*)(ks + r * 136 + c0) = w0; *(u32x4*)(ks + r * 136 + c0 + 8) = w1;
#pragma unroll
                for (int e = 0; e < 16; ++e) { kgT[(c0 + e) * 72 + r] = f2bf(v[e] * btr * eg); kdT[(c0 + e) * 72 + r] = f2bf(v[e] * ed); }
            } else {
#pragma unroll
                for (int e = 0; e < 16; ++e) vbT[(c0 + e) * 72 + r] = f2bf(acc[e] * btr);
            }
        }
    }
    __syncthreads();
    {
        const int d = tid >> 2, sg = tid & 3;
        const u32x4 a = *(const u32x4*)(kdT + d * 72 + sg * 16), b = *(const u32x4*)(kdT + d * 72 + sg * 16 + 8);
        bf16_t* dst = (bf16_t*)(ws + O_GKD) + (size_t)item * 8192 + d * 64 + sg * 16; *(u32x4*)dst = a; *(u32x4*)(dst + 8) = b;
    }
    { float* Tmz = (float*)(lds + 117248); for (int e2 = tid; e2 < 64 * 68; e2 += 512) Tmz[e2] = 0.f; }
    {
        const int mi = wave >> 1;
        bf16_t* qko = (bf16_t*)(ws + O_GQK) + (size_t)item * 4096;
#pragma unroll
        for (int q = 0; q < 2; ++q) {
            const int nj = (wave & 1) * 2 + q;
            f32x4 kk = {0.f, 0.f, 0.f, 0.f}, qk = {0.f, 0.f, 0.f, 0.f};
            if (nj <= mi) {
#pragma unroll
                for (int s = 0; s < 4; ++s) {
                    const bf16x8 bk = *(const bf16x8*)(ks + (nj * 16 + fr) * 136 + s * 32 + fq * 8);
                    const bf16x8 ak = *(const bf16x8*)(ks + (mi * 16 + fr) * 136 + s * 32 + fq * 8);
                    const bf16x8 aq = *(const bf16x8*)(qs + (mi * 16 + fr) * 136 + s * 32 + fq * 8);
                    kk = MFMA16(ak, bk, kk); qk = MFMA16(aq, bk, qk);
                }
            }
            const int j = nj * 16 + fr; const float gj = gcs[j];
#pragma unroll
            for (int e = 0; e < 4; ++e) {
                const int i = mi * 16 + fq * 4 + e;
                const float dec = (j <= i) ? expf(gcs[i] - gj) : 0.f;
                Am[i * 68 + j] = (j < i) ? bts[i] * kk[e] * dec : 0.f;
                qko[i * 64 + j] = f2bf((j <= i) ? qk[e] * dec : 0.f);
            }
        }
    }
    __syncthreads();
    {
        float* Tm = (float*)(lds + 117248); float* Ps = (float*)(lds + 134656) + wave * 320;
        if (wave == 0) {
            const int bo = fq * 16; float t[16];
#pragma unroll
            for (int i = 0; i < 16; ++i) {
                float s = (i == fr) ? 1.f : 0.f;
#pragma unroll
                for (int j = 0; j < i; ++j) s -= Am[(bo + i) * 68 + bo + j] * t[j];
                t[i] = s; Tm[(bo + i) * 68 + bo + fr] = s;
            }
        }
        asm volatile("s_waitcnt lgkmcnt(0)" ::: "memory"); __syncthreads();
#pragma unroll
        for (int d = 1; d < 4; ++d) {
            if (wave < 4 - d) {
                const int bi = wave + d, bj = wave;
                f32x4 Q = {0.f, 0.f, 0.f, 0.f};
                for (int kb = bj; kb < bi; ++kb) {
                    const float* X = Am + (bi * 16) * 68 + kb * 16; const float* Y = Tm + (kb * 16) * 68 + bj * 16;
#pragma unroll
                    for (int s = 0; s < 4; ++s) Q = __builtin_amdgcn_mfma_f32_16x16x4f32(X[fr * 68 + 4 * s + fq], Y[(4 * s + fq) * 68 + fr], Q, 0, 0, 0);
                }
#pragma unroll
                for (int e2 = 0; e2 < 4; ++e2) Ps[(fq * 4 + e2) * 20 + fr] = Q[e2];
                asm volatile("s_waitcnt lgkmcnt(0)" ::: "memory");
                f32x4 R = {0.f, 0.f, 0.f, 0.f};
                const float* X = Tm + (bi * 16) * 68 + bi * 16;
#pragma unroll
                for (int s = 0; s < 4; ++s) R = __builtin_amdgcn_mfma_f32_16x16x4f32(X[fr * 68 + 4 * s + fq], Ps[(4 * s + fq) * 20 + fr], R, 0, 0, 0);
#pragma unroll
                for (int e2 = 0; e2 < 4; ++e2) Tm[(bi * 16 + fq * 4 + e2) * 68 + bj * 16 + fr] = -R[e2];
            }
            asm volatile("s_waitcnt lgkmcnt(0)" ::: "memory"); __syncthreads();
        }
        for (int e2 = tid; e2 < 4096; e2 += 512) { const int r = e2 >> 6, c = e2 & 63; Tb[r * 72 + c] = f2bf(Tm[r * 68 + c]); }
    }
    __syncthreads();
    {
        const int mi = wave & 3;
        const bf16x8 a0 = *(const bf16x8*)(Tb + (mi * 16 + fr) * 72 + fq * 8), a1 = *(const bf16x8*)(Tb + (mi * 16 + fr) * 72 + 32 + fq * 8);
        float* vo = (float*)(ws + O_GVAL) + (size_t)item * 8192; bf16_t* ko = (bf16_t*)(ws + O_GKC) + (size_t)item * 8192;
#pragma unroll
        for (int q = 0; q < 4; ++q) {
            const int nt = (wave >> 2) * 4 + q;
            f32x4 v = {0.f, 0.f, 0.f, 0.f}, kc = {0.f, 0.f, 0.f, 0.f};
            v = MFMA16(a0, *(const bf16x8*)(vbT + (nt * 16 + fr) * 72 + fq * 8), v); v = MFMA16(a1, *(const bf16x8*)(vbT + (nt * 16 + fr) * 72 + 32 + fq * 8), v);
            kc = MFMA16(a0, *(const bf16x8*)(kgT + (nt * 16 + fr) * 72 + fq * 8), kc); kc = MFMA16(a1, *(const bf16x8*)(kgT + (nt * 16 + fr) * 72 + 32 + fq * 8), kc);
#pragma unroll
            for (int e = 0; e < 4; ++e) { const int i = mi * 16 + fq * 4 + e, d = nt * 16 + fr; vo[i * 128 + d] = v[e]; ko[i * 128 + d] = f2bf(kc[e]); }
        }
    }
    if (tid == 0) ((float*)(ws + O_GEGL))[item] = expf(gcs[63]);
    __syncthreads();
}

struct GdnFrag { bf16x8 kc[4], qg[4], qk[2], kd[2][2]; float val[4]; float egl; };
__device__ __forceinline__ void gdn_load(const unsigned char* ws, int item, int mt, int fr, int fq, int dv0, GdnFrag& f) {
    const bf16_t* kc = (const bf16_t*)(ws + O_GKC) + (size_t)item * 8192 + (mt * 16 + fr) * 128 + fq * 8;
    const bf16_t* qg = (const bf16_t*)(ws + O_GQG) + (size_t)item * 8192 + (mt * 16 + fr) * 128 + fq * 8;
    const bf16_t* qk = (const bf16_t*)(ws + O_GQK) + (size_t)item * 4096 + (mt * 16 + fr) * 64 + fq * 8;
    const bf16_t* kd = (const bf16_t*)(ws + O_GKD) + (size_t)item * 8192 + (2 * mt * 16 + fr) * 64 + fq * 8;
    const float* vl = (const float*)(ws + O_GVAL) + (size_t)item * 8192 + (mt * 16 + fq * 4) * 128 + dv0 + fr;
#pragma unroll
    for (int s = 0; s < 4; ++s) { f.kc[s] = *(const bf16x8*)(kc + s * 32); f.qg[s] = *(const bf16x8*)(qg + s * 32); }
#pragma unroll
    for (int s = 0; s < 2; ++s) { f.qk[s] = *(const bf16x8*)(qk + s * 32); f.kd[0][s] = *(const bf16x8*)(kd + s * 32); f.kd[1][s] = *(const bf16x8*)(kd + 16 * 64 + s * 32); }
#pragma unroll
    for (int e = 0; e < 4; ++e) f.val[e] = vl[e * 128];
    f.egl = ((const float*)(ws + O_GEGL))[item];
}
__device__ void gdn_recurrence(const Params& p, int b, unsigned char* lds) {
    const unsigned char* ws = p.ws;
    const int tid = tidx(), wave = tid >> 6, lane = tid & 63, fr = lane & 15, fq = lane >> 4;
    const int h = b >> 2, quad = wave >> 2, mt = wave & 3, dv0 = (b & 3) * 32 + quad * 16;
    bf16_t* Sl = (bf16_t*)lds + quad * (16 * 136); bf16_t* vn = (bf16_t*)(lds + 2 * 16 * 136 * 2) + quad * (16 * 72);
    float* go = (float*)(p.ws + O_PQKV);
    for (int e = tid; e < 2 * 16 * 136; e += 512) ((bf16_t*)lds)[e] = 0;
    __syncthreads();
    f32x4 St[2] = {{0.f, 0.f, 0.f, 0.f}, {0.f, 0.f, 0.f, 0.f}};
    GdnFrag cur, nxt; gdn_load(ws, h, mt, fr, fq, dv0, cur); nxt = cur;
    for (int n = 0; n < 256; ++n) {
        if (n + 1 < 256) gdn_load(ws, (n + 1) * 8 + h, mt, fr, fq, dv0, nxt);
        bf16x8 Sb[4];
#pragma unroll
        for (int s = 0; s < 4; ++s) Sb[s] = *(const bf16x8*)(Sl + fr * 136 + s * 32 + fq * 8);
        f32x4 U = {0.f, 0.f, 0.f, 0.f};
#pragma unroll
        for (int s = 0; s < 4; ++s) U = MFMA16(cur.kc[s], Sb[s], U);
        { u32x2 w; w.x = pk2(cur.val[0] - U[0], cur.val[1] - U[1]); w.y = pk2(cur.val[2] - U[2], cur.val[3] - U[3]); *(u32x2*)(vn + fr * 72 + mt * 16 + fq * 4) = w; }
        asm volatile("s_waitcnt lgkmcnt(0)" ::: "memory"); __builtin_amdgcn_s_barrier(); asm volatile("" ::: "memory");
        const bf16x8 V0 = *(const bf16x8*)(vn + fr * 72 + fq * 8), V1 = *(const bf16x8*)(vn + fr * 72 + 32 + fq * 8);
        f32x4 O = {0.f, 0.f, 0.f, 0.f};
#pragma unroll
        for (int s = 0; s < 4; ++s) O = MFMA16(cur.qg[s], Sb[s], O);
        O = MFMA16(cur.qk[0], V0, O); O = MFMA16(cur.qk[1], V1, O);
#pragma unroll
        for (int e = 0; e < 4; ++e) go[(size_t)(n * 64 + mt * 16 + fq * 4 + e) * 1024 + h * 128 + dv0 + fr] = O[e];
#pragma unroll
        for (int q = 0; q < 2; ++q) {
            St[q] = St[q] * cur.egl;
            St[q] = MFMA16(V0, cur.kd[q][0], St[q]); St[q] = MFMA16(V1, cur.kd[q][1], St[q]);
#pragma unroll
            for (int e = 0; e < 4; ++e) Sl[(fq * 4 + e) * 136 + (2 * mt + q) * 16 + fr] = f2bf(St[q][e]);
        }
        asm volatile("s_waitcnt lgkmcnt(0)" ::: "memory"); __builtin_amdgcn_s_barrier(); asm volatile("" ::: "memory");
        cur = nxt;
    }
}
__device__ __forceinline__ void flash_tile(const bf16x8 (&Qf)[2], const bf16_t* kp, int ldk, const bf16_t* vp, int ldv, unsigned vmask,
                                           float (&m)[4], float (&l)[4], f32x4 (&O)[4], bf16_t* Pt, int fr, int fq) {
    f32x4 S[4];
#pragma unroll
    for (int s = 0; s < 4; ++s) { const bf16x8 k0 = *(const bf16x8*)(kp + (size_t)(s * 16) * ldk), k1 = *(const bf16x8*)(kp + (size_t)(s * 16) * ldk + 32);
        S[s] = (f32x4){0.f, 0.f, 0.f, 0.f}; S[s] = MFMA16(Qf[0], k0, S[s]); S[s] = MFMA16(Qf[1], k1, S[s]); }
    bf16x8 Vf[4][2];
#pragma unroll
    for (int dt = 0; dt < 4; ++dt) { Vf[dt][0] = *(const bf16x8*)(vp + (size_t)(dt * 16) * ldv); Vf[dt][1] = *(const bf16x8*)(vp + (size_t)(dt * 16) * ldv + 32); }
    float mx[4];
#pragma unroll
    for (int j = 0; j < 4; ++j) { float v = -1e30f;
#pragma unroll
        for (int s = 0; s < 4; ++s) v = ((vmask >> s) & 1u) ? fmaxf(v, S[s][j]) : v;
        v = fmaxf(v, __shfl_xor(v, 1)); v = fmaxf(v, __shfl_xor(v, 2)); v = fmaxf(v, __shfl_xor(v, 4)); v = fmaxf(v, __shfl_xor(v, 8)); mx[j] = v; }
#pragma unroll
    for (int j = 0; j < 4; ++j) { const float mn = fmaxf(m[j], mx[j]); const float a = __expf(m[j] - mn); m[j] = mn; l[j] *= a;
#pragma unroll
        for (int dt = 0; dt < 4; ++dt) O[dt][j] *= a; }
#pragma unroll
    for (int s = 0; s < 4; ++s)
#pragma unroll
        for (int j = 0; j < 4; ++j) { const float pv = ((vmask >> s) & 1u) ? __expf(S[s][j] - m[j]) : 0.f; l[j] += pv; Pt[(fq * 4 + j) * 72 + s * 16 + fr] = f2bf(pv); }
    asm volatile("s_waitcnt lgkmcnt(0)" ::: "memory");
    const bf16x8 P0 = *(const bf16x8*)(Pt + fr * 72 + fq * 8), P1 = *(const bf16x8*)(Pt + fr * 72 + 32 + fq * 8);
    asm volatile("s_waitcnt lgkmcnt(0)" ::: "memory");
#pragma unroll
    for (int dt = 0; dt < 4; ++dt) { O[dt] = MFMA16(P0, Vf[dt][0], O[dt]); O[dt] = MFMA16(P1, Vf[dt][1], O[dt]); }
}
__device__ __forceinline__ void branch_finish(float (&l)[4], f32x4 (&O)[4], const float* grow, int br, int hk, f32x4 (&Y)[4]) {
#pragma unroll
    for (int j = 0; j < 4; ++j) { float s = l[j]; s += __shfl_xor(s, 1); s += __shfl_xor(s, 2); s += __shfl_xor(s, 4); s += __shfl_xor(s, 8);
        const float g = sigmoidf_(grow[(hk * 4 + j) * 3 + br]) / fmaxf(s, 1e-30f);
#pragma unroll
        for (int dt = 0; dt < 4; ++dt) Y[dt][j] += g * O[dt][j]; }
}
constexpr int NSA_WLDS = 15680;
__device__ void nsa_wave_task(const Params& p, int layer, int t0, unsigned char* wl) {
    unsigned char* ws = p.ws;
    const int lane = tidx() & 63, fr = lane & 15, fq = lane >> 4;
    float* imp = (float*)wl; unsigned* flg = (unsigned*)(wl + 4160); bf16_t* Pt = (bf16_t*)(wl + 5184); float* yb = (float*)(wl + 7488);
    const bf16_t* qn = (const bf16_t*)(ws + O_QN); const bf16_t* ksn = (const bf16_t*)(ws + O_KSN); const bf16_t* kwn = (const bf16_t*)(ws + O_KWN);
    const bf16_t* vsT = (const bf16_t*)(ws + O_VST); const bf16_t* vwT = (const bf16_t*)(ws + O_VWT); const bf16_t* kc = (const bf16_t*)(ws + O_KC); const bf16_t* vcT = (const bf16_t*)(ws + O_VCT);
    const int trow = t0 + fq;
    const float* grow = (const float*)(ws + O_P32) + (size_t)trow * 1536 + 1280;
    const int tmax = t0 + 3;
    for (int hk = 0; hk < 2; ++hk) {
        bf16x8 Qf[2];
        { const bf16_t* qp = qn + (size_t)(t0 + (fr >> 2)) * 512 + (hk * 4 + (fr & 3)) * 64 + fq * 8; Qf[0] = *(const bf16x8*)qp; Qf[1] = *(const bf16x8*)(qp + 32); }
        f32x4 Y[4];
#pragma unroll
        for (int dt = 0; dt < 4; ++dt) Y[dt] = (f32x4){0.f, 0.f, 0.f, 0.f};
        float m[4], l[4]; f32x4 O[4];
#pragma unroll
        for (int j = 0; j < 4; ++j) { m[j] = -1e30f; l[j] = 0.f; O[j] = (f32x4){0.f, 0.f, 0.f, 0.f}; }
        const int ncmp_t = tmax >= 31 ? ((((tmax - 31) >> 4) >> 6) + 1) : 0;
        for (int kt = 0; kt < ncmp_t; ++kt) {
            const int key0 = kt * 64; unsigned vm = 0;
#pragma unroll
            for (int s = 0; s < 4; ++s) vm |= ((16 * (key0 + s * 16 + fr) + 31 <= trow) ? 1u : 0u) << s;
            flash_tile(Qf, kc + ((size_t)hk * 1024 + key0 + fr) * 64 + fq * 8, 64, vcT + ((size_t)hk * 64 + fr) * 1024 + key0 + fq * 8, 1024, vm, m, l, O, Pt, fr, fq);
        }
        float linv[4];
#pragma unroll
        for (int j = 0; j < 4; ++j) { float s = l[j]; s += __shfl_xor(s, 1); s += __shfl_xor(s, 2); s += __shfl_xor(s, 4); s += __shfl_xor(s, 8); linv[j] = s > 0.f ? 1.0f / s : 0.f; }
        branch_finish(l, O, grow, 0, hk, Y);
        for (int e = lane; e < 4 * 260; e += 64) imp[e] = 0.f;
        for (int e = lane; e < 256; e += 64) flg[e] = 0u;
        asm volatile("s_waitcnt lgkmcnt(0)" ::: "memory");
        for (int kt = 0; kt < ncmp_t; ++kt) {
            const int key0 = kt * 64;
            const bf16_t* kp = kc + ((size_t)hk * 1024 + key0 + fr) * 64 + fq * 8;
#pragma unroll
            for (int s = 0; s < 4; ++s) {
                const bf16x8 k0 = *(const bf16x8*)(kp + (size_t)(s * 16) * 64), k1 = *(const bf16x8*)(kp + (size_t)(s * 16) * 64 + 32);
                f32x4 S = {0.f, 0.f, 0.f, 0.f}; S = MFMA16(Qf[0], k0, S); S = MFMA16(Qf[1], k1, S);
                const int nn = key0 + s * 16 + fr; const bool valid = 16 * nn + 31 <= trow;
                float ps = 0.f;
#pragma unroll
                for (int j = 0; j < 4; ++j) ps += valid ? __expf(S[j] - m[j]) * linv[j] : 0.f;
                float p4 = ps; p4 += __shfl_xor(p4, 1); p4 += __shfl_xor(p4, 2);
                if ((fr & 3) == 0) imp[fq * 260 + (nn >> 2)] += p4;
                asm volatile("s_waitcnt lgkmcnt(0)" ::: "memory");
                if ((fr & 3) == 3) imp[fq * 260 + (nn >> 2) + 1] += ps;
                asm volatile("s_waitcnt lgkmcnt(0)" ::: "memory");
            }
        }
        for (int tok = 0; tok < 4; ++tok) {
            const int t = t0 + tok, cur = t >> 6, nsel = cur + 1 < 16 ? cur + 1 : 16;
            unsigned long long key[4];
#pragma unroll
            for (int i = 0; i < 4; ++i) { const int j = lane + 64 * i; unsigned long long k = 0ull;
                if (j <= cur) { const bool forced = (j == 0) || (j == cur) || (j == cur - 1); const unsigned vb = forced ? 0x7F800000u : __float_as_uint(imp[tok * 260 + j]); k = ((unsigned long long)vb << 32) | (unsigned)(0xFFFF - j); }
                key[i] = k; }
            for (int it = 0; it < nsel; ++it) {
                unsigned long long best = key[0]; best = key[1] > best ? key[1] : best; best = key[2] > best ? key[2] : best; best = key[3] > best ? key[3] : best;
#pragma unroll
                for (int o = 32; o >= 1; o >>= 1) { const unsigned lo = __shfl_xor((unsigned)best, o), hi = __shfl_xor((unsigned)(best >> 32), o); const unsigned long long ob = ((unsigned long long)hi << 32) | lo; best = ob > best ? ob : best; }
                const int jsel = 0xFFFF - (int)(best & 0xFFFFu);
#pragma unroll
                for (int i = 0; i < 4; ++i) if (key[i] == best) key[i] = 0ull;
                if (lane == 0) flg[jsel] |= (1u << tok);
            }
        }
        asm volatile("s_waitcnt lgkmcnt(0)" ::: "memory");
#pragma unroll
        for (int j = 0; j < 4; ++j) { m[j] = -1e30f; l[j] = 0.f; O[j] = (f32x4){0.f, 0.f, 0.f, 0.f}; }
        const int curmax = tmax >> 6;
        for (int jb = 0; jb <= curmax; ++jb) {
            const unsigned fw = flg[jb];
            if (fw == 0u) continue;
            const int key0 = jb * 64; const bool rowsel = (fw >> fq) & 1u; unsigned vm = 0;
#pragma unroll
            for (int s = 0; s < 4; ++s) vm |= ((rowsel && (key0 + s * 16 + fr <= trow)) ? 1u : 0u) << s;
            flash_tile(Qf, ksn + (size_t)(key0 + fr) * 128 + hk * 64 + fq * 8, 128, vsT + ((size_t)hk * 64 + fr) * T_ + key0 + fq * 8, T_, vm, m, l, O, Pt, fr, fq);
        }
        branch_finish(l, O, grow, 1, hk, Y);
#pragma unroll
        for (int j = 0; j < 4; ++j) { m[j] = -1e30f; l[j] = 0.f; O[j] = (f32x4){0.f, 0.f, 0.f, 0.f}; }
        const int wlo = t0 - 511 > 0 ? ((t0 - 511) & ~63) : 0;
        for (int key0 = wlo; key0 <= tmax; key0 += 64) {
            unsigned vm = 0;
#pragma unroll
            for (int s = 0; s < 4; ++s) { const int kpos = key0 + s * 16 + fr; vm |= ((kpos <= trow && kpos > trow - 512) ? 1u : 0u) << s; }
            flash_tile(Qf, kwn + (size_t)(key0 + fr) * 128 + hk * 64 + fq * 8, 128, vwT + ((size_t)hk * 64 + fr) * T_ + key0 + fq * 8, T_, vm, m, l, O, Pt, fr, fq);
        }
        branch_finish(l, O, grow, 2, hk, Y);
#pragma unroll
        for (int dt = 0; dt < 4; ++dt)
#pragma unroll
            for (int j = 0; j < 4; ++j) yb[fq * 512 + (hk * 4 + j) * 64 + dt * 16 + fr] = Y[dt][j];
    }
    asm volatile("s_waitcnt lgkmcnt(0)" ::: "memory");
    bf16_t* mix = (bf16_t*)(ws + O_HN);
    const float* gn = p.in[12] + (size_t)layer * 512;
    for (int tok = 0; tok < 4; ++tok) {
        const f32x4 a = *(const f32x4*)(yb + tok * 512 + lane * 8), b = *(const f32x4*)(yb + tok * 512 + lane * 8 + 4);
        float ss = a[0] * a[0] + a[1] * a[1] + a[2] * a[2] + a[3] * a[3] + b[0] * b[0] + b[1] * b[1] + b[2] * b[2] + b[3] * b[3];
        ss = wave_sum(ss);
        const float rs = rsqrtf(ss * (1.0f / 512.0f) + 1e-6f);
        const f32x4 g0 = *(const f32x4*)(gn + lane * 8), g1 = *(const f32x4*)(gn + lane * 8 + 4);
        u32x4 w; w.x = pk2(a[0] * rs * g0[0], a[1] * rs * g0[1]); w.y = pk2(a[2] * rs * g0[2], a[3] * rs * g0[3]); w.z = pk2(b[0] * rs * g1[0], b[1] * rs * g1[1]); w.w = pk2(b[2] * rs * g1[2], b[3] * rs * g1[3]);
        *(u32x4*)(mix + (size_t)(t0 + tok) * DM + lane * 8) = w;
    }
    asm volatile("s_waitcnt lgkmcnt(0)" ::: "memory");
}

__device__ void phase_finalize(const Params& p, int layer) {
    unsigned char* ws = p.ws;
    const int wave = tidx() >> 6, lane = tidx() & 63;
    const float* yglu = (const float*)(ws + O_YGLU); const float* go = (const float*)(ws + O_PQKV); const bf16_t* Pz = (const bf16_t*)(ws + O_PZ); bf16_t* mix = (bf16_t*)(ws + O_HN);
    const float* gs = p.in[22] + (size_t)layer * 512 + lane * 8; const float* gg = p.in[26] + (size_t)layer * 128 + (lane & 7) * 16;
    for (int t = blockIdx.x * 8 + wave; t < T_; t += gridDim.x * 8) {
        {
            const f32x4 a = *(const f32x4*)(yglu + (size_t)t * 512 + lane * 8), b = *(const f32x4*)(yglu + (size_t)t * 512 + lane * 8 + 4);
            float ss = a[0] * a[0] + a[1] * a[1] + a[2] * a[2] + a[3] * a[3] + b[0] * b[0] + b[1] * b[1] + b[2] * b[2] + b[3] * b[3];
            ss = wave_sum(ss); const float rs = rsqrtf(ss * (1.0f / 512.0f) + 1e-6f);
            const f32x4 g0 = *(const f32x4*)gs, g1 = *(const f32x4*)(gs + 4);
            u32x4 w; w.x = pk2(a[0] * rs * g0[0], a[1] * rs * g0[1]); w.y = pk2(a[2] * rs * g0[2], a[3] * rs * g0[3]); w.z = pk2(b[0] * rs * g1[0], b[1] * rs * g1[1]); w.w = pk2(b[2] * rs * g1[2], b[3] * rs * g1[3]);
            *(u32x4*)(mix + (size_t)t * DM + 512 + lane * 8) = w;
        }
        {
            f32x4 o[4]; float ss = 0.f;
#pragma unroll
            for (int q = 0; q < 4; ++q) { o[q] = *(const f32x4*)(go + (size_t)t * 1024 + lane * 16 + q * 4); ss += o[q][0] * o[q][0] + o[q][1] * o[q][1] + o[q][2] * o[q][2] + o[q][3] * o[q][3]; }
            ss += __shfl_xor(ss, 1); ss += __shfl_xor(ss, 2); ss += __shfl_xor(ss, 4);
            const float rs = rsqrtf(ss * (1.0f / 128.0f) + 1e-6f);
            const u32x4 z0 = *(const u32x4*)(Pz + (size_t)t * 1024 + lane * 16), z1 = *(const u32x4*)(Pz + (size_t)t * 1024 + lane * 16 + 8);
            float zz[16] = {bflo(z0.x), bfhi(z0.x), bflo(z0.y), bfhi(z0.y), bflo(z0.z), bfhi(z0.z), bflo(z0.w), bfhi(z0.w), bflo(z1.x), bfhi(z1.x), bflo(z1.y), bfhi(z1.y), bflo(z1.z), bfhi(z1.z), bflo(z1.w), bfhi(z1.w)};
            float r[16];
#pragma unroll
            for (int q = 0; q < 4; ++q) { const f32x4 g = *(const f32x4*)(gg + q * 4);
#pragma unroll
                for (int e = 0; e < 4; ++e) r[q * 4 + e] = o[q][e] * rs * g[e] * siluf_(zz[q * 4 + e]); }
            u32x4 w0, w1; w0.x = pk2(r[0], r[1]); w0.y = pk2(r[2], r[3]); w0.z = pk2(r[4], r[5]); w0.w = pk2(r[6], r[7]); w1.x = pk2(r[8], r[9]); w1.y = pk2(r[10], r[11]); w1.z = pk2(r[12], r[13]); w1.w = pk2(r[14], r[15]);
            *(u32x4*)(mix + (size_t)t * DM + 1024 + lane * 16) = w0; *(u32x4*)(mix + (size_t)t * DM + 1024 + lane * 16 + 8) = w1;
        }
    }
}

__device__ void phase_ffn_act(const Params& p, int layer) {
    unsigned char* ws = p.ws;
    const bf16_t* hf = (const bf16_t*)(ws + O_HF); bf16_t* act = (bf16_t*)(ws + O_ACT);
    const float* cw = p.in[30] + (size_t)layer * 3 * NFF; const float* cb = p.in[31] + (size_t)layer * NFF;
    const int nitems = 512 * 688;
    for (int it = blockIdx.x * 512 + tidx(); it < nitems; it += gridDim.x * 512) {
        const int seg = it / 688, cg8 = it - seg * 688, c = cg8 * 8, t0 = seg * 32;
        float w[2][3][8], bb[2][8];
#pragma unroll
        for (int hh = 0; hh < 2; ++hh) {
#pragma unroll
            for (int j = 0; j < 3; ++j) { const f32x4 a = *(const f32x4*)(cw + j * NFF + hh * DFF + c), b = *(const f32x4*)(cw + j * NFF + hh * DFF + c + 4);
                w[hh][j][0] = a[0]; w[hh][j][1] = a[1]; w[hh][j][2] = a[2]; w[hh][j][3] = a[3]; w[hh][j][4] = b[0]; w[hh][j][5] = b[1]; w[hh][j][6] = b[2]; w[hh][j][7] = b[3]; }
            const f32x4 a = *(const f32x4*)(cb + hh * DFF + c), b = *(const f32x4*)(cb + hh * DFF + c + 4);
            bb[hh][0] = a[0]; bb[hh][1] = a[1]; bb[hh][2] = a[2]; bb[hh][3] = a[3]; bb[hh][4] = b[0]; bb[hh][5] = b[1]; bb[hh][6] = b[2]; bb[hh][7] = b[3];
        }
        u32x4 r0[2], r1[2];
#pragma unroll
        for (int hh = 0; hh < 2; ++hh) {
            r0[hh] = (t0 >= 2) ? *(const u32x4*)(hf + (size_t)(t0 - 2) * NFF + hh * DFF + c) : (u32x4){0u, 0u, 0u, 0u};
            r1[hh] = (t0 >= 1) ? *(const u32x4*)(hf + (size_t)(t0 - 1) * NFF + hh * DFF + c) : (u32x4){0u, 0u, 0u, 0u};
        }
        for (int tt = 0; tt < 32; ++tt) {
            const int t = t0 + tt;
            u32x4 r2[2]; float v[2][8];
#pragma unroll
            for (int hh = 0; hh < 2; ++hh) {
                r2[hh] = *(const u32x4*)(hf + (size_t)t * NFF + hh * DFF + c);
                const unsigned a0[4] = {r0[hh].x, r0[hh].y, r0[hh].z, r0[hh].w}, a1[4] = {r1[hh].x, r1[hh].y, r1[hh].z, r1[hh].w}, a2[4] = {r2[hh].x, r2[hh].y, r2[hh].z, r2[hh].w};
#pragma unroll
                for (int e = 0; e < 4; ++e) {
                    v[hh][2 * e]     = bb[hh][2 * e]     + w[hh][0][2 * e]     * bflo(a0[e]) + w[hh][1][2 * e]     * bflo(a1[e]) + w[hh][2][2 * e]     * bflo(a2[e]);
                    v[hh][2 * e + 1] = bb[hh][2 * e + 1] + w[hh][0][2 * e + 1] * bfhi(a0[e]) + w[hh][1][2 * e + 1] * bfhi(a1[e]) + w[hh][2][2 * e + 1] * bfhi(a2[e]);
                }
                r0[hh] = r1[hh]; r1[hh] = r2[hh];
            }
            u32x4 o; o.x = pk2(siluf_(v[0][0]) * v[1][0], siluf_(v[0][1]) * v[1][1]); o.y = pk2(siluf_(v[0][2]) * v[1][2], siluf_(v[0][3]) * v[1][3]);
            o.z = pk2(siluf_(v[0][4]) * v[1][4], siluf_(v[0][5]) * v[1][5]); o.w = pk2(siluf_(v[0][6]) * v[1][6], siluf_(v[0][7]) * v[1][7]);
            *(u32x4*)(act + (size_t)t * DFF + c) = o;
        }
    }
}
#ifdef REPEAT_PHASE
constexpr int NPHT = NPH + 1;
#else
constexpr int NPHT = NPH;
#endif
#ifndef MULTI_LAUNCH
#define MULTI_LAUNCH 0
#endif
__global__ void __launch_bounds__(512) mega(Params p) {
    extern __shared__ __attribute__((aligned(16))) unsigned char smem[];
    cg::grid_group grid = cg::this_grid();
    const int b = blockIdx.x, G = gridDim.x;
    PG8_LAS unsigned char* glds = (PG8_LAS unsigned char*)smem;
    for (int ph = p.ph_lo; ph < p.ph_hi; ++ph) {

        #ifdef REPEAT_PHASE
        const int layer = ph / (NPH + 1), ki = ph % (NPH + 1), rep = (ki == REPEAT_PHASE + 1) ? 1 : 0; int k = ki <= REPEAT_PHASE ? ki : ki - 1;
#else
        const int layer = ph / NPH, rep = 0; int k = ph % NPH;
#endif
#ifdef DBG_ONLY
        if (k != DBG_ONLY) k = 99;
#endif
        unsigned long long wsl = (unsigned long long)p.ws; asm volatile("" : "+s"(wsl));
        unsigned char* ws = (unsigned char*)wsl;
        int tid = threadIdx.x; asm volatile("" : "+v"(tid));
        const int wave = tid >> 6;
        bf16_t* hn = (bf16_t*)(ws + O_HN);
        Params q = p; q.ws = ws;
        if (k == 0) {
            if (ph == 0 && rep == 0 && b == 0 && tid < 64) ((unsigned*)(ws + O_CTR))[tid * 16] = 0u;
            phase_convert(q, layer, (float*)smem);
            phase_rmsnorm(layer == 0 ? p.in[0] : p.out, p.in[1] + (size_t)layer * DM, hn, layer == 0 ? p.out : nullptr);
        } else if (k == 1) {
            pg8::Gemm g{hn, (const bf16_t*)(ws + O_WIN), T_, NIN, DM}; pg8::StaticOrder S; S.init(T_, NIN, G, b);
            EpiProj E{(float*)(ws + O_P32), (bf16_t*)(ws + O_PU), (bf16_t*)(ws + O_PQKV), (bf16_t*)(ws + O_PZ)};
            pg8::gemm_phase<EpiProj, pg8::StaticOrder, false>(glds, g, S, E, nullptr);
        } else if (k == 2) {
            for (int it = b; it < 3072; it += G) {
                if (it < 2048) gdn_prep_item(q, layer, it, smem);
                else if (it < 2304) nsa_prep_item(q, layer, it - 2048, (float*)smem);
                else if (it < 2560) s5_passA_wave(q, layer, (it - 2304) * 8 + wave);
                else cmp1_wave_tile(q, layer, (it - 2560) * 8 + wave);
            }
        } else if (k == 3) {
            for (int idx = b * 8 + wave; idx < 4096; idx += G * 8) cmp2_wave_row(q, layer, idx);
            for (int it = b * 8 + wave; it < 2048; it += G * 8) s5_passB_wave(q, layer, it, (bf16_t*)(smem + wave * 4352));
        } else if (k == 4) {
            if (b < 32) gdn_recurrence(q, b, smem);
            else if (b < 160) {
                pg8::Gemm g{(const bf16_t*)(ws + O_YGELU), (const bf16_t*)(ws + O_WGLU), T_, 512, 512}; pg8::StaticOrder S; S.init(T_, 512, 128, b - 32);
                EpiGlu E{(const bf16_t*)(ws + O_YGELU), (float*)(ws + O_YGLU)};
                pg8::gemm_phase<EpiGlu, pg8::StaticOrder, false>(glds, g, S, E, nullptr);
            }
            __syncthreads();
            unsigned* ctr = (unsigned*)(ws + O_CTR) + (layer * 2 + rep) * 16;
            volatile int* sidx = (volatile int*)(smem + LDS_BYTES - 16);
            for (;;) {
                if (tid == 0) *sidx = (int)atomicAdd(ctr, 1u);
                __syncthreads();
                const int idx = *sidx;
                __syncthreads();
                if (idx >= 512) break;
                nsa_wave_task(q, layer, (511 - idx) * 32 + wave * 4, smem + wave * NSA_WLDS);
            }
        } else if (k == 5) {
            phase_finalize(q, layer);
        } else if (k == 6) {
            pg8::Gemm g{hn, (const bf16_t*)(ws + O_WOUT), T_, DM, DM}; pg8::StaticOrder S; S.init(T_, DM, G, b);
            EpiResid E{p.out, DM};
            pg8::gemm_phase<EpiResid, pg8::StaticOrder, false>(glds, g, S, E, nullptr);
        } else if (k == 7) {
            phase_rmsnorm(p.out, p.in[28] + (size_t)layer * DM, hn, nullptr);
        } else if (k == 8) {
            pg8::Gemm g{hn, (const bf16_t*)(ws + O_WFIN), T_, NFF, DM}; pg8::StaticOrder S; S.init(T_, NFF, G, b);
            EpiBf E{(bf16_t*)(ws + O_HF), NFF};
            pg8::gemm_phase<EpiBf, pg8::StaticOrder, false>(glds, g, S, E, nullptr);
        } else if (k == 9) {
            phase_ffn_act(q, layer);
        } else if (k == 10) {
            pg8::Gemm g{(const bf16_t*)(ws + O_ACT), (const bf16_t*)(ws + O_WFOUT), T_, DM, DFF}; pg8::StaticOrder S; S.init(T_, DM, G, b);
            EpiResid E{p.out, DM};
            pg8::gemm_phase<EpiResid, pg8::StaticOrder, false>(glds, g, S, E, nullptr);
        }
        __syncthreads();
        if (ph + 1 < p.ph_hi) grid.sync();
    }
}

extern "C" void kernel_launch(void* const* d_in, const int* in_sizes, int n_in, void* d_out, int out_size, void* d_ws, size_t ws_size, hipStream_t stream) {
    static int grid_blocks = 0;
    if (!grid_blocks) {
        if (n_in != 33 || out_size != T_ * DM || ws_size < WS_NEED) { fprintf(stderr, "kernel_launch: unexpected shapes or workspace (%d inputs, out %d, ws %zu < %zu)\n", n_in, out_size, ws_size, (size_t)WS_NEED); grid_blocks = -1; return; }
        int dev = 0, cus = 0, per_cu = 0;
        hipGetDevice(&dev);
        hipDeviceGetAttribute(&cus, hipDeviceAttributeMultiprocessorCount, dev);
        if (hipFuncSetAttribute((const void*)mega, hipFuncAttributeMaxDynamicSharedMemorySize, LDS_BYTES) != hipSuccess) { fprintf(stderr, "kernel_launch: hipFuncSetAttribute failed\n"); grid_blocks = -1; return; }
        hipOccupancyMaxActiveBlocksPerMultiprocessor(&per_cu, (const void*)mega, 512, LDS_BYTES);
        (void)hipGetLastError();
        if (per_cu < 1) per_cu = 1;
        grid_blocks = cus * per_cu; if (grid_blocks > 256) grid_blocks = 256;
        if (grid_blocks < 160) { fprintf(stderr, "kernel_launch: grid %d too small\n", grid_blocks); grid_blocks = -1; return; }
    }
    if (grid_blocks < 0) return;
    Params p{};
    for (int i = 0; i < 33; ++i) p.in[i] = (const float*)d_in[i];
    p.out = (float*)d_out; p.ws = (unsigned char*)d_ws;
#if MULTI_LAUNCH
    for (int ph = 0; ph < 2 * NPHT; ++ph) { p.ph_lo = ph; p.ph_hi = ph + 1; hipLaunchKernelGGL(mega, dim3(grid_blocks), dim3(512), LDS_BYTES, stream, p); }
#else
    p.ph_lo = 0; p.ph_hi = 2 * NPHT;
    void* args[] = {&p};
    hipError_t e = hipLaunchCooperativeKernel((const void*)mega, dim3(grid_blocks), dim3(512), args, LDS_BYTES, stream);
    if (e != hipSuccess) fprintf(stderr, "cooperative launch failed: %s (grid %d)\n", hipGetErrorString(e), grid_blocks);
#endif
}
```

```cpp
#include <hip/hip_runtime.h>
#include <hip/hip_cooperative_groups.h>
#include <cstdio>
namespace cg = cooperative_groups;
__device__ __forceinline__ int tidx() { int t = threadIdx.x; asm volatile("" : "+v"(t)); return t; }
namespace pg8 {
#define PG8_LAS __attribute__((address_space(3)))
typedef unsigned short bf16_t;
typedef short bf16x8 __attribute__((ext_vector_type(8)));
typedef float f32x4 __attribute__((ext_vector_type(4)));
typedef unsigned u32x4 __attribute__((ext_vector_type(4)));
constexpr int BM = 256, BK = 64, HALF = 128, HTB = HALF * BK * 2  , STAGE_BYTES = 8 * HTB, NXCD = 8, WGM = 8;

__host__ __device__ __forceinline__ int lds_byte(int r, int c) { const int st = (r >> 4) * 2 + (c >> 5), rr = r & 15, cc = c & 31, ob = rr * 64 + cc * 2; return st * 1024 + (ob ^ (((ob >> 9) & 1) << 5)); }
__host__ __device__ __forceinline__ void stage_rc(int b, int& R, int& C) { const int st = b / 1024, sb = b % 1024, swz = sb ^ (((sb >> 9) & 1) << 5); R = (st >> 1) * 16 + swz / 64; C = (st & 1) * 32 + (swz % 64) / 2; }
__host__ __device__ __forceinline__ int perm32(int rho) { const int n = rho >> 4, i = rho & 15; return 8 * (i >> 2) + 4 * n + (i & 3); }

struct Unit { int pm, pn; };
struct Gemm { const bf16_t* A; const bf16_t* Bt; int M, N, K; };

struct StaticOrder {
    int nM, nN, nwg, G, c;
    __host__ __device__ void init(int M, int N, int G_, int c_) { nM = M / BM; nN = N / BM; nwg = nM * nN; G = G_; c = c_; }
    __host__ __device__ bool next(int i, Unit& u) const {
        const long L = (long)i * G + c; if (L >= nwg) return false;
        int wgid = (int)L; { const int q = nwg / NXCD, r = nwg % NXCD, xcd = wgid % NXCD, off = wgid / NXCD; wgid = (xcd < r ? xcd * (q + 1) : r * (q + 1) + (xcd - r) * q) + off; }
        const int nig = WGM * nN, gid = wgid / nig, fm = gid * WGM, gsz = (nM - fm) < WGM ? (nM - fm) : WGM;
        u.pm = fm + ((wgid % nig) % gsz); u.pn = (wgid % nig) / gsz; return true;
    }
    __device__ __forceinline__ void a_ready(const Unit&) const {}
    __device__ __forceinline__ void done(const Unit&) const {}
};
__device__ __forceinline__ unsigned cvt_pk_bf16(float lo, float hi) { unsigned r; asm volatile("v_cvt_pk_bf16_f32 %0, %1, %2" : "=v"(r) : "v"(lo), "v"(hi)); return r; }
template <class Epi, class Sched, bool STAMP = false>
__device__ __forceinline__ void gemm_phase(PG8_LAS unsigned char* lds, const Gemm g, const Sched& S, const Epi& E, unsigned long long* stamps) {
    const int tid = tidx(), wid = __builtin_amdgcn_readfirstlane(tid >> 6), lane = tid & 63, wr = wid >> 2, wc = wid & 3, fr = lane & 15, fq = lane >> 4;
    const int K = g.K, nt = K / BK;
    int ts_lo = 0, ts_hi = 0, nts = 0; const unsigned long long rt_entry = STAMP ? (unsigned long long)wall_clock64() : 0ull;
#define PG8_STAMP() do { if (STAMP && wid == 0 && nts < 64) { const unsigned long long _c = (unsigned long long)clock64(); \
        ts_lo = (lane == nts) ? (int)(unsigned)_c : ts_lo; ts_hi = (lane == nts) ? (int)(unsigned)(_c >> 32) : ts_hi; ++nts; } } while (0)
    PG8_STAMP();
    unsigned voffA[2], voffB[2];
#pragma unroll
    for (int i = 0; i < 2; ++i) { int R, C; stage_rc(tid * 16 + i * 8192, R, C); const int Rb = Epi::PERM ? ((R & ~31) + perm32(R & 31)) : R;
        voffA[i] = (unsigned)(R * K + C) * 2u; voffB[i] = (unsigned)(Rb * K + C) * 2u; }
    const size_t kstep = (size_t)(BK * 2);
    const size_t hstep = (size_t)HALF * K * 2;
    const size_t tstep = 2 * hstep;
    const unsigned ldsw = (unsigned)wid * 1024u;
    const int aoff = lds_byte(wr * 64 + fr, fq * 8), boff = lds_byte(wc * 32 + fr, fq * 8);
#define PG8_SA(b, h) (((b) * 2 + (h)) * HTB)
#define PG8_SB(b, h) ((4 + (b) * 2 + (h)) * HTB)
#define PG8_STAGE(bufoff, gbase, voff) do { _Pragma("unroll") for (int _i = 0; _i < 2; ++_i) \
        __builtin_amdgcn_global_load_lds((const unsigned*)((const char*)(gbase) + (voff)[_i]), (PG8_LAS unsigned*)(lds + (bufoff) + ldsw + _i * 8192), 16, 0, 0); } while (0)
#define PG8_LDA(dst, b, h) do { _Pragma("unroll") for (int m = 0; m < 4; ++m) _Pragma("unroll") for (int k = 0; k < 2; ++k) dst[m][k] = *(const PG8_LAS bf16x8*)(lds + PG8_SA(b, h) + aoff + m * 2048 + k * 1024); } while (0)
#define PG8_LDB(dst, b, h) do { _Pragma("unroll") for (int n = 0; n < 2; ++n) _Pragma("unroll") for (int k = 0; k < 2; ++k) dst[n][k] = *(const PG8_LAS bf16x8*)(lds + PG8_SB(b, h) + boff + n * 2048 + k * 1024); } while (0)
#define PG8_MMA(ai, bj, At, Bt) do { __builtin_amdgcn_s_setprio(1); _Pragma("unroll") for (int m = 0; m < 4; ++m) _Pragma("unroll") for (int n = 0; n < 2; ++n) _Pragma("unroll") for (int k = 0; k < 2; ++k) \
        acc[ai][bj][m][n] = __builtin_amdgcn_mfma_f32_16x16x32_bf16(Bt[n][k], At[m][k], acc[ai][bj][m][n], 0, 0, 0); __builtin_amdgcn_s_setprio(0); } while (0)
#define PG8_WAIT_V(n) asm volatile("s_waitcnt vmcnt(" #n ")" ::: "memory")
#define PG8_WAIT_L(n) asm volatile("s_waitcnt lgkmcnt(" #n ")" ::: "memory")
#define PG8_BAR __builtin_amdgcn_s_barrier()
#define PG8_SCHED __builtin_amdgcn_sched_barrier(0)
    Unit cur, nxt; int ui = 0;
    if (!S.next(0, cur)) return;
    f32x4 acc[2][2][4][2];
#pragma unroll
    for (int a = 0; a < 2; ++a)
#pragma unroll
        for (int b = 0; b < 2; ++b)
#pragma unroll
            for (int m = 0; m < 4; ++m)
#pragma unroll
                for (int n = 0; n < 2; ++n) acc[a][b][m][n] = (f32x4){0.f, 0.f, 0.f, 0.f};
    bf16x8 At[4][2], B0[2][2], B1[2][2];
    const char* cA = (const char*)g.A + (size_t)cur.pm * tstep; const char* cB = (const char*)g.Bt + (size_t)cur.pn * tstep;
    S.a_ready(cur);
    PG8_STAGE(PG8_SB(0, 0), cB, voffB); PG8_STAGE(PG8_SA(0, 0), cA, voffA); PG8_STAGE(PG8_SB(0, 1), cB + hstep, voffB); PG8_STAGE(PG8_SA(0, 1), cA + hstep, voffA);
    if (wr == 1) PG8_BAR;
    PG8_WAIT_V(4); PG8_BAR;
    PG8_STAGE(PG8_SB(1, 0), cB + kstep, voffB); PG8_STAGE(PG8_SA(1, 0), cA + kstep, voffA); PG8_STAGE(PG8_SB(1, 1), cB + hstep + kstep, voffB);
    PG8_WAIT_V(6); PG8_BAR;
    PG8_STAMP();
    for (;;) {
        const bool has_next = S.next(ui + 1, nxt);
        const char* nA = has_next ? (const char*)g.A + (size_t)nxt.pm * tstep : cA; const char* nB = has_next ? (const char*)g.Bt + (size_t)nxt.pn * tstep : cB;
        for (int t = 0; t < nt; t += 2) {
            const bool last = (t == nt - 2);
            const char* a1 = cA + (size_t)(t + 1) * kstep;
            const char* a2 = last ? nA : cA + (size_t)(t + 2) * kstep; const char* b2 = last ? nB : cB + (size_t)(t + 2) * kstep;
            const char* a3 = a2 + kstep; const char* b3 = b2 + kstep;
            if (last && has_next) S.a_ready(nxt);
            PG8_LDB(B0, 0, 0); PG8_SCHED; PG8_LDA(At, 0, 0); PG8_STAGE(PG8_SA(1, 1), a1 + hstep, voffA);
            PG8_WAIT_L(8); PG8_BAR; PG8_WAIT_L(0); PG8_MMA(0, 0, At, B0); PG8_BAR; PG8_SCHED;
            PG8_LDB(B1, 0, 1); PG8_STAGE(PG8_SB(0, 0), b2, voffB);
            PG8_BAR; PG8_WAIT_L(0); PG8_MMA(0, 1, At, B1); PG8_BAR;
            PG8_LDA(At, 0, 1); PG8_STAGE(PG8_SA(0, 0), a2, voffA);
            PG8_BAR; PG8_WAIT_L(0); PG8_MMA(1, 0, At, B0); PG8_BAR; PG8_SCHED;
            PG8_STAGE(PG8_SB(0, 1), b2 + hstep, voffB);
            PG8_WAIT_V(6); PG8_BAR; PG8_MMA(1, 1, At, B1); PG8_BAR;
            PG8_LDB(B0, 1, 0); PG8_SCHED; PG8_LDA(At, 1, 0); PG8_STAGE(PG8_SA(0, 1), a2 + hstep, voffA);
            PG8_WAIT_L(8); PG8_BAR; PG8_WAIT_L(0); PG8_MMA(0, 0, At, B0); PG8_BAR; PG8_SCHED;
            PG8_LDB(B1, 1, 1); PG8_STAGE(PG8_SB(1, 0), b3, voffB);
            PG8_BAR; PG8_WAIT_L(0); PG8_MMA(0, 1, At, B1); PG8_BAR;
            PG8_LDA(At, 1, 1); PG8_STAGE(PG8_SA(1, 0), a3, voffA);
            PG8_BAR; PG8_WAIT_L(0); PG8_MMA(1, 0, At, B0); PG8_BAR; PG8_SCHED;
            PG8_STAGE(PG8_SB(1, 1), b3 + hstep, voffB);
            PG8_WAIT_V(6); PG8_BAR; PG8_MMA(1, 1, At, B1); PG8_BAR;
        }
        PG8_STAMP();
        if constexpr (!Epi::AFTER_DRAIN) { E(acc, cur, wr, wc, fr, fq); S.done(cur); }
        PG8_STAMP();
        if (!has_next) break;
#pragma unroll
        for (int a = 0; a < 2; ++a)
#pragma unroll
            for (int b = 0; b < 2; ++b)
#pragma unroll
                for (int m = 0; m < 4; ++m)
#pragma unroll
                    for (int n = 0; n < 2; ++n) acc[a][b][m][n] = (f32x4){0.f, 0.f, 0.f, 0.f};
        cur = nxt; cA = nA; cB = nB; ++ui;
    }
    PG8_WAIT_V(0);
    if (wr == 0) PG8_BAR;
    PG8_BAR;
    if constexpr (Epi::AFTER_DRAIN) { E.fused(acc, cur, wr, wc, fr, fq, lds, wid, lane); S.done(cur); }
    PG8_STAMP();
    if (STAMP && wid == 0) { stamps[lane] = lane < nts ? (((unsigned long long)(unsigned)ts_hi << 32) | (unsigned)ts_lo) : 0ull;
        if (lane == 62) stamps[62] = rt_entry; if (lane == 63) stamps[63] = (unsigned long long)wall_clock64(); }
#undef PG8_STAMP
#undef PG8_SA
#undef PG8_SB
#undef PG8_STAGE
#undef PG8_LDA
#undef PG8_LDB
#undef PG8_MMA
#undef PG8_WAIT_V
#undef PG8_WAIT_L
#undef PG8_BAR
#undef PG8_SCHED
}
}
using pg8::bf16_t; using pg8::bf16x8; using pg8::f32x4; using pg8::u32x4; using pg8::Unit;
typedef unsigned u32x2 __attribute__((ext_vector_type(2)));
#define MFMA16(a, b, c) __builtin_amdgcn_mfma_f32_16x16x32_bf16((a), (b), (c), 0, 0, 0)

constexpr int T_ = 16384, DM = 2048, NIN = 6144, DFF = 5504, NFF = 11008;
constexpr int LDS_BYTES = 144 * 1024;
constexpr int NPH = 11;

constexpr size_t O_CTR   = 0;
constexpr size_t O_WIN   = 4096;
constexpr size_t O_WOUT  = O_WIN   + (size_t)NIN * DM * 2;
constexpr size_t O_WFIN  = O_WOUT  + (size_t)DM * DM * 2;
constexpr size_t O_WFOUT = O_WFIN  + (size_t)NFF * DM * 2;
constexpr size_t O_WCK   = O_WFOUT + (size_t)DM * DFF * 2;
constexpr size_t O_WCV   = O_WCK   + (size_t)256 * 2048 * 2;
constexpr size_t O_WGLU  = O_WCV   + (size_t)256 * 2048 * 2;
constexpr size_t O_HN    = O_WGLU  + (size_t)512 * 512 * 2;
constexpr size_t O_R     = O_HN    + (size_t)T_ * DM * 2;
constexpr size_t O_P32   = O_R;
constexpr size_t O_PU    = O_P32   + (size_t)T_ * 1536 * 4;
constexpr size_t O_PQKV  = O_PU    + (size_t)T_ * 512 * 2;
constexpr size_t O_PZ    = O_PQKV  + (size_t)T_ * 3072 * 2;
constexpr size_t O_QN    = O_PZ    + (size_t)T_ * 1024 * 2;
constexpr size_t O_KSN   = O_QN    + (size_t)T_ * 512 * 2;
constexpr size_t O_KWN   = O_KSN   + (size_t)T_ * 128 * 2;
constexpr size_t O_VST   = O_KWN   + (size_t)T_ * 128 * 2;
constexpr size_t O_VWT   = O_VST   + (size_t)T_ * 128 * 2;
constexpr size_t O_KC    = O_VWT   + (size_t)T_ * 128 * 2;
constexpr size_t O_VCT   = O_KC    + (size_t)2 * 1024 * 64 * 2;
constexpr size_t O_HCMP  = O_VCT   + (size_t)2 * 64 * 1024 * 2;
constexpr size_t O_GKC   = O_HCMP  + (size_t)2 * 2048 * 256 * 4;
constexpr size_t O_GQG   = O_GKC   + (size_t)2048 * 64 * 128 * 2;
constexpr size_t O_GQK   = O_GQG   + (size_t)2048 * 64 * 128 * 2;
constexpr size_t O_GKD   = O_GQK   + (size_t)2048 * 64 * 64 * 2;
constexpr size_t O_GVAL  = O_GKD   + (size_t)2048 * 64 * 128 * 2;
constexpr size_t O_GEGL  = O_GVAL  + (size_t)2048 * 64 * 128 * 4;
constexpr size_t O_XEND  = O_GEGL  + 8192;
constexpr size_t O_YGELU = O_XEND  + (size_t)64 * 32 * 64 * 2 * 4;
constexpr size_t O_YGLU  = O_YGELU + (size_t)T_ * 512 * 2;
constexpr size_t O_ATT_END = O_YGLU + (size_t)T_ * 512 * 4;
constexpr size_t O_HF    = O_R;
constexpr size_t O_ACT   = O_HF    + (size_t)T_ * NFF * 2;
constexpr size_t O_FFN_END = O_ACT + (size_t)T_ * DFF * 2;
constexpr size_t WS_NEED = O_ATT_END > O_FFN_END ? O_ATT_END : O_FFN_END;

struct Params { const float* in[33]; float* out; unsigned char* ws; int ph_lo, ph_hi; };

__device__ __forceinline__ unsigned short f2bf(float f) { unsigned u = __float_as_uint(f); u += 0x7FFFu + ((u >> 16) & 1u); return (unsigned short)(u >> 16); }
__device__ __forceinline__ float bf2f(unsigned short b) { return __uint_as_float(((unsigned)b) << 16); }
__device__ __forceinline__ unsigned pk2(float lo, float hi) { return pg8::cvt_pk_bf16(lo, hi); }
__device__ __forceinline__ float bflo(unsigned w) { return __uint_as_float(w << 16); }
__device__ __forceinline__ float bfhi(unsigned w) { return __uint_as_float(w & 0xFFFF0000u); }
__device__ __forceinline__ float sigmoidf_(float x) { return __builtin_amdgcn_rcpf(1.0f + __expf(-x)); }
__device__ __forceinline__ float siluf_(float x) { return x * __builtin_amdgcn_rcpf(1.0f + __expf(-x)); }
__device__ __forceinline__ float vmaxf(float a, float b) { float r; asm("v_max_f32 %0, %1, %2" : "=v"(r) : "v"(a), "v"(b)); return r; }
__device__ __forceinline__ float gelu_tanh(float x) { const float u = 0.7978845608028654f * (x + 0.044715f * x * x * x); const float th = 1.0f - 2.0f * __builtin_amdgcn_rcpf(__expf(2.0f * u) + 1.0f); return 0.5f * x * (1.0f + th); }
__device__ __forceinline__ float softplusf_(float x) { return x > 20.f ? x : log1pf(expf(x)); }
__device__ __forceinline__ float wave_sum(float v) { for (int o = 32; o >= 1; o >>= 1) v += __shfl_xor(v, o); return v; }
__device__ __forceinline__ bf16x8 pack8f(f32x4 a, f32x4 b) { u32x4 w; w.x = pk2(a[0], a[1]); w.y = pk2(a[2], a[3]); w.z = pk2(b[0], b[1]); w.w = pk2(b[2], b[3]); return __builtin_bit_cast(bf16x8, w); }
__device__ __forceinline__ float rdlane(float v, int l) { return __int_as_float(__builtin_amdgcn_readlane(__float_as_int(v), l)); }

struct EpiProj {
    static constexpr bool PERM = false, AFTER_DRAIN = false;
    float* P32; bf16_t* Pu; bf16_t* Pqkv; bf16_t* Pz;
    static __device__ __forceinline__ void st_bf(const f32x4 (&acc)[2][2][4][2], bf16_t* base, int ld) {
#pragma unroll
        for (int ai = 0; ai < 2; ++ai)
#pragma unroll
            for (int m = 0; m < 4; ++m) { bf16_t* rp = base + (size_t)(ai * 128 + m * 16) * ld;
#pragma unroll
                for (int bj = 0; bj < 2; ++bj)
#pragma unroll
                    for (int n = 0; n < 2; ++n) { const f32x4 v = acc[ai][bj][m][n]; u32x2 w; w.x = pk2(v[0], v[1]); w.y = pk2(v[2], v[3]); *(u32x2*)(rp + bj * 128 + n * 16) = w; } }
    }
    __device__ __forceinline__ void operator()(const f32x4 (&acc)[2][2][4][2], const Unit& u, int wr, int wc, int fr, int fq) const {
        const int row0 = u.pm * 256 + wr * 64 + fr, colt = wc * 32 + 4 * fq;
        if (u.pn < 6) {
            float* base = P32 + (size_t)row0 * 1536 + u.pn * 256 + colt;
#pragma unroll
            for (int ai = 0; ai < 2; ++ai)
#pragma unroll
                for (int m = 0; m < 4; ++m) { float* rp = base + (size_t)(ai * 128 + m * 16) * 1536;
#pragma unroll
                    for (int bj = 0; bj < 2; ++bj)
#pragma unroll
                        for (int n = 0; n < 2; ++n) *(f32x4*)(rp + bj * 128 + n * 16) = acc[ai][bj][m][n]; }
        } else if (u.pn < 8)  st_bf(acc, Pu   + (size_t)row0 * 512  + (u.pn - 6)  * 256 + colt, 512);
        else if (u.pn < 20)   st_bf(acc, Pqkv + (size_t)row0 * 3072 + (u.pn - 8)  * 256 + colt, 3072);
        else                  st_bf(acc, Pz   + (size_t)row0 * 1024 + (u.pn - 20) * 256 + colt, 1024);
    }
};
struct EpiResid {
    static constexpr bool PERM = false, AFTER_DRAIN = false;
    float* X; int ld;
    __device__ __forceinline__ void operator()(const f32x4 (&acc)[2][2][4][2], const Unit& u, int wr, int wc, int fr, int fq) const {
        float* base = X + (size_t)(u.pm * 256 + wr * 64 + fr) * ld + u.pn * 256 + wc * 32 + 4 * fq;
#pragma unroll
        for (int ai = 0; ai < 2; ++ai)
#pragma unroll
            for (int m = 0; m < 4; ++m) { float* rp = base + (size_t)(ai * 128 + m * 16) * ld;
#pragma unroll
                for (int bj = 0; bj < 2; ++bj)
#pragma unroll
                    for (int n = 0; n < 2; ++n) { f32x4* q = (f32x4*)(rp + bj * 128 + n * 16); *q = *q + acc[ai][bj][m][n]; } }
    }
};
struct EpiBf {
    static constexpr bool PERM = false, AFTER_DRAIN = false;
    bf16_t* O; int ld;
    __device__ __forceinline__ void operator()(const f32x4 (&acc)[2][2][4][2], const Unit& u, int wr, int wc, int fr, int fq) const {
        bf16_t* base = O + (size_t)(u.pm * 256 + wr * 64 + fr) * ld + u.pn * 256 + wc * 32 + 4 * fq;
#pragma unroll
        for (int ai = 0; ai < 2; ++ai)
#pragma unroll
            for (int m = 0; m < 4; ++m) { bf16_t* rp = base + (size_t)(ai * 128 + m * 16) * ld;
#pragma unroll
                for (int bj = 0; bj < 2; ++bj)
#pragma unroll
                    for (int n = 0; n < 2; ++n) { const f32x4 v = acc[ai][bj][m][n]; u32x2 w; w.x = pk2(v[0], v[1]); w.y = pk2(v[2], v[3]); *(u32x2*)(rp + bj * 128 + n * 16) = w; } }
    }
};
struct EpiGlu {
    static constexpr bool PERM = false, AFTER_DRAIN = false;
    const bf16_t* Y; float* O;
    __device__ __forceinline__ void operator()(const f32x4 (&acc)[2][2][4][2], const Unit& u, int wr, int wc, int fr, int fq) const {
        const size_t off0 = (size_t)(u.pm * 256 + wr * 64 + fr) * 512 + u.pn * 256 + wc * 32 + 4 * fq;
#pragma unroll
        for (int ai = 0; ai < 2; ++ai)
#pragma unroll
            for (int m = 0; m < 4; ++m) { const size_t ro = off0 + (size_t)(ai * 128 + m * 16) * 512;
#pragma unroll
                for (int bj = 0; bj < 2; ++bj)
#pragma unroll
                    for (int n = 0; n < 2; ++n) { const size_t o = ro + bj * 128 + n * 16; const u32x2 yw = *(const u32x2*)(Y + o); const f32x4 a = acc[ai][bj][m][n];
                        f32x4 r; r[0] = bflo(yw.x) * sigmoidf_(a[0]); r[1] = bfhi(yw.x) * sigmoidf_(a[1]); r[2] = bflo(yw.y) * sigmoidf_(a[2]); r[3] = bfhi(yw.y) * sigmoidf_(a[3]); *(f32x4*)(O + o) = r; } }
    }
};
__device__ __forceinline__ int map_in_col(int n) { return n < 1304 ? n : (n < 1312 ? 5912 + (n - 1304) : (n < 1320 ? 5920 + (n - 1312) : (n < 1536 ? -1 : 1304 + (n - 1536)))); }
__device__ void convT_tile(const float* __restrict__ src, int srcN, int K, bf16_t* __restrict__ dst, int tile, bool inmap, float* sm) {
    const int nk = K >> 6, tk = tile % nk, tn = tile / nk, k0 = tk * 64, n0 = tn * 64;
    const int tx = tidx() & 63, ty = tidx() >> 6;
    const int n = n0 + tx, sc = inmap ? map_in_col(n) : n;
#pragma unroll
    for (int i = 0; i < 8; ++i) { const int k = ty + 8 * i; sm[k * 65 + tx] = (sc >= 0) ? src[(size_t)(k0 + k) * srcN + sc] : 0.f; }
    __syncthreads();
#pragma unroll
    for (int i = 0; i < 8; ++i) { const int nn = ty + 8 * i; dst[(size_t)(n0 + nn) * K + k0 + tx] = f2bf(sm[tx * 65 + nn]); }
    __syncthreads();
}
__device__ void phase_convert(const Params& p, int layer, float* sm) {
    unsigned char* ws = p.ws;
    const int G = gridDim.x, b = blockIdx.x;
    const int n0 = 32 * 96, n1 = n0 + 32 * 32, n2 = n1 + 32 * 172, n3 = n2 + 86 * 32, n4 = n3 + 128, n5 = n4 + 128, n6 = n5 + 64;
    for (int it = b; it < n6; it += G) {
        if (it < n0)      convT_tile(p.in[2]  + (size_t)layer * DM * 5928, 5928, DM, (bf16_t*)(ws + O_WIN), it, true, sm);
        else if (it < n1) convT_tile(p.in[27] + (size_t)layer * DM * DM, DM, DM, (bf16_t*)(ws + O_WOUT), it - n0, false, sm);
        else if (it < n2) convT_tile(p.in[29] + (size_t)layer * DM * NFF, NFF, DM, (bf16_t*)(ws + O_WFIN), it - n1, false, sm);
        else if (it < n3) convT_tile(p.in[32] + (size_t)layer * DFF * DM, DM, DFF, (bf16_t*)(ws + O_WFOUT), it - n2, false, sm);
        else if (it < n4) convT_tile(p.in[8]  + (size_t)layer * 2048 * 256, 256, 2048, (bf16_t*)(ws + O_WCK), it - n3, false, sm);
        else if (it < n5) convT_tile(p.in[10] + (size_t)layer * 2048 * 256, 256, 2048, (bf16_t*)(ws + O_WCV), it - n4, false, sm);
        else              convT_tile(p.in[21] + (size_t)layer * 512 * 512, 512, 512, (bf16_t*)(ws + O_WGLU), it - n5, false, sm);
    }
}
__device__ void phase_rmsnorm(const float* __restrict__ x, const float* __restrict__ gain, bf16_t* __restrict__ hn, float* __restrict__ xcopy) {
    const int wave = tidx() >> 6, lane = tidx() & 63;
    for (int r = blockIdx.x * 8 + wave; r < T_; r += gridDim.x * 8) {
        const f32x4* xr = (const f32x4*)(x + (size_t)r * DM);
        f32x4 v[8]; float ss = 0.f;
#pragma unroll
        for (int i = 0; i < 8; ++i) { v[i] = xr[lane + 64 * i]; ss += v[i][0] * v[i][0] + v[i][1] * v[i][1] + v[i][2] * v[i][2] + v[i][3] * v[i][3]; }
        ss = wave_sum(ss);
        const float rs = rsqrtf(ss * (1.0f / DM) + 1e-6f);
#pragma unroll
        for (int i = 0; i < 8; ++i) { const f32x4 g = ((const f32x4*)gain)[lane + 64 * i]; u32x2 w; w.x = pk2(v[i][0] * rs * g[0], v[i][1] * rs * g[1]); w.y = pk2(v[i][2] * rs * g[2], v[i][3] * rs * g[3]);
            *(u32x2*)(hn + (size_t)r * DM + (lane + 64 * i) * 4) = w; if (xcopy) ((f32x4*)(xcopy + (size_t)r * DM))[lane + 64 * i] = v[i]; }
    }
}

__device__ void nsa_prep_item(const Params& p, int layer, int item, float* sm) {
    unsigned char* ws = p.ws;
    const float* P32 = (const float*)(ws + O_P32);
    bf16_t* qn = (bf16_t*)(ws + O_QN); bf16_t* ksn = (bf16_t*)(ws + O_KSN); bf16_t* kwn = (bf16_t*)(ws + O_KWN);
    const int wave = tidx() >> 6, lane = tidx() & 63, tid = tidx();
    const int t0 = item * 64;
    const float gq = p.in[3][layer * 64 + lane], gks = p.in[5][layer * 64 + lane], gkw = p.in[6][layer * 64 + lane];
    const float inv = powf(500000.0f, -(float)(lane & 7) * 0.125f);
    for (int tt = 0; tt < 8; ++tt) {
        const int t = t0 + wave * 8 + tt;
        float sn, cs; sincosf((float)t * inv, &sn, &cs);
        const float* row = P32 + (size_t)t * 1536;
#pragma unroll
        for (int hv = 0; hv < 12; ++hv) {
            const int col = hv < 8 ? hv * 64 : (hv < 10 ? 768 + (hv - 8) * 64 : 1024 + (hv - 10) * 64);
            const float g = hv < 8 ? gq : (hv < 10 ? gks : gkw);
            const float x = row[col + lane];
            const float ss = wave_sum(x * x);
            float y = x * rsqrtf(ss * (1.0f / 64.0f) + 1e-6f) * g;
            const float yp = __shfl(y, lane ^ 8);
            if (lane < 8) y = y * cs - yp * sn; else if (lane < 16) y = y * cs + yp * sn;
            if (hv < 8) qn[(size_t)t * 512 + hv * 64 + lane] = f2bf(y * 0.18033688011112042f);
            else if (hv < 10) ksn[(size_t)t * 128 + (hv - 8) * 64 + lane] = f2bf(y);
            else kwn[(size_t)t * 128 + (hv - 10) * 64 + lane] = f2bf(y);
        }
    }
    for (int e = tid; e < 64 * 256; e += 512) { const int tk = e >> 8, c = e & 255; sm[tk * 257 + c] = P32[(size_t)(t0 + tk) * 1536 + (c < 128 ? 896 + c : 1152 + (c - 128))]; }
    __syncthreads();
    bf16_t* vsT = (bf16_t*)(ws + O_VST); bf16_t* vwT = (bf16_t*)(ws + O_VWT);
#pragma unroll
    for (int i = 0; i < 4; ++i) {
        const int rowid = (tid >> 3) + 64 * i, ts = tid & 7;
        u32x4 w; float f[8];
#pragma unroll
        for (int k = 0; k < 8; ++k) { const int cpos = ts * 8 + k; f[k] = sm[((cpos & 3) * 16 + (cpos >> 2)) * 257 + rowid]; }
        w.x = pk2(f[0], f[1]); w.y = pk2(f[2], f[3]); w.z = pk2(f[4], f[5]); w.w = pk2(f[6], f[7]);
        bf16_t* dst = (rowid < 128 ? vsT + (size_t)rowid * T_ : vwT + (size_t)(rowid - 128) * T_) + t0 + ts * 8;
        *(u32x4*)dst = w;
    }
    __syncthreads();
}

__device__ void cmp1_wave_tile(const Params& p, int layer, int tile) {
    unsigned char* ws = p.ws;
    const float* P32 = (const float*)(ws + O_P32);
    const int lane = tidx() & 63, fr = lane & 15, fq = lane >> 4;
    const int nt = tile & 15, mt = (tile >> 4) & 127, which = tile >> 11;
    const bf16_t* Wt = (const bf16_t*)(ws + (which ? O_WCV : O_WCK)) + (size_t)(nt * 16 + fr) * 2048 + fq * 8;
    const float* pe = p.in[7] + (size_t)layer * 2048;
    const int r = mt * 16 + fr, n = r >> 1, hk = r & 1;
    const bool rv = n < 1023;
    const float* arow = P32 + (size_t)(16 * (rv ? n : 0)) * 1536 + (which ? 640 : 512) + hk * 64 + fq * 8;
    f32x4 acc = {0.f, 0.f, 0.f, 0.f};
#pragma unroll 4
    for (int ks = 0; ks < 64; ++ks) {
        const int l = ks >> 1, d = (ks & 1) * 32;
        const f32x4* ap = (const f32x4*)(arow + (size_t)l * 1536 + d);
        const f32x4* pp = (const f32x4*)(pe + l * 64 + d + fq * 8);
        f32x4 a0 = ap[0] + pp[0], a1 = ap[1] + pp[1];
        if (!rv) { a0 = (f32x4){0.f, 0.f, 0.f, 0.f}; a1 = a0; }
        const bf16x8 af = pack8f(a0, a1);
        const bf16x8 bf = *(const bf16x8*)(Wt + ks * 32);
        acc = MFMA16(af, bf, acc);
    }
    float* H = (float*)(ws + O_HCMP) + (size_t)which * 2048 * 256;
#pragma unroll
    for (int j = 0; j < 4; ++j) H[(size_t)(mt * 16 + fq * 4 + j) * 256 + nt * 16 + fr] = gelu_tanh(acc[j]);
}
__device__ void cmp2_wave_row(const Params& p, int layer, int idx) {
    unsigned char* ws = p.ws;
    const int lane = tidx() & 63;
    const int which = idx >> 11, r = idx & 2047, n = r >> 1, hk = r & 1;
    const float* H = (const float*)(ws + O_HCMP) + ((size_t)which * 2048 + r) * 256;
    const float* w2 = p.in[which ? 11 : 9] + (size_t)layer * 256 * 64;
    float acc = 0.f;
    if (n < 1023) {
#pragma unroll 8
        for (int f = 0; f < 256; ++f) acc += H[f] * w2[f * 64 + lane];
    }
    if (which == 0) {
        const float ss = wave_sum(acc * acc);
        float y = acc * rsqrtf(ss * (1.0f / 64.0f) + 1e-6f) * p.in[4][layer * 64 + lane];
        const float inv = powf(500000.0f, -(float)(lane & 7) * 0.125f);
        float sn, cs; sincosf((float)(16 * n + 16) * inv, &sn, &cs);
        const float yp = __shfl(y, lane ^ 8);
        if (lane < 8) y = y * cs - yp * sn; else if (lane < 16) y = y * cs + yp * sn;
        if (n >= 1023) y = 0.f;
        ((bf16_t*)(ws + O_KC))[((size_t)hk * 1024 + n) * 64 + lane] = f2bf(y);
    } else {
        ((bf16_t*)(ws + O_VCT))[((size_t)hk * 64 + lane) * 1024 + ((n & ~63) | ((n & 15) << 2) | ((n >> 4) & 3))] = f2bf(acc);
    }
}

struct S5Coef { float ar, ai; float bbr[16], bbi[16]; };
__device__ __forceinline__ void s5_setup(const Params& p, int layer, int g, int lane, S5Coef& c) {
    const int gp = layer * 2048 + g * 64 + lane;
    const float dt = expf(p.in[15][layer * 32 + g]);
    const float lr = p.in[13][gp], li = p.in[14][gp];
    const float mag = expf(lr * dt); float sn, cs; sincosf(li * dt, &sn, &cs);
    c.ar = mag * cs; c.ai = mag * sn;
    const float den = lr * lr + li * li, nr = c.ar - 1.0f, ni = c.ai;
    const float cr = (nr * lr + ni * li) / den, ci = (ni * lr - nr * li) / den;
    const f32x4* br = (const f32x4*)(p.in[16] + (size_t)gp * 16); const f32x4* bi = (const f32x4*)(p.in[17] + (size_t)gp * 16);
#pragma unroll
    for (int q = 0; q < 4; ++q) { const f32x4 a = br[q], b = bi[q];
#pragma unroll
        for (int e = 0; e < 4; ++e) { c.bbr[q * 4 + e] = cr * a[e] - ci * b[e]; c.bbi[q * 4 + e] = cr * b[e] + ci * a[e]; } }
}
__device__ __forceinline__ void s5_load_u(const bf16_t* Pu, int tok, int g, float (&ur)[16]) {
    const u32x4* s = (const u32x4*)(Pu + (size_t)tok * 512 + g * 16); const u32x4 a = s[0], b = s[1];
    ur[0] = bflo(a.x); ur[1] = bfhi(a.x); ur[2] = bflo(a.y); ur[3] = bfhi(a.y); ur[4] = bflo(a.z); ur[5] = bfhi(a.z); ur[6] = bflo(a.w); ur[7] = bfhi(a.w);
    ur[8] = bflo(b.x); ur[9] = bfhi(b.x); ur[10] = bflo(b.y); ur[11] = bfhi(b.y); ur[12] = bflo(b.z); ur[13] = bfhi(b.z); ur[14] = bflo(b.w); ur[15] = bfhi(b.w);
}
__device__ void s5_passA_wave(const Params& p, int layer, int item) {
    unsigned char* ws = p.ws; const bf16_t* Pu = (const bf16_t*)(ws + O_PU);
    const int lane = tidx() & 63, c = item >> 5, g = item & 31;
    S5Coef k; s5_setup(p, layer, g, lane, k);
    float xr = 0.f, xi = 0.f;
    for (int sub = 0; sub < 4; ++sub) {
        float ur[16]; s5_load_u(Pu, c * 256 + sub * 64 + lane, g, ur);
        for (int j = 0; j < 64; ++j) {
            float bur = 0.f, bui = 0.f;
#pragma unroll
            for (int h = 0; h < 16; ++h) { const float u = rdlane(ur[h], j); bur += k.bbr[h] * u; bui += k.bbi[h] * u; }
            const float nxr = k.ar * xr - k.ai * xi + bur, nxi = k.ar * xi + k.ai * xr + bui; xr = nxr; xi = nxi;
        }
    }
    float* xe = (float*)(ws + O_XEND) + ((size_t)(c * 32 + g) * 64 + lane) * 2; xe[0] = xr; xe[1] = xi;
}
__device__ void s5_passB_wave(const Params& p, int layer, int item, bf16_t* xl) {
    unsigned char* ws = p.ws; const bf16_t* Pu = (const bf16_t*)(ws + O_PU); bf16_t* yg = (bf16_t*)(ws + O_YGELU);
    const int lane = tidx() & 63, fr = lane & 15, fq = lane >> 4, c = item >> 5, g = item & 31;
    S5Coef k; s5_setup(p, layer, g, lane, k);
    float pr = k.ar, pi = k.ai;
#pragma unroll
    for (int s = 0; s < 8; ++s) { const float nr = pr * pr - pi * pi, ni = 2.f * pr * pi; pr = nr; pi = ni; }
    float xr = 0.f, xi = 0.f;
    const float* xe = (const float*)(ws + O_XEND) + ((size_t)g * 64 + lane) * 2;
    for (int cc = 0; cc < c; ++cc) { const float er = xe[(size_t)cc * 32 * 64 * 2], ei = xe[(size_t)cc * 32 * 64 * 2 + 1]; const float nr = pr * xr - pi * xi + er, ni = pr * xi + pi * xr + ei; xr = nr; xi = ni; }
    bf16x8 cf[4];
    {
        const float* cre = p.in[18] + (size_t)layer * 32 * 16 * 64 + ((size_t)g * 16 + fr) * 64; const float* cim = p.in[19] + (size_t)layer * 32 * 16 * 64 + ((size_t)g * 16 + fr) * 64;
#pragma unroll
        for (int ks = 0; ks < 4; ++ks) { const float* s = (ks < 2 ? cre : cim) + (ks & 1) * 32 + fq * 8; f32x4 a = ((const f32x4*)s)[0], b = ((const f32x4*)s)[1]; if (ks >= 2) { a = -a; b = -b; } cf[ks] = pack8f(a, b); }
    }
    const float dsk = p.in[20][layer * 512 + g * 16 + fr];
    for (int sub = 0; sub < 4; ++sub) {
        const int tb = c * 256 + sub * 64;
        float ur[16]; s5_load_u(Pu, tb + lane, g, ur);
        for (int jb = 0; jb < 4; ++jb) {
            for (int jj = 0; jj < 16; ++jj) {
                const int j = jb * 16 + jj;
                float bur = 0.f, bui = 0.f;
#pragma unroll
                for (int h = 0; h < 16; ++h) { const float u = rdlane(ur[h], j); bur += k.bbr[h] * u; bui += k.bbi[h] * u; }
                const float nxr = k.ar * xr - k.ai * xi + bur, nxi = k.ar * xi + k.ai * xr + bui; xr = nxr; xi = nxi;
                xl[jj * 136 + lane] = f2bf(xr); xl[jj * 136 + 64 + lane] = f2bf(xi);
            }
            asm volatile("s_waitcnt lgkmcnt(0)" ::: "memory");
            f32x4 y = {0.f, 0.f, 0.f, 0.f};
#pragma unroll
            for (int ks = 0; ks < 4; ++ks) { const bf16x8 af = *(const bf16x8*)(xl + fr * 136 + ks * 32 + fq * 8); y = MFMA16(af, cf[ks], y); }
            asm volatile("s_waitcnt lgkmcnt(0)" ::: "memory");
#pragma unroll
            for (int q = 0; q < 4; ++q) { const int tok = tb + jb * 16 + fq * 4 + q; const float u = bf2f(Pu[(size_t)tok * 512 + g * 16 + fr]); yg[(size_t)tok * 512 + g * 16 + fr] = f2bf(gelu_tanh(y[q] + dsk * u)); }
        }
    }
}
__device__ void gdn_prep_item(const Params& p, int layer, int item, unsigned char* lds) {
    unsigned char* ws = p.ws;
    const int tid = tidx(), wave = tid >> 6, lane = tid & 63, fr = lane & 15, fq = lane >> 4;
    const int n = item >> 3, h = item & 7, t0 = n * 64;
    bf16_t* qs = (bf16_t*)(lds); bf16_t* ks = (bf16_t*)(lds + 17408); bf16_t* vbT = (bf16_t*)(lds + 34816); bf16_t* kgT = (bf16_t*)(lds + 53248); bf16_t* kdT = (bf16_t*)(lds + 71680);
    float* Am = (float*)(lds + 90112); bf16_t* Tb = (bf16_t*)(lds + 107520); float* gcs = (float*)(lds + 116736); float* bts = (float*)(lds + 116992);
    const float* P32 = (const float*)(ws + O_P32); const bf16_t* Pqkv = (const bf16_t*)(ws + O_PQKV);
    if (wave == 0) {
        const int t = t0 + lane;
        const float a = P32[(size_t)t * 1536 + 1304 + h], b = P32[(size_t)t * 1536 + 1312 + h];
        const float g = -expf(p.in[24][layer * 8 + h]) * softplusf_(a + p.in[25][layer * 8 + h]);
        float s = g;
#pragma unroll
        for (int off = 1; off < 64; off <<= 1) { const float o = __shfl_up(s, off); if (lane >= off) s += o; }
        gcs[lane] = s; bts[lane] = sigmoidf_(b);
    }
    __syncthreads();
    {
        const int r = tid >> 3, c0 = (tid & 7) * 16;
        const float gcr = gcs[r], btr = bts[r], eg = expf(gcr), ed = expf(gcs[63] - gcr);
        const float* cw = p.in[23] + (size_t)layer * 4 * 3072;
#pragma unroll
        for (int which = 0; which < 3; ++which) {
            const int col = which * 1024 + h * 128 + c0;
            float acc[16];
#pragma unroll
            for (int e = 0; e < 16; ++e) acc[e] = 0.f;
#pragma unroll
            for (int j = 0; j < 4; ++j) {
                const int tr = t0 + r - 3 + j;
                if (tr >= 0) {
                    const u32x4* s = (const u32x4*)(Pqkv + (size_t)tr * 3072 + col); const u32x4 a = s[0], b = s[1];
                    const f32x4* wp = (const f32x4*)(cw + j * 3072 + col); const f32x4 w0 = wp[0], w1 = wp[1], w2 = wp[2], w3 = wp[3];
                    acc[0] += w0[0] * bflo(a.x); acc[1] += w0[1] * bfhi(a.x); acc[2] += w0[2] * bflo(a.y); acc[3] += w0[3] * bfhi(a.y);
                    acc[4] += w1[0] * bflo(a.z); acc[5] += w1[1] * bfhi(a.z); acc[6] += w1[2] * bflo(a.w); acc[7] += w1[3] * bfhi(a.w);
                    acc[8] += w2[0] * bflo(b.x); acc[9] += w2[1] * bfhi(b.x); acc[10] += w2[2] * bflo(b.y); acc[11] += w2[3] * bfhi(b.y);
                    acc[12] += w3[0] * bflo(b.z); acc[13] += w3[1] * bfhi(b.z); acc[14] += w3[2] * bflo(b.w); acc[15] += w3[3] * bfhi(b.w);
                }
            }
            float ss = 0.f;
#pragma unroll
            for (int e = 0; e < 16; ++e) { acc[e] = siluf_(acc[e]); ss += acc[e] * acc[e]; }
            ss += __shfl_xor(ss, 1); ss += __shfl_xor(ss, 2); ss += __shfl_xor(ss, 4);
            const float rn = rsqrtf(ss + 1e-6f);
            if (which == 0) {
                bf16_t* qg = (bf16_t*)(ws + O_GQG) + (size_t)item * 8192 + r * 128 + c0;
                float v[16];
#pragma unroll
                for (int e = 0; e < 16; ++e) v[e] = acc[e] * rn * 0.08838834764831845f;
                u32x4 w0, w1; w0.x = pk2(v[0], v[1]); w0.y = pk2(v[2], v[3]); w0.z = pk2(v[4], v[5]); w0.w = pk2(v[6], v[7]); w1.x = pk2(v[8], v[9]); w1.y = pk2(v[10], v[11]); w1.z = pk2(v[12], v[13]); w1.w = pk2(v[14], v[15]);
                *(u32x4*)(qs + r * 136 + c0) = w0; *(u32x4*)(qs + r * 136 + c0 + 8) = w1;
                u32x4 g0, g1; g0.x = pk2(v[0] * eg, v[1] * eg); g0.y = pk2(v[2] * eg, v[3] * eg); g0.z = pk2(v[4] * eg, v[5] * eg); g0.w = pk2(v[6] * eg, v[7] * eg);
                g1.x = pk2(v[8] * eg, v[9] * eg); g1.y = pk2(v[10] * eg, v[11] * eg); g1.z = pk2(v[12] * eg, v[13] * eg); g1.w = pk2(v[14] * eg, v[15] * eg);
                *(u32x4*)qg = g0; *(u32x4*)(qg + 8) = g1;
            } else if (which == 1) {
                float v[16];
#pragma unroll
                for (int e = 0; e < 16; ++e) v[e] = acc[e] * rn;
                u32x4 w0, w1; w0.x = pk2(v[0], v[1]); w0.y = pk2(v[2], v[3]); w0.z = pk2(v[4], v[5]); w0.w = pk2(v[6], v[7]); w1.x = pk2(v[8], v[9]); w1.y = pk2(v[10], v[11]); w1.z = pk2(v[12], v[13]); w1.w = pk2(v[14], v[15]);
                *(u32x4*)(ks + r * 136 + c0) = w0; *(u32x4*)(ks + r * 136 + c0 + 8) = w1;
#pragma unroll
                for (int e = 0; e < 16; ++e) { kgT[(c0 + e) * 72 + r] = f2bf(v[e] * btr * eg); kdT[(c0 + e) * 72 + r] = f2bf(v[e] * ed); }
            } else {
#pragma unroll
                for (int e = 0; e < 16; ++e) vbT[(c0 + e) * 72 + r] = f2bf(acc[e] * btr);
            }
        }
    }
    __syncthreads();
    {
        const int d = tid >> 2, sg = tid & 3;
        const u32x4 a = *(const u32x4*)(kdT + d * 72 + sg * 16), b = *(const u32x4*)(kdT + d * 72 + sg * 16 + 8);
        bf16_t* dst = (bf16_t*)(ws + O_GKD) + (size_t)item * 8192 + d * 64 + sg * 16; *(u32x4*)dst = a; *(u32x4*)(dst + 8) = b;
    }
    { float* Tmz = (float*)(lds + 117248); for (int e2 = tid; e2 < 64 * 68; e2 += 512) Tmz[e2] = 0.f; }
    {
        const int mi = wave >> 1;
        bf16_t* qko = (bf16_t*)(ws + O_GQK) + (size_t)item * 4096;
#pragma unroll
        for (int q = 0; q < 2; ++q) {
            const int nj = (wave & 1) * 2 + q;
            f32x4 kk = {0.f, 0.f, 0.f, 0.f}, qk = {0.f, 0.f, 0.f, 0.f};
            if (nj <= mi) {
#pragma unroll
                for (int s = 0; s < 4; ++s) {
                    const bf16x8 bk = *(const bf16x8*)(ks + (nj * 16 + fr) * 136 + s * 32 + fq * 8);
                    const bf16x8 ak = *(const bf16x8*)(ks + (mi * 16 + fr) * 136 + s * 32 + fq * 8);
                    const bf16x8 aq = *(const bf16x8*)(qs + (mi * 16 + fr) * 136 + s * 32 + fq * 8);
                    kk = MFMA16(ak, bk, kk); qk = MFMA16(aq, bk, qk);
                }
            }
            const int j = nj * 16 + fr; const float gj = gcs[j];
#pragma unroll
            for (int e = 0; e < 4; ++e) {
                const int i = mi * 16 + fq * 4 + e;
                const float dec = (j <= i) ? expf(gcs[i] - gj) : 0.f;
                Am[i * 68 + j] = (j < i) ? bts[i] * kk[e] * dec : 0.f;
                qko[i * 64 + j] = f2bf((j <= i) ? qk[e] * dec : 0.f);
            }
        }
    }
    __syncthreads();
    {
        float* Tm = (float*)(lds + 117248); float* Ps = (float*)(lds + 134656) + wave * 320;
        if (wave == 0) {
            const int bo = fq * 16; float t[16];
#pragma unroll
            for (int i = 0; i < 16; ++i) {
                float s = (i == fr) ? 1.f : 0.f;
#pragma unroll
                for (int j = 0; j < i; ++j) s -= Am[(bo + i) * 68 + bo + j] * t[j];
                t[i] = s; Tm[(bo + i) * 68 + bo + fr] = s;
            }
        }
        asm volatile("s_waitcnt lgkmcnt(0)" ::: "memory"); __syncthreads();
#pragma unroll
        for (int d = 1; d < 4; ++d) {
            if (wave < 4 - d) {
                const int bi = wave + d, bj = wave;
                f32x4 Q = {0.f, 0.f, 0.f, 0.f};
                for (int kb = bj; kb < bi; ++kb) {
                    const float* X = Am + (bi * 16) * 68 + kb * 16; const float* Y = Tm + (kb * 16) * 68 + bj * 16;
#pragma unroll
                    for (int s = 0; s < 4; ++s) Q = __builtin_amdgcn_mfma_f32_16x16x4f32(X[fr * 68 + 4 * s + fq], Y[(4 * s + fq) * 68 + fr], Q, 0, 0, 0);
                }
#pragma unroll
                for (int e2 = 0; e2 < 4; ++e2) Ps[(fq * 4 + e2) * 20 + fr] = Q[e2];
                asm volatile("s_waitcnt lgkmcnt(0)" ::: "memory");
                f32x4 R = {0.f, 0.f, 0.f, 0.f};
                const float* X = Tm + (bi * 16) * 68 + bi * 16;
#pragma unroll
                for (int s = 0; s < 4; ++s) R = __builtin_amdgcn_mfma_f32_16x16x4f32(X[fr * 68 + 4 * s + fq], Ps[(4 * s + fq) * 20 + fr], R, 0, 0, 0);
#pragma unroll
                for (int e2 = 0; e2 < 4; ++e2) Tm[(bi * 16 + fq * 4 + e2) * 68 + bj * 16 + fr] = -R[e2];
            }
            asm volatile("s_waitcnt lgkmcnt(0)" ::: "memory"); __syncthreads();
        }
        for (int e2 = tid; e2 < 4096; e2 += 512) { const int r = e2 >> 6, c = e2 & 63; Tb[r * 72 + c] = f2bf(Tm[r * 68 + c]); }
    }
    __syncthreads();
    {
        const int mi = wave & 3;
        const bf16x8 a0 = *(const bf16x8*)(Tb + (mi * 16 + fr) * 72 + fq * 8), a1 = *(const bf16x8*)(Tb + (mi * 16 + fr) * 72 + 32 + fq * 8);
        float* vo = (float*)(ws + O_GVAL) + (size_t)item * 8192; bf16_t* ko = (bf16_t*)(ws + O_GKC) + (size_t)item * 8192;
#pragma unroll
        for (int q = 0; q < 4; ++q) {
            const int nt = (wave >> 2) * 4 + q;
            f32x4 v = {0.f, 0.f, 0.f, 0.f}, kc = {0.f, 0.f, 0.f, 0.f};
            v = MFMA16(a0, *(const bf16x8*)(vbT + (nt * 16 + fr) * 72 + fq * 8), v); v = MFMA16(a1, *(const bf16x8*)(vbT + (nt * 16 + fr) * 72 + 32 + fq * 8), v);
            kc = MFMA16(a0, *(const bf16x8*)(kgT + (nt * 16 + fr) * 72 + fq * 8), kc); kc = MFMA16(a1, *(const bf16x8*)(kgT + (nt * 16 + fr) * 72 + 32 + fq * 8), kc);
#pragma unroll
            for (int e = 0; e < 4; ++e) { const int i = mi * 16 + fq * 4 + e, d = nt * 16 + fr; vo[i * 128 + d] = v[e]; ko[i * 128 + d] = f2bf(kc[e]); }
        }
    }
    if (tid == 0) ((float*)(ws + O_GEGL))[item] = expf(gcs[63]);
    __syncthreads();
}

struct GdnUO { bf16x8 kc[4], qg[4], qk[2]; float val[2][4]; };
struct GdnSU { bf16x8 kd[2][2]; float egl; };
__device__ __forceinline__ void gdn_load_uo(const unsigned char* ws, int item, int mt, int fr, int fq, int dvb, GdnUO& f) {
    const bf16_t* kc = (const bf16_t*)(ws + O_GKC) + (size_t)item * 8192 + (mt * 16 + fr) * 128 + fq * 8;
    const bf16_t* qg = (const bf16_t*)(ws + O_GQG) + (size_t)item * 8192 + (mt * 16 + fr) * 128 + fq * 8;
    const bf16_t* qk = (const bf16_t*)(ws + O_GQK) + (size_t)item * 4096 + (mt * 16 + fr) * 64 + fq * 8;
    const float* vl = (const float*)(ws + O_GVAL) + (size_t)item * 8192 + (mt * 16 + fq * 4) * 128 + dvb + fr;
#pragma unroll
    for (int s = 0; s < 4; ++s) { f.kc[s] = *(const bf16x8*)(kc + s * 32); f.qg[s] = *(const bf16x8*)(qg + s * 32); }
#pragma unroll
    for (int s = 0; s < 2; ++s) f.qk[s] = *(const bf16x8*)(qk + s * 32);
#pragma unroll
    for (int nt = 0; nt < 2; ++nt)
#pragma unroll
        for (int e = 0; e < 4; ++e) f.val[nt][e] = vl[e * 128 + nt * 16];
}
__device__ __forceinline__ void gdn_load_su(const unsigned char* ws, int item, int w4, int fr, int fq, GdnSU& f) {
    const bf16_t* kd = (const bf16_t*)(ws + O_GKD) + (size_t)item * 8192 + (2 * w4 * 16 + fr) * 64 + fq * 8;
#pragma unroll
    for (int s = 0; s < 2; ++s) { f.kd[0][s] = *(const bf16x8*)(kd + s * 32); f.kd[1][s] = *(const bf16x8*)(kd + 16 * 64 + s * 32); }
    f.egl = ((const float*)(ws + O_GEGL))[item];
}
#define GDN_BAR() do { asm volatile("s_waitcnt lgkmcnt(0)" ::: "memory"); __builtin_amdgcn_s_barrier(); asm volatile("" ::: "memory"); } while (0)
__device__ __forceinline__ void gdn_step_uo(const GdnUO& c, bf16_t* Sl, bf16_t* vn, float* go, int n, int h, int mt, int fr, int fq, int dvb) {
    bf16x8 Sb[2][4];
#pragma unroll
    for (int nt = 0; nt < 2; ++nt)
#pragma unroll
        for (int s = 0; s < 4; ++s) Sb[nt][s] = *(const bf16x8*)(Sl + nt * (16 * 136) + fr * 136 + s * 32 + fq * 8);
    f32x4 U[2], O[2];
#pragma unroll
    for (int nt = 0; nt < 2; ++nt) { U[nt] = (f32x4){0.f, 0.f, 0.f, 0.f}; O[nt] = (f32x4){0.f, 0.f, 0.f, 0.f};
#pragma unroll
        for (int s = 0; s < 4; ++s) U[nt] = MFMA16(c.kc[s], Sb[nt][s], U[nt]);
        u32x2 w; w.x = pk2(c.val[nt][0] - U[nt][0], c.val[nt][1] - U[nt][1]); w.y = pk2(c.val[nt][2] - U[nt][2], c.val[nt][3] - U[nt][3]);
        *(u32x2*)(vn + nt * (16 * 72) + fr * 72 + mt * 16 + fq * 4) = w; }
#pragma unroll
    for (int nt = 0; nt < 2; ++nt)
#pragma unroll
        for (int s = 0; s < 4; ++s) O[nt] = MFMA16(c.qg[s], Sb[nt][s], O[nt]);
    GDN_BAR();
#pragma unroll
    for (int nt = 0; nt < 2; ++nt) {
        const bf16x8 V0 = *(const bf16x8*)(vn + nt * (16 * 72) + fr * 72 + fq * 8), V1 = *(const bf16x8*)(vn + nt * (16 * 72) + fr * 72 + 32 + fq * 8);
        O[nt] = MFMA16(c.qk[0], V0, O[nt]); O[nt] = MFMA16(c.qk[1], V1, O[nt]);
#pragma unroll
        for (int e = 0; e < 4; ++e) go[(size_t)(n * 64 + mt * 16 + fq * 4 + e) * 1024 + h * 128 + dvb + nt * 16 + fr] = O[nt][e];
    }
    GDN_BAR();
}
__device__ __forceinline__ void gdn_step_su(const GdnSU& c, f32x4 (&St)[2][2], bf16_t* Sl, const bf16_t* vn, int w4, int fr, int fq) {
    GDN_BAR();
#pragma unroll
    for (int nt = 0; nt < 2; ++nt) {
        const bf16x8 V0 = *(const bf16x8*)(vn + nt * (16 * 72) + fr * 72 + fq * 8), V1 = *(const bf16x8*)(vn + nt * (16 * 72) + fr * 72 + 32 + fq * 8);
#pragma unroll
        for (int q = 0; q < 2; ++q) {
            St[nt][q] = St[nt][q] * c.egl;
            St[nt][q] = MFMA16(V0, c.kd[q][0], St[nt][q]); St[nt][q] = MFMA16(V1, c.kd[q][1], St[nt][q]);
#pragma unroll
            for (int e = 0; e < 4; ++e) Sl[nt * (16 * 136) + (fq * 4 + e) * 136 + (2 * w4 + q) * 16 + fr] = f2bf(St[nt][q][e]);
        }
    }
    GDN_BAR();
}
__device__ void gdn_recurrence(const Params& p, int b, unsigned char* lds) {
    const unsigned char* ws = p.ws;
    const int tid = tidx(), wave = tid >> 6, lane = tid & 63, fr = lane & 15, fq = lane >> 4;
    const int h = b >> 2, dvb = (b & 3) * 32;
    bf16_t* Sl = (bf16_t*)lds; bf16_t* vn = (bf16_t*)(lds + 2 * 16 * 136 * 2);
    float* go = (float*)(p.ws + O_PQKV);
    for (int e = tid; e < 2 * 16 * 136; e += 512) Sl[e] = 0;
    __syncthreads();
    if (wave < 4) {
        const int mt = wave;
        GdnUO f0, f1, f2;
        gdn_load_uo(ws, h, mt, fr, fq, dvb, f0); gdn_load_uo(ws, 8 + h, mt, fr, fq, dvb, f1);
        for (int n = 0; n < 255; n += 3) {
            gdn_load_uo(ws, (n + 2) * 8 + h, mt, fr, fq, dvb, f2); gdn_step_uo(f0, Sl, vn, go, n, h, mt, fr, fq, dvb);
            gdn_load_uo(ws, (n + 3) * 8 + h, mt, fr, fq, dvb, f0); gdn_step_uo(f1, Sl, vn, go, n + 1, h, mt, fr, fq, dvb);
            if (n + 4 < 256) gdn_load_uo(ws, (n + 4) * 8 + h, mt, fr, fq, dvb, f1);
            gdn_step_uo(f2, Sl, vn, go, n + 2, h, mt, fr, fq, dvb);
        }
        gdn_step_uo(f0, Sl, vn, go, 255, h, mt, fr, fq, dvb);
    } else {
        const int w4 = wave - 4;
        f32x4 St[2][2];
#pragma unroll
        for (int a = 0; a < 2; ++a)
#pragma unroll
            for (int c = 0; c < 2; ++c) St[a][c] = (f32x4){0.f, 0.f, 0.f, 0.f};
        GdnSU f0, f1, f2;
        gdn_load_su(ws, h, w4, fr, fq, f0); gdn_load_su(ws, 8 + h, w4, fr, fq, f1);
        for (int n = 0; n < 255; n += 3) {
            gdn_load_su(ws, (n + 2) * 8 + h, w4, fr, fq, f2); gdn_step_su(f0, St, Sl, vn, w4, fr, fq);
            gdn_load_su(ws, (n + 3) * 8 + h, w4, fr, fq, f0); gdn_step_su(f1, St, Sl, vn, w4, fr, fq);
            if (n + 4 < 256) gdn_load_su(ws, (n + 4) * 8 + h, w4, fr, fq, f1);
            gdn_step_su(f2, St, Sl, vn, w4, fr, fq);
        }
        gdn_step_su(f0, St, Sl, vn, w4, fr, fq);
    }
}
struct KVF { bf16x8 k[4][2]; };
__device__ __forceinline__ void kv_load(const bf16_t* kp, int ldk, KVF& f) {
#pragma unroll
    for (int s = 0; s < 4; ++s) { f.k[s][0] = *(const bf16x8*)(kp + (size_t)(s * 16) * ldk); f.k[s][1] = *(const bf16x8*)(kp + (size_t)(s * 16) * ldk + 32); }
}
template <int CTRL> __device__ __forceinline__ float dppf(float v) { return __int_as_float(__builtin_amdgcn_update_dpp(0, __float_as_int(v), CTRL, 0xF, 0xF, true)); }
template <int CTRL> __device__ __forceinline__ unsigned dppu(unsigned v) { return (unsigned)__builtin_amdgcn_update_dpp(0, (int)v, CTRL, 0xF, 0xF, true); }
__device__ __forceinline__ float rmax16(float v) { v = vmaxf(v, dppf<0xB1>(v)); v = vmaxf(v, dppf<0x4E>(v)); v = vmaxf(v, dppf<0x124>(v)); v = vmaxf(v, dppf<0x128>(v)); return v; }
__device__ __forceinline__ float rsum16(float v) { v += dppf<0xB1>(v); v += dppf<0x4E>(v); v += dppf<0x124>(v); v += dppf<0x128>(v); return v; }
template <int CTRL> __device__ __forceinline__ unsigned long long dppmax64(unsigned long long b) { const unsigned lo = dppu<CTRL>((unsigned)b), hi = dppu<CTRL>((unsigned)(b >> 32)); const unsigned long long ob = ((unsigned long long)hi << 32) | lo; return ob > b ? ob : b; }
__device__ __forceinline__ void flash_compute(const bf16x8 (&Qf)[2], KVF& f, const bf16_t* knext, int ldk, const bf16_t* vp, int ldv, unsigned vmask, float (&m)[4], float (&l)[4], f32x4 (&O)[4], bf16_t* Pt, int fr, int fq) {
    f32x4 S[4];
    bf16x8 Vf[4][2];
    __builtin_amdgcn_sched_barrier(0);
#pragma unroll
    for (int dt = 0; dt < 4; ++dt) { Vf[dt][0] = *(const bf16x8*)(vp + (size_t)(dt * 16) * ldv); Vf[dt][1] = *(const bf16x8*)(vp + (size_t)(dt * 16) * ldv + 32); }
#pragma unroll
    for (int s = 0; s < 4; ++s) { S[s] = (f32x4){0.f, 0.f, 0.f, 0.f}; S[s] = MFMA16(Qf[0], f.k[s][0], S[s]); S[s] = MFMA16(Qf[1], f.k[s][1], S[s]); }
    if (knext) kv_load(knext, ldk, f);
    float mx[4];
#pragma unroll
    for (int j = 0; j < 4; ++j) { float v = -1e30f;
#pragma unroll
        for (int s = 0; s < 4; ++s) v = ((vmask >> s) & 1u) ? vmaxf(v, S[s][j]) : v;
        mx[j] = rmax16(v); }
#pragma unroll
    for (int j = 0; j < 4; ++j) { const float mn = vmaxf(m[j], mx[j]); const float a = __builtin_amdgcn_exp2f(m[j] - mn); m[j] = mn; l[j] *= a;
#pragma unroll
        for (int dt = 0; dt < 4; ++dt) O[dt][j] *= a; }
#pragma unroll
    for (int j = 0; j < 4; ++j) { float pv[4];
#pragma unroll
        for (int s = 0; s < 4; ++s) { pv[s] = ((vmask >> s) & 1u) ? __builtin_amdgcn_exp2f(S[s][j] - m[j]) : 0.f; l[j] += pv[s]; }
        u32x2 w; w.x = pk2(pv[0], pv[1]); w.y = pk2(pv[2], pv[3]); *(u32x2*)(Pt + (fq * 4 + j) * 72 + fr * 4) = w; }
    asm volatile("s_waitcnt lgkmcnt(0)" ::: "memory");
    const bf16x8 P0 = *(const bf16x8*)(Pt + fr * 72 + fq * 8), P1 = *(const bf16x8*)(Pt + fr * 72 + 32 + fq * 8);
    asm volatile("s_waitcnt lgkmcnt(0)" ::: "memory");
#pragma unroll
    for (int dt = 0; dt < 4; ++dt) { O[dt] = MFMA16(P0, Vf[dt][0], O[dt]); O[dt] = MFMA16(P1, Vf[dt][1], O[dt]); }
    __builtin_amdgcn_sched_barrier(0);
}
template <int BR> struct BranchIt {
    const bf16_t* kb; const bf16_t* vb; const unsigned* flg; int last, trow, fr, fq;
    static constexpr int LDK = BR == 0 ? 64 : 128, LDV = BR == 0 ? 1024 : T_;
    __device__ __forceinline__ int next(int from) const {
        if (BR == 1) { int jb = from; while (jb <= last && flg[jb] == 0u) ++jb; return jb <= last ? jb : -1; }
        return from <= last ? from : -1;
    }
    __device__ __forceinline__ void load(int idx, KVF& f) const { kv_load(kb + (size_t)(idx * 64) * LDK, LDK, f); }
    __device__ __forceinline__ const bf16_t* vptr(int idx) const { return vb + idx * 64; }
    __device__ __forceinline__ const bf16_t* kptr(int idx) const { return kb + (size_t)(idx * 64) * LDK; }
    __device__ __forceinline__ unsigned mask(int idx) const {
        unsigned vm = 0; const int key0 = idx * 64;
        if (BR == 0) {
#pragma unroll
            for (int s = 0; s < 4; ++s) vm |= ((16 * (key0 + s * 16 + fr) + 31 <= trow) ? 1u : 0u) << s;
        } else if (BR == 1) {
            const bool rowsel = (flg[idx] >> fq) & 1u;
#pragma unroll
            for (int s = 0; s < 4; ++s) vm |= ((rowsel && (key0 + s * 16 + fr <= trow)) ? 1u : 0u) << s;
        } else {
#pragma unroll
            for (int s = 0; s < 4; ++s) { const int kpos = key0 + s * 16 + fr; vm |= ((kpos <= trow && kpos > trow - 512) ? 1u : 0u) << s; }
        }
        return vm;
    }
};
template <int BR> __device__ __forceinline__ void run_branch(const BranchIt<BR>& it, int first, const bf16x8 (&Qf)[2], float (&m)[4], float (&l)[4], f32x4 (&O)[4], bf16_t* Pt) {
#pragma unroll
    for (int j = 0; j < 4; ++j) { m[j] = -1e30f; l[j] = 0.f; O[j] = (f32x4){0.f, 0.f, 0.f, 0.f}; }
    int ia = it.next(first);
    if (ia < 0) return;
    KVF A; it.load(ia, A);
    while (ia >= 0) {
        const int ib = it.next(ia + 1);
        flash_compute(Qf, A, ib >= 0 ? it.kptr(ib) : nullptr, BranchIt<BR>::LDK, it.vptr(ia), BranchIt<BR>::LDV, it.mask(ia), m, l, O, Pt, it.fr, it.fq);
        ia = ib;
    }
}
__device__ __forceinline__ void branch_finish(float (&l)[4], f32x4 (&O)[4], const float* grow, int br, int hk, float* ybp  ) {
#pragma unroll
    for (int j = 0; j < 4; ++j) { const float s = rsum16(l[j]);
        const float g = sigmoidf_(grow[(hk * 4 + j) * 3 + br]) / fmaxf(s, 1e-30f);
#pragma unroll
        for (int dt = 0; dt < 4; ++dt) { float* q = ybp + j * 64 + dt * 16; if (br == 0) *q = g * O[dt][j]; else *q += g * O[dt][j]; } }
}
constexpr int NSA_WLDS = 15680;
__device__ void nsa_wave_task(const Params& p, int layer, int t0, unsigned char* wl) {
    unsigned char* ws = p.ws;
    const int lane = tidx() & 63, fr = lane & 15, fq = lane >> 4;
    float* imp = (float*)wl; unsigned* flg = (unsigned*)(wl + 4160); bf16_t* Pt = (bf16_t*)(wl + 5184); float* yb = (float*)(wl + 7488);
    const bf16_t* qn = (const bf16_t*)(ws + O_QN); const bf16_t* ksn = (const bf16_t*)(ws + O_KSN); const bf16_t* kwn = (const bf16_t*)(ws + O_KWN);
    const bf16_t* vsT = (const bf16_t*)(ws + O_VST); const bf16_t* vwT = (const bf16_t*)(ws + O_VWT); const bf16_t* kc = (const bf16_t*)(ws + O_KC); const bf16_t* vcT = (const bf16_t*)(ws + O_VCT);
    const int trow = t0 + fq;
    const float* grow = (const float*)(ws + O_P32) + (size_t)trow * 1536 + 1280;
    const int tmax = t0 + 3;
    for (int hk = 0; hk < 2; ++hk) {
        bf16x8 Qf[2];
        { const bf16_t* qp = qn + (size_t)(t0 + (fr >> 2)) * 512 + (hk * 4 + (fr & 3)) * 64 + fq * 8; Qf[0] = *(const bf16x8*)qp; Qf[1] = *(const bf16x8*)(qp + 32); }
        float* ybp = yb + fq * 512 + hk * 256 + fr;
        float m[4], l[4]; f32x4 O[4];
        const int ncmp_t = tmax >= 31 ? ((((tmax - 31) >> 4) >> 6) + 1) : 0;
        const bf16_t* kcb = kc + ((size_t)hk * 1024 + fr) * 64 + fq * 8;
        { BranchIt<0> it{kcb, vcT + ((size_t)hk * 64 + fr) * 1024 + fq * 8, nullptr, ncmp_t - 1, trow, fr, fq}; run_branch<0>(it, 0, Qf, m, l, O, Pt); }
        float linv[4];
#pragma unroll
        for (int j = 0; j < 4; ++j) { const float s = rsum16(l[j]); linv[j] = s > 0.f ? 1.0f / s : 0.f; }
        branch_finish(l, O, grow, 0, hk, ybp);
        for (int e = lane; e < 4 * 260; e += 64) imp[e] = 0.f;
        for (int e = lane; e < 256; e += 64) flg[e] = 0u;
        asm volatile("s_waitcnt lgkmcnt(0)" ::: "memory");
        {
            KVF ka;
            if (ncmp_t > 0) kv_load(kcb, 64, ka);
            for (int kt = 0; kt < ncmp_t; ++kt) {
                const int key0 = kt * 64;
                f32x4 S[4];
#pragma unroll
                for (int s = 0; s < 4; ++s) { S[s] = (f32x4){0.f, 0.f, 0.f, 0.f}; S[s] = MFMA16(Qf[0], ka.k[s][0], S[s]); S[s] = MFMA16(Qf[1], ka.k[s][1], S[s]); }
                if (kt + 1 < ncmp_t) kv_load(kcb + (size_t)(key0 + 64) * 64, 64, ka);
#pragma unroll
                for (int s = 0; s < 4; ++s) {
                    const int nn = key0 + s * 16 + fr; const bool valid = 16 * nn + 31 <= trow;
                    float ps = 0.f;
#pragma unroll
                    for (int j = 0; j < 4; ++j) ps += valid ? __builtin_amdgcn_exp2f(S[s][j] - m[j]) * linv[j] : 0.f;
                    float p4 = ps; p4 += dppf<0xB1>(p4); p4 += dppf<0x4E>(p4);
                    if ((fr & 3) == 0) imp[fq * 260 + (nn >> 2)] += p4;
                    asm volatile("s_waitcnt lgkmcnt(0)" ::: "memory");
                    if ((fr & 3) == 3) imp[fq * 260 + (nn >> 2) + 1] += ps;
                    asm volatile("s_waitcnt lgkmcnt(0)" ::: "memory");
                }
            }
        }
#ifdef OLD_TOPK
        for (int tok = 0; tok < 4; ++tok) {
            const int t = t0 + tok, cur = t >> 6, nsel = cur + 1 < 16 ? cur + 1 : 16;
            unsigned long long key[4];
#pragma unroll
            for (int i = 0; i < 4; ++i) { const int j = lane + 64 * i; unsigned long long k = 0ull;
                if (j <= cur) { const bool forced = (j == 0) || (j == cur) || (j == cur - 1); const unsigned vb = forced ? 0x7F800000u : __float_as_uint(imp[tok * 260 + j]); k = ((unsigned long long)vb << 32) | (unsigned)(0xFFFF - j); }
                key[i] = k; }
            for (int it2 = 0; it2 < nsel; ++it2) {
                unsigned long long best = key[0]; best = key[1] > best ? key[1] : best; best = key[2] > best ? key[2] : best; best = key[3] > best ? key[3] : best;
#pragma unroll
                for (int o = 32; o >= 1; o >>= 1) { const unsigned lo = __shfl_xor((unsigned)best, o), hi = __shfl_xor((unsigned)(best >> 32), o); const unsigned long long ob = ((unsigned long long)hi << 32) | lo; best = ob > best ? ob : best; }
                const int jsel = 0xFFFF - (int)(best & 0xFFFFu);
#pragma unroll
                for (int i = 0; i < 4; ++i) if (key[i] == best) key[i] = 0ull;
                if (lane == 0) flg[jsel] |= (1u << tok);
            }
        }
#else
        {
            unsigned long long key[4][4];
#pragma unroll
            for (int tok = 0; tok < 4; ++tok) { const int cur = (t0 + tok) >> 6;
#pragma unroll
                for (int i = 0; i < 4; ++i) { const int j = lane + 64 * i; unsigned long long k = 0ull;
                    if (j <= cur) { const bool forced = (j == 0) || (j == cur) || (j == cur - 1); const unsigned vb = forced ? 0x7F800000u : __float_as_uint(imp[tok * 260 + j]); k = ((unsigned long long)vb << 32) | (unsigned)(0xFFFF - j); }
                    key[tok][i] = k; } }
            for (int itn = 0; itn < 16; ++itn) {
                unsigned long long best[4];
#pragma unroll
                for (int tok = 0; tok < 4; ++tok) { unsigned long long b0 = key[tok][0]; b0 = key[tok][1] > b0 ? key[tok][1] : b0; b0 = key[tok][2] > b0 ? key[tok][2] : b0; b0 = key[tok][3] > b0 ? key[tok][3] : b0; best[tok] = b0; }
#pragma unroll
                for (int tok = 0; tok < 4; ++tok) { best[tok] = dppmax64<0xB1>(best[tok]); best[tok] = dppmax64<0x4E>(best[tok]); best[tok] = dppmax64<0x124>(best[tok]); best[tok] = dppmax64<0x128>(best[tok]); }
#pragma unroll
                for (int o = 16; o <= 32; o <<= 1) {
#pragma unroll
                    for (int tok = 0; tok < 4; ++tok) { const unsigned lo = __shfl_xor((unsigned)best[tok], o), hi = __shfl_xor((unsigned)(best[tok] >> 32), o); const unsigned long long ob = ((unsigned long long)hi << 32) | lo; best[tok] = ob > best[tok] ? ob : best[tok]; }
                }
#pragma unroll
                for (int tok = 0; tok < 4; ++tok) {
                    if (best[tok] != 0ull) {
#pragma unroll
                        for (int i = 0; i < 4; ++i) if (key[tok][i] == best[tok]) key[tok][i] = 0ull;
                        if (lane == 0) flg[0xFFFF - (int)(best[tok] & 0xFFFFu)] |= (1u << tok);
                    }
                }
            }
        }
#endif
        asm volatile("s_waitcnt lgkmcnt(0)" ::: "memory");
        { BranchIt<1> it{ksn + (size_t)fr * 128 + hk * 64 + fq * 8, vsT + ((size_t)hk * 64 + fr) * T_ + fq * 8, flg, tmax >> 6, trow, fr, fq}; run_branch<1>(it, 0, Qf, m, l, O, Pt); }
        branch_finish(l, O, grow, 1, hk, ybp);
        { BranchIt<2> it{kwn + (size_t)fr * 128 + hk * 64 + fq * 8, vwT + ((size_t)hk * 64 + fr) * T_ + fq * 8, nullptr, tmax >> 6, trow, fr, fq}; run_branch<2>(it, t0 - 511 > 0 ? ((t0 - 511) >> 6) : 0, Qf, m, l, O, Pt); }
        branch_finish(l, O, grow, 2, hk, ybp);
    }
    asm volatile("s_waitcnt lgkmcnt(0)" ::: "memory");
    bf16_t* mix = (bf16_t*)(ws + O_HN);
    const float* gn = p.in[12] + (size_t)layer * 512;
    for (int tok = 0; tok < 4; ++tok) {
        const f32x4 a = *(const f32x4*)(yb + tok * 512 + lane * 8), b = *(const f32x4*)(yb + tok * 512 + lane * 8 + 4);
        float ss = a[0] * a[0] + a[1] * a[1] + a[2] * a[2] + a[3] * a[3] + b[0] * b[0] + b[1] * b[1] + b[2] * b[2] + b[3] * b[3];
        ss = wave_sum(ss);
        const float rs = rsqrtf(ss * (1.0f / 512.0f) + 1e-6f);
        const f32x4 g0 = *(const f32x4*)(gn + lane * 8), g1 = *(const f32x4*)(gn + lane * 8 + 4);
        u32x4 w; w.x = pk2(a[0] * rs * g0[0], a[1] * rs * g0[1]); w.y = pk2(a[2] * rs * g0[2], a[3] * rs * g0[3]); w.z = pk2(b[0] * rs * g1[0], b[1] * rs * g1[1]); w.w = pk2(b[2] * rs * g1[2], b[3] * rs * g1[3]);
        *(u32x4*)(mix + (size_t)(t0 + tok) * DM + lane * 8) = w;
    }
    asm volatile("s_waitcnt lgkmcnt(0)" ::: "memory");
}

__device__ void phase_finalize(const Params& p, int layer) {
    unsigned char* ws = p.ws;
    const int wave = tidx() >> 6, lane = tidx() & 63;
    const float* yglu = (const float*)(ws + O_YGLU); const float* go = (const float*)(ws + O_PQKV); const bf16_t* Pz = (const bf16_t*)(ws + O_PZ); bf16_t* mix = (bf16_t*)(ws + O_HN);
    const float* gs = p.in[22] + (size_t)layer * 512 + lane * 8; const float* gg = p.in[26] + (size_t)layer * 128 + (lane & 7) * 16;
    for (int t = blockIdx.x * 8 + wave; t < T_; t += gridDim.x * 8) {
        {
            const f32x4 a = *(const f32x4*)(yglu + (size_t)t * 512 + lane * 8), b = *(const f32x4*)(yglu + (size_t)t * 512 + lane * 8 + 4);
            float ss = a[0] * a[0] + a[1] * a[1] + a[2] * a[2] + a[3] * a[3] + b[0] * b[0] + b[1] * b[1] + b[2] * b[2] + b[3] * b[3];
            ss = wave_sum(ss); const float rs = rsqrtf(ss * (1.0f / 512.0f) + 1e-6f);
            const f32x4 g0 = *(const f32x4*)gs, g1 = *(const f32x4*)(gs + 4);
            u32x4 w; w.x = pk2(a[0] * rs * g0[0], a[1] * rs * g0[1]); w.y = pk2(a[2] * rs * g0[2], a[3] * rs * g0[3]); w.z = pk2(b[0] * rs * g1[0], b[1] * rs * g1[1]); w.w = pk2(b[2] * rs * g1[2], b[3] * rs * g1[3]);
            *(u32x4*)(mix + (size_t)t * DM + 512 + lane * 8) = w;
        }
        {
            f32x4 o[4]; float ss = 0.f;
#pragma unroll
            for (int q = 0; q < 4; ++q) { o[q] = *(const f32x4*)(go + (size_t)t * 1024 + lane * 16 + q * 4); ss += o[q][0] * o[q][0] + o[q][1] * o[q][1] + o[q][2] * o[q][2] + o[q][3] * o[q][3]; }
            ss += __shfl_xor(ss, 1); ss += __shfl_xor(ss, 2); ss += __shfl_xor(ss, 4);
            const float rs = rsqrtf(ss * (1.0f / 128.0f) + 1e-6f);
            const u32x4 z0 = *(const u32x4*)(Pz + (size_t)t * 1024 + lane * 16), z1 = *(const u32x4*)(Pz + (size_t)t * 1024 + lane * 16 + 8);
            float zz[16] = {bflo(z0.x), bfhi(z0.x), bflo(z0.y), bfhi(z0.y), bflo(z0.z), bfhi(z0.z), bflo(z0.w), bfhi(z0.w), bflo(z1.x), bfhi(z1.x), bflo(z1.y), bfhi(z1.y), bflo(z1.z), bfhi(z1.z), bflo(z1.w), bfhi(z1.w)};
            float r[16];
#pragma unroll
            for (int q = 0; q < 4; ++q) { const f32x4 g = *(const f32x4*)(gg + q * 4);
#pragma unroll
                for (int e = 0; e < 4; ++e) r[q * 4 + e] = o[q][e] * rs * g[e] * siluf_(zz[q * 4 + e]); }
            u32x4 w0, w1; w0.x = pk2(r[0], r[1]); w0.y = pk2(r[2], r[3]); w0.z = pk2(r[4], r[5]); w0.w = pk2(r[6], r[7]); w1.x = pk2(r[8], r[9]); w1.y = pk2(r[10], r[11]); w1.z = pk2(r[12], r[13]); w1.w = pk2(r[14], r[15]);
            *(u32x4*)(mix + (size_t)t * DM + 1024 + lane * 16) = w0; *(u32x4*)(mix + (size_t)t * DM + 1024 + lane * 16 + 8) = w1;
        }
    }
}

__device__ void phase_ffn_act(const Params& p, int layer) {
    unsigned char* ws = p.ws;
    const bf16_t* hf = (const bf16_t*)(ws + O_HF); bf16_t* act = (bf16_t*)(ws + O_ACT);
    const float* cw = p.in[30] + (size_t)layer * 3 * NFF; const float* cb = p.in[31] + (size_t)layer * NFF;
    const int nitems = 512 * 688;
    for (int it = blockIdx.x * 512 + tidx(); it < nitems; it += gridDim.x * 512) {
        const int seg = it / 688, cg8 = it - seg * 688, c = cg8 * 8, t0 = seg * 32;
        float w[2][3][8], bb[2][8];
#pragma unroll
        for (int hh = 0; hh < 2; ++hh) {
#pragma unroll
            for (int j = 0; j < 3; ++j) { const f32x4 a = *(const f32x4*)(cw + j * NFF + hh * DFF + c), b = *(const f32x4*)(cw + j * NFF + hh * DFF + c + 4);
                w[hh][j][0] = a[0]; w[hh][j][1] = a[1]; w[hh][j][2] = a[2]; w[hh][j][3] = a[3]; w[hh][j][4] = b[0]; w[hh][j][5] = b[1]; w[hh][j][6] = b[2]; w[hh][j][7] = b[3]; }
            const f32x4 a = *(const f32x4*)(cb + hh * DFF + c), b = *(const f32x4*)(cb + hh * DFF + c + 4);
            bb[hh][0] = a[0]; bb[hh][1] = a[1]; bb[hh][2] = a[2]; bb[hh][3] = a[3]; bb[hh][4] = b[0]; bb[hh][5] = b[1]; bb[hh][6] = b[2]; bb[hh][7] = b[3];
        }
        u32x4 r0[2], r1[2];
#pragma unroll
        for (int hh = 0; hh < 2; ++hh) {
            r0[hh] = (t0 >= 2) ? *(const u32x4*)(hf + (size_t)(t0 - 2) * NFF + hh * DFF + c) : (u32x4){0u, 0u, 0u, 0u};
            r1[hh] = (t0 >= 1) ? *(const u32x4*)(hf + (size_t)(t0 - 1) * NFF + hh * DFF + c) : (u32x4){0u, 0u, 0u, 0u};
        }
        for (int tt = 0; tt < 32; ++tt) {
            const int t = t0 + tt;
            u32x4 r2[2]; float v[2][8];
#pragma unroll
            for (int hh = 0; hh < 2; ++hh) {
                r2[hh] = *(const u32x4*)(hf + (size_t)t * NFF + hh * DFF + c);
                const unsigned a0[4] = {r0[hh].x, r0[hh].y, r0[hh].z, r0[hh].w}, a1[4] = {r1[hh].x, r1[hh].y, r1[hh].z, r1[hh].w}, a2[4] = {r2[hh].x, r2[hh].y, r2[hh].z, r2[hh].w};
#pragma unroll
                for (int e = 0; e < 4; ++e) {
                    v[hh][2 * e]     = bb[hh][2 * e]     + w[hh][0][2 * e]     * bflo(a0[e]) + w[hh][1][2 * e]     * bflo(a1[e]) + w[hh][2][2 * e]     * bflo(a2[e]);
                    v[hh][2 * e + 1] = bb[hh][2 * e + 1] + w[hh][0][2 * e + 1] * bfhi(a0[e]) + w[hh][1][2 * e + 1] * bfhi(a1[e]) + w[hh][2][2 * e + 1] * bfhi(a2[e]);
                }
                r0[hh] = r1[hh]; r1[hh] = r2[hh];
            }
            u32x4 o; o.x = pk2(siluf_(v[0][0]) * v[1][0], siluf_(v[0][1]) * v[1][1]); o.y = pk2(siluf_(v[0][2]) * v[1][2], siluf_(v[0][3]) * v[1][3]);
            o.z = pk2(siluf_(v[0][4]) * v[1][4], siluf_(v[0][5]) * v[1][5]); o.w = pk2(siluf_(v[0][6]) * v[1][6], siluf_(v[0][7]) * v[1][7]);
            *(u32x4*)(act + (size_t)t * DFF + c) = o;
        }
    }
}
#ifdef REPEAT_PHASE
constexpr int NPHT = NPH + 1;
#else
constexpr int NPHT = NPH;
#endif
#ifndef MULTI_LAUNCH
#define MULTI_LAUNCH 0
#endif
__global__ void __launch_bounds__(512) mega(Params p) {
    extern __shared__ __attribute__((aligned(16))) unsigned char smem[];
    cg::grid_group grid = cg::this_grid();
    const int b = blockIdx.x, G = gridDim.x;
    PG8_LAS unsigned char* glds = (PG8_LAS unsigned char*)smem;
    for (int ph = p.ph_lo; ph < p.ph_hi; ++ph) {

        #ifdef REPEAT_PHASE
        const int layer = ph / (NPH + 1), ki = ph % (NPH + 1), rep = (ki == REPEAT_PHASE + 1) ? 1 : 0; int k = ki <= REPEAT_PHASE ? ki : ki - 1;
#else
        const int layer = ph / NPH, rep = 0; int k = ph % NPH;
#endif
#ifdef DBG_ONLY
        if (k != DBG_ONLY) k = 99;
#endif
        typedef unsigned char __attribute__((address_space(1))) gu8_t;
        gu8_t* wsg = (gu8_t*)p.ws; asm volatile("" : "+s"(wsg));
        unsigned char* ws = (unsigned char*)wsg;
        int tid = threadIdx.x; asm volatile("" : "+v"(tid));
        const int wave = tid >> 6;
        bf16_t* hn = (bf16_t*)(ws + O_HN);
        Params q = p; q.ws = ws;
        if (k == 0) {
            if (ph == 0 && rep == 0 && b == 0 && tid < 64) ((unsigned*)(ws + O_CTR))[tid * 16] = 0u;
            phase_convert(q, layer, (float*)smem);
            phase_rmsnorm(layer == 0 ? p.in[0] : p.out, p.in[1] + (size_t)layer * DM, hn, layer == 0 ? p.out : nullptr);
        } else if (k == 1) {
            pg8::Gemm g{hn, (const bf16_t*)(ws + O_WIN), T_, NIN, DM}; pg8::StaticOrder S; S.init(T_, NIN, G, b);
            EpiProj E{(float*)(ws + O_P32), (bf16_t*)(ws + O_PU), (bf16_t*)(ws + O_PQKV), (bf16_t*)(ws + O_PZ)};
            pg8::gemm_phase<EpiProj, pg8::StaticOrder, false>(glds, g, S, E, nullptr);
        } else if (k == 2) {
            for (int it = b; it < 3072; it += G) {
                if (it < 2048) gdn_prep_item(q, layer, it, smem);
                else if (it < 2304) nsa_prep_item(q, layer, it - 2048, (float*)smem);
                else if (it < 2560) s5_passA_wave(q, layer, (it - 2304) * 8 + wave);
                else cmp1_wave_tile(q, layer, (it - 2560) * 8 + wave);
            }
        } else if (k == 3) {
            for (int idx = b * 8 + wave; idx < 4096; idx += G * 8) cmp2_wave_row(q, layer, idx);
            for (int it = b * 8 + wave; it < 2048; it += G * 8) s5_passB_wave(q, layer, it, (bf16_t*)(smem + wave * 4352));
        } else if (k == 4) {
#ifdef REP4_MODE
            const bool do_rec = (rep == 0) || (REP4_MODE == 1), do_glu = (rep == 0), do_nsa = (rep == 0) || (REP4_MODE == 2);
#else
            const bool do_rec = true, do_glu = true, do_nsa = true;
#endif
            if (b < 32) {
#ifndef NO_REC
 if (do_rec) gdn_recurrence(q, b, smem);
#endif
 }
            else if (b < 160 && do_glu) {
                pg8::Gemm g{(const bf16_t*)(ws + O_YGELU), (const bf16_t*)(ws + O_WGLU), T_, 512, 512}; pg8::StaticOrder S; S.init(T_, 512, 128, b - 32);
                EpiGlu E{(const bf16_t*)(ws + O_YGELU), (float*)(ws + O_YGLU)};
                pg8::gemm_phase<EpiGlu, pg8::StaticOrder, false>(glds, g, S, E, nullptr);
            }
            __syncthreads();
            unsigned* ctr = (unsigned*)(ws + O_CTR) + (layer * 2 + rep) * 16;
            volatile int* sidx = (volatile int*)(smem + LDS_BYTES - 16);
#ifndef NO_NSA
            if (do_nsa) for (;;) {
                if (tid == 0) *sidx = (int)atomicAdd(ctr, 1u);
                __syncthreads();
                const int idx = *sidx;
                __syncthreads();
                if (idx >= 512) break;
                nsa_wave_task(q, layer, (511 - idx) * 32 + wave * 4, smem + wave * NSA_WLDS);
            }
#endif
        } else if (k == 5) {
            phase_finalize(q, layer);
        } else if (k == 6) {
            pg8::Gemm g{hn, (const bf16_t*)(ws + O_WOUT), T_, DM, DM}; pg8::StaticOrder S; S.init(T_, DM, G, b);
            EpiResid E{p.out, DM};
            pg8::gemm_phase<EpiResid, pg8::StaticOrder, false>(glds, g, S, E, nullptr);
        } else if (k == 7) {
            phase_rmsnorm(p.out, p.in[28] + (size_t)layer * DM, hn, nullptr);
        } else if (k == 8) {
            pg8::Gemm g{hn, (const bf16_t*)(ws + O_WFIN), T_, NFF, DM}; pg8::StaticOrder S; S.init(T_, NFF, G, b);
            EpiBf E{(bf16_t*)(ws + O_HF), NFF};
            pg8::gemm_phase<EpiBf, pg8::StaticOrder, false>(glds, g, S, E, nullptr);
        } else if (k == 9) {
            phase_ffn_act(q, layer);
        } else if (k == 10) {
            pg8::Gemm g{(const bf16_t*)(ws + O_ACT), (const bf16_t*)(ws + O_WFOUT), T_, DM, DFF}; pg8::StaticOrder S; S.init(T_, DM, G, b);
            EpiResid E{p.out, DM};
            pg8::gemm_phase<EpiResid, pg8::StaticOrder, false>(glds, g, S, E, nullptr);
        }
        __syncthreads();
        if (ph + 1 < p.ph_hi) grid.sync();
    }
}

extern "C" void kernel_launch(void* const* d_in, const int* in_sizes, int n_in, void* d_out, int out_size, void* d_ws, size_t ws_size, hipStream_t stream) {
    static int grid_blocks = 0;
    if (!grid_blocks) {
        if (n_in != 33 || out_size != T_ * DM || ws_size < WS_NEED) { fprintf(stderr, "kernel_launch: unexpected shapes or workspace (%d inputs, out %d, ws %zu < %zu)\n", n_in, out_size, ws_size, (size_t)WS_NEED); grid_blocks = -1; return; }
        int dev = 0, cus = 0, per_cu = 0;
        hipGetDevice(&dev);
        hipDeviceGetAttribute(&cus, hipDeviceAttributeMultiprocessorCount, dev);
        if (hipFuncSetAttribute((const void*)mega, hipFuncAttributeMaxDynamicSharedMemorySize, LDS_BYTES) != hipSuccess) { fprintf(stderr, "kernel_launch: hipFuncSetAttribute failed\n"); grid_blocks = -1; return; }
        hipOccupancyMaxActiveBlocksPerMultiprocessor(&per_cu, (const void*)mega, 512, LDS_BYTES);
        (void)hipGetLastError();
        if (per_cu < 1) per_cu = 1;
        grid_blocks = cus * per_cu; if (grid_blocks > 256) grid_blocks = 256;
        if (grid_blocks < 160) { fprintf(stderr, "kernel_launch: grid %d too small\n", grid_blocks); grid_blocks = -1; return; }
    }
    if (grid_blocks < 0) return;
    Params p{};
    for (int i = 0; i < 33; ++i) p.in[i] = (const float*)d_in[i];
    p.out = (float*)d_out; p.ws = (unsigned char*)d_ws;
#if MULTI_LAUNCH
    for (int ph = 0; ph < 2 * NPHT; ++ph) { p.ph_lo = ph; p.ph_hi = ph + 1; hipLaunchKernelGGL(mega, dim3(grid_blocks), dim3(512), LDS_BYTES, stream, p); }
#else
    p.ph_lo = 0; p.ph_hi = 2 * NPHT;
    void* args[] = {&p};
    hipError_t e = hipLaunchCooperativeKernel((const void*)mega, dim3(grid_blocks), dim3(512), args, LDS_BYTES, stream);
    if (e != hipSuccess) fprintf(stderr, "cooperative launch failed: %s (grid %d)\n", hipGetErrorString(e), grid_blocks);
#endif
}
```

```cpp
#include <hip/hip_runtime.h>
#include <hip/hip_cooperative_groups.h>
#include <cstdio>
namespace cg = cooperative_groups;
__device__ __forceinline__ int tidx() { int t = threadIdx.x; asm volatile("" : "+v"(t)); return t; }
namespace pg8 {
#define PG8_LAS __attribute__((address_space(3)))
typedef unsigned short bf16_t;
typedef short bf16x8 __attribute__((ext_vector_type(8)));
typedef float f32x4 __attribute__((ext_vector_type(4)));
typedef unsigned u32x4 __attribute__((ext_vector_type(4)));
constexpr int BM = 256, BK = 64, HALF = 128, HTB = HALF * BK * 2  , STAGE_BYTES = 8 * HTB, NXCD = 8, WGM = 8;

__host__ __device__ __forceinline__ int lds_byte(int r, int c) { const int st = (r >> 4) * 2 + (c >> 5), rr = r & 15, cc = c & 31, ob = rr * 64 + cc * 2; return st * 1024 + (ob ^ (((ob >> 9) & 1) << 5)); }
__host__ __device__ __forceinline__ void stage_rc(int b, int& R, int& C) { const int st = b / 1024, sb = b % 1024, swz = sb ^ (((sb >> 9) & 1) << 5); R = (st >> 1) * 16 + swz / 64; C = (st & 1) * 32 + (swz % 64) / 2; }
__host__ __device__ __forceinline__ int perm32(int rho) { const int n = rho >> 4, i = rho & 15; return 8 * (i >> 2) + 4 * n + (i & 3); }

struct Unit { int pm, pn; };
struct Gemm { const bf16_t* A; const bf16_t* Bt; int M, N, K; };

struct StaticOrder {
    int nM, nN, nwg, G, c;
    __host__ __device__ void init(int M, int N, int G_, int c_) { nM = M / BM; nN = N / BM; nwg = nM * nN; G = G_; c = c_; }
    __host__ __device__ bool next(int i, Unit& u) const {
        const long L = (long)i * G + c; if (L >= nwg) return false;
        int wgid = (int)L; { const int q = nwg / NXCD, r = nwg % NXCD, xcd = wgid % NXCD, off = wgid / NXCD; wgid = (xcd < r ? xcd * (q + 1) : r * (q + 1) + (xcd - r) * q) + off; }
        const int nig = WGM * nN, gid = wgid / nig, fm = gid * WGM, gsz = (nM - fm) < WGM ? (nM - fm) : WGM;
        u.pm = fm + ((wgid % nig) % gsz); u.pn = (wgid % nig) / gsz; return true;
    }
    __device__ __forceinline__ void a_ready(const Unit&) const {}
    __device__ __forceinline__ void done(const Unit&) const {}
};
__device__ __forceinline__ unsigned cvt_pk_bf16(float lo, float hi) { unsigned r; asm volatile("v_cvt_pk_bf16_f32 %0, %1, %2" : "=v"(r) : "v"(lo), "v"(hi)); return r; }
template <class Epi, class Sched, bool STAMP = false>
__device__ __forceinline__ void gemm_phase(PG8_LAS unsigned char* lds, const Gemm g, const Sched& S, const Epi& E, unsigned long long* stamps) {
    const int tid = tidx(), wid = __builtin_amdgcn_readfirstlane(tid >> 6), lane = tid & 63, wr = wid >> 2, wc = wid & 3, fr = lane & 15, fq = lane >> 4;
    const int K = g.K, nt = K / BK;
    int ts_lo = 0, ts_hi = 0, nts = 0; const unsigned long long rt_entry = STAMP ? (unsigned long long)wall_clock64() : 0ull;
#define PG8_STAMP() do { if (STAMP && wid == 0 && nts < 64) { const unsigned long long _c = (unsigned long long)clock64(); \
        ts_lo = (lane == nts) ? (int)(unsigned)_c : ts_lo; ts_hi = (lane == nts) ? (int)(unsigned)(_c >> 32) : ts_hi; ++nts; } } while (0)
    PG8_STAMP();
    unsigned voffA[2], voffB[2];
#pragma unroll
    for (int i = 0; i < 2; ++i) { int R, C; stage_rc(tid * 16 + i * 8192, R, C); const int Rb = Epi::PERM ? ((R & ~31) + perm32(R & 31)) : R;
        voffA[i] = (unsigned)(R * K + C) * 2u; voffB[i] = (unsigned)(Rb * K + C) * 2u; }
    const size_t kstep = (size_t)(BK * 2);
    const size_t hstep = (size_t)HALF * K * 2;
    const size_t tstep = 2 * hstep;
    const unsigned ldsw = (unsigned)wid * 1024u;
    const int aoff = lds_byte(wr * 64 + fr, fq * 8), boff = lds_byte(wc * 32 + fr, fq * 8);
#define PG8_SA(b, h) (((b) * 2 + (h)) * HTB)
#define PG8_SB(b, h) ((4 + (b) * 2 + (h)) * HTB)
#define PG8_STAGE(bufoff, gbase, voff) do { _Pragma("unroll") for (int _i = 0; _i < 2; ++_i) \
        __builtin_amdgcn_global_load_lds((const unsigned*)((const char*)(gbase) + (voff)[_i]), (PG8_LAS unsigned*)(lds + (bufoff) + ldsw + _i * 8192), 16, 0, 0); } while (0)
#define PG8_LDA(dst, b, h) do { _Pragma("unroll") for (int m = 0; m < 4; ++m) _Pragma("unroll") for (int k = 0; k < 2; ++k) dst[m][k] = *(const PG8_LAS bf16x8*)(lds + PG8_SA(b, h) + aoff + m * 2048 + k * 1024); } while (0)
#define PG8_LDB(dst, b, h) do { _Pragma("unroll") for (int n = 0; n < 2; ++n) _Pragma("unroll") for (int k = 0; k < 2; ++k) dst[n][k] = *(const PG8_LAS bf16x8*)(lds + PG8_SB(b, h) + boff + n * 2048 + k * 1024); } while (0)
#define PG8_MMA(ai, bj, At, Bt) do { __builtin_amdgcn_s_setprio(1); _Pragma("unroll") for (int m = 0; m < 4; ++m) _Pragma("unroll") for (int n = 0; n < 2; ++n) _Pragma("unroll") for (int k = 0; k < 2; ++k) \
        acc[ai][bj][m][n] = __builtin_amdgcn_mfma_f32_16x16x32_bf16(Bt[n][k], At[m][k], acc[ai][bj][m][n], 0, 0, 0); __builtin_amdgcn_s_setprio(0); } while (0)
#define PG8_WAIT_V(n) asm volatile("s_waitcnt vmcnt(" #n ")" ::: "memory")
#define PG8_WAIT_L(n) asm volatile("s_waitcnt lgkmcnt(" #n ")" ::: "memory")
#define PG8_BAR __builtin_amdgcn_s_barrier()
#define PG8_SCHED __builtin_amdgcn_sched_barrier(0)
    Unit cur, nxt; int ui = 0;
    if (!S.next(0, cur)) return;
    f32x4 acc[2][2][4][2];
#pragma unroll
    for (int a = 0; a < 2; ++a)
#pragma unroll
        for (int b = 0; b < 2; ++b)
#pragma unroll
            for (int m = 0; m < 4; ++m)
#pragma unroll
                for (int n = 0; n < 2; ++n) acc[a][b][m][n] = (f32x4){0.f, 0.f, 0.f, 0.f};
    bf16x8 At[4][2], B0[2][2], B1[2][2];
    const char* cA = (const char*)g.A + (size_t)cur.pm * tstep; const char* cB = (const char*)g.Bt + (size_t)cur.pn * tstep;
    S.a_ready(cur);
    PG8_STAGE(PG8_SB(0, 0), cB, voffB); PG8_STAGE(PG8_SA(0, 0), cA, voffA); PG8_STAGE(PG8_SB(0, 1), cB + hstep, voffB); PG8_STAGE(PG8_SA(0, 1), cA + hstep, voffA);
    if (wr == 1) PG8_BAR;
    PG8_WAIT_V(4); PG8_BAR;
    PG8_STAGE(PG8_SB(1, 0), cB + kstep, voffB); PG8_STAGE(PG8_SA(1, 0), cA + kstep, voffA); PG8_STAGE(PG8_SB(1, 1), cB + hstep + kstep, voffB);
    PG8_WAIT_V(6); PG8_BAR;
    PG8_STAMP();
    for (;;) {
        const bool has_next = S.next(ui + 1, nxt);
        const char* nA = has_next ? (const char*)g.A + (size_t)nxt.pm * tstep : cA; const char* nB = has_next ? (const char*)g.Bt + (size_t)nxt.pn * tstep : cB;
        for (int t = 0; t < nt; t += 2) {
            const bool last = (t == nt - 2);
            const char* a1 = cA + (size_t)(t + 1) * kstep;
            const char* a2 = last ? nA : cA + (size_t)(t + 2) * kstep; const char* b2 = last ? nB : cB + (size_t)(t + 2) * kstep;
            const char* a3 = a2 + kstep; const char* b3 = b2 + kstep;
            if (last && has_next) S.a_ready(nxt);
            PG8_LDB(B0, 0, 0); PG8_SCHED; PG8_LDA(At, 0, 0); PG8_STAGE(PG8_SA(1, 1), a1 + hstep, voffA);
            PG8_WAIT_L(8); PG8_BAR; PG8_WAIT_L(0); PG8_MMA(0, 0, At, B0); PG8_BAR; PG8_SCHED;
            PG8_LDB(B1, 0, 1); PG8_STAGE(PG8_SB(0, 0), b2, voffB);
            PG8_BAR; PG8_WAIT_L(0); PG8_MMA(0, 1, At, B1); PG8_BAR;
            PG8_LDA(At, 0, 1); PG8_STAGE(PG8_SA(0, 0), a2, voffA);
            PG8_BAR; PG8_WAIT_L(0); PG8_MMA(1, 0, At, B0); PG8_BAR; PG8_SCHED;
            PG8_STAGE(PG8_SB(0, 1), b2 + hstep, voffB);
            PG8_WAIT_V(6); PG8_BAR; PG8_MMA(1, 1, At, B1); PG8_BAR;
            PG8_LDB(B0, 1, 0); PG8_SCHED; PG8_LDA(At, 1, 0); PG8_STAGE(PG8_SA(0, 1), a2 + hstep, voffA);
            PG8_WAIT_L(8); PG8_BAR; PG8_WAIT_L(0); PG8_MMA(0, 0, At, B0); PG8_BAR; PG8_SCHED;
            PG8_LDB(B1, 1, 1); PG8_STAGE(PG8_SB(1, 0), b3, voffB);
            PG8_BAR; PG8_WAIT_L(0); PG8_MMA(0, 1, At, B1); PG8_BAR;
            PG8_LDA(At, 1, 1); PG8_STAGE(PG8_SA(1, 0), a3, voffA);
            PG8_BAR; PG8_WAIT_L(0); PG8_MMA(1, 0, At, B0); PG8_BAR; PG8_SCHED;
            PG8_STAGE(PG8_SB(1, 1), b3 + hstep, voffB);
            PG8_WAIT_V(6); PG8_BAR; PG8_MMA(1, 1, At, B1); PG8_BAR;
        }
        PG8_STAMP();
        if constexpr (!Epi::AFTER_DRAIN) { E(acc, cur, wr, wc, fr, fq); S.done(cur); }
        PG8_STAMP();
        if (!has_next) break;
#pragma unroll
        for (int a = 0; a < 2; ++a)
#pragma unroll
            for (int b = 0; b < 2; ++b)
#pragma unroll
                for (int m = 0; m < 4; ++m)
#pragma unroll
                    for (int n = 0; n < 2; ++n) acc[a][b][m][n] = (f32x4){0.f, 0.f, 0.f, 0.f};
        cur = nxt; cA = nA; cB = nB; ++ui;
    }
    PG8_WAIT_V(0);
    if (wr == 0) PG8_BAR;
    PG8_BAR;
    if constexpr (Epi::AFTER_DRAIN) { E.fused(acc, cur, wr, wc, fr, fq, lds, wid, lane); S.done(cur); }
    PG8_STAMP();
    if (STAMP && wid == 0) { stamps[lane] = lane < nts ? (((unsigned long long)(unsigned)ts_hi << 32) | (unsigned)ts_lo) : 0ull;
        if (lane == 62) stamps[62] = rt_entry; if (lane == 63) stamps[63] = (unsigned long long)wall_clock64(); }
#undef PG8_STAMP
#undef PG8_SA
#undef PG8_SB
#undef PG8_STAGE
#undef PG8_LDA
#undef PG8_LDB
#undef PG8_MMA
#undef PG8_WAIT_V
#undef PG8_WAIT_L
#undef PG8_BAR
#undef PG8_SCHED
}
}
#define XB_TMO      128
#define XB_XCNT(j)  (256  + 64 * (j))
#define XB_XSUB(j)  (1280 + 64 * (j))
#define XB_XGEN(j)  (2304 + 64 * (j))
#define XB_TOP      3328
#define XB_TOPGEN   3392
#define XCD_BAR_WORDS 3456
#define XB_SPIN_CAP (1u << 18)
#define XB_LAS __attribute__((address_space(3)))

__device__ __forceinline__ unsigned xb_ld(unsigned* p)              { return __hip_atomic_load(p, __ATOMIC_RELAXED, __HIP_MEMORY_SCOPE_AGENT); }
__device__ __forceinline__ unsigned xb_add(unsigned* p, unsigned v) { return __hip_atomic_fetch_add(p, v, __ATOMIC_RELAXED, __HIP_MEMORY_SCOPE_AGENT); }
__device__ __forceinline__ unsigned xb_xcc_id() { return (unsigned)__builtin_amdgcn_s_getreg((3 << 11) | 20) & 0xFu; }
#define XB_SPIN(cond, bar) do { unsigned _sp = 0; while (cond) { __builtin_amdgcn_s_sleep(1); \
    if ((++_sp & 255u) == 0u) { if (xb_ld(&(bar)[XB_TMO])) break; if (_sp > XB_SPIN_CAP) { atomicAdd(&(bar)[XB_TMO], 1u); break; } } } } while (0)

struct XcdBarrier {
    unsigned* bar; unsigned x;
    volatile XB_LAS unsigned* st;
};

__device__ __forceinline__ XcdBarrier xcd_barrier_post(unsigned* bar, volatile XB_LAS unsigned* st) {
    XcdBarrier b; b.bar = bar; b.x = xb_xcc_id(); b.st = st;
    if (threadIdx.x == 0) (void)xb_add(&bar[XB_XCNT(b.x)], 1u);
    return b;
}
__device__ __forceinline__ void xcd_barrier_complete(unsigned* bar, unsigned x, unsigned& nloc, unsigned& nx) {
    const unsigned G = gridDim.x * gridDim.y * gridDim.z;
    unsigned sum, cnt, mine, sp = 0u;
    for (;;) {
        sum = 0u; cnt = 0u; mine = 0u;
#pragma unroll
        for (unsigned j = 0; j < 16; ++j) { const unsigned c = xb_ld(&bar[XB_XCNT(j)]); sum += c; cnt += (c > 0u) ? 1u : 0u; mine = (j == x) ? c : mine; }
        if (sum == G) break;
        __builtin_amdgcn_s_sleep(1);
        if ((++sp & 255u) == 0u) { if (xb_ld(&bar[XB_TMO])) break; if (sp > XB_SPIN_CAP) { atomicAdd(&bar[XB_TMO], 1u); break; } }
    }
    nloc = mine > 0u ? mine : 1u; nx = cnt > 0u ? cnt : 1u;
}

__device__ __forceinline__ void xcd_barrier(const XcdBarrier& b) {
    asm volatile("s_waitcnt vmcnt(0)" ::: "memory");
    __syncthreads();
    if (threadIdx.x == 0) {
        unsigned* bar = b.bar;
        __builtin_amdgcn_s_waitcnt(0);
        unsigned nloc = b.st[0], nx = b.st[1];
        if (nloc == 0u) { xcd_barrier_complete(bar, b.x, nloc, nx); b.st[0] = nloc; b.st[1] = nx; }
        const unsigned old = xb_add(&bar[XB_XSUB(b.x)], 1u);
        const unsigned gen = old / nloc;
        if (old + 1u == (gen + 1u) * nloc) {
            __builtin_amdgcn_fence(__ATOMIC_RELEASE, "agent");
            asm volatile("s_waitcnt vmcnt(0)" ::: "memory");
            const unsigned og = xb_add(&bar[XB_TOP], 1u);
            const unsigned tg = og / nx;
            if (og + 1u == (tg + 1u) * nx) xb_add(&bar[XB_TOPGEN], 1u);
            else XB_SPIN(xb_ld(&bar[XB_TOPGEN]) == tg, bar);
            __builtin_amdgcn_fence(__ATOMIC_ACQUIRE, "agent");
            xb_add(&bar[XB_XGEN(b.x)], 1u);
            asm volatile("s_waitcnt vmcnt(0)" ::: "memory");
        } else {
            XB_SPIN(xb_ld(&bar[XB_XGEN(b.x)]) == gen, bar);
            __builtin_amdgcn_fence(__ATOMIC_ACQUIRE, "agent");
            asm volatile("s_waitcnt vmcnt(0)" ::: "memory");
        }
    }
    __syncthreads();
}
using pg8::bf16_t; using pg8::bf16x8; using pg8::f32x4; using pg8::u32x4; using pg8::Unit;
typedef unsigned u32x2 __attribute__((ext_vector_type(2)));
#define MFMA16(a, b, c) __builtin_amdgcn_mfma_f32_16x16x32_bf16((a), (b), (c), 0, 0, 0)

constexpr int T_ = 16384, DM = 2048, NIN = 6144, DFF = 5504, NFF = 11008;
constexpr int LDS_BYTES = 144 * 1024;
constexpr int NPH = 11;

constexpr size_t O_CTR   = 0;
constexpr size_t O_BAR   = 4096;
constexpr size_t O_WIN   = 4096 + 16384;
constexpr size_t O_WOUT  = O_WIN   + (size_t)NIN * DM * 2;
constexpr size_t O_WFIN  = O_WOUT  + (size_t)DM * DM * 2;
constexpr size_t O_WFOUT = O_WFIN  + (size_t)NFF * DM * 2;
constexpr size_t O_WCK   = O_WFOUT + (size_t)DM * DFF * 2;
constexpr size_t O_WCV   = O_WCK   + (size_t)256 * 2048 * 2;
constexpr size_t O_WGLU  = O_WCV   + (size_t)256 * 2048 * 2;
constexpr size_t O_HN    = O_WGLU  + (size_t)512 * 512 * 2;
constexpr size_t O_R     = O_HN    + (size_t)T_ * DM * 2;
constexpr size_t O_P32   = O_R;
constexpr size_t O_PU    = O_P32   + (size_t)T_ * 1536 * 4;
constexpr size_t O_PQKV  = O_PU    + (size_t)T_ * 512 * 2;
constexpr size_t O_PZ    = O_PQKV  + (size_t)T_ * 3072 * 2;
constexpr size_t O_QN    = O_PZ    + (size_t)T_ * 1024 * 2;
constexpr size_t O_KSN   = O_QN    + (size_t)T_ * 512 * 2;
constexpr size_t O_KWN   = O_KSN   + (size_t)T_ * 128 * 2;
constexpr size_t O_VST   = O_KWN   + (size_t)T_ * 128 * 2;
constexpr size_t O_VWT   = O_VST   + (size_t)T_ * 128 * 2;
constexpr size_t O_KC    = O_VWT   + (size_t)T_ * 128 * 2;
constexpr size_t O_VCT   = O_KC    + (size_t)2 * 1024 * 64 * 2;
constexpr size_t O_HCMP  = O_VCT   + (size_t)2 * 64 * 1024 * 2;
constexpr size_t O_GKC   = O_HCMP  + (size_t)2 * 2048 * 256 * 4;
constexpr size_t O_GQG   = O_GKC   + (size_t)2048 * 64 * 128 * 2;
constexpr size_t O_GQK   = O_GQG   + (size_t)2048 * 64 * 128 * 2;
constexpr size_t O_GKD   = O_GQK   + (size_t)2048 * 64 * 64 * 2;
constexpr size_t O_GVAL  = O_GKD   + (size_t)2048 * 64 * 128 * 2;
constexpr size_t O_GEGL  = O_GVAL  + (size_t)2048 * 64 * 128 * 4;
constexpr size_t O_XEND  = O_GEGL  + 8192;
constexpr size_t O_YGELU = O_XEND  + (size_t)64 * 32 * 64 * 2 * 4;
constexpr size_t O_YGLU  = O_YGELU + (size_t)T_ * 512 * 2;
constexpr size_t O_ATT_END = O_YGLU + (size_t)T_ * 512 * 4;
constexpr size_t O_HF    = O_R;
constexpr size_t O_ACT   = O_HF    + (size_t)T_ * NFF * 2;
constexpr size_t O_FFN_END = O_ACT + (size_t)T_ * DFF * 2;
constexpr size_t WS_NEED = O_ATT_END > O_FFN_END ? O_ATT_END : O_FFN_END;

struct Params { const float* in[33]; float* out; unsigned char* ws; int ph_lo, ph_hi; };

__device__ __forceinline__ unsigned short f2bf(float f) { unsigned u = __float_as_uint(f); u += 0x7FFFu + ((u >> 16) & 1u); return (unsigned short)(u >> 16); }
__device__ __forceinline__ float bf2f(unsigned short b) { return __uint_as_float(((unsigned)b) << 16); }
__device__ __forceinline__ unsigned pk2(float lo, float hi) { return pg8::cvt_pk_bf16(lo, hi); }
__device__ __forceinline__ float bflo(unsigned w) { return __uint_as_float(w << 16); }
__device__ __forceinline__ float bfhi(unsigned w) { return __uint_as_float(w & 0xFFFF0000u); }
__device__ __forceinline__ float sigmoidf_(float x) { return __builtin_amdgcn_rcpf(1.0f + __expf(-x)); }
__device__ __forceinline__ float siluf_(float x) { return x * __builtin_amdgcn_rcpf(1.0f + __expf(-x)); }
__device__ __forceinline__ float vmaxf(float a, float b) { float r; asm("v_max_f32 %0, %1, %2" : "=v"(r) : "v"(a), "v"(b)); return r; }
__device__ __forceinline__ float gelu_tanh(float x) { const float u = 0.7978845608028654f * (x + 0.044715f * x * x * x); const float th = 1.0f - 2.0f * __builtin_amdgcn_rcpf(__expf(2.0f * u) + 1.0f); return 0.5f * x * (1.0f + th); }
__device__ __forceinline__ float softplusf_(float x) { return x > 20.f ? x : log1pf(expf(x)); }
__device__ __forceinline__ float wave_sum(float v) { for (int o = 32; o >= 1; o >>= 1) v += __shfl_xor(v, o); return v; }
__device__ __forceinline__ bf16x8 pack8f(f32x4 a, f32x4 b) { u32x4 w; w.x = pk2(a[0], a[1]); w.y = pk2(a[2], a[3]); w.z = pk2(b[0], b[1]); w.w = pk2(b[2], b[3]); return __builtin_bit_cast(bf16x8, w); }
__device__ __forceinline__ float rdlane(float v, int l) { return __int_as_float(__builtin_amdgcn_readlane(__float_as_int(v), l)); }

struct EpiProj {
    static constexpr bool PERM = false, AFTER_DRAIN = false;
    float* P32; bf16_t* Pu; bf16_t* Pqkv; bf16_t* Pz;
    static __device__ __forceinline__ void st_bf(const f32x4 (&acc)[2][2][4][2], bf16_t* base, int ld) {
#pragma unroll
        for (int ai = 0; ai < 2; ++ai)
#pragma unroll
            for (int m = 0; m < 4; ++m) { bf16_t* rp = base + (size_t)(ai * 128 + m * 16) * ld;
#pragma unroll
                for (int bj = 0; bj < 2; ++bj)
#pragma unroll
                    for (int n = 0; n < 2; ++n) { const f32x4 v = acc[ai][bj][m][n]; u32x2 w; w.x = pk2(v[0], v[1]); w.y = pk2(v[2], v[3]); *(u32x2*)(rp + bj * 128 + n * 16) = w; } }
    }
    __device__ __forceinline__ void operator()(const f32x4 (&acc)[2][2][4][2], const Unit& u, int wr, int wc, int fr, int fq) const {
        const int row0 = u.pm * 256 + wr * 64 + fr, colt = wc * 32 + 4 * fq;
        if (u.pn < 6) {
            float* base = P32 + (size_t)row0 * 1536 + u.pn * 256 + colt;
#pragma unroll
            for (int ai = 0; ai < 2; ++ai)
#pragma unroll
                for (int m = 0; m < 4; ++m) { float* rp = base + (size_t)(ai * 128 + m * 16) * 1536;
#pragma unroll
                    for (int bj = 0; bj < 2; ++bj)
#pragma unroll
                        for (int n = 0; n < 2; ++n) *(f32x4*)(rp + bj * 128 + n * 16) = acc[ai][bj][m][n]; }
        } else if (u.pn < 8)  st_bf(acc, Pu   + (size_t)row0 * 512  + (u.pn - 6)  * 256 + colt, 512);
        else if (u.pn < 20)   st_bf(acc, Pqkv + (size_t)row0 * 3072 + (u.pn - 8)  * 256 + colt, 3072);
        else                  st_bf(acc, Pz   + (size_t)row0 * 1024 + (u.pn - 20) * 256 + colt, 1024);
    }
};
struct EpiResid {
    static constexpr bool PERM = false, AFTER_DRAIN = false;
    float* X; int ld;
    __device__ __forceinline__ void operator()(const f32x4 (&acc)[2][2][4][2], const Unit& u, int wr, int wc, int fr, int fq) const {
        float* base = X + (size_t)(u.pm * 256 + wr * 64 + fr) * ld + u.pn * 256 + wc * 32 + 4 * fq;
#pragma unroll
        for (int ai = 0; ai < 2; ++ai)
#pragma unroll
            for (int m = 0; m < 4; ++m) { float* rp = base + (size_t)(ai * 128 + m * 16) * ld;
#pragma unroll
                for (int bj = 0; bj < 2; ++bj)
#pragma unroll
                    for (int n = 0; n < 2; ++n) { f32x4* q = (f32x4*)(rp + bj * 128 + n * 16); *q = *q + acc[ai][bj][m][n]; } }
    }
};
struct EpiBf {
    static constexpr bool PERM = false, AFTER_DRAIN = false;
    bf16_t* O; int ld;
    __device__ __forceinline__ void operator()(const f32x4 (&acc)[2][2][4][2], const Unit& u, int wr, int wc, int fr, int fq) const {
        bf16_t* base = O + (size_t)(u.pm * 256 + wr * 64 + fr) * ld + u.pn * 256 + wc * 32 + 4 * fq;
#pragma unroll
        for (int ai = 0; ai < 2; ++ai)
#pragma unroll
            for (int m = 0; m < 4; ++m) { bf16_t* rp = base + (size_t)(ai * 128 + m * 16) * ld;
#pragma unroll
                for (int bj = 0; bj < 2; ++bj)
#pragma unroll
                    for (int n = 0; n < 2; ++n) { const f32x4 v = acc[ai][bj][m][n]; u32x2 w; w.x = pk2(v[0], v[1]); w.y = pk2(v[2], v[3]); *(u32x2*)(rp + bj * 128 + n * 16) = w; } }
    }
};
struct EpiGlu {
    static constexpr bool PERM = false, AFTER_DRAIN = false;
    const bf16_t* Y; float* O;
    __device__ __forceinline__ void operator()(const f32x4 (&acc)[2][2][4][2], const Unit& u, int wr, int wc, int fr, int fq) const {
        const size_t off0 = (size_t)(u.pm * 256 + wr * 64 + fr) * 512 + u.pn * 256 + wc * 32 + 4 * fq;
#pragma unroll
        for (int ai = 0; ai < 2; ++ai)
#pragma unroll
            for (int m = 0; m < 4; ++m) { const size_t ro = off0 + (size_t)(ai * 128 + m * 16) * 512;
#pragma unroll
                for (int bj = 0; bj < 2; ++bj)
#pragma unroll
                    for (int n = 0; n < 2; ++n) { const size_t o = ro + bj * 128 + n * 16; const u32x2 yw = *(const u32x2*)(Y + o); const f32x4 a = acc[ai][bj][m][n];
                        f32x4 r; r[0] = bflo(yw.x) * sigmoidf_(a[0]); r[1] = bfhi(yw.x) * sigmoidf_(a[1]); r[2] = bflo(yw.y) * sigmoidf_(a[2]); r[3] = bfhi(yw.y) * sigmoidf_(a[3]); *(f32x4*)(O + o) = r; } }
    }
};
__device__ __forceinline__ int map_in_col(int n) { return n < 1304 ? n : (n < 1312 ? 5912 + (n - 1304) : (n < 1320 ? 5920 + (n - 1312) : (n < 1536 ? -1 : 1304 + (n - 1536)))); }
__device__ void convT_tile(const float* __restrict__ src, int srcN, int K, bf16_t* __restrict__ dst, int tile, bool inmap, float* sm) {
    const int nk = K >> 6, tk = tile % nk, tn = tile / nk, k0 = tk * 64, n0 = tn * 256;
    const int tid = tidx(), tx = tid & 255, ty = tid >> 8;
    const int n = n0 + tx, sc = inmap ? map_in_col(n) : n;
    float v[32];
#pragma unroll
    for (int i = 0; i < 32; ++i) v[i] = (sc >= 0) ? src[(size_t)(k0 + ty + 2 * i) * srcN + sc] : 0.f;
#pragma unroll
    for (int i = 0; i < 32; ++i) sm[(ty + 2 * i) * 257 + tx] = v[i];
    __syncthreads();
    const int nn = tid >> 1, hf = tid & 1;
    bf16_t* o = dst + (size_t)(n0 + nn) * K + k0 + hf * 32;
#pragma unroll
    for (int q = 0; q < 4; ++q) { u32x4 w; const float* sp = sm + (hf * 32 + q * 8) * 257 + nn;
        w.x = pk2(sp[0], sp[257]); w.y = pk2(sp[2 * 257], sp[3 * 257]); w.z = pk2(sp[4 * 257], sp[5 * 257]); w.w = pk2(sp[6 * 257], sp[7 * 257]); *(u32x4*)(o + q * 8) = w; }
    __syncthreads();
}
__device__ void phase_convert(const Params& p, int layer, float* sm) {
    unsigned char* ws = p.ws;
    const int G = gridDim.x, b = blockIdx.x;
    const int n0 = 32 * 24, n1 = n0 + 32 * 8, n2 = n1 + 32 * 43, n3 = n2 + 86 * 8, n4 = n3 + 32, n5 = n4 + 32, n6 = n5 + 16;
    for (int it = b; it < n6; it += G) {
        if (it < n0)      convT_tile(p.in[2]  + (size_t)layer * DM * 5928, 5928, DM, (bf16_t*)(ws + O_WIN), it, true, sm);
        else if (it < n1) convT_tile(p.in[27] + (size_t)layer * DM * DM, DM, DM, (bf16_t*)(ws + O_WOUT), it - n0, false, sm);
        else if (it < n2) convT_tile(p.in[29] + (size_t)layer * DM * NFF, NFF, DM, (bf16_t*)(ws + O_WFIN), it - n1, false, sm);
        else if (it < n3) convT_tile(p.in[32] + (size_t)layer * DFF * DM, DM, DFF, (bf16_t*)(ws + O_WFOUT), it - n2, false, sm);
        else if (it < n4) convT_tile(p.in[8]  + (size_t)layer * 2048 * 256, 256, 2048, (bf16_t*)(ws + O_WCK), it - n3, false, sm);
        else if (it < n5) convT_tile(p.in[10] + (size_t)layer * 2048 * 256, 256, 2048, (bf16_t*)(ws + O_WCV), it - n4, false, sm);
        else              convT_tile(p.in[21] + (size_t)layer * 512 * 512, 512, 512, (bf16_t*)(ws + O_WGLU), it - n5, false, sm);
    }
}
__device__ void phase_rmsnorm(const float* __restrict__ x, const float* __restrict__ gain, bf16_t* __restrict__ hn, float* __restrict__ xcopy) {
    const int wave = tidx() >> 6, lane = tidx() & 63;
    for (int r = blockIdx.x * 8 + wave; r < T_; r += gridDim.x * 8) {
        const f32x4* xr = (const f32x4*)(x + (size_t)r * DM);
        f32x4 v[8]; float ss = 0.f;
#pragma unroll
        for (int i = 0; i < 8; ++i) { v[i] = xr[lane + 64 * i]; ss += v[i][0] * v[i][0] + v[i][1] * v[i][1] + v[i][2] * v[i][2] + v[i][3] * v[i][3]; }
        ss = wave_sum(ss);
        const float rs = rsqrtf(ss * (1.0f / DM) + 1e-6f);
#pragma unroll
        for (int i = 0; i < 8; ++i) { const f32x4 g = ((const f32x4*)gain)[lane + 64 * i]; u32x2 w; w.x = pk2(v[i][0] * rs * g[0], v[i][1] * rs * g[1]); w.y = pk2(v[i][2] * rs * g[2], v[i][3] * rs * g[3]);
            *(u32x2*)(hn + (size_t)r * DM + (lane + 64 * i) * 4) = w; if (xcopy) ((f32x4*)(xcopy + (size_t)r * DM))[lane + 64 * i] = v[i]; }
    }
}

__device__ void nsa_prep_item(const Params& p, int layer, int item, float* sm) {
    unsigned char* ws = p.ws;
    const float* P32 = (const float*)(ws + O_P32);
    bf16_t* qn = (bf16_t*)(ws + O_QN); bf16_t* ksn = (bf16_t*)(ws + O_KSN); bf16_t* kwn = (bf16_t*)(ws + O_KWN);
    const int wave = tidx() >> 6, lane = tidx() & 63, tid = tidx();
    const int t0 = item * 64;
    const float gq = p.in[3][layer * 64 + lane], gks = p.in[5][layer * 64 + lane], gkw = p.in[6][layer * 64 + lane];
    const float inv = powf(500000.0f, -(float)(lane & 7) * 0.125f);
    for (int tt = 0; tt < 8; ++tt) {
        const int t = t0 + wave * 8 + tt;
        float sn, cs; sincosf((float)t * inv, &sn, &cs);
        const float* row = P32 + (size_t)t * 1536;
#pragma unroll
        for (int hv = 0; hv < 12; ++hv) {
            const int col = hv < 8 ? hv * 64 : (hv < 10 ? 768 + (hv - 8) * 64 : 1024 + (hv - 10) * 64);
            const float g = hv < 8 ? gq : (hv < 10 ? gks : gkw);
            const float x = row[col + lane];
            const float ss = wave_sum(x * x);
            float y = x * rsqrtf(ss * (1.0f / 64.0f) + 1e-6f) * g;
            const float yp = __shfl(y, lane ^ 8);
            if (lane < 8) y = y * cs - yp * sn; else if (lane < 16) y = y * cs + yp * sn;
            if (hv < 8) qn[(size_t)t * 512 + hv * 64 + lane] = f2bf(y * 0.18033688011112042f);
            else if (hv < 10) ksn[(size_t)t * 128 + (hv - 8) * 64 + lane] = f2bf(y);
            else kwn[(size_t)t * 128 + (hv - 10) * 64 + lane] = f2bf(y);
        }
    }
    for (int e = tid; e < 64 * 256; e += 512) { const int tk = e >> 8, c = e & 255; sm[tk * 257 + c] = P32[(size_t)(t0 + tk) * 1536 + (c < 128 ? 896 + c : 1152 + (c - 128))]; }
    __syncthreads();
    bf16_t* vsT = (bf16_t*)(ws + O_VST); bf16_t* vwT = (bf16_t*)(ws + O_VWT);
#pragma unroll
    for (int i = 0; i < 4; ++i) {
        const int rowid = (tid >> 3) + 64 * i, ts = tid & 7;
        u32x4 w; float f[8];
#pragma unroll
        for (int k = 0; k < 8; ++k) { const int cpos = ts * 8 + k; f[k] = sm[((cpos & 3) * 16 + (cpos >> 2)) * 257 + rowid]; }
        w.x = pk2(f[0], f[1]); w.y = pk2(f[2], f[3]); w.z = pk2(f[4], f[5]); w.w = pk2(f[6], f[7]);
        const int rr = rowid & 127;
        bf16_t* dst = (rowid < 128 ? vsT : vwT) + ((size_t)((rr >> 6) * 256 + item) * 64 + (rr & 63)) * 64 + ts * 8;
        *(u32x4*)dst = w;
    }
    __syncthreads();
}

__device__ void cmp1_wave_tile(const Params& p, int layer, int tile) {
    unsigned char* ws = p.ws;
    const float* P32 = (const float*)(ws + O_P32);
    const int lane = tidx() & 63, fr = lane & 15, fq = lane >> 4;
    const int nt = tile & 15, mt = (tile >> 4) & 127, which = tile >> 11;
    const bf16_t* Wt = (const bf16_t*)(ws + (which ? O_WCV : O_WCK)) + (size_t)(nt * 16 + fr) * 2048 + fq * 8;
    const float* pe = p.in[7] + (size_t)layer * 2048;
    const int r = mt * 16 + fr, n = r >> 1, hk = r & 1;
    const bool rv = n < 1023;
    const float* arow = P32 + (size_t)(16 * (rv ? n : 0)) * 1536 + (which ? 640 : 512) + hk * 64 + fq * 8;
    f32x4 acc = {0.f, 0.f, 0.f, 0.f};
#pragma unroll 4
    for (int ks = 0; ks < 64; ++ks) {
        const int l = ks >> 1, d = (ks & 1) * 32;
        const f32x4* ap = (const f32x4*)(arow + (size_t)l * 1536 + d);
        const f32x4* pp = (const f32x4*)(pe + l * 64 + d + fq * 8);
        f32x4 a0 = ap[0] + pp[0], a1 = ap[1] + pp[1];
        if (!rv) { a0 = (f32x4){0.f, 0.f, 0.f, 0.f}; a1 = a0; }
        const bf16x8 af = pack8f(a0, a1);
        const bf16x8 bf = *(const bf16x8*)(Wt + ks * 32);
        acc = MFMA16(af, bf, acc);
    }
    float* H = (float*)(ws + O_HCMP) + (size_t)which * 2048 * 256;
#pragma unroll
    for (int j = 0; j < 4; ++j) H[(size_t)(mt * 16 + fq * 4 + j) * 256 + nt * 16 + fr] = gelu_tanh(acc[j]);
}
__device__ void cmp2_wave_row(const Params& p, int layer, int idx) {
    unsigned char* ws = p.ws;
    const int lane = tidx() & 63;
    const int which = idx >> 11, r = idx & 2047, n = r >> 1, hk = r & 1;
    const float* H = (const float*)(ws + O_HCMP) + ((size_t)which * 2048 + r) * 256;
    const float* w2 = p.in[which ? 11 : 9] + (size_t)layer * 256 * 64;
    float acc = 0.f;
    if (n < 1023) {
#pragma unroll 8
        for (int f = 0; f < 256; ++f) acc += H[f] * w2[f * 64 + lane];
    }
    if (which == 0) {
        const float ss = wave_sum(acc * acc);
        float y = acc * rsqrtf(ss * (1.0f / 64.0f) + 1e-6f) * p.in[4][layer * 64 + lane];
        const float inv = powf(500000.0f, -(float)(lane & 7) * 0.125f);
        float sn, cs; sincosf((float)(16 * n + 16) * inv, &sn, &cs);
        const float yp = __shfl(y, lane ^ 8);
        if (lane < 8) y = y * cs - yp * sn; else if (lane < 16) y = y * cs + yp * sn;
        if (n >= 1023) y = 0.f;
        ((bf16_t*)(ws + O_KC))[((size_t)hk * 1024 + n) * 64 + lane] = f2bf(y);
    } else {
        ((bf16_t*)(ws + O_VCT))[((size_t)(hk * 16 + (n >> 6)) * 64 + lane) * 64 + (((n & 15) << 2) | ((n >> 4) & 3))] = f2bf(acc);
    }
}

struct S5Coef { float ar, ai; float bbr[16], bbi[16]; };
__device__ __forceinline__ void s5_setup(const Params& p, int layer, int g, int lane, S5Coef& c) {
    const int gp = layer * 2048 + g * 64 + lane;
    const float dt = expf(p.in[15][layer * 32 + g]);
    const float lr = p.in[13][gp], li = p.in[14][gp];
    const float mag = expf(lr * dt); float sn, cs; sincosf(li * dt, &sn, &cs);
    c.ar = mag * cs; c.ai = mag * sn;
    const float den = lr * lr + li * li, nr = c.ar - 1.0f, ni = c.ai;
    const float cr = (nr * lr + ni * li) / den, ci = (ni * lr - nr * li) / den;
    const f32x4* br = (const f32x4*)(p.in[16] + (size_t)gp * 16); const f32x4* bi = (const f32x4*)(p.in[17] + (size_t)gp * 16);
#pragma unroll
    for (int q = 0; q < 4; ++q) { const f32x4 a = br[q], b = bi[q];
#pragma unroll
        for (int e = 0; e < 4; ++e) { c.bbr[q * 4 + e] = cr * a[e] - ci * b[e]; c.bbi[q * 4 + e] = cr * b[e] + ci * a[e]; } }
}
__device__ __forceinline__ void s5_load_u(const bf16_t* Pu, int tok, int g, float (&ur)[16]) {
    const u32x4* s = (const u32x4*)(Pu + (size_t)tok * 512 + g * 16); const u32x4 a = s[0], b = s[1];
    ur[0] = bflo(a.x); ur[1] = bfhi(a.x); ur[2] = bflo(a.y); ur[3] = bfhi(a.y); ur[4] = bflo(a.z); ur[5] = bfhi(a.z); ur[6] = bflo(a.w); ur[7] = bfhi(a.w);
    ur[8] = bflo(b.x); ur[9] = bfhi(b.x); ur[10] = bflo(b.y); ur[11] = bfhi(b.y); ur[12] = bflo(b.z); ur[13] = bfhi(b.z); ur[14] = bflo(b.w); ur[15] = bfhi(b.w);
}
__device__ void s5_passA_wave(const Params& p, int layer, int item) {
    unsigned char* ws = p.ws; const bf16_t* Pu = (const bf16_t*)(ws + O_PU);
    const int lane = tidx() & 63, c = item >> 5, g = item & 31;
    S5Coef k; s5_setup(p, layer, g, lane, k);
    float xr = 0.f, xi = 0.f;
    for (int sub = 0; sub < 4; ++sub) {
        float ur[16]; s5_load_u(Pu, c * 256 + sub * 64 + lane, g, ur);
        for (int j = 0; j < 64; ++j) {
            float bur = 0.f, bui = 0.f;
#pragma unroll
            for (int h = 0; h < 16; ++h) { const float u = rdlane(ur[h], j); bur += k.bbr[h] * u; bui += k.bbi[h] * u; }
            const float nxr = k.ar * xr - k.ai * xi + bur, nxi = k.ar * xi + k.ai * xr + bui; xr = nxr; xi = nxi;
        }
    }
    float* xe = (float*)(ws + O_XEND) + ((size_t)(c * 32 + g) * 64 + lane) * 2; xe[0] = xr; xe[1] = xi;
}
__device__ void s5_passB_wave(const Params& p, int layer, int item, bf16_t* xl) {
    unsigned char* ws = p.ws; const bf16_t* Pu = (const bf16_t*)(ws + O_PU); bf16_t* yg = (bf16_t*)(ws + O_YGELU);
    const int lane = tidx() & 63, fr = lane & 15, fq = lane >> 4, c = item >> 5, g = item & 31;
    S5Coef k; s5_setup(p, layer, g, lane, k);
    float pr = k.ar, pi = k.ai;
#pragma unroll
    for (int s = 0; s < 8; ++s) { const float nr = pr * pr - pi * pi, ni = 2.f * pr * pi; pr = nr; pi = ni; }
    float xr = 0.f, xi = 0.f;
    const float* xe = (const float*)(ws + O_XEND) + ((size_t)g * 64 + lane) * 2;
    for (int cc = 0; cc < c; ++cc) { const float er = xe[(size_t)cc * 32 * 64 * 2], ei = xe[(size_t)cc * 32 * 64 * 2 + 1]; const float nr = pr * xr - pi * xi + er, ni = pr * xi + pi * xr + ei; xr = nr; xi = ni; }
    bf16x8 cf[4];
    {
        const float* cre = p.in[18] + (size_t)layer * 32 * 16 * 64 + ((size_t)g * 16 + fr) * 64; const float* cim = p.in[19] + (size_t)layer * 32 * 16 * 64 + ((size_t)g * 16 + fr) * 64;
#pragma unroll
        for (int ks = 0; ks < 4; ++ks) { const float* s = (ks < 2 ? cre : cim) + (ks & 1) * 32 + fq * 8; f32x4 a = ((const f32x4*)s)[0], b = ((const f32x4*)s)[1]; if (ks >= 2) { a = -a; b = -b; } cf[ks] = pack8f(a, b); }
    }
    const float dsk = p.in[20][layer * 512 + g * 16 + fr];
    for (int sub = 0; sub < 4; ++sub) {
        const int tb = c * 256 + sub * 64;
        float ur[16]; s5_load_u(Pu, tb + lane, g, ur);
        for (int jb = 0; jb < 4; ++jb) {
            for (int jj = 0; jj < 16; ++jj) {
                const int j = jb * 16 + jj;
                float bur = 0.f, bui = 0.f;
#pragma unroll
                for (int h = 0; h < 16; ++h) { const float u = rdlane(ur[h], j); bur += k.bbr[h] * u; bui += k.bbi[h] * u; }
                const float nxr = k.ar * xr - k.ai * xi + bur, nxi = k.ar * xi + k.ai * xr + bui; xr = nxr; xi = nxi;
                xl[jj * 136 + lane] = f2bf(xr); xl[jj * 136 + 64 + lane] = f2bf(xi);
            }
            asm volatile("s_waitcnt lgkmcnt(0)" ::: "memory");
            f32x4 y = {0.f, 0.f, 0.f, 0.f};
#pragma unroll
            for (int ks = 0; ks < 4; ++ks) { const bf16x8 af = *(const bf16x8*)(xl + fr * 136 + ks * 32 + fq * 8); y = MFMA16(af, cf[ks], y); }
            asm volatile("s_waitcnt lgkmcnt(0)" ::: "memory");
#pragma unroll
            for (int q = 0; q < 4; ++q) { const int tok = tb + jb * 16 + fq * 4 + q; const float u = bf2f(Pu[(size_t)tok * 512 + g * 16 + fr]); yg[(size_t)tok * 512 + g * 16 + fr] = f2bf(gelu_tanh(y[q] + dsk * u)); }
        }
    }
}
__device__ void gdn_prep_item(const Params& p, int layer, int item, unsigned char* lds) {
    unsigned char* ws = p.ws;
    const int tid = tidx(), wave = tid >> 6, lane = tid & 63, fr = lane & 15, fq = lane >> 4;
    const int n = item >> 3, h = item & 7, t0 = n * 64;
    bf16_t* qs = (bf16_t*)(lds); bf16_t* ks = (bf16_t*)(lds + 17408); bf16_t* vbT = (bf16_t*)(lds + 34816); bf16_t* kgT = (bf16_t*)(lds + 53248); bf16_t* kdT = (bf16_t*)(lds + 71680);
    float* Am = (float*)(lds + 90112); bf16_t* Tb = (bf16_t*)(lds + 107520); float* gcs = (float*)(lds + 116736); float* bts = (float*)(lds + 116992);
    const float* P32 = (const float*)(ws + O_P32); const bf16_t* Pqkv = (const bf16_t*)(ws + O_PQKV);
    if (wave == 0) {
        const int t = t0 + lane;
        const float a = P32[(size_t)t * 1536 + 1304 + h], b = P32[(size_t)t * 1536 + 1312 + h];
        const float g = -expf(p.in[24][layer * 8 + h]) * softplusf_(a + p.in[25][layer * 8 + h]);
        float s = g;
#pragma unroll
        for (int off = 1; off < 64; off <<= 1) { const float o = __shfl_up(s, off); if (lane >= off) s += o; }
        gcs[lane] = s; bts[lane] = sigmoidf_(b);
    }
    __syncthreads();
    {
        const int r = tid >> 3, c0 = (tid & 7) * 16;
        const float gcr = gcs[r], btr = bts[r], eg = expf(gcr), ed = expf(gcs[63] - gcr);
        const float* cw = p.in[23] + (size_t)layer * 4 * 3072;
#pragma unroll
        for (int which = 0; which < 3; ++which) {
            const int col = which * 1024 + h * 128 + c0;
            float acc[16];
#pragma unroll
            for (int e = 0; e < 16; ++e) acc[e] = 0.f;
#pragma unroll
            for (int j = 0; j < 4; ++j) {
                const int tr = t0 + r - 3 + j;
                if (tr >= 0) {
                    const u32x4* s = (const u32x4*)(Pqkv + (size_t)tr * 3072 + col); const u32x4 a = s[0], b = s[1];
                    const f32x4* wp = (const f32x4*)(cw + j * 3072 + col); const f32x4 w0 = wp[0], w1 = wp[1], w2 = wp[2], w3 = wp[3];
                    acc[0] += w0[0] * bflo(a.x); acc[1] += w0[1] * bfhi(a.x); acc[2] += w0[2] * bflo(a.y); acc[3] += w0[3] * bfhi(a.y);
                    acc[4] += w1[0] * bflo(a.z); acc[5] += w1[1] * bfhi(a.z); acc[6] += w1[2] * bflo(a.w); acc[7] += w1[3] * bfhi(a.w);
                    acc[8] += w2[0] * bflo(b.x); acc[9] += w2[1] * bfhi(b.x); acc[10] += w2[2] * bflo(b.y); acc[11] += w2[3] * bfhi(b.y);
                    acc[12] += w3[0] * bflo(b.z); acc[13] += w3[1] * bfhi(b.z); acc[14] += w3[2] * bflo(b.w); acc[15] += w3[3] * bfhi(b.w);
                }
            }
            float ss = 0.f;
#pragma unroll
            for (int e = 0; e < 16; ++e) { acc[e] = siluf_(acc[e]); ss += acc[e] * acc[e]; }
            ss += __shfl_xor(ss, 1); ss += __shfl_xor(ss, 2); ss += __shfl_xor(ss, 4);
            const float rn = rsqrtf(ss + 1e-6f);
            if (which == 0) {
                bf16_t* qg = (bf16_t*)(ws + O_GQG) + (size_t)item * 8192 + r * 128 + c0;
                float v[16];
#pragma unroll
                for (int e = 0; e < 16; ++e) v[e] = acc[e] * rn * 0.08838834764831845f;
                u32x4 w0, w1; w0.x = pk2(v[0], v[1]); w0.y = pk2(v[2], v[3]); w0.z = pk2(v[4], v[5]); w0.w = pk2(v[6], v[7]); w1.x = pk2(v[8], v[9]); w1.y = pk2(v[10], v[11]); w1.z = pk2(v[12], v[13]); w1.w = pk2(v[14], v[15]);
                *(u32x4*)(qs + r * 136 + c0) = w0; *(u32x4*)(qs + r * 136 + c0 + 8) = w1;
                u32x4 g0, g1; g0.x = pk2(v[0] * eg, v[1] * eg); g0.y = pk2(v[2] * eg, v[3] * eg); g0.z = pk2(v[4] * eg, v[5] * eg); g0.w = pk2(v[6] * eg, v[7] * eg);
                g1.x = pk2(v[8] * eg, v[9] * eg); g1.y = pk2(v[10] * eg, v[11] * eg); g1.z = pk2(v[12] * eg, v[13] * eg); g1.w = pk2(v[14] * eg, v[15] * eg);
                *(u32x4*)qg = g0; *(u32x4*)(qg + 8) = g1;
            } else if (which == 1) {
                float v[16];
#pragma unroll
                for (int e = 0; e < 16; ++e) v[e] = acc[e] * rn;
                u32x4 w0, w1; w0.x = pk2(v[0], v[1]); w0.y = pk2(v[2], v[3]); w0.z = pk2(v[4], v[5]); w0.w = pk2(v[6], v[7]); w1.x = pk2(v[8], v[9]); w1.y = pk2(v[10], v[11]); w1.z = pk2(v[12], v[13]); w1.w = pk2(v[14], v[15]);
                *(u32x4*)(ks + r * 136 + c0) = w0; *(u32x4*)(ks + r * 136 + c0 + 8) = w1;
#pragma unroll
                for (int e = 0; e < 16; ++e) { kgT[(c0 + e) * 72 + r] = f2bf(v[e] * btr * eg); kdT[(c0 + e) * 72 + r] = f2bf(v[e] * ed); }
            } else {
#pragma unroll
                for (int e = 0; e < 16; ++e) vbT[(c0 + e) * 72 + r] = f2bf(acc[e] * btr);
            }
        }
    }
    __syncthreads();
    {
        const int d = tid >> 2, sg = tid & 3;
        const u32x4 a = *(const u32x4*)(kdT + d * 72 + sg * 16), b = *(const u32x4*)(kdT + d * 72 + sg * 16 + 8);
        bf16_t* dst = (bf16_t*)(ws + O_GKD) + (size_t)item * 8192 + d * 64 + sg * 16; *(u32x4*)dst = a; *(u32x4*)(dst + 8) = b;
    }
    { float* Tmz = (float*)(lds + 117248); for (int e2 = tid; e2 < 64 * 68; e2 += 512) Tmz[e2] = 0.f; }
    {
        const int mi = wave >> 1;
        bf16_t* qko = (bf16_t*)(ws + O_GQK) + (size_t)item * 4096;
#pragma unroll
        for (int q = 0; q < 2; ++q) {
            const int nj = (wave & 1) * 2 + q;
            f32x4 kk = {0.f, 0.f, 0.f, 0.f}, qk = {0.f, 0.f, 0.f, 0.f};
            if (nj <= mi) {
#pragma unroll
                for (int s = 0; s < 4; ++s) {
                    const bf16x8 bk = *(const bf16x8*)(ks + (nj * 16 + fr) * 136 + s * 32 + fq * 8);
                    const bf16x8 ak = *(const bf16x8*)(ks + (mi * 16 + fr) * 136 + s * 32 + fq * 8);
                    const bf16x8 aq = *(const bf16x8*)(qs + (mi * 16 + fr) * 136 + s * 32 + fq * 8);
                    kk = MFMA16(ak, bk, kk); qk = MFMA16(aq, bk, qk);
                }
            }
            const int j = nj * 16 + fr; const float gj = gcs[j];
#pragma unroll
            for (int e = 0; e < 4; ++e) {
                const int i = mi * 16 + fq * 4 + e;
                const float dec = (j <= i) ? expf(gcs[i] - gj) : 0.f;
                Am[i * 68 + j] = (j < i) ? bts[i] * kk[e] * dec : 0.f;
                qko[i * 64 + j] = f2bf((j <= i) ? qk[e] * dec : 0.f);
            }
        }
    }
    __syncthreads();
    {
        float* Tm = (float*)(lds + 117248); float* Ps = (float*)(lds + 134656) + wave * 320;
        if (wave == 0) {
            const int bo = fq * 16; float t[16];
#pragma unroll
            for (int i = 0; i < 16; ++i) {
                float s = (i == fr) ? 1.f : 0.f;
#pragma unroll
                for (int j = 0; j < i; ++j) s -= Am[(bo + i) * 68 + bo + j] * t[j];
                t[i] = s; Tm[(bo + i) * 68 + bo + fr] = s;
            }
        }
        asm volatile("s_waitcnt lgkmcnt(0)" ::: "memory"); __syncthreads();
#pragma unroll
        for (int d = 1; d < 4; ++d) {
            if (wave < 4 - d) {
                const int bi = wave + d, bj = wave;
                f32x4 Q = {0.f, 0.f, 0.f, 0.f};
                for (int kb = bj; kb < bi; ++kb) {
                    const float* X = Am + (bi * 16) * 68 + kb * 16; const float* Y = Tm + (kb * 16) * 68 + bj * 16;
#pragma unroll
                    for (int s = 0; s < 4; ++s) Q = __builtin_amdgcn_mfma_f32_16x16x4f32(X[fr * 68 + 4 * s + fq], Y[(4 * s + fq) * 68 + fr], Q, 0, 0, 0);
                }
#pragma unroll
                for (int e2 = 0; e2 < 4; ++e2) Ps[(fq * 4 + e2) * 20 + fr] = Q[e2];
                asm volatile("s_waitcnt lgkmcnt(0)" ::: "memory");
                f32x4 R = {0.f, 0.f, 0.f, 0.f};
                const float* X = Tm + (bi * 16) * 68 + bi * 16;
#pragma unroll
                for (int s = 0; s < 4; ++s) R = __builtin_amdgcn_mfma_f32_16x16x4f32(X[fr * 68 + 4 * s + fq], Ps[(4 * s + fq) * 20 + fr], R, 0, 0, 0);
#pragma unroll
                for (int e2 = 0; e2 < 4; ++e2) Tm[(bi * 16 + fq * 4 + e2) * 68 + bj * 16 + fr] = -R[e2];
            }
            asm volatile("s_waitcnt lgkmcnt(0)" ::: "memory"); __syncthreads();
        }
        for (int e2 = tid; e2 < 4096; e2 += 512) { const int r = e2 >> 6, c = e2 & 63; Tb[r * 72 + c] = f2bf(Tm[r * 68 + c]); }
    }
    __syncthreads();
    {
        const int mi = wave & 3;
        const bf16x8 a0 = *(const bf16x8*)(Tb + (mi * 16 + fr) * 72 + fq * 8), a1 = *(const bf16x8*)(Tb + (mi * 16 + fr) * 72 + 32 + fq * 8);
        float* vo = (float*)(ws + O_GVAL) + (size_t)item * 8192; bf16_t* ko = (bf16_t*)(ws + O_GKC) + (size_t)item * 8192;
#pragma unroll
        for (int q = 0; q < 4; ++q) {
            const int nt = (wave >> 2) * 4 + q;
            f32x4 v = {0.f, 0.f, 0.f, 0.f}, kc = {0.f, 0.f, 0.f, 0.f};
            v = MFMA16(a0, *(const bf16x8*)(vbT + (nt * 16 + fr) * 72 + fq * 8), v); v = MFMA16(a1, *(const bf16x8*)(vbT + (nt * 16 + fr) * 72 + 32 + fq * 8), v);
            kc = MFMA16(a0, *(const bf16x8*)(kgT + (nt * 16 + fr) * 72 + fq * 8), kc); kc = MFMA16(a1, *(const bf16x8*)(kgT + (nt * 16 + fr) * 72 + 32 + fq * 8), kc);
#pragma unroll
            for (int e = 0; e < 4; ++e) { const int i = mi * 16 + fq * 4 + e, d = nt * 16 + fr; vo[i * 128 + d] = v[e]; ko[i * 128 + d] = f2bf(kc[e]); }
        }
    }
    if (tid == 0) ((float*)(ws + O_GEGL))[item] = expf(gcs[63]);
    __syncthreads();
}

struct GdnUO { bf16x8 kc[4], qg[4], qk[2]; float val[2][4]; };
struct GdnSU { bf16x8 kd[2][2]; float egl; };
__device__ __forceinline__ void gdn_load_uo(const unsigned char* ws, int item, int mt, int fr, int fq, int dvb, GdnUO& f) {
    const bf16_t* kc = (const bf16_t*)(ws + O_GKC) + (size_t)item * 8192 + (mt * 16 + fr) * 128 + fq * 8;
    const bf16_t* qg = (const bf16_t*)(ws + O_GQG) + (size_t)item * 8192 + (mt * 16 + fr) * 128 + fq * 8;
    const bf16_t* qk = (const bf16_t*)(ws + O_GQK) + (size_t)item * 4096 + (mt * 16 + fr) * 64 + fq * 8;
    const float* vl = (const float*)(ws + O_GVAL) + (size_t)item * 8192 + (mt * 16 + fq * 4) * 128 + dvb + fr;
#pragma unroll
    for (int s = 0; s < 4; ++s) { f.kc[s] = *(const bf16x8*)(kc + s * 32); f.qg[s] = *(const bf16x8*)(qg + s * 32); }
#pragma unroll
    for (int s = 0; s < 2; ++s) f.qk[s] = *(const bf16x8*)(qk + s * 32);
#pragma unroll
    for (int nt = 0; nt < 2; ++nt)
#pragma unroll
        for (int e = 0; e < 4; ++e) f.val[nt][e] = vl[e * 128 + nt * 16];
}
__device__ __forceinline__ void gdn_load_su(const unsigned char* ws, int item, int w4, int fr, int fq, GdnSU& f) {
    const bf16_t* kd = (const bf16_t*)(ws + O_GKD) + (size_t)item * 8192 + (2 * w4 * 16 + fr) * 64 + fq * 8;
#pragma unroll
    for (int s = 0; s < 2; ++s) { f.kd[0][s] = *(const bf16x8*)(kd + s * 32); f.kd[1][s] = *(const bf16x8*)(kd + 16 * 64 + s * 32); }
    f.egl = ((const float*)(ws + O_GEGL))[item];
}
#define GDN_BAR() do { asm volatile("s_waitcnt lgkmcnt(0)" ::: "memory"); __builtin_amdgcn_s_barrier(); asm volatile("" ::: "memory"); } while (0)
__device__ __forceinline__ void gdn_step_uo(const GdnUO& c, bf16_t* Sl, bf16_t* vn, float* go, int n, int h, int mt, int fr, int fq, int dvb) {
    bf16x8 Sb[2][4];
#pragma unroll
    for (int nt = 0; nt < 2; ++nt)
#pragma unroll
        for (int s = 0; s < 4; ++s) Sb[nt][s] = *(const bf16x8*)(Sl + nt * (16 * 136) + fr * 136 + s * 32 + fq * 8);
    f32x4 U[2], O[2];
#pragma unroll
    for (int nt = 0; nt < 2; ++nt) { U[nt] = (f32x4){0.f, 0.f, 0.f, 0.f}; O[nt] = (f32x4){0.f, 0.f, 0.f, 0.f};
#pragma unroll
        for (int s = 0; s < 4; ++s) U[nt] = MFMA16(c.kc[s], Sb[nt][s], U[nt]);
        u32x2 w; w.x = pk2(c.val[nt][0] - U[nt][0], c.val[nt][1] - U[nt][1]); w.y = pk2(c.val[nt][2] - U[nt][2], c.val[nt][3] - U[nt][3]);
        *(u32x2*)(vn + nt * (16 * 72) + fr * 72 + mt * 16 + fq * 4) = w; }
#pragma unroll
    for (int nt = 0; nt < 2; ++nt)
#pragma unroll
        for (int s = 0; s < 4; ++s) O[nt] = MFMA16(c.qg[s], Sb[nt][s], O[nt]);
    GDN_BAR();
#pragma unroll
    for (int nt = 0; nt < 2; ++nt) {
        const bf16x8 V0 = *(const bf16x8*)(vn + nt * (16 * 72) + fr * 72 + fq * 8), V1 = *(const bf16x8*)(vn + nt * (16 * 72) + fr * 72 + 32 + fq * 8);
        O[nt] = MFMA16(c.qk[0], V0, O[nt]); O[nt] = MFMA16(c.qk[1], V1, O[nt]);
#pragma unroll
        for (int e = 0; e < 4; ++e) go[(size_t)(n * 64 + mt * 16 + fq * 4 + e) * 1024 + h * 128 + dvb + nt * 16 + fr] = O[nt][e];
    }
    GDN_BAR();
}
__device__ __forceinline__ void gdn_step_su(const GdnSU& c, f32x4 (&St)[2][2], bf16_t* Sl, const bf16_t* vn, int w4, int fr, int fq) {
    GDN_BAR();
#pragma unroll
    for (int nt = 0; nt < 2; ++nt) {
        const bf16x8 V0 = *(const bf16x8*)(vn + nt * (16 * 72) + fr * 72 + fq * 8), V1 = *(const bf16x8*)(vn + nt * (16 * 72) + fr * 72 + 32 + fq * 8);
#pragma unroll
        for (int q = 0; q < 2; ++q) {
            St[nt][q] = St[nt][q] * c.egl;
            St[nt][q] = MFMA16(V0, c.kd[q][0], St[nt][q]); St[nt][q] = MFMA16(V1, c.kd[q][1], St[nt][q]);
#pragma unroll
            for (int e = 0; e < 4; ++e) Sl[nt * (16 * 136) + (fq * 4 + e) * 136 + (2 * w4 + q) * 16 + fr] = f2bf(St[nt][q][e]);
        }
    }
    GDN_BAR();
}
__device__ void gdn_recurrence(const Params& p, int b, unsigned char* lds) {
    const unsigned char* ws = p.ws;
    const int tid = tidx(), wave = tid >> 6, lane = tid & 63, fr = lane & 15, fq = lane >> 4;
    const int h = b >> 2, dvb = (b & 3) * 32;
    bf16_t* Sl = (bf16_t*)lds; bf16_t* vn = (bf16_t*)(lds + 2 * 16 * 136 * 2);
    float* go = (float*)(p.ws + O_PQKV);
    for (int e = tid; e < 2 * 16 * 136; e += 512) Sl[e] = 0;
    __syncthreads();
    if (wave < 4) {
        const int mt = wave;
        GdnUO f0, f1, f2;
        gdn_load_uo(ws, h, mt, fr, fq, dvb, f0); gdn_load_uo(ws, 8 + h, mt, fr, fq, dvb, f1);
        for (int n = 0; n < 255; n += 3) {
            gdn_load_uo(ws, (n + 2) * 8 + h, mt, fr, fq, dvb, f2); gdn_step_uo(f0, Sl, vn, go, n, h, mt, fr, fq, dvb);
            gdn_load_uo(ws, (n + 3) * 8 + h, mt, fr, fq, dvb, f0); gdn_step_uo(f1, Sl, vn, go, n + 1, h, mt, fr, fq, dvb);
            if (n + 4 < 256) gdn_load_uo(ws, (n + 4) * 8 + h, mt, fr, fq, dvb, f1);
            gdn_step_uo(f2, Sl, vn, go, n + 2, h, mt, fr, fq, dvb);
        }
        gdn_step_uo(f0, Sl, vn, go, 255, h, mt, fr, fq, dvb);
    } else {
        const int w4 = wave - 4;
        f32x4 St[2][2];
#pragma unroll
        for (int a = 0; a < 2; ++a)
#pragma unroll
            for (int c = 0; c < 2; ++c) St[a][c] = (f32x4){0.f, 0.f, 0.f, 0.f};
        GdnSU f0, f1, f2;
        gdn_load_su(ws, h, w4, fr, fq, f0); gdn_load_su(ws, 8 + h, w4, fr, fq, f1);
        for (int n = 0; n < 255; n += 3) {
            gdn_load_su(ws, (n + 2) * 8 + h, w4, fr, fq, f2); gdn_step_su(f0, St, Sl, vn, w4, fr, fq);
            gdn_load_su(ws, (n + 3) * 8 + h, w4, fr, fq, f0); gdn_step_su(f1, St, Sl, vn, w4, fr, fq);
            if (n + 4 < 256) gdn_load_su(ws, (n + 4) * 8 + h, w4, fr, fq, f1);
            gdn_step_su(f2, St, Sl, vn, w4, fr, fq);
        }
        gdn_step_su(f0, St, Sl, vn, w4, fr, fq);
    }
}
struct KVF { bf16x8 k[4][2]; };
__device__ __forceinline__ void kv_load(const bf16_t* kp, int ldk, KVF& f) {
#pragma unroll
    for (int s = 0; s < 4; ++s) { f.k[s][0] = *(const bf16x8*)(kp + (size_t)(s * 16) * ldk); f.k[s][1] = *(const bf16x8*)(kp + (size_t)(s * 16) * ldk + 32); }
}
template <int CTRL> __device__ __forceinline__ float dppf(float v) { return __int_as_float(__builtin_amdgcn_update_dpp(0, __float_as_int(v), CTRL, 0xF, 0xF, true)); }
template <int CTRL> __device__ __forceinline__ unsigned dppu(unsigned v) { return (unsigned)__builtin_amdgcn_update_dpp(0, (int)v, CTRL, 0xF, 0xF, true); }
__device__ __forceinline__ float rmax16(float v) { v = vmaxf(v, dppf<0xB1>(v)); v = vmaxf(v, dppf<0x4E>(v)); v = vmaxf(v, dppf<0x124>(v)); v = vmaxf(v, dppf<0x128>(v)); return v; }
__device__ __forceinline__ float rsum16(float v) { v += dppf<0xB1>(v); v += dppf<0x4E>(v); v += dppf<0x124>(v); v += dppf<0x128>(v); return v; }
template <int CTRL> __device__ __forceinline__ unsigned long long dppmax64(unsigned long long b) { const unsigned lo = dppu<CTRL>((unsigned)b), hi = dppu<CTRL>((unsigned)(b >> 32)); const unsigned long long ob = ((unsigned long long)hi << 32) | lo; return ob > b ? ob : b; }
__device__ __forceinline__ void flash_compute(const bool FAKEV, const bf16x8 (&Qf)[2], KVF& f, const bf16_t* knext, int ldk, const bf16_t* vp, int ldv, unsigned vmask, float (&m)[4], float (&l)[4], f32x4 (&O)[4], bf16_t* Pt, int fr, int fq) {
    f32x4 S[4];
    bf16x8 Vf[4][2];
    __builtin_amdgcn_sched_barrier(0);
#pragma unroll
    for (int dt = 0; dt < 4; ++dt) { if (FAKEV) { Vf[dt][0] = f.k[dt][0]; Vf[dt][1] = f.k[dt][1]; } else { Vf[dt][0] = *(const bf16x8*)(vp + (size_t)(dt * 16) * ldv); Vf[dt][1] = *(const bf16x8*)(vp + (size_t)(dt * 16) * ldv + 32); } }
#pragma unroll
    for (int s = 0; s < 4; ++s) { S[s] = (f32x4){0.f, 0.f, 0.f, 0.f}; S[s] = MFMA16(Qf[0], f.k[s][0], S[s]); S[s] = MFMA16(Qf[1], f.k[s][1], S[s]); }
    if (knext) kv_load(knext, ldk, f);
    float mx[4];
#pragma unroll
    for (int j = 0; j < 4; ++j) { float v = -1e30f;
#pragma unroll
        for (int s = 0; s < 4; ++s) v = ((vmask >> s) & 1u) ? vmaxf(v, S[s][j]) : v;
        mx[j] = rmax16(v); }
#pragma unroll
    for (int j = 0; j < 4; ++j) { const float mn = vmaxf(m[j], mx[j]); const float a = __builtin_amdgcn_exp2f(m[j] - mn); m[j] = mn; l[j] *= a;
#pragma unroll
        for (int dt = 0; dt < 4; ++dt) O[dt][j] *= a; }
#pragma unroll
    for (int j = 0; j < 4; ++j) { float pv[4];
#pragma unroll
        for (int s = 0; s < 4; ++s) { pv[s] = ((vmask >> s) & 1u) ? __builtin_amdgcn_exp2f(S[s][j] - m[j]) : 0.f; l[j] += pv[s]; }
        u32x2 w; w.x = pk2(pv[0], pv[1]); w.y = pk2(pv[2], pv[3]); *(u32x2*)(Pt + (fq * 4 + j) * 72 + fr * 4) = w; }
    asm volatile("s_waitcnt lgkmcnt(0)" ::: "memory");
    const bf16x8 P0 = *(const bf16x8*)(Pt + fr * 72 + fq * 8), P1 = *(const bf16x8*)(Pt + fr * 72 + 32 + fq * 8);
    asm volatile("s_waitcnt lgkmcnt(0)" ::: "memory");
#pragma unroll
    for (int dt = 0; dt < 4; ++dt) { O[dt] = MFMA16(P0, Vf[dt][0], O[dt]); O[dt] = MFMA16(P1, Vf[dt][1], O[dt]); }
    __builtin_amdgcn_sched_barrier(0);
}
template <int BR> struct BranchIt {
    const bf16_t* kb; const bf16_t* vb; const unsigned* flg; int last, trow, fr, fq;
    static constexpr int LDK = BR == 0 ? 64 : 128, LDV = 64;
    __device__ __forceinline__ int next(int from) const {
        if (BR == 1) { int jb = from; while (jb <= last && flg[jb] == 0u) ++jb; return jb <= last ? jb : -1; }
        return from <= last ? from : -1;
    }
    __device__ __forceinline__ void load(int idx, KVF& f) const { kv_load(kb + (size_t)(idx * 64) * LDK, LDK, f); }
    __device__ __forceinline__ const bf16_t* vptr(int idx) const { return vb + (size_t)idx * 4096; }
    __device__ __forceinline__ const bf16_t* kptr(int idx) const { return kb + (size_t)(idx * 64) * LDK; }
    __device__ __forceinline__ unsigned mask(int idx) const {
        unsigned vm = 0; const int key0 = idx * 64;
        if (BR == 0) {
#pragma unroll
            for (int s = 0; s < 4; ++s) vm |= ((16 * (key0 + s * 16 + fr) + 31 <= trow) ? 1u : 0u) << s;
        } else if (BR == 1) {
            const bool rowsel = (flg[idx] >> fq) & 1u;
#pragma unroll
            for (int s = 0; s < 4; ++s) vm |= ((rowsel && (key0 + s * 16 + fr <= trow)) ? 1u : 0u) << s;
        } else {
#pragma unroll
            for (int s = 0; s < 4; ++s) { const int kpos = key0 + s * 16 + fr; vm |= ((kpos <= trow && kpos > trow - 512) ? 1u : 0u) << s; }
        }
        return vm;
    }
};
template <int BR> __device__ __forceinline__ void run_branch(const bool FAKEV, const BranchIt<BR>& it, int first, const bf16x8 (&Qf)[2], float (&m)[4], float (&l)[4], f32x4 (&O)[4], bf16_t* Pt) {
#pragma unroll
    for (int j = 0; j < 4; ++j) { m[j] = -1e30f; l[j] = 0.f; O[j] = (f32x4){0.f, 0.f, 0.f, 0.f}; }
    int ia = it.next(first);
    if (ia < 0) return;
    KVF A; it.load(ia, A);
    while (ia >= 0) {
        const int ib = it.next(ia + 1);
        flash_compute(FAKEV, Qf, A, ib >= 0 ? it.kptr(ib) : nullptr, BranchIt<BR>::LDK, it.vptr(ia), BranchIt<BR>::LDV, it.mask(ia), m, l, O, Pt, it.fr, it.fq);
        ia = ib;
    }
}
__device__ __forceinline__ void branch_finish(float (&l)[4], f32x4 (&O)[4], const float* grow, int br, int hk, float* ybp  ) {
#pragma unroll
    for (int j = 0; j < 4; ++j) { const float s = rsum16(l[j]);
        const float g = sigmoidf_(grow[(hk * 4 + j) * 3 + br]) / fmaxf(s, 1e-30f);
#pragma unroll
        for (int dt = 0; dt < 4; ++dt) { float* q = ybp + j * 64 + dt * 16; if (br == 0) *q = g * O[dt][j]; else *q += g * O[dt][j]; } }
}
constexpr int NSA_WLDS = 15680;
__device__ void nsa_wave_task(const bool FAKEV, const Params& p, int layer, int t0, unsigned char* wl) {
    unsigned char* ws = p.ws;
    const int lane = tidx() & 63, fr = lane & 15, fq = lane >> 4;
    float* imp = (float*)wl; unsigned* flg = (unsigned*)(wl + 4160); bf16_t* Pt = (bf16_t*)(wl + 5184); float* yb = (float*)(wl + 7488);
    const bf16_t* qn = (const bf16_t*)(ws + O_QN); const bf16_t* ksn = (const bf16_t*)(ws + O_KSN); const bf16_t* kwn = (const bf16_t*)(ws + O_KWN);
    const bf16_t* vsT = (const bf16_t*)(ws + O_VST); const bf16_t* vwT = (const bf16_t*)(ws + O_VWT); const bf16_t* kc = (const bf16_t*)(ws + O_KC); const bf16_t* vcT = (const bf16_t*)(ws + O_VCT);
    const int trow = t0 + fq;
    const float* grow = (const float*)(ws + O_P32) + (size_t)trow * 1536 + 1280;
    const int tmax = t0 + 3;
    for (int hk = 0; hk < 2; ++hk) {
        bf16x8 Qf[2];
        { const bf16_t* qp = qn + (size_t)(t0 + (fr >> 2)) * 512 + (hk * 4 + (fr & 3)) * 64 + fq * 8; Qf[0] = *(const bf16x8*)qp; Qf[1] = *(const bf16x8*)(qp + 32); }
        float* ybp = yb + fq * 512 + hk * 256 + fr;
        float m[4], l[4]; f32x4 O[4];
        const int ncmp_t = tmax >= 31 ? ((((tmax - 31) >> 4) >> 6) + 1) : 0;
        const bf16_t* kcb = kc + ((size_t)hk * 1024 + fr) * 64 + fq * 8;
        { BranchIt<0> it{kcb, vcT + (size_t)hk * 16 * 4096 + fr * 64 + fq * 8, nullptr, ncmp_t - 1, trow, fr, fq}; run_branch<0>(FAKEV, it, 0, Qf, m, l, O, Pt); }
        float linv[4];
#pragma unroll
        for (int j = 0; j < 4; ++j) { const float s = rsum16(l[j]); linv[j] = s > 0.f ? 1.0f / s : 0.f; }
        branch_finish(l, O, grow, 0, hk, ybp);
        for (int e = lane; e < 4 * 260; e += 64) imp[e] = 0.f;
        for (int e = lane; e < 256; e += 64) flg[e] = 0u;
        asm volatile("s_waitcnt lgkmcnt(0)" ::: "memory");
        {
            KVF ka;
            if (ncmp_t > 0) kv_load(kcb, 64, ka);
            for (int kt = 0; kt < ncmp_t; ++kt) {
                const int key0 = kt * 64;
                f32x4 S[4];
#pragma unroll
                for (int s = 0; s < 4; ++s) { S[s] = (f32x4){0.f, 0.f, 0.f, 0.f}; S[s] = MFMA16(Qf[0], ka.k[s][0], S[s]); S[s] = MFMA16(Qf[1], ka.k[s][1], S[s]); }
                if (kt + 1 < ncmp_t) kv_load(kcb + (size_t)(key0 + 64) * 64, 64, ka);
#pragma unroll
                for (int s = 0; s < 4; ++s) {
                    const int nn = key0 + s * 16 + fr; const bool valid = 16 * nn + 31 <= trow;
                    float ps = 0.f;
#pragma unroll
                    for (int j = 0; j < 4; ++j) ps += valid ? __builtin_amdgcn_exp2f(S[s][j] - m[j]) * linv[j] : 0.f;
                    float p4 = ps; p4 += dppf<0xB1>(p4); p4 += dppf<0x4E>(p4);
                    if ((fr & 3) == 0) imp[fq * 260 + (nn >> 2)] += p4;
                    asm volatile("s_waitcnt lgkmcnt(0)" ::: "memory");
                    if ((fr & 3) == 3) imp[fq * 260 + (nn >> 2) + 1] += ps;
                    asm volatile("s_waitcnt lgkmcnt(0)" ::: "memory");
                }
            }
        }
#ifdef OLD_TOPK
        for (int tok = 0; tok < 4; ++tok) {
            const int t = t0 + tok, cur = t >> 6, nsel = cur + 1 < 16 ? cur + 1 : 16;
            unsigned long long key[4];
#pragma unroll
            for (int i = 0; i < 4; ++i) { const int j = lane + 64 * i; unsigned long long k = 0ull;
                if (j <= cur) { const bool forced = (j == 0) || (j == cur) || (j == cur - 1); const unsigned vb = forced ? 0x7F800000u : __float_as_uint(imp[tok * 260 + j]); k = ((unsigned long long)vb << 32) | (unsigned)(0xFFFF - j); }
                key[i] = k; }
            for (int it2 = 0; it2 < nsel; ++it2) {
                unsigned long long best = key[0]; best = key[1] > best ? key[1] : best; best = key[2] > best ? key[2] : best; best = key[3] > best ? key[3] : best;
#pragma unroll
                for (int o = 32; o >= 1; o >>= 1) { const unsigned lo = __shfl_xor((unsigned)best, o), hi = __shfl_xor((unsigned)(best >> 32), o); const unsigned long long ob = ((unsigned long long)hi << 32) | lo; best = ob > best ? ob : best; }
                const int jsel = 0xFFFF - (int)(best & 0xFFFFu);
#pragma unroll
                for (int i = 0; i < 4; ++i) if (key[i] == best) key[i] = 0ull;
                if (lane == 0) flg[jsel] |= (1u << tok);
            }
        }
#else
        {
            unsigned long long key[4][4];
#pragma unroll
            for (int tok = 0; tok < 4; ++tok) { const int cur = (t0 + tok) >> 6;
#pragma unroll
                for (int i = 0; i < 4; ++i) { const int j = lane + 64 * i; unsigned long long k = 0ull;
                    if (j <= cur) { const bool forced = (j == 0) || (j == cur) || (j == cur - 1); const unsigned vb = forced ? 0x7F800000u : __float_as_uint(imp[tok * 260 + j]); k = ((unsigned long long)vb << 32) | (unsigned)(0xFFFF - j); }
                    key[tok][i] = k; } }
            for (int itn = 0; itn < 16; ++itn) {
                unsigned long long best[4];
#pragma unroll
                for (int tok = 0; tok < 4; ++tok) { unsigned long long b0 = key[tok][0]; b0 = key[tok][1] > b0 ? key[tok][1] : b0; b0 = key[tok][2] > b0 ? key[tok][2] : b0; b0 = key[tok][3] > b0 ? key[tok][3] : b0; best[tok] = b0; }
#pragma unroll
                for (int tok = 0; tok < 4; ++tok) { best[tok] = dppmax64<0xB1>(best[tok]); best[tok] = dppmax64<0x4E>(best[tok]); best[tok] = dppmax64<0x124>(best[tok]); best[tok] = dppmax64<0x128>(best[tok]); }
#pragma unroll
                for (int o = 16; o <= 32; o <<= 1) {
#pragma unroll
                    for (int tok = 0; tok < 4; ++tok) { const unsigned lo = __shfl_xor((unsigned)best[tok], o), hi = __shfl_xor((unsigned)(best[tok] >> 32), o); const unsigned long long ob = ((unsigned long long)hi << 32) | lo; best[tok] = ob > best[tok] ? ob : best[tok]; }
                }
#pragma unroll
                for (int tok = 0; tok < 4; ++tok) {
                    if (best[tok] != 0ull) {
#pragma unroll
                        for (int i = 0; i < 4; ++i) if (key[tok][i] == best[tok]) key[tok][i] = 0ull;
                        if (lane == 0) flg[0xFFFF - (int)(best[tok] & 0xFFFFu)] |= (1u << tok);
                    }
                }
            }
        }
#endif
        asm volatile("s_waitcnt lgkmcnt(0)" ::: "memory");
        { BranchIt<1> it{ksn + (size_t)fr * 128 + hk * 64 + fq * 8, vsT + (size_t)hk * 256 * 4096 + fr * 64 + fq * 8, flg, tmax >> 6, trow, fr, fq}; run_branch<1>(FAKEV, it, 0, Qf, m, l, O, Pt); }
        branch_finish(l, O, grow, 1, hk, ybp);
        { BranchIt<2> it{kwn + (size_t)fr * 128 + hk * 64 + fq * 8, vwT + (size_t)hk * 256 * 4096 + fr * 64 + fq * 8, nullptr, tmax >> 6, trow, fr, fq}; run_branch<2>(FAKEV, it, t0 - 511 > 0 ? ((t0 - 511) >> 6) : 0, Qf, m, l, O, Pt); }
        branch_finish(l, O, grow, 2, hk, ybp);
    }
    asm volatile("s_waitcnt lgkmcnt(0)" ::: "memory");
    bf16_t* mix = FAKEV ? (bf16_t*)(ws + O_P32) : (bf16_t*)(ws + O_HN);
    const int mixld = FAKEV ? 3072 : DM;
    const float* gn = p.in[12] + (size_t)layer * 512;
    for (int tok = 0; tok < 4; ++tok) {
        const f32x4 a = *(const f32x4*)(yb + tok * 512 + lane * 8), b = *(const f32x4*)(yb + tok * 512 + lane * 8 + 4);
        float ss = a[0] * a[0] + a[1] * a[1] + a[2] * a[2] + a[3] * a[3] + b[0] * b[0] + b[1] * b[1] + b[2] * b[2] + b[3] * b[3];
        ss = wave_sum(ss);
        const float rs = rsqrtf(ss * (1.0f / 512.0f) + 1e-6f);
        const f32x4 g0 = *(const f32x4*)(gn + lane * 8), g1 = *(const f32x4*)(gn + lane * 8 + 4);
        u32x4 w; w.x = pk2(a[0] * rs * g0[0], a[1] * rs * g0[1]); w.y = pk2(a[2] * rs * g0[2], a[3] * rs * g0[3]); w.z = pk2(b[0] * rs * g1[0], b[1] * rs * g1[1]); w.w = pk2(b[2] * rs * g1[2], b[3] * rs * g1[3]);
        *(u32x4*)(mix + (size_t)(t0 + tok) * mixld + lane * 8) = w;
    }
    asm volatile("s_waitcnt lgkmcnt(0)" ::: "memory");
}

__device__ void phase_finalize(const Params& p, int layer) {
    unsigned char* ws = p.ws;
    const int wave = tidx() >> 6, lane = tidx() & 63;
    const float* yglu = (const float*)(ws + O_YGLU); const float* go = (const float*)(ws + O_PQKV); const bf16_t* Pz = (const bf16_t*)(ws + O_PZ); bf16_t* mix = (bf16_t*)(ws + O_HN);
    const float* gs = p.in[22] + (size_t)layer * 512 + lane * 8; const float* gg = p.in[26] + (size_t)layer * 128 + (lane & 7) * 16;
    for (int t = blockIdx.x * 8 + wave; t < T_; t += gridDim.x * 8) {
        {
            const f32x4 a = *(const f32x4*)(yglu + (size_t)t * 512 + lane * 8), b = *(const f32x4*)(yglu + (size_t)t * 512 + lane * 8 + 4);
            float ss = a[0] * a[0] + a[1] * a[1] + a[2] * a[2] + a[3] * a[3] + b[0] * b[0] + b[1] * b[1] + b[2] * b[2] + b[3] * b[3];
            ss = wave_sum(ss); const float rs = rsqrtf(ss * (1.0f / 512.0f) + 1e-6f);
            const f32x4 g0 = *(const f32x4*)gs, g1 = *(const f32x4*)(gs + 4);
            u32x4 w; w.x = pk2(a[0] * rs * g0[0], a[1] * rs * g0[1]); w.y = pk2(a[2] * rs * g0[2], a[3] * rs * g0[3]); w.z = pk2(b[0] * rs * g1[0], b[1] * rs * g1[1]); w.w = pk2(b[2] * rs * g1[2], b[3] * rs * g1[3]);
            *(u32x4*)(mix + (size_t)t * DM + 512 + lane * 8) = w;
        }
        {
            f32x4 o[4]; float ss = 0.f;
#pragma unroll
            for (int q = 0; q < 4; ++q) { o[q] = *(const f32x4*)(go + (size_t)t * 1024 + lane * 16 + q * 4); ss += o[q][0] * o[q][0] + o[q][1] * o[q][1] + o[q][2] * o[q][2] + o[q][3] * o[q][3]; }
            ss += __shfl_xor(ss, 1); ss += __shfl_xor(ss, 2); ss += __shfl_xor(ss, 4);
            const float rs = rsqrtf(ss * (1.0f / 128.0f) + 1e-6f);
            const u32x4 z0 = *(const u32x4*)(Pz + (size_t)t * 1024 + lane * 16), z1 = *(const u32x4*)(Pz + (size_t)t * 1024 + lane * 16 + 8);
            float zz[16] = {bflo(z0.x), bfhi(z0.x), bflo(z0.y), bfhi(z0.y), bflo(z0.z), bfhi(z0.z), bflo(z0.w), bfhi(z0.w), bflo(z1.x), bfhi(z1.x), bflo(z1.y), bfhi(z1.y), bflo(z1.z), bfhi(z1.z), bflo(z1.w), bfhi(z1.w)};
            float r[16];
#pragma unroll
            for (int q = 0; q < 4; ++q) { const f32x4 g = *(const f32x4*)(gg + q * 4);
#pragma unroll
                for (int e = 0; e < 4; ++e) r[q * 4 + e] = o[q][e] * rs * g[e] * siluf_(zz[q * 4 + e]); }
            u32x4 w0, w1; w0.x = pk2(r[0], r[1]); w0.y = pk2(r[2], r[3]); w0.z = pk2(r[4], r[5]); w0.w = pk2(r[6], r[7]); w1.x = pk2(r[8], r[9]); w1.y = pk2(r[10], r[11]); w1.z = pk2(r[12], r[13]); w1.w = pk2(r[14], r[15]);
            *(u32x4*)(mix + (size_t)t * DM + 1024 + lane * 16) = w0; *(u32x4*)(mix + (size_t)t * DM + 1024 + lane * 16 + 8) = w1;
        }
    }
}

__device__ void phase_ffn_act(const Params& p, int layer) {
    unsigned char* ws = p.ws;
    const bf16_t* hf = (const bf16_t*)(ws + O_HF); bf16_t* act = (bf16_t*)(ws + O_ACT);
    const float* cw = p.in[30] + (size_t)layer * 3 * NFF; const float* cb = p.in[31] + (size_t)layer * NFF;
    const int nitems = 512 * 688;
    for (int it = blockIdx.x * 512 + tidx(); it < nitems; it += gridDim.x * 512) {
        const int seg = it / 688, cg8 = it - seg * 688, c = cg8 * 8, t0 = seg * 32;
        float w[2][3][8], bb[2][8];
#pragma unroll
        for (int hh = 0; hh < 2; ++hh) {
#pragma unroll
            for (int j = 0; j < 3; ++j) { const f32x4 a = *(const f32x4*)(cw + j * NFF + hh * DFF + c), b = *(const f32x4*)(cw + j * NFF + hh * DFF + c + 4);
                w[hh][j][0] = a[0]; w[hh][j][1] = a[1]; w[hh][j][2] = a[2]; w[hh][j][3] = a[3]; w[hh][j][4] = b[0]; w[hh][j][5] = b[1]; w[hh][j][6] = b[2]; w[hh][j][7] = b[3]; }
            const f32x4 a = *(const f32x4*)(cb + hh * DFF + c), b = *(const f32x4*)(cb + hh * DFF + c + 4);
            bb[hh][0] = a[0]; bb[hh][1] = a[1]; bb[hh][2] = a[2]; bb[hh][3] = a[3]; bb[hh][4] = b[0]; bb[hh][5] = b[1]; bb[hh][6] = b[2]; bb[hh][7] = b[3];
        }
        u32x4 r0[2], r1[2];
#pragma unroll
        for (int hh = 0; hh < 2; ++hh) {
            r0[hh] = (t0 >= 2) ? *(const u32x4*)(hf + (size_t)(t0 - 2) * NFF + hh * DFF + c) : (u32x4){0u, 0u, 0u, 0u};
            r1[hh] = (t0 >= 1) ? *(const u32x4*)(hf + (size_t)(t0 - 1) * NFF + hh * DFF + c) : (u32x4){0u, 0u, 0u, 0u};
        }
        for (int tt = 0; tt < 32; ++tt) {
            const int t = t0 + tt;
            u32x4 r2[2]; float v[2][8];
#pragma unroll
            for (int hh = 0; hh < 2; ++hh) {
                r2[hh] = *(const u32x4*)(hf + (size_t)t * NFF + hh * DFF + c);
                const unsigned a0[4] = {r0[hh].x, r0[hh].y, r0[hh].z, r0[hh].w}, a1[4] = {r1[hh].x, r1[hh].y, r1[hh].z, r1[hh].w}, a2[4] = {r2[hh].x, r2[hh].y, r2[hh].z, r2[hh].w};
#pragma unroll
                for (int e = 0; e < 4; ++e) {
                    v[hh][2 * e]     = bb[hh][2 * e]     + w[hh][0][2 * e]     * bflo(a0[e]) + w[hh][1][2 * e]     * bflo(a1[e]) + w[hh][2][2 * e]     * bflo(a2[e]);
                    v[hh][2 * e + 1] = bb[hh][2 * e + 1] + w[hh][0][2 * e + 1] * bfhi(a0[e]) + w[hh][1][2 * e + 1] * bfhi(a1[e]) + w[hh][2][2 * e + 1] * bfhi(a2[e]);
                }
                r0[hh] = r1[hh]; r1[hh] = r2[hh];
            }
            u32x4 o; o.x = pk2(siluf_(v[0][0]) * v[1][0], siluf_(v[0][1]) * v[1][1]); o.y = pk2(siluf_(v[0][2]) * v[1][2], siluf_(v[0][3]) * v[1][3]);
            o.z = pk2(siluf_(v[0][4]) * v[1][4], siluf_(v[0][5]) * v[1][5]); o.w = pk2(siluf_(v[0][6]) * v[1][6], siluf_(v[0][7]) * v[1][7]);
            *(u32x4*)(act + (size_t)t * DFF + c) = o;
        }
    }
}
#ifdef REPEAT_PHASE
constexpr int NPHT = NPH + 1;
#else
constexpr int NPHT = NPH;
#endif
#ifndef MULTI_LAUNCH
#define MULTI_LAUNCH 0
#endif
__global__ void __launch_bounds__(512) mega(Params p) {
    extern __shared__ __attribute__((aligned(16))) unsigned char smem[];
    cg::grid_group grid = cg::this_grid();
    const int b = blockIdx.x, G = gridDim.x;
    PG8_LAS unsigned char* glds = (PG8_LAS unsigned char*)smem;
    volatile XB_LAS unsigned* xst = (volatile XB_LAS unsigned*)(smem + LDS_BYTES - 32);
    if (threadIdx.x == 0) { xst[0] = 0u; xst[1] = 0u; }
    __syncthreads();
    XcdBarrier xbar; xbar.bar = (unsigned*)(p.ws + O_BAR); xbar.x = 0; xbar.st = xst;
    for (int ph = p.ph_lo; ph < p.ph_hi; ++ph) {

        #ifdef REPEAT_PHASE
        const int layer = ph / (NPH + 1), ki = ph % (NPH + 1), rep = (ki == REPEAT_PHASE + 1) ? 1 : 0; int k = ki <= REPEAT_PHASE ? ki : ki - 1;
#else
        const int layer = ph / NPH, rep = 0; int k = ph % NPH;
#endif
#ifdef DBG_ONLY
        if (k != DBG_ONLY) k = 99;
#endif
        typedef unsigned char __attribute__((address_space(1))) gu8_t;
        gu8_t* wsg = (gu8_t*)p.ws; asm volatile("" : "+s"(wsg));
        unsigned char* ws = (unsigned char*)wsg;
        int tid = threadIdx.x; asm volatile("" : "+v"(tid));
        const int wave = tid >> 6;
        bf16_t* hn = (bf16_t*)(ws + O_HN);
        Params q = p; q.ws = ws;
        if (k == 0) {
            if (ph == 0 && rep == 0 && b == 0) { if (tid < 64) ((unsigned*)(ws + O_CTR))[tid * 16] = 0u; for (int i = tid; i < XCD_BAR_WORDS; i += 512) ((unsigned*)(ws + O_BAR))[i] = 0u; }
            phase_convert(q, layer, (float*)smem);
            phase_rmsnorm(layer == 0 ? p.in[0] : p.out, p.in[1] + (size_t)layer * DM, hn, layer == 0 ? p.out : nullptr);
        } else if (k == 1) {
            pg8::Gemm g{hn, (const bf16_t*)(ws + O_WIN), T_, NIN, DM}; pg8::StaticOrder S; S.init(T_, NIN, G, b);
            EpiProj E{(float*)(ws + O_P32), (bf16_t*)(ws + O_PU), (bf16_t*)(ws + O_PQKV), (bf16_t*)(ws + O_PZ)};
            pg8::gemm_phase<EpiProj, pg8::StaticOrder, false>(glds, g, S, E, nullptr);
        } else if (k == 2) {
            for (int it = b; it < 3072; it += G) {
                if (it < 2048) gdn_prep_item(q, layer, it, smem);
                else if (it < 2304) nsa_prep_item(q, layer, it - 2048, (float*)smem);
                else if (it < 2560) s5_passA_wave(q, layer, (it - 2304) * 8 + wave);
                else cmp1_wave_tile(q, layer, (it - 2560) * 8 + wave);
            }
        } else if (k == 3) {
            for (int idx = b * 8 + wave; idx < 4096; idx += G * 8) cmp2_wave_row(q, layer, idx);
            for (int it = b * 8 + wave; it < 2048; it += G * 8) s5_passB_wave(q, layer, it, (bf16_t*)(smem + wave * 4352));
        } else if (k == 4) {
#ifdef REP4_MODE
            const bool do_rec = (rep == 0) || (REP4_MODE == 1), do_glu = (rep == 0), do_nsa = (rep == 0) || (REP4_MODE == 2);
#else
            const bool do_rec = true, do_glu = true, do_nsa = true;
#endif
            if (b < 32) {
#ifndef NO_REC
 if (do_rec) gdn_recurrence(q, b, smem);
#endif
 }
            else if (b < 160 && do_glu) {
#ifndef NO_GLU
                pg8::Gemm g{(const bf16_t*)(ws + O_YGELU), (const bf16_t*)(ws + O_WGLU), T_, 512, 512}; pg8::StaticOrder S; S.init(T_, 512, 128, b - 32);
                EpiGlu E{(const bf16_t*)(ws + O_YGELU), (float*)(ws + O_YGLU)};
                pg8::gemm_phase<EpiGlu, pg8::StaticOrder, false>(glds, g, S, E, nullptr);
#endif
            }
            __syncthreads();
            unsigned* ctr = (unsigned*)(ws + O_CTR) + (layer * 2 + rep) * 16;
            volatile int* sidx = (volatile int*)(smem + LDS_BYTES - 16);
#ifndef NO_NSA
            if (do_nsa) for (;;) {
                if (tid == 0) *sidx = (int)atomicAdd(ctr, 1u);
                __syncthreads();
                const int idx = *sidx;
                __syncthreads();
                if (idx >= 512) break;
                nsa_wave_task(false, q, layer, (511 - idx) * 32 + wave * 4, smem + wave * NSA_WLDS);
            }
#endif
        } else if (k == 5) {
            phase_finalize(q, layer);
        } else if (k == 6) {
            pg8::Gemm g{hn, (const bf16_t*)(ws + O_WOUT), T_, DM, DM}; pg8::StaticOrder S; S.init(T_, DM, G, b);
            EpiResid E{p.out, DM};
            pg8::gemm_phase<EpiResid, pg8::StaticOrder, false>(glds, g, S, E, nullptr);
        } else if (k == 7) {
            phase_rmsnorm(p.out, p.in[28] + (size_t)layer * DM, hn, nullptr);
        } else if (k == 8) {
            pg8::Gemm g{hn, (const bf16_t*)(ws + O_WFIN), T_, NFF, DM}; pg8::StaticOrder S; S.init(T_, NFF, G, b);
            EpiBf E{(bf16_t*)(ws + O_HF), NFF};
            pg8::gemm_phase<EpiBf, pg8::StaticOrder, false>(glds, g, S, E, nullptr);
        } else if (k == 9) {
            phase_ffn_act(q, layer);
        } else if (k == 10) {
            pg8::Gemm g{(const bf16_t*)(ws + O_ACT), (const bf16_t*)(ws + O_WFOUT), T_, DM, DFF}; pg8::StaticOrder S; S.init(T_, DM, G, b);
            EpiResid E{p.out, DM};
            pg8::gemm_phase<EpiResid, pg8::StaticOrder, false>(glds, g, S, E, nullptr);
        }
        __syncthreads();
        if (ph + 1 < p.ph_hi) {
            if (ph == p.ph_lo) { grid.sync(); xbar = xcd_barrier_post((unsigned*)(p.ws + O_BAR), xst); }
            else xcd_barrier(xbar);
        }
    }
}

extern "C" void kernel_launch(void* const* d_in, const int* in_sizes, int n_in, void* d_out, int out_size, void* d_ws, size_t ws_size, hipStream_t stream) {
    static int grid_blocks = 0;
    if (!grid_blocks) {
        if (n_in != 33 || out_size != T_ * DM || ws_size < WS_NEED) { fprintf(stderr, "kernel_launch: unexpected shapes or workspace (%d inputs, out %d, ws %zu < %zu)\n", n_in, out_size, ws_size, (size_t)WS_NEED); grid_blocks = -1; return; }
        int dev = 0, cus = 0, per_cu = 0;
        hipGetDevice(&dev);
        hipDeviceGetAttribute(&cus, hipDeviceAttributeMultiprocessorCount, dev);
        if (hipFuncSetAttribute((const void*)mega, hipFuncAttributeMaxDynamicSharedMemorySize, LDS_BYTES) != hipSuccess) { fprintf(stderr, "kernel_launch: hipFuncSetAttribute failed\n"); grid_blocks = -1; return; }
        hipOccupancyMaxActiveBlocksPerMultiprocessor(&per_cu, (const void*)mega, 512, LDS_BYTES);
        (void)hipGetLastError();
        if (per_cu < 1) per_cu = 1;
        grid_blocks = cus * per_cu; if (grid_blocks > 256) grid_blocks = 256;
        if (grid_blocks < 160) { fprintf(stderr, "kernel_launch: grid %d too small\n", grid_blocks); grid_blocks = -1; return; }
    }
    if (grid_blocks < 0) return;
    Params p{};
    for (int i = 0; i < 33; ++i) p.in[i] = (const float*)d_in[i];
    p.out = (float*)d_out; p.ws = (unsigned char*)d_ws;
#if MULTI_LAUNCH
    for (int ph = 0; ph < 2 * NPHT; ++ph) { p.ph_lo = ph; p.ph_hi = ph + 1; hipLaunchKernelGGL(mega, dim3(grid_blocks), dim3(512), LDS_BYTES, stream, p); }
#else
    p.ph_lo = 0; p.ph_hi = 2 * NPHT;
    void* args[] = {&p};
    hipError_t e = hipLaunchCooperativeKernel((const void*)mega, dim3(grid_blocks), dim3(512), args, LDS_BYTES, stream);
    if (e != hipSuccess) fprintf(stderr, "cooperative launch failed: %s (grid %d)\n", hipGetErrorString(e), grid_blocks);
#endif
}
```

```cpp
#include <hip/hip_runtime.h>
#include <hip/hip_cooperative_groups.h>
#include <cstdio>
namespace cg = cooperative_groups;
__device__ __forceinline__ int tidx() { int t = threadIdx.x; asm volatile("" : "+v"(t)); return t; }
namespace pg8 {
#define PG8_LAS __attribute__((address_space(3)))
typedef unsigned short bf16_t;
typedef short bf16x8 __attribute__((ext_vector_type(8)));
typedef float f32x4 __attribute__((ext_vector_type(4)));
typedef unsigned u32x4 __attribute__((ext_vector_type(4)));
constexpr int BM = 256, BK = 64, HALF = 128, HTB = HALF * BK * 2  , STAGE_BYTES = 8 * HTB, NXCD = 8, WGM = 8;

__host__ __device__ __forceinline__ int lds_byte(int r, int c) { const int st = (r >> 4) * 2 + (c >> 5), rr = r & 15, cc = c & 31, ob = rr * 64 + cc * 2; return st * 1024 + (ob ^ (((ob >> 9) & 1) << 5)); }
__host__ __device__ __forceinline__ void stage_rc(int b, int& R, int& C) { const int st = b / 1024, sb = b % 1024, swz = sb ^ (((sb >> 9) & 1) << 5); R = (st >> 1) * 16 + swz / 64; C = (st & 1) * 32 + (swz % 64) / 2; }
__host__ __device__ __forceinline__ int perm32(int rho) { const int n = rho >> 4, i = rho & 15; return 8 * (i >> 2) + 4 * n + (i & 3); }

struct Unit { int pm, pn; };
struct Gemm { const bf16_t* A; const bf16_t* Bt; int M, N, K; };

struct StaticOrder {
    int nM, nN, nwg, G, c;
    __host__ __device__ void init(int M, int N, int G_, int c_) { nM = M / BM; nN = N / BM; nwg = nM * nN; G = G_; c = c_; }
    __host__ __device__ bool next(int i, Unit& u) const {
        const long L = (long)i * G + c; if (L >= nwg) return false;
        int wgid = (int)L; { const int q = nwg / NXCD, r = nwg % NXCD, xcd = wgid % NXCD, off = wgid / NXCD; wgid = (xcd < r ? xcd * (q + 1) : r * (q + 1) + (xcd - r) * q) + off; }
        const int nig = WGM * nN, gid = wgid / nig, fm = gid * WGM, gsz = (nM - fm) < WGM ? (nM - fm) : WGM;
        u.pm = fm + ((wgid % nig) % gsz); u.pn = (wgid % nig) / gsz; return true;
    }
    __device__ __forceinline__ void a_ready(const Unit&) const {}
    __device__ __forceinline__ void done(const Unit&) const {}
};
__device__ __forceinline__ unsigned cvt_pk_bf16(float lo, float hi) { unsigned r; asm volatile("v_cvt_pk_bf16_f32 %0, %1, %2" : "=v"(r) : "v"(lo), "v"(hi)); return r; }
template <class Epi, class Sched, bool STAMP = false>
__device__ __forceinline__ void gemm_phase(PG8_LAS unsigned char* lds, const Gemm g, const Sched& S, const Epi& E, unsigned long long* stamps) {
    const int tid = tidx(), wid = __builtin_amdgcn_readfirstlane(tid >> 6), lane = tid & 63, wr = wid >> 2, wc = wid & 3, fr = lane & 15, fq = lane >> 4;
    const int K = g.K, nt = K / BK;
    int ts_lo = 0, ts_hi = 0, nts = 0; const unsigned long long rt_entry = STAMP ? (unsigned long long)wall_clock64() : 0ull;
#define PG8_STAMP() do { if (STAMP && wid == 0 && nts < 64) { const unsigned long long _c = (unsigned long long)clock64(); \
        ts_lo = (lane == nts) ? (int)(unsigned)_c : ts_lo; ts_hi = (lane == nts) ? (int)(unsigned)(_c >> 32) : ts_hi; ++nts; } } while (0)
    PG8_STAMP();
    unsigned voffA[2], voffB[2];
#pragma unroll
    for (int i = 0; i < 2; ++i) { int R, C; stage_rc(tid * 16 + i * 8192, R, C); const int Rb = Epi::PERM ? ((R & ~31) + perm32(R & 31)) : R;
        voffA[i] = (unsigned)(R * K + C) * 2u; voffB[i] = (unsigned)(Rb * K + C) * 2u; }
    const size_t kstep = (size_t)(BK * 2);
    const size_t hstep = (size_t)HALF * K * 2;
    const size_t tstep = 2 * hstep;
    const unsigned ldsw = (unsigned)wid * 1024u;
    const int aoff = lds_byte(wr * 64 + fr, fq * 8), boff = lds_byte(wc * 32 + fr, fq * 8);
#define PG8_SA(b, h) (((b) * 2 + (h)) * HTB)
#define PG8_SB(b, h) ((4 + (b) * 2 + (h)) * HTB)
#define PG8_STAGE(bufoff, gbase, voff) do { _Pragma("unroll") for (int _i = 0; _i < 2; ++_i) \
        __builtin_amdgcn_global_load_lds((const unsigned*)((const char*)(gbase) + (voff)[_i]), (PG8_LAS unsigned*)(lds + (bufoff) + ldsw + _i * 8192), 16, 0, 0); } while (0)
#define PG8_LDA(dst, b, h) do { _Pragma("unroll") for (int m = 0; m < 4; ++m) _Pragma("unroll") for (int k = 0; k < 2; ++k) dst[m][k] = *(const PG8_LAS bf16x8*)(lds + PG8_SA(b, h) + aoff + m * 2048 + k * 1024); } while (0)
#define PG8_LDB(dst, b, h) do { _Pragma("unroll") for (int n = 0; n < 2; ++n) _Pragma("unroll") for (int k = 0; k < 2; ++k) dst[n][k] = *(const PG8_LAS bf16x8*)(lds + PG8_SB(b, h) + boff + n * 2048 + k * 1024); } while (0)
#define PG8_MMA(ai, bj, At, Bt) do { __builtin_amdgcn_s_setprio(1); _Pragma("unroll") for (int m = 0; m < 4; ++m) _Pragma("unroll") for (int n = 0; n < 2; ++n) _Pragma("unroll") for (int k = 0; k < 2; ++k) \
        acc[ai][bj][m][n] = __builtin_amdgcn_mfma_f32_16x16x32_bf16(Bt[n][k], At[m][k], acc[ai][bj][m][n], 0, 0, 0); __builtin_amdgcn_s_setprio(0); } while (0)
#define PG8_WAIT_V(n) asm volatile("s_waitcnt vmcnt(" #n ")" ::: "memory")
#define PG8_WAIT_L(n) asm volatile("s_waitcnt lgkmcnt(" #n ")" ::: "memory")
#define PG8_BAR __builtin_amdgcn_s_barrier()
#define PG8_SCHED __builtin_amdgcn_sched_barrier(0)
    Unit cur, nxt; int ui = 0;
    if (!S.next(0, cur)) return;
    f32x4 acc[2][2][4][2];
#pragma unroll
    for (int a = 0; a < 2; ++a)
#pragma unroll
        for (int b = 0; b < 2; ++b)
#pragma unroll
            for (int m = 0; m < 4; ++m)
#pragma unroll
                for (int n = 0; n < 2; ++n) acc[a][b][m][n] = (f32x4){0.f, 0.f, 0.f, 0.f};
    bf16x8 At[4][2], B0[2][2], B1[2][2];
    const char* cA = (const char*)g.A + (size_t)cur.pm * tstep; const char* cB = (const char*)g.Bt + (size_t)cur.pn * tstep;
    S.a_ready(cur);
    PG8_STAGE(PG8_SB(0, 0), cB, voffB); PG8_STAGE(PG8_SA(0, 0), cA, voffA); PG8_STAGE(PG8_SB(0, 1), cB + hstep, voffB); PG8_STAGE(PG8_SA(0, 1), cA + hstep, voffA);
    if (wr == 1) PG8_BAR;
    PG8_WAIT_V(4); PG8_BAR;
    PG8_STAGE(PG8_SB(1, 0), cB + kstep, voffB); PG8_STAGE(PG8_SA(1, 0), cA + kstep, voffA); PG8_STAGE(PG8_SB(1, 1), cB + hstep + kstep, voffB);
    PG8_WAIT_V(6); PG8_BAR;
    PG8_STAMP();
    for (;;) {
        const bool has_next = S.next(ui + 1, nxt);
        const char* nA = has_next ? (const char*)g.A + (size_t)nxt.pm * tstep : cA; const char* nB = has_next ? (const char*)g.Bt + (size_t)nxt.pn * tstep : cB;
        for (int t = 0; t < nt; t += 2) {
            const bool last = (t == nt - 2);
            const char* a1 = cA + (size_t)(t + 1) * kstep;
            const char* a2 = last ? nA : cA + (size_t)(t + 2) * kstep; const char* b2 = last ? nB : cB + (size_t)(t + 2) * kstep;
            const char* a3 = a2 + kstep; const char* b3 = b2 + kstep;
            if (last && has_next) S.a_ready(nxt);
            PG8_LDB(B0, 0, 0); PG8_SCHED; PG8_LDA(At, 0, 0); PG8_STAGE(PG8_SA(1, 1), a1 + hstep, voffA);
            PG8_WAIT_L(8); PG8_BAR; PG8_WAIT_L(0); PG8_MMA(0, 0, At, B0); PG8_BAR; PG8_SCHED;
            PG8_LDB(B1, 0, 1); PG8_STAGE(PG8_SB(0, 0), b2, voffB);
            PG8_BAR; PG8_WAIT_L(0); PG8_MMA(0, 1, At, B1); PG8_BAR;
            PG8_LDA(At, 0, 1); PG8_STAGE(PG8_SA(0, 0), a2, voffA);
            PG8_BAR; PG8_WAIT_L(0); PG8_MMA(1, 0, At, B0); PG8_BAR; PG8_SCHED;
            PG8_STAGE(PG8_SB(0, 1), b2 + hstep, voffB);
            PG8_WAIT_V(6); PG8_BAR; PG8_MMA(1, 1, At, B1); PG8_BAR;
            PG8_LDB(B0, 1, 0); PG8_SCHED; PG8_LDA(At, 1, 0); PG8_STAGE(PG8_SA(0, 1), a2 + hstep, voffA);
            PG8_WAIT_L(8); PG8_BAR; PG8_WAIT_L(0); PG8_MMA(0, 0, At, B0); PG8_BAR; PG8_SCHED;
            PG8_LDB(B1, 1, 1); PG8_STAGE(PG8_SB(1, 0), b3, voffB);
            PG8_BAR; PG8_WAIT_L(0); PG8_MMA(0, 1, At, B1); PG8_BAR;
            PG8_LDA(At, 1, 1); PG8_STAGE(PG8_SA(1, 0), a3, voffA);
            PG8_BAR; PG8_WAIT_L(0); PG8_MMA(1, 0, At, B0); PG8_BAR; PG8_SCHED;
            PG8_STAGE(PG8_SB(1, 1), b3 + hstep, voffB);
            PG8_WAIT_V(6); PG8_BAR; PG8_MMA(1, 1, At, B1); PG8_BAR;
        }
        PG8_STAMP();
        if constexpr (!Epi::AFTER_DRAIN) { E(acc, cur, wr, wc, fr, fq); S.done(cur); }
        PG8_STAMP();
        if (!has_next) break;
#pragma unroll
        for (int a = 0; a < 2; ++a)
#pragma unroll
            for (int b = 0; b < 2; ++b)
#pragma unroll
                for (int m = 0; m < 4; ++m)
#pragma unroll
                    for (int n = 0; n < 2; ++n) acc[a][b][m][n] = (f32x4){0.f, 0.f, 0.f, 0.f};
        cur = nxt; cA = nA; cB = nB; ++ui;
    }
    PG8_WAIT_V(0);
    if (wr == 0) PG8_BAR;
    PG8_BAR;
    if constexpr (Epi::AFTER_DRAIN) { E.fused(acc, cur, wr, wc, fr, fq, lds, wid, lane); S.done(cur); }
    PG8_STAMP();
    if (STAMP && wid == 0) { stamps[lane] = lane < nts ? (((unsigned long long)(unsigned)ts_hi << 32) | (unsigned)ts_lo) : 0ull;
        if (lane == 62) stamps[62] = rt_entry; if (lane == 63) stamps[63] = (unsigned long long)wall_clock64(); }
#undef PG8_STAMP
#undef PG8_SA
#undef PG8_SB
#undef PG8_STAGE
#undef PG8_LDA
#undef PG8_LDB
#undef PG8_MMA
#undef PG8_WAIT_V
#undef PG8_WAIT_L
#undef PG8_BAR
#undef PG8_SCHED
}
}
#define XB_TMO      128
#define XB_XCNT(j)  (256  + 64 * (j))
#define XB_XSUB(j)  (1280 + 64 * (j))
#define XB_XGEN(j)  (2304 + 64 * (j))
#define XB_TOP      3328
#define XB_TOPGEN   3392
#define XCD_BAR_WORDS 3456
#define XB_SPIN_CAP (1u << 18)
#define XB_LAS __attribute__((address_space(3)))

__device__ __forceinline__ unsigned xb_ld(unsigned* p)              { return __hip_atomic_load(p, __ATOMIC_RELAXED, __HIP_MEMORY_SCOPE_AGENT); }
__device__ __forceinline__ unsigned xb_add(unsigned* p, unsigned v) { return __hip_atomic_fetch_add(p, v, __ATOMIC_RELAXED, __HIP_MEMORY_SCOPE_AGENT); }
__device__ __forceinline__ unsigned xb_xcc_id() { return (unsigned)__builtin_amdgcn_s_getreg((3 << 11) | 20) & 0xFu; }
#define XB_SPIN(cond, bar) do { unsigned _sp = 0; while (cond) { __builtin_amdgcn_s_sleep(1); \
    if ((++_sp & 255u) == 0u) { if (xb_ld(&(bar)[XB_TMO])) break; if (_sp > XB_SPIN_CAP) { atomicAdd(&(bar)[XB_TMO], 1u); break; } } } } while (0)

struct XcdBarrier {
    unsigned* bar; unsigned x;
    volatile XB_LAS unsigned* st;
};

__device__ __forceinline__ XcdBarrier xcd_barrier_post(unsigned* bar, volatile XB_LAS unsigned* st) {
    XcdBarrier b; b.bar = bar; b.x = xb_xcc_id(); b.st = st;
    if (threadIdx.x == 0) (void)xb_add(&bar[XB_XCNT(b.x)], 1u);
    return b;
}
__device__ __forceinline__ void xcd_barrier_complete(unsigned* bar, unsigned x, unsigned& nloc, unsigned& nx) {
    const unsigned G = gridDim.x * gridDim.y * gridDim.z;
    unsigned sum, cnt, mine, sp = 0u;
    for (;;) {
        sum = 0u; cnt = 0u; mine = 0u;
#pragma unroll
        for (unsigned j = 0; j < 16; ++j) { const unsigned c = xb_ld(&bar[XB_XCNT(j)]); sum += c; cnt += (c > 0u) ? 1u : 0u; mine = (j == x) ? c : mine; }
        if (sum == G) break;
        __builtin_amdgcn_s_sleep(1);
        if ((++sp & 255u) == 0u) { if (xb_ld(&bar[XB_TMO])) break; if (sp > XB_SPIN_CAP) { atomicAdd(&bar[XB_TMO], 1u); break; } }
    }
    nloc = mine > 0u ? mine : 1u; nx = cnt > 0u ? cnt : 1u;
}

__device__ __forceinline__ void xcd_barrier(const XcdBarrier& b) {
    asm volatile("s_waitcnt vmcnt(0)" ::: "memory");
    __syncthreads();
    if (threadIdx.x == 0) {
        unsigned* bar = b.bar;
        __builtin_amdgcn_s_waitcnt(0);
        unsigned nloc = b.st[0], nx = b.st[1];
        if (nloc == 0u) { xcd_barrier_complete(bar, b.x, nloc, nx); b.st[0] = nloc; b.st[1] = nx; }
        const unsigned old = xb_add(&bar[XB_XSUB(b.x)], 1u);
        const unsigned gen = old / nloc;
        if (old + 1u == (gen + 1u) * nloc) {
            __builtin_amdgcn_fence(__ATOMIC_RELEASE, "agent");
            asm volatile("s_waitcnt vmcnt(0)" ::: "memory");
            const unsigned og = xb_add(&bar[XB_TOP], 1u);
            const unsigned tg = og / nx;
            if (og + 1u == (tg + 1u) * nx) xb_add(&bar[XB_TOPGEN], 1u);
            else XB_SPIN(xb_ld(&bar[XB_TOPGEN]) == tg, bar);
            __builtin_amdgcn_fence(__ATOMIC_ACQUIRE, "agent");
            xb_add(&bar[XB_XGEN(b.x)], 1u);
            asm volatile("s_waitcnt vmcnt(0)" ::: "memory");
        } else {
            XB_SPIN(xb_ld(&bar[XB_XGEN(b.x)]) == gen, bar);
            __builtin_amdgcn_fence(__ATOMIC_ACQUIRE, "agent");
            asm volatile("s_waitcnt vmcnt(0)" ::: "memory");
        }
    }
    __syncthreads();
}
using pg8::bf16_t; using pg8::bf16x8; using pg8::f32x4; using pg8::u32x4; using pg8::Unit;
typedef unsigned u32x2 __attribute__((ext_vector_type(2)));
#define MFMA16(a, b, c) __builtin_amdgcn_mfma_f32_16x16x32_bf16((a), (b), (c), 0, 0, 0)

constexpr int T_ = 16384, DM = 2048, NIN = 6144, DFF = 5504, NFF = 11008;
constexpr int LDS_BYTES = 144 * 1024;
constexpr int NPH = 11;

constexpr size_t O_CTR   = 0;
constexpr size_t O_BAR   = 4096;
constexpr size_t O_WIN   = 4096 + 16384;
constexpr size_t O_WOUT  = O_WIN   + (size_t)NIN * DM * 2;
constexpr size_t O_WFIN  = O_WOUT  + (size_t)DM * DM * 2;
constexpr size_t O_WFOUT = O_WFIN  + (size_t)NFF * DM * 2;
constexpr size_t O_WCK   = O_WFOUT + (size_t)DM * DFF * 2;
constexpr size_t O_WCV   = O_WCK   + (size_t)256 * 2048 * 2;
constexpr size_t O_WGLU  = O_WCV   + (size_t)256 * 2048 * 2;
constexpr size_t O_HN    = O_WGLU  + (size_t)512 * 512 * 2;
constexpr size_t O_R     = O_HN    + (size_t)T_ * DM * 2;
constexpr size_t O_P32   = O_R;
constexpr size_t O_PU    = O_P32   + (size_t)T_ * 1536 * 4;
constexpr size_t O_PQKV  = O_PU    + (size_t)T_ * 512 * 2;
constexpr size_t O_PZ    = O_PQKV  + (size_t)T_ * 3072 * 2;
constexpr size_t O_QN    = O_PZ    + (size_t)T_ * 1024 * 2;
constexpr size_t O_KSN   = O_QN    + (size_t)T_ * 512 * 2;
constexpr size_t O_KWN   = O_KSN   + (size_t)T_ * 128 * 2;
constexpr size_t O_VST   = O_KWN   + (size_t)T_ * 128 * 2;
constexpr size_t O_VWT   = O_VST   + (size_t)T_ * 128 * 2;
constexpr size_t O_KC    = O_VWT   + (size_t)T_ * 128 * 2;
constexpr size_t O_VCT   = O_KC    + (size_t)2 * 1024 * 64 * 2;
constexpr size_t O_HCMP  = O_VCT   + (size_t)2 * 64 * 1024 * 2;
constexpr size_t O_GKC   = O_HCMP  + (size_t)2 * 2048 * 256 * 4;
constexpr size_t O_GQG   = O_GKC   + (size_t)2048 * 64 * 128 * 2;
constexpr size_t O_GQK   = O_GQG   + (size_t)2048 * 64 * 128 * 2;
constexpr size_t O_GKD   = O_GQK   + (size_t)2048 * 64 * 64 * 2;
constexpr size_t O_GVAL  = O_GKD   + (size_t)2048 * 64 * 128 * 2;
constexpr size_t O_GEGL  = O_GVAL  + (size_t)2048 * 64 * 128 * 4;
constexpr size_t O_XEND  = O_GEGL  + 8192;
constexpr size_t O_YGELU = O_XEND  + (size_t)64 * 32 * 64 * 2 * 4;
constexpr size_t O_YGLU  = O_YGELU + (size_t)T_ * 512 * 2;
constexpr size_t O_ATT_END = O_YGLU + (size_t)T_ * 512 * 4;
constexpr size_t O_HF    = O_R;
constexpr size_t O_ACT   = O_HF    + (size_t)T_ * NFF * 2;
constexpr size_t O_FFN_END = O_ACT + (size_t)T_ * DFF * 2;
constexpr size_t WS_NEED = O_ATT_END > O_FFN_END ? O_ATT_END : O_FFN_END;

struct Params { const float* in[33]; float* out; unsigned char* ws; int ph_lo, ph_hi; };

__device__ __forceinline__ unsigned short f2bf(float f) { unsigned u = __float_as_uint(f); u += 0x7FFFu + ((u >> 16) & 1u); return (unsigned short)(u >> 16); }
__device__ __forceinline__ float bf2f(unsigned short b) { return __uint_as_float(((unsigned)b) << 16); }
__device__ __forceinline__ unsigned pk2(float lo, float hi) { return pg8::cvt_pk_bf16(lo, hi); }
__device__ __forceinline__ float bflo(unsigned w) { return __uint_as_float(w << 16); }
__device__ __forceinline__ float bfhi(unsigned w) { return __uint_as_float(w & 0xFFFF0000u); }
__device__ __forceinline__ float sigmoidf_(float x) { return __builtin_amdgcn_rcpf(1.0f + __expf(-x)); }
__device__ __forceinline__ float siluf_(float x) { return x * __builtin_amdgcn_rcpf(1.0f + __expf(-x)); }
__device__ __forceinline__ float vmaxf(float a, float b) { float r; asm("v_max_f32 %0, %1, %2" : "=v"(r) : "v"(a), "v"(b)); return r; }
__device__ __forceinline__ float gelu_tanh(float x) { const float u = 0.7978845608028654f * (x + 0.044715f * x * x * x); const float th = 1.0f - 2.0f * __builtin_amdgcn_rcpf(__expf(2.0f * u) + 1.0f); return 0.5f * x * (1.0f + th); }
__device__ __forceinline__ float softplusf_(float x) { return x > 20.f ? x : log1pf(expf(x)); }
__device__ __forceinline__ float wave_sum(float v) { for (int o = 32; o >= 1; o >>= 1) v += __shfl_xor(v, o); return v; }
__device__ __forceinline__ bf16x8 pack8f(f32x4 a, f32x4 b) { u32x4 w; w.x = pk2(a[0], a[1]); w.y = pk2(a[2], a[3]); w.z = pk2(b[0], b[1]); w.w = pk2(b[2], b[3]); return __builtin_bit_cast(bf16x8, w); }
__device__ __forceinline__ float rdlane(float v, int l) { return __int_as_float(__builtin_amdgcn_readlane(__float_as_int(v), l)); }

struct EpiProj {
    static constexpr bool PERM = false, AFTER_DRAIN = false;
    float* P32; bf16_t* Pu; bf16_t* Pqkv; bf16_t* Pz;
    static __device__ __forceinline__ void st_bf(const f32x4 (&acc)[2][2][4][2], bf16_t* base, int ld) {
#pragma unroll
        for (int ai = 0; ai < 2; ++ai)
#pragma unroll
            for (int m = 0; m < 4; ++m) { bf16_t* rp = base + (size_t)(ai * 128 + m * 16) * ld;
#pragma unroll
                for (int bj = 0; bj < 2; ++bj)
#pragma unroll
                    for (int n = 0; n < 2; ++n) { const f32x4 v = acc[ai][bj][m][n]; u32x2 w; w.x = pk2(v[0], v[1]); w.y = pk2(v[2], v[3]); *(u32x2*)(rp + bj * 128 + n * 16) = w; } }
    }
    __device__ __forceinline__ void operator()(const f32x4 (&acc)[2][2][4][2], const Unit& u, int wr, int wc, int fr, int fq) const {
        const int row0 = u.pm * 256 + wr * 64 + fr, colt = wc * 32 + 4 * fq;
        if (u.pn < 6) {
            float* base = P32 + (size_t)row0 * 1536 + u.pn * 256 + colt;
#pragma unroll
            for (int ai = 0; ai < 2; ++ai)
#pragma unroll
                for (int m = 0; m < 4; ++m) { float* rp = base + (size_t)(ai * 128 + m * 16) * 1536;
#pragma unroll
                    for (int bj = 0; bj < 2; ++bj)
#pragma unroll
                        for (int n = 0; n < 2; ++n) *(f32x4*)(rp + bj * 128 + n * 16) = acc[ai][bj][m][n]; }
        } else if (u.pn < 8)  st_bf(acc, Pu   + (size_t)row0 * 512  + (u.pn - 6)  * 256 + colt, 512);
        else if (u.pn < 20)   st_bf(acc, Pqkv + (size_t)row0 * 3072 + (u.pn - 8)  * 256 + colt, 3072);
        else                  st_bf(acc, Pz   + (size_t)row0 * 1024 + (u.pn - 20) * 256 + colt, 1024);
    }
};
struct EpiResid {
    static constexpr bool PERM = false, AFTER_DRAIN = false;
    float* X; int ld;
    __device__ __forceinline__ void operator()(const f32x4 (&acc)[2][2][4][2], const Unit& u, int wr, int wc, int fr, int fq) const {
        float* base = X + (size_t)(u.pm * 256 + wr * 64 + fr) * ld + u.pn * 256 + wc * 32 + 4 * fq;
#pragma unroll
        for (int ai = 0; ai < 2; ++ai)
#pragma unroll
            for (int m = 0; m < 4; ++m) { float* rp = base + (size_t)(ai * 128 + m * 16) * ld;
#pragma unroll
                for (int bj = 0; bj < 2; ++bj)
#pragma unroll
                    for (int n = 0; n < 2; ++n) { f32x4* q = (f32x4*)(rp + bj * 128 + n * 16); *q = *q + acc[ai][bj][m][n]; } }
    }
};
struct EpiBf {
    static constexpr bool PERM = false, AFTER_DRAIN = false;
    bf16_t* O; int ld;
    __device__ __forceinline__ void operator()(const f32x4 (&acc)[2][2][4][2], const Unit& u, int wr, int wc, int fr, int fq) const {
        bf16_t* base = O + (size_t)(u.pm * 256 + wr * 64 + fr) * ld + u.pn * 256 + wc * 32 + 4 * fq;
#pragma unroll
        for (int ai = 0; ai < 2; ++ai)
#pragma unroll
            for (int m = 0; m < 4; ++m) { bf16_t* rp = base + (size_t)(ai * 128 + m * 16) * ld;
#pragma unroll
                for (int bj = 0; bj < 2; ++bj)
#pragma unroll
                    for (int n = 0; n < 2; ++n) { const f32x4 v = acc[ai][bj][m][n]; u32x2 w; w.x = pk2(v[0], v[1]); w.y = pk2(v[2], v[3]); *(u32x2*)(rp + bj * 128 + n * 16) = w; } }
    }
};
struct EpiGlu {
    static constexpr bool PERM = false, AFTER_DRAIN = false;
    const bf16_t* Y; float* O;
    __device__ __forceinline__ void operator()(const f32x4 (&acc)[2][2][4][2], const Unit& u, int wr, int wc, int fr, int fq) const {
        const size_t off0 = (size_t)(u.pm * 256 + wr * 64 + fr) * 512 + u.pn * 256 + wc * 32 + 4 * fq;
#pragma unroll
        for (int ai = 0; ai < 2; ++ai)
#pragma unroll
            for (int m = 0; m < 4; ++m) { const size_t ro = off0 + (size_t)(ai * 128 + m * 16) * 512;
#pragma unroll
                for (int bj = 0; bj < 2; ++bj)
#pragma unroll
                    for (int n = 0; n < 2; ++n) { const size_t o = ro + bj * 128 + n * 16; const u32x2 yw = *(const u32x2*)(Y + o); const f32x4 a = acc[ai][bj][m][n];
                        f32x4 r; r[0] = bflo(yw.x) * sigmoidf_(a[0]); r[1] = bfhi(yw.x) * sigmoidf_(a[1]); r[2] = bflo(yw.y) * sigmoidf_(a[2]); r[3] = bfhi(yw.y) * sigmoidf_(a[3]); *(f32x4*)(O + o) = r; } }
    }
};
__device__ __forceinline__ int map_in_col(int n) { return n < 1304 ? n : (n < 1312 ? 5912 + (n - 1304) : (n < 1320 ? 5920 + (n - 1312) : (n < 1536 ? -1 : 1304 + (n - 1536)))); }
__device__ void convT_tile(const float* __restrict__ src, int srcN, int K, bf16_t* __restrict__ dst, int tile, bool inmap, float* sm) {
    const int nk = K >> 6, tk = tile % nk, tn = tile / nk, k0 = tk * 64, n0 = tn * 256;
    const int tid = tidx(), tx = tid & 255, ty = tid >> 8;
    const int n = n0 + tx, sc = inmap ? map_in_col(n) : n;
    float v[32];
#pragma unroll
    for (int i = 0; i < 32; ++i) v[i] = (sc >= 0) ? src[(size_t)(k0 + ty + 2 * i) * srcN + sc] : 0.f;
#pragma unroll
    for (int i = 0; i < 32; ++i) sm[(ty + 2 * i) * 257 + tx] = v[i];
    __syncthreads();
    const int nn = tid >> 1, hf = tid & 1;
    bf16_t* o = dst + (size_t)(n0 + nn) * K + k0 + hf * 32;
#pragma unroll
    for (int q = 0; q < 4; ++q) { u32x4 w; const float* sp = sm + (hf * 32 + q * 8) * 257 + nn;
        w.x = pk2(sp[0], sp[257]); w.y = pk2(sp[2 * 257], sp[3 * 257]); w.z = pk2(sp[4 * 257], sp[5 * 257]); w.w = pk2(sp[6 * 257], sp[7 * 257]); *(u32x4*)(o + q * 8) = w; }
    __syncthreads();
}
__device__ void phase_convert(const Params& p, int layer, float* sm) {
    unsigned char* ws = p.ws;
    const int G = gridDim.x, b = blockIdx.x;
    const int n0 = 32 * 24, n1 = n0 + 32 * 8, n2 = n1 + 32 * 43, n3 = n2 + 86 * 8, n4 = n3 + 32, n5 = n4 + 32, n6 = n5 + 16;
    for (int it = b; it < n6; it += G) {
        if (it < n0)      convT_tile(p.in[2]  + (size_t)layer * DM * 5928, 5928, DM, (bf16_t*)(ws + O_WIN), it, true, sm);
        else if (it < n1) convT_tile(p.in[27] + (size_t)layer * DM * DM, DM, DM, (bf16_t*)(ws + O_WOUT), it - n0, false, sm);
        else if (it < n2) convT_tile(p.in[29] + (size_t)layer * DM * NFF, NFF, DM, (bf16_t*)(ws + O_WFIN), it - n1, false, sm);
        else if (it < n3) convT_tile(p.in[32] + (size_t)layer * DFF * DM, DM, DFF, (bf16_t*)(ws + O_WFOUT), it - n2, false, sm);
        else if (it < n4) convT_tile(p.in[8]  + (size_t)layer * 2048 * 256, 256, 2048, (bf16_t*)(ws + O_WCK), it - n3, false, sm);
        else if (it < n5) convT_tile(p.in[10] + (size_t)layer * 2048 * 256, 256, 2048, (bf16_t*)(ws + O_WCV), it - n4, false, sm);
        else              convT_tile(p.in[21] + (size_t)layer * 512 * 512, 512, 512, (bf16_t*)(ws + O_WGLU), it - n5, false, sm);
    }
}
__device__ void phase_rmsnorm(const float* __restrict__ x, const float* __restrict__ gain, bf16_t* __restrict__ hn, float* __restrict__ xcopy) {
    const int wave = tidx() >> 6, lane = tidx() & 63;
    for (int r = blockIdx.x * 8 + wave; r < T_; r += gridDim.x * 8) {
        const f32x4* xr = (const f32x4*)(x + (size_t)r * DM);
        f32x4 v[8]; float ss = 0.f;
#pragma unroll
        for (int i = 0; i < 8; ++i) { v[i] = xr[lane + 64 * i]; ss += v[i][0] * v[i][0] + v[i][1] * v[i][1] + v[i][2] * v[i][2] + v[i][3] * v[i][3]; }
        ss = wave_sum(ss);
        const float rs = rsqrtf(ss * (1.0f / DM) + 1e-6f);
#pragma unroll
        for (int i = 0; i < 8; ++i) { const f32x4 g = ((const f32x4*)gain)[lane + 64 * i]; u32x2 w; w.x = pk2(v[i][0] * rs * g[0], v[i][1] * rs * g[1]); w.y = pk2(v[i][2] * rs * g[2], v[i][3] * rs * g[3]);
            *(u32x2*)(hn + (size_t)r * DM + (lane + 64 * i) * 4) = w; if (xcopy) ((f32x4*)(xcopy + (size_t)r * DM))[lane + 64 * i] = v[i]; }
    }
}

__device__ void nsa_prep_item(const Params& p, int layer, int item, float* sm) {
    unsigned char* ws = p.ws;
    const float* P32 = (const float*)(ws + O_P32);
    bf16_t* qn = (bf16_t*)(ws + O_QN); bf16_t* ksn = (bf16_t*)(ws + O_KSN); bf16_t* kwn = (bf16_t*)(ws + O_KWN);
    const int wave = tidx() >> 6, lane = tidx() & 63, tid = tidx();
    const int t0 = item * 64;
    const float gq = p.in[3][layer * 64 + lane], gks = p.in[5][layer * 64 + lane], gkw = p.in[6][layer * 64 + lane];
    const float inv = powf(500000.0f, -(float)(lane & 7) * 0.125f);
    for (int tt = 0; tt < 8; ++tt) {
        const int t = t0 + wave * 8 + tt;
        float sn, cs; sincosf((float)t * inv, &sn, &cs);
        const float* row = P32 + (size_t)t * 1536;
#pragma unroll
        for (int hv = 0; hv < 12; ++hv) {
            const int col = hv < 8 ? hv * 64 : (hv < 10 ? 768 + (hv - 8) * 64 : 1024 + (hv - 10) * 64);
            const float g = hv < 8 ? gq : (hv < 10 ? gks : gkw);
            const float x = row[col + lane];
            const float ss = wave_sum(x * x);
            float y = x * rsqrtf(ss * (1.0f / 64.0f) + 1e-6f) * g;
            const float yp = __shfl(y, lane ^ 8);
            if (lane < 8) y = y * cs - yp * sn; else if (lane < 16) y = y * cs + yp * sn;
            if (hv < 8) qn[(size_t)t * 512 + hv * 64 + lane] = f2bf(y * 0.18033688011112042f);
            else if (hv < 10) ksn[(size_t)t * 128 + (hv - 8) * 64 + lane] = f2bf(y);
            else kwn[(size_t)t * 128 + (hv - 10) * 64 + lane] = f2bf(y);
        }
    }
    for (int e = tid; e < 64 * 256; e += 512) { const int tk = e >> 8, c = e & 255; sm[tk * 257 + c] = P32[(size_t)(t0 + tk) * 1536 + (c < 128 ? 896 + c : 1152 + (c - 128))]; }
    __syncthreads();
    unsigned char* vs8 = ws + O_VST; unsigned char* vw8 = ws + O_VWT;
#pragma unroll
    for (int i = 0; i < 4; ++i) {
        const int rowid = (tid >> 3) + 64 * i, ts = tid & 7;
        float f[8];
#pragma unroll
        for (int k = 0; k < 8; ++k) { const int bb = ts * 8 + k, cc = ((bb >> 3) & 1) * 32 + (bb >> 4) * 8 + (bb & 7); f[k] = sm[((cc & 3) * 16 + (cc >> 2)) * 257 + rowid]; }
        u32x2 w; int t;
        t = __builtin_amdgcn_cvt_pk_fp8_f32(f[0], f[1], 0, false); t = __builtin_amdgcn_cvt_pk_fp8_f32(f[2], f[3], t, true); w.x = (unsigned)t;
        t = __builtin_amdgcn_cvt_pk_fp8_f32(f[4], f[5], 0, false); t = __builtin_amdgcn_cvt_pk_fp8_f32(f[6], f[7], t, true); w.y = (unsigned)t;
        const int rr = rowid & 127;
        unsigned char* dst = (rowid < 128 ? vs8 : vw8) + ((size_t)((rr >> 6) * 256 + item) * 64 + (rr & 63)) * 64 + ts * 8;
        *(u32x2*)dst = w;
    }
    __syncthreads();
}

__device__ void cmp1_wave_tile(const Params& p, int layer, int tile) {
    unsigned char* ws = p.ws;
    const float* P32 = (const float*)(ws + O_P32);
    const int lane = tidx() & 63, fr = lane & 15, fq = lane >> 4;
    const int nt = tile & 15, mt = (tile >> 4) & 127, which = tile >> 11;
    const bf16_t* Wt = (const bf16_t*)(ws + (which ? O_WCV : O_WCK)) + (size_t)(nt * 16 + fr) * 2048 + fq * 8;
    const float* pe = p.in[7] + (size_t)layer * 2048;
    const int r = mt * 16 + fr, n = r >> 1, hk = r & 1;
    const bool rv = n < 1023;
    const float* arow = P32 + (size_t)(16 * (rv ? n : 0)) * 1536 + (which ? 640 : 512) + hk * 64 + fq * 8;
    f32x4 acc = {0.f, 0.f, 0.f, 0.f};
#pragma unroll 4
    for (int ks = 0; ks < 64; ++ks) {
        const int l = ks >> 1, d = (ks & 1) * 32;
        const f32x4* ap = (const f32x4*)(arow + (size_t)l * 1536 + d);
        const f32x4* pp = (const f32x4*)(pe + l * 64 + d + fq * 8);
        f32x4 a0 = ap[0] + pp[0], a1 = ap[1] + pp[1];
        if (!rv) { a0 = (f32x4){0.f, 0.f, 0.f, 0.f}; a1 = a0; }
        const bf16x8 af = pack8f(a0, a1);
        const bf16x8 bf = *(const bf16x8*)(Wt + ks * 32);
        acc = MFMA16(af, bf, acc);
    }
    float* H = (float*)(ws + O_HCMP) + (size_t)which * 2048 * 256;
#pragma unroll
    for (int j = 0; j < 4; ++j) H[(size_t)(mt * 16 + fq * 4 + j) * 256 + nt * 16 + fr] = gelu_tanh(acc[j]);
}
__device__ void cmp2_wave_row(const Params& p, int layer, int idx) {
    unsigned char* ws = p.ws;
    const int lane = tidx() & 63;
    const int which = idx >> 11, r = idx & 2047, n = r >> 1, hk = r & 1;
    const float* H = (const float*)(ws + O_HCMP) + ((size_t)which * 2048 + r) * 256;
    const float* w2 = p.in[which ? 11 : 9] + (size_t)layer * 256 * 64;
    float acc = 0.f;
    if (n < 1023) {
#pragma unroll 8
        for (int f = 0; f < 256; ++f) acc += H[f] * w2[f * 64 + lane];
    }
    if (which == 0) {
        const float ss = wave_sum(acc * acc);
        float y = acc * rsqrtf(ss * (1.0f / 64.0f) + 1e-6f) * p.in[4][layer * 64 + lane];
        const float inv = powf(500000.0f, -(float)(lane & 7) * 0.125f);
        float sn, cs; sincosf((float)(16 * n + 16) * inv, &sn, &cs);
        const float yp = __shfl(y, lane ^ 8);
        if (lane < 8) y = y * cs - yp * sn; else if (lane < 16) y = y * cs + yp * sn;
        if (n >= 1023) y = 0.f;
        ((bf16_t*)(ws + O_KC))[((size_t)hk * 1024 + n) * 64 + lane] = f2bf(y);
    } else {
        { const int cc = ((n & 15) << 2) | ((n >> 4) & 3); (ws + O_VCT)[((size_t)(hk * 16 + (n >> 6)) * 64 + lane) * 64 + ((cc >> 3) & 3) * 16 + (cc >> 5) * 8 + (cc & 7)] = (unsigned char)__builtin_amdgcn_cvt_pk_fp8_f32(acc, 0.f, 0, false); }
    }
}

struct S5Coef { float ar, ai; float bbr[16], bbi[16]; };
__device__ __forceinline__ void s5_setup(const Params& p, int layer, int g, int lane, S5Coef& c) {
    const int gp = layer * 2048 + g * 64 + lane;
    const float dt = expf(p.in[15][layer * 32 + g]);
    const float lr = p.in[13][gp], li = p.in[14][gp];
    const float mag = expf(lr * dt); float sn, cs; sincosf(li * dt, &sn, &cs);
    c.ar = mag * cs; c.ai = mag * sn;
    const float den = lr * lr + li * li, nr = c.ar - 1.0f, ni = c.ai;
    const float cr = (nr * lr + ni * li) / den, ci = (ni * lr - nr * li) / den;
    const f32x4* br = (const f32x4*)(p.in[16] + (size_t)gp * 16); const f32x4* bi = (const f32x4*)(p.in[17] + (size_t)gp * 16);
#pragma unroll
    for (int q = 0; q < 4; ++q) { const f32x4 a = br[q], b = bi[q];
#pragma unroll
        for (int e = 0; e < 4; ++e) { c.bbr[q * 4 + e] = cr * a[e] - ci * b[e]; c.bbi[q * 4 + e] = cr * b[e] + ci * a[e]; } }
}
__device__ __forceinline__ void s5_load_u(const bf16_t* Pu, int tok, int g, float (&ur)[16]) {
    const u32x4* s = (const u32x4*)(Pu + (size_t)tok * 512 + g * 16); const u32x4 a = s[0], b = s[1];
    ur[0] = bflo(a.x); ur[1] = bfhi(a.x); ur[2] = bflo(a.y); ur[3] = bfhi(a.y); ur[4] = bflo(a.z); ur[5] = bfhi(a.z); ur[6] = bflo(a.w); ur[7] = bfhi(a.w);
    ur[8] = bflo(b.x); ur[9] = bfhi(b.x); ur[10] = bflo(b.y); ur[11] = bfhi(b.y); ur[12] = bflo(b.z); ur[13] = bfhi(b.z); ur[14] = bflo(b.w); ur[15] = bfhi(b.w);
}
__device__ void s5_passA_wave(const Params& p, int layer, int item) {
    unsigned char* ws = p.ws; const bf16_t* Pu = (const bf16_t*)(ws + O_PU);
    const int lane = tidx() & 63, c = item >> 5, g = item & 31;
    S5Coef k; s5_setup(p, layer, g, lane, k);
    float xr = 0.f, xi = 0.f;
    for (int sub = 0; sub < 4; ++sub) {
        float ur[16]; s5_load_u(Pu, c * 256 + sub * 64 + lane, g, ur);
        for (int j = 0; j < 64; ++j) {
            float bur = 0.f, bui = 0.f;
#pragma unroll
            for (int h = 0; h < 16; ++h) { const float u = rdlane(ur[h], j); bur += k.bbr[h] * u; bui += k.bbi[h] * u; }
            const float nxr = k.ar * xr - k.ai * xi + bur, nxi = k.ar * xi + k.ai * xr + bui; xr = nxr; xi = nxi;
        }
    }
    float* xe = (float*)(ws + O_XEND) + ((size_t)(c * 32 + g) * 64 + lane) * 2; xe[0] = xr; xe[1] = xi;
}
__device__ void s5_passB_wave(const Params& p, int layer, int item, bf16_t* xl) {
    unsigned char* ws = p.ws; const bf16_t* Pu = (const bf16_t*)(ws + O_PU); bf16_t* yg = (bf16_t*)(ws + O_YGELU);
    const int lane = tidx() & 63, fr = lane & 15, fq = lane >> 4, c = item >> 5, g = item & 31;
    S5Coef k; s5_setup(p, layer, g, lane, k);
    float pr = k.ar, pi = k.ai;
#pragma unroll
    for (int s = 0; s < 8; ++s) { const float nr = pr * pr - pi * pi, ni = 2.f * pr * pi; pr = nr; pi = ni; }
    float xr = 0.f, xi = 0.f;
    const float* xe = (const float*)(ws + O_XEND) + ((size_t)g * 64 + lane) * 2;
    for (int cc = 0; cc < c; ++cc) { const float er = xe[(size_t)cc * 32 * 64 * 2], ei = xe[(size_t)cc * 32 * 64 * 2 + 1]; const float nr = pr * xr - pi * xi + er, ni = pr * xi + pi * xr + ei; xr = nr; xi = ni; }
    bf16x8 cf[4];
    {
        const float* cre = p.in[18] + (size_t)layer * 32 * 16 * 64 + ((size_t)g * 16 + fr) * 64; const float* cim = p.in[19] + (size_t)layer * 32 * 16 * 64 + ((size_t)g * 16 + fr) * 64;
#pragma unroll
        for (int ks = 0; ks < 4; ++ks) { const float* s = (ks < 2 ? cre : cim) + (ks & 1) * 32 + fq * 8; f32x4 a = ((const f32x4*)s)[0], b = ((const f32x4*)s)[1]; if (ks >= 2) { a = -a; b = -b; } cf[ks] = pack8f(a, b); }
    }
    const float dsk = p.in[20][layer * 512 + g * 16 + fr];
    for (int sub = 0; sub < 4; ++sub) {
        const int tb = c * 256 + sub * 64;
        float ur[16]; s5_load_u(Pu, tb + lane, g, ur);
        for (int jb = 0; jb < 4; ++jb) {
            for (int jj = 0; jj < 16; ++jj) {
                const int j = jb * 16 + jj;
                float bur = 0.f, bui = 0.f;
#pragma unroll
                for (int h = 0; h < 16; ++h) { const float u = rdlane(ur[h], j); bur += k.bbr[h] * u; bui += k.bbi[h] * u; }
                const float nxr = k.ar * xr - k.ai * xi + bur, nxi = k.ar * xi + k.ai * xr + bui; xr = nxr; xi = nxi;
                xl[jj * 136 + lane] = f2bf(xr); xl[jj * 136 + 64 + lane] = f2bf(xi);
            }
            asm volatile("s_waitcnt lgkmcnt(0)" ::: "memory");
            f32x4 y = {0.f, 0.f, 0.f, 0.f};
#pragma unroll
            for (int ks = 0; ks < 4; ++ks) { const bf16x8 af = *(const bf16x8*)(xl + fr * 136 + ks * 32 + fq * 8); y = MFMA16(af, cf[ks], y); }
            asm volatile("s_waitcnt lgkmcnt(0)" ::: "memory");
#pragma unroll
            for (int q = 0; q < 4; ++q) { const int tok = tb + jb * 16 + fq * 4 + q; const float u = bf2f(Pu[(size_t)tok * 512 + g * 16 + fr]); yg[(size_t)tok * 512 + g * 16 + fr] = f2bf(gelu_tanh(y[q] + dsk * u)); }
        }
    }
}
__device__ void gdn_prep_item(const Params& p, int layer, int item, unsigned char* lds) {
    unsigned char* ws = p.ws;
    const int tid = tidx(), wave = tid >> 6, lane = tid & 63, fr = lane & 15, fq = lane >> 4;
    const int n = item >> 3, h = item & 7, t0 = n * 64;
    bf16_t* qs = (bf16_t*)(lds); bf16_t* ks = (bf16_t*)(lds + 17408); bf16_t* vbT = (bf16_t*)(lds + 34816); bf16_t* kgT = (bf16_t*)(lds + 53248); bf16_t* kdT = (bf16_t*)(lds + 71680);
    float* Am = (float*)(lds + 90112); bf16_t* Tb = (bf16_t*)(lds + 107520); float* gcs = (float*)(lds + 116736); float* bts = (float*)(lds + 116992);
    const float* P32 = (const float*)(ws + O_P32); const bf16_t* Pqkv = (const bf16_t*)(ws + O_PQKV);
    if (wave == 0) {
        const int t = t0 + lane;
        const float a = P32[(size_t)t * 1536 + 1304 + h], b = P32[(size_t)t * 1536 + 1312 + h];
        const float g = -expf(p.in[24][layer * 8 + h]) * softplusf_(a + p.in[25][layer * 8 + h]);
        float s = g;
#pragma unroll
        for (int off = 1; off < 64; off <<= 1) { const float o = __shfl_up(s, off); if (lane >= off) s += o; }
        gcs[lane] = s; bts[lane] = sigmoidf_(b);
    }
    __syncthreads();
    {
        const int r = tid >> 3, c0 = (tid & 7) * 16;
        const float gcr = gcs[r], btr = bts[r], eg = expf(gcr), ed = expf(gcs[63] - gcr);
        const float* cw = p.in[23] + (size_t)layer * 4 * 3072;
#pragma unroll
        for (int which = 0; which < 3; ++which) {
            const int col = which * 1024 + h * 128 + c0;
            float acc[16];
#pragma unroll
            for (int e = 0; e < 16; ++e) acc[e] = 0.f;
#pragma unroll
            for (int j = 0; j < 4; ++j) {
                const int tr = t0 + r - 3 + j;
                if (tr >= 0) {
                    const u32x4* s = (const u32x4*)(Pqkv + (size_t)tr * 3072 + col); const u32x4 a = s[0], b = s[1];
                    const f32x4* wp = (const f32x4*)(cw + j * 3072 + col); const f32x4 w0 = wp[0], w1 = wp[1], w2 = wp[2], w3 = wp[3];
                    acc[0] += w0[0] * bflo(a.x); acc[1] += w0[1] * bfhi(a.x); acc[2] += w0[2] * bflo(a.y); acc[3] += w0[3] * bfhi(a.y);
                    acc[4] += w1[0] * bflo(a.z); acc[5] += w1[1] * bfhi(a.z); acc[6] += w1[2] * bflo(a.w); acc[7] += w1[3] * bfhi(a.w);
                    acc[8] += w2[0] * bflo(b.x); acc[9] += w2[1] * bfhi(b.x); acc[10] += w2[2] * bflo(b.y); acc[11] += w2[3] * bfhi(b.y);
                    acc[12] += w3[0] * bflo(b.z); acc[13] += w3[1] * bfhi(b.z); acc[14] += w3[2] * bflo(b.w); acc[15] += w3[3] * bfhi(b.w);
                }
            }
            float ss = 0.f;
#pragma unroll
            for (int e = 0; e < 16; ++e) { acc[e] = siluf_(acc[e]); ss += acc[e] * acc[e]; }
            ss += __shfl_xor(ss, 1); ss += __shfl_xor(ss, 2); ss += __shfl_xor(ss, 4);
            const float rn = rsqrtf(ss + 1e-6f);
            if (which == 0) {
                bf16_t* qg = (bf16_t*)(ws + O_GQG) + (size_t)item * 8192 + r * 128 + c0;
                float v[16];
#pragma unroll
                for (int e = 0; e < 16; ++e) v[e] = acc[e] * rn * 0.08838834764831845f;
                u32x4 w0, w1; w0.x = pk2(v[0], v[1]); w0.y = pk2(v[2], v[3]); w0.z = pk2(v[4], v[5]); w0.w = pk2(v[6], v[7]); w1.x = pk2(v[8], v[9]); w1.y = pk2(v[10], v[11]); w1.z = pk2(v[12], v[13]); w1.w = pk2(v[14], v[15]);
                *(u32x4*)(qs + r * 136 + c0) = w0; *(u32x4*)(qs + r * 136 + c0 + 8) = w1;
                u32x4 g0, g1; g0.x = pk2(v[0] * eg, v[1] * eg); g0.y = pk2(v[2] * eg, v[3] * eg); g0.z = pk2(v[4] * eg, v[5] * eg); g0.w = pk2(v[6] * eg, v[7] * eg);
                g1.x = pk2(v[8] * eg, v[9] * eg); g1.y = pk2(v[10] * eg, v[11] * eg); g1.z = pk2(v[12] * eg, v[13] * eg); g1.w = pk2(v[14] * eg, v[15] * eg);
                *(u32x4*)qg = g0; *(u32x4*)(qg + 8) = g1;
            } else if (which == 1) {
                float v[16];
#pragma unroll
                for (int e = 0; e < 16; ++e) v[e] = acc[e] * rn;
                u32x4 w0, w1; w0.x = pk2(v[0], v[1]); w0.y = pk2(v[2], v[3]); w0.z = pk2(v[4], v[5]); w0.w = pk2(v[6], v[7]); w1.x = pk2(v[8], v[9]); w1.y = pk2(v[10], v[11]); w1.z = pk2(v[12], v[13]); w1.w = pk2(v[14], v[15]);
                *(u32x4*)(ks + r * 136 + c0) = w0; *(u32x4*)(ks + r * 136 + c0 + 8) = w1;
#pragma unroll
                for (int e = 0; e < 16; ++e) { kgT[(c0 + e) * 72 + r] = f2bf(v[e] * btr * eg); kdT[(c0 + e) * 72 + r] = f2bf(v[e] * ed); }
            } else {
#pragma unroll
                for (int e = 0; e < 16; ++e) vbT[(c0 + e) * 72 + r] = f2bf(acc[e] * btr);
            }
        }
    }
    __syncthreads();
    {
        const int d = tid >> 2, sg = tid & 3;
        const u32x4 a = *(const u32x4*)(kdT + d * 72 + sg * 16), b = *(const u32x4*)(kdT + d * 72 + sg * 16 + 8);
        bf16_t* dst = (bf16_t*)(ws + O_GKD) + (size_t)item * 8192 + d * 64 + sg * 16; *(u32x4*)dst = a; *(u32x4*)(dst + 8) = b;
    }
    { float* Tmz = (float*)(lds + 117248); for (int e2 = tid; e2 < 64 * 68; e2 += 512) Tmz[e2] = 0.f; }
    {
        const int mi = wave >> 1;
        bf16_t* qko = (bf16_t*)(ws + O_GQK) + (size_t)item * 4096;
#pragma unroll
        for (int q = 0; q < 2; ++q) {
            const int nj = (wave & 1) * 2 + q;
            f32x4 kk = {0.f, 0.f, 0.f, 0.f}, qk = {0.f, 0.f, 0.f, 0.f};
            if (nj <= mi) {
#pragma unroll
                for (int s = 0; s < 4; ++s) {
                    const bf16x8 bk = *(const bf16x8*)(ks + (nj * 16 + fr) * 136 + s * 32 + fq * 8);
                    const bf16x8 ak = *(const bf16x8*)(ks + (mi * 16 + fr) * 136 + s * 32 + fq * 8);
                    const bf16x8 aq = *(const bf16x8*)(qs + (mi * 16 + fr) * 136 + s * 32 + fq * 8);
                    kk = MFMA16(ak, bk, kk); qk = MFMA16(aq, bk, qk);
                }
            }
            const int j = nj * 16 + fr; const float gj = gcs[j];
#pragma unroll
            for (int e = 0; e < 4; ++e) {
                const int i = mi * 16 + fq * 4 + e;
                const float dec = (j <= i) ? expf(gcs[i] - gj) : 0.f;
                Am[i * 68 + j] = (j < i) ? bts[i] * kk[e] * dec : 0.f;
                qko[i * 64 + j] = f2bf((j <= i) ? qk[e] * dec : 0.f);
            }
        }
    }
    __syncthreads();
    {
        float* Tm = (float*)(lds + 117248); float* Ps = (float*)(lds + 134656) + wave * 320;
        if (wave == 0) {
            const int bo = fq * 16; float t[16];
#pragma unroll
            for (int i = 0; i < 16; ++i) {
                float s = (i == fr) ? 1.f : 0.f;
#pragma unroll
                for (int j = 0; j < i; ++j) s -= Am[(bo + i) * 68 + bo + j] * t[j];
                t[i] = s; Tm[(bo + i) * 68 + bo + fr] = s;
            }
        }
        asm volatile("s_waitcnt lgkmcnt(0)" ::: "memory"); __syncthreads();
#pragma unroll
        for (int d = 1; d < 4; ++d) {
            if (wave < 4 - d) {
                const int bi = wave + d, bj = wave;
                f32x4 Q = {0.f, 0.f, 0.f, 0.f};
                for (int kb = bj; kb < bi; ++kb) {
                    const float* X = Am + (bi * 16) * 68 + kb * 16; const float* Y = Tm + (kb * 16) * 68 + bj * 16;
#pragma unroll
                    for (int s = 0; s < 4; ++s) Q = __builtin_amdgcn_mfma_f32_16x16x4f32(X[fr * 68 + 4 * s + fq], Y[(4 * s + fq) * 68 + fr], Q, 0, 0, 0);
                }
#pragma unroll
                for (int e2 = 0; e2 < 4; ++e2) Ps[(fq * 4 + e2) * 20 + fr] = Q[e2];
                asm volatile("s_waitcnt lgkmcnt(0)" ::: "memory");
                f32x4 R = {0.f, 0.f, 0.f, 0.f};
                const float* X = Tm + (bi * 16) * 68 + bi * 16;
#pragma unroll
                for (int s = 0; s < 4; ++s) R = __builtin_amdgcn_mfma_f32_16x16x4f32(X[fr * 68 + 4 * s + fq], Ps[(4 * s + fq) * 20 + fr], R, 0, 0, 0);
#pragma unroll
                for (int e2 = 0; e2 < 4; ++e2) Tm[(bi * 16 + fq * 4 + e2) * 68 + bj * 16 + fr] = -R[e2];
            }
            asm volatile("s_waitcnt lgkmcnt(0)" ::: "memory"); __syncthreads();
        }
        for (int e2 = tid; e2 < 4096; e2 += 512) { const int r = e2 >> 6, c = e2 & 63; Tb[r * 72 + c] = f2bf(Tm[r * 68 + c]); }
    }
    __syncthreads();
    {
        const int mi = wave & 3;
        const bf16x8 a0 = *(const bf16x8*)(Tb + (mi * 16 + fr) * 72 + fq * 8), a1 = *(const bf16x8*)(Tb + (mi * 16 + fr) * 72 + 32 + fq * 8);
        float* vo = (float*)(ws + O_GVAL) + (size_t)item * 8192; bf16_t* ko = (bf16_t*)(ws + O_GKC) + (size_t)item * 8192;
#pragma unroll
        for (int q = 0; q < 4; ++q) {
            const int nt = (wave >> 2) * 4 + q;
            f32x4 v = {0.f, 0.f, 0.f, 0.f}, kc = {0.f, 0.f, 0.f, 0.f};
            v = MFMA16(a0, *(const bf16x8*)(vbT + (nt * 16 + fr) * 72 + fq * 8), v); v = MFMA16(a1, *(const bf16x8*)(vbT + (nt * 16 + fr) * 72 + 32 + fq * 8), v);
            kc = MFMA16(a0, *(const bf16x8*)(kgT + (nt * 16 + fr) * 72 + fq * 8), kc); kc = MFMA16(a1, *(const bf16x8*)(kgT + (nt * 16 + fr) * 72 + 32 + fq * 8), kc);
#pragma unroll
            for (int e = 0; e < 4; ++e) { const int i = mi * 16 + fq * 4 + e, d = nt * 16 + fr; vo[i * 128 + d] = v[e]; ko[i * 128 + d] = f2bf(kc[e]); }
        }
    }
    if (tid == 0) ((float*)(ws + O_GEGL))[item] = expf(gcs[63]);
    __syncthreads();
}

struct GdnUO { bf16x8 kc[4], qg[4], qk[2]; float val[2][4]; };
struct GdnSU { bf16x8 kd[2][2]; float egl; };
__device__ __forceinline__ void gdn_load_uo(const unsigned char* ws, int item, int mt, int fr, int fq, int dvb, GdnUO& f) {
    const bf16_t* kc = (const bf16_t*)(ws + O_GKC) + (size_t)item * 8192 + (mt * 16 + fr) * 128 + fq * 8;
    const bf16_t* qg = (const bf16_t*)(ws + O_GQG) + (size_t)item * 8192 + (mt * 16 + fr) * 128 + fq * 8;
    const bf16_t* qk = (const bf16_t*)(ws + O_GQK) + (size_t)item * 4096 + (mt * 16 + fr) * 64 + fq * 8;
    const float* vl = (const float*)(ws + O_GVAL) + (size_t)item * 8192 + (mt * 16 + fq * 4) * 128 + dvb + fr;
#pragma unroll
    for (int s = 0; s < 4; ++s) { f.kc[s] = *(const bf16x8*)(kc + s * 32); f.qg[s] = *(const bf16x8*)(qg + s * 32); }
#pragma unroll
    for (int s = 0; s < 2; ++s) f.qk[s] = *(const bf16x8*)(qk + s * 32);
#pragma unroll
    for (int nt = 0; nt < 2; ++nt)
#pragma unroll
        for (int e = 0; e < 4; ++e) f.val[nt][e] = vl[e * 128 + nt * 16];
}
__device__ __forceinline__ void gdn_load_su(const unsigned char* ws, int item, int w4, int fr, int fq, GdnSU& f) {
    const bf16_t* kd = (const bf16_t*)(ws + O_GKD) + (size_t)item * 8192 + (2 * w4 * 16 + fr) * 64 + fq * 8;
#pragma unroll
    for (int s = 0; s < 2; ++s) { f.kd[0][s] = *(const bf16x8*)(kd + s * 32); f.kd[1][s] = *(const bf16x8*)(kd + 16 * 64 + s * 32); }
    f.egl = ((const float*)(ws + O_GEGL))[item];
}
#define GDN_BAR() do { asm volatile("s_waitcnt lgkmcnt(0)" ::: "memory"); __builtin_amdgcn_s_barrier(); asm volatile("" ::: "memory"); } while (0)
__device__ __forceinline__ void gdn_step_uo(const GdnUO& c, bf16_t* Sl, bf16_t* vn, float* go, int n, int h, int mt, int fr, int fq, int dvb) {
    bf16x8 Sb[2][4];
#pragma unroll
    for (int nt = 0; nt < 2; ++nt)
#pragma unroll
        for (int s = 0; s < 4; ++s) Sb[nt][s] = *(const bf16x8*)(Sl + nt * (16 * 136) + fr * 136 + s * 32 + fq * 8);
    f32x4 U[2], O[2];
#pragma unroll
    for (int nt = 0; nt < 2; ++nt) { U[nt] = (f32x4){0.f, 0.f, 0.f, 0.f}; O[nt] = (f32x4){0.f, 0.f, 0.f, 0.f};
#pragma unroll
        for (int s = 0; s < 4; ++s) U[nt] = MFMA16(c.kc[s], Sb[nt][s], U[nt]);
        u32x2 w; w.x = pk2(c.val[nt][0] - U[nt][0], c.val[nt][1] - U[nt][1]); w.y = pk2(c.val[nt][2] - U[nt][2], c.val[nt][3] - U[nt][3]);
        *(u32x2*)(vn + nt * (16 * 72) + fr * 72 + mt * 16 + fq * 4) = w; }
#pragma unroll
    for (int nt = 0; nt < 2; ++nt)
#pragma unroll
        for (int s = 0; s < 4; ++s) O[nt] = MFMA16(c.qg[s], Sb[nt][s], O[nt]);
    GDN_BAR();
#pragma unroll
    for (int nt = 0; nt < 2; ++nt) {
        const bf16x8 V0 = *(const bf16x8*)(vn + nt * (16 * 72) + fr * 72 + fq * 8), V1 = *(const bf16x8*)(vn + nt * (16 * 72) + fr * 72 + 32 + fq * 8);
        O[nt] = MFMA16(c.qk[0], V0, O[nt]); O[nt] = MFMA16(c.qk[1], V1, O[nt]);
#pragma unroll
        for (int e = 0; e < 4; ++e) go[(size_t)(n * 64 + mt * 16 + fq * 4 + e) * 1024 + h * 128 + dvb + nt * 16 + fr] = O[nt][e];
    }
    GDN_BAR();
}
__device__ __forceinline__ void gdn_step_su(const GdnSU& c, f32x4 (&St)[2][2], bf16_t* Sl, const bf16_t* vn, int w4, int fr, int fq) {
    GDN_BAR();
#pragma unroll
    for (int nt = 0; nt < 2; ++nt) {
        const bf16x8 V0 = *(const bf16x8*)(vn + nt * (16 * 72) + fr * 72 + fq * 8), V1 = *(const bf16x8*)(vn + nt * (16 * 72) + fr * 72 + 32 + fq * 8);
#pragma unroll
        for (int q = 0; q < 2; ++q) {
            St[nt][q] = St[nt][q] * c.egl;
            St[nt][q] = MFMA16(V0, c.kd[q][0], St[nt][q]); St[nt][q] = MFMA16(V1, c.kd[q][1], St[nt][q]);
#pragma unroll
            for (int e = 0; e < 4; ++e) Sl[nt * (16 * 136) + (fq * 4 + e) * 136 + (2 * w4 + q) * 16 + fr] = f2bf(St[nt][q][e]);
        }
    }
    GDN_BAR();
}
__device__ void gdn_recurrence(const Params& p, int b, unsigned char* lds) {
    const unsigned char* ws = p.ws;
    const int tid = tidx(), wave = tid >> 6, lane = tid & 63, fr = lane & 15, fq = lane >> 4;
    const int h = b >> 2, dvb = (b & 3) * 32;
    bf16_t* Sl = (bf16_t*)lds; bf16_t* vn = (bf16_t*)(lds + 2 * 16 * 136 * 2);
    float* go = (float*)(p.ws + O_PQKV);
    for (int e = tid; e < 2 * 16 * 136; e += 512) Sl[e] = 0;
    __syncthreads();
    if (wave < 4) {
        const int mt = wave;
        GdnUO f0, f1, f2;
        gdn_load_uo(ws, h, mt, fr, fq, dvb, f0); gdn_load_uo(ws, 8 + h, mt, fr, fq, dvb, f1);
        for (int n = 0; n < 255; n += 3) {
            gdn_load_uo(ws, (n + 2) * 8 + h, mt, fr, fq, dvb, f2); gdn_step_uo(f0, Sl, vn, go, n, h, mt, fr, fq, dvb);
            gdn_load_uo(ws, (n + 3) * 8 + h, mt, fr, fq, dvb, f0); gdn_step_uo(f1, Sl, vn, go, n + 1, h, mt, fr, fq, dvb);
            if (n + 4 < 256) gdn_load_uo(ws, (n + 4) * 8 + h, mt, fr, fq, dvb, f1);
            gdn_step_uo(f2, Sl, vn, go, n + 2, h, mt, fr, fq, dvb);
        }
        gdn_step_uo(f0, Sl, vn, go, 255, h, mt, fr, fq, dvb);
    } else {
        const int w4 = wave - 4;
        f32x4 St[2][2];
#pragma unroll
        for (int a = 0; a < 2; ++a)
#pragma unroll
            for (int c = 0; c < 2; ++c) St[a][c] = (f32x4){0.f, 0.f, 0.f, 0.f};
        GdnSU f0, f1, f2;
        gdn_load_su(ws, h, w4, fr, fq, f0); gdn_load_su(ws, 8 + h, w4, fr, fq, f1);
        for (int n = 0; n < 255; n += 3) {
            gdn_load_su(ws, (n + 2) * 8 + h, w4, fr, fq, f2); gdn_step_su(f0, St, Sl, vn, w4, fr, fq);
            gdn_load_su(ws, (n + 3) * 8 + h, w4, fr, fq, f0); gdn_step_su(f1, St, Sl, vn, w4, fr, fq);
            if (n + 4 < 256) gdn_load_su(ws, (n + 4) * 8 + h, w4, fr, fq, f1);
            gdn_step_su(f2, St, Sl, vn, w4, fr, fq);
        }
        gdn_step_su(f0, St, Sl, vn, w4, fr, fq);
    }
}
struct KVF { bf16x8 k[4][2]; };
__device__ __forceinline__ void kv_load(const bf16_t* kp, int ldk, KVF& f) {
#pragma unroll
    for (int s = 0; s < 4; ++s) { f.k[s][0] = *(const bf16x8*)(kp + (size_t)(s * 16) * ldk); f.k[s][1] = *(const bf16x8*)(kp + (size_t)(s * 16) * ldk + 32); }
}
template <int CTRL> __device__ __forceinline__ float dppf(float v) { return __int_as_float(__builtin_amdgcn_update_dpp(0, __float_as_int(v), CTRL, 0xF, 0xF, true)); }
template <int CTRL> __device__ __forceinline__ unsigned dppu(unsigned v) { return (unsigned)__builtin_amdgcn_update_dpp(0, (int)v, CTRL, 0xF, 0xF, true); }
__device__ __forceinline__ float rmax16(float v) { v = vmaxf(v, dppf<0xB1>(v)); v = vmaxf(v, dppf<0x4E>(v)); v = vmaxf(v, dppf<0x124>(v)); v = vmaxf(v, dppf<0x128>(v)); return v; }
__device__ __forceinline__ float rsum16(float v) { v += dppf<0xB1>(v); v += dppf<0x4E>(v); v += dppf<0x124>(v); v += dppf<0x128>(v); return v; }
template <int CTRL> __device__ __forceinline__ unsigned long long dppmax64(unsigned long long b) { const unsigned lo = dppu<CTRL>((unsigned)b), hi = dppu<CTRL>((unsigned)(b >> 32)); const unsigned long long ob = ((unsigned long long)hi << 32) | lo; return ob > b ? ob : b; }
#define MFMA8(a, b, c) __builtin_amdgcn_mfma_f32_16x16x32_fp8_fp8((a), (b), (c), 0, 0, 0)
__device__ __forceinline__ void flash_compute(const bf16x8 (&Qf)[2], KVF& f, const bf16_t* knext, int ldk, const unsigned char* vp, unsigned vmask, float (&m)[4], float (&l)[4], f32x4 (&O)[4], unsigned char* Pt, int fr, int fq) {
    f32x4 S[4];
    u32x4 Vw[4];
#pragma unroll
    for (int dt = 0; dt < 4; ++dt) Vw[dt] = *(const u32x4*)(vp + dt * 1024);
#pragma unroll
    for (int s = 0; s < 4; ++s) { S[s] = (f32x4){0.f, 0.f, 0.f, 0.f}; S[s] = MFMA16(Qf[0], f.k[s][0], S[s]); S[s] = MFMA16(Qf[1], f.k[s][1], S[s]); }
    if (knext) kv_load(knext, ldk, f);
    float mx[4];
#pragma unroll
    for (int j = 0; j < 4; ++j) { float v = -1e30f;
#pragma unroll
        for (int s = 0; s < 4; ++s) v = ((vmask >> s) & 1u) ? vmaxf(v, S[s][j]) : v;
        mx[j] = rmax16(v); }
#pragma unroll
    for (int j = 0; j < 4; ++j) { const float mn = vmaxf(m[j], mx[j]); const float a = __builtin_amdgcn_exp2f(m[j] - mn); m[j] = mn; l[j] *= a;
#pragma unroll
        for (int dt = 0; dt < 4; ++dt) O[dt][j] *= a; }
#pragma unroll
    for (int j = 0; j < 4; ++j) { float pv[4];
#pragma unroll
        for (int s = 0; s < 4; ++s) { pv[s] = ((vmask >> s) & 1u) ? __builtin_amdgcn_exp2f(S[s][j] - m[j]) : 0.f; l[j] += pv[s]; }
        int t = __builtin_amdgcn_cvt_pk_fp8_f32(pv[0] * 256.f, pv[1] * 256.f, 0, false); t = __builtin_amdgcn_cvt_pk_fp8_f32(pv[2] * 256.f, pv[3] * 256.f, t, true);
        *(unsigned*)(Pt + (fq * 4 + j) * 72 + fr * 4) = (unsigned)t; }
    asm volatile("s_waitcnt lgkmcnt(0)" ::: "memory");
    const u32x2 p0 = *(const u32x2*)(Pt + fr * 72 + fq * 8), p1 = *(const u32x2*)(Pt + fr * 72 + 32 + fq * 8);
    asm volatile("s_waitcnt lgkmcnt(0)" ::: "memory");
    const long P0 = (long)(((unsigned long long)p0.y << 32) | p0.x), P1 = (long)(((unsigned long long)p1.y << 32) | p1.x);
#pragma unroll
    for (int dt = 0; dt < 4; ++dt) { const long V0 = (long)(((unsigned long long)Vw[dt].y << 32) | Vw[dt].x), V1 = (long)(((unsigned long long)Vw[dt].w << 32) | Vw[dt].z);
        O[dt] = MFMA8(P0, V0, O[dt]); O[dt] = MFMA8(P1, V1, O[dt]); }
}
template <int BR> struct BranchIt {
    const bf16_t* kb; const unsigned char* vb; const unsigned* flg; int last, trow, fr, fq;
    static constexpr int LDK = BR == 0 ? 64 : 128, LDV = 64;
    __device__ __forceinline__ int next(int from) const {
        if (BR == 1) { int jb = from; while (jb <= last && flg[jb] == 0u) ++jb; return jb <= last ? jb : -1; }
        return from <= last ? from : -1;
    }
    __device__ __forceinline__ void load(int idx, KVF& f) const { kv_load(kb + (size_t)(idx * 64) * LDK, LDK, f); }
    __device__ __forceinline__ const unsigned char* vptr(int idx) const { return vb + (size_t)idx * 4096; }
    __device__ __forceinline__ const bf16_t* kptr(int idx) const { return kb + (size_t)(idx * 64) * LDK; }
    __device__ __forceinline__ unsigned mask(int idx) const {
        unsigned vm = 0; const int key0 = idx * 64;
        if (BR == 0) {
#pragma unroll
            for (int s = 0; s < 4; ++s) vm |= ((16 * (key0 + s * 16 + fr) + 31 <= trow) ? 1u : 0u) << s;
        } else if (BR == 1) {
            const bool rowsel = (flg[idx] >> fq) & 1u;
#pragma unroll
            for (int s = 0; s < 4; ++s) vm |= ((rowsel && (key0 + s * 16 + fr <= trow)) ? 1u : 0u) << s;
        } else {
#pragma unroll
            for (int s = 0; s < 4; ++s) { const int kpos = key0 + s * 16 + fr; vm |= ((kpos <= trow && kpos > trow - 512) ? 1u : 0u) << s; }
        }
        return vm;
    }
};
template <int BR> __device__ __forceinline__ void run_branch(const BranchIt<BR>& it, int first, const bf16x8 (&Qf)[2], float (&m)[4], float (&l)[4], f32x4 (&O)[4], unsigned char* Pt) {
#pragma unroll
    for (int j = 0; j < 4; ++j) { m[j] = -1e30f; l[j] = 0.f; O[j] = (f32x4){0.f, 0.f, 0.f, 0.f}; }
    int ia = it.next(first);
    if (ia < 0) return;
    KVF A; it.load(ia, A);
    while (ia >= 0) {
        const int ib = it.next(ia + 1);
        flash_compute(Qf, A, ib >= 0 ? it.kptr(ib) : nullptr, BranchIt<BR>::LDK, it.vptr(ia), it.mask(ia), m, l, O, Pt, it.fr, it.fq);
        ia = ib;
    }
}
__device__ __forceinline__ void branch_finish(float (&l)[4], f32x4 (&O)[4], const float* grow, int br, int hk, float* ybp  ) {
#pragma unroll
    for (int j = 0; j < 4; ++j) { const float s = rsum16(l[j]);
        const float g = sigmoidf_(grow[(hk * 4 + j) * 3 + br]) * 0.00390625f / fmaxf(s, 1e-30f);
#pragma unroll
        for (int dt = 0; dt < 4; ++dt) { float* q = ybp + j * 64 + dt * 16; if (br == 0) *q = g * O[dt][j]; else *q += g * O[dt][j]; } }
}
constexpr int NSA_WLDS = 15680;
__device__ void nsa_wave_task(const Params& p, int layer, int t0, unsigned char* wl) {
    unsigned char* ws = p.ws;
    const int lane = tidx() & 63, fr = lane & 15, fq = lane >> 4;
    float* imp = (float*)wl; unsigned* flg = (unsigned*)(wl + 4160); unsigned char* Pt = wl + 5184; float* yb = (float*)(wl + 7488);
    const bf16_t* qn = (const bf16_t*)(ws + O_QN); const bf16_t* ksn = (const bf16_t*)(ws + O_KSN); const bf16_t* kwn = (const bf16_t*)(ws + O_KWN);
    const unsigned char* vsT = ws + O_VST; const unsigned char* vwT = ws + O_VWT; const bf16_t* kc = (const bf16_t*)(ws + O_KC); const unsigned char* vcT = ws + O_VCT;
    const int trow = t0 + fq;
    const float* grow = (const float*)(ws + O_P32) + (size_t)trow * 1536 + 1280;
    const int tmax = t0 + 3;
    for (int hk = 0; hk < 2; ++hk) {
        bf16x8 Qf[2];
        { const bf16_t* qp = qn + (size_t)(t0 + (fr >> 2)) * 512 + (hk * 4 + (fr & 3)) * 64 + fq * 8; Qf[0] = *(const bf16x8*)qp; Qf[1] = *(const bf16x8*)(qp + 32); }
        float* ybp = yb + fq * 512 + hk * 256 + fr;
        float m[4], l[4]; f32x4 O[4];
        const int ncmp_t = tmax >= 31 ? ((((tmax - 31) >> 4) >> 6) + 1) : 0;
        const bf16_t* kcb = kc + ((size_t)hk * 1024 + fr) * 64 + fq * 8;
        { BranchIt<0> it{kcb, vcT + (size_t)hk * 16 * 4096 + fr * 64 + fq * 16, nullptr, ncmp_t - 1, trow, fr, fq}; run_branch<0>(it, 0, Qf, m, l, O, Pt); }
        float linv[4];
#pragma unroll
        for (int j = 0; j < 4; ++j) { const float s = rsum16(l[j]); linv[j] = s > 0.f ? 1.0f / s : 0.f; }
        branch_finish(l, O, grow, 0, hk, ybp);
        for (int e = lane; e < 4 * 260; e += 64) imp[e] = 0.f;
        for (int e = lane; e < 256; e += 64) flg[e] = 0u;
        asm volatile("s_waitcnt lgkmcnt(0)" ::: "memory");
        {
            KVF ka;
            if (ncmp_t > 0) kv_load(kcb, 64, ka);
            for (int kt = 0; kt < ncmp_t; ++kt) {
                const int key0 = kt * 64;
                f32x4 S[4];
#pragma unroll
                for (int s = 0; s < 4; ++s) { S[s] = (f32x4){0.f, 0.f, 0.f, 0.f}; S[s] = MFMA16(Qf[0], ka.k[s][0], S[s]); S[s] = MFMA16(Qf[1], ka.k[s][1], S[s]); }
                if (kt + 1 < ncmp_t) kv_load(kcb + (size_t)(key0 + 64) * 64, 64, ka);
#pragma unroll
                for (int s = 0; s < 4; ++s) {
                    const int nn = key0 + s * 16 + fr; const bool valid = 16 * nn + 31 <= trow;
                    float ps = 0.f;
#pragma unroll
                    for (int j = 0; j < 4; ++j) ps += valid ? __builtin_amdgcn_exp2f(S[s][j] - m[j]) * linv[j] : 0.f;
                    float p4 = ps; p4 += dppf<0xB1>(p4); p4 += dppf<0x4E>(p4);
                    if ((fr & 3) == 0) imp[fq * 260 + (nn >> 2)] += p4;
                    asm volatile("s_waitcnt lgkmcnt(0)" ::: "memory");
                    if ((fr & 3) == 3) imp[fq * 260 + (nn >> 2) + 1] += ps;
                    asm volatile("s_waitcnt lgkmcnt(0)" ::: "memory");
                }
            }
        }
#ifdef OLD_TOPK
        for (int tok = 0; tok < 4; ++tok) {
            const int t = t0 + tok, cur = t >> 6, nsel = cur + 1 < 16 ? cur + 1 : 16;
            unsigned long long key[4];
#pragma unroll
            for (int i = 0; i < 4; ++i) { const int j = lane + 64 * i; unsigned long long k = 0ull;
                if (j <= cur) { const bool forced = (j == 0) || (j == cur) || (j == cur - 1); const unsigned vb = forced ? 0x7F800000u : __float_as_uint(imp[tok * 260 + j]); k = ((unsigned long long)vb << 32) | (unsigned)(0xFFFF - j); }
                key[i] = k; }
            for (int it2 = 0; it2 < nsel; ++it2) {
                unsigned long long best = key[0]; best = key[1] > best ? key[1] : best; best = key[2] > best ? key[2] : best; best = key[3] > best ? key[3] : best;
#pragma unroll
                for (int o = 32; o >= 1; o >>= 1) { const unsigned lo = __shfl_xor((unsigned)best, o), hi = __shfl_xor((unsigned)(best >> 32), o); const unsigned long long ob = ((unsigned long long)hi << 32) | lo; best = ob > best ? ob : best; }
                const int jsel = 0xFFFF - (int)(best & 0xFFFFu);
#pragma unroll
                for (int i = 0; i < 4; ++i) if (key[i] == best) key[i] = 0ull;
                if (lane == 0) flg[jsel] |= (1u << tok);
            }
        }
#else
        {
            unsigned long long key[4][4];
#pragma unroll
            for (int tok = 0; tok < 4; ++tok) { const int cur = (t0 + tok) >> 6;
#pragma unroll
                for (int i = 0; i < 4; ++i) { const int j = lane + 64 * i; unsigned long long k = 0ull;
                    if (j <= cur) { const bool forced = (j == 0) || (j == cur) || (j == cur - 1); const unsigned vb = forced ? 0x7F800000u : __float_as_uint(imp[tok * 260 + j]); k = ((unsigned long long)vb << 32) | (unsigned)(0xFFFF - j); }
                    key[tok][i] = k; } }
            for (int itn = 0; itn < 16; ++itn) {
                unsigned long long best[4];
#pragma unroll
                for (int tok = 0; tok < 4; ++tok) { unsigned long long b0 = key[tok][0]; b0 = key[tok][1] > b0 ? key[tok][1] : b0; b0 = key[tok][2] > b0 ? key[tok][2] : b0; b0 = key[tok][3] > b0 ? key[tok][3] : b0; best[tok] = b0; }
#pragma unroll
                for (int tok = 0; tok < 4; ++tok) { best[tok] = dppmax64<0xB1>(best[tok]); best[tok] = dppmax64<0x4E>(best[tok]); best[tok] = dppmax64<0x124>(best[tok]); best[tok] = dppmax64<0x128>(best[tok]); }
#pragma unroll
                for (int o = 16; o <= 32; o <<= 1) {
#pragma unroll
                    for (int tok = 0; tok < 4; ++tok) { const unsigned lo = __shfl_xor((unsigned)best[tok], o), hi = __shfl_xor((unsigned)(best[tok] >> 32), o); const unsigned long long ob = ((unsigned long long)hi << 32) | lo; best[tok] = ob > best[tok] ? ob : best[tok]; }
                }
#pragma unroll
                for (int tok = 0; tok < 4; ++tok) {
                    if (best[tok] != 0ull) {
#pragma unroll
                        for (int i = 0; i < 4; ++i) if (key[tok][i] == best[tok]) key[tok][i] = 0ull;
                        if (lane == 0) flg[0xFFFF - (int)(best[tok] & 0xFFFFu)] |= (1u << tok);
                    }
                }
            }
        }
#endif
        asm volatile("s_waitcnt lgkmcnt(0)" ::: "memory");
        { BranchIt<1> it{ksn + (size_t)fr * 128 + hk * 64 + fq * 8, vsT + (size_t)hk * 256 * 4096 + fr * 64 + fq * 16, flg, tmax >> 6, trow, fr, fq}; run_branch<1>(it, 0, Qf, m, l, O, Pt); }
        branch_finish(l, O, grow, 1, hk, ybp);
        { BranchIt<2> it{kwn + (size_t)fr * 128 + hk * 64 + fq * 8, vwT + (size_t)hk * 256 * 4096 + fr * 64 + fq * 16, nullptr, tmax >> 6, trow, fr, fq}; run_branch<2>(it, t0 - 511 > 0 ? ((t0 - 511) >> 6) : 0, Qf, m, l, O, Pt); }
        branch_finish(l, O, grow, 2, hk, ybp);
    }
    asm volatile("s_waitcnt lgkmcnt(0)" ::: "memory");
    bf16_t* mix = (bf16_t*)(ws + O_HN);
    const float* gn = p.in[12] + (size_t)layer * 512;
    for (int tok = 0; tok < 4; ++tok) {
        const f32x4 a = *(const f32x4*)(yb + tok * 512 + lane * 8), b = *(const f32x4*)(yb + tok * 512 + lane * 8 + 4);
        float ss = a[0] * a[0] + a[1] * a[1] + a[2] * a[2] + a[3] * a[3] + b[0] * b[0] + b[1] * b[1] + b[2] * b[2] + b[3] * b[3];
        ss = wave_sum(ss);
        const float rs = rsqrtf(ss * (1.0f / 512.0f) + 1e-6f);
        const f32x4 g0 = *(const f32x4*)(gn + lane * 8), g1 = *(const f32x4*)(gn + lane * 8 + 4);
        u32x4 w; w.x = pk2(a[0] * rs * g0[0], a[1] * rs * g0[1]); w.y = pk2(a[2] * rs * g0[2], a[3] * rs * g0[3]); w.z = pk2(b[0] * rs * g1[0], b[1] * rs * g1[1]); w.w = pk2(b[2] * rs * g1[2], b[3] * rs * g1[3]);
        *(u32x4*)(mix + (size_t)(t0 + tok) * DM + lane * 8) = w;
    }
    asm volatile("s_waitcnt lgkmcnt(0)" ::: "memory");
}

__device__ void phase_finalize(const Params& p, int layer) {
    unsigned char* ws = p.ws;
    const int wave = tidx() >> 6, lane = tidx() & 63;
    const float* yglu = (const float*)(ws + O_YGLU); const float* go = (const float*)(ws + O_PQKV); const bf16_t* Pz = (const bf16_t*)(ws + O_PZ); bf16_t* mix = (bf16_t*)(ws + O_HN);
    const float* gs = p.in[22] + (size_t)layer * 512 + lane * 8; const float* gg = p.in[26] + (size_t)layer * 128 + (lane & 7) * 16;
    for (int t = blockIdx.x * 8 + wave; t < T_; t += gridDim.x * 8) {
        {
            const f32x4 a = *(const f32x4*)(yglu + (size_t)t * 512 + lane * 8), b = *(const f32x4*)(yglu + (size_t)t * 512 + lane * 8 + 4);
            float ss = a[0] * a[0] + a[1] * a[1] + a[2] * a[2] + a[3] * a[3] + b[0] * b[0] + b[1] * b[1] + b[2] * b[2] + b[3] * b[3];
            ss = wave_sum(ss); const float rs = rsqrtf(ss * (1.0f / 512.0f) + 1e-6f);
            const f32x4 g0 = *(const f32x4*)gs, g1 = *(const f32x4*)(gs + 4);
            u32x4 w; w.x = pk2(a[0] * rs * g0[0], a[1] * rs * g0[1]); w.y = pk2(a[2] * rs * g0[2], a[3] * rs * g0[3]); w.z = pk2(b[0] * rs * g1[0], b[1] * rs * g1[1]); w.w = pk2(b[2] * rs * g1[2], b[3] * rs * g1[3]);
            *(u32x4*)(mix + (size_t)t * DM + 512 + lane * 8) = w;
        }
        {
            f32x4 o[4]; float ss = 0.f;
#pragma unroll
            for (int q = 0; q < 4; ++q) { o[q] = *(const f32x4*)(go + (size_t)t * 1024 + lane * 16 + q * 4); ss += o[q][0] * o[q][0] + o[q][1] * o[q][1] + o[q][2] * o[q][2] + o[q][3] * o[q][3]; }
            ss += __shfl_xor(ss, 1); ss += __shfl_xor(ss, 2); ss += __shfl_xor(ss, 4);
            const float rs = rsqrtf(ss * (1.0f / 128.0f) + 1e-6f);
            const u32x4 z0 = *(const u32x4*)(Pz + (size_t)t * 1024 + lane * 16), z1 = *(const u32x4*)(Pz + (size_t)t * 1024 + lane * 16 + 8);
            float zz[16] = {bflo(z0.x), bfhi(z0.x), bflo(z0.y), bfhi(z0.y), bflo(z0.z), bfhi(z0.z), bflo(z0.w), bfhi(z0.w), bflo(z1.x), bfhi(z1.x), bflo(z1.y), bfhi(z1.y), bflo(z1.z), bfhi(z1.z), bflo(z1.w), bfhi(z1.w)};
            float r[16];
#pragma unroll
            for (int q = 0; q < 4; ++q) { const f32x4 g = *(const f32x4*)(gg + q * 4);
#pragma unroll
                for (int e = 0; e < 4; ++e) r[q * 4 + e] = o[q][e] * rs * g[e] * siluf_(zz[q * 4 + e]); }
            u32x4 w0, w1; w0.x = pk2(r[0], r[1]); w0.y = pk2(r[2], r[3]); w0.z = pk2(r[4], r[5]); w0.w = pk2(r[6], r[7]); w1.x = pk2(r[8], r[9]); w1.y = pk2(r[10], r[11]); w1.z = pk2(r[12], r[13]); w1.w = pk2(r[14], r[15]);
            *(u32x4*)(mix + (size_t)t * DM + 1024 + lane * 16) = w0; *(u32x4*)(mix + (size_t)t * DM + 1024 + lane * 16 + 8) = w1;
        }
    }
}

__device__ void phase_ffn_act(const Params& p, int layer) {
    unsigned char* ws = p.ws;
    const bf16_t* hf = (const bf16_t*)(ws + O_HF); bf16_t* act = (bf16_t*)(ws + O_ACT);
    const float* cw = p.in[30] + (size_t)layer * 3 * NFF; const float* cb = p.in[31] + (size_t)layer * NFF;
    const int nitems = 512 * 688;
    for (int it = blockIdx.x * 512 + tidx(); it < nitems; it += gridDim.x * 512) {
        const int seg = it / 688, cg8 = it - seg * 688, c = cg8 * 8, t0 = seg * 32;
        float w[2][3][8], bb[2][8];
#pragma unroll
        for (int hh = 0; hh < 2; ++hh) {
#pragma unroll
            for (int j = 0; j < 3; ++j) { const f32x4 a = *(const f32x4*)(cw + j * NFF + hh * DFF + c), b = *(const f32x4*)(cw + j * NFF + hh * DFF + c + 4);
                w[hh][j][0] = a[0]; w[hh][j][1] = a[1]; w[hh][j][2] = a[2]; w[hh][j][3] = a[3]; w[hh][j][4] = b[0]; w[hh][j][5] = b[1]; w[hh][j][6] = b[2]; w[hh][j][7] = b[3]; }
            const f32x4 a = *(const f32x4*)(cb + hh * DFF + c), b = *(const f32x4*)(cb + hh * DFF + c + 4);
            bb[hh][0] = a[0]; bb[hh][1] = a[1]; bb[hh][2] = a[2]; bb[hh][3] = a[3]; bb[hh][4] = b[0]; bb[hh][5] = b[1]; bb[hh][6] = b[2]; bb[hh][7] = b[3];
        }
        u32x4 r0[2], r1[2];
#pragma unroll
        for (int hh = 0; hh < 2; ++hh) {
            r0[hh] = (t0 >= 2) ? *(const u32x4*)(hf + (size_t)(t0 - 2) * NFF + hh * DFF + c) : (u32x4){0u, 0u, 0u, 0u};
            r1[hh] = (t0 >= 1) ? *(const u32x4*)(hf + (size_t)(t0 - 1) * NFF + hh * DFF + c) : (u32x4){0u, 0u, 0u, 0u};
        }
        for (int tt = 0; tt < 32; ++tt) {
            const int t = t0 + tt;
            u32x4 r2[2]; float v[2][8];
#pragma unroll
            for (int hh = 0; hh < 2; ++hh) {
                r2[hh] = *(const u32x4*)(hf + (size_t)t * NFF + hh * DFF + c);
                const unsigned a0[4] = {r0[hh].x, r0[hh].y, r0[hh].z, r0[hh].w}, a1[4] = {r1[hh].x, r1[hh].y, r1[hh].z, r1[hh].w}, a2[4] = {r2[hh].x, r2[hh].y, r2[hh].z, r2[hh].w};
#pragma unroll
                for (int e = 0; e < 4; ++e) {
                    v[hh][2 * e]     = bb[hh][2 * e]     + w[hh][0][2 * e]     * bflo(a0[e]) + w[hh][1][2 * e]     * bflo(a1[e]) + w[hh][2][2 * e]     * bflo(a2[e]);
                    v[hh][2 * e + 1] = bb[hh][2 * e + 1] + w[hh][0][2 * e + 1] * bfhi(a0[e]) + w[hh][1][2 * e + 1] * bfhi(a1[e]) + w[hh][2][2 * e + 1] * bfhi(a2[e]);
                }
                r0[hh] = r1[hh]; r1[hh] = r2[hh];
            }
            u32x4 o; o.x = pk2(siluf_(v[0][0]) * v[1][0], siluf_(v[0][1]) * v[1][1]); o.y = pk2(siluf_(v[0][2]) * v[1][2], siluf_(v[0][3]) * v[1][3]);
            o.z = pk2(siluf_(v[0][4]) * v[1][4], siluf_(v[0][5]) * v[1][5]); o.w = pk2(siluf_(v[0][6]) * v[1][6], siluf_(v[0][7]) * v[1][7]);
            *(u32x4*)(act + (size_t)t * DFF + c) = o;
        }
    }
}
#ifdef REPEAT_PHASE
constexpr int NPHT = NPH + 1;
#else
constexpr int NPHT = NPH;
#endif
#ifndef MULTI_LAUNCH
#define MULTI_LAUNCH 0
#endif
__global__ void __launch_bounds__(512) mega(Params p) {
    extern __shared__ __attribute__((aligned(16))) unsigned char smem[];
    cg::grid_group grid = cg::this_grid();
    const int b = blockIdx.x, G = gridDim.x;
    PG8_LAS unsigned char* glds = (PG8_LAS unsigned char*)smem;
    volatile XB_LAS unsigned* xst = (volatile XB_LAS unsigned*)(smem + LDS_BYTES - 32);
    if (threadIdx.x == 0) { xst[0] = 0u; xst[1] = 0u; }
    __syncthreads();
    XcdBarrier xbar; xbar.bar = (unsigned*)(p.ws + O_BAR); xbar.x = 0; xbar.st = xst;
    for (int ph = p.ph_lo; ph < p.ph_hi; ++ph) {

        #ifdef REPEAT_PHASE
        const int layer = ph / (NPH + 1), ki = ph % (NPH + 1), rep = (ki == REPEAT_PHASE + 1) ? 1 : 0; int k = ki <= REPEAT_PHASE ? ki : ki - 1;
#else
        const int layer = ph / NPH, rep = 0; int k = ph % NPH;
#endif
#ifdef DBG_ONLY
        if (k != DBG_ONLY) k = 99;
#endif
        typedef unsigned char __attribute__((address_space(1))) gu8_t;
        gu8_t* wsg = (gu8_t*)p.ws; asm volatile("" : "+s"(wsg));
        unsigned char* ws = (unsigned char*)wsg;
        int tid = threadIdx.x; asm volatile("" : "+v"(tid));
        const int wave = tid >> 6;
        bf16_t* hn = (bf16_t*)(ws + O_HN);
        Params q = p; q.ws = ws;
        if (k == 0) {
            if (ph == 0 && rep == 0 && b == 0) { if (tid < 64) ((unsigned*)(ws + O_CTR))[tid * 16] = 0u; for (int i = tid; i < XCD_BAR_WORDS; i += 512) ((unsigned*)(ws + O_BAR))[i] = 0u; }
            phase_convert(q, layer, (float*)smem);
            phase_rmsnorm(layer == 0 ? p.in[0] : p.out, p.in[1] + (size_t)layer * DM, hn, layer == 0 ? p.out : nullptr);
        } else if (k == 1) {
            pg8::Gemm g{hn, (const bf16_t*)(ws + O_WIN), T_, NIN, DM}; pg8::StaticOrder S; S.init(T_, NIN, G, b);
            EpiProj E{(float*)(ws + O_P32), (bf16_t*)(ws + O_PU), (bf16_t*)(ws + O_PQKV), (bf16_t*)(ws + O_PZ)};
            pg8::gemm_phase<EpiProj, pg8::StaticOrder, false>(glds, g, S, E, nullptr);
        } else if (k == 2) {
            for (int it = b; it < 3072; it += G) {
                if (it < 2048) gdn_prep_item(q, layer, it, smem);
                else if (it < 2304) nsa_prep_item(q, layer, it - 2048, (float*)smem);
                else if (it < 2560) s5_passA_wave(q, layer, (it - 2304) * 8 + wave);
                else cmp1_wave_tile(q, layer, (it - 2560) * 8 + wave);
            }
        } else if (k == 3) {
            for (int idx = b * 8 + wave; idx < 4096; idx += G * 8) cmp2_wave_row(q, layer, idx);
            for (int it = b * 8 + wave; it < 2048; it += G * 8) s5_passB_wave(q, layer, it, (bf16_t*)(smem + wave * 4352));
        } else if (k == 4) {
#ifdef REP4_MODE
            const bool do_rec = (rep == 0) || (REP4_MODE == 1), do_glu = (rep == 0), do_nsa = (rep == 0) || (REP4_MODE == 2);
#else
            const bool do_rec = true, do_glu = true, do_nsa = true;
#endif
            if (b < 32) {
#ifndef NO_REC
 if (do_rec) gdn_recurrence(q, b, smem);
#endif
 }
            else if (b < 160 && do_glu) {
#ifndef NO_GLU
                pg8::Gemm g{(const bf16_t*)(ws + O_YGELU), (const bf16_t*)(ws + O_WGLU), T_, 512, 512}; pg8::StaticOrder S; S.init(T_, 512, 128, b - 32);
                EpiGlu E{(const bf16_t*)(ws + O_YGELU), (float*)(ws + O_YGLU)};
                pg8::gemm_phase<EpiGlu, pg8::StaticOrder, false>(glds, g, S, E, nullptr);
#endif
            }
            __syncthreads();
            unsigned* ctr = (unsigned*)(ws + O_CTR) + (layer * 2 + rep) * 16;
            volatile int* sidx = (volatile int*)(smem + LDS_BYTES - 16);
#ifndef NO_NSA
            if (do_nsa) for (;;) {
                if (tid == 0) *sidx = (int)atomicAdd(ctr, 1u);
                __syncthreads();
                const int idx = *sidx;
                __syncthreads();
                if (idx >= 512) break;
                nsa_wave_task(q, layer, (511 - idx) * 32 + wave * 4, smem + wave * NSA_WLDS);
            }
#endif
        } else if (k == 5) {
            phase_finalize(q, layer);
        } else if (k == 6) {
            pg8::Gemm g{hn, (const bf16_t*)(ws + O_WOUT), T_, DM, DM}; pg8::StaticOrder S; S.init(T_, DM, G, b);
            EpiResid E{p.out, DM};
            pg8::gemm_phase<EpiResid, pg8::StaticOrder, false>(glds, g, S, E, nullptr);
        } else if (k == 7) {
            phase_rmsnorm(p.out, p.in[28] + (size_t)layer * DM, hn, nullptr);
        } else if (k == 8) {
            pg8::Gemm g{hn, (const bf16_t*)(ws + O_WFIN), T_, NFF, DM}; pg8::StaticOrder S; S.init(T_, NFF, G, b);
            EpiBf E{(bf16_t*)(ws + O_HF), NFF};
            pg8::gemm_phase<EpiBf, pg8::StaticOrder, false>(glds, g, S, E, nullptr);
        } else if (k == 9) {
            phase_ffn_act(q, layer);
        } else if (k == 10) {
            pg8::Gemm g{(const bf16_t*)(ws + O_ACT), (const bf16_t*)(ws + O_WFOUT), T_, DM, DFF}; pg8::StaticOrder S; S.init(T_, DM, G, b);
            EpiResid E{p.out, DM};
            pg8::gemm_phase<EpiResid, pg8::StaticOrder, false>(glds, g, S, E, nullptr);
        }
        __syncthreads();
        if (ph + 1 < p.ph_hi) {
            if (ph == p.ph_lo) { grid.sync(); xbar = xcd_barrier_post((unsigned*)(p.ws + O_BAR), xst); }
            else xcd_barrier(xbar);
        }
    }
}

extern "C" void kernel_launch(void* const* d_in, const int* in_sizes, int n_in, void* d_out, int out_size, void* d_ws, size_t ws_size, hipStream_t stream) {
    static int grid_blocks = 0;
    if (!grid_blocks) {
        if (n_in != 33 || out_size != T_ * DM || ws_size < WS_NEED) { fprintf(stderr, "kernel_launch: unexpected shapes or workspace (%d inputs, out %d, ws %zu < %zu)\n", n_in, out_size, ws_size, (size_t)WS_NEED); grid_blocks = -1; return; }
        int dev = 0, cus = 0, per_cu = 0;
        hipGetDevice(&dev);
        hipDeviceGetAttribute(&cus, hipDeviceAttributeMultiprocessorCount, dev);
        if (hipFuncSetAttribute((const void*)mega, hipFuncAttributeMaxDynamicSharedMemorySize, LDS_BYTES) != hipSuccess) { fprintf(stderr, "kernel_launch: hipFuncSetAttribute failed\n"); grid_blocks = -1; return; }
        hipOccupancyMaxActiveBlocksPerMultiprocessor(&per_cu, (const void*)mega, 512, LDS_BYTES);
        (void)hipGetLastError();
        if (per_cu < 1) per_cu = 1;
        grid_blocks = cus * per_cu; if (grid_blocks > 256) grid_blocks = 256;
        if (grid_blocks < 160) { fprintf(stderr, "kernel_launch: grid %d too small\n", grid_blocks); grid_blocks = -1; return; }
    }
    if (grid_blocks < 0) return;
    Params p{};
    for (int i = 0; i < 33; ++i) p.in[i] = (const float*)d_in[i];
    p.out = (float*)d_out; p.ws = (unsigned char*)d_ws;
#if MULTI_LAUNCH
    for (int ph = 0; ph < 2 * NPHT; ++ph) { p.ph_lo = ph; p.ph_hi = ph + 1; hipLaunchKernelGGL(mega, dim3(grid_blocks), dim3(512), LDS_BYTES, stream, p); }
#else
    p.ph_lo = 0; p.ph_hi = 2 * NPHT;
    void* args[] = {&p};
    hipError_t e = hipLaunchCooperativeKernel((const void*)mega, dim3(grid_blocks), dim3(512), args, LDS_BYTES, stream);
    if (e != hipSuccess) fprintf(stderr, "cooperative launch failed: %s (grid %d)\n", hipGetErrorString(e), grid_blocks);
#endif
}
```

```cpp
#include <hip/hip_runtime.h>
#include <hip/hip_cooperative_groups.h>
#include <cstdio>
namespace cg = cooperative_groups;
__device__ __forceinline__ int tidx() { int t = threadIdx.x; asm volatile("" : "+v"(t)); return t; }
namespace pg8 {
#define PG8_LAS __attribute__((address_space(3)))
typedef unsigned short bf16_t;
typedef short bf16x8 __attribute__((ext_vector_type(8)));
typedef float f32x4 __attribute__((ext_vector_type(4)));
typedef unsigned u32x4 __attribute__((ext_vector_type(4)));
constexpr int BM = 256, BK = 64, HALF = 128, HTB = HALF * BK * 2  , STAGE_BYTES = 8 * HTB, NXCD = 8, WGM = 8;

__host__ __device__ __forceinline__ int lds_byte(int r, int c) { const int st = (r >> 4) * 2 + (c >> 5), rr = r & 15, cc = c & 31, ob = rr * 64 + cc * 2; return st * 1024 + (ob ^ (((ob >> 9) & 1) << 5)); }
__host__ __device__ __forceinline__ void stage_rc(int b, int& R, int& C) { const int st = b / 1024, sb = b % 1024, swz = sb ^ (((sb >> 9) & 1) << 5); R = (st >> 1) * 16 + swz / 64; C = (st & 1) * 32 + (swz % 64) / 2; }
__host__ __device__ __forceinline__ int perm32(int rho) { const int n = rho >> 4, i = rho & 15; return 8 * (i >> 2) + 4 * n + (i & 3); }

struct Unit { int pm, pn; };
struct Gemm { const bf16_t* A; const bf16_t* Bt; int M, N, K; };

struct StaticOrder {
    int nM, nN, nwg, G, c;
    __host__ __device__ void init(int M, int N, int G_, int c_) { nM = M / BM; nN = N / BM; nwg = nM * nN; G = G_; c = c_; }
    __host__ __device__ bool next(int i, Unit& u) const {
        const long L = (long)i * G + c; if (L >= nwg) return false;
        int wgid = (int)L; { const int q = nwg / NXCD, r = nwg % NXCD, xcd = wgid % NXCD, off = wgid / NXCD; wgid = (xcd < r ? xcd * (q + 1) : r * (q + 1) + (xcd - r) * q) + off; }
        const int nig = WGM * nN, gid = wgid / nig, fm = gid * WGM, gsz = (nM - fm) < WGM ? (nM - fm) : WGM;
        u.pm = fm + ((wgid % nig) % gsz); u.pn = (wgid % nig) / gsz; return true;
    }
    __device__ __forceinline__ void a_ready(const Unit&) const {}
    __device__ __forceinline__ void done(const Unit&) const {}
};
__device__ __forceinline__ unsigned cvt_pk_bf16(float lo, float hi) { unsigned r; asm volatile("v_cvt_pk_bf16_f32 %0, %1, %2" : "=v"(r) : "v"(lo), "v"(hi)); return r; }
template <class Epi, class Sched, bool STAMP = false>
__device__ __forceinline__ void gemm_phase(PG8_LAS unsigned char* lds, const Gemm g, const Sched& S, const Epi& E, unsigned long long* stamps) {
    const int tid = tidx(), wid = __builtin_amdgcn_readfirstlane(tid >> 6), lane = tid & 63, wr = wid >> 2, wc = wid & 3, fr = lane & 15, fq = lane >> 4;
    const int K = g.K, nt = K / BK;
    int ts_lo = 0, ts_hi = 0, nts = 0; const unsigned long long rt_entry = STAMP ? (unsigned long long)wall_clock64() : 0ull;
#define PG8_STAMP() do { if (STAMP && wid == 0 && nts < 64) { const unsigned long long _c = (unsigned long long)clock64(); \
        ts_lo = (lane == nts) ? (int)(unsigned)_c : ts_lo; ts_hi = (lane == nts) ? (int)(unsigned)(_c >> 32) : ts_hi; ++nts; } } while (0)
    PG8_STAMP();
    unsigned voffA[2], voffB[2];
#pragma unroll
    for (int i = 0; i < 2; ++i) { int R, C; stage_rc(tid * 16 + i * 8192, R, C); const int Rb = Epi::PERM ? ((R & ~31) + perm32(R & 31)) : R;
        voffA[i] = (unsigned)(R * K + C) * 2u; voffB[i] = (unsigned)(Rb * K + C) * 2u; }
    const size_t kstep = (size_t)(BK * 2);
    const size_t hstep = (size_t)HALF * K * 2;
    const size_t tstep = 2 * hstep;
    const unsigned ldsw = (unsigned)wid * 1024u;
    const int aoff = lds_byte(wr * 64 + fr, fq * 8), boff = lds_byte(wc * 32 + fr, fq * 8);
#define PG8_SA(b, h) (((b) * 2 + (h)) * HTB)
#define PG8_SB(b, h) ((4 + (b) * 2 + (h)) * HTB)
#define PG8_STAGE(bufoff, gbase, voff) do { _Pragma("unroll") for (int _i = 0; _i < 2; ++_i) \
        __builtin_amdgcn_global_load_lds((const unsigned*)((const char*)(gbase) + (voff)[_i]), (PG8_LAS unsigned*)(lds + (bufoff) + ldsw + _i * 8192), 16, 0, 0); } while (0)
#define PG8_LDA(dst, b, h) do { _Pragma("unroll") for (int m = 0; m < 4; ++m) _Pragma("unroll") for (int k = 0; k < 2; ++k) dst[m][k] = *(const PG8_LAS bf16x8*)(lds + PG8_SA(b, h) + aoff + m * 2048 + k * 1024); } while (0)
#define PG8_LDB(dst, b, h) do { _Pragma("unroll") for (int n = 0; n < 2; ++n) _Pragma("unroll") for (int k = 0; k < 2; ++k) dst[n][k] = *(const PG8_LAS bf16x8*)(lds + PG8_SB(b, h) + boff + n * 2048 + k * 1024); } while (0)
#define PG8_MMA(ai, bj, At, Bt) do { __builtin_amdgcn_s_setprio(1); _Pragma("unroll") for (int m = 0; m < 4; ++m) _Pragma("unroll") for (int n = 0; n < 2; ++n) _Pragma("unroll") for (int k = 0; k < 2; ++k) \
        acc[ai][bj][m][n] = __builtin_amdgcn_mfma_f32_16x16x32_bf16(Bt[n][k], At[m][k], acc[ai][bj][m][n], 0, 0, 0); __builtin_amdgcn_s_setprio(0); } while (0)
#define PG8_WAIT_V(n) asm volatile("s_waitcnt vmcnt(" #n ")" ::: "memory")
#define PG8_WAIT_L(n) asm volatile("s_waitcnt lgkmcnt(" #n ")" ::: "memory")
#define PG8_BAR __builtin_amdgcn_s_barrier()
#define PG8_SCHED __builtin_amdgcn_sched_barrier(0)
    Unit cur, nxt; int ui = 0;
    if (!S.next(0, cur)) return;
    f32x4 acc[2][2][4][2];
#pragma unroll
    for (int a = 0; a < 2; ++a)
#pragma unroll
        for (int b = 0; b < 2; ++b)
#pragma unroll
            for (int m = 0; m < 4; ++m)
#pragma unroll
                for (int n = 0; n < 2; ++n) acc[a][b][m][n] = (f32x4){0.f, 0.f, 0.f, 0.f};
    bf16x8 At[4][2], B0[2][2], B1[2][2];
    const char* cA = (const char*)g.A + (size_t)cur.pm * tstep; const char* cB = (const char*)g.Bt + (size_t)cur.pn * tstep;
    S.a_ready(cur);
    PG8_STAGE(PG8_SB(0, 0), cB, voffB); PG8_STAGE(PG8_SA(0, 0), cA, voffA); PG8_STAGE(PG8_SB(0, 1), cB + hstep, voffB); PG8_STAGE(PG8_SA(0, 1), cA + hstep, voffA);
    if (wr == 1) PG8_BAR;
    PG8_WAIT_V(4); PG8_BAR;
    PG8_STAGE(PG8_SB(1, 0), cB + kstep, voffB); PG8_STAGE(PG8_SA(1, 0), cA + kstep, voffA); PG8_STAGE(PG8_SB(1, 1), cB + hstep + kstep, voffB);
    PG8_WAIT_V(6); PG8_BAR;
    PG8_STAMP();
    for (;;) {
        const bool has_next = S.next(ui + 1, nxt);
        const char* nA = has_next ? (const char*)g.A + (size_t)nxt.pm * tstep : cA; const char* nB = has_next ? (const char*)g.Bt + (size_t)nxt.pn * tstep : cB;
        for (int t = 0; t < nt; t += 2) {
            const bool last = (t == nt - 2);
            const char* a1 = cA + (size_t)(t + 1) * kstep;
            const char* a2 = last ? nA : cA + (size_t)(t + 2) * kstep; const char* b2 = last ? nB : cB + (size_t)(t + 2) * kstep;
            const char* a3 = a2 + kstep; const char* b3 = b2 + kstep;
            if (last && has_next) S.a_ready(nxt);
            PG8_LDB(B0, 0, 0); PG8_SCHED; PG8_LDA(At, 0, 0); PG8_STAGE(PG8_SA(1, 1), a1 + hstep, voffA);
            PG8_WAIT_L(8); PG8_BAR; PG8_WAIT_L(0); PG8_MMA(0, 0, At, B0); PG8_BAR; PG8_SCHED;
            PG8_LDB(B1, 0, 1); PG8_STAGE(PG8_SB(0, 0), b2, voffB);
            PG8_BAR; PG8_WAIT_L(0); PG8_MMA(0, 1, At, B1); PG8_BAR;
            PG8_LDA(At, 0, 1); PG8_STAGE(PG8_SA(0, 0), a2, voffA);
            PG8_BAR; PG8_WAIT_L(0); PG8_MMA(1, 0, At, B0); PG8_BAR; PG8_SCHED;
            PG8_STAGE(PG8_SB(0, 1), b2 + hstep, voffB);
            PG8_WAIT_V(6); PG8_BAR; PG8_MMA(1, 1, At, B1); PG8_BAR;
            PG8_LDB(B0, 1, 0); PG8_SCHED; PG8_LDA(At, 1, 0); PG8_STAGE(PG8_SA(0, 1), a2 + hstep, voffA);
            PG8_WAIT_L(8); PG8_BAR; PG8_WAIT_L(0); PG8_MMA(0, 0, At, B0); PG8_BAR; PG8_SCHED;
            PG8_LDB(B1, 1, 1); PG8_STAGE(PG8_SB(1, 0), b3, voffB);
            PG8_BAR; PG8_WAIT_L(0); PG8_MMA(0, 1, At, B1); PG8_BAR;
            PG8_LDA(At, 1, 1); PG8_STAGE(PG8_SA(1, 0), a3, voffA);
            PG8_BAR; PG8_WAIT_L(0); PG8_MMA(1, 0, At, B0); PG8_BAR; PG8_SCHED;
            PG8_STAGE(PG8_SB(1, 1), b3 + hstep, voffB);
            PG8_WAIT_V(6); PG8_BAR; PG8_MMA(1, 1, At, B1); PG8_BAR;
        }
        PG8_STAMP();
        if constexpr (!Epi::AFTER_DRAIN) { E(acc, cur, wr, wc, fr, fq); S.done(cur); }
        PG8_STAMP();
        if (!has_next) break;
#pragma unroll
        for (int a = 0; a < 2; ++a)
#pragma unroll
            for (int b = 0; b < 2; ++b)
#pragma unroll
                for (int m = 0; m < 4; ++m)
#pragma unroll
                    for (int n = 0; n < 2; ++n) acc[a][b][m][n] = (f32x4){0.f, 0.f, 0.f, 0.f};
        cur = nxt; cA = nA; cB = nB; ++ui;
    }
    PG8_WAIT_V(0);
    if (wr == 0) PG8_BAR;
    PG8_BAR;
    if constexpr (Epi::AFTER_DRAIN) { E.fused(acc, cur, wr, wc, fr, fq, lds, wid, lane); S.done(cur); }
    PG8_STAMP();
    if (STAMP && wid == 0) { stamps[lane] = lane < nts ? (((unsigned long long)(unsigned)ts_hi << 32) | (unsigned)ts_lo) : 0ull;
        if (lane == 62) stamps[62] = rt_entry; if (lane == 63) stamps[63] = (unsigned long long)wall_clock64(); }
#undef PG8_STAMP
#undef PG8_SA
#undef PG8_SB
#undef PG8_STAGE
#undef PG8_LDA
#undef PG8_LDB
#undef PG8_MMA
#undef PG8_WAIT_V
#undef PG8_WAIT_L
#undef PG8_BAR
#undef PG8_SCHED
}
}
#define XB_TMO      128
#define XB_XCNT(j)  (256  + 64 * (j))
#define XB_XSUB(j)  (1280 + 64 * (j))
#define XB_XGEN(j)  (2304 + 64 * (j))
#define XB_TOP      3328
#define XB_TOPGEN   3392
#define XCD_BAR_WORDS 3456
#define XB_SPIN_CAP (1u << 18)
#define XB_LAS __attribute__((address_space(3)))

__device__ __forceinline__ unsigned xb_ld(unsigned* p)              { return __hip_atomic_load(p, __ATOMIC_RELAXED, __HIP_MEMORY_SCOPE_AGENT); }
__device__ __forceinline__ unsigned xb_add(unsigned* p, unsigned v) { return __hip_atomic_fetch_add(p, v, __ATOMIC_RELAXED, __HIP_MEMORY_SCOPE_AGENT); }
__device__ __forceinline__ unsigned xb_xcc_id() { return (unsigned)__builtin_amdgcn_s_getreg((3 << 11) | 20) & 0xFu; }
#define XB_SPIN(cond, bar) do { unsigned _sp = 0; while (cond) { __builtin_amdgcn_s_sleep(1); \
    if ((++_sp & 255u) == 0u) { if (xb_ld(&(bar)[XB_TMO])) break; if (_sp > XB_SPIN_CAP) { atomicAdd(&(bar)[XB_TMO], 1u); break; } } } } while (0)

struct XcdBarrier {
    unsigned* bar; unsigned x;
    volatile XB_LAS unsigned* st;
};

__device__ __forceinline__ XcdBarrier xcd_barrier_post(unsigned* bar, volatile XB_LAS unsigned* st) {
    XcdBarrier b; b.bar = bar; b.x = xb_xcc_id(); b.st = st;
    if (threadIdx.x == 0) (void)xb_add(&bar[XB_XCNT(b.x)], 1u);
    return b;
}
__device__ __forceinline__ void xcd_barrier_complete(unsigned* bar, unsigned x, unsigned& nloc, unsigned& nx) {
    const unsigned G = gridDim.x * gridDim.y * gridDim.z;
    unsigned sum, cnt, mine, sp = 0u;
    for (;;) {
        sum = 0u; cnt = 0u; mine = 0u;
#pragma unroll
        for (unsigned j = 0; j < 16; ++j) { const unsigned c = xb_ld(&bar[XB_XCNT(j)]); sum += c; cnt += (c > 0u) ? 1u : 0u; mine = (j == x) ? c : mine; }
        if (sum == G) break;
        __builtin_amdgcn_s_sleep(1);
        if ((++sp & 255u) == 0u) { if (xb_ld(&bar[XB_TMO])) break; if (sp > XB_SPIN_CAP) { atomicAdd(&bar[XB_TMO], 1u); break; } }
    }
    nloc = mine > 0u ? mine : 1u; nx = cnt > 0u ? cnt : 1u;
}

__device__ __forceinline__ void xcd_barrier(const XcdBarrier& b) {
    asm volatile("s_waitcnt vmcnt(0)" ::: "memory");
    __syncthreads();
    if (threadIdx.x == 0) {
        unsigned* bar = b.bar;
        __builtin_amdgcn_s_waitcnt(0);
        unsigned nloc = b.st[0], nx = b.st[1];
        if (nloc == 0u) { xcd_barrier_complete(bar, b.x, nloc, nx); b.st[0] = nloc; b.st[1] = nx; }
        const unsigned old = xb_add(&bar[XB_XSUB(b.x)], 1u);
        const unsigned gen = old / nloc;
        if (old + 1u == (gen + 1u) * nloc) {
            __builtin_amdgcn_fence(__ATOMIC_RELEASE, "agent");
            asm volatile("s_waitcnt vmcnt(0)" ::: "memory");
            const unsigned og = xb_add(&bar[XB_TOP], 1u);
            const unsigned tg = og / nx;
            if (og + 1u == (tg + 1u) * nx) xb_add(&bar[XB_TOPGEN], 1u);
            else XB_SPIN(xb_ld(&bar[XB_TOPGEN]) == tg, bar);
            __builtin_amdgcn_fence(__ATOMIC_ACQUIRE, "agent");
            xb_add(&bar[XB_XGEN(b.x)], 1u);
            asm volatile("s_waitcnt vmcnt(0)" ::: "memory");
        } else {
            XB_SPIN(xb_ld(&bar[XB_XGEN(b.x)]) == gen, bar);
            __builtin_amdgcn_fence(__ATOMIC_ACQUIRE, "agent");
            asm volatile("s_waitcnt vmcnt(0)" ::: "memory");
        }
    }
    __syncthreads();
}
using pg8::bf16_t; using pg8::bf16x8; using pg8::f32x4; using pg8::u32x4; using pg8::Unit;
typedef unsigned u32x2 __attribute__((ext_vector_type(2)));
#define MFMA16(a, b, c) __builtin_amdgcn_mfma_f32_16x16x32_bf16((a), (b), (c), 0, 0, 0)

constexpr int T_ = 16384, DM = 2048, NIN = 6144, DFF = 5504, NFF = 11008;
constexpr int LDS_BYTES = 144 * 1024;
constexpr int NPH = 11;

constexpr size_t O_CTR   = 0;
constexpr size_t O_BAR   = 4096;
constexpr size_t O_WIN   = 4096 + 16384;
constexpr size_t O_WOUT  = O_WIN   + (size_t)NIN * DM * 2;
constexpr size_t O_WFIN  = O_WOUT  + (size_t)DM * DM * 2;
constexpr size_t O_WFOUT = O_WFIN  + (size_t)NFF * DM * 2;
constexpr size_t O_WCK   = O_WFOUT + (size_t)DM * DFF * 2;
constexpr size_t O_WCV   = O_WCK   + (size_t)256 * 2048 * 2;
constexpr size_t O_WGLU  = O_WCV   + (size_t)256 * 2048 * 2;
constexpr size_t O_HN    = O_WGLU  + (size_t)512 * 512 * 2;
constexpr size_t O_R     = O_HN    + (size_t)T_ * DM * 2;
constexpr size_t O_P32   = O_R;
constexpr size_t O_PU    = O_P32   + (size_t)T_ * 1536 * 4;
constexpr size_t O_PQKV  = O_PU    + (size_t)T_ * 512 * 2;
constexpr size_t O_PZ    = O_PQKV  + (size_t)T_ * 3072 * 2;
constexpr size_t O_QN    = O_PZ    + (size_t)T_ * 1024 * 2;
constexpr size_t O_KSN   = O_QN    + (size_t)T_ * 512 * 2;
constexpr size_t O_KWN   = O_KSN   + (size_t)T_ * 128 * 2;
constexpr size_t O_VST   = O_KWN   + (size_t)T_ * 128 * 2;
constexpr size_t O_VWT   = O_VST   + (size_t)T_ * 128 * 2;
constexpr size_t O_KC    = O_VWT   + (size_t)T_ * 128 * 2;
constexpr size_t O_VCT   = O_KC    + (size_t)2 * 1024 * 64 * 2;
constexpr size_t O_HCMP  = O_VCT   + (size_t)2 * 64 * 1024 * 2;
constexpr size_t O_GKC   = O_HCMP  + (size_t)2 * 2048 * 256 * 4;
constexpr size_t O_GQG   = O_GKC   + (size_t)2048 * 64 * 128 * 2;
constexpr size_t O_GQK   = O_GQG   + (size_t)2048 * 64 * 128 * 2;
constexpr size_t O_GKD   = O_GQK   + (size_t)2048 * 64 * 64 * 2;
constexpr size_t O_GVAL  = O_GKD   + (size_t)2048 * 64 * 128 * 2;
constexpr size_t O_GEGL  = O_GVAL  + (size_t)2048 * 64 * 128 * 4;
constexpr size_t O_XEND  = O_GEGL  + 8192;
constexpr size_t O_YGELU = O_XEND  + (size_t)64 * 32 * 64 * 2 * 4;
constexpr size_t O_YGLU  = O_YGELU + (size_t)T_ * 512 * 2;
constexpr size_t O_ATT_END = O_YGLU + (size_t)T_ * 512 * 4;
constexpr size_t O_HF    = O_R;
constexpr size_t O_ACT   = O_HF    + (size_t)T_ * NFF * 2;
constexpr size_t O_FFN_END = O_ACT + (size_t)T_ * DFF * 2;
constexpr size_t WS_NEED = O_ATT_END > O_FFN_END ? O_ATT_END : O_FFN_END;

struct Params { const float* in[33]; float* out; unsigned char* ws; int ph_lo, ph_hi; };

__device__ __forceinline__ unsigned short f2bf(float f) { unsigned u = __float_as_uint(f); u += 0x7FFFu + ((u >> 16) & 1u); return (unsigned short)(u >> 16); }
__device__ __forceinline__ float bf2f(unsigned short b) { return __uint_as_float(((unsigned)b) << 16); }
__device__ __forceinline__ unsigned pk2(float lo, float hi) { return pg8::cvt_pk_bf16(lo, hi); }
__device__ __forceinline__ float bflo(unsigned w) { return __uint_as_float(w << 16); }
__device__ __forceinline__ float bfhi(unsigned w) { return __uint_as_float(w & 0xFFFF0000u); }
__device__ __forceinline__ float sigmoidf_(float x) { return __builtin_amdgcn_rcpf(1.0f + __expf(-x)); }
__device__ __forceinline__ float siluf_(float x) { return x * __builtin_amdgcn_rcpf(1.0f + __expf(-x)); }
__device__ __forceinline__ float vmaxf(float a, float b) { float r; asm("v_max_f32 %0, %1, %2" : "=v"(r) : "v"(a), "v"(b)); return r; }
__device__ __forceinline__ float gelu_tanh(float x) { const float u = 0.7978845608028654f * (x + 0.044715f * x * x * x); const float th = 1.0f - 2.0f * __builtin_amdgcn_rcpf(__expf(2.0f * u) + 1.0f); return 0.5f * x * (1.0f + th); }
__device__ __forceinline__ float softplusf_(float x) { return x > 20.f ? x : log1pf(expf(x)); }
__device__ __forceinline__ float wave_sum(float v) { for (int o = 32; o >= 1; o >>= 1) v += __shfl_xor(v, o); return v; }
__device__ __forceinline__ bf16x8 pack8f(f32x4 a, f32x4 b) { u32x4 w; w.x = pk2(a[0], a[1]); w.y = pk2(a[2], a[3]); w.z = pk2(b[0], b[1]); w.w = pk2(b[2], b[3]); return __builtin_bit_cast(bf16x8, w); }
__device__ __forceinline__ float rdlane(float v, int l) { return __int_as_float(__builtin_amdgcn_readlane(__float_as_int(v), l)); }

struct EpiProj {
    static constexpr bool PERM = false, AFTER_DRAIN = false;
    float* P32; bf16_t* Pu; bf16_t* Pqkv; bf16_t* Pz;
    static __device__ __forceinline__ void st_bf(const f32x4 (&acc)[2][2][4][2], bf16_t* base, int ld) {
#pragma unroll
        for (int ai = 0; ai < 2; ++ai)
#pragma unroll
            for (int m = 0; m < 4; ++m) { bf16_t* rp = base + (size_t)(ai * 128 + m * 16) * ld;
#pragma unroll
                for (int bj = 0; bj < 2; ++bj)
#pragma unroll
                    for (int n = 0; n < 2; ++n) { const f32x4 v = acc[ai][bj][m][n]; u32x2 w; w.x = pk2(v[0], v[1]); w.y = pk2(v[2], v[3]); *(u32x2*)(rp + bj * 128 + n * 16) = w; } }
    }
    __device__ __forceinline__ void operator()(const f32x4 (&acc)[2][2][4][2], const Unit& u, int wr, int wc, int fr, int fq) const {
        const int row0 = u.pm * 256 + wr * 64 + fr, colt = wc * 32 + 4 * fq;
        if (u.pn < 6) {
            float* base = P32 + (size_t)row0 * 1536 + u.pn * 256 + colt;
#pragma unroll
            for (int ai = 0; ai < 2; ++ai)
#pragma unroll
                for (int m = 0; m < 4; ++m) { float* rp = base + (size_t)(ai * 128 + m * 16) * 1536;
#pragma unroll
                    for (int bj = 0; bj < 2; ++bj)
#pragma unroll
                        for (int n = 0; n < 2; ++n) *(f32x4*)(rp + bj * 128 + n * 16) = acc[ai][bj][m][n]; }
        } else if (u.pn < 8)  st_bf(acc, Pu   + (size_t)row0 * 512  + (u.pn - 6)  * 256 + colt, 512);
        else if (u.pn < 20)   st_bf(acc, Pqkv + (size_t)row0 * 3072 + (u.pn - 8)  * 256 + colt, 3072);
        else                  st_bf(acc, Pz   + (size_t)row0 * 1024 + (u.pn - 20) * 256 + colt, 1024);
    }
};
struct EpiResid {
    static constexpr bool PERM = false, AFTER_DRAIN = false;
    float* X; int ld;
    __device__ __forceinline__ void operator()(const f32x4 (&acc)[2][2][4][2], const Unit& u, int wr, int wc, int fr, int fq) const {
        float* base = X + (size_t)(u.pm * 256 + wr * 64 + fr) * ld + u.pn * 256 + wc * 32 + 4 * fq;
#pragma unroll
        for (int ai = 0; ai < 2; ++ai)
#pragma unroll
            for (int m = 0; m < 4; ++m) { float* rp = base + (size_t)(ai * 128 + m * 16) * ld;
#pragma unroll
                for (int bj = 0; bj < 2; ++bj)
#pragma unroll
                    for (int n = 0; n < 2; ++n) { f32x4* q = (f32x4*)(rp + bj * 128 + n * 16); *q = *q + acc[ai][bj][m][n]; } }
    }
};
struct EpiBf {
    static constexpr bool PERM = false, AFTER_DRAIN = false;
    bf16_t* O; int ld;
    __device__ __forceinline__ void operator()(const f32x4 (&acc)[2][2][4][2], const Unit& u, int wr, int wc, int fr, int fq) const {
        bf16_t* base = O + (size_t)(u.pm * 256 + wr * 64 + fr) * ld + u.pn * 256 + wc * 32 + 4 * fq;
#pragma unroll
        for (int ai = 0; ai < 2; ++ai)
#pragma unroll
            for (int m = 0; m < 4; ++m) { bf16_t* rp = base + (size_t)(ai * 128 + m * 16) * ld;
#pragma unroll
                for (int bj = 0; bj < 2; ++bj)
#pragma unroll
                    for (int n = 0; n < 2; ++n) { const f32x4 v = acc[ai][bj][m][n]; u32x2 w; w.x = pk2(v[0], v[1]); w.y = pk2(v[2], v[3]); *(u32x2*)(rp + bj * 128 + n * 16) = w; } }
    }
};
struct EpiGlu {
    static constexpr bool PERM = false, AFTER_DRAIN = false;
    const bf16_t* Y; float* O;
    __device__ __forceinline__ void operator()(const f32x4 (&acc)[2][2][4][2], const Unit& u, int wr, int wc, int fr, int fq) const {
        const size_t off0 = (size_t)(u.pm * 256 + wr * 64 + fr) * 512 + u.pn * 256 + wc * 32 + 4 * fq;
#pragma unroll
        for (int ai = 0; ai < 2; ++ai)
#pragma unroll
            for (int m = 0; m < 4; ++m) { const size_t ro = off0 + (size_t)(ai * 128 + m * 16) * 512;
#pragma unroll
                for (int bj = 0; bj < 2; ++bj)
#pragma unroll
                    for (int n = 0; n < 2; ++n) { const size_t o = ro + bj * 128 + n * 16; const u32x2 yw = *(const u32x2*)(Y + o); const f32x4 a = acc[ai][bj][m][n];
                        f32x4 r; r[0] = bflo(yw.x) * sigmoidf_(a[0]); r[1] = bfhi(yw.x) * sigmoidf_(a[1]); r[2] = bflo(yw.y) * sigmoidf_(a[2]); r[3] = bfhi(yw.y) * sigmoidf_(a[3]); *(f32x4*)(O + o) = r; } }
    }
};
__device__ __forceinline__ int map_in_col(int n) { return n < 1304 ? n : (n < 1312 ? 5912 + (n - 1304) : (n < 1320 ? 5920 + (n - 1312) : (n < 1536 ? -1 : 1304 + (n - 1536)))); }
__device__ void convT_tile(const float* __restrict__ src, int srcN, int K, bf16_t* __restrict__ dst, int tile, bool inmap, float* sm) {
    const int nk = K >> 6, tk = tile % nk, tn = tile / nk, k0 = tk * 64, n0 = tn * 256;
    const int tid = tidx(), tx = tid & 255, ty = tid >> 8;
    const int n = n0 + tx, sc = inmap ? map_in_col(n) : n;
    float v[32];
#pragma unroll
    for (int i = 0; i < 32; ++i) v[i] = (sc >= 0) ? src[(size_t)(k0 + ty + 2 * i) * srcN + sc] : 0.f;
#pragma unroll
    for (int i = 0; i < 32; ++i) sm[(ty + 2 * i) * 257 + tx] = v[i];
    __syncthreads();
    const int nn = tid >> 1, hf = tid & 1;
    bf16_t* o = dst + (size_t)(n0 + nn) * K + k0 + hf * 32;
#pragma unroll
    for (int q = 0; q < 4; ++q) { u32x4 w; const float* sp = sm + (hf * 32 + q * 8) * 257 + nn;
        w.x = pk2(sp[0], sp[257]); w.y = pk2(sp[2 * 257], sp[3 * 257]); w.z = pk2(sp[4 * 257], sp[5 * 257]); w.w = pk2(sp[6 * 257], sp[7 * 257]); *(u32x4*)(o + q * 8) = w; }
    __syncthreads();
}
__device__ void phase_convert(const Params& p, int layer, float* sm) {
    unsigned char* ws = p.ws;
    const int G = gridDim.x, b = blockIdx.x;
    const int n0 = 32 * 24, n1 = n0 + 32 * 8, n2 = n1 + 32 * 43, n3 = n2 + 86 * 8, n4 = n3 + 32, n5 = n4 + 32, n6 = n5 + 16;
    for (int it = b; it < n6; it += G) {
        if (it < n0)      convT_tile(p.in[2]  + (size_t)layer * DM * 5928, 5928, DM, (bf16_t*)(ws + O_WIN), it, true, sm);
        else if (it < n1) convT_tile(p.in[27] + (size_t)layer * DM * DM, DM, DM, (bf16_t*)(ws + O_WOUT), it - n0, false, sm);
        else if (it < n2) convT_tile(p.in[29] + (size_t)layer * DM * NFF, NFF, DM, (bf16_t*)(ws + O_WFIN), it - n1, false, sm);
        else if (it < n3) convT_tile(p.in[32] + (size_t)layer * DFF * DM, DM, DFF, (bf16_t*)(ws + O_WFOUT), it - n2, false, sm);
        else if (it < n4) convT_tile(p.in[8]  + (size_t)layer * 2048 * 256, 256, 2048, (bf16_t*)(ws + O_WCK), it - n3, false, sm);
        else if (it < n5) convT_tile(p.in[10] + (size_t)layer * 2048 * 256, 256, 2048, (bf16_t*)(ws + O_WCV), it - n4, false, sm);
        else              convT_tile(p.in[21] + (size_t)layer * 512 * 512, 512, 512, (bf16_t*)(ws + O_WGLU), it - n5, false, sm);
    }
}
__device__ void phase_rmsnorm(const float* __restrict__ x, const float* __restrict__ gain, bf16_t* __restrict__ hn, float* __restrict__ xcopy) {
    const int wave = tidx() >> 6, lane = tidx() & 63;
    for (int r = blockIdx.x * 8 + wave; r < T_; r += gridDim.x * 8) {
        const f32x4* xr = (const f32x4*)(x + (size_t)r * DM);
        f32x4 v[8]; float ss = 0.f;
#pragma unroll
        for (int i = 0; i < 8; ++i) { v[i] = xr[lane + 64 * i]; ss += v[i][0] * v[i][0] + v[i][1] * v[i][1] + v[i][2] * v[i][2] + v[i][3] * v[i][3]; }
        ss = wave_sum(ss);
        const float rs = rsqrtf(ss * (1.0f / DM) + 1e-6f);
#pragma unroll
        for (int i = 0; i < 8; ++i) { const f32x4 g = ((const f32x4*)gain)[lane + 64 * i]; u32x2 w; w.x = pk2(v[i][0] * rs * g[0], v[i][1] * rs * g[1]); w.y = pk2(v[i][2] * rs * g[2], v[i][3] * rs * g[3]);
            *(u32x2*)(hn + (size_t)r * DM + (lane + 64 * i) * 4) = w; if (xcopy) ((f32x4*)(xcopy + (size_t)r * DM))[lane + 64 * i] = v[i]; }
    }
}

__device__ void nsa_prep_item(const Params& p, int layer, int item, float* sm) {
    unsigned char* ws = p.ws;
    const float* P32 = (const float*)(ws + O_P32);
    bf16_t* qn = (bf16_t*)(ws + O_QN); bf16_t* ksn = (bf16_t*)(ws + O_KSN); bf16_t* kwn = (bf16_t*)(ws + O_KWN);
    const int wave = tidx() >> 6, lane = tidx() & 63, tid = tidx();
    const int t0 = item * 64;
    const float gq = p.in[3][layer * 64 + lane], gks = p.in[5][layer * 64 + lane], gkw = p.in[6][layer * 64 + lane];
    const float inv = powf(500000.0f, -(float)(lane & 7) * 0.125f);
    for (int tt = 0; tt < 8; ++tt) {
        const int t = t0 + wave * 8 + tt;
        float sn, cs; sincosf((float)t * inv, &sn, &cs);
        const float* row = P32 + (size_t)t * 1536;
#pragma unroll
        for (int hv = 0; hv < 12; ++hv) {
            const int col = hv < 8 ? hv * 64 : (hv < 10 ? 768 + (hv - 8) * 64 : 1024 + (hv - 10) * 64);
            const float g = hv < 8 ? gq : (hv < 10 ? gks : gkw);
            const float x = row[col + lane];
            const float ss = wave_sum(x * x);
            float y = x * rsqrtf(ss * (1.0f / 64.0f) + 1e-6f) * g;
            const float yp = __shfl(y, lane ^ 8);
            if (lane < 8) y = y * cs - yp * sn; else if (lane < 16) y = y * cs + yp * sn;
            if (hv < 8) qn[(size_t)t * 512 + hv * 64 + lane] = f2bf(y * 0.18033688011112042f);
            else {
                unsigned char* k8 = (hv < 10 ? ws + O_KSN : ws + O_KWN) + ((size_t)(((hv - 8) & 1) * 256 + (t >> 6)) * 64 + (t & 63)) * 64 + ((lane >> 3) & 3) * 16 + (lane >> 5) * 8 + (lane & 7);
                *k8 = (unsigned char)__builtin_amdgcn_cvt_pk_fp8_f32(y, 0.f, 0, false);
            }
        }
    }
    for (int e = tid; e < 64 * 256; e += 512) { const int tk = e >> 8, c = e & 255; sm[tk * 257 + c] = P32[(size_t)(t0 + tk) * 1536 + (c < 128 ? 896 + c : 1152 + (c - 128))]; }
    __syncthreads();
    unsigned char* vs8 = ws + O_VST; unsigned char* vw8 = ws + O_VWT;
#pragma unroll
    for (int i = 0; i < 4; ++i) {
        const int rowid = (tid >> 3) + 64 * i, ts = tid & 7;
        float f[8];
#pragma unroll
        for (int k = 0; k < 8; ++k) { const int bb = ts * 8 + k, cc = ((bb >> 3) & 1) * 32 + (bb >> 4) * 8 + (bb & 7); f[k] = sm[((cc & 3) * 16 + (cc >> 2)) * 257 + rowid]; }
        u32x2 w; int t;
        t = __builtin_amdgcn_cvt_pk_fp8_f32(f[0], f[1], 0, false); t = __builtin_amdgcn_cvt_pk_fp8_f32(f[2], f[3], t, true); w.x = (unsigned)t;
        t = __builtin_amdgcn_cvt_pk_fp8_f32(f[4], f[5], 0, false); t = __builtin_amdgcn_cvt_pk_fp8_f32(f[6], f[7], t, true); w.y = (unsigned)t;
        const int rr = rowid & 127;
        unsigned char* dst = (rowid < 128 ? vs8 : vw8) + ((size_t)((rr >> 6) * 256 + item) * 64 + (rr & 63)) * 64 + ts * 8;
        *(u32x2*)dst = w;
    }
    __syncthreads();
}

__device__ void cmp1_wave_tile(const Params& p, int layer, int tile) {
    unsigned char* ws = p.ws;
    const float* P32 = (const float*)(ws + O_P32);
    const int lane = tidx() & 63, fr = lane & 15, fq = lane >> 4;
    const int nt = tile & 15, mt = (tile >> 4) & 127, which = tile >> 11;
    const bf16_t* Wt = (const bf16_t*)(ws + (which ? O_WCV : O_WCK)) + (size_t)(nt * 16 + fr) * 2048 + fq * 8;
    const float* pe = p.in[7] + (size_t)layer * 2048;
    const int r = mt * 16 + fr, n = r >> 1, hk = r & 1;
    const bool rv = n < 1023;
    const float* arow = P32 + (size_t)(16 * (rv ? n : 0)) * 1536 + (which ? 640 : 512) + hk * 64 + fq * 8;
    f32x4 acc = {0.f, 0.f, 0.f, 0.f};
#pragma unroll 4
    for (int ks = 0; ks < 64; ++ks) {
        const int l = ks >> 1, d = (ks & 1) * 32;
        const f32x4* ap = (const f32x4*)(arow + (size_t)l * 1536 + d);
        const f32x4* pp = (const f32x4*)(pe + l * 64 + d + fq * 8);
        f32x4 a0 = ap[0] + pp[0], a1 = ap[1] + pp[1];
        if (!rv) { a0 = (f32x4){0.f, 0.f, 0.f, 0.f}; a1 = a0; }
        const bf16x8 af = pack8f(a0, a1);
        const bf16x8 bf = *(const bf16x8*)(Wt + ks * 32);
        acc = MFMA16(af, bf, acc);
    }
    float* H = (float*)(ws + O_HCMP) + (size_t)which * 2048 * 256;
#pragma unroll
    for (int j = 0; j < 4; ++j) H[(size_t)(mt * 16 + fq * 4 + j) * 256 + nt * 16 + fr] = gelu_tanh(acc[j]);
}
__device__ void cmp2_wave_row(const Params& p, int layer, int idx) {
    unsigned char* ws = p.ws;
    const int lane = tidx() & 63;
    const int which = idx >> 11, r = idx & 2047, n = r >> 1, hk = r & 1;
    const float* H = (const float*)(ws + O_HCMP) + ((size_t)which * 2048 + r) * 256;
    const float* w2 = p.in[which ? 11 : 9] + (size_t)layer * 256 * 64;
    float acc = 0.f;
    if (n < 1023) {
#pragma unroll 8
        for (int f = 0; f < 256; ++f) acc += H[f] * w2[f * 64 + lane];
    }
    if (which == 0) {
        const float ss = wave_sum(acc * acc);
        float y = acc * rsqrtf(ss * (1.0f / 64.0f) + 1e-6f) * p.in[4][layer * 64 + lane];
        const float inv = powf(500000.0f, -(float)(lane & 7) * 0.125f);
        float sn, cs; sincosf((float)(16 * n + 16) * inv, &sn, &cs);
        const float yp = __shfl(y, lane ^ 8);
        if (lane < 8) y = y * cs - yp * sn; else if (lane < 16) y = y * cs + yp * sn;
        if (n >= 1023) y = 0.f;
        ((bf16_t*)(ws + O_KC))[((size_t)hk * 1024 + n) * 64 + lane] = f2bf(y);
    } else {
        { const int cc = ((n & 15) << 2) | ((n >> 4) & 3); (ws + O_VCT)[((size_t)(hk * 16 + (n >> 6)) * 64 + lane) * 64 + ((cc >> 3) & 3) * 16 + (cc >> 5) * 8 + (cc & 7)] = (unsigned char)__builtin_amdgcn_cvt_pk_fp8_f32(acc, 0.f, 0, false); }
    }
}

struct S5Coef { float ar, ai; float bbr[16], bbi[16]; };
__device__ __forceinline__ void s5_setup(const Params& p, int layer, int g, int lane, S5Coef& c) {
    const int gp = layer * 2048 + g * 64 + lane;
    const float dt = expf(p.in[15][layer * 32 + g]);
    const float lr = p.in[13][gp], li = p.in[14][gp];
    const float mag = expf(lr * dt); float sn, cs; sincosf(li * dt, &sn, &cs);
    c.ar = mag * cs; c.ai = mag * sn;
    const float den = lr * lr + li * li, nr = c.ar - 1.0f, ni = c.ai;
    const float cr = (nr * lr + ni * li) / den, ci = (ni * lr - nr * li) / den;
    const f32x4* br = (const f32x4*)(p.in[16] + (size_t)gp * 16); const f32x4* bi = (const f32x4*)(p.in[17] + (size_t)gp * 16);
#pragma unroll
    for (int q = 0; q < 4; ++q) { const f32x4 a = br[q], b = bi[q];
#pragma unroll
        for (int e = 0; e < 4; ++e) { c.bbr[q * 4 + e] = cr * a[e] - ci * b[e]; c.bbi[q * 4 + e] = cr * b[e] + ci * a[e]; } }
}
__device__ __forceinline__ void s5_load_u(const bf16_t* Pu, int tok, int g, float (&ur)[16]) {
    const u32x4* s = (const u32x4*)(Pu + (size_t)tok * 512 + g * 16); const u32x4 a = s[0], b = s[1];
    ur[0] = bflo(a.x); ur[1] = bfhi(a.x); ur[2] = bflo(a.y); ur[3] = bfhi(a.y); ur[4] = bflo(a.z); ur[5] = bfhi(a.z); ur[6] = bflo(a.w); ur[7] = bfhi(a.w);
    ur[8] = bflo(b.x); ur[9] = bfhi(b.x); ur[10] = bflo(b.y); ur[11] = bfhi(b.y); ur[12] = bflo(b.z); ur[13] = bfhi(b.z); ur[14] = bflo(b.w); ur[15] = bfhi(b.w);
}
__device__ void s5_passA_wave(const Params& p, int layer, int item) {
    unsigned char* ws = p.ws; const bf16_t* Pu = (const bf16_t*)(ws + O_PU);
    const int lane = tidx() & 63, c = item >> 5, g = item & 31;
    S5Coef k; s5_setup(p, layer, g, lane, k);
    float xr = 0.f, xi = 0.f;
    for (int sub = 0; sub < 4; ++sub) {
        float ur[16]; s5_load_u(Pu, c * 256 + sub * 64 + lane, g, ur);
        for (int j = 0; j < 64; ++j) {
            float bur = 0.f, bui = 0.f;
#pragma unroll
            for (int h = 0; h < 16; ++h) { const float u = rdlane(ur[h], j); bur += k.bbr[h] * u; bui += k.bbi[h] * u; }
            const float nxr = k.ar * xr - k.ai * xi + bur, nxi = k.ar * xi + k.ai * xr + bui; xr = nxr; xi = nxi;
        }
    }
    float* xe = (float*)(ws + O_XEND) + ((size_t)(c * 32 + g) * 64 + lane) * 2; xe[0] = xr; xe[1] = xi;
}
__device__ void s5_passB_wave(const Params& p, int layer, int item, bf16_t* xl) {
    unsigned char* ws = p.ws; const bf16_t* Pu = (const bf16_t*)(ws + O_PU); bf16_t* yg = (bf16_t*)(ws + O_YGELU);
    const int lane = tidx() & 63, fr = lane & 15, fq = lane >> 4, c = item >> 5, g = item & 31;
    S5Coef k; s5_setup(p, layer, g, lane, k);
    float pr = k.ar, pi = k.ai;
#pragma unroll
    for (int s = 0; s < 8; ++s) { const float nr = pr * pr - pi * pi, ni = 2.f * pr * pi; pr = nr; pi = ni; }
    float xr = 0.f, xi = 0.f;
    const float* xe = (const float*)(ws + O_XEND) + ((size_t)g * 64 + lane) * 2;
    for (int cc = 0; cc < c; ++cc) { const float er = xe[(size_t)cc * 32 * 64 * 2], ei = xe[(size_t)cc * 32 * 64 * 2 + 1]; const float nr = pr * xr - pi * xi + er, ni = pr * xi + pi * xr + ei; xr = nr; xi = ni; }
    bf16x8 cf[4];
    {
        const float* cre = p.in[18] + (size_t)layer * 32 * 16 * 64 + ((size_t)g * 16 + fr) * 64; const float* cim = p.in[19] + (size_t)layer * 32 * 16 * 64 + ((size_t)g * 16 + fr) * 64;
#pragma unroll
        for (int ks = 0; ks < 4; ++ks) { const float* s = (ks < 2 ? cre : cim) + (ks & 1) * 32 + fq * 8; f32x4 a = ((const f32x4*)s)[0], b = ((const f32x4*)s)[1]; if (ks >= 2) { a = -a; b = -b; } cf[ks] = pack8f(a, b); }
    }
    const float dsk = p.in[20][layer * 512 + g * 16 + fr];
    for (int sub = 0; sub < 4; ++sub) {
        const int tb = c * 256 + sub * 64;
        float ur[16]; s5_load_u(Pu, tb + lane, g, ur);
        for (int jb = 0; jb < 4; ++jb) {
            for (int jj = 0; jj < 16; ++jj) {
                const int j = jb * 16 + jj;
                float bur = 0.f, bui = 0.f;
#pragma unroll
                for (int h = 0; h < 16; ++h) { const float u = rdlane(ur[h], j); bur += k.bbr[h] * u; bui += k.bbi[h] * u; }
                const float nxr = k.ar * xr - k.ai * xi + bur, nxi = k.ar * xi + k.ai * xr + bui; xr = nxr; xi = nxi;
                xl[jj * 136 + lane] = f2bf(xr); xl[jj * 136 + 64 + lane] = f2bf(xi);
            }
            asm volatile("s_waitcnt lgkmcnt(0)" ::: "memory");
            f32x4 y = {0.f, 0.f, 0.f, 0.f};
#pragma unroll
            for (int ks = 0; ks < 4; ++ks) { const bf16x8 af = *(const bf16x8*)(xl + fr * 136 + ks * 32 + fq * 8); y = MFMA16(af, cf[ks], y); }
            asm volatile("s_waitcnt lgkmcnt(0)" ::: "memory");
#pragma unroll
            for (int q = 0; q < 4; ++q) { const int tok = tb + jb * 16 + fq * 4 + q; const float u = bf2f(Pu[(size_t)tok * 512 + g * 16 + fr]); yg[(size_t)tok * 512 + g * 16 + fr] = f2bf(gelu_tanh(y[q] + dsk * u)); }
        }
    }
}
__device__ void gdn_prep_item(const Params& p, int layer, int item, unsigned char* lds) {
    unsigned char* ws = p.ws;
    const int tid = tidx(), wave = tid >> 6, lane = tid & 63, fr = lane & 15, fq = lane >> 4;
    const int n = item >> 3, h = item & 7, t0 = n * 64;
    bf16_t* qs = (bf16_t*)(lds); bf16_t* ks = (bf16_t*)(lds + 17408); bf16_t* vbT = (bf16_t*)(lds + 34816); bf16_t* kgT = (bf16_t*)(lds + 53248); bf16_t* kdT = (bf16_t*)(lds + 71680);
    float* Am = (float*)(lds + 90112); bf16_t* Tb = (bf16_t*)(lds + 107520); float* gcs = (float*)(lds + 116736); float* bts = (float*)(lds + 116992);
    const float* P32 = (const float*)(ws + O_P32); const bf16_t* Pqkv = (const bf16_t*)(ws + O_PQKV);
    if (wave == 0) {
        const int t = t0 + lane;
        const float a = P32[(size_t)t * 1536 + 1304 + h], b = P32[(size_t)t * 1536 + 1312 + h];
        const float g = -expf(p.in[24][layer * 8 + h]) * softplusf_(a + p.in[25][layer * 8 + h]);
        float s = g;
#pragma unroll
        for (int off = 1; off < 64; off <<= 1) { const float o = __shfl_up(s, off); if (lane >= off) s += o; }
        gcs[lane] = s; bts[lane] = sigmoidf_(b);
    }
    __syncthreads();
    {
        const int r = tid >> 3, c0 = (tid & 7) * 16;
        const float gcr = gcs[r], btr = bts[r], eg = expf(gcr), ed = expf(gcs[63] - gcr);
        const float* cw = p.in[23] + (size_t)layer * 4 * 3072;
#pragma unroll
        for (int which = 0; which < 3; ++which) {
            const int col = which * 1024 + h * 128 + c0;
            float acc[16];
#pragma unroll
            for (int e = 0; e < 16; ++e) acc[e] = 0.f;
#pragma unroll
            for (int j = 0; j < 4; ++j) {
                const int tr = t0 + r - 3 + j;
                if (tr >= 0) {
                    const u32x4* s = (const u32x4*)(Pqkv + (size_t)tr * 3072 + col); const u32x4 a = s[0], b = s[1];
                    const f32x4* wp = (const f32x4*)(cw + j * 3072 + col); const f32x4 w0 = wp[0], w1 = wp[1], w2 = wp[2], w3 = wp[3];
                    acc[0] += w0[0] * bflo(a.x); acc[1] += w0[1] * bfhi(a.x); acc[2] += w0[2] * bflo(a.y); acc[3] += w0[3] * bfhi(a.y);
                    acc[4] += w1[0] * bflo(a.z); acc[5] += w1[1] * bfhi(a.z); acc[6] += w1[2] * bflo(a.w); acc[7] += w1[3] * bfhi(a.w);
                    acc[8] += w2[0] * bflo(b.x); acc[9] += w2[1] * bfhi(b.x); acc[10] += w2[2] * bflo(b.y); acc[11] += w2[3] * bfhi(b.y);
                    acc[12] += w3[0] * bflo(b.z); acc[13] += w3[1] * bfhi(b.z); acc[14] += w3[2] * bflo(b.w); acc[15] += w3[3] * bfhi(b.w);
                }
            }
            float ss = 0.f;
#pragma unroll
            for (int e = 0; e < 16; ++e) { acc[e] = siluf_(acc[e]); ss += acc[e] * acc[e]; }
            ss += __shfl_xor(ss, 1); ss += __shfl_xor(ss, 2); ss += __shfl_xor(ss, 4);
            const float rn = rsqrtf(ss + 1e-6f);
            if (which == 0) {
                bf16_t* qg = (bf16_t*)(ws + O_GQG) + (size_t)item * 8192 + r * 128 + c0;
                float v[16];
#pragma unroll
                for (int e = 0; e < 16; ++e) v[e] = acc[e] * rn * 0.08838834764831845f;
                u32x4 w0, w1; w0.x = pk2(v[0], v[1]); w0.y = pk2(v[2], v[3]); w0.z = pk2(v[4], v[5]); w0.w = pk2(v[6], v[7]); w1.x = pk2(v[8], v[9]); w1.y = pk2(v[10], v[11]); w1.z = pk2(v[12], v[13]); w1.w = pk2(v[14], v[15]);
                *(u32x4*)(qs + r * 136 + c0) = w0; *(u32x4*)(qs + r * 136 + c0 + 8) = w1;
                u32x4 g0, g1; g0.x = pk2(v[0] * eg, v[1] * eg); g0.y = pk2(v[2] * eg, v[3] * eg); g0.z = pk2(v[4] * eg, v[5] * eg); g0.w = pk2(v[6] * eg, v[7] * eg);
                g1.x = pk2(v[8] * eg, v[9] * eg); g1.y = pk2(v[10] * eg, v[11] * eg); g1.z = pk2(v[12] * eg, v[13] * eg); g1.w = pk2(v[14] * eg, v[15] * eg);
                *(u32x4*)qg = g0; *(u32x4*)(qg + 8) = g1;
            } else if (which == 1) {
                float v[16];
#pragma unroll
                for (int e = 0; e < 16; ++e) v[e] = acc[e] * rn;
                u32x4 w0, w1; w0.x = pk2(v[0], v[1]); w0.y = pk2(v[2], v[3]); w0.z = pk2(v[4], v[5]); w0.w = pk2(v[6], v[7]); w1.x = pk2(v[8], v[9]); w1.y = pk2(v[10], v[11]); w1.z = pk2(v[12], v[13]); w1.w = pk2(v[14], v[15]);
                *(u32x4*)(ks + r * 136 + c0) = w0; *(u32x4*)(ks + r * 136 + c0 + 8) = w1;
#pragma unroll
                for (int e = 0; e < 16; ++e) { kgT[(c0 + e) * 72 + r] = f2bf(v[e] * btr * eg); kdT[(c0 + e) * 72 + r] = f2bf(v[e] * ed); }
            } else {
#pragma unroll
                for (int e = 0; e < 16; ++e) vbT[(c0 + e) * 72 + r] = f2bf(acc[e] * btr);
            }
        }
    }
    __syncthreads();
    {
        const int d = tid >> 2, sg = tid & 3;
        const u32x4 a = *(const u32x4*)(kdT + d * 72 + sg * 16), b = *(const u32x4*)(kdT + d * 72 + sg * 16 + 8);
        bf16_t* dst = (bf16_t*)(ws + O_GKD) + (size_t)item * 8192 + d * 64 + sg * 16; *(u32x4*)dst = a; *(u32x4*)(dst + 8) = b;
    }
    { float* Tmz = (float*)(lds + 117248); for (int e2 = tid; e2 < 64 * 68; e2 += 512) Tmz[e2] = 0.f; }
    {
        const int mi = wave >> 1;
        bf16_t* qko = (bf16_t*)(ws + O_GQK) + (size_t)item * 4096;
#pragma unroll
        for (int q = 0; q < 2; ++q) {
            const int nj = (wave & 1) * 2 + q;
            f32x4 kk = {0.f, 0.f, 0.f, 0.f}, qk = {0.f, 0.f, 0.f, 0.f};
            if (nj <= mi) {
#pragma unroll
                for (int s = 0; s < 4; ++s) {
                    const bf16x8 bk = *(const bf16x8*)(ks + (nj * 16 + fr) * 136 + s * 32 + fq * 8);
                    const bf16x8 ak = *(const bf16x8*)(ks + (mi * 16 + fr) * 136 + s * 32 + fq * 8);
                    const bf16x8 aq = *(const bf16x8*)(qs + (mi * 16 + fr) * 136 + s * 32 + fq * 8);
                    kk = MFMA16(ak, bk, kk); qk = MFMA16(aq, bk, qk);
                }
            }
            const int j = nj * 16 + fr; const float gj = gcs[j];
#pragma unroll
            for (int e = 0; e < 4; ++e) {
                const int i = mi * 16 + fq * 4 + e;
                const float dec = (j <= i) ? expf(gcs[i] - gj) : 0.f;
                Am[i * 68 + j] = (j < i) ? bts[i] * kk[e] * dec : 0.f;
                qko[i * 64 + j] = f2bf((j <= i) ? qk[e] * dec : 0.f);
            }
        }
    }
    __syncthreads();
    {
        float* Tm = (float*)(lds + 117248); float* Ps = (float*)(lds + 134656) + wave * 320;
        if (wave == 0) {
            const int bo = fq * 16; float t[16];
#pragma unroll
            for (int i = 0; i < 16; ++i) {
                float s = (i == fr) ? 1.f : 0.f;
#pragma unroll
                for (int j = 0; j < i; ++j) s -= Am[(bo + i) * 68 + bo + j] * t[j];
                t[i] = s; Tm[(bo + i) * 68 + bo + fr] = s;
            }
        }
        asm volatile("s_waitcnt lgkmcnt(0)" ::: "memory"); __syncthreads();
#pragma unroll
        for (int d = 1; d < 4; ++d) {
            if (wave < 4 - d) {
                const int bi = wave + d, bj = wave;
                f32x4 Q = {0.f, 0.f, 0.f, 0.f};
                for (int kb = bj; kb < bi; ++kb) {
                    const float* X = Am + (bi * 16) * 68 + kb * 16; const float* Y = Tm + (kb * 16) * 68 + bj * 16;
#pragma unroll
                    for (int s = 0; s < 4; ++s) Q = __builtin_amdgcn_mfma_f32_16x16x4f32(X[fr * 68 + 4 * s + fq], Y[(4 * s + fq) * 68 + fr], Q, 0, 0, 0);
                }
#pragma unroll
                for (int e2 = 0; e2 < 4; ++e2) Ps[(fq * 4 + e2) * 20 + fr] = Q[e2];
                asm volatile("s_waitcnt lgkmcnt(0)" ::: "memory");
                f32x4 R = {0.f, 0.f, 0.f, 0.f};
                const float* X = Tm + (bi * 16) * 68 + bi * 16;
#pragma unroll
                for (int s = 0; s < 4; ++s) R = __builtin_amdgcn_mfma_f32_16x16x4f32(X[fr * 68 + 4 * s + fq], Ps[(4 * s + fq) * 20 + fr], R, 0, 0, 0);
#pragma unroll
                for (int e2 = 0; e2 < 4; ++e2) Tm[(bi * 16 + fq * 4 + e2) * 68 + bj * 16 + fr] = -R[e2];
            }
            asm volatile("s_waitcnt lgkmcnt(0)" ::: "memory"); __syncthreads();
        }
        for (int e2 = tid; e2 < 4096; e2 += 512) { const int r = e2 >> 6, c = e2 & 63; Tb[r * 72 + c] = f2bf(Tm[r * 68 + c]); }
    }
    __syncthreads();
    {
        const int mi = wave & 3;
        const bf16x8 a0 = *(const bf16x8*)(Tb + (mi * 16 + fr) * 72 + fq * 8), a1 = *(const bf16x8*)(Tb + (mi * 16 + fr) * 72 + 32 + fq * 8);
        float* vo = (float*)(ws + O_GVAL) + (size_t)item * 8192; bf16_t* ko = (bf16_t*)(ws + O_GKC) + (size_t)item * 8192;
#pragma unroll
        for (int q = 0; q < 4; ++q) {
            const int nt = (wave >> 2) * 4 + q;
            f32x4 v = {0.f, 0.f, 0.f, 0.f}, kc = {0.f, 0.f, 0.f, 0.f};
            v = MFMA16(a0, *(const bf16x8*)(vbT + (nt * 16 + fr) * 72 + fq * 8), v); v = MFMA16(a1, *(const bf16x8*)(vbT + (nt * 16 + fr) * 72 + 32 + fq * 8), v);
            kc = MFMA16(a0, *(const bf16x8*)(kgT + (nt * 16 + fr) * 72 + fq * 8), kc); kc = MFMA16(a1, *(const bf16x8*)(kgT + (nt * 16 + fr) * 72 + 32 + fq * 8), kc);
#pragma unroll
            for (int e = 0; e < 4; ++e) { const int i = mi * 16 + fq * 4 + e, d = nt * 16 + fr; vo[i * 128 + d] = v[e]; ko[i * 128 + d] = f2bf(kc[e]); }
        }
    }
    if (tid == 0) ((float*)(ws + O_GEGL))[item] = expf(gcs[63]);
    __syncthreads();
}

struct GdnUO { bf16x8 kc[4], qg[4], qk[2]; float val[2][4]; };
struct GdnSU { bf16x8 kd[2][2]; float egl; };
__device__ __forceinline__ void gdn_load_uo(const unsigned char* ws, int item, int mt, int fr, int fq, int dvb, GdnUO& f) {
    const bf16_t* kc = (const bf16_t*)(ws + O_GKC) + (size_t)item * 8192 + (mt * 16 + fr) * 128 + fq * 8;
    const bf16_t* qg = (const bf16_t*)(ws + O_GQG) + (size_t)item * 8192 + (mt * 16 + fr) * 128 + fq * 8;
    const bf16_t* qk = (const bf16_t*)(ws + O_GQK) + (size_t)item * 4096 + (mt * 16 + fr) * 64 + fq * 8;
    const float* vl = (const float*)(ws + O_GVAL) + (size_t)item * 8192 + (mt * 16 + fq * 4) * 128 + dvb + fr;
#pragma unroll
    for (int s = 0; s < 4; ++s) { f.kc[s] = *(const bf16x8*)(kc + s * 32); f.qg[s] = *(const bf16x8*)(qg + s * 32); }
#pragma unroll
    for (int s = 0; s < 2; ++s) f.qk[s] = *(const bf16x8*)(qk + s * 32);
#pragma unroll
    for (int nt = 0; nt < 2; ++nt)
#pragma unroll
        for (int e = 0; e < 4; ++e) f.val[nt][e] = vl[e * 128 + nt * 16];
}
__device__ __forceinline__ void gdn_load_su(const unsigned char* ws, int item, int w4, int fr, int fq, GdnSU& f) {
    const bf16_t* kd = (const bf16_t*)(ws + O_GKD) + (size_t)item * 8192 + (2 * w4 * 16 + fr) * 64 + fq * 8;
#pragma unroll
    for (int s = 0; s < 2; ++s) { f.kd[0][s] = *(const bf16x8*)(kd + s * 32); f.kd[1][s] = *(const bf16x8*)(kd + 16 * 64 + s * 32); }
    f.egl = ((const float*)(ws + O_GEGL))[item];
}
#define GDN_BAR() do { asm volatile("s_waitcnt lgkmcnt(0)" ::: "memory"); __builtin_amdgcn_s_barrier(); asm volatile("" ::: "memory"); } while (0)
__device__ __forceinline__ void gdn_step_uo(const GdnUO& c, bf16_t* Sl, bf16_t* vn, float* go, int n, int h, int mt, int fr, int fq, int dvb) {
    bf16x8 Sb[2][4];
#pragma unroll
    for (int nt = 0; nt < 2; ++nt)
#pragma unroll
        for (int s = 0; s < 4; ++s) Sb[nt][s] = *(const bf16x8*)(Sl + nt * (16 * 136) + fr * 136 + s * 32 + fq * 8);
    f32x4 U[2], O[2];
#pragma unroll
    for (int nt = 0; nt < 2; ++nt) { U[nt] = (f32x4){0.f, 0.f, 0.f, 0.f}; O[nt] = (f32x4){0.f, 0.f, 0.f, 0.f};
#pragma unroll
        for (int s = 0; s < 4; ++s) U[nt] = MFMA16(c.kc[s], Sb[nt][s], U[nt]);
        u32x2 w; w.x = pk2(c.val[nt][0] - U[nt][0], c.val[nt][1] - U[nt][1]); w.y = pk2(c.val[nt][2] - U[nt][2], c.val[nt][3] - U[nt][3]);
        *(u32x2*)(vn + nt * (16 * 72) + fr * 72 + mt * 16 + fq * 4) = w; }
#pragma unroll
    for (int nt = 0; nt < 2; ++nt)
#pragma unroll
        for (int s = 0; s < 4; ++s) O[nt] = MFMA16(c.qg[s], Sb[nt][s], O[nt]);
    GDN_BAR();
#pragma unroll
    for (int nt = 0; nt < 2; ++nt) {
        const bf16x8 V0 = *(const bf16x8*)(vn + nt * (16 * 72) + fr * 72 + fq * 8), V1 = *(const bf16x8*)(vn + nt * (16 * 72) + fr * 72 + 32 + fq * 8);
        O[nt] = MFMA16(c.qk[0], V0, O[nt]); O[nt] = MFMA16(c.qk[1], V1, O[nt]);
#pragma unroll
        for (int e = 0; e < 4; ++e) go[(size_t)(n * 64 + mt * 16 + fq * 4 + e) * 1024 + h * 128 + dvb + nt * 16 + fr] = O[nt][e];
    }
    GDN_BAR();
}
__device__ __forceinline__ void gdn_step_su(const GdnSU& c, f32x4 (&St)[2][2], bf16_t* Sl, const bf16_t* vn, int w4, int fr, int fq) {
    GDN_BAR();
#pragma unroll
    for (int nt = 0; nt < 2; ++nt) {
        const bf16x8 V0 = *(const bf16x8*)(vn + nt * (16 * 72) + fr * 72 + fq * 8), V1 = *(const bf16x8*)(vn + nt * (16 * 72) + fr * 72 + 32 + fq * 8);
#pragma unroll
        for (int q = 0; q < 2; ++q) {
            St[nt][q] = St[nt][q] * c.egl;
            St[nt][q] = MFMA16(V0, c.kd[q][0], St[nt][q]); St[nt][q] = MFMA16(V1, c.kd[q][1], St[nt][q]);
#pragma unroll
            for (int e = 0; e < 4; ++e) Sl[nt * (16 * 136) + (fq * 4 + e) * 136 + (2 * w4 + q) * 16 + fr] = f2bf(St[nt][q][e]);
        }
    }
    GDN_BAR();
}
__device__ void gdn_recurrence(const Params& p, int b, unsigned char* lds) {
    const unsigned char* ws = p.ws;
    const int tid = tidx(), wave = tid >> 6, lane = tid & 63, fr = lane & 15, fq = lane >> 4;
    const int h = b >> 2, dvb = (b & 3) * 32;
    bf16_t* Sl = (bf16_t*)lds; bf16_t* vn = (bf16_t*)(lds + 2 * 16 * 136 * 2);
    float* go = (float*)(p.ws + O_PQKV);
    for (int e = tid; e < 2 * 16 * 136; e += 512) Sl[e] = 0;
    __syncthreads();
    if (wave < 4) {
        const int mt = wave;
        GdnUO f0, f1, f2;
        gdn_load_uo(ws, h, mt, fr, fq, dvb, f0); gdn_load_uo(ws, 8 + h, mt, fr, fq, dvb, f1);
        for (int n = 0; n < 255; n += 3) {
            gdn_load_uo(ws, (n + 2) * 8 + h, mt, fr, fq, dvb, f2); gdn_step_uo(f0, Sl, vn, go, n, h, mt, fr, fq, dvb);
            gdn_load_uo(ws, (n + 3) * 8 + h, mt, fr, fq, dvb, f0); gdn_step_uo(f1, Sl, vn, go, n + 1, h, mt, fr, fq, dvb);
            if (n + 4 < 256) gdn_load_uo(ws, (n + 4) * 8 + h, mt, fr, fq, dvb, f1);
            gdn_step_uo(f2, Sl, vn, go, n + 2, h, mt, fr, fq, dvb);
        }
        gdn_step_uo(f0, Sl, vn, go, 255, h, mt, fr, fq, dvb);
    } else {
        const int w4 = wave - 4;
        f32x4 St[2][2];
#pragma unroll
        for (int a = 0; a < 2; ++a)
#pragma unroll
            for (int c = 0; c < 2; ++c) St[a][c] = (f32x4){0.f, 0.f, 0.f, 0.f};
        GdnSU f0, f1, f2;
        gdn_load_su(ws, h, w4, fr, fq, f0); gdn_load_su(ws, 8 + h, w4, fr, fq, f1);
        for (int n = 0; n < 255; n += 3) {
            gdn_load_su(ws, (n + 2) * 8 + h, w4, fr, fq, f2); gdn_step_su(f0, St, Sl, vn, w4, fr, fq);
            gdn_load_su(ws, (n + 3) * 8 + h, w4, fr, fq, f0); gdn_step_su(f1, St, Sl, vn, w4, fr, fq);
            if (n + 4 < 256) gdn_load_su(ws, (n + 4) * 8 + h, w4, fr, fq, f1);
            gdn_step_su(f2, St, Sl, vn, w4, fr, fq);
        }
        gdn_step_su(f0, St, Sl, vn, w4, fr, fq);
    }
}
struct KVF { bf16x8 k[4][2]; };
__device__ __forceinline__ void kv_load(const bf16_t* kp, int ldk, KVF& f) {
#pragma unroll
    for (int s = 0; s < 4; ++s) { f.k[s][0] = *(const bf16x8*)(kp + (size_t)(s * 16) * ldk); f.k[s][1] = *(const bf16x8*)(kp + (size_t)(s * 16) * ldk + 32); }
}
template <int CTRL> __device__ __forceinline__ float dppf(float v) { return __int_as_float(__builtin_amdgcn_update_dpp(0, __float_as_int(v), CTRL, 0xF, 0xF, true)); }
template <int CTRL> __device__ __forceinline__ unsigned dppu(unsigned v) { return (unsigned)__builtin_amdgcn_update_dpp(0, (int)v, CTRL, 0xF, 0xF, true); }
__device__ __forceinline__ float rmax16(float v) { v = vmaxf(v, dppf<0xB1>(v)); v = vmaxf(v, dppf<0x4E>(v)); v = vmaxf(v, dppf<0x124>(v)); v = vmaxf(v, dppf<0x128>(v)); return v; }
__device__ __forceinline__ float rsum16(float v) { v += dppf<0xB1>(v); v += dppf<0x4E>(v); v += dppf<0x124>(v); v += dppf<0x128>(v); return v; }
template <int CTRL> __device__ __forceinline__ unsigned long long dppmax64(unsigned long long b) { const unsigned lo = dppu<CTRL>((unsigned)b), hi = dppu<CTRL>((unsigned)(b >> 32)); const unsigned long long ob = ((unsigned long long)hi << 32) | lo; return ob > b ? ob : b; }
#define MFMA8(a, b, c) __builtin_amdgcn_mfma_f32_16x16x32_fp8_fp8((a), (b), (c), 0, 0, 0)
__device__ __forceinline__ long mk64(unsigned lo, unsigned hi) { return (long)(((unsigned long long)hi << 32) | lo); }
__device__ __forceinline__ long bf8_to_fp8(bf16x8 v) {
    const u32x4 w = __builtin_bit_cast(u32x4, v);
    int a = __builtin_amdgcn_cvt_pk_fp8_f32(bflo(w.x), bfhi(w.x), 0, false); a = __builtin_amdgcn_cvt_pk_fp8_f32(bflo(w.y), bfhi(w.y), a, true);
    int b = __builtin_amdgcn_cvt_pk_fp8_f32(bflo(w.z), bfhi(w.z), 0, false); b = __builtin_amdgcn_cvt_pk_fp8_f32(bflo(w.w), bfhi(w.w), b, true);
    return mk64((unsigned)a, (unsigned)b);
}
struct K8F { u32x4 k[4]; };
__device__ __forceinline__ void k8_load(const unsigned char* kp, K8F& f) {
#pragma unroll
    for (int s = 0; s < 4; ++s) f.k[s] = *(const u32x4*)(kp + s * 1024);
}
__device__ __forceinline__ void softmax_pv(const f32x4 (&S)[4], const u32x4 (&Vw)[4], unsigned vmask, float (&m)[4], float (&l)[4], f32x4 (&O)[4], unsigned char* Pt, int fr, int fq) {
    float mx[4];
#pragma unroll
    for (int j = 0; j < 4; ++j) { float v = -1e30f;
#pragma unroll
        for (int s = 0; s < 4; ++s) v = ((vmask >> s) & 1u) ? vmaxf(v, S[s][j]) : v;
        mx[j] = rmax16(v); }
#pragma unroll
    for (int j = 0; j < 4; ++j) { const float mn = vmaxf(m[j], mx[j]); const float a = __builtin_amdgcn_exp2f(m[j] - mn); m[j] = mn; l[j] *= a;
#pragma unroll
        for (int dt = 0; dt < 4; ++dt) O[dt][j] *= a; }
#pragma unroll
    for (int j = 0; j < 4; ++j) { float pv[4];
#pragma unroll
        for (int s = 0; s < 4; ++s) { pv[s] = ((vmask >> s) & 1u) ? __builtin_amdgcn_exp2f(S[s][j] - m[j]) : 0.f; l[j] += pv[s]; }
        int t = __builtin_amdgcn_cvt_pk_fp8_f32(pv[0] * 256.f, pv[1] * 256.f, 0, false); t = __builtin_amdgcn_cvt_pk_fp8_f32(pv[2] * 256.f, pv[3] * 256.f, t, true);
        *(unsigned*)(Pt + (fq * 4 + j) * 72 + fr * 4) = (unsigned)t; }
    asm volatile("s_waitcnt lgkmcnt(0)" ::: "memory");
    const u32x2 p0 = *(const u32x2*)(Pt + fr * 72 + fq * 8), p1 = *(const u32x2*)(Pt + fr * 72 + 32 + fq * 8);
    asm volatile("s_waitcnt lgkmcnt(0)" ::: "memory");
    const long P0 = mk64(p0.x, p0.y), P1 = mk64(p1.x, p1.y);
#pragma unroll
    for (int dt = 0; dt < 4; ++dt) { O[dt] = MFMA8(P0, mk64(Vw[dt].x, Vw[dt].y), O[dt]); O[dt] = MFMA8(P1, mk64(Vw[dt].z, Vw[dt].w), O[dt]); }
}
__device__ __forceinline__ void flash_compute(const bf16x8 (&Qf)[2], KVF& f, const bf16_t* knext, int ldk, const unsigned char* vp, unsigned vmask, float (&m)[4], float (&l)[4], f32x4 (&O)[4], unsigned char* Pt, int fr, int fq) {
    f32x4 S[4]; u32x4 Vw[4];
#pragma unroll
    for (int dt = 0; dt < 4; ++dt) Vw[dt] = *(const u32x4*)(vp + dt * 1024);
#pragma unroll
    for (int s = 0; s < 4; ++s) { S[s] = (f32x4){0.f, 0.f, 0.f, 0.f}; S[s] = MFMA16(Qf[0], f.k[s][0], S[s]); S[s] = MFMA16(Qf[1], f.k[s][1], S[s]); }
    if (knext) kv_load(knext, ldk, f);
    softmax_pv(S, Vw, vmask, m, l, O, Pt, fr, fq);
}
__device__ __forceinline__ void flash_compute8(const long (&Q8)[2], K8F& f, const unsigned char* knext, const unsigned char* vp, unsigned vmask, float (&m)[4], float (&l)[4], f32x4 (&O)[4], unsigned char* Pt, int fr, int fq) {
    f32x4 S[4]; u32x4 Vw[4];
#pragma unroll
    for (int dt = 0; dt < 4; ++dt) Vw[dt] = *(const u32x4*)(vp + dt * 1024);
#pragma unroll
    for (int s = 0; s < 4; ++s) { S[s] = (f32x4){0.f, 0.f, 0.f, 0.f}; S[s] = MFMA8(Q8[0], mk64(f.k[s].x, f.k[s].y), S[s]); S[s] = MFMA8(Q8[1], mk64(f.k[s].z, f.k[s].w), S[s]); }
    if (knext) k8_load(knext, f);
    softmax_pv(S, Vw, vmask, m, l, O, Pt, fr, fq);
}
template <int BR> struct BranchIt {
    const bf16_t* kb; const unsigned char* kb8; const unsigned char* vb; const unsigned* flg; int last, trow, fr, fq;
    static constexpr int LDK = 64;
    __device__ __forceinline__ int next(int from) const {
        if (BR == 1) { int jb = from; while (jb <= last && flg[jb] == 0u) ++jb; return jb <= last ? jb : -1; }
        return from <= last ? from : -1;
    }
    __device__ __forceinline__ const unsigned char* vptr(int idx) const { return vb + (size_t)idx * 4096; }
    __device__ __forceinline__ const bf16_t* kptr(int idx) const { return kb + (size_t)(idx * 64) * LDK; }
    __device__ __forceinline__ const unsigned char* kptr8(int idx) const { return kb8 + (size_t)idx * 4096; }
    __device__ __forceinline__ unsigned mask(int idx) const {
        unsigned vm = 0; const int key0 = idx * 64;
        if (BR == 0) {
#pragma unroll
            for (int s = 0; s < 4; ++s) vm |= ((16 * (key0 + s * 16 + fr) + 31 <= trow) ? 1u : 0u) << s;
        } else if (BR == 1) {
            const bool rowsel = (flg[idx] >> fq) & 1u;
#pragma unroll
            for (int s = 0; s < 4; ++s) vm |= ((rowsel && (key0 + s * 16 + fr <= trow)) ? 1u : 0u) << s;
        } else {
#pragma unroll
            for (int s = 0; s < 4; ++s) { const int kpos = key0 + s * 16 + fr; vm |= ((kpos <= trow && kpos > trow - 512) ? 1u : 0u) << s; }
        }
        return vm;
    }
};
template <int BR> __device__ __forceinline__ void run_branch(const BranchIt<BR>& it, int first, const bf16x8 (&Qf)[2], const long (&Q8)[2], float (&m)[4], float (&l)[4], f32x4 (&O)[4], unsigned char* Pt) {
#pragma unroll
    for (int j = 0; j < 4; ++j) { m[j] = -1e30f; l[j] = 0.f; O[j] = (f32x4){0.f, 0.f, 0.f, 0.f}; }
    int ia = it.next(first);
    if (ia < 0) return;
    if (BR == 0) {
        KVF A; kv_load(it.kptr(ia), BranchIt<BR>::LDK, A);
        while (ia >= 0) {
            const int ib = it.next(ia + 1);
            flash_compute(Qf, A, ib >= 0 ? it.kptr(ib) : nullptr, BranchIt<BR>::LDK, it.vptr(ia), it.mask(ia), m, l, O, Pt, it.fr, it.fq);
            ia = ib;
        }
    } else {
        K8F A; k8_load(it.kptr8(ia), A);
        while (ia >= 0) {
            const int ib = it.next(ia + 1);
            flash_compute8(Q8, A, ib >= 0 ? it.kptr8(ib) : nullptr, it.vptr(ia), it.mask(ia), m, l, O, Pt, it.fr, it.fq);
            ia = ib;
        }
    }
}
__device__ __forceinline__ void branch_finish(float (&l)[4], f32x4 (&O)[4], const float* grow, int br, int hk, float* ybp  ) {
#pragma unroll
    for (int j = 0; j < 4; ++j) { const float s = rsum16(l[j]);
        const float g = sigmoidf_(grow[(hk * 4 + j) * 3 + br]) * 0.00390625f / fmaxf(s, 1e-30f);
#pragma unroll
        for (int dt = 0; dt < 4; ++dt) { float* q = ybp + j * 64 + dt * 16; if (br == 0) *q = g * O[dt][j]; else *q += g * O[dt][j]; } }
}
constexpr int NSA_WLDS = 15680;
__device__ void nsa_wave_task(const Params& p, int layer, int t0, unsigned char* wl) {
    unsigned char* ws = p.ws;
    const int lane = tidx() & 63, fr = lane & 15, fq = lane >> 4;
    float* imp = (float*)wl; unsigned* flg = (unsigned*)(wl + 4160); unsigned char* Pt = wl + 5184; float* yb = (float*)(wl + 7488);
    const bf16_t* qn = (const bf16_t*)(ws + O_QN); const unsigned char* ks8 = ws + O_KSN; const unsigned char* kw8 = ws + O_KWN;
    const unsigned char* vsT = ws + O_VST; const unsigned char* vwT = ws + O_VWT; const bf16_t* kc = (const bf16_t*)(ws + O_KC); const unsigned char* vcT = ws + O_VCT;
    const int trow = t0 + fq;
    const float* grow = (const float*)(ws + O_P32) + (size_t)trow * 1536 + 1280;
    const int tmax = t0 + 3;
    for (int hk = 0; hk < 2; ++hk) {
        bf16x8 Qf[2];
        { const bf16_t* qp = qn + (size_t)(t0 + (fr >> 2)) * 512 + (hk * 4 + (fr & 3)) * 64 + fq * 8; Qf[0] = *(const bf16x8*)qp; Qf[1] = *(const bf16x8*)(qp + 32); }
        long Q8[2]; Q8[0] = bf8_to_fp8(Qf[0]); Q8[1] = bf8_to_fp8(Qf[1]);
        float* ybp = yb + fq * 512 + hk * 256 + fr;
        float m[4], l[4]; f32x4 O[4];
        const int ncmp_t = tmax >= 31 ? ((((tmax - 31) >> 4) >> 6) + 1) : 0;
        const bf16_t* kcb = kc + ((size_t)hk * 1024 + fr) * 64 + fq * 8;
        { BranchIt<0> it{kcb, nullptr, vcT + (size_t)hk * 16 * 4096 + fr * 64 + fq * 16, nullptr, ncmp_t - 1, trow, fr, fq}; run_branch<0>(it, 0, Qf, Q8, m, l, O, Pt); }
        float linv[4];
#pragma unroll
        for (int j = 0; j < 4; ++j) { const float s = rsum16(l[j]); linv[j] = s > 0.f ? 1.0f / s : 0.f; }
        branch_finish(l, O, grow, 0, hk, ybp);
        for (int e = lane; e < 4 * 260; e += 64) imp[e] = 0.f;
        for (int e = lane; e < 256; e += 64) flg[e] = 0u;
        asm volatile("s_waitcnt lgkmcnt(0)" ::: "memory");
        {
            KVF ka;
            if (ncmp_t > 0) kv_load(kcb, 64, ka);
            for (int kt = 0; kt < ncmp_t; ++kt) {
                const int key0 = kt * 64;
                f32x4 S[4];
#pragma unroll
                for (int s = 0; s < 4; ++s) { S[s] = (f32x4){0.f, 0.f, 0.f, 0.f}; S[s] = MFMA16(Qf[0], ka.k[s][0], S[s]); S[s] = MFMA16(Qf[1], ka.k[s][1], S[s]); }
                if (kt + 1 < ncmp_t) kv_load(kcb + (size_t)(key0 + 64) * 64, 64, ka);
#pragma unroll
                for (int s = 0; s < 4; ++s) {
                    const int nn = key0 + s * 16 + fr; const bool valid = 16 * nn + 31 <= trow;
                    float ps = 0.f;
#pragma unroll
                    for (int j = 0; j < 4; ++j) ps += valid ? __builtin_amdgcn_exp2f(S[s][j] - m[j]) * linv[j] : 0.f;
                    float p4 = ps; p4 += dppf<0xB1>(p4); p4 += dppf<0x4E>(p4);
                    if ((fr & 3) == 0) imp[fq * 260 + (nn >> 2)] += p4;
                    asm volatile("s_waitcnt lgkmcnt(0)" ::: "memory");
                    if ((fr & 3) == 3) imp[fq * 260 + (nn >> 2) + 1] += ps;
                    asm volatile("s_waitcnt lgkmcnt(0)" ::: "memory");
                }
            }
        }
#ifdef OLD_TOPK
        for (int tok = 0; tok < 4; ++tok) {
            const int t = t0 + tok, cur = t >> 6, nsel = cur + 1 < 16 ? cur + 1 : 16;
            unsigned long long key[4];
#pragma unroll
            for (int i = 0; i < 4; ++i) { const int j = lane + 64 * i; unsigned long long k = 0ull;
                if (j <= cur) { const bool forced = (j == 0) || (j == cur) || (j == cur - 1); const unsigned vb = forced ? 0x7F800000u : __float_as_uint(imp[tok * 260 + j]); k = ((unsigned long long)vb << 32) | (unsigned)(0xFFFF - j); }
                key[i] = k; }
            for (int it2 = 0; it2 < nsel; ++it2) {
                unsigned long long best = key[0]; best = key[1] > best ? key[1] : best; best = key[2] > best ? key[2] : best; best = key[3] > best ? key[3] : best;
#pragma unroll
                for (int o = 32; o >= 1; o >>= 1) { const unsigned lo = __shfl_xor((unsigned)best, o), hi = __shfl_xor((unsigned)(best >> 32), o); const unsigned long long ob = ((unsigned long long)hi << 32) | lo; best = ob > best ? ob : best; }
                const int jsel = 0xFFFF - (int)(best & 0xFFFFu);
#pragma unroll
                for (int i = 0; i < 4; ++i) if (key[i] == best) key[i] = 0ull;
                if (lane == 0) flg[jsel] |= (1u << tok);
            }
        }
#else
        {
            unsigned long long key[4][4];
#pragma unroll
            for (int tok = 0; tok < 4; ++tok) { const int cur = (t0 + tok) >> 6;
#pragma unroll
                for (int i = 0; i < 4; ++i) { const int j = lane + 64 * i; unsigned long long k = 0ull;
                    if (j <= cur) { const bool forced = (j == 0) || (j == cur) || (j == cur - 1); const unsigned vb = forced ? 0x7F800000u : __float_as_uint(imp[tok * 260 + j]); k = ((unsigned long long)vb << 32) | (unsigned)(0xFFFF - j); }
                    key[tok][i] = k; } }
            for (int itn = 0; itn < 16; ++itn) {
                unsigned long long best[4];
#pragma unroll
                for (int tok = 0; tok < 4; ++tok) { unsigned long long b0 = key[tok][0]; b0 = key[tok][1] > b0 ? key[tok][1] : b0; b0 = key[tok][2] > b0 ? key[tok][2] : b0; b0 = key[tok][3] > b0 ? key[tok][3] : b0; best[tok] = b0; }
#pragma unroll
                for (int tok = 0; tok < 4; ++tok) { best[tok] = dppmax64<0xB1>(best[tok]); best[tok] = dppmax64<0x4E>(best[tok]); best[tok] = dppmax64<0x124>(best[tok]); best[tok] = dppmax64<0x128>(best[tok]); }
#pragma unroll
                for (int o = 16; o <= 32; o <<= 1) {
#pragma unroll
                    for (int tok = 0; tok < 4; ++tok) { const unsigned lo = __shfl_xor((unsigned)best[tok], o), hi = __shfl_xor((unsigned)(best[tok] >> 32), o); const unsigned long long ob = ((unsigned long long)hi << 32) | lo; best[tok] = ob > best[tok] ? ob : best[tok]; }
                }
#pragma unroll
                for (int tok = 0; tok < 4; ++tok) {
                    if (best[tok] != 0ull) {
#pragma unroll
                        for (int i = 0; i < 4; ++i) if (key[tok][i] == best[tok]) key[tok][i] = 0ull;
                        if (lane == 0) flg[0xFFFF - (int)(best[tok] & 0xFFFFu)] |= (1u << tok);
                    }
                }
            }
        }
#endif
        asm volatile("s_waitcnt lgkmcnt(0)" ::: "memory");
        { BranchIt<1> it{nullptr, ks8 + (size_t)hk * 256 * 4096 + fr * 64 + fq * 16, vsT + (size_t)hk * 256 * 4096 + fr * 64 + fq * 16, flg, tmax >> 6, trow, fr, fq}; run_branch<1>(it, 0, Qf, Q8, m, l, O, Pt); }
        branch_finish(l, O, grow, 1, hk, ybp);
        { BranchIt<2> it{nullptr, kw8 + (size_t)hk * 256 * 4096 + fr * 64 + fq * 16, vwT + (size_t)hk * 256 * 4096 + fr * 64 + fq * 16, nullptr, tmax >> 6, trow, fr, fq}; run_branch<2>(it, t0 - 511 > 0 ? ((t0 - 511) >> 6) : 0, Qf, Q8, m, l, O, Pt); }
        branch_finish(l, O, grow, 2, hk, ybp);
    }
    asm volatile("s_waitcnt lgkmcnt(0)" ::: "memory");
    bf16_t* mix = (bf16_t*)(ws + O_HN);
    const float* gn = p.in[12] + (size_t)layer * 512;
    for (int tok = 0; tok < 4; ++tok) {
        const f32x4 a = *(const f32x4*)(yb + tok * 512 + lane * 8), b = *(const f32x4*)(yb + tok * 512 + lane * 8 + 4);
        float ss = a[0] * a[0] + a[1] * a[1] + a[2] * a[2] + a[3] * a[3] + b[0] * b[0] + b[1] * b[1] + b[2] * b[2] + b[3] * b[3];
        ss = wave_sum(ss);
        const float rs = rsqrtf(ss * (1.0f / 512.0f) + 1e-6f);
        const f32x4 g0 = *(const f32x4*)(gn + lane * 8), g1 = *(const f32x4*)(gn + lane * 8 + 4);
        u32x4 w; w.x = pk2(a[0] * rs * g0[0], a[1] * rs * g0[1]); w.y = pk2(a[2] * rs * g0[2], a[3] * rs * g0[3]); w.z = pk2(b[0] * rs * g1[0], b[1] * rs * g1[1]); w.w = pk2(b[2] * rs * g1[2], b[3] * rs * g1[3]);
        *(u32x4*)(mix + (size_t)(t0 + tok) * DM + lane * 8) = w;
    }
    asm volatile("s_waitcnt lgkmcnt(0)" ::: "memory");
}

__device__ void phase_finalize(const Params& p, int layer) {
    unsigned char* ws = p.ws;
    const int wave = tidx() >> 6, lane = tidx() & 63;
    const float* yglu = (const float*)(ws + O_YGLU); const float* go = (const float*)(ws + O_PQKV); const bf16_t* Pz = (const bf16_t*)(ws + O_PZ); bf16_t* mix = (bf16_t*)(ws + O_HN);
    const float* gs = p.in[22] + (size_t)layer * 512 + lane * 8; const float* gg = p.in[26] + (size_t)layer * 128 + (lane & 7) * 16;
    for (int t = blockIdx.x * 8 + wave; t < T_; t += gridDim.x * 8) {
        {
            const f32x4 a = *(const f32x4*)(yglu + (size_t)t * 512 + lane * 8), b = *(const f32x4*)(yglu + (size_t)t * 512 + lane * 8 + 4);
            float ss = a[0] * a[0] + a[1] * a[1] + a[2] * a[2] + a[3] * a[3] + b[0] * b[0] + b[1] * b[1] + b[2] * b[2] + b[3] * b[3];
            ss = wave_sum(ss); const float rs = rsqrtf(ss * (1.0f / 512.0f) + 1e-6f);
            const f32x4 g0 = *(const f32x4*)gs, g1 = *(const f32x4*)(gs + 4);
            u32x4 w; w.x = pk2(a[0] * rs * g0[0], a[1] * rs * g0[1]); w.y = pk2(a[2] * rs * g0[2], a[3] * rs * g0[3]); w.z = pk2(b[0] * rs * g1[0], b[1] * rs * g1[1]); w.w = pk2(b[2] * rs * g1[2], b[3] * rs * g1[3]);
            *(u32x4*)(mix + (size_t)t * DM + 512 + lane * 8) = w;
        }
        {
            f32x4 o[4]; float ss = 0.f;
#pragma unroll
            for (int q = 0; q < 4; ++q) { o[q] = *(const f32x4*)(go + (size_t)t * 1024 + lane * 16 + q * 4); ss += o[q][0] * o[q][0] + o[q][1] * o[q][1] + o[q][2] * o[q][2] + o[q][3] * o[q][3]; }
            ss += __shfl_xor(ss, 1); ss += __shfl_xor(ss, 2); ss += __shfl_xor(ss, 4);
            const float rs = rsqrtf(ss * (1.0f / 128.0f) + 1e-6f);
            const u32x4 z0 = *(const u32x4*)(Pz + (size_t)t * 1024 + lane * 16), z1 = *(const u32x4*)(Pz + (size_t)t * 1024 + lane * 16 + 8);
            float zz[16] = {bflo(z0.x), bfhi(z0.x), bflo(z0.y), bfhi(z0.y), bflo(z0.z), bfhi(z0.z), bflo(z0.w), bfhi(z0.w), bflo(z1.x), bfhi(z1.x), bflo(z1.y), bfhi(z1.y), bflo(z1.z), bfhi(z1.z), bflo(z1.w), bfhi(z1.w)};
            float r[16];
#pragma unroll
            for (int q = 0; q < 4; ++q) { const f32x4 g = *(const f32x4*)(gg + q * 4);
#pragma unroll
                for (int e = 0; e < 4; ++e) r[q * 4 + e] = o[q][e] * rs * g[e] * siluf_(zz[q * 4 + e]); }
            u32x4 w0, w1; w0.x = pk2(r[0], r[1]); w0.y = pk2(r[2], r[3]); w0.z = pk2(r[4], r[5]); w0.w = pk2(r[6], r[7]); w1.x = pk2(r[8], r[9]); w1.y = pk2(r[10], r[11]); w1.z = pk2(r[12], r[13]); w1.w = pk2(r[14], r[15]);
            *(u32x4*)(mix + (size_t)t * DM + 1024 + lane * 16) = w0; *(u32x4*)(mix + (size_t)t * DM + 1024 + lane * 16 + 8) = w1;
        }
    }
}

__device__ void phase_ffn_act(const Params& p, int layer) {
    unsigned char* ws = p.ws;
    const bf16_t* hf = (const bf16_t*)(ws + O_HF); bf16_t* act = (bf16_t*)(ws + O_ACT);
    const float* cw = p.in[30] + (size_t)layer * 3 * NFF; const float* cb = p.in[31] + (size_t)layer * NFF;
    const int nitems = 512 * 688;
    for (int it = blockIdx.x * 512 + tidx(); it < nitems; it += gridDim.x * 512) {
        const int seg = it / 688, cg8 = it - seg * 688, c = cg8 * 8, t0 = seg * 32;
        float w[2][3][8], bb[2][8];
#pragma unroll
        for (int hh = 0; hh < 2; ++hh) {
#pragma unroll
            for (int j = 0; j < 3; ++j) { const f32x4 a = *(const f32x4*)(cw + j * NFF + hh * DFF + c), b = *(const f32x4*)(cw + j * NFF + hh * DFF + c + 4);
                w[hh][j][0] = a[0]; w[hh][j][1] = a[1]; w[hh][j][2] = a[2]; w[hh][j][3] = a[3]; w[hh][j][4] = b[0]; w[hh][j][5] = b[1]; w[hh][j][6] = b[2]; w[hh][j][7] = b[3]; }
            const f32x4 a = *(const f32x4*)(cb + hh * DFF + c), b = *(const f32x4*)(cb + hh * DFF + c + 4);
            bb[hh][0] = a[0]; bb[hh][1] = a[1]; bb[hh][2] = a[2]; bb[hh][3] = a[3]; bb[hh][4] = b[0]; bb[hh][5] = b[1]; bb[hh][6] = b[2]; bb[hh][7] = b[3];
        }
        u32x4 r0[2], r1[2];
#pragma unroll
        for (int hh = 0; hh < 2; ++hh) {
            r0[hh] = (t0 >= 2) ? *(const u32x4*)(hf + (size_t)(t0 - 2) * NFF + hh * DFF + c) : (u32x4){0u, 0u, 0u, 0u};
            r1[hh] = (t0 >= 1) ? *(const u32x4*)(hf + (size_t)(t0 - 1) * NFF + hh * DFF + c) : (u32x4){0u, 0u, 0u, 0u};
        }
        for (int tt = 0; tt < 32; ++tt) {
            const int t = t0 + tt;
            u32x4 r2[2]; float v[2][8];
#pragma unroll
            for (int hh = 0; hh < 2; ++hh) {
                r2[hh] = *(const u32x4*)(hf + (size_t)t * NFF + hh * DFF + c);
                const unsigned a0[4] = {r0[hh].x, r0[hh].y, r0[hh].z, r0[hh].w}, a1[4] = {r1[hh].x, r1[hh].y, r1[hh].z, r1[hh].w}, a2[4] = {r2[hh].x, r2[hh].y, r2[hh].z, r2[hh].w};
#pragma unroll
                for (int e = 0; e < 4; ++e) {
                    v[hh][2 * e]     = bb[hh][2 * e]     + w[hh][0][2 * e]     * bflo(a0[e]) + w[hh][1][2 * e]     * bflo(a1[e]) + w[hh][2][2 * e]     * bflo(a2[e]);
                    v[hh][2 * e + 1] = bb[hh][2 * e + 1] + w[hh][0][2 * e + 1] * bfhi(a0[e]) + w[hh][1][2 * e + 1] * bfhi(a1[e]) + w[hh][2][2 * e + 1] * bfhi(a2[e]);
                }
                r0[hh] = r1[hh]; r1[hh] = r2[hh];
            }
            u32x4 o; o.x = pk2(siluf_(v[0][0]) * v[1][0], siluf_(v[0][1]) * v[1][1]); o.y = pk2(siluf_(v[0][2]) * v[1][2], siluf_(v[0][3]) * v[1][3]);
            o.z = pk2(siluf_(v[0][4]) * v[1][4], siluf_(v[0][5]) * v[1][5]); o.w = pk2(siluf_(v[0][6]) * v[1][6], siluf_(v[0][7]) * v[1][7]);
            *(u32x4*)(act + (size_t)t * DFF + c) = o;
        }
    }
}
#ifdef REPEAT_PHASE
constexpr int NPHT = NPH + 1;
#else
constexpr int NPHT = NPH;
#endif
#ifndef MULTI_LAUNCH
#define MULTI_LAUNCH 0
#endif
__global__ void __launch_bounds__(512) mega(Params p) {
    extern __shared__ __attribute__((aligned(16))) unsigned char smem[];
    cg::grid_group grid = cg::this_grid();
    const int b = blockIdx.x, G = gridDim.x;
    PG8_LAS unsigned char* glds = (PG8_LAS unsigned char*)smem;
    volatile XB_LAS unsigned* xst = (volatile XB_LAS unsigned*)(smem + LDS_BYTES - 32);
    if (threadIdx.x == 0) { xst[0] = 0u; xst[1] = 0u; }
    __syncthreads();
    XcdBarrier xbar; xbar.bar = (unsigned*)(p.ws + O_BAR); xbar.x = 0; xbar.st = xst;
    for (int ph = p.ph_lo; ph < p.ph_hi; ++ph) {

        #ifdef REPEAT_PHASE
        const int layer = ph / (NPH + 1), ki = ph % (NPH + 1), rep = (ki == REPEAT_PHASE + 1) ? 1 : 0; int k = ki <= REPEAT_PHASE ? ki : ki - 1;
#else
        const int layer = ph / NPH, rep = 0; int k = ph % NPH;
#endif
#ifdef DBG_ONLY
        if (k != DBG_ONLY) k = 99;
#endif
        typedef unsigned char __attribute__((address_space(1))) gu8_t;
        gu8_t* wsg = (gu8_t*)p.ws; asm volatile("" : "+s"(wsg));
        unsigned char* ws = (unsigned char*)wsg;
        int tid = threadIdx.x; asm volatile("" : "+v"(tid));
        const int wave = tid >> 6;
        bf16_t* hn = (bf16_t*)(ws + O_HN);
        Params q = p; q.ws = ws;
        if (k == 0) {
            if (ph == 0 && rep == 0 && b == 0) { if (tid < 64) ((unsigned*)(ws + O_CTR))[tid * 16] = 0u; for (int i = tid; i < XCD_BAR_WORDS; i += 512) ((unsigned*)(ws + O_BAR))[i] = 0u; }
            phase_convert(q, layer, (float*)smem);
            phase_rmsnorm(layer == 0 ? p.in[0] : p.out, p.in[1] + (size_t)layer * DM, hn, layer == 0 ? p.out : nullptr);
        } else if (k == 1) {
            pg8::Gemm g{hn, (const bf16_t*)(ws + O_WIN), T_, NIN, DM}; pg8::StaticOrder S; S.init(T_, NIN, G, b);
            EpiProj E{(float*)(ws + O_P32), (bf16_t*)(ws + O_PU), (bf16_t*)(ws + O_PQKV), (bf16_t*)(ws + O_PZ)};
            pg8::gemm_phase<EpiProj, pg8::StaticOrder, false>(glds, g, S, E, nullptr);
        } else if (k == 2) {
            for (int it = b; it < 3072; it += G) {
                if (it < 2048) gdn_prep_item(q, layer, it, smem);
                else if (it < 2304) nsa_prep_item(q, layer, it - 2048, (float*)smem);
                else if (it < 2560) s5_passA_wave(q, layer, (it - 2304) * 8 + wave);
                else cmp1_wave_tile(q, layer, (it - 2560) * 8 + wave);
            }
        } else if (k == 3) {
            for (int idx = b * 8 + wave; idx < 4096; idx += G * 8) cmp2_wave_row(q, layer, idx);
            for (int it = b * 8 + wave; it < 2048; it += G * 8) s5_passB_wave(q, layer, it, (bf16_t*)(smem + wave * 4352));
        } else if (k == 4) {
#ifdef REP4_MODE
            const bool do_rec = (rep == 0) || (REP4_MODE == 1), do_glu = (rep == 0), do_nsa = (rep == 0) || (REP4_MODE == 2);
#else
            const bool do_rec = true, do_glu = true, do_nsa = true;
#endif
            if (b < 32) {
#ifndef NO_REC
 if (do_rec) gdn_recurrence(q, b, smem);
#endif
 }
            else if (b < 160 && do_glu) {
#ifndef NO_GLU
                pg8::Gemm g{(const bf16_t*)(ws + O_YGELU), (const bf16_t*)(ws + O_WGLU), T_, 512, 512}; pg8::StaticOrder S; S.init(T_, 512, 128, b - 32);
                EpiGlu E{(const bf16_t*)(ws + O_YGELU), (float*)(ws + O_YGLU)};
                pg8::gemm_phase<EpiGlu, pg8::StaticOrder, false>(glds, g, S, E, nullptr);
#endif
            }
            __syncthreads();
            unsigned* ctr = (unsigned*)(ws + O_CTR) + (layer * 2 + rep) * 16;
            volatile int* sidx = (volatile int*)(smem + LDS_BYTES - 16);
#ifndef NO_NSA
            if (do_nsa) for (;;) {
                if (tid == 0) *sidx = (int)atomicAdd(ctr, 1u);
                __syncthreads();
                const int idx = *sidx;
                __syncthreads();
                if (idx >= 512) break;
                nsa_wave_task(q, layer, (511 - idx) * 32 + wave * 4, smem + wave * NSA_WLDS);
            }
#endif
        } else if (k == 5) {
            phase_finalize(q, layer);
        } else if (k == 6) {
            pg8::Gemm g{hn, (const bf16_t*)(ws + O_WOUT), T_, DM, DM}; pg8::StaticOrder S; S.init(T_, DM, G, b);
            EpiResid E{p.out, DM};
            pg8::gemm_phase<EpiResid, pg8::StaticOrder, false>(glds, g, S, E, nullptr);
        } else if (k == 7) {
            phase_rmsnorm(p.out, p.in[28] + (size_t)layer * DM, hn, nullptr);
        } else if (k == 8) {
            pg8::Gemm g{hn, (const bf16_t*)(ws + O_WFIN), T_, NFF, DM}; pg8::StaticOrder S; S.init(T_, NFF, G, b);
            EpiBf E{(bf16_t*)(ws + O_HF), NFF};
            pg8::gemm_phase<EpiBf, pg8::StaticOrder, false>(glds, g, S, E, nullptr);
        } else if (k == 9) {
            phase_ffn_act(q, layer);
        } else if (k == 10) {
            pg8::Gemm g{(const bf16_t*)(ws + O_ACT), (const bf16_t*)(ws + O_WFOUT), T_, DM, DFF}; pg8::StaticOrder S; S.init(T_, DM, G, b);
            EpiResid E{p.out, DM};
            pg8::gemm_phase<EpiResid, pg8::StaticOrder, false>(glds, g, S, E, nullptr);
        }
        __syncthreads();
        if (ph + 1 < p.ph_hi) {
            if (ph == p.ph_lo) { grid.sync(); xbar = xcd_barrier_post((unsigned*)(p.ws + O_BAR), xst); }
            else xcd_barrier(xbar);
        }
    }
}

extern "C" void kernel_launch(void* const* d_in, const int* in_sizes, int n_in, void* d_out, int out_size, void* d_ws, size_t ws_size, hipStream_t stream) {
    static int grid_blocks = 0;
    if (!grid_blocks) {
        if (n_in != 33 || out_size != T_ * DM || ws_size < WS_NEED) { fprintf(stderr, "kernel_launch: unexpected shapes or workspace (%d inputs, out %d, ws %zu < %zu)\n", n_in, out_size, ws_size, (size_t)WS_NEED); grid_blocks = -1; return; }
        int dev = 0, cus = 0, per_cu = 0;
        hipGetDevice(&dev);
        hipDeviceGetAttribute(&cus, hipDeviceAttributeMultiprocessorCount, dev);
        if (hipFuncSetAttribute((const void*)mega, hipFuncAttributeMaxDynamicSharedMemorySize, LDS_BYTES) != hipSuccess) { fprintf(stderr, "kernel_launch: hipFuncSetAttribute failed\n"); grid_blocks = -1; return; }
        hipOccupancyMaxActiveBlocksPerMultiprocessor(&per_cu, (const void*)mega, 512, LDS_BYTES);
        (void)hipGetLastError();
        if (per_cu < 1) per_cu = 1;
        grid_blocks = cus * per_cu; if (grid_blocks > 256) grid_blocks = 256;
        if (grid_blocks < 160) { fprintf(stderr, "kernel_launch: grid %d too small\n", grid_blocks); grid_blocks = -1; return; }
    }
    if (grid_blocks < 0) return;
    Params p{};
    for (int i = 0; i < 33; ++i) p.in[i] = (const float*)d_in[i];
    p.out = (float*)d_out; p.ws = (unsigned char*)d_ws;
#if MULTI_LAUNCH
    for (int ph = 0; ph < 2 * NPHT; ++ph) { p.ph_lo = ph; p.ph_hi = ph + 1; hipLaunchKernelGGL(mega, dim3(grid_blocks), dim3(512), LDS_BYTES, stream, p); }
#else
    p.ph_lo = 0; p.ph_hi = 2 * NPHT;
    void* args[] = {&p};
    hipError_t e = hipLaunchCooperativeKernel((const void*)mega, dim3(grid_blocks), dim3(512), args, LDS_BYTES, stream);
    if (e != hipSuccess) fprintf(stderr, "cooperative launch failed: %s (grid %d)\n", hipGetErrorString(e), grid_blocks);
#endif
}
```

```cpp
#include <hip/hip_runtime.h>
#include <hip/hip_cooperative_groups.h>
#include <cstdio>
namespace cg = cooperative_groups;
__device__ __forceinline__ int tidx() { int t = threadIdx.x; asm volatile("" : "+v"(t)); return t; }
namespace pg8 {
#define PG8_LAS __attribute__((address_space(3)))
typedef unsigned short bf16_t;
typedef short bf16x8 __attribute__((ext_vector_type(8)));
typedef float f32x4 __attribute__((ext_vector_type(4)));
typedef unsigned u32x4 __attribute__((ext_vector_type(4)));
constexpr int BM = 256, BK = 64, HALF = 128, HTB = HALF * BK * 2  , STAGE_BYTES = 8 * HTB, NXCD = 8, WGM = 8;

__host__ __device__ __forceinline__ int lds_byte(int r, int c) { const int st = (r >> 4) * 2 + (c >> 5), rr = r & 15, cc = c & 31, ob = rr * 64 + cc * 2; return st * 1024 + (ob ^ (((ob >> 9) & 1) << 5)); }
__host__ __device__ __forceinline__ void stage_rc(int b, int& R, int& C) { const int st = b / 1024, sb = b % 1024, swz = sb ^ (((sb >> 9) & 1) << 5); R = (st >> 1) * 16 + swz / 64; C = (st & 1) * 32 + (swz % 64) / 2; }
__host__ __device__ __forceinline__ int perm32(int rho) { const int n = rho >> 4, i = rho & 15; return 8 * (i >> 2) + 4 * n + (i & 3); }

struct Unit { int pm, pn; };
struct Gemm { const bf16_t* A; const bf16_t* Bt; int M, N, K; };

struct StaticOrder {
    int nM, nN, nwg, G, c;
    __host__ __device__ void init(int M, int N, int G_, int c_) { nM = M / BM; nN = N / BM; nwg = nM * nN; G = G_; c = c_; }
    __host__ __device__ bool next(int i, Unit& u) const {
        const long L = (long)i * G + c; if (L >= nwg) return false;
        int wgid = (int)L; { const int q = nwg / NXCD, r = nwg % NXCD, xcd = wgid % NXCD, off = wgid / NXCD; wgid = (xcd < r ? xcd * (q + 1) : r * (q + 1) + (xcd - r) * q) + off; }
        const int nig = WGM * nN, gid = wgid / nig, fm = gid * WGM, gsz = (nM - fm) < WGM ? (nM - fm) : WGM;
        u.pm = fm + ((wgid % nig) % gsz); u.pn = (wgid % nig) / gsz; return true;
    }
    __device__ __forceinline__ void a_ready(const Unit&) const {}
    __device__ __forceinline__ void done(const Unit&) const {}
};
__device__ __forceinline__ unsigned cvt_pk_bf16(float lo, float hi) { unsigned r; asm volatile("v_cvt_pk_bf16_f32 %0, %1, %2" : "=v"(r) : "v"(lo), "v"(hi)); return r; }
template <class Epi, class Sched, bool STAMP = false>
__device__ __forceinline__ void gemm_phase(PG8_LAS unsigned char* lds, const Gemm g, const Sched& S, const Epi& E, unsigned long long* stamps) {
    const int tid = tidx(), wid = __builtin_amdgcn_readfirstlane(tid >> 6), lane = tid & 63, wr = wid >> 2, wc = wid & 3, fr = lane & 15, fq = lane >> 4;
    const int K = g.K, nt = K / BK;
    int ts_lo = 0, ts_hi = 0, nts = 0; const unsigned long long rt_entry = STAMP ? (unsigned long long)wall_clock64() : 0ull;
#define PG8_STAMP() do { if (STAMP && wid == 0 && nts < 64) { const unsigned long long _c = (unsigned long long)clock64(); \
        ts_lo = (lane == nts) ? (int)(unsigned)_c : ts_lo; ts_hi = (lane == nts) ? (int)(unsigned)(_c >> 32) : ts_hi; ++nts; } } while (0)
    PG8_STAMP();
    unsigned voffA[2], voffB[2];
#pragma unroll
    for (int i = 0; i < 2; ++i) { int R, C; stage_rc(tid * 16 + i * 8192, R, C); const int Rb = Epi::PERM ? ((R & ~31) + perm32(R & 31)) : R;
        voffA[i] = (unsigned)(R * K + C) * 2u; voffB[i] = (unsigned)(Rb * K + C) * 2u; }
    const size_t kstep = (size_t)(BK * 2);
    const size_t hstep = (size_t)HALF * K * 2;
    const size_t tstep = 2 * hstep;
    const unsigned ldsw = (unsigned)wid * 1024u;
    const int aoff = lds_byte(wr * 64 + fr, fq * 8), boff = lds_byte(wc * 32 + fr, fq * 8);
#define PG8_SA(b, h) (((b) * 2 + (h)) * HTB)
#define PG8_SB(b, h) ((4 + (b) * 2 + (h)) * HTB)
#define PG8_STAGE(bufoff, gbase, voff) do { _Pragma("unroll") for (int _i = 0; _i < 2; ++_i) \
        __builtin_amdgcn_global_load_lds((const unsigned*)((const char*)(gbase) + (voff)[_i]), (PG8_LAS unsigned*)(lds + (bufoff) + ldsw + _i * 8192), 16, 0, 0); } while (0)
#define PG8_LDA(dst, b, h) do { _Pragma("unroll") for (int m = 0; m < 4; ++m) _Pragma("unroll") for (int k = 0; k < 2; ++k) dst[m][k] = *(const PG8_LAS bf16x8*)(lds + PG8_SA(b, h) + aoff + m * 2048 + k * 1024); } while (0)
#define PG8_LDB(dst, b, h) do { _Pragma("unroll") for (int n = 0; n < 2; ++n) _Pragma("unroll") for (int k = 0; k < 2; ++k) dst[n][k] = *(const PG8_LAS bf16x8*)(lds + PG8_SB(b, h) + boff + n * 2048 + k * 1024); } while (0)
#define PG8_MMA(ai, bj, At, Bt) do { __builtin_amdgcn_s_setprio(1); _Pragma("unroll") for (int m = 0; m < 4; ++m) _Pragma("unroll") for (int n = 0; n < 2; ++n) _Pragma("unroll") for (int k = 0; k < 2; ++k) \
        acc[ai][bj][m][n] = __builtin_amdgcn_mfma_f32_16x16x32_bf16(Bt[n][k], At[m][k], acc[ai][bj][m][n], 0, 0, 0); __builtin_amdgcn_s_setprio(0); } while (0)
#define PG8_WAIT_V(n) asm volatile("s_waitcnt vmcnt(" #n ")" ::: "memory")
#define PG8_WAIT_L(n) asm volatile("s_waitcnt lgkmcnt(" #n ")" ::: "memory")
#define PG8_BAR __builtin_amdgcn_s_barrier()
#define PG8_SCHED __builtin_amdgcn_sched_barrier(0)
    Unit cur, nxt; int ui = 0;
    if (!S.next(0, cur)) return;
    f32x4 acc[2][2][4][2];
#pragma unroll
    for (int a = 0; a < 2; ++a)
#pragma unroll
        for (int b = 0; b < 2; ++b)
#pragma unroll
            for (int m = 0; m < 4; ++m)
#pragma unroll
                for (int n = 0; n < 2; ++n) acc[a][b][m][n] = (f32x4){0.f, 0.f, 0.f, 0.f};
    bf16x8 At[4][2], B0[2][2], B1[2][2];
    const char* cA = (const char*)g.A + (size_t)cur.pm * tstep; const char* cB = (const char*)g.Bt + (size_t)cur.pn * tstep;
    S.a_ready(cur);
    PG8_STAGE(PG8_SB(0, 0), cB, voffB); PG8_STAGE(PG8_SA(0, 0), cA, voffA); PG8_STAGE(PG8_SB(0, 1), cB + hstep, voffB); PG8_STAGE(PG8_SA(0, 1), cA + hstep, voffA);
    if (wr == 1) PG8_BAR;
    PG8_WAIT_V(4); PG8_BAR;
    PG8_STAGE(PG8_SB(1, 0), cB + kstep, voffB); PG8_STAGE(PG8_SA(1, 0), cA + kstep, voffA); PG8_STAGE(PG8_SB(1, 1), cB + hstep + kstep, voffB);
    PG8_WAIT_V(6); PG8_BAR;
    PG8_STAMP();
    for (;;) {
        const bool has_next = S.next(ui + 1, nxt);
        const char* nA = has_next ? (const char*)g.A + (size_t)nxt.pm * tstep : cA; const char* nB = has_next ? (const char*)g.Bt + (size_t)nxt.pn * tstep : cB;
        for (int t = 0; t < nt; t += 2) {
            const bool last = (t == nt - 2);
            const char* a1 = cA + (size_t)(t + 1) * kstep;
            const char* a2 = last ? nA : cA + (size_t)(t + 2) * kstep; const char* b2 = last ? nB : cB + (size_t)(t + 2) * kstep;
            const char* a3 = a2 + kstep; const char* b3 = b2 + kstep;
            if (last && has_next) S.a_ready(nxt);
            PG8_LDB(B0, 0, 0); PG8_SCHED; PG8_LDA(At, 0, 0); PG8_STAGE(PG8_SA(1, 1), a1 + hstep, voffA);
            PG8_WAIT_L(8); PG8_BAR; PG8_WAIT_L(0); PG8_MMA(0, 0, At, B0); PG8_BAR; PG8_SCHED;
            PG8_LDB(B1, 0, 1); PG8_STAGE(PG8_SB(0, 0), b2, voffB);
            PG8_BAR; PG8_WAIT_L(0); PG8_MMA(0, 1, At, B1); PG8_BAR;
            PG8_LDA(At, 0, 1); PG8_STAGE(PG8_SA(0, 0), a2, voffA);
            PG8_BAR; PG8_WAIT_L(0); PG8_MMA(1, 0, At, B0); PG8_BAR; PG8_SCHED;
            PG8_STAGE(PG8_SB(0, 1), b2 + hstep, voffB);
            PG8_WAIT_V(6); PG8_BAR; PG8_MMA(1, 1, At, B1); PG8_BAR;
            PG8_LDB(B0, 1, 0); PG8_SCHED; PG8_LDA(At, 1, 0); PG8_STAGE(PG8_SA(0, 1), a2 + hstep, voffA);
            PG8_WAIT_L(8); PG8_BAR; PG8_WAIT_L(0); PG8_MMA(0, 0, At, B0); PG8_BAR; PG8_SCHED;
            PG8_LDB(B1, 1, 1); PG8_STAGE(PG8_SB(1, 0), b3, voffB);
            PG8_BAR; PG8_WAIT_L(0); PG8_MMA(0, 1, At, B1); PG8_BAR;
            PG8_LDA(At, 1, 1); PG8_STAGE(PG8_SA(1, 0), a3, voffA);
            PG8_BAR; PG8_WAIT_L(0); PG8_MMA(1, 0, At, B0); PG8_BAR; PG8_SCHED;
            PG8_STAGE(PG8_SB(1, 1), b3 + hstep, voffB);
            PG8_WAIT_V(6); PG8_BAR; PG8_MMA(1, 1, At, B1); PG8_BAR;
        }
        PG8_STAMP();
        if constexpr (!Epi::AFTER_DRAIN) { E(acc, cur, wr, wc, fr, fq); S.done(cur); }
        PG8_STAMP();
        if (!has_next) break;
#pragma unroll
        for (int a = 0; a < 2; ++a)
#pragma unroll
            for (int b = 0; b < 2; ++b)
#pragma unroll
                for (int m = 0; m < 4; ++m)
#pragma unroll
                    for (int n = 0; n < 2; ++n) acc[a][b][m][n] = (f32x4){0.f, 0.f, 0.f, 0.f};
        cur = nxt; cA = nA; cB = nB; ++ui;
    }
    PG8_WAIT_V(0);
    if (wr == 0) PG8_BAR;
    PG8_BAR;
    if constexpr (Epi::AFTER_DRAIN) { E.fused(acc, cur, wr, wc, fr, fq, lds, wid, lane); S.done(cur); }
    PG8_STAMP();
    if (STAMP && wid == 0) { stamps[lane] = lane < nts ? (((unsigned long long)(unsigned)ts_hi << 32) | (unsigned)ts_lo) : 0ull;
        if (lane == 62) stamps[62] = rt_entry; if (lane == 63) stamps[63] = (unsigned long long)wall_clock64(); }
#undef PG8_STAMP
#undef PG8_SA
#undef PG8_SB
#undef PG8_STAGE
#undef PG8_LDA
#undef PG8_LDB
#undef PG8_MMA
#undef PG8_WAIT_V
#undef PG8_WAIT_L
#undef PG8_BAR
#undef PG8_SCHED
}
}
#define XB_TMO      128
#define XB_XCNT(j)  (256  + 64 * (j))
#define XB_XSUB(j)  (1280 + 64 * (j))
#define XB_XGEN(j)  (2304 + 64 * (j))
#define XB_TOP      3328
#define XB_TOPGEN   3392
#define XCD_BAR_WORDS 3456
#define XB_SPIN_CAP (1u << 18)
#define XB_LAS __attribute__((address_space(3)))

__device__ __forceinline__ unsigned xb_ld(unsigned* p)              { return __hip_atomic_load(p, __ATOMIC_RELAXED, __HIP_MEMORY_SCOPE_AGENT); }
__device__ __forceinline__ unsigned xb_add(unsigned* p, unsigned v) { return __hip_atomic_fetch_add(p, v, __ATOMIC_RELAXED, __HIP_MEMORY_SCOPE_AGENT); }
__device__ __forceinline__ unsigned xb_xcc_id() { return (unsigned)__builtin_amdgcn_s_getreg((3 << 11) | 20) & 0xFu; }
#define XB_SPIN(cond, bar) do { unsigned _sp = 0; while (cond) { __builtin_amdgcn_s_sleep(1); \
    if ((++_sp & 255u) == 0u) { if (xb_ld(&(bar)[XB_TMO])) break; if (_sp > XB_SPIN_CAP) { atomicAdd(&(bar)[XB_TMO], 1u); break; } } } } while (0)

struct XcdBarrier {
    unsigned* bar; unsigned x;
    volatile XB_LAS unsigned* st;
};

__device__ __forceinline__ XcdBarrier xcd_barrier_post(unsigned* bar, volatile XB_LAS unsigned* st) {
    XcdBarrier b; b.bar = bar; b.x = xb_xcc_id(); b.st = st;
    if (threadIdx.x == 0) (void)xb_add(&bar[XB_XCNT(b.x)], 1u);
    return b;
}
__device__ __forceinline__ void xcd_barrier_complete(unsigned* bar, unsigned x, unsigned& nloc, unsigned& nx) {
    const unsigned G = gridDim.x * gridDim.y * gridDim.z;
    unsigned sum, cnt, mine, sp = 0u;
    for (;;) {
        sum = 0u; cnt = 0u; mine = 0u;
#pragma unroll
        for (unsigned j = 0; j < 16; ++j) { const unsigned c = xb_ld(&bar[XB_XCNT(j)]); sum += c; cnt += (c > 0u) ? 1u : 0u; mine = (j == x) ? c : mine; }
        if (sum == G) break;
        __builtin_amdgcn_s_sleep(1);
        if ((++sp & 255u) == 0u) { if (xb_ld(&bar[XB_TMO])) break; if (sp > XB_SPIN_CAP) { atomicAdd(&bar[XB_TMO], 1u); break; } }
    }
    nloc = mine > 0u ? mine : 1u; nx = cnt > 0u ? cnt : 1u;
}

__device__ __forceinline__ void xcd_barrier(const XcdBarrier& b) {
    asm volatile("s_waitcnt vmcnt(0)" ::: "memory");
    __syncthreads();
    if (threadIdx.x == 0) {
        unsigned* bar = b.bar;
        __builtin_amdgcn_s_waitcnt(0);
        unsigned nloc = b.st[0], nx = b.st[1];
        if (nloc == 0u) { xcd_barrier_complete(bar, b.x, nloc, nx); b.st[0] = nloc; b.st[1] = nx; }
        const unsigned old = xb_add(&bar[XB_XSUB(b.x)], 1u);
        const unsigned gen = old / nloc;
        if (old + 1u == (gen + 1u) * nloc) {
            __builtin_amdgcn_fence(__ATOMIC_RELEASE, "agent");
            asm volatile("s_waitcnt vmcnt(0)" ::: "memory");
            const unsigned og = xb_add(&bar[XB_TOP], 1u);
            const unsigned tg = og / nx;
            if (og + 1u == (tg + 1u) * nx) xb_add(&bar[XB_TOPGEN], 1u);
            else XB_SPIN(xb_ld(&bar[XB_TOPGEN]) == tg, bar);
            __builtin_amdgcn_fence(__ATOMIC_ACQUIRE, "agent");
            xb_add(&bar[XB_XGEN(b.x)], 1u);
            asm volatile("s_waitcnt vmcnt(0)" ::: "memory");
        } else {
            XB_SPIN(xb_ld(&bar[XB_XGEN(b.x)]) == gen, bar);
            __builtin_amdgcn_fence(__ATOMIC_ACQUIRE, "agent");
            asm volatile("s_waitcnt vmcnt(0)" ::: "memory");
        }
    }
    __syncthreads();
}
using pg8::bf16_t; using pg8::bf16x8; using pg8::f32x4; using pg8::u32x4; using pg8::Unit;
typedef unsigned u32x2 __attribute__((ext_vector_type(2)));
#define MFMA16(a, b, c) __builtin_amdgcn_mfma_f32_16x16x32_bf16((a), (b), (c), 0, 0, 0)

constexpr int T_ = 16384, DM = 2048, NIN = 6144, DFF = 5504, NFF = 11008;
constexpr int LDS_BYTES = 144 * 1024;
constexpr int NPH = 11;

constexpr size_t O_CTR   = 0;
constexpr size_t O_BAR   = 4096;
constexpr size_t O_WIN   = 4096 + 16384;
constexpr size_t O_WOUT  = O_WIN   + (size_t)NIN * DM * 2;
constexpr size_t O_WFIN  = O_WOUT  + (size_t)DM * DM * 2;
constexpr size_t O_WFOUT = O_WFIN  + (size_t)NFF * DM * 2;
constexpr size_t O_WCK   = O_WFOUT + (size_t)DM * DFF * 2;
constexpr size_t O_WCV   = O_WCK   + (size_t)256 * 2048 * 2;
constexpr size_t O_WGLU  = O_WCV   + (size_t)256 * 2048 * 2;
constexpr size_t O_HN    = O_WGLU  + (size_t)512 * 512 * 2;
constexpr size_t O_R     = O_HN    + (size_t)T_ * DM * 2;
constexpr size_t O_P32   = O_R;
constexpr size_t O_PU    = O_P32   + (size_t)T_ * 1536 * 4;
constexpr size_t O_PQKV  = O_PU    + (size_t)T_ * 512 * 2;
constexpr size_t O_PZ    = O_PQKV  + (size_t)T_ * 3072 * 2;
constexpr size_t O_QN    = O_PZ    + (size_t)T_ * 1024 * 2;
constexpr size_t O_KSN   = O_QN    + (size_t)T_ * 512 * 2;
constexpr size_t O_KWN   = O_KSN   + (size_t)T_ * 128 * 2;
constexpr size_t O_VST   = O_KWN   + (size_t)T_ * 128 * 2;
constexpr size_t O_VWT   = O_VST   + (size_t)T_ * 128 * 2;
constexpr size_t O_KC    = O_VWT   + (size_t)T_ * 128 * 2;
constexpr size_t O_VCT   = O_KC    + (size_t)2 * 1024 * 64 * 2;
constexpr size_t O_HCMP  = O_VCT   + (size_t)2 * 64 * 1024 * 2;
constexpr size_t O_GKC   = O_HCMP  + (size_t)2 * 2048 * 256 * 4;
constexpr size_t O_GQG   = O_GKC   + (size_t)2048 * 64 * 128 * 2;
constexpr size_t O_GQK   = O_GQG   + (size_t)2048 * 64 * 128 * 2;
constexpr size_t O_GKD   = O_GQK   + (size_t)2048 * 64 * 64 * 2;
constexpr size_t O_GVAL  = O_GKD   + (size_t)2048 * 64 * 128 * 2;
constexpr size_t O_GEGL  = O_GVAL  + (size_t)2048 * 64 * 128 * 4;
constexpr size_t O_XEND  = O_GEGL  + 8192;
constexpr size_t O_YGELU = O_XEND  + (size_t)64 * 32 * 64 * 2 * 4;
constexpr size_t O_YGLU  = O_YGELU + (size_t)T_ * 512 * 2;
constexpr size_t O_ATT_END = O_YGLU + (size_t)T_ * 512 * 4;
constexpr size_t O_HF    = O_R;
constexpr size_t O_ACT   = O_HF    + (size_t)T_ * NFF * 2;
constexpr size_t O_FFN_END = O_ACT + (size_t)T_ * DFF * 2;
constexpr size_t WS_NEED = O_ATT_END > O_FFN_END ? O_ATT_END : O_FFN_END;

struct Params { const float* in[33]; float* out; unsigned char* ws; int ph_lo, ph_hi; };

__device__ __forceinline__ unsigned short f2bf(float f) { unsigned u = __float_as_uint(f); u += 0x7FFFu + ((u >> 16) & 1u); return (unsigned short)(u >> 16); }
__device__ __forceinline__ float bf2f(unsigned short b) { return __uint_as_float(((unsigned)b) << 16); }
__device__ __forceinline__ unsigned pk2(float lo, float hi) { return pg8::cvt_pk_bf16(lo, hi); }
__device__ __forceinline__ float bflo(unsigned w) { return __uint_as_float(w << 16); }
__device__ __forceinline__ float bfhi(unsigned w) { return __uint_as_float(w & 0xFFFF0000u); }
__device__ __forceinline__ float sigmoidf_(float x) { return __builtin_amdgcn_rcpf(1.0f + __expf(-x)); }
__device__ __forceinline__ float siluf_(float x) { return x * __builtin_amdgcn_rcpf(1.0f + __expf(-x)); }
__device__ __forceinline__ float vmaxf(float a, float b) { float r; asm("v_max_f32 %0, %1, %2" : "=v"(r) : "v"(a), "v"(b)); return r; }
__device__ __forceinline__ float gelu_tanh(float x) { const float u = 0.7978845608028654f * (x + 0.044715f * x * x * x); const float th = 1.0f - 2.0f * __builtin_amdgcn_rcpf(__expf(2.0f * u) + 1.0f); return 0.5f * x * (1.0f + th); }
__device__ __forceinline__ float softplusf_(float x) { return x > 20.f ? x : log1pf(expf(x)); }
__device__ __forceinline__ float wave_sum(float v) { for (int o = 32; o >= 1; o >>= 1) v += __shfl_xor(v, o); return v; }
__device__ __forceinline__ bf16x8 pack8f(f32x4 a, f32x4 b) { u32x4 w; w.x = pk2(a[0], a[1]); w.y = pk2(a[2], a[3]); w.z = pk2(b[0], b[1]); w.w = pk2(b[2], b[3]); return __builtin_bit_cast(bf16x8, w); }
__device__ __forceinline__ float rdlane(float v, int l) { return __int_as_float(__builtin_amdgcn_readlane(__float_as_int(v), l)); }

struct EpiProj {
    static constexpr bool PERM = false, AFTER_DRAIN = false;
    float* P32; bf16_t* Pu; bf16_t* Pqkv; bf16_t* Pz;
    static __device__ __forceinline__ void st_bf(const f32x4 (&acc)[2][2][4][2], bf16_t* base, int ld) {
#pragma unroll
        for (int ai = 0; ai < 2; ++ai)
#pragma unroll
            for (int m = 0; m < 4; ++m) { bf16_t* rp = base + (size_t)(ai * 128 + m * 16) * ld;
#pragma unroll
                for (int bj = 0; bj < 2; ++bj)
#pragma unroll
                    for (int n = 0; n < 2; ++n) { const f32x4 v = acc[ai][bj][m][n]; u32x2 w; w.x = pk2(v[0], v[1]); w.y = pk2(v[2], v[3]); *(u32x2*)(rp + bj * 128 + n * 16) = w; } }
    }
    __device__ __forceinline__ void operator()(const f32x4 (&acc)[2][2][4][2], const Unit& u, int wr, int wc, int fr, int fq) const {
        const int row0 = u.pm * 256 + wr * 64 + fr, colt = wc * 32 + 4 * fq;
        if (u.pn < 6) {
            float* base = P32 + (size_t)row0 * 1536 + u.pn * 256 + colt;
#pragma unroll
            for (int ai = 0; ai < 2; ++ai)
#pragma unroll
                for (int m = 0; m < 4; ++m) { float* rp = base + (size_t)(ai * 128 + m * 16) * 1536;
#pragma unroll
                    for (int bj = 0; bj < 2; ++bj)
#pragma unroll
                        for (int n = 0; n < 2; ++n) *(f32x4*)(rp + bj * 128 + n * 16) = acc[ai][bj][m][n]; }
        } else if (u.pn < 8)  st_bf(acc, Pu   + (size_t)row0 * 512  + (u.pn - 6)  * 256 + colt, 512);
        else if (u.pn < 20)   st_bf(acc, Pqkv + (size_t)row0 * 3072 + (u.pn - 8)  * 256 + colt, 3072);
        else                  st_bf(acc, Pz   + (size_t)row0 * 1024 + (u.pn - 20) * 256 + colt, 1024);
    }
};
struct EpiResid {
    static constexpr bool PERM = false, AFTER_DRAIN = false;
    float* X; int ld;
    __device__ __forceinline__ void operator()(const f32x4 (&acc)[2][2][4][2], const Unit& u, int wr, int wc, int fr, int fq) const {
        float* base = X + (size_t)(u.pm * 256 + wr * 64 + fr) * ld + u.pn * 256 + wc * 32 + 4 * fq;
#pragma unroll
        for (int ai = 0; ai < 2; ++ai)
#pragma unroll
            for (int m = 0; m < 4; ++m) { float* rp = base + (size_t)(ai * 128 + m * 16) * ld;
#pragma unroll
                for (int bj = 0; bj < 2; ++bj)
#pragma unroll
                    for (int n = 0; n < 2; ++n) { f32x4* q = (f32x4*)(rp + bj * 128 + n * 16); *q = *q + acc[ai][bj][m][n]; } }
    }
};
struct EpiBf {
    static constexpr bool PERM = false, AFTER_DRAIN = false;
    bf16_t* O; int ld;
    __device__ __forceinline__ void operator()(const f32x4 (&acc)[2][2][4][2], const Unit& u, int wr, int wc, int fr, int fq) const {
        bf16_t* base = O + (size_t)(u.pm * 256 + wr * 64 + fr) * ld + u.pn * 256 + wc * 32 + 4 * fq;
#pragma unroll
        for (int ai = 0; ai < 2; ++ai)
#pragma unroll
            for (int m = 0; m < 4; ++m) { bf16_t* rp = base + (size_t)(ai * 128 + m * 16) * ld;
#pragma unroll
                for (int bj = 0; bj < 2; ++bj)
#pragma unroll
                    for (int n = 0; n < 2; ++n) { const f32x4 v = acc[ai][bj][m][n]; u32x2 w; w.x = pk2(v[0], v[1]); w.y = pk2(v[2], v[3]); *(u32x2*)(rp + bj * 128 + n * 16) = w; } }
    }
};
struct EpiGlu {
    static constexpr bool PERM = false, AFTER_DRAIN = false;
    const bf16_t* Y; float* O;
    __device__ __forceinline__ void operator()(const f32x4 (&acc)[2][2][4][2], const Unit& u, int wr, int wc, int fr, int fq) const {
        const size_t off0 = (size_t)(u.pm * 256 + wr * 64 + fr) * 512 + u.pn * 256 + wc * 32 + 4 * fq;
#pragma unroll
        for (int ai = 0; ai < 2; ++ai)
#pragma unroll
            for (int m = 0; m < 4; ++m) { const size_t ro = off0 + (size_t)(ai * 128 + m * 16) * 512;
#pragma unroll
                for (int bj = 0; bj < 2; ++bj)
#pragma unroll
                    for (int n = 0; n < 2; ++n) { const size_t o = ro + bj * 128 + n * 16; const u32x2 yw = *(const u32x2*)(Y + o); const f32x4 a = acc[ai][bj][m][n];
                        f32x4 r; r[0] = bflo(yw.x) * sigmoidf_(a[0]); r[1] = bfhi(yw.x) * sigmoidf_(a[1]); r[2] = bflo(yw.y) * sigmoidf_(a[2]); r[3] = bfhi(yw.y) * sigmoidf_(a[3]); *(f32x4*)(O + o) = r; } }
    }
};
__device__ __forceinline__ int map_in_col(int n) { return n < 1304 ? n : (n < 1312 ? 5912 + (n - 1304) : (n < 1320 ? 5920 + (n - 1312) : (n < 1536 ? -1 : 1304 + (n - 1536)))); }
__device__ void convT_tile(const float* __restrict__ src, int srcN, int K, bf16_t* __restrict__ dst, int tile, bool inmap, float* sm) {
    const int nk = K >> 6, tk = tile % nk, tn = tile / nk, k0 = tk * 64, n0 = tn * 256;
    const int tid = tidx(), tx = tid & 255, ty = tid >> 8;
    const int n = n0 + tx, sc = inmap ? map_in_col(n) : n;
    float v[32];
#pragma unroll
    for (int i = 0; i < 32; ++i) v[i] = (sc >= 0) ? src[(size_t)(k0 + ty + 2 * i) * srcN + sc] : 0.f;
#pragma unroll
    for (int i = 0; i < 32; ++i) sm[(ty + 2 * i) * 257 + tx] = v[i];
    __syncthreads();
    const int nn = tid >> 1, hf = tid & 1;
    bf16_t* o = dst + (size_t)(n0 + nn) * K + k0 + hf * 32;
#pragma unroll
    for (int q = 0; q < 4; ++q) { u32x4 w; const float* sp = sm + (hf * 32 + q * 8) * 257 + nn;
        w.x = pk2(sp[0], sp[257]); w.y = pk2(sp[2 * 257], sp[3 * 257]); w.z = pk2(sp[4 * 257], sp[5 * 257]); w.w = pk2(sp[6 * 257], sp[7 * 257]); *(u32x4*)(o + q * 8) = w; }
    __syncthreads();
}
__device__ void phase_convert(const Params& p, int layer, float* sm) {
    unsigned char* ws = p.ws;
    const int G = gridDim.x, b = blockIdx.x;
    const int n0 = 32 * 24, n1 = n0 + 32 * 8, n2 = n1 + 32 * 43, n3 = n2 + 86 * 8, n4 = n3 + 32, n5 = n4 + 32, n6 = n5 + 16;
    for (int it = b; it < n6; it += G) {
        if (it < n0)      convT_tile(p.in[2]  + (size_t)layer * DM * 5928, 5928, DM, (bf16_t*)(ws + O_WIN), it, true, sm);
        else if (it < n1) convT_tile(p.in[27] + (size_t)layer * DM * DM, DM, DM, (bf16_t*)(ws + O_WOUT), it - n0, false, sm);
        else if (it < n2) convT_tile(p.in[29] + (size_t)layer * DM * NFF, NFF, DM, (bf16_t*)(ws + O_WFIN), it - n1, false, sm);
        else if (it < n3) convT_tile(p.in[32] + (size_t)layer * DFF * DM, DM, DFF, (bf16_t*)(ws + O_WFOUT), it - n2, false, sm);
        else if (it < n4) convT_tile(p.in[8]  + (size_t)layer * 2048 * 256, 256, 2048, (bf16_t*)(ws + O_WCK), it - n3, false, sm);
        else if (it < n5) convT_tile(p.in[10] + (size_t)layer * 2048 * 256, 256, 2048, (bf16_t*)(ws + O_WCV), it - n4, false, sm);
        else              convT_tile(p.in[21] + (size_t)layer * 512 * 512, 512, 512, (bf16_t*)(ws + O_WGLU), it - n5, false, sm);
    }
}
__device__ void phase_rmsnorm(const float* __restrict__ x, const float* __restrict__ gain, bf16_t* __restrict__ hn, float* __restrict__ xcopy) {
    const int wave = tidx() >> 6, lane = tidx() & 63;
    for (int r = blockIdx.x * 8 + wave; r < T_; r += gridDim.x * 8) {
        const f32x4* xr = (const f32x4*)(x + (size_t)r * DM);
        f32x4 v[8]; float ss = 0.f;
#pragma unroll
        for (int i = 0; i < 8; ++i) { v[i] = xr[lane + 64 * i]; ss += v[i][0] * v[i][0] + v[i][1] * v[i][1] + v[i][2] * v[i][2] + v[i][3] * v[i][3]; }
        ss = wave_sum(ss);
        const float rs = rsqrtf(ss * (1.0f / DM) + 1e-6f);
#pragma unroll
        for (int i = 0; i < 8; ++i) { const f32x4 g = ((const f32x4*)gain)[lane + 64 * i]; u32x2 w; w.x = pk2(v[i][0] * rs * g[0], v[i][1] * rs * g[1]); w.y = pk2(v[i][2] * rs * g[2], v[i][3] * rs * g[3]);
            *(u32x2*)(hn + (size_t)r * DM + (lane + 64 * i) * 4) = w; if (xcopy) ((f32x4*)(xcopy + (size_t)r * DM))[lane + 64 * i] = v[i]; }
    }
}

__device__ void nsa_prep_item(const Params& p, int layer, int item, float* sm) {
    unsigned char* ws = p.ws;
    const float* P32 = (const float*)(ws + O_P32);
    bf16_t* qn = (bf16_t*)(ws + O_QN); bf16_t* ksn = (bf16_t*)(ws + O_KSN); bf16_t* kwn = (bf16_t*)(ws + O_KWN);
    const int wave = tidx() >> 6, lane = tidx() & 63, tid = tidx();
    const int t0 = item * 64;
    const float gq = p.in[3][layer * 64 + lane], gks = p.in[5][layer * 64 + lane], gkw = p.in[6][layer * 64 + lane];
    const float inv = powf(500000.0f, -(float)(lane & 7) * 0.125f);
    for (int tt = 0; tt < 8; ++tt) {
        const int t = t0 + wave * 8 + tt;
        float sn, cs; sincosf((float)t * inv, &sn, &cs);
        const float* row = P32 + (size_t)t * 1536;
#pragma unroll
        for (int hv = 0; hv < 12; ++hv) {
            const int col = hv < 8 ? hv * 64 : (hv < 10 ? 768 + (hv - 8) * 64 : 1024 + (hv - 10) * 64);
            const float g = hv < 8 ? gq : (hv < 10 ? gks : gkw);
            const float x = row[col + lane];
            const float ss = wave_sum(x * x);
            float y = x * rsqrtf(ss * (1.0f / 64.0f) + 1e-6f) * g;
            const float yp = __shfl(y, lane ^ 8);
            if (lane < 8) y = y * cs - yp * sn; else if (lane < 16) y = y * cs + yp * sn;
            if (hv < 8) qn[(size_t)t * 512 + hv * 64 + lane] = f2bf(y * 0.18033688011112042f);
            else {
                unsigned char* k8 = (hv < 10 ? ws + O_KSN : ws + O_KWN) + ((size_t)(((hv - 8) & 1) * 256 + (t >> 6)) * 64 + (t & 63)) * 64 + ((lane >> 3) & 3) * 16 + (lane >> 5) * 8 + (lane & 7);
                *k8 = (unsigned char)__builtin_amdgcn_cvt_pk_fp8_f32(y, 0.f, 0, false);
            }
        }
    }
    for (int e = tid; e < 64 * 256; e += 512) { const int tk = e >> 8, c = e & 255; sm[tk * 257 + c] = P32[(size_t)(t0 + tk) * 1536 + (c < 128 ? 896 + c : 1152 + (c - 128))]; }
    __syncthreads();
    unsigned char* vs8 = ws + O_VST; unsigned char* vw8 = ws + O_VWT;
#pragma unroll
    for (int i = 0; i < 4; ++i) {
        const int rowid = (tid >> 3) + 64 * i, ts = tid & 7;
        float f[8];
#pragma unroll
        for (int k = 0; k < 8; ++k) { const int bb = ts * 8 + k, cc = ((bb >> 3) & 1) * 32 + (bb >> 4) * 8 + (bb & 7); f[k] = sm[((cc & 3) * 16 + (cc >> 2)) * 257 + rowid]; }
        u32x2 w; int t;
        t = __builtin_amdgcn_cvt_pk_fp8_f32(f[0], f[1], 0, false); t = __builtin_amdgcn_cvt_pk_fp8_f32(f[2], f[3], t, true); w.x = (unsigned)t;
        t = __builtin_amdgcn_cvt_pk_fp8_f32(f[4], f[5], 0, false); t = __builtin_amdgcn_cvt_pk_fp8_f32(f[6], f[7], t, true); w.y = (unsigned)t;
        const int rr = rowid & 127;
        unsigned char* dst = (rowid < 128 ? vs8 : vw8) + ((size_t)((rr >> 6) * 256 + item) * 64 + (rr & 63)) * 64 + ts * 8;
        *(u32x2*)dst = w;
    }
    __syncthreads();
}

__device__ void cmp1_wave_tile(const Params& p, int layer, int tile) {
    unsigned char* ws = p.ws;
    const float* P32 = (const float*)(ws + O_P32);
    const int lane = tidx() & 63, fr = lane & 15, fq = lane >> 4;
    const int nt = tile & 15, mt = (tile >> 4) & 127, which = tile >> 11;
    const bf16_t* Wt = (const bf16_t*)(ws + (which ? O_WCV : O_WCK)) + (size_t)(nt * 16 + fr) * 2048 + fq * 8;
    const float* pe = p.in[7] + (size_t)layer * 2048;
    const int r = mt * 16 + fr, n = r >> 1, hk = r & 1;
    const bool rv = n < 1023;
    const float* arow = P32 + (size_t)(16 * (rv ? n : 0)) * 1536 + (which ? 640 : 512) + hk * 64 + fq * 8;
    f32x4 acc = {0.f, 0.f, 0.f, 0.f};
#pragma unroll 8
    for (int ks = 0; ks < 64; ++ks) {
        const int l = ks >> 1, d = (ks & 1) * 32;
        const f32x4* ap = (const f32x4*)(arow + (size_t)l * 1536 + d);
        const f32x4* pp = (const f32x4*)(pe + l * 64 + d + fq * 8);
        f32x4 a0 = ap[0] + pp[0], a1 = ap[1] + pp[1];
        if (!rv) { a0 = (f32x4){0.f, 0.f, 0.f, 0.f}; a1 = a0; }
        const bf16x8 af = pack8f(a0, a1);
        const bf16x8 bf = *(const bf16x8*)(Wt + ks * 32);
        acc = MFMA16(af, bf, acc);
    }
    float* H = (float*)(ws + O_HCMP) + (size_t)which * 2048 * 256;
#pragma unroll
    for (int j = 0; j < 4; ++j) H[(size_t)(mt * 16 + fq * 4 + j) * 256 + nt * 16 + fr] = gelu_tanh(acc[j]);
}
__device__ void cmp2_wave_row(const Params& p, int layer, int idx) {
    unsigned char* ws = p.ws;
    const int lane = tidx() & 63;
    const int which = idx >> 11, r = idx & 2047, n = r >> 1, hk = r & 1;
    const float* H = (const float*)(ws + O_HCMP) + ((size_t)which * 2048 + r) * 256;
    const float* w2 = p.in[which ? 11 : 9] + (size_t)layer * 256 * 64;
    float acc = 0.f;
    if (n < 1023) {
        float a4[4] = {0.f, 0.f, 0.f, 0.f};
#pragma unroll 8
        for (int f = 0; f < 256; f += 4) { const f32x4 h4 = *(const f32x4*)(H + f); a4[0] += h4[0] * w2[f * 64 + lane]; a4[1] += h4[1] * w2[(f + 1) * 64 + lane]; a4[2] += h4[2] * w2[(f + 2) * 64 + lane]; a4[3] += h4[3] * w2[(f + 3) * 64 + lane]; }
        acc = (a4[0] + a4[1]) + (a4[2] + a4[3]);
    }
    if (which == 0) {
        const float ss = wave_sum(acc * acc);
        float y = acc * rsqrtf(ss * (1.0f / 64.0f) + 1e-6f) * p.in[4][layer * 64 + lane];
        const float inv = powf(500000.0f, -(float)(lane & 7) * 0.125f);
        float sn, cs; sincosf((float)(16 * n + 16) * inv, &sn, &cs);
        const float yp = __shfl(y, lane ^ 8);
        if (lane < 8) y = y * cs - yp * sn; else if (lane < 16) y = y * cs + yp * sn;
        if (n >= 1023) y = 0.f;
        ((bf16_t*)(ws + O_KC))[((size_t)hk * 1024 + n) * 64 + lane] = f2bf(y);
    } else {
        { const int cc = ((n & 15) << 2) | ((n >> 4) & 3); (ws + O_VCT)[((size_t)(hk * 16 + (n >> 6)) * 64 + lane) * 64 + ((cc >> 3) & 3) * 16 + (cc >> 5) * 8 + (cc & 7)] = (unsigned char)__builtin_amdgcn_cvt_pk_fp8_f32(acc, 0.f, 0, false); }
    }
}

typedef float f32x2 __attribute__((ext_vector_type(2)));
struct S5Coef { float ar, ai; f32x2 bb[16]; };
__device__ __forceinline__ void s5_setup(const Params& p, int layer, int g, int lane, S5Coef& c) {
    const int gp = layer * 2048 + g * 64 + lane;
    const float dt = expf(p.in[15][layer * 32 + g]);
    const float lr = p.in[13][gp], li = p.in[14][gp];
    const float mag = expf(lr * dt); float sn, cs; sincosf(li * dt, &sn, &cs);
    c.ar = mag * cs; c.ai = mag * sn;
    const float den = lr * lr + li * li, nr = c.ar - 1.0f, ni = c.ai;
    const float cr = (nr * lr + ni * li) / den, ci = (ni * lr - nr * li) / den;
    const f32x4* br = (const f32x4*)(p.in[16] + (size_t)gp * 16); const f32x4* bi = (const f32x4*)(p.in[17] + (size_t)gp * 16);
#pragma unroll
    for (int q = 0; q < 4; ++q) { const f32x4 a = br[q], b = bi[q];
#pragma unroll
        for (int e = 0; e < 4; ++e) c.bb[q * 4 + e] = (f32x2){cr * a[e] - ci * b[e], cr * b[e] + ci * a[e]}; }
}
__device__ __forceinline__ void s5_stage_u(const bf16_t* Pu, int tok, int g, float* ul, int lane) {
    const u32x4* s = (const u32x4*)(Pu + (size_t)tok * 512 + g * 16); const u32x4 a = s[0], b = s[1];
    f32x4* o = (f32x4*)(ul + lane * 16);
    o[0] = (f32x4){bflo(a.x), bfhi(a.x), bflo(a.y), bfhi(a.y)}; o[1] = (f32x4){bflo(a.z), bfhi(a.z), bflo(a.w), bfhi(a.w)};
    o[2] = (f32x4){bflo(b.x), bfhi(b.x), bflo(b.y), bfhi(b.y)}; o[3] = (f32x4){bflo(b.z), bfhi(b.z), bflo(b.w), bfhi(b.w)};
    asm volatile("s_waitcnt lgkmcnt(0)" ::: "memory");
}
__device__ __forceinline__ void s5_step(const S5Coef& k, const float* uj, float& xr, float& xi) {
    const f32x4 u0 = ((const f32x4*)uj)[0], u1 = ((const f32x4*)uj)[1], u2 = ((const f32x4*)uj)[2], u3 = ((const f32x4*)uj)[3];
    f32x2 acc0 = {0.f, 0.f}, acc1 = {0.f, 0.f};
#pragma unroll
    for (int e = 0; e < 4; ++e) { acc0 += k.bb[e] * u0[e]; acc1 += k.bb[4 + e] * u1[e]; }
#pragma unroll
    for (int e = 0; e < 4; ++e) { acc0 += k.bb[8 + e] * u2[e]; acc1 += k.bb[12 + e] * u3[e]; }
    const f32x2 bu = acc0 + acc1;
    const float nxr = k.ar * xr - k.ai * xi + bu[0], nxi = k.ar * xi + k.ai * xr + bu[1]; xr = nxr; xi = nxi;
}
__device__ void s5_passA_wave(const Params& p, int layer, int item, float* ul) {
    unsigned char* ws = p.ws; const bf16_t* Pu = (const bf16_t*)(ws + O_PU);
    const int lane = tidx() & 63, c = item >> 5, g = item & 31;
    S5Coef k; s5_setup(p, layer, g, lane, k);
    float xr = 0.f, xi = 0.f;
    for (int sub = 0; sub < 4; ++sub) {
        s5_stage_u(Pu, c * 256 + sub * 64 + lane, g, ul, lane);
#pragma unroll 4
        for (int j = 0; j < 64; ++j) s5_step(k, ul + j * 16, xr, xi);
        asm volatile("s_waitcnt lgkmcnt(0)" ::: "memory");
    }
    float* xe = (float*)(ws + O_XEND) + ((size_t)(c * 32 + g) * 64 + lane) * 2; xe[0] = xr; xe[1] = xi;
}
__device__ void s5_passB_wave(const Params& p, int layer, int item, bf16_t* xl, float* ul) {
    unsigned char* ws = p.ws; const bf16_t* Pu = (const bf16_t*)(ws + O_PU); bf16_t* yg = (bf16_t*)(ws + O_YGELU);
    const int lane = tidx() & 63, fr = lane & 15, fq = lane >> 4, c = item >> 5, g = item & 31;
    S5Coef k; s5_setup(p, layer, g, lane, k);
    float pr = k.ar, pi = k.ai;
#pragma unroll
    for (int s = 0; s < 8; ++s) { const float nr = pr * pr - pi * pi, ni = 2.f * pr * pi; pr = nr; pi = ni; }
    float xr = 0.f, xi = 0.f;
    const float* xe = (const float*)(ws + O_XEND) + ((size_t)g * 64 + lane) * 2;
#pragma unroll 8
    for (int cc = 0; cc < c; ++cc) { const float er = xe[(size_t)cc * 32 * 64 * 2], ei = xe[(size_t)cc * 32 * 64 * 2 + 1]; const float nr = pr * xr - pi * xi + er, ni = pr * xi + pi * xr + ei; xr = nr; xi = ni; }
    bf16x8 cf[4];
    {
        const float* cre = p.in[18] + (size_t)layer * 32 * 16 * 64 + ((size_t)g * 16 + fr) * 64; const float* cim = p.in[19] + (size_t)layer * 32 * 16 * 64 + ((size_t)g * 16 + fr) * 64;
#pragma unroll
        for (int ks = 0; ks < 4; ++ks) { const float* s = (ks < 2 ? cre : cim) + (ks & 1) * 32 + fq * 8; f32x4 a = ((const f32x4*)s)[0], b = ((const f32x4*)s)[1]; if (ks >= 2) { a = -a; b = -b; } cf[ks] = pack8f(a, b); }
    }
    const float dsk = p.in[20][layer * 512 + g * 16 + fr];
    for (int sub = 0; sub < 4; ++sub) {
        const int tb = c * 256 + sub * 64;
        s5_stage_u(Pu, tb + lane, g, ul, lane);
        for (int jb = 0; jb < 4; ++jb) {
#pragma unroll 4
            for (int jj = 0; jj < 16; ++jj) {
                s5_step(k, ul + (jb * 16 + jj) * 16, xr, xi);
                xl[jj * 136 + lane] = f2bf(xr); xl[jj * 136 + 64 + lane] = f2bf(xi);
            }
            asm volatile("s_waitcnt lgkmcnt(0)" ::: "memory");
            f32x4 y = {0.f, 0.f, 0.f, 0.f};
#pragma unroll
            for (int ks = 0; ks < 4; ++ks) { const bf16x8 af = *(const bf16x8*)(xl + fr * 136 + ks * 32 + fq * 8); y = MFMA16(af, cf[ks], y); }
            asm volatile("s_waitcnt lgkmcnt(0)" ::: "memory");
#pragma unroll
            for (int q = 0; q < 4; ++q) { const int tl = jb * 16 + fq * 4 + q; const float u = ul[tl * 16 + fr]; yg[(size_t)(tb + tl) * 512 + g * 16 + fr] = f2bf(gelu_tanh(y[q] + dsk * u)); }
        }
        asm volatile("s_waitcnt lgkmcnt(0)" ::: "memory");
    }
}
__device__ void gdn_prep_item(const Params& p, int layer, int item, unsigned char* lds) {
    unsigned char* ws = p.ws;
    const int tid = tidx(), wave = tid >> 6, lane = tid & 63, fr = lane & 15, fq = lane >> 4;
    const int n = item >> 3, h = item & 7, t0 = n * 64;
    bf16_t* qs = (bf16_t*)(lds); bf16_t* ks = (bf16_t*)(lds + 17408); bf16_t* vbT = (bf16_t*)(lds + 34816); bf16_t* kgT = (bf16_t*)(lds + 53248); bf16_t* kdT = (bf16_t*)(lds + 71680);
    float* Am = (float*)(lds + 90112); bf16_t* Tb = (bf16_t*)(lds + 107520); float* gcs = (float*)(lds + 116736); float* bts = (float*)(lds + 116992);
    const float* P32 = (const float*)(ws + O_P32); const bf16_t* Pqkv = (const bf16_t*)(ws + O_PQKV);
    if (wave == 0) {
        const int t = t0 + lane;
        const float a = P32[(size_t)t * 1536 + 1304 + h], b = P32[(size_t)t * 1536 + 1312 + h];
        const float g = -expf(p.in[24][layer * 8 + h]) * softplusf_(a + p.in[25][layer * 8 + h]);
        float s = g;
#pragma unroll
        for (int off = 1; off < 64; off <<= 1) { const float o = __shfl_up(s, off); if (lane >= off) s += o; }
        gcs[lane] = s; bts[lane] = sigmoidf_(b);
    }
    __syncthreads();
    {
        const int r = tid >> 3, c0 = (tid & 7) * 16;
        const float gcr = gcs[r], btr = bts[r], eg = expf(gcr), ed = expf(gcs[63] - gcr);
        const float* cw = p.in[23] + (size_t)layer * 4 * 3072;
#pragma unroll
        for (int which = 0; which < 3; ++which) {
            const int col = which * 1024 + h * 128 + c0;
            float acc[16];
#pragma unroll
            for (int e = 0; e < 16; ++e) acc[e] = 0.f;
#pragma unroll
            for (int j = 0; j < 4; ++j) {
                const int tr = t0 + r - 3 + j;
                if (tr >= 0) {
                    const u32x4* s = (const u32x4*)(Pqkv + (size_t)tr * 3072 + col); const u32x4 a = s[0], b = s[1];
                    const f32x4* wp = (const f32x4*)(cw + j * 3072 + col); const f32x4 w0 = wp[0], w1 = wp[1], w2 = wp[2], w3 = wp[3];
                    acc[0] += w0[0] * bflo(a.x); acc[1] += w0[1] * bfhi(a.x); acc[2] += w0[2] * bflo(a.y); acc[3] += w0[3] * bfhi(a.y);
                    acc[4] += w1[0] * bflo(a.z); acc[5] += w1[1] * bfhi(a.z); acc[6] += w1[2] * bflo(a.w); acc[7] += w1[3] * bfhi(a.w);
                    acc[8] += w2[0] * bflo(b.x); acc[9] += w2[1] * bfhi(b.x); acc[10] += w2[2] * bflo(b.y); acc[11] += w2[3] * bfhi(b.y);
                    acc[12] += w3[0] * bflo(b.z); acc[13] += w3[1] * bfhi(b.z); acc[14] += w3[2] * bflo(b.w); acc[15] += w3[3] * bfhi(b.w);
                }
            }
            float ss = 0.f;
#pragma unroll
            for (int e = 0; e < 16; ++e) { acc[e] = siluf_(acc[e]); ss += acc[e] * acc[e]; }
            ss += __shfl_xor(ss, 1); ss += __shfl_xor(ss, 2); ss += __shfl_xor(ss, 4);
            const float rn = rsqrtf(ss + 1e-6f);
            if (which == 0) {
                bf16_t* qg = (bf16_t*)(ws + O_GQG) + (size_t)item * 8192 + r * 128 + c0;
                float v[16];
#pragma unroll
                for (int e = 0; e < 16; ++e) v[e] = acc[e] * rn * 0.08838834764831845f;
                u32x4 w0, w1; w0.x = pk2(v[0], v[1]); w0.y = pk2(v[2], v[3]); w0.z = pk2(v[4], v[5]); w0.w = pk2(v[6], v[7]); w1.x = pk2(v[8], v[9]); w1.y = pk2(v[10], v[11]); w1.z = pk2(v[12], v[13]); w1.w = pk2(v[14], v[15]);
                *(u32x4*)(qs + r * 136 + c0) = w0; *(u32x4*)(qs + r * 136 + c0 + 8) = w1;
                u32x4 g0, g1; g0.x = pk2(v[0] * eg, v[1] * eg); g0.y = pk2(v[2] * eg, v[3] * eg); g0.z = pk2(v[4] * eg, v[5] * eg); g0.w = pk2(v[6] * eg, v[7] * eg);
                g1.x = pk2(v[8] * eg, v[9] * eg); g1.y = pk2(v[10] * eg, v[11] * eg); g1.z = pk2(v[12] * eg, v[13] * eg); g1.w = pk2(v[14] * eg, v[15] * eg);
                *(u32x4*)qg = g0; *(u32x4*)(qg + 8) = g1;
            } else if (which == 1) {
                float v[16];
#pragma unroll
                for (int e = 0; e < 16; ++e) v[e] = acc[e] * rn;
                u32x4 w0, w1; w0.x = pk2(v[0], v[1]); w0.y = pk2(v[2], v[3]); w0.z = pk2(v[4], v[5]); w0.w = pk2(v[6], v[7]); w1.x = pk2(v[8], v[9]); w1.y = pk2(v[10], v[11]); w1.z = pk2(v[12], v[13]); w1.w = pk2(v[14], v[15]);
                *(u32x4*)(ks + r * 136 + c0) = w0; *(u32x4*)(ks + r * 136 + c0 + 8) = w1;
#pragma unroll
                for (int e = 0; e < 16; ++e) { kgT[(c0 + e) * 72 + r] = f2bf(v[e] * btr * eg); kdT[(c0 + e) * 72 + r] = f2bf(v[e] * ed); }
            } else {
#pragma unroll
                for (int e = 0; e < 16; ++e) vbT[(c0 + e) * 72 + r] = f2bf(acc[e] * btr);
            }
        }
    }
    __syncthreads();
    {
        const int d = tid >> 2, sg = tid & 3;
        const u32x4 a = *(const u32x4*)(kdT + d * 72 + sg * 16), b = *(const u32x4*)(kdT + d * 72 + sg * 16 + 8);
        bf16_t* dst = (bf16_t*)(ws + O_GKD) + (size_t)item * 8192 + d * 64 + sg * 16; *(u32x4*)dst = a; *(u32x4*)(dst + 8) = b;
    }
    { float* Tmz = (float*)(lds + 117248); for (int e2 = tid; e2 < 64 * 68; e2 += 512) Tmz[e2] = 0.f; }
    {
        const int mi = wave >> 1;
        bf16_t* qko = (bf16_t*)(ws + O_GQK) + (size_t)item * 4096;
#pragma unroll
        for (int q = 0; q < 2; ++q) {
            const int nj = (wave & 1) * 2 + q;
            f32x4 kk = {0.f, 0.f, 0.f, 0.f}, qk = {0.f, 0.f, 0.f, 0.f};
            if (nj <= mi) {
#pragma unroll
                for (int s = 0; s < 4; ++s) {
                    const bf16x8 bk = *(const bf16x8*)(ks + (nj * 16 + fr) * 136 + s * 32 + fq * 8);
                    const bf16x8 ak = *(const bf16x8*)(ks + (mi * 16 + fr) * 136 + s * 32 + fq * 8);
                    const bf16x8 aq = *(const bf16x8*)(qs + (mi * 16 + fr) * 136 + s * 32 + fq * 8);
                    kk = MFMA16(ak, bk, kk); qk = MFMA16(aq, bk, qk);
                }
            }
            const int j = nj * 16 + fr; const float gj = gcs[j];
#pragma unroll
            for (int e = 0; e < 4; ++e) {
                const int i = mi * 16 + fq * 4 + e;
                const float dec = (j <= i) ? expf(gcs[i] - gj) : 0.f;
                Am[i * 68 + j] = (j < i) ? bts[i] * kk[e] * dec : 0.f;
                qko[i * 64 + j] = f2bf((j <= i) ? qk[e] * dec : 0.f);
            }
        }
    }
    __syncthreads();
    {
        float* Tm = (float*)(lds + 117248); float* Ps = (float*)(lds + 134656) + wave * 320;
        if (wave == 0) {
            const int bo = fq * 16; float t[16];
#pragma unroll
            for (int i = 0; i < 16; ++i) {
                float s = (i == fr) ? 1.f : 0.f;
#pragma unroll
                for (int j = 0; j < i; ++j) s -= Am[(bo + i) * 68 + bo + j] * t[j];
                t[i] = s; Tm[(bo + i) * 68 + bo + fr] = s;
            }
        }
        asm volatile("s_waitcnt lgkmcnt(0)" ::: "memory"); __syncthreads();
#pragma unroll
        for (int d = 1; d < 4; ++d) {
            if (wave < 4 - d) {
                const int bi = wave + d, bj = wave;
                f32x4 Q = {0.f, 0.f, 0.f, 0.f};
                for (int kb = bj; kb < bi; ++kb) {
                    const float* X = Am + (bi * 16) * 68 + kb * 16; const float* Y = Tm + (kb * 16) * 68 + bj * 16;
#pragma unroll
                    for (int s = 0; s < 4; ++s) Q = __builtin_amdgcn_mfma_f32_16x16x4f32(X[fr * 68 + 4 * s + fq], Y[(4 * s + fq) * 68 + fr], Q, 0, 0, 0);
                }
#pragma unroll
                for (int e2 = 0; e2 < 4; ++e2) Ps[(fq * 4 + e2) * 20 + fr] = Q[e2];
                asm volatile("s_waitcnt lgkmcnt(0)" ::: "memory");
                f32x4 R = {0.f, 0.f, 0.f, 0.f};
                const float* X = Tm + (bi * 16) * 68 + bi * 16;
#pragma unroll
                for (int s = 0; s < 4; ++s) R = __builtin_amdgcn_mfma_f32_16x16x4f32(X[fr * 68 + 4 * s + fq], Ps[(4 * s + fq) * 20 + fr], R, 0, 0, 0);
#pragma unroll
                for (int e2 = 0; e2 < 4; ++e2) Tm[(bi * 16 + fq * 4 + e2) * 68 + bj * 16 + fr] = -R[e2];
            }
            asm volatile("s_waitcnt lgkmcnt(0)" ::: "memory"); __syncthreads();
        }
        for (int e2 = tid; e2 < 4096; e2 += 512) { const int r = e2 >> 6, c = e2 & 63; Tb[r * 72 + c] = f2bf(Tm[r * 68 + c]); }
    }
    __syncthreads();
    {
        const int mi = wave & 3;
        const bf16x8 a0 = *(const bf16x8*)(Tb + (mi * 16 + fr) * 72 + fq * 8), a1 = *(const bf16x8*)(Tb + (mi * 16 + fr) * 72 + 32 + fq * 8);
        float* vo = (float*)(ws + O_GVAL) + (size_t)item * 8192; bf16_t* ko = (bf16_t*)(ws + O_GKC) + (size_t)item * 8192;
#pragma unroll
        for (int q = 0; q < 4; ++q) {
            const int nt = (wave >> 2) * 4 + q;
            f32x4 v = {0.f, 0.f, 0.f, 0.f}, kc = {0.f, 0.f, 0.f, 0.f};
            v = MFMA16(a0, *(const bf16x8*)(vbT + (nt * 16 + fr) * 72 + fq * 8), v); v = MFMA16(a1, *(const bf16x8*)(vbT + (nt * 16 + fr) * 72 + 32 + fq * 8), v);
            kc = MFMA16(a0, *(const bf16x8*)(kgT + (nt * 16 + fr) * 72 + fq * 8), kc); kc = MFMA16(a1, *(const bf16x8*)(kgT + (nt * 16 + fr) * 72 + 32 + fq * 8), kc);
#pragma unroll
            for (int e = 0; e < 4; ++e) { const int i = mi * 16 + fq * 4 + e, d = nt * 16 + fr; vo[i * 128 + d] = v[e]; ko[i * 128 + d] = f2bf(kc[e]); }
        }
    }
    if (tid == 0) ((float*)(ws + O_GEGL))[item] = expf(gcs[63]);
    __syncthreads();
}

struct GdnUO { bf16x8 kc[4], qg[4], qk[2]; float val[2][4]; };
struct GdnSU { bf16x8 kd[2][2]; float egl; };
__device__ __forceinline__ void gdn_load_uo(const unsigned char* ws, int item, int mt, int fr, int fq, int dvb, GdnUO& f) {
    const bf16_t* kc = (const bf16_t*)(ws + O_GKC) + (size_t)item * 8192 + (mt * 16 + fr) * 128 + fq * 8;
    const bf16_t* qg = (const bf16_t*)(ws + O_GQG) + (size_t)item * 8192 + (mt * 16 + fr) * 128 + fq * 8;
    const bf16_t* qk = (const bf16_t*)(ws + O_GQK) + (size_t)item * 4096 + (mt * 16 + fr) * 64 + fq * 8;
    const float* vl = (const float*)(ws + O_GVAL) + (size_t)item * 8192 + (mt * 16 + fq * 4) * 128 + dvb + fr;
#pragma unroll
    for (int s = 0; s < 4; ++s) { f.kc[s] = *(const bf16x8*)(kc + s * 32); f.qg[s] = *(const bf16x8*)(qg + s * 32); }
#pragma unroll
    for (int s = 0; s < 2; ++s) f.qk[s] = *(const bf16x8*)(qk + s * 32);
#pragma unroll
    for (int nt = 0; nt < 2; ++nt)
#pragma unroll
        for (int e = 0; e < 4; ++e) f.val[nt][e] = vl[e * 128 + nt * 16];
}
__device__ __forceinline__ void gdn_load_su(const unsigned char* ws, int item, int w4, int fr, int fq, GdnSU& f) {
    const bf16_t* kd = (const bf16_t*)(ws + O_GKD) + (size_t)item * 8192 + (2 * w4 * 16 + fr) * 64 + fq * 8;
#pragma unroll
    for (int s = 0; s < 2; ++s) { f.kd[0][s] = *(const bf16x8*)(kd + s * 32); f.kd[1][s] = *(const bf16x8*)(kd + 16 * 64 + s * 32); }
    f.egl = ((const float*)(ws + O_GEGL))[item];
}
#define GDN_BAR() do { asm volatile("s_waitcnt lgkmcnt(0)" ::: "memory"); __builtin_amdgcn_s_barrier(); asm volatile("" ::: "memory"); } while (0)
__device__ __forceinline__ void gdn_step_uo(const GdnUO& c, bf16_t* Sl, bf16_t* vn, float* go, int n, int h, int mt, int fr, int fq, int dvb) {
    bf16x8 Sb[2][4];
#pragma unroll
    for (int nt = 0; nt < 2; ++nt)
#pragma unroll
        for (int s = 0; s < 4; ++s) Sb[nt][s] = *(const bf16x8*)(Sl + nt * (16 * 136) + fr * 136 + s * 32 + fq * 8);
    f32x4 U[2], O[2];
#pragma unroll
    for (int nt = 0; nt < 2; ++nt) { U[nt] = (f32x4){0.f, 0.f, 0.f, 0.f}; O[nt] = (f32x4){0.f, 0.f, 0.f, 0.f};
#pragma unroll
        for (int s = 0; s < 4; ++s) U[nt] = MFMA16(c.kc[s], Sb[nt][s], U[nt]);
        u32x2 w; w.x = pk2(c.val[nt][0] - U[nt][0], c.val[nt][1] - U[nt][1]); w.y = pk2(c.val[nt][2] - U[nt][2], c.val[nt][3] - U[nt][3]);
        *(u32x2*)(vn + nt * (16 * 72) + fr * 72 + mt * 16 + fq * 4) = w; }
#pragma unroll
    for (int nt = 0; nt < 2; ++nt)
#pragma unroll
        for (int s = 0; s < 4; ++s) O[nt] = MFMA16(c.qg[s], Sb[nt][s], O[nt]);
    GDN_BAR();
#pragma unroll
    for (int nt = 0; nt < 2; ++nt) {
        const bf16x8 V0 = *(const bf16x8*)(vn + nt * (16 * 72) + fr * 72 + fq * 8), V1 = *(const bf16x8*)(vn + nt * (16 * 72) + fr * 72 + 32 + fq * 8);
        O[nt] = MFMA16(c.qk[0], V0, O[nt]); O[nt] = MFMA16(c.qk[1], V1, O[nt]);
#pragma unroll
        for (int e = 0; e < 4; ++e) go[(size_t)(n * 64 + mt * 16 + fq * 4 + e) * 1024 + h * 128 + dvb + nt * 16 + fr] = O[nt][e];
    }
    GDN_BAR();
}
__device__ __forceinline__ void gdn_step_su(const GdnSU& c, f32x4 (&St)[2][2], bf16_t* Sl, const bf16_t* vn, int w4, int fr, int fq) {
    GDN_BAR();
#pragma unroll
    for (int nt = 0; nt < 2; ++nt) {
        const bf16x8 V0 = *(const bf16x8*)(vn + nt * (16 * 72) + fr * 72 + fq * 8), V1 = *(const bf16x8*)(vn + nt * (16 * 72) + fr * 72 + 32 + fq * 8);
#pragma unroll
        for (int q = 0; q < 2; ++q) {
            St[nt][q] = St[nt][q] * c.egl;
            St[nt][q] = MFMA16(V0, c.kd[q][0], St[nt][q]); St[nt][q] = MFMA16(V1, c.kd[q][1], St[nt][q]);
#pragma unroll
            for (int e = 0; e < 4; ++e) Sl[nt * (16 * 136) + (fq * 4 + e) * 136 + (2 * w4 + q) * 16 + fr] = f2bf(St[nt][q][e]);
        }
    }
    GDN_BAR();
}
__device__ void gdn_recurrence(const Params& p, int b, unsigned char* lds) {
    const unsigned char* ws = p.ws;
    const int tid = tidx(), wave = tid >> 6, lane = tid & 63, fr = lane & 15, fq = lane >> 4;
    const int h = b >> 2, dvb = (b & 3) * 32;
    bf16_t* Sl = (bf16_t*)lds; bf16_t* vn = (bf16_t*)(lds + 2 * 16 * 136 * 2);
    float* go = (float*)(p.ws + O_PQKV);
    for (int e = tid; e < 2 * 16 * 136; e += 512) Sl[e] = 0;
    __syncthreads();
    if (wave < 4) {
        const int mt = wave;
        GdnUO f0, f1, f2;
        gdn_load_uo(ws, h, mt, fr, fq, dvb, f0); gdn_load_uo(ws, 8 + h, mt, fr, fq, dvb, f1);
        for (int n = 0; n < 255; n += 3) {
            gdn_load_uo(ws, (n + 2) * 8 + h, mt, fr, fq, dvb, f2); gdn_step_uo(f0, Sl, vn, go, n, h, mt, fr, fq, dvb);
            gdn_load_uo(ws, (n + 3) * 8 + h, mt, fr, fq, dvb, f0); gdn_step_uo(f1, Sl, vn, go, n + 1, h, mt, fr, fq, dvb);
            if (n + 4 < 256) gdn_load_uo(ws, (n + 4) * 8 + h, mt, fr, fq, dvb, f1);
            gdn_step_uo(f2, Sl, vn, go, n + 2, h, mt, fr, fq, dvb);
        }
        gdn_step_uo(f0, Sl, vn, go, 255, h, mt, fr, fq, dvb);
    } else {
        const int w4 = wave - 4;
        f32x4 St[2][2];
#pragma unroll
        for (int a = 0; a < 2; ++a)
#pragma unroll
            for (int c = 0; c < 2; ++c) St[a][c] = (f32x4){0.f, 0.f, 0.f, 0.f};
        GdnSU f0, f1, f2;
        gdn_load_su(ws, h, w4, fr, fq, f0); gdn_load_su(ws, 8 + h, w4, fr, fq, f1);
        for (int n = 0; n < 255; n += 3) {
            gdn_load_su(ws, (n + 2) * 8 + h, w4, fr, fq, f2); gdn_step_su(f0, St, Sl, vn, w4, fr, fq);
            gdn_load_su(ws, (n + 3) * 8 + h, w4, fr, fq, f0); gdn_step_su(f1, St, Sl, vn, w4, fr, fq);
            if (n + 4 < 256) gdn_load_su(ws, (n + 4) * 8 + h, w4, fr, fq, f1);
            gdn_step_su(f2, St, Sl, vn, w4, fr, fq);
        }
        gdn_step_su(f0, St, Sl, vn, w4, fr, fq);
    }
}
struct KVF { bf16x8 k[4][2]; };
__device__ __forceinline__ void kv_load(const bf16_t* kp, int ldk, KVF& f) {
#pragma unroll
    for (int s = 0; s < 4; ++s) { f.k[s][0] = *(const bf16x8*)(kp + (size_t)(s * 16) * ldk); f.k[s][1] = *(const bf16x8*)(kp + (size_t)(s * 16) * ldk + 32); }
}
template <int CTRL> __device__ __forceinline__ float dppf(float v) { return __int_as_float(__builtin_amdgcn_update_dpp(0, __float_as_int(v), CTRL, 0xF, 0xF, true)); }
template <int CTRL> __device__ __forceinline__ unsigned dppu(unsigned v) { return (unsigned)__builtin_amdgcn_update_dpp(0, (int)v, CTRL, 0xF, 0xF, true); }
__device__ __forceinline__ float rmax16(float v) { v = vmaxf(v, dppf<0xB1>(v)); v = vmaxf(v, dppf<0x4E>(v)); v = vmaxf(v, dppf<0x124>(v)); v = vmaxf(v, dppf<0x128>(v)); return v; }
__device__ __forceinline__ float rsum16(float v) { v += dppf<0xB1>(v); v += dppf<0x4E>(v); v += dppf<0x124>(v); v += dppf<0x128>(v); return v; }
template <int CTRL> __device__ __forceinline__ unsigned long long dppmax64(unsigned long long b) { const unsigned lo = dppu<CTRL>((unsigned)b), hi = dppu<CTRL>((unsigned)(b >> 32)); const unsigned long long ob = ((unsigned long long)hi << 32) | lo; return ob > b ? ob : b; }
#define MFMA8(a, b, c) __builtin_amdgcn_mfma_f32_16x16x32_fp8_fp8((a), (b), (c), 0, 0, 0)
__device__ __forceinline__ long mk64(unsigned lo, unsigned hi) { return (long)(((unsigned long long)hi << 32) | lo); }
__device__ __forceinline__ long bf8_to_fp8(bf16x8 v) {
    const u32x4 w = __builtin_bit_cast(u32x4, v);
    int a = __builtin_amdgcn_cvt_pk_fp8_f32(bflo(w.x), bfhi(w.x), 0, false); a = __builtin_amdgcn_cvt_pk_fp8_f32(bflo(w.y), bfhi(w.y), a, true);
    int b = __builtin_amdgcn_cvt_pk_fp8_f32(bflo(w.z), bfhi(w.z), 0, false); b = __builtin_amdgcn_cvt_pk_fp8_f32(bflo(w.w), bfhi(w.w), b, true);
    return mk64((unsigned)a, (unsigned)b);
}
struct K8F { u32x4 k[4]; };
__device__ __forceinline__ void k8_load(const unsigned char* kp, K8F& f) {
#pragma unroll
    for (int s = 0; s < 4; ++s) f.k[s] = *(const u32x4*)(kp + s * 1024);
}
__device__ __forceinline__ void softmax_pv(const f32x4 (&S)[4], const u32x4 (&Vw)[4], unsigned vmask, float (&m)[4], float (&l)[4], f32x4 (&O)[4], unsigned char* Pt, int fr, int fq) {
    float mx[4];
#pragma unroll
    for (int j = 0; j < 4; ++j) { float v = -1e30f;
#pragma unroll
        for (int s = 0; s < 4; ++s) v = ((vmask >> s) & 1u) ? vmaxf(v, S[s][j]) : v;
        mx[j] = rmax16(v); }
#pragma unroll
    for (int j = 0; j < 4; ++j) { const float mn = vmaxf(m[j], mx[j]); const float a = __builtin_amdgcn_exp2f(m[j] - mn); m[j] = mn; l[j] *= a;
#pragma unroll
        for (int dt = 0; dt < 4; ++dt) O[dt][j] *= a; }
#pragma unroll
    for (int j = 0; j < 4; ++j) { float pv[4];
#pragma unroll
        for (int s = 0; s < 4; ++s) { pv[s] = ((vmask >> s) & 1u) ? __builtin_amdgcn_exp2f(S[s][j] - m[j]) : 0.f; l[j] += pv[s]; }
        int t = __builtin_amdgcn_cvt_pk_fp8_f32(pv[0] * 256.f, pv[1] * 256.f, 0, false); t = __builtin_amdgcn_cvt_pk_fp8_f32(pv[2] * 256.f, pv[3] * 256.f, t, true);
        *(unsigned*)(Pt + (fq * 4 + j) * 72 + fr * 4) = (unsigned)t; }
    asm volatile("s_waitcnt lgkmcnt(0)" ::: "memory");
    const u32x2 p0 = *(const u32x2*)(Pt + fr * 72 + fq * 8), p1 = *(const u32x2*)(Pt + fr * 72 + 32 + fq * 8);
    asm volatile("s_waitcnt lgkmcnt(0)" ::: "memory");
    const long P0 = mk64(p0.x, p0.y), P1 = mk64(p1.x, p1.y);
#pragma unroll
    for (int dt = 0; dt < 4; ++dt) { O[dt] = MFMA8(P0, mk64(Vw[dt].x, Vw[dt].y), O[dt]); O[dt] = MFMA8(P1, mk64(Vw[dt].z, Vw[dt].w), O[dt]); }
}
__device__ __forceinline__ void flash_compute(const bf16x8 (&Qf)[2], KVF& f, const bf16_t* knext, int ldk, const unsigned char* vp, unsigned vmask, float (&m)[4], float (&l)[4], f32x4 (&O)[4], unsigned char* Pt, int fr, int fq) {
    f32x4 S[4]; u32x4 Vw[4];
#pragma unroll
    for (int dt = 0; dt < 4; ++dt) Vw[dt] = *(const u32x4*)(vp + dt * 1024);
#pragma unroll
    for (int s = 0; s < 4; ++s) { S[s] = (f32x4){0.f, 0.f, 0.f, 0.f}; S[s] = MFMA16(Qf[0], f.k[s][0], S[s]); S[s] = MFMA16(Qf[1], f.k[s][1], S[s]); }
    if (knext) kv_load(knext, ldk, f);
    softmax_pv(S, Vw, vmask, m, l, O, Pt, fr, fq);
}
struct V8F { u32x4 v[4]; };
__device__ __forceinline__ void v8_load(const unsigned char* vp, V8F& f) {
#pragma unroll
    for (int dt = 0; dt < 4; ++dt) f.v[dt] = *(const u32x4*)(vp + dt * 1024);
}
__device__ __forceinline__ void flash_compute8(const long (&Q8)[2], const K8F& f, const V8F& vf, unsigned vmask, float (&m)[4], float (&l)[4], f32x4 (&O)[4], unsigned char* Pt, int fr, int fq) {
    f32x4 S[4];
#pragma unroll
    for (int s = 0; s < 4; ++s) { S[s] = (f32x4){0.f, 0.f, 0.f, 0.f}; S[s] = MFMA8(Q8[0], mk64(f.k[s].x, f.k[s].y), S[s]); S[s] = MFMA8(Q8[1], mk64(f.k[s].z, f.k[s].w), S[s]); }
    softmax_pv(S, vf.v, vmask, m, l, O, Pt, fr, fq);
}
template <int BR> struct BranchIt {
    const bf16_t* kb; const unsigned char* kb8; const unsigned char* vb; const unsigned* flg; int last, trow, fr, fq;
    static constexpr int LDK = 64;
    __device__ __forceinline__ int next(int from) const {
        if (BR == 1) { int jb = from; while (jb <= last && flg[jb] == 0u) ++jb; return jb <= last ? jb : -1; }
        return from <= last ? from : -1;
    }
    __device__ __forceinline__ const unsigned char* vptr(int idx) const { return vb + (size_t)idx * 4096; }
    __device__ __forceinline__ const bf16_t* kptr(int idx) const { return kb + (size_t)(idx * 64) * LDK; }
    __device__ __forceinline__ const unsigned char* kptr8(int idx) const { return kb8 + (size_t)idx * 4096; }
    __device__ __forceinline__ unsigned mask(int idx) const {
        unsigned vm = 0; const int key0 = idx * 64;
        if (BR == 0) {
#pragma unroll
            for (int s = 0; s < 4; ++s) vm |= ((16 * (key0 + s * 16 + fr) + 31 <= trow) ? 1u : 0u) << s;
        } else if (BR == 1) {
            const bool rowsel = (flg[idx] >> fq) & 1u;
#pragma unroll
            for (int s = 0; s < 4; ++s) vm |= ((rowsel && (key0 + s * 16 + fr <= trow)) ? 1u : 0u) << s;
        } else {
#pragma unroll
            for (int s = 0; s < 4; ++s) { const int kpos = key0 + s * 16 + fr; vm |= ((kpos <= trow && kpos > trow - 512) ? 1u : 0u) << s; }
        }
        return vm;
    }
};
template <int BR> __device__ __forceinline__ void run_branch(const BranchIt<BR>& it, int first, const bf16x8 (&Qf)[2], const long (&Q8)[2], float (&m)[4], float (&l)[4], f32x4 (&O)[4], unsigned char* Pt) {
#pragma unroll
    for (int j = 0; j < 4; ++j) { m[j] = -1e30f; l[j] = 0.f; O[j] = (f32x4){0.f, 0.f, 0.f, 0.f}; }
    int ia = it.next(first);
    if (ia < 0) return;
    if (BR == 0) {
        KVF A; kv_load(it.kptr(ia), BranchIt<BR>::LDK, A);
        while (ia >= 0) {
            const int ib = it.next(ia + 1);
            flash_compute(Qf, A, ib >= 0 ? it.kptr(ib) : nullptr, BranchIt<BR>::LDK, it.vptr(ia), it.mask(ia), m, l, O, Pt, it.fr, it.fq);
            ia = ib;
        }
    } else {
        K8F kA, kB; V8F vA, vB; k8_load(it.kptr8(ia), kA); v8_load(it.vptr(ia), vA);
        for (;;) {
            const int ib = it.next(ia + 1), ibc = ib >= 0 ? ib : ia;
            k8_load(it.kptr8(ibc), kB); v8_load(it.vptr(ibc), vB);
            flash_compute8(Q8, kA, vA, it.mask(ia), m, l, O, Pt, it.fr, it.fq);
            if (ib < 0) break;
            const int ic = it.next(ib + 1), icc = ic >= 0 ? ic : ib;
            k8_load(it.kptr8(icc), kA); v8_load(it.vptr(icc), vA);
            flash_compute8(Q8, kB, vB, it.mask(ib), m, l, O, Pt, it.fr, it.fq);
            if (ic < 0) break;
            ia = ic;
        }
    }
}
__device__ __forceinline__ void branch_finish(float (&l)[4], f32x4 (&O)[4], const float* grow, int br, int hk, float* ybp  ) {
#pragma unroll
    for (int j = 0; j < 4; ++j) { const float s = rsum16(l[j]);
        const float g = sigmoidf_(grow[(hk * 4 + j) * 3 + br]) * 0.00390625f / fmaxf(s, 1e-30f);
#pragma unroll
        for (int dt = 0; dt < 4; ++dt) { float* q = ybp + j * 64 + dt * 16; if (br == 0) *q = g * O[dt][j]; else *q += g * O[dt][j]; } }
}
constexpr int NSA_WLDS = 15680;
__device__ void nsa_wave_task(const Params& p, int layer, int t0, unsigned char* wl) {
    unsigned char* ws = p.ws;
    const int lane = tidx() & 63, fr = lane & 15, fq = lane >> 4;
    float* imp = (float*)wl; unsigned* flg = (unsigned*)(wl + 4160); unsigned char* Pt = wl + 5184; float* yb = (float*)(wl + 7488);
    const bf16_t* qn = (const bf16_t*)(ws + O_QN); const unsigned char* ks8 = ws + O_KSN; const unsigned char* kw8 = ws + O_KWN;
    const unsigned char* vsT = ws + O_VST; const unsigned char* vwT = ws + O_VWT; const bf16_t* kc = (const bf16_t*)(ws + O_KC); const unsigned char* vcT = ws + O_VCT;
    const int trow = t0 + fq;
    const float* grow = (const float*)(ws + O_P32) + (size_t)trow * 1536 + 1280;
    const int tmax = t0 + 3;
    for (int hk = 0; hk < 2; ++hk) {
        bf16x8 Qf[2];
        { const bf16_t* qp = qn + (size_t)(t0 + (fr >> 2)) * 512 + (hk * 4 + (fr & 3)) * 64 + fq * 8; Qf[0] = *(const bf16x8*)qp; Qf[1] = *(const bf16x8*)(qp + 32); }
        long Q8[2]; Q8[0] = bf8_to_fp8(Qf[0]); Q8[1] = bf8_to_fp8(Qf[1]);
        float* ybp = yb + fq * 512 + hk * 256 + fr;
        float m[4], l[4]; f32x4 O[4];
        const int ncmp_t = tmax >= 31 ? ((((tmax - 31) >> 4) >> 6) + 1) : 0;
        const bf16_t* kcb = kc + ((size_t)hk * 1024 + fr) * 64 + fq * 8;
        { BranchIt<0> it{kcb, nullptr, vcT + (size_t)hk * 16 * 4096 + fr * 64 + fq * 16, nullptr, ncmp_t - 1, trow, fr, fq}; run_branch<0>(it, 0, Qf, Q8, m, l, O, Pt); }
        float linv[4];
#pragma unroll
        for (int j = 0; j < 4; ++j) { const float s = rsum16(l[j]); linv[j] = s > 0.f ? 1.0f / s : 0.f; }
        branch_finish(l, O, grow, 0, hk, ybp);
        for (int e = lane; e < 4 * 260; e += 64) imp[e] = 0.f;
        for (int e = lane; e < 256; e += 64) flg[e] = 0u;
        asm volatile("s_waitcnt lgkmcnt(0)" ::: "memory");
        {
            KVF ka;
            if (ncmp_t > 0) kv_load(kcb, 64, ka);
            for (int kt = 0; kt < ncmp_t; ++kt) {
                const int key0 = kt * 64;
                f32x4 S[4];
#pragma unroll
                for (int s = 0; s < 4; ++s) { S[s] = (f32x4){0.f, 0.f, 0.f, 0.f}; S[s] = MFMA16(Qf[0], ka.k[s][0], S[s]); S[s] = MFMA16(Qf[1], ka.k[s][1], S[s]); }
                if (kt + 1 < ncmp_t) kv_load(kcb + (size_t)(key0 + 64) * 64, 64, ka);
#pragma unroll
                for (int s = 0; s < 4; ++s) {
                    const int nn = key0 + s * 16 + fr; const bool valid = 16 * nn + 31 <= trow;
                    float ps = 0.f;
#pragma unroll
                    for (int j = 0; j < 4; ++j) ps += valid ? __builtin_amdgcn_exp2f(S[s][j] - m[j]) * linv[j] : 0.f;
                    float p4 = ps; p4 += dppf<0xB1>(p4); p4 += dppf<0x4E>(p4);
                    if ((fr & 3) == 0) imp[fq * 260 + (nn >> 2)] += p4;
                    asm volatile("s_waitcnt lgkmcnt(0)" ::: "memory");
                    if ((fr & 3) == 3) imp[fq * 260 + (nn >> 2) + 1] += ps;
                    asm volatile("s_waitcnt lgkmcnt(0)" ::: "memory");
                }
            }
        }
#ifdef OLD_TOPK
        for (int tok = 0; tok < 4; ++tok) {
            const int t = t0 + tok, cur = t >> 6, nsel = cur + 1 < 16 ? cur + 1 : 16;
            unsigned long long key[4];
#pragma unroll
            for (int i = 0; i < 4; ++i) { const int j = lane + 64 * i; unsigned long long k = 0ull;
                if (j <= cur) { const bool forced = (j == 0) || (j == cur) || (j == cur - 1); const unsigned vb = forced ? 0x7F800000u : __float_as_uint(imp[tok * 260 + j]); k = ((unsigned long long)vb << 32) | (unsigned)(0xFFFF - j); }
                key[i] = k; }
            for (int it2 = 0; it2 < nsel; ++it2) {
                unsigned long long best = key[0]; best = key[1] > best ? key[1] : best; best = key[2] > best ? key[2] : best; best = key[3] > best ? key[3] : best;
#pragma unroll
                for (int o = 32; o >= 1; o >>= 1) { const unsigned lo = __shfl_xor((unsigned)best, o), hi = __shfl_xor((unsigned)(best >> 32), o); const unsigned long long ob = ((unsigned long long)hi << 32) | lo; best = ob > best ? ob : best; }
                const int jsel = 0xFFFF - (int)(best & 0xFFFFu);
#pragma unroll
                for (int i = 0; i < 4; ++i) if (key[i] == best) key[i] = 0ull;
                if (lane == 0) flg[jsel] |= (1u << tok);
            }
        }
#else
        {
            unsigned long long key[4][4];
#pragma unroll
            for (int tok = 0; tok < 4; ++tok) { const int cur = (t0 + tok) >> 6;
#pragma unroll
                for (int i = 0; i < 4; ++i) { const int j = lane + 64 * i; unsigned long long k = 0ull;
                    if (j <= cur) { const bool forced = (j == 0) || (j == cur) || (j == cur - 1); const unsigned vb = forced ? 0x7F800000u : __float_as_uint(imp[tok * 260 + j]); k = ((unsigned long long)vb << 32) | (unsigned)(0xFFFF - j); }
                    key[tok][i] = k; } }
            for (int itn = 0; itn < 16; ++itn) {
                unsigned long long best[4];
#pragma unroll
                for (int tok = 0; tok < 4; ++tok) { unsigned long long b0 = key[tok][0]; b0 = key[tok][1] > b0 ? key[tok][1] : b0; b0 = key[tok][2] > b0 ? key[tok][2] : b0; b0 = key[tok][3] > b0 ? key[tok][3] : b0; best[tok] = b0; }
#pragma unroll
                for (int tok = 0; tok < 4; ++tok) { best[tok] = dppmax64<0xB1>(best[tok]); best[tok] = dppmax64<0x4E>(best[tok]); best[tok] = dppmax64<0x124>(best[tok]); best[tok] = dppmax64<0x128>(best[tok]); }
#pragma unroll
                for (int o = 16; o <= 32; o <<= 1) {
#pragma unroll
                    for (int tok = 0; tok < 4; ++tok) { const unsigned lo = __shfl_xor((unsigned)best[tok], o), hi = __shfl_xor((unsigned)(best[tok] >> 32), o); const unsigned long long ob = ((unsigned long long)hi << 32) | lo; best[tok] = ob > best[tok] ? ob : best[tok]; }
                }
#pragma unroll
                for (int tok = 0; tok < 4; ++tok) {
                    if (best[tok] != 0ull) {
#pragma unroll
                        for (int i = 0; i < 4; ++i) if (key[tok][i] == best[tok]) key[tok][i] = 0ull;
                        if (lane == 0) flg[0xFFFF - (int)(best[tok] & 0xFFFFu)] |= (1u << tok);
                    }
                }
            }
        }
#endif
        asm volatile("s_waitcnt lgkmcnt(0)" ::: "memory");
        { BranchIt<1> it{nullptr, ks8 + (size_t)hk * 256 * 4096 + fr * 64 + fq * 16, vsT + (size_t)hk * 256 * 4096 + fr * 64 + fq * 16, flg, tmax >> 6, trow, fr, fq}; run_branch<1>(it, 0, Qf, Q8, m, l, O, Pt); }
        branch_finish(l, O, grow, 1, hk, ybp);
        { BranchIt<2> it{nullptr, kw8 + (size_t)hk * 256 * 4096 + fr * 64 + fq * 16, vwT + (size_t)hk * 256 * 4096 + fr * 64 + fq * 16, nullptr, tmax >> 6, trow, fr, fq}; run_branch<2>(it, t0 - 511 > 0 ? ((t0 - 511) >> 6) : 0, Qf, Q8, m, l, O, Pt); }
        branch_finish(l, O, grow, 2, hk, ybp);
    }
    asm volatile("s_waitcnt lgkmcnt(0)" ::: "memory");
    bf16_t* mix = (bf16_t*)(ws + O_HN);
    const float* gn = p.in[12] + (size_t)layer * 512;
    for (int tok = 0; tok < 4; ++tok) {
        const f32x4 a = *(const f32x4*)(yb + tok * 512 + lane * 8), b = *(const f32x4*)(yb + tok * 512 + lane * 8 + 4);
        float ss = a[0] * a[0] + a[1] * a[1] + a[2] * a[2] + a[3] * a[3] + b[0] * b[0] + b[1] * b[1] + b[2] * b[2] + b[3] * b[3];
        ss = wave_sum(ss);
        const float rs = rsqrtf(ss * (1.0f / 512.0f) + 1e-6f);
        const f32x4 g0 = *(const f32x4*)(gn + lane * 8), g1 = *(const f32x4*)(gn + lane * 8 + 4);
        u32x4 w; w.x = pk2(a[0] * rs * g0[0], a[1] * rs * g0[1]); w.y = pk2(a[2] * rs * g0[2], a[3] * rs * g0[3]); w.z = pk2(b[0] * rs * g1[0], b[1] * rs * g1[1]); w.w = pk2(b[2] * rs * g1[2], b[3] * rs * g1[3]);
        *(u32x4*)(mix + (size_t)(t0 + tok) * DM + lane * 8) = w;
    }
    asm volatile("s_waitcnt lgkmcnt(0)" ::: "memory");
}

__device__ void phase_finalize(const Params& p, int layer) {
    unsigned char* ws = p.ws;
    const int wave = tidx() >> 6, lane = tidx() & 63;
    const float* yglu = (const float*)(ws + O_YGLU); const float* go = (const float*)(ws + O_PQKV); const bf16_t* Pz = (const bf16_t*)(ws + O_PZ); bf16_t* mix = (bf16_t*)(ws + O_HN);
    const float* gs = p.in[22] + (size_t)layer * 512 + lane * 8; const float* gg = p.in[26] + (size_t)layer * 128 + (lane & 7) * 16;
    for (int t = blockIdx.x * 8 + wave; t < T_; t += gridDim.x * 8) {
        {
            const f32x4 a = *(const f32x4*)(yglu + (size_t)t * 512 + lane * 8), b = *(const f32x4*)(yglu + (size_t)t * 512 + lane * 8 + 4);
            float ss = a[0] * a[0] + a[1] * a[1] + a[2] * a[2] + a[3] * a[3] + b[0] * b[0] + b[1] * b[1] + b[2] * b[2] + b[3] * b[3];
            ss = wave_sum(ss); const float rs = rsqrtf(ss * (1.0f / 512.0f) + 1e-6f);
            const f32x4 g0 = *(const f32x4*)gs, g1 = *(const f32x4*)(gs + 4);
            u32x4 w; w.x = pk2(a[0] * rs * g0[0], a[1] * rs * g0[1]); w.y = pk2(a[2] * rs * g0[2], a[3] * rs * g0[3]); w.z = pk2(b[0] * rs * g1[0], b[1] * rs * g1[1]); w.w = pk2(b[2] * rs * g1[2], b[3] * rs * g1[3]);
            *(u32x4*)(mix + (size_t)t * DM + 512 + lane * 8) = w;
        }
        {
            f32x4 o[4]; float ss = 0.f;
#pragma unroll
            for (int q = 0; q < 4; ++q) { o[q] = *(const f32x4*)(go + (size_t)t * 1024 + lane * 16 + q * 4); ss += o[q][0] * o[q][0] + o[q][1] * o[q][1] + o[q][2] * o[q][2] + o[q][3] * o[q][3]; }
            ss += __shfl_xor(ss, 1); ss += __shfl_xor(ss, 2); ss += __shfl_xor(ss, 4);
            const float rs = rsqrtf(ss * (1.0f / 128.0f) + 1e-6f);
            const u32x4 z0 = *(const u32x4*)(Pz + (size_t)t * 1024 + lane * 16), z1 = *(const u32x4*)(Pz + (size_t)t * 1024 + lane * 16 + 8);
            float zz[16] = {bflo(z0.x), bfhi(z0.x), bflo(z0.y), bfhi(z0.y), bflo(z0.z), bfhi(z0.z), bflo(z0.w), bfhi(z0.w), bflo(z1.x), bfhi(z1.x), bflo(z1.y), bfhi(z1.y), bflo(z1.z), bfhi(z1.z), bflo(z1.w), bfhi(z1.w)};
            float r[16];
#pragma unroll
            for (int q = 0; q < 4; ++q) { const f32x4 g = *(const f32x4*)(gg + q * 4);
#pragma unroll
                for (int e = 0; e < 4; ++e) r[q * 4 + e] = o[q][e] * rs * g[e] * siluf_(zz[q * 4 + e]); }
            u32x4 w0, w1; w0.x = pk2(r[0], r[1]); w0.y = pk2(r[2], r[3]); w0.z = pk2(r[4], r[5]); w0.w = pk2(r[6], r[7]); w1.x = pk2(r[8], r[9]); w1.y = pk2(r[10], r[11]); w1.z = pk2(r[12], r[13]); w1.w = pk2(r[14], r[15]);
            *(u32x4*)(mix + (size_t)t * DM + 1024 + lane * 16) = w0; *(u32x4*)(mix + (size_t)t * DM + 1024 + lane * 16 + 8) = w1;
        }
    }
}

__device__ void phase_ffn_act(const Params& p, int layer) {
    unsigned char* ws = p.ws;
    const bf16_t* hf = (const bf16_t*)(ws + O_HF); bf16_t* act = (bf16_t*)(ws + O_ACT);
    const float* cw = p.in[30] + (size_t)layer * 3 * NFF; const float* cb = p.in[31] + (size_t)layer * NFF;
    const int nitems = 512 * 688;
    for (int it = blockIdx.x * 512 + tidx(); it < nitems; it += gridDim.x * 512) {
        const int seg = it / 688, cg8 = it - seg * 688, c = cg8 * 8, t0 = seg * 32;
        float w[2][3][8], bb[2][8];
#pragma unroll
        for (int hh = 0; hh < 2; ++hh) {
#pragma unroll
            for (int j = 0; j < 3; ++j) { const f32x4 a = *(const f32x4*)(cw + j * NFF + hh * DFF + c), b = *(const f32x4*)(cw + j * NFF + hh * DFF + c + 4);
                w[hh][j][0] = a[0]; w[hh][j][1] = a[1]; w[hh][j][2] = a[2]; w[hh][j][3] = a[3]; w[hh][j][4] = b[0]; w[hh][j][5] = b[1]; w[hh][j][6] = b[2]; w[hh][j][7] = b[3]; }
            const f32x4 a = *(const f32x4*)(cb + hh * DFF + c), b = *(const f32x4*)(cb + hh * DFF + c + 4);
            bb[hh][0] = a[0]; bb[hh][1] = a[1]; bb[hh][2] = a[2]; bb[hh][3] = a[3]; bb[hh][4] = b[0]; bb[hh][5] = b[1]; bb[hh][6] = b[2]; bb[hh][7] = b[3];
        }
        u32x4 r0[2], r1[2];
#pragma unroll
        for (int hh = 0; hh < 2; ++hh) {
            r0[hh] = (t0 >= 2) ? *(const u32x4*)(hf + (size_t)(t0 - 2) * NFF + hh * DFF + c) : (u32x4){0u, 0u, 0u, 0u};
            r1[hh] = (t0 >= 1) ? *(const u32x4*)(hf + (size_t)(t0 - 1) * NFF + hh * DFF + c) : (u32x4){0u, 0u, 0u, 0u};
        }
#pragma unroll 4
        for (int tt = 0; tt < 32; ++tt) {
            const int t = t0 + tt;
            u32x4 r2[2]; float v[2][8];
#pragma unroll
            for (int hh = 0; hh < 2; ++hh) {
                r2[hh] = *(const u32x4*)(hf + (size_t)t * NFF + hh * DFF + c);
                const unsigned a0[4] = {r0[hh].x, r0[hh].y, r0[hh].z, r0[hh].w}, a1[4] = {r1[hh].x, r1[hh].y, r1[hh].z, r1[hh].w}, a2[4] = {r2[hh].x, r2[hh].y, r2[hh].z, r2[hh].w};
#pragma unroll
                for (int e = 0; e < 4; ++e) {
                    v[hh][2 * e]     = bb[hh][2 * e]     + w[hh][0][2 * e]     * bflo(a0[e]) + w[hh][1][2 * e]     * bflo(a1[e]) + w[hh][2][2 * e]     * bflo(a2[e]);
                    v[hh][2 * e + 1] = bb[hh][2 * e + 1] + w[hh][0][2 * e + 1] * bfhi(a0[e]) + w[hh][1][2 * e + 1] * bfhi(a1[e]) + w[hh][2][2 * e + 1] * bfhi(a2[e]);
                }
                r0[hh] = r1[hh]; r1[hh] = r2[hh];
            }
            u32x4 o; o.x = pk2(siluf_(v[0][0]) * v[1][0], siluf_(v[0][1]) * v[1][1]); o.y = pk2(siluf_(v[0][2]) * v[1][2], siluf_(v[0][3]) * v[1][3]);
            o.z = pk2(siluf_(v[0][4]) * v[1][4], siluf_(v[0][5]) * v[1][5]); o.w = pk2(siluf_(v[0][6]) * v[1][6], siluf_(v[0][7]) * v[1][7]);
            *(u32x4*)(act + (size_t)t * DFF + c) = o;
        }
    }
}
#ifdef REPEAT_PHASE
constexpr int NPHT = NPH + 1;
#else
constexpr int NPHT = NPH;
#endif
#ifndef MULTI_LAUNCH
#define MULTI_LAUNCH 0
#endif
__global__ void __launch_bounds__(512) mega(Params p) {
    extern __shared__ __attribute__((aligned(16))) unsigned char smem[];
    cg::grid_group grid = cg::this_grid();
    const int b = blockIdx.x, G = gridDim.x;
    PG8_LAS unsigned char* glds = (PG8_LAS unsigned char*)smem;
    volatile XB_LAS unsigned* xst = (volatile XB_LAS unsigned*)(smem + LDS_BYTES - 32);
    if (threadIdx.x == 0) { xst[0] = 0u; xst[1] = 0u; }
    __syncthreads();
    XcdBarrier xbar; xbar.bar = (unsigned*)(p.ws + O_BAR); xbar.x = 0; xbar.st = xst;
    for (int ph = p.ph_lo; ph < p.ph_hi; ++ph) {

        #ifdef REPEAT_PHASE
        const int layer = ph / (NPH + 1), ki = ph % (NPH + 1), rep = (ki == REPEAT_PHASE + 1) ? 1 : 0; int k = ki <= REPEAT_PHASE ? ki : ki - 1;
#else
        const int layer = ph / NPH, rep = 0; int k = ph % NPH;
#endif
#ifdef DBG_ONLY
        if (k != DBG_ONLY) k = 99;
#endif
        typedef unsigned char __attribute__((address_space(1))) gu8_t;
        gu8_t* wsg = (gu8_t*)p.ws; asm volatile("" : "+s"(wsg));
        unsigned char* ws = (unsigned char*)wsg;
        int tid = threadIdx.x; asm volatile("" : "+v"(tid));
        const int wave = tid >> 6;
        bf16_t* hn = (bf16_t*)(ws + O_HN);
        Params q = p; q.ws = ws;
        if (k == 0) {
            if (ph == 0 && rep == 0 && b == 0) { if (tid < 64) ((unsigned*)(ws + O_CTR))[tid * 16] = 0u; for (int i = tid; i < XCD_BAR_WORDS; i += 512) ((unsigned*)(ws + O_BAR))[i] = 0u; }
            phase_convert(q, layer, (float*)smem);
            phase_rmsnorm(layer == 0 ? p.in[0] : p.out, p.in[1] + (size_t)layer * DM, hn, layer == 0 ? p.out : nullptr);
        } else if (k == 1) {
            pg8::Gemm g{hn, (const bf16_t*)(ws + O_WIN), T_, NIN, DM}; pg8::StaticOrder S; S.init(T_, NIN, G, b);
            EpiProj E{(float*)(ws + O_P32), (bf16_t*)(ws + O_PU), (bf16_t*)(ws + O_PQKV), (bf16_t*)(ws + O_PZ)};
            pg8::gemm_phase<EpiProj, pg8::StaticOrder, false>(glds, g, S, E, nullptr);
        } else if (k == 2) {
            for (int it = b; it < 3072; it += G) {
                if (it < 2048) gdn_prep_item(q, layer, it, smem);
                else if (it < 2304) nsa_prep_item(q, layer, it - 2048, (float*)smem);
                else if (it < 2560) s5_passA_wave(q, layer, (it - 2304) * 8 + wave, (float*)(smem + wave * 4096));
                else cmp1_wave_tile(q, layer, (it - 2560) * 8 + wave);
            }
        } else if (k == 3) {
            for (int idx = b * 8 + wave; idx < 4096; idx += G * 8) cmp2_wave_row(q, layer, idx);
            for (int it = b * 8 + wave; it < 2048; it += G * 8) s5_passB_wave(q, layer, it, (bf16_t*)(smem + wave * 8448), (float*)(smem + wave * 8448 + 4352));
        } else if (k == 4) {
#ifdef REP4_MODE
            const bool do_rec = (rep == 0) || (REP4_MODE == 1), do_glu = (rep == 0), do_nsa = (rep == 0) || (REP4_MODE == 2);
#else
            const bool do_rec = true, do_glu = true, do_nsa = true;
#endif
            if (b < 32) {
#ifndef NO_REC
 if (do_rec) gdn_recurrence(q, b, smem);
#endif
 }
            else if (b < 160 && do_glu) {
#ifndef NO_GLU
                pg8::Gemm g{(const bf16_t*)(ws + O_YGELU), (const bf16_t*)(ws + O_WGLU), T_, 512, 512}; pg8::StaticOrder S; S.init(T_, 512, 128, b - 32);
                EpiGlu E{(const bf16_t*)(ws + O_YGELU), (float*)(ws + O_YGLU)};
                pg8::gemm_phase<EpiGlu, pg8::StaticOrder, false>(glds, g, S, E, nullptr);
#endif
            }
            __syncthreads();
            unsigned* ctr = (unsigned*)(ws + O_CTR) + (layer * 2 + rep) * 16;
            volatile int* sidx = (volatile int*)(smem + LDS_BYTES - 16);
#ifndef NO_NSA
            if (do_nsa) for (;;) {
                if (tid == 0) *sidx = (int)atomicAdd(ctr, 1u);
                __syncthreads();
                const int idx = *sidx;
                __syncthreads();
                if (idx >= 512) break;
                nsa_wave_task(q, layer, (511 - idx) * 32 + wave * 4, smem + wave * NSA_WLDS);
            }
#endif
        } else if (k == 5) {
            phase_finalize(q, layer);
        } else if (k == 6) {
            pg8::Gemm g{hn, (const bf16_t*)(ws + O_WOUT), T_, DM, DM}; pg8::StaticOrder S; S.init(T_, DM, G, b);
            EpiResid E{p.out, DM};
            pg8::gemm_phase<EpiResid, pg8::StaticOrder, false>(glds, g, S, E, nullptr);
        } else if (k == 7) {
            phase_rmsnorm(p.out, p.in[28] + (size_t)layer * DM, hn, nullptr);
        } else if (k == 8) {
            pg8::Gemm g{hn, (const bf16_t*)(ws + O_WFIN), T_, NFF, DM}; pg8::StaticOrder S; S.init(T_, NFF, G, b);
            EpiBf E{(bf16_t*)(ws + O_HF), NFF};
            pg8::gemm_phase<EpiBf, pg8::StaticOrder, false>(glds, g, S, E, nullptr);
        } else if (k == 9) {
            phase_ffn_act(q, layer);
        } else if (k == 10) {
            pg8::Gemm g{(const bf16_t*)(ws + O_ACT), (const bf16_t*)(ws + O_WFOUT), T_, DM, DFF}; pg8::StaticOrder S; S.init(T_, DM, G, b);
            EpiResid E{p.out, DM};
            pg8::gemm_phase<EpiResid, pg8::StaticOrder, false>(glds, g, S, E, nullptr);
        }
        __syncthreads();
        if (ph + 1 < p.ph_hi) {
            if (ph == p.ph_lo) { grid.sync(); xbar = xcd_barrier_post((unsigned*)(p.ws + O_BAR), xst); }
            else xcd_barrier(xbar);
        }
    }
}

extern "C" void kernel_launch(void* const* d_in, const int* in_sizes, int n_in, void* d_out, int out_size, void* d_ws, size_t ws_size, hipStream_t stream) {
    static int grid_blocks = 0;
    if (!grid_blocks) {
        if (n_in != 33 || out_size != T_ * DM || ws_size < WS_NEED) { fprintf(stderr, "kernel_launch: unexpected shapes or workspace (%d inputs, out %d, ws %zu < %zu)\n", n_in, out_size, ws_size, (size_t)WS_NEED); grid_blocks = -1; return; }
        int dev = 0, cus = 0, per_cu = 0;
        hipGetDevice(&dev);
        hipDeviceGetAttribute(&cus, hipDeviceAttributeMultiprocessorCount, dev);
        if (hipFuncSetAttribute((const void*)mega, hipFuncAttributeMaxDynamicSharedMemorySize, LDS_BYTES) != hipSuccess) { fprintf(stderr, "kernel_launch: hipFuncSetAttribute failed\n"); grid_blocks = -1; return; }
        hipOccupancyMaxActiveBlocksPerMultiprocessor(&per_cu, (const void*)mega, 512, LDS_BYTES);
        (void)hipGetLastError();
        if (per_cu < 1) per_cu = 1;
        grid_blocks = cus * per_cu; if (grid_blocks > 256) grid_blocks = 256;
        if (grid_blocks < 160) { fprintf(stderr, "kernel_launch: grid %d too small\n", grid_blocks); grid_blocks = -1; return; }
    }
    if (grid_blocks < 0) return;
    Params p{};
    for (int i = 0; i < 33; ++i) p.in[i] = (const float*)d_in[i];
    p.out = (float*)d_out; p.ws = (unsigned char*)d_ws;
#if MULTI_LAUNCH
    for (int ph = 0; ph < 2 * NPHT; ++ph) { p.ph_lo = ph; p.ph_hi = ph + 1; hipLaunchKernelGGL(mega, dim3(grid_blocks), dim3(512), LDS_BYTES, stream, p); }
#else
    p.ph_lo = 0; p.ph_hi = 2 * NPHT;
    void* args[] = {&p};
    hipError_t e = hipLaunchCooperativeKernel((const void*)mega, dim3(grid_blocks), dim3(512), args, LDS_BYTES, stream);
    if (e != hipSuccess) fprintf(stderr, "cooperative launch failed: %s (grid %d)\n", hipGetErrorString(e), grid_blocks);
#endif
}
```

```cpp
#include <hip/hip_runtime.h>
#include <hip/hip_cooperative_groups.h>
#include <cstdio>
namespace cg = cooperative_groups;
__device__ __forceinline__ int tidx() { int t = threadIdx.x; asm volatile("" : "+v"(t)); return t; }
namespace pg8 {
#define PG8_LAS __attribute__((address_space(3)))
typedef unsigned short bf16_t;
typedef short bf16x8 __attribute__((ext_vector_type(8)));
typedef float f32x4 __attribute__((ext_vector_type(4)));
typedef unsigned u32x4 __attribute__((ext_vector_type(4)));
constexpr int BM = 256, BK = 64, HALF = 128, HTB = HALF * BK * 2  , STAGE_BYTES = 8 * HTB, NXCD = 8, WGM = 8;

__host__ __device__ __forceinline__ int lds_byte(int r, int c) { const int st = (r >> 4) * 2 + (c >> 5), rr = r & 15, cc = c & 31, ob = rr * 64 + cc * 2; return st * 1024 + (ob ^ (((ob >> 9) & 1) << 5)); }
__host__ __device__ __forceinline__ void stage_rc(int b, int& R, int& C) { const int st = b / 1024, sb = b % 1024, swz = sb ^ (((sb >> 9) & 1) << 5); R = (st >> 1) * 16 + swz / 64; C = (st & 1) * 32 + (swz % 64) / 2; }
__host__ __device__ __forceinline__ int perm32(int rho) { const int n = rho >> 4, i = rho & 15; return 8 * (i >> 2) + 4 * n + (i & 3); }

struct Unit { int pm, pn; };
struct Gemm { const bf16_t* A; const bf16_t* Bt; int M, N, K; };

struct StaticOrder {
    int nM, nN, nwg, G, c;
    __host__ __device__ void init(int M, int N, int G_, int c_) { nM = M / BM; nN = N / BM; nwg = nM * nN; G = G_; c = c_; }
    __host__ __device__ bool next(int i, Unit& u) const {
        const long L = (long)i * G + c; if (L >= nwg) return false;
        int wgid = (int)L; { const int q = nwg / NXCD, r = nwg % NXCD, xcd = wgid % NXCD, off = wgid / NXCD; wgid = (xcd < r ? xcd * (q + 1) : r * (q + 1) + (xcd - r) * q) + off; }
        const int nig = WGM * nN, gid = wgid / nig, fm = gid * WGM, gsz = (nM - fm) < WGM ? (nM - fm) : WGM;
        u.pm = fm + ((wgid % nig) % gsz); u.pn = (wgid % nig) / gsz; return true;
    }
    __device__ __forceinline__ void a_ready(const Unit&) const {}
    __device__ __forceinline__ void done(const Unit&) const {}
};
__device__ __forceinline__ unsigned cvt_pk_bf16(float lo, float hi) { unsigned r; asm volatile("v_cvt_pk_bf16_f32 %0, %1, %2" : "=v"(r) : "v"(lo), "v"(hi)); return r; }
template <class Epi, class Sched, bool STAMP = false>
__device__ __forceinline__ void gemm_phase(PG8_LAS unsigned char* lds, const Gemm g, const Sched& S, const Epi& E, unsigned long long* stamps) {
    const int tid = tidx(), wid = __builtin_amdgcn_readfirstlane(tid >> 6), lane = tid & 63, wr = wid >> 2, wc = wid & 3, fr = lane & 15, fq = lane >> 4;
    const int K = g.K, nt = K / BK;
    int ts_lo = 0, ts_hi = 0, nts = 0; const unsigned long long rt_entry = STAMP ? (unsigned long long)wall_clock64() : 0ull;
#define PG8_STAMP() do { if (STAMP && wid == 0 && nts < 64) { const unsigned long long _c = (unsigned long long)clock64(); \
        ts_lo = (lane == nts) ? (int)(unsigned)_c : ts_lo; ts_hi = (lane == nts) ? (int)(unsigned)(_c >> 32) : ts_hi; ++nts; } } while (0)
    PG8_STAMP();
    unsigned voffA[2], voffB[2];
#pragma unroll
    for (int i = 0; i < 2; ++i) { int R, C; stage_rc(tid * 16 + i * 8192, R, C); const int Rb = Epi::PERM ? ((R & ~31) + perm32(R & 31)) : R;
        voffA[i] = (unsigned)(R * K + C) * 2u; voffB[i] = (unsigned)(Rb * K + C) * 2u; }
    const size_t kstep = (size_t)(BK * 2);
    const size_t hstep = (size_t)HALF * K * 2;
    const size_t tstep = 2 * hstep;
    const unsigned ldsw = (unsigned)wid * 1024u;
    const int aoff = lds_byte(wr * 64 + fr, fq * 8), boff = lds_byte(wc * 32 + fr, fq * 8);
#define PG8_SA(b, h) (((b) * 2 + (h)) * HTB)
#define PG8_SB(b, h) ((4 + (b) * 2 + (h)) * HTB)
#define PG8_STAGE(bufoff, gbase, voff) do { _Pragma("unroll") for (int _i = 0; _i < 2; ++_i) \
        __builtin_amdgcn_global_load_lds((const unsigned*)((const char*)(gbase) + (voff)[_i]), (PG8_LAS unsigned*)(lds + (bufoff) + ldsw + _i * 8192), 16, 0, 0); } while (0)
#define PG8_LDA(dst, b, h) do { _Pragma("unroll") for (int m = 0; m < 4; ++m) _Pragma("unroll") for (int k = 0; k < 2; ++k) dst[m][k] = *(const PG8_LAS bf16x8*)(lds + PG8_SA(b, h) + aoff + m * 2048 + k * 1024); } while (0)
#define PG8_LDB(dst, b, h) do { _Pragma("unroll") for (int n = 0; n < 2; ++n) _Pragma("unroll") for (int k = 0; k < 2; ++k) dst[n][k] = *(const PG8_LAS bf16x8*)(lds + PG8_SB(b, h) + boff + n * 2048 + k * 1024); } while (0)
#define PG8_MMA(ai, bj, At, Bt) do { __builtin_amdgcn_s_setprio(1); _Pragma("unroll") for (int m = 0; m < 4; ++m) _Pragma("unroll") for (int n = 0; n < 2; ++n) _Pragma("unroll") for (int k = 0; k < 2; ++k) \
        acc[ai][bj][m][n] = __builtin_amdgcn_mfma_f32_16x16x32_bf16(Bt[n][k], At[m][k], acc[ai][bj][m][n], 0, 0, 0); __builtin_amdgcn_s_setprio(0); } while (0)
#define PG8_WAIT_V(n) asm volatile("s_waitcnt vmcnt(" #n ")" ::: "memory")
#define PG8_WAIT_L(n) asm volatile("s_waitcnt lgkmcnt(" #n ")" ::: "memory")
#define PG8_BAR __builtin_amdgcn_s_barrier()
#define PG8_SCHED __builtin_amdgcn_sched_barrier(0)
    Unit cur, nxt; int ui = 0;
    if (!S.next(0, cur)) return;
    f32x4 acc[2][2][4][2];
#pragma unroll
    for (int a = 0; a < 2; ++a)
#pragma unroll
        for (int b = 0; b < 2; ++b)
#pragma unroll
            for (int m = 0; m < 4; ++m)
#pragma unroll
                for (int n = 0; n < 2; ++n) acc[a][b][m][n] = (f32x4){0.f, 0.f, 0.f, 0.f};
    bf16x8 At[4][2], B0[2][2], B1[2][2];
    const char* cA = (const char*)g.A + (size_t)cur.pm * tstep; const char* cB = (const char*)g.Bt + (size_t)cur.pn * tstep;
    S.a_ready(cur);
    PG8_STAGE(PG8_SB(0, 0), cB, voffB); PG8_STAGE(PG8_SA(0, 0), cA, voffA); PG8_STAGE(PG8_SB(0, 1), cB + hstep, voffB); PG8_STAGE(PG8_SA(0, 1), cA + hstep, voffA);
    if (wr == 1) PG8_BAR;
    PG8_WAIT_V(4); PG8_BAR;
    PG8_STAGE(PG8_SB(1, 0), cB + kstep, voffB); PG8_STAGE(PG8_SA(1, 0), cA + kstep, voffA); PG8_STAGE(PG8_SB(1, 1), cB + hstep + kstep, voffB);
    PG8_WAIT_V(6); PG8_BAR;
    PG8_STAMP();
    for (;;) {
        const bool has_next = S.next(ui + 1, nxt);
        const char* nA = has_next ? (const char*)g.A + (size_t)nxt.pm * tstep : cA; const char* nB = has_next ? (const char*)g.Bt + (size_t)nxt.pn * tstep : cB;
        for (int t = 0; t < nt; t += 2) {
            const bool last = (t == nt - 2);
            const char* a1 = cA + (size_t)(t + 1) * kstep;
            const char* a2 = last ? nA : cA + (size_t)(t + 2) * kstep; const char* b2 = last ? nB : cB + (size_t)(t + 2) * kstep;
            const char* a3 = a2 + kstep; const char* b3 = b2 + kstep;
            if (last && has_next) S.a_ready(nxt);
            PG8_LDB(B0, 0, 0); PG8_SCHED; PG8_LDA(At, 0, 0); PG8_STAGE(PG8_SA(1, 1), a1 + hstep, voffA);
            PG8_WAIT_L(8); PG8_BAR; PG8_WAIT_L(0); PG8_MMA(0, 0, At, B0); PG8_BAR; PG8_SCHED;
            PG8_LDB(B1, 0, 1); PG8_STAGE(PG8_SB(0, 0), b2, voffB);
            PG8_BAR; PG8_WAIT_L(0); PG8_MMA(0, 1, At, B1); PG8_BAR;
            PG8_LDA(At, 0, 1); PG8_STAGE(PG8_SA(0, 0), a2, voffA);
            PG8_BAR; PG8_WAIT_L(0); PG8_MMA(1, 0, At, B0); PG8_BAR; PG8_SCHED;
            PG8_STAGE(PG8_SB(0, 1), b2 + hstep, voffB);
            PG8_WAIT_V(6); PG8_BAR; PG8_MMA(1, 1, At, B1); PG8_BAR;
            PG8_LDB(B0, 1, 0); PG8_SCHED; PG8_LDA(At, 1, 0); PG8_STAGE(PG8_SA(0, 1), a2 + hstep, voffA);
            PG8_WAIT_L(8); PG8_BAR; PG8_WAIT_L(0); PG8_MMA(0, 0, At, B0); PG8_BAR; PG8_SCHED;
            PG8_LDB(B1, 1, 1); PG8_STAGE(PG8_SB(1, 0), b3, voffB);
            PG8_BAR; PG8_WAIT_L(0); PG8_MMA(0, 1, At, B1); PG8_BAR;
            PG8_LDA(At, 1, 1); PG8_STAGE(PG8_SA(1, 0), a3, voffA);
            PG8_BAR; PG8_WAIT_L(0); PG8_MMA(1, 0, At, B0); PG8_BAR; PG8_SCHED;
            PG8_STAGE(PG8_SB(1, 1), b3 + hstep, voffB);
            PG8_WAIT_V(6); PG8_BAR; PG8_MMA(1, 1, At, B1); PG8_BAR;
        }
        PG8_STAMP();
        if constexpr (!Epi::AFTER_DRAIN) { E(acc, cur, wr, wc, fr, fq); S.done(cur); }
        PG8_STAMP();
        if (!has_next) break;
#pragma unroll
        for (int a = 0; a < 2; ++a)
#pragma unroll
            for (int b = 0; b < 2; ++b)
#pragma unroll
                for (int m = 0; m < 4; ++m)
#pragma unroll
                    for (int n = 0; n < 2; ++n) acc[a][b][m][n] = (f32x4){0.f, 0.f, 0.f, 0.f};
        cur = nxt; cA = nA; cB = nB; ++ui;
    }
    PG8_WAIT_V(0);
    if (wr == 0) PG8_BAR;
    PG8_BAR;
    if constexpr (Epi::AFTER_DRAIN) { E.fused(acc, cur, wr, wc, fr, fq, lds, wid, lane); S.done(cur); }
    PG8_STAMP();
    if (STAMP && wid == 0) { stamps[lane] = lane < nts ? (((unsigned long long)(unsigned)ts_hi << 32) | (unsigned)ts_lo) : 0ull;
        if (lane == 62) stamps[62] = rt_entry; if (lane == 63) stamps[63] = (unsigned long long)wall_clock64(); }
#undef PG8_STAMP
#undef PG8_SA
#undef PG8_SB
#undef PG8_STAGE
#undef PG8_LDA
#undef PG8_LDB
#undef PG8_MMA
#undef PG8_WAIT_V
#undef PG8_WAIT_L
#undef PG8_BAR
#undef PG8_SCHED
}
}
#define XB_TMO      128
#define XB_XCNT(j)  (256  + 64 * (j))
#define XB_XSUB(j)  (1280 + 64 * (j))
#define XB_XGEN(j)  (2304 + 64 * (j))
#define XB_TOP      3328
#define XB_TOPGEN   3392
#define XCD_BAR_WORDS 3456
#define XB_SPIN_CAP (1u << 18)
#define XB_LAS __attribute__((address_space(3)))

__device__ __forceinline__ unsigned xb_ld(unsigned* p)              { return __hip_atomic_load(p, __ATOMIC_RELAXED, __HIP_MEMORY_SCOPE_AGENT); }
__device__ __forceinline__ unsigned xb_add(unsigned* p, unsigned v) { return __hip_atomic_fetch_add(p, v, __ATOMIC_RELAXED, __HIP_MEMORY_SCOPE_AGENT); }
__device__ __forceinline__ unsigned xb_xcc_id() { return (unsigned)__builtin_amdgcn_s_getreg((3 << 11) | 20) & 0xFu; }
#define XB_SPIN(cond, bar) do { unsigned _sp = 0; while (cond) { __builtin_amdgcn_s_sleep(1); \
    if ((++_sp & 255u) == 0u) { if (xb_ld(&(bar)[XB_TMO])) break; if (_sp > XB_SPIN_CAP) { atomicAdd(&(bar)[XB_TMO], 1u); break; } } } } while (0)

struct XcdBarrier {
    unsigned* bar; unsigned x;
    volatile XB_LAS unsigned* st;
};

__device__ __forceinline__ XcdBarrier xcd_barrier_post(unsigned* bar, volatile XB_LAS unsigned* st) {
    XcdBarrier b; b.bar = bar; b.x = xb_xcc_id(); b.st = st;
    if (threadIdx.x == 0) (void)xb_add(&bar[XB_XCNT(b.x)], 1u);
    return b;
}
__device__ __forceinline__ void xcd_barrier_complete(unsigned* bar, unsigned x, unsigned& nloc, unsigned& nx) {
    const unsigned G = gridDim.x * gridDim.y * gridDim.z;
    unsigned sum, cnt, mine, sp = 0u;
    for (;;) {
        sum = 0u; cnt = 0u; mine = 0u;
#pragma unroll
        for (unsigned j = 0; j < 16; ++j) { const unsigned c = xb_ld(&bar[XB_XCNT(j)]); sum += c; cnt += (c > 0u) ? 1u : 0u; mine = (j == x) ? c : mine; }
        if (sum == G) break;
        __builtin_amdgcn_s_sleep(1);
        if ((++sp & 255u) == 0u) { if (xb_ld(&bar[XB_TMO])) break; if (sp > XB_SPIN_CAP) { atomicAdd(&bar[XB_TMO], 1u); break; } }
    }
    nloc = mine > 0u ? mine : 1u; nx = cnt > 0u ? cnt : 1u;
}

__device__ __forceinline__ void xcd_barrier(const XcdBarrier& b) {
    asm volatile("s_waitcnt vmcnt(0)" ::: "memory");
    __syncthreads();
    if (threadIdx.x == 0) {
        unsigned* bar = b.bar;
        __builtin_amdgcn_s_waitcnt(0);
        unsigned nloc = b.st[0], nx = b.st[1];
        if (nloc == 0u) { xcd_barrier_complete(bar, b.x, nloc, nx); b.st[0] = nloc; b.st[1] = nx; }
        const unsigned old = xb_add(&bar[XB_XSUB(b.x)], 1u);
        const unsigned gen = old / nloc;
        if (old + 1u == (gen + 1u) * nloc) {
            __builtin_amdgcn_fence(__ATOMIC_RELEASE, "agent");
            asm volatile("s_waitcnt vmcnt(0)" ::: "memory");
            const unsigned og = xb_add(&bar[XB_TOP], 1u);
            const unsigned tg = og / nx;
            if (og + 1u == (tg + 1u) * nx) xb_add(&bar[XB_TOPGEN], 1u);
            else XB_SPIN(xb_ld(&bar[XB_TOPGEN]) == tg, bar);
            __builtin_amdgcn_fence(__ATOMIC_ACQUIRE, "agent");
            xb_add(&bar[XB_XGEN(b.x)], 1u);
            asm volatile("s_waitcnt vmcnt(0)" ::: "memory");
        } else {
            XB_SPIN(xb_ld(&bar[XB_XGEN(b.x)]) == gen, bar);
            __builtin_amdgcn_fence(__ATOMIC_ACQUIRE, "agent");
            asm volatile("s_waitcnt vmcnt(0)" ::: "memory");
        }
    }
    __syncthreads();
}
using pg8::bf16_t; using pg8::bf16x8; using pg8::f32x4; using pg8::u32x4; using pg8::Unit;
typedef unsigned u32x2 __attribute__((ext_vector_type(2)));
#define MFMA16(a, b, c) __builtin_amdgcn_mfma_f32_16x16x32_bf16((a), (b), (c), 0, 0, 0)

constexpr int T_ = 16384, DM = 2048, NIN = 6144, DFF = 5504, NFF = 11008;
constexpr int LDS_BYTES = 144 * 1024;
constexpr int NPH = 11;

constexpr size_t O_CTR   = 0;
constexpr size_t O_BAR   = 4096;
constexpr size_t O_WIN   = 4096 + 16384;
constexpr size_t O_WOUT  = O_WIN   + (size_t)NIN * DM * 2;
constexpr size_t O_WFIN  = O_WOUT  + (size_t)DM * DM * 2;
constexpr size_t O_WFOUT = O_WFIN  + (size_t)NFF * DM * 2;
constexpr size_t O_WCK   = O_WFOUT + (size_t)DM * DFF * 2;
constexpr size_t O_WCV   = O_WCK   + (size_t)256 * 2048 * 2;
constexpr size_t O_WGLU  = O_WCV   + (size_t)256 * 2048 * 2;
constexpr size_t O_HN    = O_WGLU  + (size_t)512 * 512 * 2;
constexpr size_t O_R     = O_HN    + (size_t)T_ * DM * 2;
constexpr size_t O_P32   = O_R;
constexpr size_t O_PU    = O_P32   + (size_t)T_ * 1536 * 4;
constexpr size_t O_PQKV  = O_PU    + (size_t)T_ * 512 * 2;
constexpr size_t O_PZ    = O_PQKV  + (size_t)T_ * 3072 * 2;
constexpr size_t O_QN    = O_PZ    + (size_t)T_ * 1024 * 2;
constexpr size_t O_KSN   = O_QN    + (size_t)T_ * 512 * 2;
constexpr size_t O_KWN   = O_KSN   + (size_t)T_ * 128 * 2;
constexpr size_t O_VST   = O_KWN   + (size_t)T_ * 128 * 2;
constexpr size_t O_VWT   = O_VST   + (size_t)T_ * 128 * 2;
constexpr size_t O_KC    = O_VWT   + (size_t)T_ * 128 * 2;
constexpr size_t O_VCT   = O_KC    + (size_t)2 * 1024 * 64 * 2;
constexpr size_t O_HCMP  = O_VCT   + (size_t)2 * 64 * 1024 * 2;
constexpr size_t O_GKC   = O_HCMP  + (size_t)2 * 2048 * 256 * 4;
constexpr size_t O_GQG   = O_GKC   + (size_t)2048 * 64 * 128 * 2;
constexpr size_t O_GQK   = O_GQG   + (size_t)2048 * 64 * 128 * 2;
constexpr size_t O_GKD   = O_GQK   + (size_t)2048 * 64 * 64 * 2;
constexpr size_t O_GVAL  = O_GKD   + (size_t)2048 * 64 * 128 * 2;
constexpr size_t O_GEGL  = O_GVAL  + (size_t)2048 * 64 * 128 * 4;
constexpr size_t O_XEND  = O_GEGL  + 8192;
constexpr size_t O_YGELU = O_XEND  + (size_t)64 * 32 * 64 * 2 * 4;
constexpr size_t O_YGLU  = O_YGELU + (size_t)T_ * 512 * 2;
constexpr size_t O_ATT_END = O_YGLU + (size_t)T_ * 512 * 4;
constexpr size_t O_HF    = O_R;
constexpr size_t O_ACT   = O_HF    + (size_t)T_ * NFF * 2;
constexpr size_t O_FFN_END = O_ACT + (size_t)T_ * DFF * 2;
constexpr size_t WS_NEED = O_ATT_END > O_FFN_END ? O_ATT_END : O_FFN_END;

struct Params { const float* in[33]; float* out; unsigned char* ws; int ph_lo, ph_hi; };

__device__ __forceinline__ unsigned short f2bf(float f) { unsigned u = __float_as_uint(f); u += 0x7FFFu + ((u >> 16) & 1u); return (unsigned short)(u >> 16); }
__device__ __forceinline__ float bf2f(unsigned short b) { return __uint_as_float(((unsigned)b) << 16); }
__device__ __forceinline__ unsigned pk2(float lo, float hi) { return pg8::cvt_pk_bf16(lo, hi); }
__device__ __forceinline__ float bflo(unsigned w) { return __uint_as_float(w << 16); }
__device__ __forceinline__ float bfhi(unsigned w) { return __uint_as_float(w & 0xFFFF0000u); }
__device__ __forceinline__ float sigmoidf_(float x) { return __builtin_amdgcn_rcpf(1.0f + __expf(-x)); }
__device__ __forceinline__ float siluf_(float x) { return x * __builtin_amdgcn_rcpf(1.0f + __expf(-x)); }
__device__ __forceinline__ float vmaxf(float a, float b) { float r; asm("v_max_f32 %0, %1, %2" : "=v"(r) : "v"(a), "v"(b)); return r; }
__device__ __forceinline__ float gelu_tanh(float x) { const float u = 0.7978845608028654f * (x + 0.044715f * x * x * x); const float th = 1.0f - 2.0f * __builtin_amdgcn_rcpf(__expf(2.0f * u) + 1.0f); return 0.5f * x * (1.0f + th); }
__device__ __forceinline__ float softplusf_(float x) { return x > 20.f ? x : log1pf(expf(x)); }
__device__ __forceinline__ float wave_sum(float v) { for (int o = 32; o >= 1; o >>= 1) v += __shfl_xor(v, o); return v; }
__device__ __forceinline__ bf16x8 pack8f(f32x4 a, f32x4 b) { u32x4 w; w.x = pk2(a[0], a[1]); w.y = pk2(a[2], a[3]); w.z = pk2(b[0], b[1]); w.w = pk2(b[2], b[3]); return __builtin_bit_cast(bf16x8, w); }
__device__ __forceinline__ float rdlane(float v, int l) { return __int_as_float(__builtin_amdgcn_readlane(__float_as_int(v), l)); }

struct EpiProj {
    static constexpr bool PERM = true, AFTER_DRAIN = false;
    float* P32; bf16_t* Pu; bf16_t* Pqkv; bf16_t* Pz;
    static __device__ __forceinline__ void st_bf(const f32x4 (&acc)[2][2][4][2], bf16_t* base, int ld) {
#pragma unroll
        for (int ai = 0; ai < 2; ++ai)
#pragma unroll
            for (int m = 0; m < 4; ++m) { bf16_t* rp = base + (size_t)(ai * 128 + m * 16) * ld;
#pragma unroll
                for (int bj = 0; bj < 2; ++bj) { const f32x4 v0 = acc[ai][bj][m][0], v1 = acc[ai][bj][m][1]; u32x4 w; w.x = pk2(v0[0], v0[1]); w.y = pk2(v0[2], v0[3]); w.z = pk2(v1[0], v1[1]); w.w = pk2(v1[2], v1[3]); *(u32x4*)(rp + bj * 128) = w; } }
    }
    __device__ __forceinline__ void operator()(const f32x4 (&acc)[2][2][4][2], const Unit& u, int wr, int wc, int fr, int fq) const {
        const int row0 = u.pm * 256 + wr * 64 + fr, colt = wc * 32 + 8 * fq;
        if (u.pn < 6) {
            float* base = P32 + (size_t)row0 * 1536 + u.pn * 256 + colt;
#pragma unroll
            for (int ai = 0; ai < 2; ++ai)
#pragma unroll
                for (int m = 0; m < 4; ++m) { float* rp = base + (size_t)(ai * 128 + m * 16) * 1536;
#pragma unroll
                    for (int bj = 0; bj < 2; ++bj) { *(f32x4*)(rp + bj * 128) = acc[ai][bj][m][0]; *(f32x4*)(rp + bj * 128 + 4) = acc[ai][bj][m][1]; } }
        } else if (u.pn < 8)  st_bf(acc, Pu   + (size_t)row0 * 512  + (u.pn - 6)  * 256 + colt, 512);
        else if (u.pn < 20)   st_bf(acc, Pqkv + (size_t)row0 * 3072 + (u.pn - 8)  * 256 + colt, 3072);
        else                  st_bf(acc, Pz   + (size_t)row0 * 1024 + (u.pn - 20) * 256 + colt, 1024);
    }
};
struct EpiResid {
    static constexpr bool PERM = false, AFTER_DRAIN = false;
    float* X; int ld;
    __device__ __forceinline__ void operator()(const f32x4 (&acc)[2][2][4][2], const Unit& u, int wr, int wc, int fr, int fq) const {
        float* base = X + (size_t)(u.pm * 256 + wr * 64 + fr) * ld + u.pn * 256 + wc * 32 + 4 * fq;
#pragma unroll
        for (int ai = 0; ai < 2; ++ai)
#pragma unroll
            for (int m = 0; m < 4; ++m) { float* rp = base + (size_t)(ai * 128 + m * 16) * ld;
#pragma unroll
                for (int bj = 0; bj < 2; ++bj)
#pragma unroll
                    for (int n = 0; n < 2; ++n) { f32x4* q = (f32x4*)(rp + bj * 128 + n * 16); *q = *q + acc[ai][bj][m][n]; } }
    }
};
struct EpiBf {
    static constexpr bool PERM = true, AFTER_DRAIN = false;
    bf16_t* O; int ld;
    __device__ __forceinline__ void operator()(const f32x4 (&acc)[2][2][4][2], const Unit& u, int wr, int wc, int fr, int fq) const {
        bf16_t* base = O + (size_t)(u.pm * 256 + wr * 64 + fr) * ld + u.pn * 256 + wc * 32 + 8 * fq;
#pragma unroll
        for (int ai = 0; ai < 2; ++ai)
#pragma unroll
            for (int m = 0; m < 4; ++m) { bf16_t* rp = base + (size_t)(ai * 128 + m * 16) * ld;
#pragma unroll
                for (int bj = 0; bj < 2; ++bj) { const f32x4 v0 = acc[ai][bj][m][0], v1 = acc[ai][bj][m][1]; u32x4 w; w.x = pk2(v0[0], v0[1]); w.y = pk2(v0[2], v0[3]); w.z = pk2(v1[0], v1[1]); w.w = pk2(v1[2], v1[3]); *(u32x4*)(rp + bj * 128) = w; } }
    }
};
struct EpiGlu {
    static constexpr bool PERM = false, AFTER_DRAIN = false;
    const bf16_t* Y; float* O;
    __device__ __forceinline__ void operator()(const f32x4 (&acc)[2][2][4][2], const Unit& u, int wr, int wc, int fr, int fq) const {
        const size_t off0 = (size_t)(u.pm * 256 + wr * 64 + fr) * 512 + u.pn * 256 + wc * 32 + 4 * fq;
#pragma unroll
        for (int ai = 0; ai < 2; ++ai)
#pragma unroll
            for (int m = 0; m < 4; ++m) { const size_t ro = off0 + (size_t)(ai * 128 + m * 16) * 512;
#pragma unroll
                for (int bj = 0; bj < 2; ++bj)
#pragma unroll
                    for (int n = 0; n < 2; ++n) { const size_t o = ro + bj * 128 + n * 16; const u32x2 yw = *(const u32x2*)(Y + o); const f32x4 a = acc[ai][bj][m][n];
                        f32x4 r; r[0] = bflo(yw.x) * sigmoidf_(a[0]); r[1] = bfhi(yw.x) * sigmoidf_(a[1]); r[2] = bflo(yw.y) * sigmoidf_(a[2]); r[3] = bfhi(yw.y) * sigmoidf_(a[3]); *(f32x4*)(O + o) = r; } }
    }
};
__device__ __forceinline__ int map_in_col(int n) { return n < 1304 ? n : (n < 1312 ? 5912 + (n - 1304) : (n < 1320 ? 5920 + (n - 1312) : (n < 1536 ? -1 : 1304 + (n - 1536)))); }
__device__ void convT_tile(const float* __restrict__ src, int srcN, int K, bf16_t* __restrict__ dst, int tile, bool inmap, float* sm) {
    const int nk = K >> 6, tk = tile % nk, tn = tile / nk, k0 = tk * 64, n0 = tn * 256;
    const int tid = tidx(), tx = tid & 255, ty = tid >> 8;
    const int n = n0 + tx, sc = inmap ? map_in_col(n) : n;
    float v[32];
#pragma unroll
    for (int i = 0; i < 32; ++i) v[i] = (sc >= 0) ? src[(size_t)(k0 + ty + 2 * i) * srcN + sc] : 0.f;
#pragma unroll
    for (int i = 0; i < 32; ++i) sm[(ty + 2 * i) * 257 + tx] = v[i];
    __syncthreads();
    const int nn = tid >> 1, hf = tid & 1;
    bf16_t* o = dst + (size_t)(n0 + nn) * K + k0 + hf * 32;
#pragma unroll
    for (int q = 0; q < 4; ++q) { u32x4 w; const float* sp = sm + (hf * 32 + q * 8) * 257 + nn;
        w.x = pk2(sp[0], sp[257]); w.y = pk2(sp[2 * 257], sp[3 * 257]); w.z = pk2(sp[4 * 257], sp[5 * 257]); w.w = pk2(sp[6 * 257], sp[7 * 257]); *(u32x4*)(o + q * 8) = w; }
    __syncthreads();
}
__device__ void phase_convert(const Params& p, int layer, float* sm) {
    unsigned char* ws = p.ws;
    const int G = gridDim.x, b = blockIdx.x;
    const int n0 = 32 * 24, n1 = n0 + 32 * 8, n2 = n1 + 32 * 43, n3 = n2 + 86 * 8, n4 = n3 + 32, n5 = n4 + 32, n6 = n5 + 16;
    for (int it = b; it < n6; it += G) {
        if (it < n0)      convT_tile(p.in[2]  + (size_t)layer * DM * 5928, 5928, DM, (bf16_t*)(ws + O_WIN), it, true, sm);
        else if (it < n1) convT_tile(p.in[27] + (size_t)layer * DM * DM, DM, DM, (bf16_t*)(ws + O_WOUT), it - n0, false, sm);
        else if (it < n2) convT_tile(p.in[29] + (size_t)layer * DM * NFF, NFF, DM, (bf16_t*)(ws + O_WFIN), it - n1, false, sm);
        else if (it < n3) convT_tile(p.in[32] + (size_t)layer * DFF * DM, DM, DFF, (bf16_t*)(ws + O_WFOUT), it - n2, false, sm);
        else if (it < n4) convT_tile(p.in[8]  + (size_t)layer * 2048 * 256, 256, 2048, (bf16_t*)(ws + O_WCK), it - n3, false, sm);
        else if (it < n5) convT_tile(p.in[10] + (size_t)layer * 2048 * 256, 256, 2048, (bf16_t*)(ws + O_WCV), it - n4, false, sm);
        else              convT_tile(p.in[21] + (size_t)layer * 512 * 512, 512, 512, (bf16_t*)(ws + O_WGLU), it - n5, false, sm);
    }
}
__device__ void phase_rmsnorm(const float* __restrict__ x, const float* __restrict__ gain, bf16_t* __restrict__ hn, float* __restrict__ xcopy) {
    const int wave = tidx() >> 6, lane = tidx() & 63;
    for (int r = blockIdx.x * 8 + wave; r < T_; r += gridDim.x * 8) {
        const f32x4* xr = (const f32x4*)(x + (size_t)r * DM);
        f32x4 v[8]; float ss = 0.f;
#pragma unroll
        for (int i = 0; i < 8; ++i) { v[i] = xr[lane + 64 * i]; ss += v[i][0] * v[i][0] + v[i][1] * v[i][1] + v[i][2] * v[i][2] + v[i][3] * v[i][3]; }
        ss = wave_sum(ss);
        const float rs = rsqrtf(ss * (1.0f / DM) + 1e-6f);
#pragma unroll
        for (int i = 0; i < 8; ++i) { const f32x4 g = ((const f32x4*)gain)[lane + 64 * i]; u32x2 w; w.x = pk2(v[i][0] * rs * g[0], v[i][1] * rs * g[1]); w.y = pk2(v[i][2] * rs * g[2], v[i][3] * rs * g[3]);
            *(u32x2*)(hn + (size_t)r * DM + (lane + 64 * i) * 4) = w; if (xcopy) ((f32x4*)(xcopy + (size_t)r * DM))[lane + 64 * i] = v[i]; }
    }
}

__device__ void nsa_prep_item(const Params& p, int layer, int item, float* sm) {
    unsigned char* ws = p.ws;
    const float* P32 = (const float*)(ws + O_P32);
    bf16_t* qn = (bf16_t*)(ws + O_QN); bf16_t* ksn = (bf16_t*)(ws + O_KSN); bf16_t* kwn = (bf16_t*)(ws + O_KWN);
    const int wave = tidx() >> 6, lane = tidx() & 63, tid = tidx();
    const int t0 = item * 64;
    const float gq = p.in[3][layer * 64 + lane], gks = p.in[5][layer * 64 + lane], gkw = p.in[6][layer * 64 + lane];
    const float inv = powf(500000.0f, -(float)(lane & 7) * 0.125f);
    for (int tt = 0; tt < 8; ++tt) {
        const int t = t0 + wave * 8 + tt;
        float sn, cs; sincosf((float)t * inv, &sn, &cs);
        const float* row = P32 + (size_t)t * 1536;
#pragma unroll
        for (int hv = 0; hv < 12; ++hv) {
            const int col = hv < 8 ? hv * 64 : (hv < 10 ? 768 + (hv - 8) * 64 : 1024 + (hv - 10) * 64);
            const float g = hv < 8 ? gq : (hv < 10 ? gks : gkw);
            const float x = row[col + lane];
            const float ss = wave_sum(x * x);
            float y = x * rsqrtf(ss * (1.0f / 64.0f) + 1e-6f) * g;
            const float yp = __shfl(y, lane ^ 8);
            if (lane < 8) y = y * cs - yp * sn; else if (lane < 16) y = y * cs + yp * sn;
            if (hv < 8) qn[(size_t)t * 512 + hv * 64 + lane] = f2bf(y * 0.18033688011112042f);
            else {
                unsigned char* k8 = (hv < 10 ? ws + O_KSN : ws + O_KWN) + ((size_t)(((hv - 8) & 1) * 256 + (t >> 6)) * 64 + (t & 63)) * 64 + ((lane >> 3) & 3) * 16 + (lane >> 5) * 8 + (lane & 7);
                *k8 = (unsigned char)__builtin_amdgcn_cvt_pk_fp8_f32(y, 0.f, 0, false);
            }
        }
    }
    for (int e = tid; e < 64 * 256; e += 512) { const int tk = e >> 8, c = e & 255; sm[tk * 257 + c] = P32[(size_t)(t0 + tk) * 1536 + (c < 128 ? 896 + c : 1152 + (c - 128))]; }
    __syncthreads();
    unsigned char* vs8 = ws + O_VST; unsigned char* vw8 = ws + O_VWT;
#pragma unroll
    for (int i = 0; i < 4; ++i) {
        const int rowid = (tid >> 3) + 64 * i, ts = tid & 7;
        float f[8];
#pragma unroll
        for (int k = 0; k < 8; ++k) { const int bb = ts * 8 + k, cc = ((bb >> 3) & 1) * 32 + (bb >> 4) * 8 + (bb & 7); f[k] = sm[((cc & 3) * 16 + (cc >> 2)) * 257 + rowid]; }
        u32x2 w; int t;
        t = __builtin_amdgcn_cvt_pk_fp8_f32(f[0], f[1], 0, false); t = __builtin_amdgcn_cvt_pk_fp8_f32(f[2], f[3], t, true); w.x = (unsigned)t;
        t = __builtin_amdgcn_cvt_pk_fp8_f32(f[4], f[5], 0, false); t = __builtin_amdgcn_cvt_pk_fp8_f32(f[6], f[7], t, true); w.y = (unsigned)t;
        const int rr = rowid & 127;
        unsigned char* dst = (rowid < 128 ? vs8 : vw8) + ((size_t)((rr >> 6) * 256 + item) * 64 + (rr & 63)) * 64 + ts * 8;
        *(u32x2*)dst = w;
    }
    __syncthreads();
}

__device__ void cmp1_wave_tile(const Params& p, int layer, int tile) {
    unsigned char* ws = p.ws;
    const float* P32 = (const float*)(ws + O_P32);
    const int lane = tidx() & 63, fr = lane & 15, fq = lane >> 4;
    const int nt = tile & 15, mt = (tile >> 4) & 127, which = tile >> 11;
    const bf16_t* Wt = (const bf16_t*)(ws + (which ? O_WCV : O_WCK)) + (size_t)(nt * 16 + fr) * 2048 + fq * 8;
    const float* pe = p.in[7] + (size_t)layer * 2048;
    const int r = mt * 16 + fr, n = r >> 1, hk = r & 1;
    const bool rv = n < 1023;
    const float* arow = P32 + (size_t)(16 * (rv ? n : 0)) * 1536 + (which ? 640 : 512) + hk * 64 + fq * 8;
    f32x4 acc = {0.f, 0.f, 0.f, 0.f};
#pragma unroll 8
    for (int ks = 0; ks < 64; ++ks) {
        const int l = ks >> 1, d = (ks & 1) * 32;
        const f32x4* ap = (const f32x4*)(arow + (size_t)l * 1536 + d);
        const f32x4* pp = (const f32x4*)(pe + l * 64 + d + fq * 8);
        f32x4 a0 = ap[0] + pp[0], a1 = ap[1] + pp[1];
        if (!rv) { a0 = (f32x4){0.f, 0.f, 0.f, 0.f}; a1 = a0; }
        const bf16x8 af = pack8f(a0, a1);
        const bf16x8 bf = *(const bf16x8*)(Wt + ks * 32);
        acc = MFMA16(af, bf, acc);
    }
    float* H = (float*)(ws + O_HCMP) + (size_t)which * 2048 * 256;
#pragma unroll
    for (int j = 0; j < 4; ++j) H[(size_t)(mt * 16 + fq * 4 + j) * 256 + nt * 16 + fr] = gelu_tanh(acc[j]);
}
__device__ void cmp2_wave_row(const Params& p, int layer, int idx) {
    unsigned char* ws = p.ws;
    const int lane = tidx() & 63;
    const int which = idx >> 11, r = idx & 2047, n = r >> 1, hk = r & 1;
    const float* H = (const float*)(ws + O_HCMP) + ((size_t)which * 2048 + r) * 256;
    const float* w2 = p.in[which ? 11 : 9] + (size_t)layer * 256 * 64;
    float acc = 0.f;
    if (n < 1023) {
        float a4[4] = {0.f, 0.f, 0.f, 0.f};
#pragma unroll 8
        for (int f = 0; f < 256; f += 4) { const f32x4 h4 = *(const f32x4*)(H + f); a4[0] += h4[0] * w2[f * 64 + lane]; a4[1] += h4[1] * w2[(f + 1) * 64 + lane]; a4[2] += h4[2] * w2[(f + 2) * 64 + lane]; a4[3] += h4[3] * w2[(f + 3) * 64 + lane]; }
        acc = (a4[0] + a4[1]) + (a4[2] + a4[3]);
    }
    if (which == 0) {
        const float ss = wave_sum(acc * acc);
        float y = acc * rsqrtf(ss * (1.0f / 64.0f) + 1e-6f) * p.in[4][layer * 64 + lane];
        const float inv = powf(500000.0f, -(float)(lane & 7) * 0.125f);
        float sn, cs; sincosf((float)(16 * n + 16) * inv, &sn, &cs);
        const float yp = __shfl(y, lane ^ 8);
        if (lane < 8) y = y * cs - yp * sn; else if (lane < 16) y = y * cs + yp * sn;
        if (n >= 1023) y = 0.f;
        ((bf16_t*)(ws + O_KC))[((size_t)hk * 1024 + n) * 64 + lane] = f2bf(y);
    } else {
        { const int cc = ((n & 15) << 2) | ((n >> 4) & 3); (ws + O_VCT)[((size_t)(hk * 16 + (n >> 6)) * 64 + lane) * 64 + ((cc >> 3) & 3) * 16 + (cc >> 5) * 8 + (cc & 7)] = (unsigned char)__builtin_amdgcn_cvt_pk_fp8_f32(acc, 0.f, 0, false); }
    }
}

typedef float f32x2 __attribute__((ext_vector_type(2)));
struct S5Coef { float ar, ai; f32x2 bb[16]; };
__device__ __forceinline__ void s5_setup(const Params& p, int layer, int g, int lane, S5Coef& c) {
    const int gp = layer * 2048 + g * 64 + lane;
    const float dt = expf(p.in[15][layer * 32 + g]);
    const float lr = p.in[13][gp], li = p.in[14][gp];
    const float mag = expf(lr * dt); float sn, cs; sincosf(li * dt, &sn, &cs);
    c.ar = mag * cs; c.ai = mag * sn;
    const float den = lr * lr + li * li, nr = c.ar - 1.0f, ni = c.ai;
    const float cr = (nr * lr + ni * li) / den, ci = (ni * lr - nr * li) / den;
    const f32x4* br = (const f32x4*)(p.in[16] + (size_t)gp * 16); const f32x4* bi = (const f32x4*)(p.in[17] + (size_t)gp * 16);
#pragma unroll
    for (int q = 0; q < 4; ++q) { const f32x4 a = br[q], b = bi[q];
#pragma unroll
        for (int e = 0; e < 4; ++e) c.bb[q * 4 + e] = (f32x2){cr * a[e] - ci * b[e], cr * b[e] + ci * a[e]}; }
}
__device__ __forceinline__ void s5_stage_u(const bf16_t* Pu, int tok, int g, float* ul, int lane) {
    const u32x4* s = (const u32x4*)(Pu + (size_t)tok * 512 + g * 16); const u32x4 a = s[0], b = s[1];
    f32x4* o = (f32x4*)(ul + lane * 16);
    o[0] = (f32x4){bflo(a.x), bfhi(a.x), bflo(a.y), bfhi(a.y)}; o[1] = (f32x4){bflo(a.z), bfhi(a.z), bflo(a.w), bfhi(a.w)};
    o[2] = (f32x4){bflo(b.x), bfhi(b.x), bflo(b.y), bfhi(b.y)}; o[3] = (f32x4){bflo(b.z), bfhi(b.z), bflo(b.w), bfhi(b.w)};
    asm volatile("s_waitcnt lgkmcnt(0)" ::: "memory");
}
__device__ __forceinline__ void s5_step(const S5Coef& k, const float* uj, float& xr, float& xi) {
    const f32x4 u0 = ((const f32x4*)uj)[0], u1 = ((const f32x4*)uj)[1], u2 = ((const f32x4*)uj)[2], u3 = ((const f32x4*)uj)[3];
    f32x2 acc0 = {0.f, 0.f}, acc1 = {0.f, 0.f};
#pragma unroll
    for (int e = 0; e < 4; ++e) { acc0 += k.bb[e] * u0[e]; acc1 += k.bb[4 + e] * u1[e]; }
#pragma unroll
    for (int e = 0; e < 4; ++e) { acc0 += k.bb[8 + e] * u2[e]; acc1 += k.bb[12 + e] * u3[e]; }
    const f32x2 bu = acc0 + acc1;
    const float nxr = k.ar * xr - k.ai * xi + bu[0], nxi = k.ar * xi + k.ai * xr + bu[1]; xr = nxr; xi = nxi;
}
__device__ void s5_passA_wave(const Params& p, int layer, int item, float* ul) {
    unsigned char* ws = p.ws; const bf16_t* Pu = (const bf16_t*)(ws + O_PU);
    const int lane = tidx() & 63, c = item >> 5, g = item & 31;
    S5Coef k; s5_setup(p, layer, g, lane, k);
    float xr = 0.f, xi = 0.f;
    for (int sub = 0; sub < 4; ++sub) {
        s5_stage_u(Pu, c * 256 + sub * 64 + lane, g, ul, lane);
#pragma unroll 4
        for (int j = 0; j < 64; ++j) s5_step(k, ul + j * 16, xr, xi);
        asm volatile("s_waitcnt lgkmcnt(0)" ::: "memory");
    }
    float* xe = (float*)(ws + O_XEND) + ((size_t)(c * 32 + g) * 64 + lane) * 2; xe[0] = xr; xe[1] = xi;
}
__device__ void s5_passB_wave(const Params& p, int layer, int item, bf16_t* xl, float* ul) {
    unsigned char* ws = p.ws; const bf16_t* Pu = (const bf16_t*)(ws + O_PU); bf16_t* yg = (bf16_t*)(ws + O_YGELU);
    const int lane = tidx() & 63, fr = lane & 15, fq = lane >> 4, c = item >> 5, g = item & 31;
    S5Coef k; s5_setup(p, layer, g, lane, k);
    float pr = k.ar, pi = k.ai;
#pragma unroll
    for (int s = 0; s < 8; ++s) { const float nr = pr * pr - pi * pi, ni = 2.f * pr * pi; pr = nr; pi = ni; }
    float xr = 0.f, xi = 0.f;
    const float* xe = (const float*)(ws + O_XEND) + ((size_t)g * 64 + lane) * 2;
#pragma unroll 8
    for (int cc = 0; cc < c; ++cc) { const float er = xe[(size_t)cc * 32 * 64 * 2], ei = xe[(size_t)cc * 32 * 64 * 2 + 1]; const float nr = pr * xr - pi * xi + er, ni = pr * xi + pi * xr + ei; xr = nr; xi = ni; }
    bf16x8 cf[4];
    {
        const float* cre = p.in[18] + (size_t)layer * 32 * 16 * 64 + ((size_t)g * 16 + fr) * 64; const float* cim = p.in[19] + (size_t)layer * 32 * 16 * 64 + ((size_t)g * 16 + fr) * 64;
#pragma unroll
        for (int ks = 0; ks < 4; ++ks) { const float* s = (ks < 2 ? cre : cim) + (ks & 1) * 32 + fq * 8; f32x4 a = ((const f32x4*)s)[0], b = ((const f32x4*)s)[1]; if (ks >= 2) { a = -a; b = -b; } cf[ks] = pack8f(a, b); }
    }
    const float dsk = p.in[20][layer * 512 + g * 16 + fr];
    for (int sub = 0; sub < 4; ++sub) {
        const int tb = c * 256 + sub * 64;
        s5_stage_u(Pu, tb + lane, g, ul, lane);
        for (int jb = 0; jb < 4; ++jb) {
#pragma unroll 4
            for (int jj = 0; jj < 16; ++jj) {
                s5_step(k, ul + (jb * 16 + jj) * 16, xr, xi);
                xl[jj * 136 + lane] = f2bf(xr); xl[jj * 136 + 64 + lane] = f2bf(xi);
            }
            asm volatile("s_waitcnt lgkmcnt(0)" ::: "memory");
            f32x4 y = {0.f, 0.f, 0.f, 0.f};
#pragma unroll
            for (int ks = 0; ks < 4; ++ks) { const bf16x8 af = *(const bf16x8*)(xl + fr * 136 + ks * 32 + fq * 8); y = MFMA16(af, cf[ks], y); }
            asm volatile("s_waitcnt lgkmcnt(0)" ::: "memory");
#pragma unroll
            for (int q = 0; q < 4; ++q) { const int tl = jb * 16 + fq * 4 + q; const float u = ul[tl * 16 + fr]; yg[(size_t)(tb + tl) * 512 + g * 16 + fr] = f2bf(gelu_tanh(y[q] + dsk * u)); }
        }
        asm volatile("s_waitcnt lgkmcnt(0)" ::: "memory");
    }
}
__device__ void gdn_prep_item(const Params& p, int layer, int item, unsigned char* lds) {
    unsigned char* ws = p.ws;
    const int tid = tidx(), wave = tid >> 6, lane = tid & 63, fr = lane & 15, fq = lane >> 4;
    const int n = item >> 3, h = item & 7, t0 = n * 64;
    bf16_t* qs = (bf16_t*)(lds); bf16_t* ks = (bf16_t*)(lds + 17408); bf16_t* vbT = (bf16_t*)(lds + 34816); bf16_t* kgT = (bf16_t*)(lds + 53248); bf16_t* kdT = (bf16_t*)(lds + 71680);
    float* Am = (float*)(lds + 90112); bf16_t* Tb = (bf16_t*)(lds + 107520); float* gcs = (float*)(lds + 116736); float* bts = (float*)(lds + 116992);
    const float* P32 = (const float*)(ws + O_P32); const bf16_t* Pqkv = (const bf16_t*)(ws + O_PQKV);
    if (wave == 0) {
        const int t = t0 + lane;
        const float a = P32[(size_t)t * 1536 + 1304 + h], b = P32[(size_t)t * 1536 + 1312 + h];
        const float g = -expf(p.in[24][layer * 8 + h]) * softplusf_(a + p.in[25][layer * 8 + h]);
        float s = g;
#pragma unroll
        for (int off = 1; off < 64; off <<= 1) { const float o = __shfl_up(s, off); if (lane >= off) s += o; }
        gcs[lane] = s; bts[lane] = sigmoidf_(b);
    }
    __syncthreads();
    {
        const int r = tid >> 3, c0 = (tid & 7) * 16;
        const float gcr = gcs[r], btr = bts[r], eg = expf(gcr), ed = expf(gcs[63] - gcr);
        const float* cw = p.in[23] + (size_t)layer * 4 * 3072;
#pragma unroll
        for (int which = 0; which < 3; ++which) {
            const int col = which * 1024 + h * 128 + c0;
            float acc[16];
#pragma unroll
            for (int e = 0; e < 16; ++e) acc[e] = 0.f;
#pragma unroll
            for (int j = 0; j < 4; ++j) {
                const int tr = t0 + r - 3 + j;
                if (tr >= 0) {
                    const u32x4* s = (const u32x4*)(Pqkv + (size_t)tr * 3072 + col); const u32x4 a = s[0], b = s[1];
                    const f32x4* wp = (const f32x4*)(cw + j * 3072 + col); const f32x4 w0 = wp[0], w1 = wp[1], w2 = wp[2], w3 = wp[3];
                    acc[0] += w0[0] * bflo(a.x); acc[1] += w0[1] * bfhi(a.x); acc[2] += w0[2] * bflo(a.y); acc[3] += w0[3] * bfhi(a.y);
                    acc[4] += w1[0] * bflo(a.z); acc[5] += w1[1] * bfhi(a.z); acc[6] += w1[2] * bflo(a.w); acc[7] += w1[3] * bfhi(a.w);
                    acc[8] += w2[0] * bflo(b.x); acc[9] += w2[1] * bfhi(b.x); acc[10] += w2[2] * bflo(b.y); acc[11] += w2[3] * bfhi(b.y);
                    acc[12] += w3[0] * bflo(b.z); acc[13] += w3[1] * bfhi(b.z); acc[14] += w3[2] * bflo(b.w); acc[15] += w3[3] * bfhi(b.w);
                }
            }
            float ss = 0.f;
#pragma unroll
            for (int e = 0; e < 16; ++e) { acc[e] = siluf_(acc[e]); ss += acc[e] * acc[e]; }
            ss += __shfl_xor(ss, 1); ss += __shfl_xor(ss, 2); ss += __shfl_xor(ss, 4);
            const float rn = rsqrtf(ss + 1e-6f);
            if (which == 0) {
                bf16_t* qg = (bf16_t*)(ws + O_GQG) + (size_t)item * 8192 + r * 128 + c0;
                float v[16];
#pragma unroll
                for (int e = 0; e < 16; ++e) v[e] = acc[e] * rn * 0.08838834764831845f;
                u32x4 w0, w1; w0.x = pk2(v[0], v[1]); w0.y = pk2(v[2], v[3]); w0.z = pk2(v[4], v[5]); w0.w = pk2(v[6], v[7]); w1.x = pk2(v[8], v[9]); w1.y = pk2(v[10], v[11]); w1.z = pk2(v[12], v[13]); w1.w = pk2(v[14], v[15]);
                *(u32x4*)(qs + r * 136 + c0) = w0; *(u32x4*)(qs + r * 136 + c0 + 8) = w1;
                u32x4 g0, g1; g0.x = pk2(v[0] * eg, v[1] * eg); g0.y = pk2(v[2] * eg, v[3] * eg); g0.z = pk2(v[4] * eg, v[5] * eg); g0.w = pk2(v[6] * eg, v[7] * eg);
                g1.x = pk2(v[8] * eg, v[9] * eg); g1.y = pk2(v[10] * eg, v[11] * eg); g1.z = pk2(v[12] * eg, v[13] * eg); g1.w = pk2(v[14] * eg, v[15] * eg);
                *(u32x4*)qg = g0; *(u32x4*)(qg + 8) = g1;
            } else if (which == 1) {
                float v[16];
#pragma unroll
                for (int e = 0; e < 16; ++e) v[e] = acc[e] * rn;
                u32x4 w0, w1; w0.x = pk2(v[0], v[1]); w0.y = pk2(v[2], v[3]); w0.z = pk2(v[4], v[5]); w0.w = pk2(v[6], v[7]); w1.x = pk2(v[8], v[9]); w1.y = pk2(v[10], v[11]); w1.z = pk2(v[12], v[13]); w1.w = pk2(v[14], v[15]);
                *(u32x4*)(ks + r * 136 + c0) = w0; *(u32x4*)(ks + r * 136 + c0 + 8) = w1;
#pragma unroll
                for (int e = 0; e < 16; ++e) { kgT[(c0 + e) * 72 + r] = f2bf(v[e] * btr * eg); kdT[(c0 + e) * 72 + r] = f2bf(v[e] * ed); }
            } else {
#pragma unroll
                for (int e = 0; e < 16; ++e) vbT[(c0 + e) * 72 + r] = f2bf(acc[e] * btr);
            }
        }
    }
    __syncthreads();
    {
        const int d = tid >> 2, sg = tid & 3;
        const u32x4 a = *(const u32x4*)(kdT + d * 72 + sg * 16), b = *(const u32x4*)(kdT + d * 72 + sg * 16 + 8);
        bf16_t* dst = (bf16_t*)(ws + O_GKD) + (size_t)item * 8192 + d * 64 + sg * 16; *(u32x4*)dst = a; *(u32x4*)(dst + 8) = b;
    }
    { float* Tmz = (float*)(lds + 117248); for (int e2 = tid; e2 < 64 * 68; e2 += 512) Tmz[e2] = 0.f; }
    {
        const int mi = wave >> 1;
        bf16_t* qko = (bf16_t*)(ws + O_GQK) + (size_t)item * 4096;
#pragma unroll
        for (int q = 0; q < 2; ++q) {
            const int nj = (wave & 1) * 2 + q;
            f32x4 kk = {0.f, 0.f, 0.f, 0.f}, qk = {0.f, 0.f, 0.f, 0.f};
            if (nj <= mi) {
#pragma unroll
                for (int s = 0; s < 4; ++s) {
                    const bf16x8 bk = *(const bf16x8*)(ks + (nj * 16 + fr) * 136 + s * 32 + fq * 8);
                    const bf16x8 ak = *(const bf16x8*)(ks + (mi * 16 + fr) * 136 + s * 32 + fq * 8);
                    const bf16x8 aq = *(const bf16x8*)(qs + (mi * 16 + fr) * 136 + s * 32 + fq * 8);
                    kk = MFMA16(ak, bk, kk); qk = MFMA16(aq, bk, qk);
                }
            }
            const int j = nj * 16 + fr; const float gj = gcs[j];
#pragma unroll
            for (int e = 0; e < 4; ++e) {
                const int i = mi * 16 + fq * 4 + e;
                const float dec = (j <= i) ? expf(gcs[i] - gj) : 0.f;
                Am[i * 68 + j] = (j < i) ? bts[i] * kk[e] * dec : 0.f;
                qko[i * 64 + j] = f2bf((j <= i) ? qk[e] * dec : 0.f);
            }
        }
    }
    __syncthreads();
    {
        float* Tm = (float*)(lds + 117248); float* Ps = (float*)(lds + 134656) + wave * 320;
        if (wave == 0) {
            const int bo = fq * 16; float t[16];
#pragma unroll
            for (int i = 0; i < 16; ++i) {
                float s = (i == fr) ? 1.f : 0.f;
#pragma unroll
                for (int j = 0; j < i; ++j) s -= Am[(bo + i) * 68 + bo + j] * t[j];
                t[i] = s; Tm[(bo + i) * 68 + bo + fr] = s;
            }
        }
        asm volatile("s_waitcnt lgkmcnt(0)" ::: "memory"); __syncthreads();
#pragma unroll
        for (int d = 1; d < 4; ++d) {
            if (wave < 4 - d) {
                const int bi = wave + d, bj = wave;
                f32x4 Q = {0.f, 0.f, 0.f, 0.f};
                for (int kb = bj; kb < bi; ++kb) {
                    const float* X = Am + (bi * 16) * 68 + kb * 16; const float* Y = Tm + (kb * 16) * 68 + bj * 16;
#pragma unroll
                    for (int s = 0; s < 4; ++s) Q = __builtin_amdgcn_mfma_f32_16x16x4f32(X[fr * 68 + 4 * s + fq], Y[(4 * s + fq) * 68 + fr], Q, 0, 0, 0);
                }
#pragma unroll
                for (int e2 = 0; e2 < 4; ++e2) Ps[(fq * 4 + e2) * 20 + fr] = Q[e2];
                asm volatile("s_waitcnt lgkmcnt(0)" ::: "memory");
                f32x4 R = {0.f, 0.f, 0.f, 0.f};
                const float* X = Tm + (bi * 16) * 68 + bi * 16;
#pragma unroll
                for (int s = 0; s < 4; ++s) R = __builtin_amdgcn_mfma_f32_16x16x4f32(X[fr * 68 + 4 * s + fq], Ps[(4 * s + fq) * 20 + fr], R, 0, 0, 0);
#pragma unroll
                for (int e2 = 0; e2 < 4; ++e2) Tm[(bi * 16 + fq * 4 + e2) * 68 + bj * 16 + fr] = -R[e2];
            }
            asm volatile("s_waitcnt lgkmcnt(0)" ::: "memory"); __syncthreads();
        }
        for (int e2 = tid; e2 < 4096; e2 += 512) { const int r = e2 >> 6, c = e2 & 63; Tb[r * 72 + c] = f2bf(Tm[r * 68 + c]); }
    }
    __syncthreads();
    {
        const int mi = wave & 3;
        const bf16x8 a0 = *(const bf16x8*)(Tb + (mi * 16 + fr) * 72 + fq * 8), a1 = *(const bf16x8*)(Tb + (mi * 16 + fr) * 72 + 32 + fq * 8);
        float* vo = (float*)(ws + O_GVAL) + (size_t)item * 8192; bf16_t* ko = (bf16_t*)(ws + O_GKC) + (size_t)item * 8192;
#pragma unroll
        for (int q = 0; q < 4; ++q) {
            const int nt = (wave >> 2) * 4 + q;
            f32x4 v = {0.f, 0.f, 0.f, 0.f}, kc = {0.f, 0.f, 0.f, 0.f};
            v = MFMA16(a0, *(const bf16x8*)(vbT + (nt * 16 + fr) * 72 + fq * 8), v); v = MFMA16(a1, *(const bf16x8*)(vbT + (nt * 16 + fr) * 72 + 32 + fq * 8), v);
            kc = MFMA16(a0, *(const bf16x8*)(kgT + (nt * 16 + fr) * 72 + fq * 8), kc); kc = MFMA16(a1, *(const bf16x8*)(kgT + (nt * 16 + fr) * 72 + 32 + fq * 8), kc);
#pragma unroll
            for (int e = 0; e < 4; ++e) { const int i = mi * 16 + fq * 4 + e, d = nt * 16 + fr; vo[i * 128 + d] = v[e]; ko[i * 128 + d] = f2bf(kc[e]); }
        }
    }
    if (tid == 0) ((float*)(ws + O_GEGL))[item] = expf(gcs[63]);
    __syncthreads();
}

struct GdnUO { bf16x8 kc[4], qg[4], qk[2]; float val[2][4]; };
struct GdnSU { bf16x8 kd[2][2]; float egl; };
__device__ __forceinline__ void gdn_load_uo(const unsigned char* ws, int item, int mt, int fr, int fq, int dvb, GdnUO& f) {
    const bf16_t* kc = (const bf16_t*)(ws + O_GKC) + (size_t)item * 8192 + (mt * 16 + fr) * 128 + fq * 8;
    const bf16_t* qg = (const bf16_t*)(ws + O_GQG) + (size_t)item * 8192 + (mt * 16 + fr) * 128 + fq * 8;
    const bf16_t* qk = (const bf16_t*)(ws + O_GQK) + (size_t)item * 4096 + (mt * 16 + fr) * 64 + fq * 8;
    const float* vl = (const float*)(ws + O_GVAL) + (size_t)item * 8192 + (mt * 16 + fq * 4) * 128 + dvb + fr;
#pragma unroll
    for (int s = 0; s < 4; ++s) { f.kc[s] = *(const bf16x8*)(kc + s * 32); f.qg[s] = *(const bf16x8*)(qg + s * 32); }
#pragma unroll
    for (int s = 0; s < 2; ++s) f.qk[s] = *(const bf16x8*)(qk + s * 32);
#pragma unroll
    for (int nt = 0; nt < 2; ++nt)
#pragma unroll
        for (int e = 0; e < 4; ++e) f.val[nt][e] = vl[e * 128 + nt * 16];
}
__device__ __forceinline__ void gdn_load_su(const unsigned char* ws, int item, int w4, int fr, int fq, GdnSU& f) {
    const bf16_t* kd = (const bf16_t*)(ws + O_GKD) + (size_t)item * 8192 + (2 * w4 * 16 + fr) * 64 + fq * 8;
#pragma unroll
    for (int s = 0; s < 2; ++s) { f.kd[0][s] = *(const bf16x8*)(kd + s * 32); f.kd[1][s] = *(const bf16x8*)(kd + 16 * 64 + s * 32); }
    f.egl = ((const float*)(ws + O_GEGL))[item];
}
#define GDN_BAR() do { asm volatile("s_waitcnt lgkmcnt(0)" ::: "memory"); __builtin_amdgcn_s_barrier(); asm volatile("" ::: "memory"); } while (0)
__device__ __forceinline__ void gdn_step_uo(const GdnUO& c, bf16_t* Sl, bf16_t* vn, float* go, int n, int h, int mt, int fr, int fq, int dvb) {
    bf16x8 Sb[2][4];
#pragma unroll
    for (int nt = 0; nt < 2; ++nt)
#pragma unroll
        for (int s = 0; s < 4; ++s) Sb[nt][s] = *(const bf16x8*)(Sl + nt * (16 * 136) + fr * 136 + s * 32 + fq * 8);
    f32x4 U[2], O[2];
#pragma unroll
    for (int nt = 0; nt < 2; ++nt) { U[nt] = (f32x4){0.f, 0.f, 0.f, 0.f}; O[nt] = (f32x4){0.f, 0.f, 0.f, 0.f};
#pragma unroll
        for (int s = 0; s < 4; ++s) U[nt] = MFMA16(c.kc[s], Sb[nt][s], U[nt]);
        u32x2 w; w.x = pk2(c.val[nt][0] - U[nt][0], c.val[nt][1] - U[nt][1]); w.y = pk2(c.val[nt][2] - U[nt][2], c.val[nt][3] - U[nt][3]);
        *(u32x2*)(vn + nt * (16 * 72) + fr * 72 + mt * 16 + fq * 4) = w; }
#pragma unroll
    for (int nt = 0; nt < 2; ++nt)
#pragma unroll
        for (int s = 0; s < 4; ++s) O[nt] = MFMA16(c.qg[s], Sb[nt][s], O[nt]);
    GDN_BAR();
#pragma unroll
    for (int nt = 0; nt < 2; ++nt) {
        const bf16x8 V0 = *(const bf16x8*)(vn + nt * (16 * 72) + fr * 72 + fq * 8), V1 = *(const bf16x8*)(vn + nt * (16 * 72) + fr * 72 + 32 + fq * 8);
        O[nt] = MFMA16(c.qk[0], V0, O[nt]); O[nt] = MFMA16(c.qk[1], V1, O[nt]);
#pragma unroll
        for (int e = 0; e < 4; ++e) go[(size_t)(n * 64 + mt * 16 + fq * 4 + e) * 1024 + h * 128 + dvb + nt * 16 + fr] = O[nt][e];
    }
    GDN_BAR();
}
__device__ __forceinline__ void gdn_step_su(const GdnSU& c, f32x4 (&St)[2][2], bf16_t* Sl, const bf16_t* vn, int w4, int fr, int fq) {
    GDN_BAR();
#pragma unroll
    for (int nt = 0; nt < 2; ++nt) {
        const bf16x8 V0 = *(const bf16x8*)(vn + nt * (16 * 72) + fr * 72 + fq * 8), V1 = *(const bf16x8*)(vn + nt * (16 * 72) + fr * 72 + 32 + fq * 8);
#pragma unroll
        for (int q = 0; q < 2; ++q) {
            St[nt][q] = St[nt][q] * c.egl;
            St[nt][q] = MFMA16(V0, c.kd[q][0], St[nt][q]); St[nt][q] = MFMA16(V1, c.kd[q][1], St[nt][q]);
#pragma unroll
            for (int e = 0; e < 4; ++e) Sl[nt * (16 * 136) + (fq * 4 + e) * 136 + (2 * w4 + q) * 16 + fr] = f2bf(St[nt][q][e]);
        }
    }
    GDN_BAR();
}
__device__ void gdn_recurrence(const Params& p, int b, unsigned char* lds) {
    const unsigned char* ws = p.ws;
    const int tid = tidx(), wave = tid >> 6, lane = tid & 63, fr = lane & 15, fq = lane >> 4;
    const int h = b >> 2, dvb = (b & 3) * 32;
    bf16_t* Sl = (bf16_t*)lds; bf16_t* vn = (bf16_t*)(lds + 2 * 16 * 136 * 2);
    float* go = (float*)(p.ws + O_PQKV);
    for (int e = tid; e < 2 * 16 * 136; e += 512) Sl[e] = 0;
    __syncthreads();
    if (wave < 4) {
        const int mt = wave;
        GdnUO f0, f1, f2;
        gdn_load_uo(ws, h, mt, fr, fq, dvb, f0); gdn_load_uo(ws, 8 + h, mt, fr, fq, dvb, f1);
        for (int n = 0; n < 255; n += 3) {
            gdn_load_uo(ws, (n + 2) * 8 + h, mt, fr, fq, dvb, f2); gdn_step_uo(f0, Sl, vn, go, n, h, mt, fr, fq, dvb);
            gdn_load_uo(ws, (n + 3) * 8 + h, mt, fr, fq, dvb, f0); gdn_step_uo(f1, Sl, vn, go, n + 1, h, mt, fr, fq, dvb);
            if (n + 4 < 256) gdn_load_uo(ws, (n + 4) * 8 + h, mt, fr, fq, dvb, f1);
            gdn_step_uo(f2, Sl, vn, go, n + 2, h, mt, fr, fq, dvb);
        }
        gdn_step_uo(f0, Sl, vn, go, 255, h, mt, fr, fq, dvb);
    } else {
        const int w4 = wave - 4;
        f32x4 St[2][2];
#pragma unroll
        for (int a = 0; a < 2; ++a)
#pragma unroll
            for (int c = 0; c < 2; ++c) St[a][c] = (f32x4){0.f, 0.f, 0.f, 0.f};
        GdnSU f0, f1, f2;
        gdn_load_su(ws, h, w4, fr, fq, f0); gdn_load_su(ws, 8 + h, w4, fr, fq, f1);
        for (int n = 0; n < 255; n += 3) {
            gdn_load_su(ws, (n + 2) * 8 + h, w4, fr, fq, f2); gdn_step_su(f0, St, Sl, vn, w4, fr, fq);
            gdn_load_su(ws, (n + 3) * 8 + h, w4, fr, fq, f0); gdn_step_su(f1, St, Sl, vn, w4, fr, fq);
            if (n + 4 < 256) gdn_load_su(ws, (n + 4) * 8 + h, w4, fr, fq, f1);
            gdn_step_su(f2, St, Sl, vn, w4, fr, fq);
        }
        gdn_step_su(f0, St, Sl, vn, w4, fr, fq);
    }
}
struct KVF { bf16x8 k[4][2]; };
__device__ __forceinline__ void kv_load(const bf16_t* kp, int ldk, KVF& f) {
#pragma unroll
    for (int s = 0; s < 4; ++s) { f.k[s][0] = *(const bf16x8*)(kp + (size_t)(s * 16) * ldk); f.k[s][1] = *(const bf16x8*)(kp + (size_t)(s * 16) * ldk + 32); }
}
template <int CTRL> __device__ __forceinline__ float dppf(float v) { return __int_as_float(__builtin_amdgcn_update_dpp(0, __float_as_int(v), CTRL, 0xF, 0xF, true)); }
template <int CTRL> __device__ __forceinline__ unsigned dppu(unsigned v) { return (unsigned)__builtin_amdgcn_update_dpp(0, (int)v, CTRL, 0xF, 0xF, true); }
__device__ __forceinline__ float rmax16(float v) { v = vmaxf(v, dppf<0xB1>(v)); v = vmaxf(v, dppf<0x4E>(v)); v = vmaxf(v, dppf<0x124>(v)); v = vmaxf(v, dppf<0x128>(v)); return v; }
__device__ __forceinline__ float rsum16(float v) { v += dppf<0xB1>(v); v += dppf<0x4E>(v); v += dppf<0x124>(v); v += dppf<0x128>(v); return v; }
template <int CTRL> __device__ __forceinline__ unsigned long long dppmax64(unsigned long long b) { const unsigned lo = dppu<CTRL>((unsigned)b), hi = dppu<CTRL>((unsigned)(b >> 32)); const unsigned long long ob = ((unsigned long long)hi << 32) | lo; return ob > b ? ob : b; }
#define MFMA8(a, b, c) __builtin_amdgcn_mfma_f32_16x16x32_fp8_fp8((a), (b), (c), 0, 0, 0)
__device__ __forceinline__ long mk64(unsigned lo, unsigned hi) { return (long)(((unsigned long long)hi << 32) | lo); }
__device__ __forceinline__ long bf8_to_fp8(bf16x8 v) {
    const u32x4 w = __builtin_bit_cast(u32x4, v);
    int a = __builtin_amdgcn_cvt_pk_fp8_f32(bflo(w.x), bfhi(w.x), 0, false); a = __builtin_amdgcn_cvt_pk_fp8_f32(bflo(w.y), bfhi(w.y), a, true);
    int b = __builtin_amdgcn_cvt_pk_fp8_f32(bflo(w.z), bfhi(w.z), 0, false); b = __builtin_amdgcn_cvt_pk_fp8_f32(bflo(w.w), bfhi(w.w), b, true);
    return mk64((unsigned)a, (unsigned)b);
}
struct K8F { u32x4 k[4]; };
__device__ __forceinline__ void k8_load(const unsigned char* kp, K8F& f) {
#pragma unroll
    for (int s = 0; s < 4; ++s) f.k[s] = *(const u32x4*)(kp + s * 1024);
}
__device__ __forceinline__ void softmax_pv(const f32x4 (&S)[4], const u32x4 (&Vw)[4], unsigned vmask, float (&m)[4], float (&l)[4], f32x4 (&O)[4], unsigned char* Pt, int fr, int fq) {
    float mx[4];
#pragma unroll
    for (int j = 0; j < 4; ++j) { float v = -1e30f;
#pragma unroll
        for (int s = 0; s < 4; ++s) v = ((vmask >> s) & 1u) ? vmaxf(v, S[s][j]) : v;
        mx[j] = rmax16(v); }
#pragma unroll
    for (int j = 0; j < 4; ++j) { const float mn = vmaxf(m[j], mx[j]); const float a = __builtin_amdgcn_exp2f(m[j] - mn); m[j] = mn; l[j] *= a;
#pragma unroll
        for (int dt = 0; dt < 4; ++dt) O[dt][j] *= a; }
#pragma unroll
    for (int j = 0; j < 4; ++j) { float pv[4];
#pragma unroll
        for (int s = 0; s < 4; ++s) { pv[s] = ((vmask >> s) & 1u) ? __builtin_amdgcn_exp2f(S[s][j] - m[j]) : 0.f; l[j] += pv[s]; }
        int t = __builtin_amdgcn_cvt_pk_fp8_f32(pv[0] * 256.f, pv[1] * 256.f, 0, false); t = __builtin_amdgcn_cvt_pk_fp8_f32(pv[2] * 256.f, pv[3] * 256.f, t, true);
        *(unsigned*)(Pt + (fq * 4 + j) * 72 + fr * 4) = (unsigned)t; }
    asm volatile("s_waitcnt lgkmcnt(0)" ::: "memory");
    const u32x2 p0 = *(const u32x2*)(Pt + fr * 72 + fq * 8), p1 = *(const u32x2*)(Pt + fr * 72 + 32 + fq * 8);
    asm volatile("s_waitcnt lgkmcnt(0)" ::: "memory");
    const long P0 = mk64(p0.x, p0.y), P1 = mk64(p1.x, p1.y);
#pragma unroll
    for (int dt = 0; dt < 4; ++dt) { O[dt] = MFMA8(P0, mk64(Vw[dt].x, Vw[dt].y), O[dt]); O[dt] = MFMA8(P1, mk64(Vw[dt].z, Vw[dt].w), O[dt]); }
}
__device__ __forceinline__ void flash_compute(const bf16x8 (&Qf)[2], KVF& f, const bf16_t* knext, int ldk, const unsigned char* vp, unsigned vmask, float (&m)[4], float (&l)[4], f32x4 (&O)[4], unsigned char* Pt, int fr, int fq) {
    f32x4 S[4]; u32x4 Vw[4];
#pragma unroll
    for (int dt = 0; dt < 4; ++dt) Vw[dt] = *(const u32x4*)(vp + dt * 1024);
#pragma unroll
    for (int s = 0; s < 4; ++s) { S[s] = (f32x4){0.f, 0.f, 0.f, 0.f}; S[s] = MFMA16(Qf[0], f.k[s][0], S[s]); S[s] = MFMA16(Qf[1], f.k[s][1], S[s]); }
    if (knext) kv_load(knext, ldk, f);
    softmax_pv(S, Vw, vmask, m, l, O, Pt, fr, fq);
}
struct V8F { u32x4 v[4]; };
__device__ __forceinline__ void v8_load(const unsigned char* vp, V8F& f) {
#pragma unroll
    for (int dt = 0; dt < 4; ++dt) f.v[dt] = *(const u32x4*)(vp + dt * 1024);
}
__device__ __forceinline__ void flash_compute8(const long (&Q8)[2], const K8F& f, const V8F& vf, unsigned vmask, float (&m)[4], float (&l)[4], f32x4 (&O)[4], unsigned char* Pt, int fr, int fq) {
    f32x4 S[4];
#pragma unroll
    for (int s = 0; s < 4; ++s) { S[s] = (f32x4){0.f, 0.f, 0.f, 0.f}; S[s] = MFMA8(Q8[0], mk64(f.k[s].x, f.k[s].y), S[s]); S[s] = MFMA8(Q8[1], mk64(f.k[s].z, f.k[s].w), S[s]); }
    softmax_pv(S, vf.v, vmask, m, l, O, Pt, fr, fq);
}
template <int BR> struct BranchIt {
    const bf16_t* kb; const unsigned char* kb8; const unsigned char* vb; const unsigned* flg; int last, trow, fr, fq;
    static constexpr int LDK = 64;
    __device__ __forceinline__ int next(int from) const {
        if (BR == 1) { int jb = from; while (jb <= last && flg[jb] == 0u) ++jb; return jb <= last ? jb : -1; }
        return from <= last ? from : -1;
    }
    __device__ __forceinline__ const unsigned char* vptr(int idx) const { return vb + (size_t)idx * 4096; }
    __device__ __forceinline__ const bf16_t* kptr(int idx) const { return kb + (size_t)(idx * 64) * LDK; }
    __device__ __forceinline__ const unsigned char* kptr8(int idx) const { return kb8 + (size_t)idx * 4096; }
    __device__ __forceinline__ unsigned mask(int idx) const {
        unsigned vm = 0; const int key0 = idx * 64;
        if (BR == 0) {
#pragma unroll
            for (int s = 0; s < 4; ++s) vm |= ((16 * (key0 + s * 16 + fr) + 31 <= trow) ? 1u : 0u) << s;
        } else if (BR == 1) {
            const bool rowsel = (flg[idx] >> fq) & 1u;
#pragma unroll
            for (int s = 0; s < 4; ++s) vm |= ((rowsel && (key0 + s * 16 + fr <= trow)) ? 1u : 0u) << s;
        } else {
#pragma unroll
            for (int s = 0; s < 4; ++s) { const int kpos = key0 + s * 16 + fr; vm |= ((kpos <= trow && kpos > trow - 512) ? 1u : 0u) << s; }
        }
        return vm;
    }
};
template <int BR> __device__ __forceinline__ void run_branch(const BranchIt<BR>& it, int first, const bf16x8 (&Qf)[2], const long (&Q8)[2], float (&m)[4], float (&l)[4], f32x4 (&O)[4], unsigned char* Pt) {
#pragma unroll
    for (int j = 0; j < 4; ++j) { m[j] = -1e30f; l[j] = 0.f; O[j] = (f32x4){0.f, 0.f, 0.f, 0.f}; }
    int ia = it.next(first);
    if (ia < 0) return;
    if (BR == 0) {
        KVF A; kv_load(it.kptr(ia), BranchIt<BR>::LDK, A);
        while (ia >= 0) {
            const int ib = it.next(ia + 1);
            flash_compute(Qf, A, ib >= 0 ? it.kptr(ib) : nullptr, BranchIt<BR>::LDK, it.vptr(ia), it.mask(ia), m, l, O, Pt, it.fr, it.fq);
            ia = ib;
        }
    } else {
        K8F kA, kB; V8F vA, vB; k8_load(it.kptr8(ia), kA); v8_load(it.vptr(ia), vA);
        for (;;) {
            const int ib = it.next(ia + 1), ibc = ib >= 0 ? ib : ia;
            k8_load(it.kptr8(ibc), kB); v8_load(it.vptr(ibc), vB);
            flash_compute8(Q8, kA, vA, it.mask(ia), m, l, O, Pt, it.fr, it.fq);
            if (ib < 0) break;
            const int ic = it.next(ib + 1), icc = ic >= 0 ? ic : ib;
            k8_load(it.kptr8(icc), kA); v8_load(it.vptr(icc), vA);
            flash_compute8(Q8, kB, vB, it.mask(ib), m, l, O, Pt, it.fr, it.fq);
            if (ic < 0) break;
            ia = ic;
        }
    }
}
__device__ __forceinline__ void branch_finish(float (&l)[4], f32x4 (&O)[4], const float* grow, int br, int hk, float* ybp  ) {
#pragma unroll
    for (int j = 0; j < 4; ++j) { const float s = rsum16(l[j]);
        const float g = sigmoidf_(grow[(hk * 4 + j) * 3 + br]) * 0.00390625f / fmaxf(s, 1e-30f);
#pragma unroll
        for (int dt = 0; dt < 4; ++dt) { float* q = ybp + j * 64 + dt * 16; if (br == 0) *q = g * O[dt][j]; else *q += g * O[dt][j]; } }
}
constexpr int NSA_WLDS = 15680;
__device__ void nsa_wave_task(const Params& p, int layer, int t0, unsigned char* wl) {
    unsigned char* ws = p.ws;
    const int lane = tidx() & 63, fr = lane & 15, fq = lane >> 4;
    float* imp = (float*)wl; unsigned* flg = (unsigned*)(wl + 4160); unsigned char* Pt = wl + 5184; float* yb = (float*)(wl + 7488);
    const bf16_t* qn = (const bf16_t*)(ws + O_QN); const unsigned char* ks8 = ws + O_KSN; const unsigned char* kw8 = ws + O_KWN;
    const unsigned char* vsT = ws + O_VST; const unsigned char* vwT = ws + O_VWT; const bf16_t* kc = (const bf16_t*)(ws + O_KC); const unsigned char* vcT = ws + O_VCT;
    const int trow = t0 + fq;
    const float* grow = (const float*)(ws + O_P32) + (size_t)trow * 1536 + 1280;
    const int tmax = t0 + 3;
    for (int hk = 0; hk < 2; ++hk) {
        bf16x8 Qf[2];
        { const bf16_t* qp = qn + (size_t)(t0 + (fr >> 2)) * 512 + (hk * 4 + (fr & 3)) * 64 + fq * 8; Qf[0] = *(const bf16x8*)qp; Qf[1] = *(const bf16x8*)(qp + 32); }
        long Q8[2]; Q8[0] = bf8_to_fp8(Qf[0]); Q8[1] = bf8_to_fp8(Qf[1]);
        float* ybp = yb + fq * 512 + hk * 256 + fr;
        float m[4], l[4]; f32x4 O[4];
        const int ncmp_t = tmax >= 31 ? ((((tmax - 31) >> 4) >> 6) + 1) : 0;
        const bf16_t* kcb = kc + ((size_t)hk * 1024 + fr) * 64 + fq * 8;
        { BranchIt<0> it{kcb, nullptr, vcT + (size_t)hk * 16 * 4096 + fr * 64 + fq * 16, nullptr, ncmp_t - 1, trow, fr, fq}; run_branch<0>(it, 0, Qf, Q8, m, l, O, Pt); }
        float linv[4];
#pragma unroll
        for (int j = 0; j < 4; ++j) { const float s = rsum16(l[j]); linv[j] = s > 0.f ? 1.0f / s : 0.f; }
        branch_finish(l, O, grow, 0, hk, ybp);
        for (int e = lane; e < 4 * 260; e += 64) imp[e] = 0.f;
        for (int e = lane; e < 256; e += 64) flg[e] = 0u;
        asm volatile("s_waitcnt lgkmcnt(0)" ::: "memory");
        {
            KVF ka;
            if (ncmp_t > 0) kv_load(kcb, 64, ka);
            for (int kt = 0; kt < ncmp_t; ++kt) {
                const int key0 = kt * 64;
                f32x4 S[4];
#pragma unroll
                for (int s = 0; s < 4; ++s) { S[s] = (f32x4){0.f, 0.f, 0.f, 0.f}; S[s] = MFMA16(Qf[0], ka.k[s][0], S[s]); S[s] = MFMA16(Qf[1], ka.k[s][1], S[s]); }
                if (kt + 1 < ncmp_t) kv_load(kcb + (size_t)(key0 + 64) * 64, 64, ka);
#pragma unroll
                for (int s = 0; s < 4; ++s) {
                    const int nn = key0 + s * 16 + fr; const bool valid = 16 * nn + 31 <= trow;
                    float ps = 0.f;
#pragma unroll
                    for (int j = 0; j < 4; ++j) ps += valid ? __builtin_amdgcn_exp2f(S[s][j] - m[j]) * linv[j] : 0.f;
                    float p4 = ps; p4 += dppf<0xB1>(p4); p4 += dppf<0x4E>(p4);
                    if ((fr & 3) == 0) imp[fq * 260 + (nn >> 2)] += p4;
                    asm volatile("s_waitcnt lgkmcnt(0)" ::: "memory");
                    if ((fr & 3) == 3) imp[fq * 260 + (nn >> 2) + 1] += ps;
                    asm volatile("s_waitcnt lgkmcnt(0)" ::: "memory");
                }
            }
        }
#ifdef OLD_TOPK
        for (int tok = 0; tok < 4; ++tok) {
            const int t = t0 + tok, cur = t >> 6, nsel = cur + 1 < 16 ? cur + 1 : 16;
            unsigned long long key[4];
#pragma unroll
            for (int i = 0; i < 4; ++i) { const int j = lane + 64 * i; unsigned long long k = 0ull;
                if (j <= cur) { const bool forced = (j == 0) || (j == cur) || (j == cur - 1); const unsigned vb = forced ? 0x7F800000u : __float_as_uint(imp[tok * 260 + j]); k = ((unsigned long long)vb << 32) | (unsigned)(0xFFFF - j); }
                key[i] = k; }
            for (int it2 = 0; it2 < nsel; ++it2) {
                unsigned long long best = key[0]; best = key[1] > best ? key[1] : best; best = key[2] > best ? key[2] : best; best = key[3] > best ? key[3] : best;
#pragma unroll
                for (int o = 32; o >= 1; o >>= 1) { const unsigned lo = __shfl_xor((unsigned)best, o), hi = __shfl_xor((unsigned)(best >> 32), o); const unsigned long long ob = ((unsigned long long)hi << 32) | lo; best = ob > best ? ob : best; }
                const int jsel = 0xFFFF - (int)(best & 0xFFFFu);
#pragma unroll
                for (int i = 0; i < 4; ++i) if (key[i] == best) key[i] = 0ull;
                if (lane == 0) flg[jsel] |= (1u << tok);
            }
        }
#else
        {
            unsigned long long key[4][4];
#pragma unroll
            for (int tok = 0; tok < 4; ++tok) { const int cur = (t0 + tok) >> 6;
#pragma unroll
                for (int i = 0; i < 4; ++i) { const int j = lane + 64 * i; unsigned long long k = 0ull;
                    if (j <= cur) { const bool forced = (j == 0) || (j == cur) || (j == cur - 1); const unsigned vb = forced ? 0x7F800000u : __float_as_uint(imp[tok * 260 + j]); k = ((unsigned long long)vb << 32) | (unsigned)(0xFFFF - j); }
                    key[tok][i] = k; } }
            for (int itn = 0; itn < 16; ++itn) {
                unsigned long long best[4];
#pragma unroll
                for (int tok = 0; tok < 4; ++tok) { unsigned long long b0 = key[tok][0]; b0 = key[tok][1] > b0 ? key[tok][1] : b0; b0 = key[tok][2] > b0 ? key[tok][2] : b0; b0 = key[tok][3] > b0 ? key[tok][3] : b0; best[tok] = b0; }
#pragma unroll
                for (int tok = 0; tok < 4; ++tok) { best[tok] = dppmax64<0xB1>(best[tok]); best[tok] = dppmax64<0x4E>(best[tok]); best[tok] = dppmax64<0x124>(best[tok]); best[tok] = dppmax64<0x128>(best[tok]); }
#pragma unroll
                for (int o = 16; o <= 32; o <<= 1) {
#pragma unroll
                    for (int tok = 0; tok < 4; ++tok) { const unsigned lo = __shfl_xor((unsigned)best[tok], o), hi = __shfl_xor((unsigned)(best[tok] >> 32), o); const unsigned long long ob = ((unsigned long long)hi << 32) | lo; best[tok] = ob > best[tok] ? ob : best[tok]; }
                }
#pragma unroll
                for (int tok = 0; tok < 4; ++tok) {
                    if (best[tok] != 0ull) {
#pragma unroll
                        for (int i = 0; i < 4; ++i) if (key[tok][i] == best[tok]) key[tok][i] = 0ull;
                        if (lane == 0) flg[0xFFFF - (int)(best[tok] & 0xFFFFu)] |= (1u << tok);
                    }
                }
            }
        }
#endif
        asm volatile("s_waitcnt lgkmcnt(0)" ::: "memory");
        { BranchIt<1> it{nullptr, ks8 + (size_t)hk * 256 * 4096 + fr * 64 + fq * 16, vsT + (size_t)hk * 256 * 4096 + fr * 64 + fq * 16, flg, tmax >> 6, trow, fr, fq}; run_branch<1>(it, 0, Qf, Q8, m, l, O, Pt); }
        branch_finish(l, O, grow, 1, hk, ybp);
        { BranchIt<2> it{nullptr, kw8 + (size_t)hk * 256 * 4096 + fr * 64 + fq * 16, vwT + (size_t)hk * 256 * 4096 + fr * 64 + fq * 16, nullptr, tmax >> 6, trow, fr, fq}; run_branch<2>(it, t0 - 511 > 0 ? ((t0 - 511) >> 6) : 0, Qf, Q8, m, l, O, Pt); }
        branch_finish(l, O, grow, 2, hk, ybp);
    }
    asm volatile("s_waitcnt lgkmcnt(0)" ::: "memory");
    bf16_t* mix = (bf16_t*)(ws + O_HN);
    const float* gn = p.in[12] + (size_t)layer * 512;
    for (int tok = 0; tok < 4; ++tok) {
        const f32x4 a = *(const f32x4*)(yb + tok * 512 + lane * 8), b = *(const f32x4*)(yb + tok * 512 + lane * 8 + 4);
        float ss = a[0] * a[0] + a[1] * a[1] + a[2] * a[2] + a[3] * a[3] + b[0] * b[0] + b[1] * b[1] + b[2] * b[2] + b[3] * b[3];
        ss = wave_sum(ss);
        const float rs = rsqrtf(ss * (1.0f / 512.0f) + 1e-6f);
        const f32x4 g0 = *(const f32x4*)(gn + lane * 8), g1 = *(const f32x4*)(gn + lane * 8 + 4);
        u32x4 w; w.x = pk2(a[0] * rs * g0[0], a[1] * rs * g0[1]); w.y = pk2(a[2] * rs * g0[2], a[3] * rs * g0[3]); w.z = pk2(b[0] * rs * g1[0], b[1] * rs * g1[1]); w.w = pk2(b[2] * rs * g1[2], b[3] * rs * g1[3]);
        *(u32x4*)(mix + (size_t)(t0 + tok) * DM + lane * 8) = w;
    }
    asm volatile("s_waitcnt lgkmcnt(0)" ::: "memory");
}

__device__ void phase_finalize(const Params& p, int layer) {
    unsigned char* ws = p.ws;
    const int wave = tidx() >> 6, lane = tidx() & 63;
    const float* yglu = (const float*)(ws + O_YGLU); const float* go = (const float*)(ws + O_PQKV); const bf16_t* Pz = (const bf16_t*)(ws + O_PZ); bf16_t* mix = (bf16_t*)(ws + O_HN);
    const float* gs = p.in[22] + (size_t)layer * 512 + lane * 8; const float* gg = p.in[26] + (size_t)layer * 128 + (lane & 7) * 16;
    for (int t = blockIdx.x * 8 + wave; t < T_; t += gridDim.x * 8) {
        {
            const f32x4 a = *(const f32x4*)(yglu + (size_t)t * 512 + lane * 8), b = *(const f32x4*)(yglu + (size_t)t * 512 + lane * 8 + 4);
            float ss = a[0] * a[0] + a[1] * a[1] + a[2] * a[2] + a[3] * a[3] + b[0] * b[0] + b[1] * b[1] + b[2] * b[2] + b[3] * b[3];
            ss = wave_sum(ss); const float rs = rsqrtf(ss * (1.0f / 512.0f) + 1e-6f);
            const f32x4 g0 = *(const f32x4*)gs, g1 = *(const f32x4*)(gs + 4);
            u32x4 w; w.x = pk2(a[0] * rs * g0[0], a[1] * rs * g0[1]); w.y = pk2(a[2] * rs * g0[2], a[3] * rs * g0[3]); w.z = pk2(b[0] * rs * g1[0], b[1] * rs * g1[1]); w.w = pk2(b[2] * rs * g1[2], b[3] * rs * g1[3]);
            *(u32x4*)(mix + (size_t)t * DM + 512 + lane * 8) = w;
        }
        {
            f32x4 o[4]; float ss = 0.f;
#pragma unroll
            for (int q = 0; q < 4; ++q) { o[q] = *(const f32x4*)(go + (size_t)t * 1024 + lane * 16 + q * 4); ss += o[q][0] * o[q][0] + o[q][1] * o[q][1] + o[q][2] * o[q][2] + o[q][3] * o[q][3]; }
            ss += __shfl_xor(ss, 1); ss += __shfl_xor(ss, 2); ss += __shfl_xor(ss, 4);
            const float rs = rsqrtf(ss * (1.0f / 128.0f) + 1e-6f);
            const u32x4 z0 = *(const u32x4*)(Pz + (size_t)t * 1024 + lane * 16), z1 = *(const u32x4*)(Pz + (size_t)t * 1024 + lane * 16 + 8);
            float zz[16] = {bflo(z0.x), bfhi(z0.x), bflo(z0.y), bfhi(z0.y), bflo(z0.z), bfhi(z0.z), bflo(z0.w), bfhi(z0.w), bflo(z1.x), bfhi(z1.x), bflo(z1.y), bfhi(z1.y), bflo(z1.z), bfhi(z1.z), bflo(z1.w), bfhi(z1.w)};
            float r[16];
#pragma unroll
            for (int q = 0; q < 4; ++q) { const f32x4 g = *(const f32x4*)(gg + q * 4);
#pragma unroll
                for (int e = 0; e < 4; ++e) r[q * 4 + e] = o[q][e] * rs * g[e] * siluf_(zz[q * 4 + e]); }
            u32x4 w0, w1; w0.x = pk2(r[0], r[1]); w0.y = pk2(r[2], r[3]); w0.z = pk2(r[4], r[5]); w0.w = pk2(r[6], r[7]); w1.x = pk2(r[8], r[9]); w1.y = pk2(r[10], r[11]); w1.z = pk2(r[12], r[13]); w1.w = pk2(r[14], r[15]);
            *(u32x4*)(mix + (size_t)t * DM + 1024 + lane * 16) = w0; *(u32x4*)(mix + (size_t)t * DM + 1024 + lane * 16 + 8) = w1;
        }
    }
}

__device__ void phase_ffn_act(const Params& p, int layer) {
    unsigned char* ws = p.ws;
    const bf16_t* hf = (const bf16_t*)(ws + O_HF); bf16_t* act = (bf16_t*)(ws + O_ACT);
    const float* cw = p.in[30] + (size_t)layer * 3 * NFF; const float* cb = p.in[31] + (size_t)layer * NFF;
    const int nitems = 512 * 688;
    for (int it = blockIdx.x * 512 + tidx(); it < nitems; it += gridDim.x * 512) {
        const int seg = it / 688, cg8 = it - seg * 688, c = cg8 * 8, t0 = seg * 32;
        float w[2][3][8], bb[2][8];
#pragma unroll
        for (int hh = 0; hh < 2; ++hh) {
#pragma unroll
            for (int j = 0; j < 3; ++j) { const f32x4 a = *(const f32x4*)(cw + j * NFF + hh * DFF + c), b = *(const f32x4*)(cw + j * NFF + hh * DFF + c + 4);
                w[hh][j][0] = a[0]; w[hh][j][1] = a[1]; w[hh][j][2] = a[2]; w[hh][j][3] = a[3]; w[hh][j][4] = b[0]; w[hh][j][5] = b[1]; w[hh][j][6] = b[2]; w[hh][j][7] = b[3]; }
            const f32x4 a = *(const f32x4*)(cb + hh * DFF + c), b = *(const f32x4*)(cb + hh * DFF + c + 4);
            bb[hh][0] = a[0]; bb[hh][1] = a[1]; bb[hh][2] = a[2]; bb[hh][3] = a[3]; bb[hh][4] = b[0]; bb[hh][5] = b[1]; bb[hh][6] = b[2]; bb[hh][7] = b[3];
        }
        u32x4 r0[2], r1[2];
#pragma unroll
        for (int hh = 0; hh < 2; ++hh) {
            r0[hh] = (t0 >= 2) ? *(const u32x4*)(hf + (size_t)(t0 - 2) * NFF + hh * DFF + c) : (u32x4){0u, 0u, 0u, 0u};
            r1[hh] = (t0 >= 1) ? *(const u32x4*)(hf + (size_t)(t0 - 1) * NFF + hh * DFF + c) : (u32x4){0u, 0u, 0u, 0u};
        }
#pragma unroll 4
        for (int tt = 0; tt < 32; ++tt) {
            const int t = t0 + tt;
            u32x4 r2[2]; float v[2][8];
#pragma unroll
            for (int hh = 0; hh < 2; ++hh) {
                r2[hh] = *(const u32x4*)(hf + (size_t)t * NFF + hh * DFF + c);
                const unsigned a0[4] = {r0[hh].x, r0[hh].y, r0[hh].z, r0[hh].w}, a1[4] = {r1[hh].x, r1[hh].y, r1[hh].z, r1[hh].w}, a2[4] = {r2[hh].x, r2[hh].y, r2[hh].z, r2[hh].w};
#pragma unroll
                for (int e = 0; e < 4; ++e) {
                    v[hh][2 * e]     = bb[hh][2 * e]     + w[hh][0][2 * e]     * bflo(a0[e]) + w[hh][1][2 * e]     * bflo(a1[e]) + w[hh][2][2 * e]     * bflo(a2[e]);
                    v[hh][2 * e + 1] = bb[hh][2 * e + 1] + w[hh][0][2 * e + 1] * bfhi(a0[e]) + w[hh][1][2 * e + 1] * bfhi(a1[e]) + w[hh][2][2 * e + 1] * bfhi(a2[e]);
                }
                r0[hh] = r1[hh]; r1[hh] = r2[hh];
            }
            u32x4 o; o.x = pk2(siluf_(v[0][0]) * v[1][0], siluf_(v[0][1]) * v[1][1]); o.y = pk2(siluf_(v[0][2]) * v[1][2], siluf_(v[0][3]) * v[1][3]);
            o.z = pk2(siluf_(v[0][4]) * v[1][4], siluf_(v[0][5]) * v[1][5]); o.w = pk2(siluf_(v[0][6]) * v[1][6], siluf_(v[0][7]) * v[1][7]);
            *(u32x4*)(act + (size_t)t * DFF + c) = o;
        }
    }
}
#ifdef REPEAT_PHASE
constexpr int NPHT = NPH + 1;
#else
constexpr int NPHT = NPH;
#endif
#ifndef MULTI_LAUNCH
#define MULTI_LAUNCH 0
#endif
__global__ void __launch_bounds__(512) mega(Params p) {
    extern __shared__ __attribute__((aligned(16))) unsigned char smem[];
    cg::grid_group grid = cg::this_grid();
    const int b = blockIdx.x, G = gridDim.x;
    PG8_LAS unsigned char* glds = (PG8_LAS unsigned char*)smem;
    volatile XB_LAS unsigned* xst = (volatile XB_LAS unsigned*)(smem + LDS_BYTES - 32);
    if (threadIdx.x == 0) { xst[0] = 0u; xst[1] = 0u; }
    __syncthreads();
    XcdBarrier xbar; xbar.bar = (unsigned*)(p.ws + O_BAR); xbar.x = 0; xbar.st = xst;
    for (int ph = p.ph_lo; ph < p.ph_hi; ++ph) {

        #ifdef REPEAT_PHASE
        const int layer = ph / (NPH + 1), ki = ph % (NPH + 1), rep = (ki == REPEAT_PHASE + 1) ? 1 : 0; int k = ki <= REPEAT_PHASE ? ki : ki - 1;
#else
        const int layer = ph / NPH, rep = 0; int k = ph % NPH;
#endif
#ifdef DBG_ONLY
        if (k != DBG_ONLY) k = 99;
#endif
        typedef unsigned char __attribute__((address_space(1))) gu8_t;
        gu8_t* wsg = (gu8_t*)p.ws; asm volatile("" : "+s"(wsg));
        unsigned char* ws = (unsigned char*)wsg;
        int tid = threadIdx.x; asm volatile("" : "+v"(tid));
        const int wave = tid >> 6;
        bf16_t* hn = (bf16_t*)(ws + O_HN);
        Params q = p; q.ws = ws;
        if (k == 0) {
            if (ph == 0 && rep == 0 && b == 0) { if (tid < 64) ((unsigned*)(ws + O_CTR))[tid * 16] = 0u; for (int i = tid; i < XCD_BAR_WORDS; i += 512) ((unsigned*)(ws + O_BAR))[i] = 0u; }
            phase_convert(q, layer, (float*)smem);
            phase_rmsnorm(layer == 0 ? p.in[0] : p.out, p.in[1] + (size_t)layer * DM, hn, layer == 0 ? p.out : nullptr);
        } else if (k == 1) {
            pg8::Gemm g{hn, (const bf16_t*)(ws + O_WIN), T_, NIN, DM}; pg8::StaticOrder S; S.init(T_, NIN, G, b);
            EpiProj E{(float*)(ws + O_P32), (bf16_t*)(ws + O_PU), (bf16_t*)(ws + O_PQKV), (bf16_t*)(ws + O_PZ)};
            pg8::gemm_phase<EpiProj, pg8::StaticOrder, false>(glds, g, S, E, nullptr);
        } else if (k == 2) {
            for (int it = b; it < 3072; it += G) {
                if (it < 2048) gdn_prep_item(q, layer, it, smem);
                else if (it < 2304) nsa_prep_item(q, layer, it - 2048, (float*)smem);
                else if (it < 2560) s5_passA_wave(q, layer, (it - 2304) * 8 + wave, (float*)(smem + wave * 4096));
                else cmp1_wave_tile(q, layer, (it - 2560) * 8 + wave);
            }
        } else if (k == 3) {
            for (int idx = b * 8 + wave; idx < 4096; idx += G * 8) cmp2_wave_row(q, layer, idx);
            for (int it = b * 8 + wave; it < 2048; it += G * 8) s5_passB_wave(q, layer, it, (bf16_t*)(smem + wave * 8448), (float*)(smem + wave * 8448 + 4352));
        } else if (k == 4) {
#ifdef REP4_MODE
            const bool do_rec = (rep == 0) || (REP4_MODE == 1), do_glu = (rep == 0), do_nsa = (rep == 0) || (REP4_MODE == 2);
#else
            const bool do_rec = true, do_glu = true, do_nsa = true;
#endif
            if (b < 32) {
#ifndef NO_REC
 if (do_rec) gdn_recurrence(q, b, smem);
#endif
 }
            else if (b < 160 && do_glu) {
#ifndef NO_GLU
                pg8::Gemm g{(const bf16_t*)(ws + O_YGELU), (const bf16_t*)(ws + O_WGLU), T_, 512, 512}; pg8::StaticOrder S; S.init(T_, 512, 128, b - 32);
                EpiGlu E{(const bf16_t*)(ws + O_YGELU), (float*)(ws + O_YGLU)};
                pg8::gemm_phase<EpiGlu, pg8::StaticOrder, false>(glds, g, S, E, nullptr);
#endif
            }
            __syncthreads();
            unsigned* ctr = (unsigned*)(ws + O_CTR) + (layer * 2 + rep) * 16;
            volatile int* sidx = (volatile int*)(smem + LDS_BYTES - 16);
#ifndef NO_NSA
            if (do_nsa) for (;;) {
                if (tid == 0) *sidx = (int)atomicAdd(ctr, 1u);
                __syncthreads();
                const int idx = *sidx;
                __syncthreads();
                if (idx >= 512) break;
                nsa_wave_task(q, layer, (511 - idx) * 32 + wave * 4, smem + wave * NSA_WLDS);
            }
#endif
        } else if (k == 5) {
            phase_finalize(q, layer);
        } else if (k == 6) {
            pg8::Gemm g{hn, (const bf16_t*)(ws + O_WOUT), T_, DM, DM}; pg8::StaticOrder S; S.init(T_, DM, G, b);
            EpiResid E{p.out, DM};
            pg8::gemm_phase<EpiResid, pg8::StaticOrder, false>(glds, g, S, E, nullptr);
        } else if (k == 7) {
            phase_rmsnorm(p.out, p.in[28] + (size_t)layer * DM, hn, nullptr);
        } else if (k == 8) {
            pg8::Gemm g{hn, (const bf16_t*)(ws + O_WFIN), T_, NFF, DM}; pg8::StaticOrder S; S.init(T_, NFF, G, b);
            EpiBf E{(bf16_t*)(ws + O_HF), NFF};
            pg8::gemm_phase<EpiBf, pg8::StaticOrder, false>(glds, g, S, E, nullptr);
        } else if (k == 9) {
            phase_ffn_act(q, layer);
        } else if (k == 10) {
            pg8::Gemm g{(const bf16_t*)(ws + O_ACT), (const bf16_t*)(ws + O_WFOUT), T_, DM, DFF}; pg8::StaticOrder S; S.init(T_, DM, G, b);
            EpiResid E{p.out, DM};
            pg8::gemm_phase<EpiResid, pg8::StaticOrder, false>(glds, g, S, E, nullptr);
        }
        __syncthreads();
        if (ph + 1 < p.ph_hi) {
            if (ph == p.ph_lo) { grid.sync(); xbar = xcd_barrier_post((unsigned*)(p.ws + O_BAR), xst); }
            else xcd_barrier(xbar);
        }
    }
}

extern "C" void kernel_launch(void* const* d_in, const int* in_sizes, int n_in, void* d_out, int out_size, void* d_ws, size_t ws_size, hipStream_t stream) {
    static int grid_blocks = 0;
    if (!grid_blocks) {
        if (n_in != 33 || out_size != T_ * DM || ws_size < WS_NEED) { fprintf(stderr, "kernel_launch: unexpected shapes or workspace (%d inputs, out %d, ws %zu < %zu)\n", n_in, out_size, ws_size, (size_t)WS_NEED); grid_blocks = -1; return; }
        int dev = 0, cus = 0, per_cu = 0;
        hipGetDevice(&dev);
        hipDeviceGetAttribute(&cus, hipDeviceAttributeMultiprocessorCount, dev);
        if (hipFuncSetAttribute((const void*)mega, hipFuncAttributeMaxDynamicSharedMemorySize, LDS_BYTES) != hipSuccess) { fprintf(stderr, "kernel_launch: hipFuncSetAttribute failed\n"); grid_blocks = -1; return; }
        hipOccupancyMaxActiveBlocksPerMultiprocessor(&per_cu, (const void*)mega, 512, LDS_BYTES);
        (void)hipGetLastError();
        if (per_cu < 1) per_cu = 1;
        grid_blocks = cus * per_cu; if (grid_blocks > 256) grid_blocks = 256;
        if (grid_blocks < 160) { fprintf(stderr, "kernel_launch: grid %d too small\n", grid_blocks); grid_blocks = -1; return; }
    }
    if (grid_blocks < 0) return;
    Params p{};
    for (int i = 0; i < 33; ++i) p.in[i] = (const float*)d_in[i];
    p.out = (float*)d_out; p.ws = (unsigned char*)d_ws;
#if MULTI_LAUNCH
    for (int ph = 0; ph < 2 * NPHT; ++ph) { p.ph_lo = ph; p.ph_hi = ph + 1; hipLaunchKernelGGL(mega, dim3(grid_blocks), dim3(512), LDS_BYTES, stream, p); }
#else
    p.ph_lo = 0; p.ph_hi = 2 * NPHT;
    void* args[] = {&p};
    hipError_t e = hipLaunchCooperativeKernel((const void*)mega, dim3(grid_blocks), dim3(512), args, LDS_BYTES, stream);
    if (e != hipSuccess) fprintf(stderr, "cooperative launch failed: %s (grid %d)\n", hipGetErrorString(e), grid_blocks);
#endif
}
```

```cpp
#include <hip/hip_runtime.h>
#include <hip/hip_cooperative_groups.h>
#include <cstdio>
namespace cg = cooperative_groups;
__device__ __forceinline__ int tidx() { int t = threadIdx.x; asm volatile("" : "+v"(t)); return t; }
namespace pg8 {
#define PG8_LAS __attribute__((address_space(3)))
typedef unsigned short bf16_t;
typedef short bf16x8 __attribute__((ext_vector_type(8)));
typedef float f32x4 __attribute__((ext_vector_type(4)));
typedef unsigned u32x4 __attribute__((ext_vector_type(4)));
constexpr int BM = 256, BK = 64, HALF = 128, HTB = HALF * BK * 2  , STAGE_BYTES = 8 * HTB, NXCD = 8, WGM = 8;

__host__ __device__ __forceinline__ int lds_byte(int r, int c) { const int st = (r >> 4) * 2 + (c >> 5), rr = r & 15, cc = c & 31, ob = rr * 64 + cc * 2; return st * 1024 + (ob ^ (((ob >> 9) & 1) << 5)); }
__host__ __device__ __forceinline__ void stage_rc(int b, int& R, int& C) { const int st = b / 1024, sb = b % 1024, swz = sb ^ (((sb >> 9) & 1) << 5); R = (st >> 1) * 16 + swz / 64; C = (st & 1) * 32 + (swz % 64) / 2; }
__host__ __device__ __forceinline__ int perm32(int rho) { const int n = rho >> 4, i = rho & 15; return 8 * (i >> 2) + 4 * n + (i & 3); }

struct Unit { int pm, pn; };
struct Gemm { const bf16_t* A; const bf16_t* Bt; int M, N, K; };

struct StaticOrder {
    int nM, nN, nwg, G, c;
    __host__ __device__ void init(int M, int N, int G_, int c_) { nM = M / BM; nN = N / BM; nwg = nM * nN; G = G_; c = c_; }
    __host__ __device__ bool next(int i, Unit& u) const {
        const long L = (long)i * G + c; if (L >= nwg) return false;
        int wgid = (int)L; { const int q = nwg / NXCD, r = nwg % NXCD, xcd = wgid % NXCD, off = wgid / NXCD; wgid = (xcd < r ? xcd * (q + 1) : r * (q + 1) + (xcd - r) * q) + off; }
        const int nig = WGM * nN, gid = wgid / nig, fm = gid * WGM, gsz = (nM - fm) < WGM ? (nM - fm) : WGM;
        u.pm = fm + ((wgid % nig) % gsz); u.pn = (wgid % nig) / gsz; return true;
    }
    __device__ __forceinline__ void a_ready(const Unit&) const {}
    __device__ __forceinline__ void done(const Unit&) const {}
};
__device__ __forceinline__ unsigned cvt_pk_bf16(float lo, float hi) { unsigned r; asm volatile("v_cvt_pk_bf16_f32 %0, %1, %2" : "=v"(r) : "v"(lo), "v"(hi)); return r; }
template <class Epi, class Sched, bool STAMP = false>
__device__ __forceinline__ void gemm_phase(PG8_LAS unsigned char* lds, const Gemm g, const Sched& S, const Epi& E, unsigned long long* stamps) {
    const int tid = tidx(), wid = __builtin_amdgcn_readfirstlane(tid >> 6), lane = tid & 63, wr = wid >> 2, wc = wid & 3, fr = lane & 15, fq = lane >> 4;
    const int K = g.K, nt = K / BK;
    int ts_lo = 0, ts_hi = 0, nts = 0; const unsigned long long rt_entry = STAMP ? (unsigned long long)wall_clock64() : 0ull;
#define PG8_STAMP() do { if (STAMP && wid == 0 && nts < 64) { const unsigned long long _c = (unsigned long long)clock64(); \
        ts_lo = (lane == nts) ? (int)(unsigned)_c : ts_lo; ts_hi = (lane == nts) ? (int)(unsigned)(_c >> 32) : ts_hi; ++nts; } } while (0)
    PG8_STAMP();
    unsigned voffA[2], voffB[2];
#pragma unroll
    for (int i = 0; i < 2; ++i) { int R, C; stage_rc(tid * 16 + i * 8192, R, C); const int Rb = Epi::PERM ? ((R & ~31) + perm32(R & 31)) : R;
        voffA[i] = (unsigned)(R * K + C) * 2u; voffB[i] = (unsigned)(Rb * K + C) * 2u; }
    const size_t kstep = (size_t)(BK * 2);
    const size_t hstep = (size_t)HALF * K * 2;
    const size_t tstep = 2 * hstep;
    const unsigned ldsw = (unsigned)wid * 1024u;
    const int aoff = lds_byte(wr * 64 + fr, fq * 8), boff = lds_byte(wc * 32 + fr, fq * 8);
#define PG8_SA(b, h) (((b) * 2 + (h)) * HTB)
#define PG8_SB(b, h) ((4 + (b) * 2 + (h)) * HTB)
#define PG8_STAGE(bufoff, gbase, voff) do { _Pragma("unroll") for (int _i = 0; _i < 2; ++_i) \
        __builtin_amdgcn_global_load_lds((const unsigned*)((const char*)(gbase) + (voff)[_i]), (PG8_LAS unsigned*)(lds + (bufoff) + ldsw + _i * 8192), 16, 0, 0); } while (0)
#define PG8_LDA(dst, b, h) do { _Pragma("unroll") for (int m = 0; m < 4; ++m) _Pragma("unroll") for (int k = 0; k < 2; ++k) dst[m][k] = *(const PG8_LAS bf16x8*)(lds + PG8_SA(b, h) + aoff + m * 2048 + k * 1024); } while (0)
#define PG8_LDB(dst, b, h) do { _Pragma("unroll") for (int n = 0; n < 2; ++n) _Pragma("unroll") for (int k = 0; k < 2; ++k) dst[n][k] = *(const PG8_LAS bf16x8*)(lds + PG8_SB(b, h) + boff + n * 2048 + k * 1024); } while (0)
#define PG8_MMA(ai, bj, At, Bt) do { __builtin_amdgcn_s_setprio(1); _Pragma("unroll") for (int m = 0; m < 4; ++m) _Pragma("unroll") for (int n = 0; n < 2; ++n) _Pragma("unroll") for (int k = 0; k < 2; ++k) \
        acc[ai][bj][m][n] = __builtin_amdgcn_mfma_f32_16x16x32_bf16(Bt[n][k], At[m][k], acc[ai][bj][m][n], 0, 0, 0); __builtin_amdgcn_s_setprio(0); } while (0)
#define PG8_WAIT_V(n) asm volatile("s_waitcnt vmcnt(" #n ")" ::: "memory")
#define PG8_WAIT_L(n) asm volatile("s_waitcnt lgkmcnt(" #n ")" ::: "memory")
#define PG8_BAR __builtin_amdgcn_s_barrier()
#define PG8_SCHED __builtin_amdgcn_sched_barrier(0)
    Unit cur, nxt; int ui = 0;
    if (!S.next(0, cur)) return;
    f32x4 acc[2][2][4][2];
#pragma unroll
    for (int a = 0; a < 2; ++a)
#pragma unroll
        for (int b = 0; b < 2; ++b)
#pragma unroll
            for (int m = 0; m < 4; ++m)
#pragma unroll
                for (int n = 0; n < 2; ++n) acc[a][b][m][n] = (f32x4){0.f, 0.f, 0.f, 0.f};
    bf16x8 At[4][2], B0[2][2], B1[2][2];
    const char* cA = (const char*)g.A + (size_t)cur.pm * tstep; const char* cB = (const char*)g.Bt + (size_t)cur.pn * tstep;
    S.a_ready(cur);
    PG8_STAGE(PG8_SB(0, 0), cB, voffB); PG8_STAGE(PG8_SA(0, 0), cA, voffA); PG8_STAGE(PG8_SB(0, 1), cB + hstep, voffB); PG8_STAGE(PG8_SA(0, 1), cA + hstep, voffA);
    if (wr == 1) PG8_BAR;
    PG8_WAIT_V(4); PG8_BAR;
    PG8_STAGE(PG8_SB(1, 0), cB + kstep, voffB); PG8_STAGE(PG8_SA(1, 0), cA + kstep, voffA); PG8_STAGE(PG8_SB(1, 1), cB + hstep + kstep, voffB);
    PG8_WAIT_V(6); PG8_BAR;
    PG8_STAMP();
    for (;;) {
        const bool has_next = S.next(ui + 1, nxt);
        const char* nA = has_next ? (const char*)g.A + (size_t)nxt.pm * tstep : cA; const char* nB = has_next ? (const char*)g.Bt + (size_t)nxt.pn * tstep : cB;
        for (int t = 0; t < nt; t += 2) {
            const bool last = (t == nt - 2);
            const char* a1 = cA + (size_t)(t + 1) * kstep;
            const char* a2 = last ? nA : cA + (size_t)(t + 2) * kstep; const char* b2 = last ? nB : cB + (size_t)(t + 2) * kstep;
            const char* a3 = a2 + kstep; const char* b3 = b2 + kstep;
            if (last && has_next) S.a_ready(nxt);
            PG8_LDB(B0, 0, 0); PG8_SCHED; PG8_LDA(At, 0, 0); PG8_STAGE(PG8_SA(1, 1), a1 + hstep, voffA);
            PG8_WAIT_L(8); PG8_BAR; PG8_WAIT_L(0); PG8_MMA(0, 0, At, B0); PG8_BAR; PG8_SCHED;
            PG8_LDB(B1, 0, 1); PG8_STAGE(PG8_SB(0, 0), b2, voffB);
            PG8_BAR; PG8_WAIT_L(0); PG8_MMA(0, 1, At, B1); PG8_BAR;
            PG8_LDA(At, 0, 1); PG8_STAGE(PG8_SA(0, 0), a2, voffA);
            PG8_BAR; PG8_WAIT_L(0); PG8_MMA(1, 0, At, B0); PG8_BAR; PG8_SCHED;
            PG8_STAGE(PG8_SB(0, 1), b2 + hstep, voffB);
            PG8_WAIT_V(6); PG8_BAR; PG8_MMA(1, 1, At, B1); PG8_BAR;
            PG8_LDB(B0, 1, 0); PG8_SCHED; PG8_LDA(At, 1, 0); PG8_STAGE(PG8_SA(0, 1), a2 + hstep, voffA);
            PG8_WAIT_L(8); PG8_BAR; PG8_WAIT_L(0); PG8_MMA(0, 0, At, B0); PG8_BAR; PG8_SCHED;
            PG8_LDB(B1, 1, 1); PG8_STAGE(PG8_SB(1, 0), b3, voffB);
            PG8_BAR; PG8_WAIT_L(0); PG8_MMA(0, 1, At, B1); PG8_BAR;
            PG8_LDA(At, 1, 1); PG8_STAGE(PG8_SA(1, 0), a3, voffA);
            PG8_BAR; PG8_WAIT_L(0); PG8_MMA(1, 0, At, B0); PG8_BAR; PG8_SCHED;
            PG8_STAGE(PG8_SB(1, 1), b3 + hstep, voffB);
            PG8_WAIT_V(6); PG8_BAR; PG8_MMA(1, 1, At, B1); PG8_BAR;
        }
        PG8_STAMP();
        if constexpr (!Epi::AFTER_DRAIN) { E(acc, cur, wr, wc, fr, fq); S.done(cur); }
        PG8_STAMP();
        if (!has_next) break;
#pragma unroll
        for (int a = 0; a < 2; ++a)
#pragma unroll
            for (int b = 0; b < 2; ++b)
#pragma unroll
                for (int m = 0; m < 4; ++m)
#pragma unroll
                    for (int n = 0; n < 2; ++n) acc[a][b][m][n] = (f32x4){0.f, 0.f, 0.f, 0.f};
        cur = nxt; cA = nA; cB = nB; ++ui;
    }
    PG8_WAIT_V(0);
    if (wr == 0) PG8_BAR;
    PG8_BAR;
    if constexpr (Epi::AFTER_DRAIN) { E.fused(acc, cur, wr, wc, fr, fq, lds, wid, lane); S.done(cur); }
    PG8_STAMP();
    if (STAMP && wid == 0) { stamps[lane] = lane < nts ? (((unsigned long long)(unsigned)ts_hi << 32) | (unsigned)ts_lo) : 0ull;
        if (lane == 62) stamps[62] = rt_entry; if (lane == 63) stamps[63] = (unsigned long long)wall_clock64(); }
#undef PG8_STAMP
#undef PG8_SA
#undef PG8_SB
#undef PG8_STAGE
#undef PG8_LDA
#undef PG8_LDB
#undef PG8_MMA
#undef PG8_WAIT_V
#undef PG8_WAIT_L
#undef PG8_BAR
#undef PG8_SCHED
}
}
#define XB_TMO      128
#define XB_XCNT(j)  (256  + 64 * (j))
#define XB_XSUB(j)  (1280 + 64 * (j))
#define XB_XGEN(j)  (2304 + 64 * (j))
#define XB_TOP      3328
#define XB_TOPGEN   3392
#define XCD_BAR_WORDS 3456
#define XB_SPIN_CAP (1u << 18)
#define XB_LAS __attribute__((address_space(3)))

__device__ __forceinline__ unsigned xb_ld(unsigned* p)              { return __hip_atomic_load(p, __ATOMIC_RELAXED, __HIP_MEMORY_SCOPE_AGENT); }
__device__ __forceinline__ unsigned xb_add(unsigned* p, unsigned v) { return __hip_atomic_fetch_add(p, v, __ATOMIC_RELAXED, __HIP_MEMORY_SCOPE_AGENT); }
__device__ __forceinline__ unsigned xb_xcc_id() { return (unsigned)__builtin_amdgcn_s_getreg((3 << 11) | 20) & 0xFu; }
#define XB_SPIN(cond, bar) do { unsigned _sp = 0; while (cond) { __builtin_amdgcn_s_sleep(1); \
    if ((++_sp & 255u) == 0u) { if (xb_ld(&(bar)[XB_TMO])) break; if (_sp > XB_SPIN_CAP) { atomicAdd(&(bar)[XB_TMO], 1u); break; } } } } while (0)

struct XcdBarrier {
    unsigned* bar; unsigned x;
    volatile XB_LAS unsigned* st;
};

__device__ __forceinline__ XcdBarrier xcd_barrier_post(unsigned* bar, volatile XB_LAS unsigned* st) {
    XcdBarrier b; b.bar = bar; b.x = xb_xcc_id(); b.st = st;
    if (threadIdx.x == 0) (void)xb_add(&bar[XB_XCNT(b.x)], 1u);
    return b;
}
__device__ __forceinline__ void xcd_barrier_complete(unsigned* bar, unsigned x, unsigned& nloc, unsigned& nx) {
    const unsigned G = gridDim.x * gridDim.y * gridDim.z;
    unsigned sum, cnt, mine, sp = 0u;
    for (;;) {
        sum = 0u; cnt = 0u; mine = 0u;
#pragma unroll
        for (unsigned j = 0; j < 16; ++j) { const unsigned c = xb_ld(&bar[XB_XCNT(j)]); sum += c; cnt += (c > 0u) ? 1u : 0u; mine = (j == x) ? c : mine; }
        if (sum == G) break;
        __builtin_amdgcn_s_sleep(1);
        if ((++sp & 255u) == 0u) { if (xb_ld(&bar[XB_TMO])) break; if (sp > XB_SPIN_CAP) { atomicAdd(&bar[XB_TMO], 1u); break; } }
    }
    nloc = mine > 0u ? mine : 1u; nx = cnt > 0u ? cnt : 1u;
}

__device__ __forceinline__ void xcd_barrier(const XcdBarrier& b) {
    asm volatile("s_waitcnt vmcnt(0)" ::: "memory");
    __syncthreads();
    if (threadIdx.x == 0) {
        unsigned* bar = b.bar;
        __builtin_amdgcn_s_waitcnt(0);
        unsigned nloc = b.st[0], nx = b.st[1];
        if (nloc == 0u) { xcd_barrier_complete(bar, b.x, nloc, nx); b.st[0] = nloc; b.st[1] = nx; }
        const unsigned old = xb_add(&bar[XB_XSUB(b.x)], 1u);
        const unsigned gen = old / nloc;
        if (old + 1u == (gen + 1u) * nloc) {
            __builtin_amdgcn_fence(__ATOMIC_RELEASE, "agent");
            asm volatile("s_waitcnt vmcnt(0)" ::: "memory");
            const unsigned og = xb_add(&bar[XB_TOP], 1u);
            const unsigned tg = og / nx;
            if (og + 1u == (tg + 1u) * nx) xb_add(&bar[XB_TOPGEN], 1u);
            else XB_SPIN(xb_ld(&bar[XB_TOPGEN]) == tg, bar);
            __builtin_amdgcn_fence(__ATOMIC_ACQUIRE, "agent");
            xb_add(&bar[XB_XGEN(b.x)], 1u);
            asm volatile("s_waitcnt vmcnt(0)" ::: "memory");
        } else {
            XB_SPIN(xb_ld(&bar[XB_XGEN(b.x)]) == gen, bar);
            __builtin_amdgcn_fence(__ATOMIC_ACQUIRE, "agent");
            asm volatile("s_waitcnt vmcnt(0)" ::: "memory");
        }
    }
    __syncthreads();
}
using pg8::bf16_t; using pg8::bf16x8; using pg8::f32x4; using pg8::u32x4; using pg8::Unit;
typedef unsigned u32x2 __attribute__((ext_vector_type(2)));
#define MFMA16(a, b, c) __builtin_amdgcn_mfma_f32_16x16x32_bf16((a), (b), (c), 0, 0, 0)

constexpr int T_ = 16384, DM = 2048, NIN = 6144, DFF = 5504, NFF = 11008;
constexpr int LDS_BYTES = 144 * 1024;
constexpr int NPH = 11;

constexpr size_t O_CTR   = 0;
constexpr size_t O_BAR   = 4096;
constexpr size_t O_WIN   = 4096 + 16384;
constexpr size_t O_WOUT  = O_WIN   + (size_t)NIN * DM * 2;
constexpr size_t O_WFIN  = O_WOUT  + (size_t)DM * DM * 2;
constexpr size_t O_WFOUT = O_WFIN  + (size_t)NFF * DM * 2;
constexpr size_t O_WCK   = O_WFOUT + (size_t)DM * DFF * 2;
constexpr size_t O_WCV   = O_WCK   + (size_t)256 * 2048 * 2;
constexpr size_t O_WGLU  = O_WCV   + (size_t)256 * 2048 * 2;
constexpr size_t O_HN    = O_WGLU  + (size_t)512 * 512 * 2;
constexpr size_t O_R     = O_HN    + (size_t)T_ * DM * 2;
constexpr size_t O_P32   = O_R;
constexpr size_t O_PU    = O_P32   + (size_t)T_ * 1536 * 4;
constexpr size_t O_PQKV  = O_PU    + (size_t)T_ * 512 * 2;
constexpr size_t O_PZ    = O_PQKV  + (size_t)T_ * 3072 * 2;
constexpr size_t O_QN    = O_PZ    + (size_t)T_ * 1024 * 2;
constexpr size_t O_KSN   = O_QN    + (size_t)T_ * 512 * 2;
constexpr size_t O_KWN   = O_KSN   + (size_t)T_ * 128 * 2;
constexpr size_t O_VST   = O_KWN   + (size_t)T_ * 128 * 2;
constexpr size_t O_VWT   = O_VST   + (size_t)T_ * 128 * 2;
constexpr size_t O_KC    = O_VWT   + (size_t)T_ * 128 * 2;
constexpr size_t O_VCT   = O_KC    + (size_t)2 * 1024 * 64 * 2;
constexpr size_t O_HCMP  = O_VCT   + (size_t)2 * 64 * 1024 * 2;
constexpr size_t O_GKC   = O_HCMP  + (size_t)2 * 2048 * 256 * 4;
constexpr size_t O_GQG   = O_GKC   + (size_t)2048 * 64 * 128 * 2;
constexpr size_t O_GQK   = O_GQG   + (size_t)2048 * 64 * 128 * 2;
constexpr size_t O_GKD   = O_GQK   + (size_t)2048 * 64 * 64 * 2;
constexpr size_t O_GVAL  = O_GKD   + (size_t)2048 * 64 * 128 * 2;
constexpr size_t O_GEGL  = O_GVAL  + (size_t)2048 * 64 * 128 * 4;
constexpr size_t O_XEND  = O_GEGL  + 8192;
constexpr size_t O_YGELU = O_XEND  + (size_t)64 * 32 * 64 * 2 * 4;
constexpr size_t O_YGLU  = O_YGELU + (size_t)T_ * 512 * 2;
constexpr size_t O_ATT_END = O_YGLU + (size_t)T_ * 512 * 4;
constexpr size_t O_HF    = O_R;
constexpr size_t O_ACT   = O_HF    + (size_t)T_ * NFF * 2;
constexpr size_t O_FFN_END = O_ACT + (size_t)T_ * DFF * 2;
constexpr size_t WS_NEED = O_ATT_END > O_FFN_END ? O_ATT_END : O_FFN_END;

struct Params { const float* in[33]; float* out; unsigned char* ws; int ph_lo, ph_hi; };

__device__ __forceinline__ unsigned short f2bf(float f) { unsigned u = __float_as_uint(f); u += 0x7FFFu + ((u >> 16) & 1u); return (unsigned short)(u >> 16); }
__device__ __forceinline__ float bf2f(unsigned short b) { return __uint_as_float(((unsigned)b) << 16); }
__device__ __forceinline__ unsigned pk2(float lo, float hi) { return pg8::cvt_pk_bf16(lo, hi); }
__device__ __forceinline__ float bflo(unsigned w) { return __uint_as_float(w << 16); }
__device__ __forceinline__ float bfhi(unsigned w) { return __uint_as_float(w & 0xFFFF0000u); }
__device__ __forceinline__ float sigmoidf_(float x) { return __builtin_amdgcn_rcpf(1.0f + __expf(-x)); }
__device__ __forceinline__ float siluf_(float x) { return x * __builtin_amdgcn_rcpf(1.0f + __expf(-x)); }
__device__ __forceinline__ float vmaxf(float a, float b) { float r; asm("v_max_f32 %0, %1, %2" : "=v"(r) : "v"(a), "v"(b)); return r; }
__device__ __forceinline__ float gelu_tanh(float x) { const float u = 0.7978845608028654f * (x + 0.044715f * x * x * x); const float th = 1.0f - 2.0f * __builtin_amdgcn_rcpf(__expf(2.0f * u) + 1.0f); return 0.5f * x * (1.0f + th); }
__device__ __forceinline__ float softplusf_(float x) { return x > 20.f ? x : log1pf(expf(x)); }
__device__ __forceinline__ float wave_sum(float v) { for (int o = 32; o >= 1; o >>= 1) v += __shfl_xor(v, o); return v; }
__device__ __forceinline__ bf16x8 pack8f(f32x4 a, f32x4 b) { u32x4 w; w.x = pk2(a[0], a[1]); w.y = pk2(a[2], a[3]); w.z = pk2(b[0], b[1]); w.w = pk2(b[2], b[3]); return __builtin_bit_cast(bf16x8, w); }
__device__ __forceinline__ float rdlane(float v, int l) { return __int_as_float(__builtin_amdgcn_readlane(__float_as_int(v), l)); }

struct EpiProj {
    static constexpr bool PERM = true, AFTER_DRAIN = false;
    float* P32; bf16_t* Pu; bf16_t* Pqkv; bf16_t* Pz;
    static __device__ __forceinline__ void st_bf(const f32x4 (&acc)[2][2][4][2], bf16_t* base, int ld) {
#pragma unroll
        for (int ai = 0; ai < 2; ++ai)
#pragma unroll
            for (int m = 0; m < 4; ++m) { bf16_t* rp = base + (size_t)(ai * 128 + m * 16) * ld;
#pragma unroll
                for (int bj = 0; bj < 2; ++bj) { const f32x4 v0 = acc[ai][bj][m][0], v1 = acc[ai][bj][m][1]; u32x4 w; w.x = pk2(v0[0], v0[1]); w.y = pk2(v0[2], v0[3]); w.z = pk2(v1[0], v1[1]); w.w = pk2(v1[2], v1[3]); *(u32x4*)(rp + bj * 128) = w; } }
    }
    __device__ __forceinline__ void operator()(const f32x4 (&acc)[2][2][4][2], const Unit& u, int wr, int wc, int fr, int fq) const {
        const int row0 = u.pm * 256 + wr * 64 + fr, colt = wc * 32 + 8 * fq;
        if (u.pn < 6) {
            float* base = P32 + (size_t)row0 * 1536 + u.pn * 256 + colt;
#pragma unroll
            for (int ai = 0; ai < 2; ++ai)
#pragma unroll
                for (int m = 0; m < 4; ++m) { float* rp = base + (size_t)(ai * 128 + m * 16) * 1536;
#pragma unroll
                    for (int bj = 0; bj < 2; ++bj) { *(f32x4*)(rp + bj * 128) = acc[ai][bj][m][0]; *(f32x4*)(rp + bj * 128 + 4) = acc[ai][bj][m][1]; } }
        } else if (u.pn < 8)  st_bf(acc, Pu   + (size_t)row0 * 512  + (u.pn - 6)  * 256 + colt, 512);
        else if (u.pn < 20)   st_bf(acc, Pqkv + (size_t)row0 * 3072 + (u.pn - 8)  * 256 + colt, 3072);
        else                  st_bf(acc, Pz   + (size_t)row0 * 1024 + (u.pn - 20) * 256 + colt, 1024);
    }
};
struct EpiResid {
    static constexpr bool PERM = false, AFTER_DRAIN = false;
    float* X; int ld;
    __device__ __forceinline__ void operator()(const f32x4 (&acc)[2][2][4][2], const Unit& u, int wr, int wc, int fr, int fq) const {
        float* base = X + (size_t)(u.pm * 256 + wr * 64 + fr) * ld + u.pn * 256 + wc * 32 + 4 * fq;
#pragma unroll
        for (int ai = 0; ai < 2; ++ai)
#pragma unroll
            for (int m = 0; m < 4; ++m) { float* rp = base + (size_t)(ai * 128 + m * 16) * ld;
#pragma unroll
                for (int bj = 0; bj < 2; ++bj)
#pragma unroll
                    for (int n = 0; n < 2; ++n) { f32x4* q = (f32x4*)(rp + bj * 128 + n * 16); *q = *q + acc[ai][bj][m][n]; } }
    }
};
struct EpiBf {
    static constexpr bool PERM = true, AFTER_DRAIN = false;
    bf16_t* O; int ld;
    __device__ __forceinline__ void operator()(const f32x4 (&acc)[2][2][4][2], const Unit& u, int wr, int wc, int fr, int fq) const {
        bf16_t* base = O + (size_t)(u.pm * 256 + wr * 64 + fr) * ld + u.pn * 256 + wc * 32 + 8 * fq;
#pragma unroll
        for (int ai = 0; ai < 2; ++ai)
#pragma unroll
            for (int m = 0; m < 4; ++m) { bf16_t* rp = base + (size_t)(ai * 128 + m * 16) * ld;
#pragma unroll
                for (int bj = 0; bj < 2; ++bj) { const f32x4 v0 = acc[ai][bj][m][0], v1 = acc[ai][bj][m][1]; u32x4 w; w.x = pk2(v0[0], v0[1]); w.y = pk2(v0[2], v0[3]); w.z = pk2(v1[0], v1[1]); w.w = pk2(v1[2], v1[3]); *(u32x4*)(rp + bj * 128) = w; } }
    }
};
struct EpiGlu {
    static constexpr bool PERM = false, AFTER_DRAIN = false;
    const bf16_t* Y; float* O;
    __device__ __forceinline__ void operator()(const f32x4 (&acc)[2][2][4][2], const Unit& u, int wr, int wc, int fr, int fq) const {
        const size_t off0 = (size_t)(u.pm * 256 + wr * 64 + fr) * 512 + u.pn * 256 + wc * 32 + 4 * fq;
#pragma unroll
        for (int ai = 0; ai < 2; ++ai)
#pragma unroll
            for (int m = 0; m < 4; ++m) { const size_t ro = off0 + (size_t)(ai * 128 + m * 16) * 512;
#pragma unroll
                for (int bj = 0; bj < 2; ++bj)
#pragma unroll
                    for (int n = 0; n < 2; ++n) { const size_t o = ro + bj * 128 + n * 16; const u32x2 yw = *(const u32x2*)(Y + o); const f32x4 a = acc[ai][bj][m][n];
                        f32x4 r; r[0] = bflo(yw.x) * sigmoidf_(a[0]); r[1] = bfhi(yw.x) * sigmoidf_(a[1]); r[2] = bflo(yw.y) * sigmoidf_(a[2]); r[3] = bfhi(yw.y) * sigmoidf_(a[3]); *(f32x4*)(O + o) = r; } }
    }
};
__device__ __forceinline__ int map_in_col(int n) { return n < 1304 ? n : (n < 1312 ? 5912 + (n - 1304) : (n < 1320 ? 5920 + (n - 1312) : (n < 1536 ? -1 : 1304 + (n - 1536)))); }
struct ConvJob { const float* src; bf16_t* dst; int srcN, K, tile; bool inmap; };
__device__ __forceinline__ bool conv_job(const Params& p, int layer, int it, ConvJob& j) {
    unsigned char* ws = p.ws;
    const int n0 = 32 * 24, n1 = n0 + 32 * 8, n2 = n1 + 32 * 43, n3 = n2 + 86 * 8, n4 = n3 + 32, n5 = n4 + 32, n6 = n5 + 16;
    if (it >= n6) return false;
    j.inmap = false;
    if (it < n0)      { j.src = p.in[2]  + (size_t)layer * DM * 5928; j.srcN = 5928; j.K = DM; j.dst = (bf16_t*)(ws + O_WIN); j.tile = it; j.inmap = true; }
    else if (it < n1) { j.src = p.in[27] + (size_t)layer * DM * DM; j.srcN = DM; j.K = DM; j.dst = (bf16_t*)(ws + O_WOUT); j.tile = it - n0; }
    else if (it < n2) { j.src = p.in[29] + (size_t)layer * DM * NFF; j.srcN = NFF; j.K = DM; j.dst = (bf16_t*)(ws + O_WFIN); j.tile = it - n1; }
    else if (it < n3) { j.src = p.in[32] + (size_t)layer * DFF * DM; j.srcN = DM; j.K = DFF; j.dst = (bf16_t*)(ws + O_WFOUT); j.tile = it - n2; }
    else if (it < n4) { j.src = p.in[8]  + (size_t)layer * 2048 * 256; j.srcN = 256; j.K = 2048; j.dst = (bf16_t*)(ws + O_WCK); j.tile = it - n3; }
    else if (it < n5) { j.src = p.in[10] + (size_t)layer * 2048 * 256; j.srcN = 256; j.K = 2048; j.dst = (bf16_t*)(ws + O_WCV); j.tile = it - n4; }
    else              { j.src = p.in[21] + (size_t)layer * 512 * 512; j.srcN = 512; j.K = 512; j.dst = (bf16_t*)(ws + O_WGLU); j.tile = it - n5; }
    return true;
}
__device__ __forceinline__ void conv_load(const ConvJob& j, int tid, float (&v)[32]) {
    const int nk = j.K >> 6, tk = j.tile % nk, tn = j.tile / nk, k0 = tk * 64, n0 = tn * 256, tx = tid & 255, ty = tid >> 8;
    const int n = n0 + tx, sc = j.inmap ? map_in_col(n) : n;
    const float* sp = j.src + (size_t)(k0 + ty) * j.srcN + (sc >= 0 ? sc : 0);
#pragma unroll
    for (int i = 0; i < 32; ++i) v[i] = (sc >= 0) ? sp[(size_t)(2 * i) * j.srcN] : 0.f;
}
__device__ __forceinline__ void conv_store(const ConvJob& j, int tid, const float (&v)[32], float* sm) {
    const int nk = j.K >> 6, tk = j.tile % nk, tn = j.tile / nk, k0 = tk * 64, n0 = tn * 256, tx = tid & 255, ty = tid >> 8;
#pragma unroll
    for (int i = 0; i < 32; ++i) sm[(ty + 2 * i) * 257 + tx] = v[i];
    __syncthreads();
    const int nn = tid >> 1, hf = tid & 1;
    bf16_t* o = j.dst + (size_t)(n0 + nn) * j.K + k0 + hf * 32;
#pragma unroll
    for (int q = 0; q < 4; ++q) { u32x4 w; const float* sp = sm + (hf * 32 + q * 8) * 257 + nn;
        w.x = pk2(sp[0], sp[257]); w.y = pk2(sp[2 * 257], sp[3 * 257]); w.z = pk2(sp[4 * 257], sp[5 * 257]); w.w = pk2(sp[6 * 257], sp[7 * 257]); *(u32x4*)(o + q * 8) = w; }
    __syncthreads();
}
__device__ void phase_convert(const Params& p, int layer, float* sm) {
    const int G = gridDim.x, tid = tidx();
    ConvJob ja, jb; float va[32], vb[32];
    int it = blockIdx.x;
    bool ha = conv_job(p, layer, it, ja);
    if (ha) conv_load(ja, tid, va);
    while (ha) {
        const bool hb = conv_job(p, layer, it + G, jb);
        if (hb) conv_load(jb, tid, vb);
        conv_store(ja, tid, va, sm);
        if (!hb) break;
        ha = conv_job(p, layer, it + 2 * G, ja);
        if (ha) conv_load(ja, tid, va);
        conv_store(jb, tid, vb, sm);
        it += 2 * G;
    }
}
__device__ void phase_rmsnorm(const float* __restrict__ x, const float* __restrict__ gain, bf16_t* __restrict__ hn, float* __restrict__ xcopy) {
    const int wave = tidx() >> 6, lane = tidx() & 63;
    for (int r = blockIdx.x * 8 + wave; r < T_; r += gridDim.x * 8) {
        const f32x4* xr = (const f32x4*)(x + (size_t)r * DM);
        f32x4 v[8]; float ss = 0.f;
#pragma unroll
        for (int i = 0; i < 8; ++i) { v[i] = xr[lane + 64 * i]; ss += v[i][0] * v[i][0] + v[i][1] * v[i][1] + v[i][2] * v[i][2] + v[i][3] * v[i][3]; }
        ss = wave_sum(ss);
        const float rs = rsqrtf(ss * (1.0f / DM) + 1e-6f);
#pragma unroll
        for (int i = 0; i < 8; ++i) { const f32x4 g = ((const f32x4*)gain)[lane + 64 * i]; u32x2 w; w.x = pk2(v[i][0] * rs * g[0], v[i][1] * rs * g[1]); w.y = pk2(v[i][2] * rs * g[2], v[i][3] * rs * g[3]);
            *(u32x2*)(hn + (size_t)r * DM + (lane + 64 * i) * 4) = w; if (xcopy) ((f32x4*)(xcopy + (size_t)r * DM))[lane + 64 * i] = v[i]; }
    }
}

__device__ void nsa_prep_item(const Params& p, int layer, int item, float* sm) {
    unsigned char* ws = p.ws;
    const float* P32 = (const float*)(ws + O_P32);
    bf16_t* qn = (bf16_t*)(ws + O_QN); bf16_t* ksn = (bf16_t*)(ws + O_KSN); bf16_t* kwn = (bf16_t*)(ws + O_KWN);
    const int wave = tidx() >> 6, lane = tidx() & 63, tid = tidx();
    const int t0 = item * 64;
    const float gq = p.in[3][layer * 64 + lane], gks = p.in[5][layer * 64 + lane], gkw = p.in[6][layer * 64 + lane];
    const float inv = powf(500000.0f, -(float)(lane & 7) * 0.125f);
    for (int tt = 0; tt < 8; ++tt) {
        const int t = t0 + wave * 8 + tt;
        float sn, cs; sincosf((float)t * inv, &sn, &cs);
        const float* row = P32 + (size_t)t * 1536;
#pragma unroll
        for (int hv = 0; hv < 12; ++hv) {
            const int col = hv < 8 ? hv * 64 : (hv < 10 ? 768 + (hv - 8) * 64 : 1024 + (hv - 10) * 64);
            const float g = hv < 8 ? gq : (hv < 10 ? gks : gkw);
            const float x = row[col + lane];
            const float ss = wave_sum(x * x);
            float y = x * rsqrtf(ss * (1.0f / 64.0f) + 1e-6f) * g;
            const float yp = __shfl(y, lane ^ 8);
            if (lane < 8) y = y * cs - yp * sn; else if (lane < 16) y = y * cs + yp * sn;
            if (hv < 8) qn[(size_t)t * 512 + hv * 64 + lane] = f2bf(y * 0.18033688011112042f);
            else {
                unsigned char* k8 = (hv < 10 ? ws + O_KSN : ws + O_KWN) + ((size_t)(((hv - 8) & 1) * 256 + (t >> 6)) * 64 + (t & 63)) * 64 + ((lane >> 3) & 3) * 16 + (lane >> 5) * 8 + (lane & 7);
                *k8 = (unsigned char)__builtin_amdgcn_cvt_pk_fp8_f32(y, 0.f, 0, false);
            }
        }
    }
    for (int e = tid; e < 64 * 256; e += 512) { const int tk = e >> 8, c = e & 255; sm[tk * 257 + c] = P32[(size_t)(t0 + tk) * 1536 + (c < 128 ? 896 + c : 1152 + (c - 128))]; }
    __syncthreads();
    unsigned char* vs8 = ws + O_VST; unsigned char* vw8 = ws + O_VWT;
#pragma unroll
    for (int i = 0; i < 4; ++i) {
        const int rowid = (tid >> 3) + 64 * i, ts = tid & 7;
        float f[8];
#pragma unroll
        for (int k = 0; k < 8; ++k) { const int bb = ts * 8 + k, cc = ((bb >> 3) & 1) * 32 + (bb >> 4) * 8 + (bb & 7); f[k] = sm[((cc & 3) * 16 + (cc >> 2)) * 257 + rowid]; }
        u32x2 w; int t;
        t = __builtin_amdgcn_cvt_pk_fp8_f32(f[0], f[1], 0, false); t = __builtin_amdgcn_cvt_pk_fp8_f32(f[2], f[3], t, true); w.x = (unsigned)t;
        t = __builtin_amdgcn_cvt_pk_fp8_f32(f[4], f[5], 0, false); t = __builtin_amdgcn_cvt_pk_fp8_f32(f[6], f[7], t, true); w.y = (unsigned)t;
        const int rr = rowid & 127;
        unsigned char* dst = (rowid < 128 ? vs8 : vw8) + ((size_t)((rr >> 6) * 256 + item) * 64 + (rr & 63)) * 64 + ts * 8;
        *(u32x2*)dst = w;
    }
    __syncthreads();
}

__device__ void cmp1_wave_tile(const Params& p, int layer, int tile) {
    unsigned char* ws = p.ws;
    const float* P32 = (const float*)(ws + O_P32);
    const int lane = tidx() & 63, fr = lane & 15, fq = lane >> 4;
    const int nt = tile & 15, mt = (tile >> 4) & 127, which = tile >> 11;
    const bf16_t* Wt = (const bf16_t*)(ws + (which ? O_WCV : O_WCK)) + (size_t)(nt * 16 + fr) * 2048 + fq * 8;
    const float* pe = p.in[7] + (size_t)layer * 2048;
    const int r = mt * 16 + fr, n = r >> 1, hk = r & 1;
    const bool rv = n < 1023;
    const float* arow = P32 + (size_t)(16 * (rv ? n : 0)) * 1536 + (which ? 640 : 512) + hk * 64 + fq * 8;
    f32x4 acc = {0.f, 0.f, 0.f, 0.f};
#pragma unroll 8
    for (int ks = 0; ks < 64; ++ks) {
        const int l = ks >> 1, d = (ks & 1) * 32;
        const f32x4* ap = (const f32x4*)(arow + (size_t)l * 1536 + d);
        const f32x4* pp = (const f32x4*)(pe + l * 64 + d + fq * 8);
        f32x4 a0 = ap[0] + pp[0], a1 = ap[1] + pp[1];
        if (!rv) { a0 = (f32x4){0.f, 0.f, 0.f, 0.f}; a1 = a0; }
        const bf16x8 af = pack8f(a0, a1);
        const bf16x8 bf = *(const bf16x8*)(Wt + ks * 32);
        acc = MFMA16(af, bf, acc);
    }
    float* H = (float*)(ws + O_HCMP) + (size_t)which * 2048 * 256;
#pragma unroll
    for (int j = 0; j < 4; ++j) H[(size_t)(mt * 16 + fq * 4 + j) * 256 + nt * 16 + fr] = gelu_tanh(acc[j]);
}
__device__ void cmp2_wave_row(const Params& p, int layer, int idx) {
    unsigned char* ws = p.ws;
    const int lane = tidx() & 63;
    const int which = idx >> 11, r = idx & 2047, n = r >> 1, hk = r & 1;
    const float* H = (const float*)(ws + O_HCMP) + ((size_t)which * 2048 + r) * 256;
    const float* w2 = p.in[which ? 11 : 9] + (size_t)layer * 256 * 64;
    float acc = 0.f;
    if (n < 1023) {
        float a4[4] = {0.f, 0.f, 0.f, 0.f};
#pragma unroll 8
        for (int f = 0; f < 256; f += 4) { const f32x4 h4 = *(const f32x4*)(H + f); a4[0] += h4[0] * w2[f * 64 + lane]; a4[1] += h4[1] * w2[(f + 1) * 64 + lane]; a4[2] += h4[2] * w2[(f + 2) * 64 + lane]; a4[3] += h4[3] * w2[(f + 3) * 64 + lane]; }
        acc = (a4[0] + a4[1]) + (a4[2] + a4[3]);
    }
    if (which == 0) {
        const float ss = wave_sum(acc * acc);
        float y = acc * rsqrtf(ss * (1.0f / 64.0f) + 1e-6f) * p.in[4][layer * 64 + lane];
        const float inv = powf(500000.0f, -(float)(lane & 7) * 0.125f);
        float sn, cs; sincosf((float)(16 * n + 16) * inv, &sn, &cs);
        const float yp = __shfl(y, lane ^ 8);
        if (lane < 8) y = y * cs - yp * sn; else if (lane < 16) y = y * cs + yp * sn;
        if (n >= 1023) y = 0.f;
        ((bf16_t*)(ws + O_KC))[((size_t)hk * 1024 + n) * 64 + lane] = f2bf(y);
    } else {
        { const int cc = ((n & 15) << 2) | ((n >> 4) & 3); (ws + O_VCT)[((size_t)(hk * 16 + (n >> 6)) * 64 + lane) * 64 + ((cc >> 3) & 3) * 16 + (cc >> 5) * 8 + (cc & 7)] = (unsigned char)__builtin_amdgcn_cvt_pk_fp8_f32(acc, 0.f, 0, false); }
    }
}

typedef float f32x2 __attribute__((ext_vector_type(2)));
struct S5Coef { float ar, ai; f32x2 bb[16]; };
__device__ __forceinline__ void s5_setup(const Params& p, int layer, int g, int lane, S5Coef& c) {
    const int gp = layer * 2048 + g * 64 + lane;
    const float dt = expf(p.in[15][layer * 32 + g]);
    const float lr = p.in[13][gp], li = p.in[14][gp];
    const float mag = expf(lr * dt); float sn, cs; sincosf(li * dt, &sn, &cs);
    c.ar = mag * cs; c.ai = mag * sn;
    const float den = lr * lr + li * li, nr = c.ar - 1.0f, ni = c.ai;
    const float cr = (nr * lr + ni * li) / den, ci = (ni * lr - nr * li) / den;
    const f32x4* br = (const f32x4*)(p.in[16] + (size_t)gp * 16); const f32x4* bi = (const f32x4*)(p.in[17] + (size_t)gp * 16);
#pragma unroll
    for (int q = 0; q < 4; ++q) { const f32x4 a = br[q], b = bi[q];
#pragma unroll
        for (int e = 0; e < 4; ++e) c.bb[q * 4 + e] = (f32x2){cr * a[e] - ci * b[e], cr * b[e] + ci * a[e]}; }
}
__device__ __forceinline__ void s5_stage_u(const bf16_t* Pu, int tok, int g, float* ul, int lane) {
    const u32x4* s = (const u32x4*)(Pu + (size_t)tok * 512 + g * 16); const u32x4 a = s[0], b = s[1];
    f32x4* o = (f32x4*)(ul + lane * 16);
    o[0] = (f32x4){bflo(a.x), bfhi(a.x), bflo(a.y), bfhi(a.y)}; o[1] = (f32x4){bflo(a.z), bfhi(a.z), bflo(a.w), bfhi(a.w)};
    o[2] = (f32x4){bflo(b.x), bfhi(b.x), bflo(b.y), bfhi(b.y)}; o[3] = (f32x4){bflo(b.z), bfhi(b.z), bflo(b.w), bfhi(b.w)};
    asm volatile("s_waitcnt lgkmcnt(0)" ::: "memory");
}
__device__ __forceinline__ void s5_step(const S5Coef& k, const float* uj, float& xr, float& xi) {
    const f32x4 u0 = ((const f32x4*)uj)[0], u1 = ((const f32x4*)uj)[1], u2 = ((const f32x4*)uj)[2], u3 = ((const f32x4*)uj)[3];
    f32x2 acc0 = {0.f, 0.f}, acc1 = {0.f, 0.f};
#pragma unroll
    for (int e = 0; e < 4; ++e) { acc0 += k.bb[e] * u0[e]; acc1 += k.bb[4 + e] * u1[e]; }
#pragma unroll
    for (int e = 0; e < 4; ++e) { acc0 += k.bb[8 + e] * u2[e]; acc1 += k.bb[12 + e] * u3[e]; }
    const f32x2 bu = acc0 + acc1;
    const float nxr = k.ar * xr - k.ai * xi + bu[0], nxi = k.ar * xi + k.ai * xr + bu[1]; xr = nxr; xi = nxi;
}
__device__ void s5_passA_wave(const Params& p, int layer, int item, float* ul) {
    unsigned char* ws = p.ws; const bf16_t* Pu = (const bf16_t*)(ws + O_PU);
    const int lane = tidx() & 63, c = item >> 5, g = item & 31;
    S5Coef k; s5_setup(p, layer, g, lane, k);
    float xr = 0.f, xi = 0.f;
    for (int sub = 0; sub < 4; ++sub) {
        s5_stage_u(Pu, c * 256 + sub * 64 + lane, g, ul, lane);
#pragma unroll 4
        for (int j = 0; j < 64; ++j) s5_step(k, ul + j * 16, xr, xi);
        asm volatile("s_waitcnt lgkmcnt(0)" ::: "memory");
    }
    float* xe = (float*)(ws + O_XEND) + ((size_t)(c * 32 + g) * 64 + lane) * 2; xe[0] = xr; xe[1] = xi;
}
__device__ void s5_passB_wave(const Params& p, int layer, int item, bf16_t* xl, float* ul) {
    unsigned char* ws = p.ws; const bf16_t* Pu = (const bf16_t*)(ws + O_PU); bf16_t* yg = (bf16_t*)(ws + O_YGELU);
    const int lane = tidx() & 63, fr = lane & 15, fq = lane >> 4, c = item >> 5, g = item & 31;
    S5Coef k; s5_setup(p, layer, g, lane, k);
    float pr = k.ar, pi = k.ai;
#pragma unroll
    for (int s = 0; s < 8; ++s) { const float nr = pr * pr - pi * pi, ni = 2.f * pr * pi; pr = nr; pi = ni; }
    float xr = 0.f, xi = 0.f;
    const float* xe = (const float*)(ws + O_XEND) + ((size_t)g * 64 + lane) * 2;
#pragma unroll 8
    for (int cc = 0; cc < c; ++cc) { const float er = xe[(size_t)cc * 32 * 64 * 2], ei = xe[(size_t)cc * 32 * 64 * 2 + 1]; const float nr = pr * xr - pi * xi + er, ni = pr * xi + pi * xr + ei; xr = nr; xi = ni; }
    bf16x8 cf[4];
    {
        const float* cre = p.in[18] + (size_t)layer * 32 * 16 * 64 + ((size_t)g * 16 + fr) * 64; const float* cim = p.in[19] + (size_t)layer * 32 * 16 * 64 + ((size_t)g * 16 + fr) * 64;
#pragma unroll
        for (int ks = 0; ks < 4; ++ks) { const float* s = (ks < 2 ? cre : cim) + (ks & 1) * 32 + fq * 8; f32x4 a = ((const f32x4*)s)[0], b = ((const f32x4*)s)[1]; if (ks >= 2) { a = -a; b = -b; } cf[ks] = pack8f(a, b); }
    }
    const float dsk = p.in[20][layer * 512 + g * 16 + fr];
    for (int sub = 0; sub < 4; ++sub) {
        const int tb = c * 256 + sub * 64;
        s5_stage_u(Pu, tb + lane, g, ul, lane);
        for (int jb = 0; jb < 4; ++jb) {
#pragma unroll 4
            for (int jj = 0; jj < 16; ++jj) {
                s5_step(k, ul + (jb * 16 + jj) * 16, xr, xi);
                xl[jj * 136 + lane] = f2bf(xr); xl[jj * 136 + 64 + lane] = f2bf(xi);
            }
            asm volatile("s_waitcnt lgkmcnt(0)" ::: "memory");
            f32x4 y = {0.f, 0.f, 0.f, 0.f};
#pragma unroll
            for (int ks = 0; ks < 4; ++ks) { const bf16x8 af = *(const bf16x8*)(xl + fr * 136 + ks * 32 + fq * 8); y = MFMA16(af, cf[ks], y); }
            asm volatile("s_waitcnt lgkmcnt(0)" ::: "memory");
#pragma unroll
            for (int q = 0; q < 4; ++q) { const int tl = jb * 16 + fq * 4 + q; const float u = ul[tl * 16 + fr]; yg[(size_t)(tb + tl) * 512 + g * 16 + fr] = f2bf(gelu_tanh(y[q] + dsk * u)); }
        }
        asm volatile("s_waitcnt lgkmcnt(0)" ::: "memory");
    }
}
__device__ void gdn_prep_item(const Params& p, int layer, int item, unsigned char* lds) {
    unsigned char* ws = p.ws;
    const int tid = tidx(), wave = tid >> 6, lane = tid & 63, fr = lane & 15, fq = lane >> 4;
    const int n = item >> 3, h = item & 7, t0 = n * 64;
    bf16_t* qs = (bf16_t*)(lds); bf16_t* ks = (bf16_t*)(lds + 17408); bf16_t* vbT = (bf16_t*)(lds + 34816); bf16_t* kgT = (bf16_t*)(lds + 53248); bf16_t* kdT = (bf16_t*)(lds + 71680);
    float* Am = (float*)(lds + 90112); bf16_t* Tb = (bf16_t*)(lds + 107520); float* gcs = (float*)(lds + 116736); float* bts = (float*)(lds + 116992);
    const float* P32 = (const float*)(ws + O_P32); const bf16_t* Pqkv = (const bf16_t*)(ws + O_PQKV);
    if (wave == 0) {
        const int t = t0 + lane;
        const float a = P32[(size_t)t * 1536 + 1304 + h], b = P32[(size_t)t * 1536 + 1312 + h];
        const float g = -expf(p.in[24][layer * 8 + h]) * softplusf_(a + p.in[25][layer * 8 + h]);
        float s = g;
#pragma unroll
        for (int off = 1; off < 64; off <<= 1) { const float o = __shfl_up(s, off); if (lane >= off) s += o; }
        gcs[lane] = s; bts[lane] = sigmoidf_(b);
    }
    __syncthreads();
    {
        const int r = tid >> 3, c0 = (tid & 7) * 16;
        const float gcr = gcs[r], btr = bts[r], eg = expf(gcr), ed = expf(gcs[63] - gcr);
        const float* cw = p.in[23] + (size_t)layer * 4 * 3072;
#pragma unroll
        for (int which = 0; which < 3; ++which) {
            const int col = which * 1024 + h * 128 + c0;
            float acc[16];
#pragma unroll
            for (int e = 0; e < 16; ++e) acc[e] = 0.f;
#pragma unroll
            for (int j = 0; j < 4; ++j) {
                const int tr = t0 + r - 3 + j;
                if (tr >= 0) {
                    const u32x4* s = (const u32x4*)(Pqkv + (size_t)tr * 3072 + col); const u32x4 a = s[0], b = s[1];
                    const f32x4* wp = (const f32x4*)(cw + j * 3072 + col); const f32x4 w0 = wp[0], w1 = wp[1], w2 = wp[2], w3 = wp[3];
                    acc[0] += w0[0] * bflo(a.x); acc[1] += w0[1] * bfhi(a.x); acc[2] += w0[2] * bflo(a.y); acc[3] += w0[3] * bfhi(a.y);
                    acc[4] += w1[0] * bflo(a.z); acc[5] += w1[1] * bfhi(a.z); acc[6] += w1[2] * bflo(a.w); acc[7] += w1[3] * bfhi(a.w);
                    acc[8] += w2[0] * bflo(b.x); acc[9] += w2[1] * bfhi(b.x); acc[10] += w2[2] * bflo(b.y); acc[11] += w2[3] * bfhi(b.y);
                    acc[12] += w3[0] * bflo(b.z); acc[13] += w3[1] * bfhi(b.z); acc[14] += w3[2] * bflo(b.w); acc[15] += w3[3] * bfhi(b.w);
                }
            }
            float ss = 0.f;
#pragma unroll
            for (int e = 0; e < 16; ++e) { acc[e] = siluf_(acc[e]); ss += acc[e] * acc[e]; }
            ss += __shfl_xor(ss, 1); ss += __shfl_xor(ss, 2); ss += __shfl_xor(ss, 4);
            const float rn = rsqrtf(ss + 1e-6f);
            if (which == 0) {
                bf16_t* qg = (bf16_t*)(ws + O_GQG) + (size_t)item * 8192 + r * 128 + c0;
                float v[16];
#pragma unroll
                for (int e = 0; e < 16; ++e) v[e] = acc[e] * rn * 0.08838834764831845f;
                u32x4 w0, w1; w0.x = pk2(v[0], v[1]); w0.y = pk2(v[2], v[3]); w0.z = pk2(v[4], v[5]); w0.w = pk2(v[6], v[7]); w1.x = pk2(v[8], v[9]); w1.y = pk2(v[10], v[11]); w1.z = pk2(v[12], v[13]); w1.w = pk2(v[14], v[15]);
                *(u32x4*)(qs + r * 136 + c0) = w0; *(u32x4*)(qs + r * 136 + c0 + 8) = w1;
                u32x4 g0, g1; g0.x = pk2(v[0] * eg, v[1] * eg); g0.y = pk2(v[2] * eg, v[3] * eg); g0.z = pk2(v[4] * eg, v[5] * eg); g0.w = pk2(v[6] * eg, v[7] * eg);
                g1.x = pk2(v[8] * eg, v[9] * eg); g1.y = pk2(v[10] * eg, v[11] * eg); g1.z = pk2(v[12] * eg, v[13] * eg); g1.w = pk2(v[14] * eg, v[15] * eg);
                *(u32x4*)qg = g0; *(u32x4*)(qg + 8) = g1;
            } else if (which == 1) {
                float v[16];
#pragma unroll
                for (int e = 0; e < 16; ++e) v[e] = acc[e] * rn;
                u32x4 w0, w1; w0.x = pk2(v[0], v[1]); w0.y = pk2(v[2], v[3]); w0.z = pk2(v[4], v[5]); w0.w = pk2(v[6], v[7]); w1.x = pk2(v[8], v[9]); w1.y = pk2(v[10], v[11]); w1.z = pk2(v[12], v[13]); w1.w = pk2(v[14], v[15]);
                *(u32x4*)(ks + r * 136 + c0) = w0; *(u32x4*)(ks + r * 136 + c0 + 8) = w1;
#pragma unroll
                for (int e = 0; e < 16; ++e) { kgT[(c0 + e) * 72 + r] = f2bf(v[e] * btr * eg); kdT[(c0 + e) * 72 + r] = f2bf(v[e] * ed); }
            } else {
#pragma unroll
                for (int e = 0; e < 16; ++e) vbT[(c0 + e) * 72 + r] = f2bf(acc[e] * btr);
            }
        }
    }
    __syncthreads();
    {
        const int d = tid >> 2, sg = tid & 3;
        const u32x4 a = *(const u32x4*)(kdT + d * 72 + sg * 16), b = *(const u32x4*)(kdT + d * 72 + sg * 16 + 8);
        bf16_t* dst = (bf16_t*)(ws + O_GKD) + (size_t)item * 8192 + d * 64 + sg * 16; *(u32x4*)dst = a; *(u32x4*)(dst + 8) = b;
    }
    { float* Tmz = (float*)(lds + 117248); for (int e2 = tid; e2 < 64 * 68; e2 += 512) Tmz[e2] = 0.f; }
    {
        const int mi = wave >> 1;
        bf16_t* qko = (bf16_t*)(ws + O_GQK) + (size_t)item * 4096;
#pragma unroll
        for (int q = 0; q < 2; ++q) {
            const int nj = (wave & 1) * 2 + q;
            f32x4 kk = {0.f, 0.f, 0.f, 0.f}, qk = {0.f, 0.f, 0.f, 0.f};
            if (nj <= mi) {
#pragma unroll
                for (int s = 0; s < 4; ++s) {
                    const bf16x8 bk = *(const bf16x8*)(ks + (nj * 16 + fr) * 136 + s * 32 + fq * 8);
                    const bf16x8 ak = *(const bf16x8*)(ks + (mi * 16 + fr) * 136 + s * 32 + fq * 8);
                    const bf16x8 aq = *(const bf16x8*)(qs + (mi * 16 + fr) * 136 + s * 32 + fq * 8);
                    kk = MFMA16(ak, bk, kk); qk = MFMA16(aq, bk, qk);
                }
            }
            const int j = nj * 16 + fr; const float gj = gcs[j];
#pragma unroll
            for (int e = 0; e < 4; ++e) {
                const int i = mi * 16 + fq * 4 + e;
                const float dec = (j <= i) ? expf(gcs[i] - gj) : 0.f;
                Am[i * 68 + j] = (j < i) ? bts[i] * kk[e] * dec : 0.f;
                qko[i * 64 + j] = f2bf((j <= i) ? qk[e] * dec : 0.f);
            }
        }
    }
    __syncthreads();
    {
        float* Tm = (float*)(lds + 117248); float* Ps = (float*)(lds + 134656) + wave * 320;
        if (wave == 0) {
            const int bo = fq * 16; float t[16];
#pragma unroll
            for (int i = 0; i < 16; ++i) {
                float s = (i == fr) ? 1.f : 0.f;
#pragma unroll
                for (int j = 0; j < i; ++j) s -= Am[(bo + i) * 68 + bo + j] * t[j];
                t[i] = s; Tm[(bo + i) * 68 + bo + fr] = s;
            }
        }
        asm volatile("s_waitcnt lgkmcnt(0)" ::: "memory"); __syncthreads();
#pragma unroll
        for (int d = 1; d < 4; ++d) {
            if (wave < 4 - d) {
                const int bi = wave + d, bj = wave;
                f32x4 Q = {0.f, 0.f, 0.f, 0.f};
                for (int kb = bj; kb < bi; ++kb) {
                    const float* X = Am + (bi * 16) * 68 + kb * 16; const float* Y = Tm + (kb * 16) * 68 + bj * 16;
#pragma unroll
                    for (int s = 0; s < 4; ++s) Q = __builtin_amdgcn_mfma_f32_16x16x4f32(X[fr * 68 + 4 * s + fq], Y[(4 * s + fq) * 68 + fr], Q, 0, 0, 0);
                }
#pragma unroll
                for (int e2 = 0; e2 < 4; ++e2) Ps[(fq * 4 + e2) * 20 + fr] = Q[e2];
                asm volatile("s_waitcnt lgkmcnt(0)" ::: "memory");
                f32x4 R = {0.f, 0.f, 0.f, 0.f};
                const float* X = Tm + (bi * 16) * 68 + bi * 16;
#pragma unroll
                for (int s = 0; s < 4; ++s) R = __builtin_amdgcn_mfma_f32_16x16x4f32(X[fr * 68 + 4 * s + fq], Ps[(4 * s + fq) * 20 + fr], R, 0, 0, 0);
#pragma unroll
                for (int e2 = 0; e2 < 4; ++e2) Tm[(bi * 16 + fq * 4 + e2) * 68 + bj * 16 + fr] = -R[e2];
            }
            asm volatile("s_waitcnt lgkmcnt(0)" ::: "memory"); __syncthreads();
        }
        for (int e2 = tid; e2 < 4096; e2 += 512) { const int r = e2 >> 6, c = e2 & 63; Tb[r * 72 + c] = f2bf(Tm[r * 68 + c]); }
    }
    __syncthreads();
    {
        const int mi = wave & 3;
        const bf16x8 a0 = *(const bf16x8*)(Tb + (mi * 16 + fr) * 72 + fq * 8), a1 = *(const bf16x8*)(Tb + (mi * 16 + fr) * 72 + 32 + fq * 8);
        float* vo = (float*)(ws + O_GVAL) + (size_t)item * 8192; bf16_t* ko = (bf16_t*)(ws + O_GKC) + (size_t)item * 8192;
#pragma unroll
        for (int q = 0; q < 4; ++q) {
            const int nt = (wave >> 2) * 4 + q;
            f32x4 v = {0.f, 0.f, 0.f, 0.f}, kc = {0.f, 0.f, 0.f, 0.f};
            v = MFMA16(a0, *(const bf16x8*)(vbT + (nt * 16 + fr) * 72 + fq * 8), v); v = MFMA16(a1, *(const bf16x8*)(vbT + (nt * 16 + fr) * 72 + 32 + fq * 8), v);
            kc = MFMA16(a0, *(const bf16x8*)(kgT + (nt * 16 + fr) * 72 + fq * 8), kc); kc = MFMA16(a1, *(const bf16x8*)(kgT + (nt * 16 + fr) * 72 + 32 + fq * 8), kc);
#pragma unroll
            for (int e = 0; e < 4; ++e) { const int i = mi * 16 + fq * 4 + e, d = nt * 16 + fr; vo[i * 128 + d] = v[e]; ko[i * 128 + d] = f2bf(kc[e]); }
        }
    }
    if (tid == 0) ((float*)(ws + O_GEGL))[item] = expf(gcs[63]);
    __syncthreads();
}

struct GdnUO { bf16x8 kc[4], qg[4], qk[2]; float val[2][4]; };
struct GdnSU { bf16x8 kd[2][2]; float egl; };
__device__ __forceinline__ void gdn_load_uo(const unsigned char* ws, int item, int mt, int fr, int fq, int dvb, GdnUO& f) {
    const bf16_t* kc = (const bf16_t*)(ws + O_GKC) + (size_t)item * 8192 + (mt * 16 + fr) * 128 + fq * 8;
    const bf16_t* qg = (const bf16_t*)(ws + O_GQG) + (size_t)item * 8192 + (mt * 16 + fr) * 128 + fq * 8;
    const bf16_t* qk = (const bf16_t*)(ws + O_GQK) + (size_t)item * 4096 + (mt * 16 + fr) * 64 + fq * 8;
    const float* vl = (const float*)(ws + O_GVAL) + (size_t)item * 8192 + (mt * 16 + fq * 4) * 128 + dvb + fr;
#pragma unroll
    for (int s = 0; s < 4; ++s) { f.kc[s] = *(const bf16x8*)(kc + s * 32); f.qg[s] = *(const bf16x8*)(qg + s * 32); }
#pragma unroll
    for (int s = 0; s < 2; ++s) f.qk[s] = *(const bf16x8*)(qk + s * 32);
#pragma unroll
    for (int nt = 0; nt < 2; ++nt)
#pragma unroll
        for (int e = 0; e < 4; ++e) f.val[nt][e] = vl[e * 128 + nt * 16];
}
__device__ __forceinline__ void gdn_load_su(const unsigned char* ws, int item, int w4, int fr, int fq, GdnSU& f) {
    const bf16_t* kd = (const bf16_t*)(ws + O_GKD) + (size_t)item * 8192 + (2 * w4 * 16 + fr) * 64 + fq * 8;
#pragma unroll
    for (int s = 0; s < 2; ++s) { f.kd[0][s] = *(const bf16x8*)(kd + s * 32); f.kd[1][s] = *(const bf16x8*)(kd + 16 * 64 + s * 32); }
    f.egl = ((const float*)(ws + O_GEGL))[item];
}
#define GDN_BAR() do { asm volatile("s_waitcnt lgkmcnt(0)" ::: "memory"); __builtin_amdgcn_s_barrier(); asm volatile("" ::: "memory"); } while (0)
__device__ __forceinline__ void gdn_step_uo(const GdnUO& c, bf16_t* Sl, bf16_t* vn, float* go, int n, int h, int mt, int fr, int fq, int dvb) {
    bf16x8 Sb[2][4];
#pragma unroll
    for (int nt = 0; nt < 2; ++nt)
#pragma unroll
        for (int s = 0; s < 4; ++s) Sb[nt][s] = *(const bf16x8*)(Sl + nt * (16 * 136) + fr * 136 + s * 32 + fq * 8);
    f32x4 U[2], O[2];
#pragma unroll
    for (int nt = 0; nt < 2; ++nt) { U[nt] = (f32x4){0.f, 0.f, 0.f, 0.f}; O[nt] = (f32x4){0.f, 0.f, 0.f, 0.f};
#pragma unroll
        for (int s = 0; s < 4; ++s) U[nt] = MFMA16(c.kc[s], Sb[nt][s], U[nt]);
        u32x2 w; w.x = pk2(c.val[nt][0] - U[nt][0], c.val[nt][1] - U[nt][1]); w.y = pk2(c.val[nt][2] - U[nt][2], c.val[nt][3] - U[nt][3]);
        *(u32x2*)(vn + nt * (16 * 72) + fr * 72 + mt * 16 + fq * 4) = w; }
#pragma unroll
    for (int nt = 0; nt < 2; ++nt)
#pragma unroll
        for (int s = 0; s < 4; ++s) O[nt] = MFMA16(c.qg[s], Sb[nt][s], O[nt]);
    GDN_BAR();
#pragma unroll
    for (int nt = 0; nt < 2; ++nt) {
        const bf16x8 V0 = *(const bf16x8*)(vn + nt * (16 * 72) + fr * 72 + fq * 8), V1 = *(const bf16x8*)(vn + nt * (16 * 72) + fr * 72 + 32 + fq * 8);
        O[nt] = MFMA16(c.qk[0], V0, O[nt]); O[nt] = MFMA16(c.qk[1], V1, O[nt]);
#pragma unroll
        for (int e = 0; e < 4; ++e) go[(size_t)(n * 64 + mt * 16 + fq * 4 + e) * 1024 + h * 128 + dvb + nt * 16 + fr] = O[nt][e];
    }
    GDN_BAR();
}
__device__ __forceinline__ void gdn_step_su(const GdnSU& c, f32x4 (&St)[2][2], bf16_t* Sl, const bf16_t* vn, int w4, int fr, int fq) {
    GDN_BAR();
#pragma unroll
    for (int nt = 0; nt < 2; ++nt) {
        const bf16x8 V0 = *(const bf16x8*)(vn + nt * (16 * 72) + fr * 72 + fq * 8), V1 = *(const bf16x8*)(vn + nt * (16 * 72) + fr * 72 + 32 + fq * 8);
#pragma unroll
        for (int q = 0; q < 2; ++q) {
            St[nt][q] = St[nt][q] * c.egl;
            St[nt][q] = MFMA16(V0, c.kd[q][0], St[nt][q]); St[nt][q] = MFMA16(V1, c.kd[q][1], St[nt][q]);
#pragma unroll
            for (int e = 0; e < 4; ++e) Sl[nt * (16 * 136) + (fq * 4 + e) * 136 + (2 * w4 + q) * 16 + fr] = f2bf(St[nt][q][e]);
        }
    }
    GDN_BAR();
}
__device__ void gdn_recurrence(const Params& p, int b, unsigned char* lds) {
    const unsigned char* ws = p.ws;
    const int tid = tidx(), wave = tid >> 6, lane = tid & 63, fr = lane & 15, fq = lane >> 4;
    const int h = b >> 2, dvb = (b & 3) * 32;
    bf16_t* Sl = (bf16_t*)lds; bf16_t* vn = (bf16_t*)(lds + 2 * 16 * 136 * 2);
    float* go = (float*)(p.ws + O_PQKV);
    for (int e = tid; e < 2 * 16 * 136; e += 512) Sl[e] = 0;
    __syncthreads();
    if (wave < 4) {
        const int mt = wave;
        GdnUO f0, f1, f2;
        gdn_load_uo(ws, h, mt, fr, fq, dvb, f0); gdn_load_uo(ws, 8 + h, mt, fr, fq, dvb, f1);
        for (int n = 0; n < 255; n += 3) {
            gdn_load_uo(ws, (n + 2) * 8 + h, mt, fr, fq, dvb, f2); gdn_step_uo(f0, Sl, vn, go, n, h, mt, fr, fq, dvb);
            gdn_load_uo(ws, (n + 3) * 8 + h, mt, fr, fq, dvb, f0); gdn_step_uo(f1, Sl, vn, go, n + 1, h, mt, fr, fq, dvb);
            if (n + 4 < 256) gdn_load_uo(ws, (n + 4) * 8 + h, mt, fr, fq, dvb, f1);
            gdn_step_uo(f2, Sl, vn, go, n + 2, h, mt, fr, fq, dvb);
        }
        gdn_step_uo(f0, Sl, vn, go, 255, h, mt, fr, fq, dvb);
    } else {
        const int w4 = wave - 4;
        f32x4 St[2][2];
#pragma unroll
        for (int a = 0; a < 2; ++a)
#pragma unroll
            for (int c = 0; c < 2; ++c) St[a][c] = (f32x4){0.f, 0.f, 0.f, 0.f};
        GdnSU f0, f1, f2;
        gdn_load_su(ws, h, w4, fr, fq, f0); gdn_load_su(ws, 8 + h, w4, fr, fq, f1);
        for (int n = 0; n < 255; n += 3) {
            gdn_load_su(ws, (n + 2) * 8 + h, w4, fr, fq, f2); gdn_step_su(f0, St, Sl, vn, w4, fr, fq);
            gdn_load_su(ws, (n + 3) * 8 + h, w4, fr, fq, f0); gdn_step_su(f1, St, Sl, vn, w4, fr, fq);
            if (n + 4 < 256) gdn_load_su(ws, (n + 4) * 8 + h, w4, fr, fq, f1);
            gdn_step_su(f2, St, Sl, vn, w4, fr, fq);
        }
        gdn_step_su(f0, St, Sl, vn, w4, fr, fq);
    }
}
struct KVF { bf16x8 k[4][2]; };
__device__ __forceinline__ void kv_load(const bf16_t* kp, int ldk, KVF& f) {
#pragma unroll
    for (int s = 0; s < 4; ++s) { f.k[s][0] = *(const bf16x8*)(kp + (size_t)(s * 16) * ldk); f.k[s][1] = *(const bf16x8*)(kp + (size_t)(s * 16) * ldk + 32); }
}
template <int CTRL> __device__ __forceinline__ float dppf(float v) { return __int_as_float(__builtin_amdgcn_update_dpp(0, __float_as_int(v), CTRL, 0xF, 0xF, true)); }
template <int CTRL> __device__ __forceinline__ unsigned dppu(unsigned v) { return (unsigned)__builtin_amdgcn_update_dpp(0, (int)v, CTRL, 0xF, 0xF, true); }
__device__ __forceinline__ float rmax16(float v) { v = vmaxf(v, dppf<0xB1>(v)); v = vmaxf(v, dppf<0x4E>(v)); v = vmaxf(v, dppf<0x124>(v)); v = vmaxf(v, dppf<0x128>(v)); return v; }
__device__ __forceinline__ float rsum16(float v) { v += dppf<0xB1>(v); v += dppf<0x4E>(v); v += dppf<0x124>(v); v += dppf<0x128>(v); return v; }
template <int CTRL> __device__ __forceinline__ unsigned long long dppmax64(unsigned long long b) { const unsigned lo = dppu<CTRL>((unsigned)b), hi = dppu<CTRL>((unsigned)(b >> 32)); const unsigned long long ob = ((unsigned long long)hi << 32) | lo; return ob > b ? ob : b; }
#define MFMA8(a, b, c) __builtin_amdgcn_mfma_f32_16x16x32_fp8_fp8((a), (b), (c), 0, 0, 0)
__device__ __forceinline__ long mk64(unsigned lo, unsigned hi) { return (long)(((unsigned long long)hi << 32) | lo); }
__device__ __forceinline__ long bf8_to_fp8(bf16x8 v) {
    const u32x4 w = __builtin_bit_cast(u32x4, v);
    int a = __builtin_amdgcn_cvt_pk_fp8_f32(bflo(w.x), bfhi(w.x), 0, false); a = __builtin_amdgcn_cvt_pk_fp8_f32(bflo(w.y), bfhi(w.y), a, true);
    int b = __builtin_amdgcn_cvt_pk_fp8_f32(bflo(w.z), bfhi(w.z), 0, false); b = __builtin_amdgcn_cvt_pk_fp8_f32(bflo(w.w), bfhi(w.w), b, true);
    return mk64((unsigned)a, (unsigned)b);
}
struct K8F { u32x4 k[4]; };
__device__ __forceinline__ void k8_load(const unsigned char* kp, K8F& f) {
#pragma unroll
    for (int s = 0; s < 4; ++s) f.k[s] = *(const u32x4*)(kp + s * 1024);
}
__device__ __forceinline__ void softmax_pv(const f32x4 (&S)[4], const u32x4 (&Vw)[4], unsigned vmask, float (&m)[4], float (&l)[4], f32x4 (&O)[4], unsigned char* Pt, int fr, int fq) {
    float mx[4];
#pragma unroll
    for (int j = 0; j < 4; ++j) { float v = -1e30f;
#pragma unroll
        for (int s = 0; s < 4; ++s) v = ((vmask >> s) & 1u) ? vmaxf(v, S[s][j]) : v;
        mx[j] = rmax16(v); }
#pragma unroll
    for (int j = 0; j < 4; ++j) { const float mn = vmaxf(m[j], mx[j]); const float a = __builtin_amdgcn_exp2f(m[j] - mn); m[j] = mn; l[j] *= a;
#pragma unroll
        for (int dt = 0; dt < 4; ++dt) O[dt][j] *= a; }
#pragma unroll
    for (int j = 0; j < 4; ++j) { float pv[4];
#pragma unroll
        for (int s = 0; s < 4; ++s) { pv[s] = ((vmask >> s) & 1u) ? __builtin_amdgcn_exp2f(S[s][j] - m[j]) : 0.f; l[j] += pv[s]; }
        int t = __builtin_amdgcn_cvt_pk_fp8_f32(pv[0] * 256.f, pv[1] * 256.f, 0, false); t = __builtin_amdgcn_cvt_pk_fp8_f32(pv[2] * 256.f, pv[3] * 256.f, t, true);
        *(unsigned*)(Pt + (fq * 4 + j) * 72 + fr * 4) = (unsigned)t; }
    asm volatile("s_waitcnt lgkmcnt(0)" ::: "memory");
    const u32x2 p0 = *(const u32x2*)(Pt + fr * 72 + fq * 8), p1 = *(const u32x2*)(Pt + fr * 72 + 32 + fq * 8);
    asm volatile("s_waitcnt lgkmcnt(0)" ::: "memory");
    const long P0 = mk64(p0.x, p0.y), P1 = mk64(p1.x, p1.y);
#pragma unroll
    for (int dt = 0; dt < 4; ++dt) { O[dt] = MFMA8(P0, mk64(Vw[dt].x, Vw[dt].y), O[dt]); O[dt] = MFMA8(P1, mk64(Vw[dt].z, Vw[dt].w), O[dt]); }
}
__device__ __forceinline__ void flash_compute(const bf16x8 (&Qf)[2], KVF& f, const bf16_t* knext, int ldk, const unsigned char* vp, unsigned vmask, float (&m)[4], float (&l)[4], f32x4 (&O)[4], unsigned char* Pt, int fr, int fq) {
    f32x4 S[4]; u32x4 Vw[4];
#pragma unroll
    for (int dt = 0; dt < 4; ++dt) Vw[dt] = *(const u32x4*)(vp + dt * 1024);
#pragma unroll
    for (int s = 0; s < 4; ++s) { S[s] = (f32x4){0.f, 0.f, 0.f, 0.f}; S[s] = MFMA16(Qf[0], f.k[s][0], S[s]); S[s] = MFMA16(Qf[1], f.k[s][1], S[s]); }
    if (knext) kv_load(knext, ldk, f);
    softmax_pv(S, Vw, vmask, m, l, O, Pt, fr, fq);
}
struct V8F { u32x4 v[4]; };
__device__ __forceinline__ void v8_load(const unsigned char* vp, V8F& f) {
#pragma unroll
    for (int dt = 0; dt < 4; ++dt) f.v[dt] = *(const u32x4*)(vp + dt * 1024);
}
__device__ __forceinline__ void flash_compute8(const long (&Q8)[2], const K8F& f, const V8F& vf, unsigned vmask, float (&m)[4], float (&l)[4], f32x4 (&O)[4], unsigned char* Pt, int fr, int fq) {
    f32x4 S[4];
#pragma unroll
    for (int s = 0; s < 4; ++s) { S[s] = (f32x4){0.f, 0.f, 0.f, 0.f}; S[s] = MFMA8(Q8[0], mk64(f.k[s].x, f.k[s].y), S[s]); S[s] = MFMA8(Q8[1], mk64(f.k[s].z, f.k[s].w), S[s]); }
    softmax_pv(S, vf.v, vmask, m, l, O, Pt, fr, fq);
}
template <int BR> struct BranchIt {
    const bf16_t* kb; const unsigned char* kb8; const unsigned char* vb; const unsigned* flg; int last, trow, fr, fq;
    static constexpr int LDK = 64;
    __device__ __forceinline__ int next(int from) const {
        if (BR == 1) { int jb = from; while (jb <= last && flg[jb] == 0u) ++jb; return jb <= last ? jb : -1; }
        return from <= last ? from : -1;
    }
    __device__ __forceinline__ const unsigned char* vptr(int idx) const { return vb + (size_t)idx * 4096; }
    __device__ __forceinline__ const bf16_t* kptr(int idx) const { return kb + (size_t)(idx * 64) * LDK; }
    __device__ __forceinline__ const unsigned char* kptr8(int idx) const { return kb8 + (size_t)idx * 4096; }
    __device__ __forceinline__ unsigned mask(int idx) const {
        unsigned vm = 0; const int key0 = idx * 64;
        if (BR == 0) {
#pragma unroll
            for (int s = 0; s < 4; ++s) vm |= ((16 * (key0 + s * 16 + fr) + 31 <= trow) ? 1u : 0u) << s;
        } else if (BR == 1) {
            const bool rowsel = (flg[idx] >> fq) & 1u;
#pragma unroll
            for (int s = 0; s < 4; ++s) vm |= ((rowsel && (key0 + s * 16 + fr <= trow)) ? 1u : 0u) << s;
        } else {
#pragma unroll
            for (int s = 0; s < 4; ++s) { const int kpos = key0 + s * 16 + fr; vm |= ((kpos <= trow && kpos > trow - 512) ? 1u : 0u) << s; }
        }
        return vm;
    }
};
template <int BR> __device__ __forceinline__ void run_branch(const BranchIt<BR>& it, int first, const bf16x8 (&Qf)[2], const long (&Q8)[2], float (&m)[4], float (&l)[4], f32x4 (&O)[4], unsigned char* Pt) {
#pragma unroll
    for (int j = 0; j < 4; ++j) { m[j] = -1e30f; l[j] = 0.f; O[j] = (f32x4){0.f, 0.f, 0.f, 0.f}; }
    int ia = it.next(first);
    if (ia < 0) return;
    if (BR == 0) {
        KVF A; kv_load(it.kptr(ia), BranchIt<BR>::LDK, A);
        while (ia >= 0) {
            const int ib = it.next(ia + 1);
            flash_compute(Qf, A, ib >= 0 ? it.kptr(ib) : nullptr, BranchIt<BR>::LDK, it.vptr(ia), it.mask(ia), m, l, O, Pt, it.fr, it.fq);
            ia = ib;
        }
    } else {
        K8F kA, kB; V8F vA, vB; k8_load(it.kptr8(ia), kA); v8_load(it.vptr(ia), vA);
        for (;;) {
            const int ib = it.next(ia + 1), ibc = ib >= 0 ? ib : ia;
            k8_load(it.kptr8(ibc), kB); v8_load(it.vptr(ibc), vB);
            flash_compute8(Q8, kA, vA, it.mask(ia), m, l, O, Pt, it.fr, it.fq);
            if (ib < 0) break;
            const int ic = it.next(ib + 1), icc = ic >= 0 ? ic : ib;
            k8_load(it.kptr8(icc), kA); v8_load(it.vptr(icc), vA);
            flash_compute8(Q8, kB, vB, it.mask(ib), m, l, O, Pt, it.fr, it.fq);
            if (ic < 0) break;
            ia = ic;
        }
    }
}
__device__ __forceinline__ void branch_finish(float (&l)[4], f32x4 (&O)[4], const float* grow, int br, int hk, float* ybp  ) {
#pragma unroll
    for (int j = 0; j < 4; ++j) { const float s = rsum16(l[j]);
        const float g = sigmoidf_(grow[(hk * 4 + j) * 3 + br]) * 0.00390625f / fmaxf(s, 1e-30f);
#pragma unroll
        for (int dt = 0; dt < 4; ++dt) { float* q = ybp + j * 64 + dt * 16; if (br == 0) *q = g * O[dt][j]; else *q += g * O[dt][j]; } }
}
constexpr int NSA_WLDS = 15680;
__device__ void nsa_wave_task(const Params& p, int layer, int t0, int hk, unsigned char* wl) {
    unsigned char* ws = p.ws;
    const int lane = tidx() & 63, fr = lane & 15, fq = lane >> 4;
    float* imp = (float*)wl; unsigned* flg = (unsigned*)(wl + 4160); unsigned char* Pt = wl + 5184; float* yb = (float*)(wl + 7488);
    const bf16_t* qn = (const bf16_t*)(ws + O_QN); const unsigned char* ks8 = ws + O_KSN; const unsigned char* kw8 = ws + O_KWN;
    const unsigned char* vsT = ws + O_VST; const unsigned char* vwT = ws + O_VWT; const bf16_t* kc = (const bf16_t*)(ws + O_KC); const unsigned char* vcT = ws + O_VCT;
    const int trow = t0 + fq;
    const float* grow = (const float*)(ws + O_P32) + (size_t)trow * 1536 + 1280;
    const int tmax = t0 + 3;
    {
        bf16x8 Qf[2];
        { const bf16_t* qp = qn + (size_t)(t0 + (fr >> 2)) * 512 + (hk * 4 + (fr & 3)) * 64 + fq * 8; Qf[0] = *(const bf16x8*)qp; Qf[1] = *(const bf16x8*)(qp + 32); }
        long Q8[2]; Q8[0] = bf8_to_fp8(Qf[0]); Q8[1] = bf8_to_fp8(Qf[1]);
        float* ybp = yb + fq * 256 + fr;
        float m[4], l[4]; f32x4 O[4];
        const int ncmp_t = tmax >= 31 ? ((((tmax - 31) >> 4) >> 6) + 1) : 0;
        const bf16_t* kcb = kc + ((size_t)hk * 1024 + fr) * 64 + fq * 8;
        { BranchIt<0> it{kcb, nullptr, vcT + (size_t)hk * 16 * 4096 + fr * 64 + fq * 16, nullptr, ncmp_t - 1, trow, fr, fq}; run_branch<0>(it, 0, Qf, Q8, m, l, O, Pt); }
        float linv[4];
#pragma unroll
        for (int j = 0; j < 4; ++j) { const float s = rsum16(l[j]); linv[j] = s > 0.f ? 1.0f / s : 0.f; }
        branch_finish(l, O, grow, 0, hk, ybp);
        for (int e = lane; e < 4 * 260; e += 64) imp[e] = 0.f;
        for (int e = lane; e < 256; e += 64) flg[e] = 0u;
        asm volatile("s_waitcnt lgkmcnt(0)" ::: "memory");
        {
            KVF ka;
            if (ncmp_t > 0) kv_load(kcb, 64, ka);
            for (int kt = 0; kt < ncmp_t; ++kt) {
                const int key0 = kt * 64;
                f32x4 S[4];
#pragma unroll
                for (int s = 0; s < 4; ++s) { S[s] = (f32x4){0.f, 0.f, 0.f, 0.f}; S[s] = MFMA16(Qf[0], ka.k[s][0], S[s]); S[s] = MFMA16(Qf[1], ka.k[s][1], S[s]); }
                if (kt + 1 < ncmp_t) kv_load(kcb + (size_t)(key0 + 64) * 64, 64, ka);
#pragma unroll
                for (int s = 0; s < 4; ++s) {
                    const int nn = key0 + s * 16 + fr; const bool valid = 16 * nn + 31 <= trow;
                    float ps = 0.f;
#pragma unroll
                    for (int j = 0; j < 4; ++j) ps += valid ? __builtin_amdgcn_exp2f(S[s][j] - m[j]) * linv[j] : 0.f;
                    float p4 = ps; p4 += dppf<0xB1>(p4); p4 += dppf<0x4E>(p4);
                    if ((fr & 3) == 0) imp[fq * 260 + (nn >> 2)] += p4;
                    asm volatile("s_waitcnt lgkmcnt(0)" ::: "memory");
                    if ((fr & 3) == 3) imp[fq * 260 + (nn >> 2) + 1] += ps;
                    asm volatile("s_waitcnt lgkmcnt(0)" ::: "memory");
                }
            }
        }
#ifdef OLD_TOPK
        for (int tok = 0; tok < 4; ++tok) {
            const int t = t0 + tok, cur = t >> 6, nsel = cur + 1 < 16 ? cur + 1 : 16;
            unsigned long long key[4];
#pragma unroll
            for (int i = 0; i < 4; ++i) { const int j = lane + 64 * i; unsigned long long k = 0ull;
                if (j <= cur) { const bool forced = (j == 0) || (j == cur) || (j == cur - 1); const unsigned vb = forced ? 0x7F800000u : __float_as_uint(imp[tok * 260 + j]); k = ((unsigned long long)vb << 32) | (unsigned)(0xFFFF - j); }
                key[i] = k; }
            for (int it2 = 0; it2 < nsel; ++it2) {
                unsigned long long best = key[0]; best = key[1] > best ? key[1] : best; best = key[2] > best ? key[2] : best; best = key[3] > best ? key[3] : best;
#pragma unroll
                for (int o = 32; o >= 1; o >>= 1) { const unsigned lo = __shfl_xor((unsigned)best, o), hi = __shfl_xor((unsigned)(best >> 32), o); const unsigned long long ob = ((unsigned long long)hi << 32) | lo; best = ob > best ? ob : best; }
                const int jsel = 0xFFFF - (int)(best & 0xFFFFu);
#pragma unroll
                for (int i = 0; i < 4; ++i) if (key[i] == best) key[i] = 0ull;
                if (lane == 0) flg[jsel] |= (1u << tok);
            }
        }
#else
        {
            unsigned long long key[4][4];
#pragma unroll
            for (int tok = 0; tok < 4; ++tok) { const int cur = (t0 + tok) >> 6;
#pragma unroll
                for (int i = 0; i < 4; ++i) { const int j = lane + 64 * i; unsigned long long k = 0ull;
                    if (j <= cur) { const bool forced = (j == 0) || (j == cur) || (j == cur - 1); const unsigned vb = forced ? 0x7F800000u : __float_as_uint(imp[tok * 260 + j]); k = ((unsigned long long)vb << 32) | (unsigned)(0xFFFF - j); }
                    key[tok][i] = k; } }
            for (int itn = 0; itn < 16; ++itn) {
                unsigned long long best[4];
#pragma unroll
                for (int tok = 0; tok < 4; ++tok) { unsigned long long b0 = key[tok][0]; b0 = key[tok][1] > b0 ? key[tok][1] : b0; b0 = key[tok][2] > b0 ? key[tok][2] : b0; b0 = key[tok][3] > b0 ? key[tok][3] : b0; best[tok] = b0; }
#pragma unroll
                for (int tok = 0; tok < 4; ++tok) { best[tok] = dppmax64<0xB1>(best[tok]); best[tok] = dppmax64<0x4E>(best[tok]); best[tok] = dppmax64<0x124>(best[tok]); best[tok] = dppmax64<0x128>(best[tok]); }
#pragma unroll
                for (int o = 16; o <= 32; o <<= 1) {
#pragma unroll
                    for (int tok = 0; tok < 4; ++tok) { const unsigned lo = __shfl_xor((unsigned)best[tok], o), hi = __shfl_xor((unsigned)(best[tok] >> 32), o); const unsigned long long ob = ((unsigned long long)hi << 32) | lo; best[tok] = ob > best[tok] ? ob : best[tok]; }
                }
#pragma unroll
                for (int tok = 0; tok < 4; ++tok) {
                    if (best[tok] != 0ull) {
#pragma unroll
                        for (int i = 0; i < 4; ++i) if (key[tok][i] == best[tok]) key[tok][i] = 0ull;
                        if (lane == 0) flg[0xFFFF - (int)(best[tok] & 0xFFFFu)] |= (1u << tok);
                    }
                }
            }
        }
#endif
        asm volatile("s_waitcnt lgkmcnt(0)" ::: "memory");
        { BranchIt<1> it{nullptr, ks8 + (size_t)hk * 256 * 4096 + fr * 64 + fq * 16, vsT + (size_t)hk * 256 * 4096 + fr * 64 + fq * 16, flg, tmax >> 6, trow, fr, fq}; run_branch<1>(it, 0, Qf, Q8, m, l, O, Pt); }
        branch_finish(l, O, grow, 1, hk, ybp);
        { BranchIt<2> it{nullptr, kw8 + (size_t)hk * 256 * 4096 + fr * 64 + fq * 16, vwT + (size_t)hk * 256 * 4096 + fr * 64 + fq * 16, nullptr, tmax >> 6, trow, fr, fq}; run_branch<2>(it, t0 - 511 > 0 ? ((t0 - 511) >> 6) : 0, Qf, Q8, m, l, O, Pt); }
        branch_finish(l, O, grow, 2, hk, ybp);
    }
    asm volatile("s_waitcnt lgkmcnt(0)" ::: "memory");
    float* ysc = (float*)(ws + O_P32);
#pragma unroll
    for (int tok = 0; tok < 4; ++tok) *(f32x4*)(ysc + (size_t)(t0 + tok) * 1536 + hk * 256 + lane * 4) = *(const f32x4*)(yb + tok * 256 + lane * 4);
    asm volatile("s_waitcnt lgkmcnt(0)" ::: "memory");
}

__device__ void phase_finalize(const Params& p, int layer) {
    unsigned char* ws = p.ws;
    const int wave = tidx() >> 6, lane = tidx() & 63;
    const float* yglu = (const float*)(ws + O_YGLU); const float* go = (const float*)(ws + O_PQKV); const bf16_t* Pz = (const bf16_t*)(ws + O_PZ); bf16_t* mix = (bf16_t*)(ws + O_HN);
    const float* gs = p.in[22] + (size_t)layer * 512 + lane * 8; const float* gg = p.in[26] + (size_t)layer * 128 + (lane & 7) * 16;
    const float* gnsa = p.in[12] + (size_t)layer * 512 + lane * 8; const float* ysc = (const float*)(ws + O_P32);
    for (int t = blockIdx.x * 8 + wave; t < T_; t += gridDim.x * 8) {
        {
            const f32x4 a = *(const f32x4*)(ysc + (size_t)t * 1536 + lane * 8), b = *(const f32x4*)(ysc + (size_t)t * 1536 + lane * 8 + 4);
            float ss = a[0] * a[0] + a[1] * a[1] + a[2] * a[2] + a[3] * a[3] + b[0] * b[0] + b[1] * b[1] + b[2] * b[2] + b[3] * b[3];
            ss = wave_sum(ss); const float rs = rsqrtf(ss * (1.0f / 512.0f) + 1e-6f);
            const f32x4 g0 = *(const f32x4*)gnsa, g1 = *(const f32x4*)(gnsa + 4);
            u32x4 w; w.x = pk2(a[0] * rs * g0[0], a[1] * rs * g0[1]); w.y = pk2(a[2] * rs * g0[2], a[3] * rs * g0[3]); w.z = pk2(b[0] * rs * g1[0], b[1] * rs * g1[1]); w.w = pk2(b[2] * rs * g1[2], b[3] * rs * g1[3]);
            *(u32x4*)(mix + (size_t)t * DM + lane * 8) = w;
        }
        {
            const f32x4 a = *(const f32x4*)(yglu + (size_t)t * 512 + lane * 8), b = *(const f32x4*)(yglu + (size_t)t * 512 + lane * 8 + 4);
            float ss = a[0] * a[0] + a[1] * a[1] + a[2] * a[2] + a[3] * a[3] + b[0] * b[0] + b[1] * b[1] + b[2] * b[2] + b[3] * b[3];
            ss = wave_sum(ss); const float rs = rsqrtf(ss * (1.0f / 512.0f) + 1e-6f);
            const f32x4 g0 = *(const f32x4*)gs, g1 = *(const f32x4*)(gs + 4);
            u32x4 w; w.x = pk2(a[0] * rs * g0[0], a[1] * rs * g0[1]); w.y = pk2(a[2] * rs * g0[2], a[3] * rs * g0[3]); w.z = pk2(b[0] * rs * g1[0], b[1] * rs * g1[1]); w.w = pk2(b[2] * rs * g1[2], b[3] * rs * g1[3]);
            *(u32x4*)(mix + (size_t)t * DM + 512 + lane * 8) = w;
        }
        {
            f32x4 o[4]; float ss = 0.f;
#pragma unroll
            for (int q = 0; q < 4; ++q) { o[q] = *(const f32x4*)(go + (size_t)t * 1024 + lane * 16 + q * 4); ss += o[q][0] * o[q][0] + o[q][1] * o[q][1] + o[q][2] * o[q][2] + o[q][3] * o[q][3]; }
            ss += __shfl_xor(ss, 1); ss += __shfl_xor(ss, 2); ss += __shfl_xor(ss, 4);
            const float rs = rsqrtf(ss * (1.0f / 128.0f) + 1e-6f);
            const u32x4 z0 = *(const u32x4*)(Pz + (size_t)t * 1024 + lane * 16), z1 = *(const u32x4*)(Pz + (size_t)t * 1024 + lane * 16 + 8);
            float zz[16] = {bflo(z0.x), bfhi(z0.x), bflo(z0.y), bfhi(z0.y), bflo(z0.z), bfhi(z0.z), bflo(z0.w), bfhi(z0.w), bflo(z1.x), bfhi(z1.x), bflo(z1.y), bfhi(z1.y), bflo(z1.z), bfhi(z1.z), bflo(z1.w), bfhi(z1.w)};
            float r[16];
#pragma unroll
            for (int q = 0; q < 4; ++q) { const f32x4 g = *(const f32x4*)(gg + q * 4);
#pragma unroll
                for (int e = 0; e < 4; ++e) r[q * 4 + e] = o[q][e] * rs * g[e] * siluf_(zz[q * 4 + e]); }
            u32x4 w0, w1; w0.x = pk2(r[0], r[1]); w0.y = pk2(r[2], r[3]); w0.z = pk2(r[4], r[5]); w0.w = pk2(r[6], r[7]); w1.x = pk2(r[8], r[9]); w1.y = pk2(r[10], r[11]); w1.z = pk2(r[12], r[13]); w1.w = pk2(r[14], r[15]);
            *(u32x4*)(mix + (size_t)t * DM + 1024 + lane * 16) = w0; *(u32x4*)(mix + (size_t)t * DM + 1024 + lane * 16 + 8) = w1;
        }
    }
}

__device__ void phase_ffn_act(const Params& p, int layer) {
    unsigned char* ws = p.ws;
    const bf16_t* hf = (const bf16_t*)(ws + O_HF); bf16_t* act = (bf16_t*)(ws + O_ACT);
    const float* cw = p.in[30] + (size_t)layer * 3 * NFF; const float* cb = p.in[31] + (size_t)layer * NFF;
    const int nitems = 512 * 688;
    for (int it = blockIdx.x * 512 + tidx(); it < nitems; it += gridDim.x * 512) {
        const int seg = it / 688, cg8 = it - seg * 688, c = cg8 * 8, t0 = seg * 32;
        float w[2][3][8], bb[2][8];
#pragma unroll
        for (int hh = 0; hh < 2; ++hh) {
#pragma unroll
            for (int j = 0; j < 3; ++j) { const f32x4 a = *(const f32x4*)(cw + j * NFF + hh * DFF + c), b = *(const f32x4*)(cw + j * NFF + hh * DFF + c + 4);
                w[hh][j][0] = a[0]; w[hh][j][1] = a[1]; w[hh][j][2] = a[2]; w[hh][j][3] = a[3]; w[hh][j][4] = b[0]; w[hh][j][5] = b[1]; w[hh][j][6] = b[2]; w[hh][j][7] = b[3]; }
            const f32x4 a = *(const f32x4*)(cb + hh * DFF + c), b = *(const f32x4*)(cb + hh * DFF + c + 4);
            bb[hh][0] = a[0]; bb[hh][1] = a[1]; bb[hh][2] = a[2]; bb[hh][3] = a[3]; bb[hh][4] = b[0]; bb[hh][5] = b[1]; bb[hh][6] = b[2]; bb[hh][7] = b[3];
        }
        u32x4 r0[2], r1[2];
#pragma unroll
        for (int hh = 0; hh < 2; ++hh) {
            r0[hh] = (t0 >= 2) ? *(const u32x4*)(hf + (size_t)(t0 - 2) * NFF + hh * DFF + c) : (u32x4){0u, 0u, 0u, 0u};
            r1[hh] = (t0 >= 1) ? *(const u32x4*)(hf + (size_t)(t0 - 1) * NFF + hh * DFF + c) : (u32x4){0u, 0u, 0u, 0u};
        }
#pragma unroll 4
        for (int tt = 0; tt < 32; ++tt) {
            const int t = t0 + tt;
            u32x4 r2[2]; float v[2][8];
#pragma unroll
            for (int hh = 0; hh < 2; ++hh) {
                r2[hh] = *(const u32x4*)(hf + (size_t)t * NFF + hh * DFF + c);
                const unsigned a0[4] = {r0[hh].x, r0[hh].y, r0[hh].z, r0[hh].w}, a1[4] = {r1[hh].x, r1[hh].y, r1[hh].z, r1[hh].w}, a2[4] = {r2[hh].x, r2[hh].y, r2[hh].z, r2[hh].w};
#pragma unroll
                for (int e = 0; e < 4; ++e) {
                    v[hh][2 * e]     = bb[hh][2 * e]     + w[hh][0][2 * e]     * bflo(a0[e]) + w[hh][1][2 * e]     * bflo(a1[e]) + w[hh][2][2 * e]     * bflo(a2[e]);
                    v[hh][2 * e + 1] = bb[hh][2 * e + 1] + w[hh][0][2 * e + 1] * bfhi(a0[e]) + w[hh][1][2 * e + 1] * bfhi(a1[e]) + w[hh][2][2 * e + 1] * bfhi(a2[e]);
                }
                r0[hh] = r1[hh]; r1[hh] = r2[hh];
            }
            u32x4 o; o.x = pk2(siluf_(v[0][0]) * v[1][0], siluf_(v[0][1]) * v[1][1]); o.y = pk2(siluf_(v[0][2]) * v[1][2], siluf_(v[0][3]) * v[1][3]);
            o.z = pk2(siluf_(v[0][4]) * v[1][4], siluf_(v[0][5]) * v[1][5]); o.w = pk2(siluf_(v[0][6]) * v[1][6], siluf_(v[0][7]) * v[1][7]);
            *(u32x4*)(act + (size_t)t * DFF + c) = o;
        }
    }
}
#ifdef REPEAT_PHASE
constexpr int NPHT = NPH + 1;
#else
constexpr int NPHT = NPH;
#endif
#ifndef MULTI_LAUNCH
#define MULTI_LAUNCH 0
#endif
__global__ void __launch_bounds__(512) mega(Params p) {
    extern __shared__ __attribute__((aligned(16))) unsigned char smem[];
    cg::grid_group grid = cg::this_grid();
    const int b = blockIdx.x, G = gridDim.x;
    PG8_LAS unsigned char* glds = (PG8_LAS unsigned char*)smem;
    volatile XB_LAS unsigned* xst = (volatile XB_LAS unsigned*)(smem + LDS_BYTES - 32);
    if (threadIdx.x == 0) { xst[0] = 0u; xst[1] = 0u; }
    __syncthreads();
    XcdBarrier xbar; xbar.bar = (unsigned*)(p.ws + O_BAR); xbar.x = 0; xbar.st = xst;
    for (int ph = p.ph_lo; ph < p.ph_hi; ++ph) {

        #ifdef REPEAT_PHASE
        const int layer = ph / (NPH + 1), ki = ph % (NPH + 1), rep = (ki == REPEAT_PHASE + 1) ? 1 : 0; int k = ki <= REPEAT_PHASE ? ki : ki - 1;
#else
        const int layer = ph / NPH, rep = 0; int k = ph % NPH;
#endif
#ifdef DBG_ONLY
        if (k != DBG_ONLY) k = 99;
#endif
        typedef unsigned char __attribute__((address_space(1))) gu8_t;
        gu8_t* wsg = (gu8_t*)p.ws; asm volatile("" : "+s"(wsg));
        unsigned char* ws = (unsigned char*)wsg;
        int tid = threadIdx.x; asm volatile("" : "+v"(tid));
        const int wave = tid >> 6;
        bf16_t* hn = (bf16_t*)(ws + O_HN);
        Params q = p; q.ws = ws;
        if (k == 0) {
            if (ph == 0 && rep == 0 && b == 0) { if (tid < 64) ((unsigned*)(ws + O_CTR))[tid * 16] = 0u; for (int i = tid; i < XCD_BAR_WORDS; i += 512) ((unsigned*)(ws + O_BAR))[i] = 0u; }
            phase_convert(q, layer, (float*)smem);
            phase_rmsnorm(layer == 0 ? p.in[0] : p.out, p.in[1] + (size_t)layer * DM, hn, layer == 0 ? p.out : nullptr);
        } else if (k == 1) {
            pg8::Gemm g{hn, (const bf16_t*)(ws + O_WIN), T_, NIN, DM}; pg8::StaticOrder S; S.init(T_, NIN, G, b);
            EpiProj E{(float*)(ws + O_P32), (bf16_t*)(ws + O_PU), (bf16_t*)(ws + O_PQKV), (bf16_t*)(ws + O_PZ)};
            pg8::gemm_phase<EpiProj, pg8::StaticOrder, false>(glds, g, S, E, nullptr);
        } else if (k == 2) {
            for (int it = b; it < 3072; it += G) {
                if (it < 2048) gdn_prep_item(q, layer, it, smem);
                else if (it < 2304) nsa_prep_item(q, layer, it - 2048, (float*)smem);
                else if (it < 2560) s5_passA_wave(q, layer, (it - 2304) * 8 + wave, (float*)(smem + wave * 4096));
                else cmp1_wave_tile(q, layer, (it - 2560) * 8 + wave);
            }
        } else if (k == 3) {
            for (int idx = b * 8 + wave; idx < 4096; idx += G * 8) cmp2_wave_row(q, layer, idx);
            for (int it = b * 8 + wave; it < 2048; it += G * 8) s5_passB_wave(q, layer, it, (bf16_t*)(smem + wave * 8448), (float*)(smem + wave * 8448 + 4352));
        } else if (k == 4) {
#ifdef REP4_MODE
            const bool do_rec = (rep == 0) || (REP4_MODE == 1), do_glu = (rep == 0), do_nsa = (rep == 0) || (REP4_MODE == 2);
#else
            const bool do_rec = true, do_glu = true, do_nsa = true;
#endif
            if (b < 32) {
#ifndef NO_REC
 if (do_rec) gdn_recurrence(q, b, smem);
#endif
 }
            else if (b < 160 && do_glu) {
#ifndef NO_GLU
                pg8::Gemm g{(const bf16_t*)(ws + O_YGELU), (const bf16_t*)(ws + O_WGLU), T_, 512, 512}; pg8::StaticOrder S; S.init(T_, 512, 128, b - 32);
                EpiGlu E{(const bf16_t*)(ws + O_YGELU), (float*)(ws + O_YGLU)};
                pg8::gemm_phase<EpiGlu, pg8::StaticOrder, false>(glds, g, S, E, nullptr);
#endif
            }
            __syncthreads();
            unsigned* ctr = (unsigned*)(ws + O_CTR) + (layer * 2 + rep) * 16;
            volatile int* sidx = (volatile int*)(smem + LDS_BYTES - 16);
#ifndef NO_NSA
            if (do_nsa) for (;;) {
                if (tid == 0) *sidx = (int)atomicAdd(ctr, 1u);
                __syncthreads();
                const int idx = *sidx;
                __syncthreads();
                if (idx >= 1024) break;
                nsa_wave_task(q, layer, (511 - (idx & 511)) * 32 + wave * 4, idx >> 9, smem + wave * NSA_WLDS);
            }
#endif
        } else if (k == 5) {
            phase_finalize(q, layer);
        } else if (k == 6) {
            pg8::Gemm g{hn, (const bf16_t*)(ws + O_WOUT), T_, DM, DM}; pg8::StaticOrder S; S.init(T_, DM, G, b);
            EpiResid E{p.out, DM};
            pg8::gemm_phase<EpiResid, pg8::StaticOrder, false>(glds, g, S, E, nullptr);
        } else if (k == 7) {
            phase_rmsnorm(p.out, p.in[28] + (size_t)layer * DM, hn, nullptr);
        } else if (k == 8) {
            pg8::Gemm g{hn, (const bf16_t*)(ws + O_WFIN), T_, NFF, DM}; pg8::StaticOrder S; S.init(T_, NFF, G, b);
            EpiBf E{(bf16_t*)(ws + O_HF), NFF};
            pg8::gemm_phase<EpiBf, pg8::StaticOrder, false>(glds, g, S, E, nullptr);
        } else if (k == 9) {
            phase_ffn_act(q, layer);
        } else if (k == 10) {
            pg8::Gemm g{(const bf16_t*)(ws + O_ACT), (const bf16_t*)(ws + O_WFOUT), T_, DM, DFF}; pg8::StaticOrder S; S.init(T_, DM, G, b);
            EpiResid E{p.out, DM};
            pg8::gemm_phase<EpiResid, pg8::StaticOrder, false>(glds, g, S, E, nullptr);
        }
        __syncthreads();
        if (ph + 1 < p.ph_hi) {
            if (ph == p.ph_lo) { grid.sync(); xbar = xcd_barrier_post((unsigned*)(p.ws + O_BAR), xst); }
            else xcd_barrier(xbar);
        }
    }
}

extern "C" void kernel_launch(void* const* d_in, const int* in_sizes, int n_in, void* d_out, int out_size, void* d_ws, size_t ws_size, hipStream_t stream) {
    static int grid_blocks = 0;
    if (!grid_blocks) {
        if (n_in != 33 || out_size != T_ * DM || ws_size < WS_NEED) { fprintf(stderr, "kernel_launch: unexpected shapes or workspace (%d inputs, out %d, ws %zu < %zu)\n", n_in, out_size, ws_size, (size_t)WS_NEED); grid_blocks = -1; return; }
        int dev = 0, cus = 0, per_cu = 0;
        hipGetDevice(&dev);
        hipDeviceGetAttribute(&cus, hipDeviceAttributeMultiprocessorCount, dev);
        if (hipFuncSetAttribute((const void*)mega, hipFuncAttributeMaxDynamicSharedMemorySize, LDS_BYTES) != hipSuccess) { fprintf(stderr, "kernel_launch: hipFuncSetAttribute failed\n"); grid_blocks = -1; return; }
        hipOccupancyMaxActiveBlocksPerMultiprocessor(&per_cu, (const void*)mega, 512, LDS_BYTES);
        (void)hipGetLastError();
        if (per_cu < 1) per_cu = 1;
        grid_blocks = cus * per_cu; if (grid_blocks > 256) grid_blocks = 256;
        if (grid_blocks < 160) { fprintf(stderr, "kernel_launch: grid %d too small\n", grid_blocks); grid_blocks = -1; return; }
    }
    if (grid_blocks < 0) return;
    Params p{};
    for (int i = 0; i < 33; ++i) p.in[i] = (const float*)d_in[i];
    p.out = (float*)d_out; p.ws = (unsigned char*)d_ws;
#if MULTI_LAUNCH
    for (int ph = 0; ph < 2 * NPHT; ++ph) { p.ph_lo = ph; p.ph_hi = ph + 1; hipLaunchKernelGGL(mega, dim3(grid_blocks), dim3(512), LDS_BYTES, stream, p); }
#else
    p.ph_lo = 0; p.ph_hi = 2 * NPHT;
    void* args[] = {&p};
    hipError_t e = hipLaunchCooperativeKernel((const void*)mega, dim3(grid_blocks), dim3(512), args, LDS_BYTES, stream);
    if (e != hipSuccess) fprintf(stderr, "cooperative launch failed: %s (grid %d)\n", hipGetErrorString(e), grid_blocks);
#endif
}
```

```cpp
#include <hip/hip_runtime.h>
#include <hip/hip_cooperative_groups.h>
#include <cstdio>
namespace cg = cooperative_groups;
__device__ __forceinline__ int tidx() { int t = threadIdx.x; asm volatile("" : "+v"(t)); return t; }
namespace pg8 {
#define PG8_LAS __attribute__((address_space(3)))
typedef unsigned short bf16_t;
typedef short bf16x8 __attribute__((ext_vector_type(8)));
typedef float f32x4 __attribute__((ext_vector_type(4)));
typedef unsigned u32x4 __attribute__((ext_vector_type(4)));
constexpr int BM = 256, BK = 64, HALF = 128, HTB = HALF * BK * 2  , STAGE_BYTES = 8 * HTB, NXCD = 8, WGM = 8;

__host__ __device__ __forceinline__ int lds_byte(int r, int c) { const int st = (r >> 4) * 2 + (c >> 5), rr = r & 15, cc = c & 31, ob = rr * 64 + cc * 2; return st * 1024 + (ob ^ (((ob >> 9) & 1) << 5)); }
__host__ __device__ __forceinline__ void stage_rc(int b, int& R, int& C) { const int st = b / 1024, sb = b % 1024, swz = sb ^ (((sb >> 9) & 1) << 5); R = (st >> 1) * 16 + swz / 64; C = (st & 1) * 32 + (swz % 64) / 2; }
__host__ __device__ __forceinline__ int perm32(int rho) { const int n = rho >> 4, i = rho & 15; return 8 * (i >> 2) + 4 * n + (i & 3); }

struct Unit { int pm, pn; };
struct Gemm { const bf16_t* A; const bf16_t* Bt; int M, N, K; };

struct StaticOrder {
    int nM, nN, nwg, G, c;
    __host__ __device__ void init(int M, int N, int G_, int c_) { nM = M / BM; nN = N / BM; nwg = nM * nN; G = G_; c = c_; }
    __host__ __device__ bool next(int i, Unit& u) const {
        const long L = (long)i * G + c; if (L >= nwg) return false;
        int wgid = (int)L; { const int q = nwg / NXCD, r = nwg % NXCD, xcd = wgid % NXCD, off = wgid / NXCD; wgid = (xcd < r ? xcd * (q + 1) : r * (q + 1) + (xcd - r) * q) + off; }
        const int nig = WGM * nN, gid = wgid / nig, fm = gid * WGM, gsz = (nM - fm) < WGM ? (nM - fm) : WGM;
        u.pm = fm + ((wgid % nig) % gsz); u.pn = (wgid % nig) / gsz; return true;
    }
    __device__ __forceinline__ void a_ready(const Unit&) const {}
    __device__ __forceinline__ void done(const Unit&) const {}
};
__device__ __forceinline__ unsigned cvt_pk_bf16(float lo, float hi) { unsigned r; asm volatile("v_cvt_pk_bf16_f32 %0, %1, %2" : "=v"(r) : "v"(lo), "v"(hi)); return r; }
template <class Epi, class Sched, bool STAMP = false>
__device__ __forceinline__ void gemm_phase(PG8_LAS unsigned char* lds, const Gemm g, const Sched& S, const Epi& E, unsigned long long* stamps) {
    const int tid = tidx(), wid = __builtin_amdgcn_readfirstlane(tid >> 6), lane = tid & 63, wr = wid >> 2, wc = wid & 3, fr = lane & 15, fq = lane >> 4;
    const int K = g.K, nt = K / BK;
    int ts_lo = 0, ts_hi = 0, nts = 0; const unsigned long long rt_entry = STAMP ? (unsigned long long)wall_clock64() : 0ull;
#define PG8_STAMP() do { if (STAMP && wid == 0 && nts < 64) { const unsigned long long _c = (unsigned long long)clock64(); \
        ts_lo = (lane == nts) ? (int)(unsigned)_c : ts_lo; ts_hi = (lane == nts) ? (int)(unsigned)(_c >> 32) : ts_hi; ++nts; } } while (0)
    PG8_STAMP();
    unsigned voffA[2], voffB[2];
#pragma unroll
    for (int i = 0; i < 2; ++i) { int R, C; stage_rc(tid * 16 + i * 8192, R, C); const int Rb = Epi::PERM ? ((R & ~31) + perm32(R & 31)) : R;
        voffA[i] = (unsigned)(R * K + C) * 2u; voffB[i] = (unsigned)(Rb * K + C) * 2u; }
    const size_t kstep = (size_t)(BK * 2);
    const size_t hstep = (size_t)HALF * K * 2;
    const size_t tstep = 2 * hstep;
    const unsigned ldsw = (unsigned)wid * 1024u;
    const int aoff = lds_byte(wr * 64 + fr, fq * 8), boff = lds_byte(wc * 32 + fr, fq * 8);
#define PG8_SA(b, h) (((b) * 2 + (h)) * HTB)
#define PG8_SB(b, h) ((4 + (b) * 2 + (h)) * HTB)
#define PG8_STAGE(bufoff, gbase, voff) do { _Pragma("unroll") for (int _i = 0; _i < 2; ++_i) \
        __builtin_amdgcn_global_load_lds((const unsigned*)((const char*)(gbase) + (voff)[_i]), (PG8_LAS unsigned*)(lds + (bufoff) + ldsw + _i * 8192), 16, 0, 0); } while (0)
#define PG8_LDA(dst, b, h) do { _Pragma("unroll") for (int m = 0; m < 4; ++m) _Pragma("unroll") for (int k = 0; k < 2; ++k) dst[m][k] = *(const PG8_LAS bf16x8*)(lds + PG8_SA(b, h) + aoff + m * 2048 + k * 1024); } while (0)
#define PG8_LDB(dst, b, h) do { _Pragma("unroll") for (int n = 0; n < 2; ++n) _Pragma("unroll") for (int k = 0; k < 2; ++k) dst[n][k] = *(const PG8_LAS bf16x8*)(lds + PG8_SB(b, h) + boff + n * 2048 + k * 1024); } while (0)
#define PG8_MMA(ai, bj, At, Bt) do { __builtin_amdgcn_s_setprio(1); _Pragma("unroll") for (int m = 0; m < 4; ++m) _Pragma("unroll") for (int n = 0; n < 2; ++n) _Pragma("unroll") for (int k = 0; k < 2; ++k) \
        acc[ai][bj][m][n] = __builtin_amdgcn_mfma_f32_16x16x32_bf16(Bt[n][k], At[m][k], acc[ai][bj][m][n], 0, 0, 0); __builtin_amdgcn_s_setprio(0); } while (0)
#define PG8_WAIT_V(n) asm volatile("s_waitcnt vmcnt(" #n ")" ::: "memory")
#define PG8_WAIT_L(n) asm volatile("s_waitcnt lgkmcnt(" #n ")" ::: "memory")
#define PG8_BAR __builtin_amdgcn_s_barrier()
#define PG8_SCHED __builtin_amdgcn_sched_barrier(0)
    Unit cur, nxt; int ui = 0;
    if (!S.next(0, cur)) return;
    f32x4 acc[2][2][4][2];
#pragma unroll
    for (int a = 0; a < 2; ++a)
#pragma unroll
        for (int b = 0; b < 2; ++b)
#pragma unroll
            for (int m = 0; m < 4; ++m)
#pragma unroll
                for (int n = 0; n < 2; ++n) acc[a][b][m][n] = (f32x4){0.f, 0.f, 0.f, 0.f};
    bf16x8 At[4][2], B0[2][2], B1[2][2];
    const char* cA = (const char*)g.A + (size_t)cur.pm * tstep; const char* cB = (const char*)g.Bt + (size_t)cur.pn * tstep;
    S.a_ready(cur);
    PG8_STAGE(PG8_SB(0, 0), cB, voffB); PG8_STAGE(PG8_SA(0, 0), cA, voffA); PG8_STAGE(PG8_SB(0, 1), cB + hstep, voffB); PG8_STAGE(PG8_SA(0, 1), cA + hstep, voffA);
    if (wr == 1) PG8_BAR;
    PG8_WAIT_V(4); PG8_BAR;
    PG8_STAGE(PG8_SB(1, 0), cB + kstep, voffB); PG8_STAGE(PG8_SA(1, 0), cA + kstep, voffA); PG8_STAGE(PG8_SB(1, 1), cB + hstep + kstep, voffB);
    PG8_WAIT_V(6); PG8_BAR;
    PG8_STAMP();
    for (;;) {
        const bool has_next = S.next(ui + 1, nxt);
        const char* nA = has_next ? (const char*)g.A + (size_t)nxt.pm * tstep : cA; const char* nB = has_next ? (const char*)g.Bt + (size_t)nxt.pn * tstep : cB;
        for (int t = 0; t < nt; t += 2) {
            const bool last = (t == nt - 2);
            const char* a1 = cA + (size_t)(t + 1) * kstep;
            const char* a2 = last ? nA : cA + (size_t)(t + 2) * kstep; const char* b2 = last ? nB : cB + (size_t)(t + 2) * kstep;
            const char* a3 = a2 + kstep; const char* b3 = b2 + kstep;
            if (last && has_next) S.a_ready(nxt);
            PG8_LDB(B0, 0, 0); PG8_SCHED; PG8_LDA(At, 0, 0); PG8_STAGE(PG8_SA(1, 1), a1 + hstep, voffA);
            PG8_WAIT_L(8); PG8_BAR; PG8_WAIT_L(0); PG8_MMA(0, 0, At, B0); PG8_BAR; PG8_SCHED;
            PG8_LDB(B1, 0, 1); PG8_STAGE(PG8_SB(0, 0), b2, voffB);
            PG8_BAR; PG8_WAIT_L(0); PG8_MMA(0, 1, At, B1); PG8_BAR;
            PG8_LDA(At, 0, 1); PG8_STAGE(PG8_SA(0, 0), a2, voffA);
            PG8_BAR; PG8_WAIT_L(0); PG8_MMA(1, 0, At, B0); PG8_BAR; PG8_SCHED;
            PG8_STAGE(PG8_SB(0, 1), b2 + hstep, voffB);
            PG8_WAIT_V(6); PG8_BAR; PG8_MMA(1, 1, At, B1); PG8_BAR;
            PG8_LDB(B0, 1, 0); PG8_SCHED; PG8_LDA(At, 1, 0); PG8_STAGE(PG8_SA(0, 1), a2 + hstep, voffA);
            PG8_WAIT_L(8); PG8_BAR; PG8_WAIT_L(0); PG8_MMA(0, 0, At, B0); PG8_BAR; PG8_SCHED;
            PG8_LDB(B1, 1, 1); PG8_STAGE(PG8_SB(1, 0), b3, voffB);
            PG8_BAR; PG8_WAIT_L(0); PG8_MMA(0, 1, At, B1); PG8_BAR;
            PG8_LDA(At, 1, 1); PG8_STAGE(PG8_SA(1, 0), a3, voffA);
            PG8_BAR; PG8_WAIT_L(0); PG8_MMA(1, 0, At, B0); PG8_BAR; PG8_SCHED;
            PG8_STAGE(PG8_SB(1, 1), b3 + hstep, voffB);
            PG8_WAIT_V(6); PG8_BAR; PG8_MMA(1, 1, At, B1); PG8_BAR;
        }
        PG8_STAMP();
        if constexpr (!Epi::AFTER_DRAIN) { E(acc, cur, wr, wc, fr, fq); S.done(cur); }
        PG8_STAMP();
        if (!has_next) break;
#pragma unroll
        for (int a = 0; a < 2; ++a)
#pragma unroll
            for (int b = 0; b < 2; ++b)
#pragma unroll
                for (int m = 0; m < 4; ++m)
#pragma unroll
                    for (int n = 0; n < 2; ++n) acc[a][b][m][n] = (f32x4){0.f, 0.f, 0.f, 0.f};
        cur = nxt; cA = nA; cB = nB; ++ui;
    }
    PG8_WAIT_V(0);
    if (wr == 0) PG8_BAR;
    PG8_BAR;
    if constexpr (Epi::AFTER_DRAIN) { E.fused(acc, cur, wr, wc, fr, fq, lds, wid, lane); S.done(cur); }
    PG8_STAMP();
    if (STAMP && wid == 0) { stamps[lane] = lane < nts ? (((unsigned long long)(unsigned)ts_hi << 32) | (unsigned)ts_lo) : 0ull;
        if (lane == 62) stamps[62] = rt_entry; if (lane == 63) stamps[63] = (unsigned long long)wall_clock64(); }
#undef PG8_STAMP
#undef PG8_SA
#undef PG8_SB
#undef PG8_STAGE
#undef PG8_LDA
#undef PG8_LDB
#undef PG8_MMA
#undef PG8_WAIT_V
#undef PG8_WAIT_L
#undef PG8_BAR
#undef PG8_SCHED
}
}
#define XB_TMO      128
#define XB_XCNT(j)  (256  + 64 * (j))
#define XB_XSUB(j)  (1280 + 64 * (j))
#define XB_XGEN(j)  (2304 + 64 * (j))
#define XB_TOP      3328
#define XB_TOPGEN   3392
#define XCD_BAR_WORDS 3456
#define XB_SPIN_CAP (1u << 18)
#define XB_LAS __attribute__((address_space(3)))

__device__ __forceinline__ unsigned xb_ld(unsigned* p)              { return __hip_atomic_load(p, __ATOMIC_RELAXED, __HIP_MEMORY_SCOPE_AGENT); }
__device__ __forceinline__ unsigned xb_add(unsigned* p, unsigned v) { return __hip_atomic_fetch_add(p, v, __ATOMIC_RELAXED, __HIP_MEMORY_SCOPE_AGENT); }
__device__ __forceinline__ unsigned xb_xcc_id() { return (unsigned)__builtin_amdgcn_s_getreg((3 << 11) | 20) & 0xFu; }
#define XB_SPIN(cond, bar) do { unsigned _sp = 0; while (cond) { __builtin_amdgcn_s_sleep(1); \
    if ((++_sp & 255u) == 0u) { if (xb_ld(&(bar)[XB_TMO])) break; if (_sp > XB_SPIN_CAP) { atomicAdd(&(bar)[XB_TMO], 1u); break; } } } } while (0)

struct XcdBarrier {
    unsigned* bar; unsigned x;
    volatile XB_LAS unsigned* st;
};

__device__ __forceinline__ XcdBarrier xcd_barrier_post(unsigned* bar, volatile XB_LAS unsigned* st) {
    XcdBarrier b; b.bar = bar; b.x = xb_xcc_id(); b.st = st;
    if (threadIdx.x == 0) (void)xb_add(&bar[XB_XCNT(b.x)], 1u);
    return b;
}
__device__ __forceinline__ void xcd_barrier_complete(unsigned* bar, unsigned x, unsigned& nloc, unsigned& nx) {
    const unsigned G = gridDim.x * gridDim.y * gridDim.z;
    unsigned sum, cnt, mine, sp = 0u;
    for (;;) {
        sum = 0u; cnt = 0u; mine = 0u;
#pragma unroll
        for (unsigned j = 0; j < 16; ++j) { const unsigned c = xb_ld(&bar[XB_XCNT(j)]); sum += c; cnt += (c > 0u) ? 1u : 0u; mine = (j == x) ? c : mine; }
        if (sum == G) break;
        __builtin_amdgcn_s_sleep(1);
        if ((++sp & 255u) == 0u) { if (xb_ld(&bar[XB_TMO])) break; if (sp > XB_SPIN_CAP) { atomicAdd(&bar[XB_TMO], 1u); break; } }
    }
    nloc = mine > 0u ? mine : 1u; nx = cnt > 0u ? cnt : 1u;
}

__device__ __forceinline__ void xcd_barrier(const XcdBarrier& b) {
    asm volatile("s_waitcnt vmcnt(0)" ::: "memory");
    __syncthreads();
    if (threadIdx.x == 0) {
        unsigned* bar = b.bar;
        __builtin_amdgcn_s_waitcnt(0);
        unsigned nloc = b.st[0], nx = b.st[1];
        if (nloc == 0u) { xcd_barrier_complete(bar, b.x, nloc, nx); b.st[0] = nloc; b.st[1] = nx; }
        const unsigned old = xb_add(&bar[XB_XSUB(b.x)], 1u);
        const unsigned gen = old / nloc;
        if (old + 1u == (gen + 1u) * nloc) {
            __builtin_amdgcn_fence(__ATOMIC_RELEASE, "agent");
            asm volatile("s_waitcnt vmcnt(0)" ::: "memory");
            const unsigned og = xb_add(&bar[XB_TOP], 1u);
            const unsigned tg = og / nx;
            if (og + 1u == (tg + 1u) * nx) xb_add(&bar[XB_TOPGEN], 1u);
            else XB_SPIN(xb_ld(&bar[XB_TOPGEN]) == tg, bar);
            __builtin_amdgcn_fence(__ATOMIC_ACQUIRE, "agent");
            xb_add(&bar[XB_XGEN(b.x)], 1u);
            asm volatile("s_waitcnt vmcnt(0)" ::: "memory");
        } else {
            XB_SPIN(xb_ld(&bar[XB_XGEN(b.x)]) == gen, bar);
            __builtin_amdgcn_fence(__ATOMIC_ACQUIRE, "agent");
            asm volatile("s_waitcnt vmcnt(0)" ::: "memory");
        }
    }
    __syncthreads();
}
using pg8::bf16_t; using pg8::bf16x8; using pg8::f32x4; using pg8::u32x4; using pg8::Unit;
typedef unsigned u32x2 __attribute__((ext_vector_type(2)));
#define MFMA16(a, b, c) __builtin_amdgcn_mfma_f32_16x16x32_bf16((a), (b), (c), 0, 0, 0)

constexpr int T_ = 16384, DM = 2048, NIN = 6144, DFF = 5504, NFF = 11008;
constexpr int LDS_BYTES = 144 * 1024;
constexpr int NPH = 11;

constexpr size_t O_CTR   = 0;
constexpr size_t O_BAR   = 4096;
constexpr size_t O_WIN   = 4096 + 16384;
constexpr size_t O_WOUT  = O_WIN   + (size_t)NIN * DM * 2;
constexpr size_t O_WFIN  = O_WOUT  + (size_t)DM * DM * 2;
constexpr size_t O_WFOUT = O_WFIN  + (size_t)NFF * DM * 2;
constexpr size_t O_WCK   = O_WFOUT + (size_t)DM * DFF * 2;
constexpr size_t O_WCV   = O_WCK   + (size_t)256 * 2048 * 2;
constexpr size_t O_WGLU  = O_WCV   + (size_t)256 * 2048 * 2;
constexpr size_t O_HN    = O_WGLU  + (size_t)512 * 512 * 2;
constexpr size_t O_R     = O_HN    + (size_t)T_ * DM * 2;
constexpr size_t O_P32   = O_R;
constexpr size_t O_PU    = O_P32   + (size_t)T_ * 1536 * 4;
constexpr size_t O_PQKV  = O_PU    + (size_t)T_ * 512 * 2;
constexpr size_t O_PZ    = O_PQKV  + (size_t)T_ * 3072 * 2;
constexpr size_t O_QN    = O_PZ    + (size_t)T_ * 1024 * 2;
constexpr size_t O_KSN   = O_QN    + (size_t)T_ * 512 * 2;
constexpr size_t O_KWN   = O_KSN   + (size_t)T_ * 128 * 2;
constexpr size_t O_VST   = O_KWN   + (size_t)T_ * 128 * 2;
constexpr size_t O_VWT   = O_VST   + (size_t)T_ * 128 * 2;
constexpr size_t O_KC    = O_VWT   + (size_t)T_ * 128 * 2;
constexpr size_t O_VCT   = O_KC    + (size_t)2 * 1024 * 64 * 2;
constexpr size_t O_HCMP  = O_VCT   + (size_t)2 * 64 * 1024 * 2;
constexpr size_t O_GKC   = O_HCMP  + (size_t)2 * 2048 * 256 * 4;
constexpr size_t O_GQG   = O_GKC   + (size_t)2048 * 64 * 128 * 2;
constexpr size_t O_GQK   = O_GQG   + (size_t)2048 * 64 * 128 * 2;
constexpr size_t O_GKD   = O_GQK   + (size_t)2048 * 64 * 64 * 2;
constexpr size_t O_GVAL  = O_GKD   + (size_t)2048 * 64 * 128 * 2;
constexpr size_t O_GEGL  = O_GVAL  + (size_t)2048 * 64 * 128 * 4;
constexpr size_t O_XEND  = O_GEGL  + 8192;
constexpr size_t O_YGELU = O_XEND  + (size_t)64 * 32 * 64 * 2 * 4;
constexpr size_t O_YGLU  = O_YGELU + (size_t)T_ * 512 * 2;
constexpr size_t O_ATT_END = O_YGLU + (size_t)T_ * 512 * 4;
constexpr size_t O_HF    = O_R;
constexpr size_t O_ACT   = O_HF    + (size_t)256 * 4 * NFF * 4;
constexpr size_t O_FFN_END = O_ACT + (size_t)T_ * DFF * 2;
constexpr size_t WS_NEED = O_ATT_END > O_FFN_END ? O_ATT_END : O_FFN_END;

struct Params { const float* in[33]; float* out; unsigned char* ws; int ph_lo, ph_hi; };

__device__ __forceinline__ unsigned short f2bf(float f) { unsigned u = __float_as_uint(f); u += 0x7FFFu + ((u >> 16) & 1u); return (unsigned short)(u >> 16); }
__device__ __forceinline__ float bf2f(unsigned short b) { return __uint_as_float(((unsigned)b) << 16); }
__device__ __forceinline__ unsigned pk2(float lo, float hi) { return pg8::cvt_pk_bf16(lo, hi); }
__device__ __forceinline__ float bflo(unsigned w) { return __uint_as_float(w << 16); }
__device__ __forceinline__ float bfhi(unsigned w) { return __uint_as_float(w & 0xFFFF0000u); }
__device__ __forceinline__ float sigmoidf_(float x) { return __builtin_amdgcn_rcpf(1.0f + __expf(-x)); }
__device__ __forceinline__ float siluf_(float x) { return x * __builtin_amdgcn_rcpf(1.0f + __expf(-x)); }
__device__ __forceinline__ float vmaxf(float a, float b) { float r; asm("v_max_f32 %0, %1, %2" : "=v"(r) : "v"(a), "v"(b)); return r; }
__device__ __forceinline__ float gelu_tanh(float x) { const float u = 0.7978845608028654f * (x + 0.044715f * x * x * x); const float th = 1.0f - 2.0f * __builtin_amdgcn_rcpf(__expf(2.0f * u) + 1.0f); return 0.5f * x * (1.0f + th); }
__device__ __forceinline__ float softplusf_(float x) { return x > 20.f ? x : log1pf(expf(x)); }
__device__ __forceinline__ float wave_sum(float v) { for (int o = 32; o >= 1; o >>= 1) v += __shfl_xor(v, o); return v; }
__device__ __forceinline__ bf16x8 pack8f(f32x4 a, f32x4 b) { u32x4 w; w.x = pk2(a[0], a[1]); w.y = pk2(a[2], a[3]); w.z = pk2(b[0], b[1]); w.w = pk2(b[2], b[3]); return __builtin_bit_cast(bf16x8, w); }
__device__ __forceinline__ float rdlane(float v, int l) { return __int_as_float(__builtin_amdgcn_readlane(__float_as_int(v), l)); }

struct EpiProj {
    static constexpr bool PERM = true, AFTER_DRAIN = false;
    float* P32; bf16_t* Pu; bf16_t* Pqkv; bf16_t* Pz;
    static __device__ __forceinline__ void st_bf(const f32x4 (&acc)[2][2][4][2], bf16_t* base, int ld) {
#pragma unroll
        for (int ai = 0; ai < 2; ++ai)
#pragma unroll
            for (int m = 0; m < 4; ++m) { bf16_t* rp = base + (size_t)(ai * 128 + m * 16) * ld;
#pragma unroll
                for (int bj = 0; bj < 2; ++bj) { const f32x4 v0 = acc[ai][bj][m][0], v1 = acc[ai][bj][m][1]; u32x4 w; w.x = pk2(v0[0], v0[1]); w.y = pk2(v0[2], v0[3]); w.z = pk2(v1[0], v1[1]); w.w = pk2(v1[2], v1[3]); *(u32x4*)(rp + bj * 128) = w; } }
    }
    __device__ __forceinline__ void operator()(const f32x4 (&acc)[2][2][4][2], const Unit& u, int wr, int wc, int fr, int fq) const {
        const int row0 = u.pm * 256 + wr * 64 + fr, colt = wc * 32 + 8 * fq;
        if (u.pn < 6) {
            float* base = P32 + (size_t)row0 * 1536 + u.pn * 256 + colt;
#pragma unroll
            for (int ai = 0; ai < 2; ++ai)
#pragma unroll
                for (int m = 0; m < 4; ++m) { float* rp = base + (size_t)(ai * 128 + m * 16) * 1536;
#pragma unroll
                    for (int bj = 0; bj < 2; ++bj) { *(f32x4*)(rp + bj * 128) = acc[ai][bj][m][0]; *(f32x4*)(rp + bj * 128 + 4) = acc[ai][bj][m][1]; } }
        } else if (u.pn < 8)  st_bf(acc, Pu   + (size_t)row0 * 512  + (u.pn - 6)  * 256 + colt, 512);
        else if (u.pn < 20)   st_bf(acc, Pqkv + (size_t)row0 * 3072 + (u.pn - 8)  * 256 + colt, 3072);
        else                  st_bf(acc, Pz   + (size_t)row0 * 1024 + (u.pn - 20) * 256 + colt, 1024);
    }
};
struct EpiResid {
    static constexpr bool PERM = false, AFTER_DRAIN = false;
    float* X; int ld;
    __device__ __forceinline__ void operator()(const f32x4 (&acc)[2][2][4][2], const Unit& u, int wr, int wc, int fr, int fq) const {
        float* base = X + (size_t)(u.pm * 256 + wr * 64 + fr) * ld + u.pn * 256 + wc * 32 + 4 * fq;
#pragma unroll
        for (int ai = 0; ai < 2; ++ai)
#pragma unroll
            for (int m = 0; m < 4; ++m) { float* rp = base + (size_t)(ai * 128 + m * 16) * ld;
#pragma unroll
                for (int bj = 0; bj < 2; ++bj)
#pragma unroll
                    for (int n = 0; n < 2; ++n) { f32x4* q = (f32x4*)(rp + bj * 128 + n * 16); *q = *q + acc[ai][bj][m][n]; } }
    }
};
struct EpiBf {
    static constexpr bool PERM = true, AFTER_DRAIN = false;
    bf16_t* O; int ld;
    __device__ __forceinline__ void operator()(const f32x4 (&acc)[2][2][4][2], const Unit& u, int wr, int wc, int fr, int fq) const {
        bf16_t* base = O + (size_t)(u.pm * 256 + wr * 64 + fr) * ld + u.pn * 256 + wc * 32 + 8 * fq;
#pragma unroll
        for (int ai = 0; ai < 2; ++ai)
#pragma unroll
            for (int m = 0; m < 4; ++m) { bf16_t* rp = base + (size_t)(ai * 128 + m * 16) * ld;
#pragma unroll
                for (int bj = 0; bj < 2; ++bj) { const f32x4 v0 = acc[ai][bj][m][0], v1 = acc[ai][bj][m][1]; u32x4 w; w.x = pk2(v0[0], v0[1]); w.y = pk2(v0[2], v0[3]); w.z = pk2(v1[0], v1[1]); w.w = pk2(v1[2], v1[3]); *(u32x4*)(rp + bj * 128) = w; } }
    }
};
struct EpiGlu {
    static constexpr bool PERM = false, AFTER_DRAIN = false;
    const bf16_t* Y; float* O;
    __device__ __forceinline__ void operator()(const f32x4 (&acc)[2][2][4][2], const Unit& u, int wr, int wc, int fr, int fq) const {
        const size_t off0 = (size_t)(u.pm * 256 + wr * 64 + fr) * 512 + u.pn * 256 + wc * 32 + 4 * fq;
#pragma unroll
        for (int ai = 0; ai < 2; ++ai)
#pragma unroll
            for (int m = 0; m < 4; ++m) { const size_t ro = off0 + (size_t)(ai * 128 + m * 16) * 512;
#pragma unroll
                for (int bj = 0; bj < 2; ++bj)
#pragma unroll
                    for (int n = 0; n < 2; ++n) { const size_t o = ro + bj * 128 + n * 16; const u32x2 yw = *(const u32x2*)(Y + o); const f32x4 a = acc[ai][bj][m][n];
                        f32x4 r; r[0] = bflo(yw.x) * sigmoidf_(a[0]); r[1] = bfhi(yw.x) * sigmoidf_(a[1]); r[2] = bflo(yw.y) * sigmoidf_(a[2]); r[3] = bfhi(yw.y) * sigmoidf_(a[3]); *(f32x4*)(O + o) = r; } }
    }
};

template <int CTRL> __device__ __forceinline__ f32x4 ror4(const f32x4 v) { f32x4 r;
    r[0] = __int_as_float(__builtin_amdgcn_update_dpp(0, __float_as_int(v[0]), CTRL, 0xF, 0xF, true)); r[1] = __int_as_float(__builtin_amdgcn_update_dpp(0, __float_as_int(v[1]), CTRL, 0xF, 0xF, true));
    r[2] = __int_as_float(__builtin_amdgcn_update_dpp(0, __float_as_int(v[2]), CTRL, 0xF, 0xF, true)); r[3] = __int_as_float(__builtin_amdgcn_update_dpp(0, __float_as_int(v[3]), CTRL, 0xF, 0xF, true)); return r; }
struct EpiFfnAct {
    static constexpr bool PERM = true, AFTER_DRAIN = false;
    bf16_t* act; float* hb; const float* cw; const float* cb;
    __device__ __forceinline__ void operator()(const f32x4 (&acc)[2][2][4][2], const Unit& u, int wr, int wc, int fr, int fq) const {
        const int colg = 128 * u.pn + wc * 32 + 8 * fq;
#pragma unroll
        for (int n = 0; n < 2; ++n) {
            const int g0 = colg + 4 * n;
            const f32x4 wg0 = *(const f32x4*)(cw + g0), wg1 = *(const f32x4*)(cw + NFF + g0), wg2 = *(const f32x4*)(cw + 2 * NFF + g0), bg = *(const f32x4*)(cb + g0);
            const f32x4 wu0 = *(const f32x4*)(cw + DFF + g0), wu1 = *(const f32x4*)(cw + NFF + DFF + g0), wu2 = *(const f32x4*)(cw + 2 * NFF + DFF + g0), bu = *(const f32x4*)(cb + DFF + g0);
#pragma unroll
            for (int ai = 0; ai < 2; ++ai) {
                const int grp = 4 * u.pm + 2 * ai + wr;
                float* hbg = hb + (size_t)grp * 4 * NFF + 256 * u.pn + wc * 32 + 8 * fq + 4 * n;
#pragma unroll
                for (int m = 0; m < 4; ++m) {
                    const f32x4 cg = acc[ai][0][m][n], cu = acc[ai][1][m][n];
                    const f32x4 pg = acc[ai][0][m > 0 ? m - 1 : 0][n], pu = acc[ai][1][m > 0 ? m - 1 : 0][n];
                    const f32x4 g1a = ror4<0x121>(cg), g2a = ror4<0x122>(cg), u1a = ror4<0x121>(cu), u2a = ror4<0x122>(cu);
                    const f32x4 g1b = ror4<0x121>(pg), g2b = ror4<0x122>(pg), u1b = ror4<0x121>(pu), u2b = ror4<0x122>(pu);
                    f32x4 g1, g2, u1, u2;
#pragma unroll
                    for (int e = 0; e < 4; ++e) { g1[e] = fr == 0 ? g1b[e] : g1a[e]; g2[e] = fr < 2 ? g2b[e] : g2a[e]; u1[e] = fr == 0 ? u1b[e] : u1a[e]; u2[e] = fr < 2 ? u2b[e] : u2a[e]; }
                    const f32x4 G = bg + wg0 * g2 + wg1 * g1 + wg2 * cg, U = bu + wu0 * u2 + wu1 * u1 + wu2 * cu;
                    u32x2 w; w.x = pk2(siluf_(G[0]) * U[0], siluf_(G[1]) * U[1]); w.y = pk2(siluf_(G[2]) * U[2], siluf_(G[3]) * U[3]);
                    const int row = u.pm * 256 + ai * 128 + wr * 64 + m * 16 + fr;
                    if (m > 0 || fr >= 2) *(u32x2*)(act + (size_t)row * DFF + g0) = w;
                    if (m == 0 && fr < 2)  { *(f32x4*)(hbg + (size_t)fr * NFF) = cg; *(f32x4*)(hbg + (size_t)fr * NFF + 128) = cu; }
                    if (m == 3 && fr >= 14) { *(f32x4*)(hbg + (size_t)(fr - 12) * NFF) = cg; *(f32x4*)(hbg + (size_t)(fr - 12) * NFF + 128) = cu; }
                }
            }
        }
    }
};
__device__ __forceinline__ int map_in_col(int n) { return n < 1304 ? n : (n < 1312 ? 5912 + (n - 1304) : (n < 1320 ? 5920 + (n - 1312) : (n < 1536 ? -1 : 1304 + (n - 1536)))); }
struct ConvJob { const float* src; bf16_t* dst; int srcN, K, tile; int inmap; };
__device__ __forceinline__ bool conv_job(const Params& p, int layer, int it, ConvJob& j) {
    unsigned char* ws = p.ws;
    const int n0 = 32 * 24, n1 = n0 + 32 * 8, n2 = n1 + 32 * 43, n3 = n2 + 86 * 8, n4 = n3 + 32, n5 = n4 + 32, n6 = n5 + 16;
    if (it >= n6) return false;
    j.inmap = 0;
    if (it < n0)      { j.src = p.in[2]  + (size_t)layer * DM * 5928; j.srcN = 5928; j.K = DM; j.dst = (bf16_t*)(ws + O_WIN); j.tile = it; j.inmap = 1; }
    else if (it < n1) { j.src = p.in[27] + (size_t)layer * DM * DM; j.srcN = DM; j.K = DM; j.dst = (bf16_t*)(ws + O_WOUT); j.tile = it - n0; }
    else if (it < n2) { j.src = p.in[29] + (size_t)layer * DM * NFF; j.srcN = NFF; j.K = DM; j.dst = (bf16_t*)(ws + O_WFIN); j.tile = it - n1; j.inmap = 2; }
    else if (it < n3) { j.src = p.in[32] + (size_t)layer * DFF * DM; j.srcN = DM; j.K = DFF; j.dst = (bf16_t*)(ws + O_WFOUT); j.tile = it - n2; }
    else if (it < n4) { j.src = p.in[8]  + (size_t)layer * 2048 * 256; j.srcN = 256; j.K = 2048; j.dst = (bf16_t*)(ws + O_WCK); j.tile = it - n3; }
    else if (it < n5) { j.src = p.in[10] + (size_t)layer * 2048 * 256; j.srcN = 256; j.K = 2048; j.dst = (bf16_t*)(ws + O_WCV); j.tile = it - n4; }
    else              { j.src = p.in[21] + (size_t)layer * 512 * 512; j.srcN = 512; j.K = 512; j.dst = (bf16_t*)(ws + O_WGLU); j.tile = it - n5; }
    return true;
}
__device__ __forceinline__ void conv_load(const ConvJob& j, int tid, float (&v)[32]) {
    const int nk = j.K >> 6, tk = j.tile % nk, tn = j.tile / nk, k0 = tk * 64, n0 = tn * 256, tx = tid & 255, ty = tid >> 8;
    const int n = n0 + tx, sc = j.inmap == 1 ? map_in_col(n) : (j.inmap == 2 ? ((n & 255) < 128 ? 128 * (n >> 8) + (n & 127) : DFF + 128 * (n >> 8) + (n & 127)) : n);
    const float* sp = j.src + (size_t)(k0 + ty) * j.srcN + (sc >= 0 ? sc : 0);
#pragma unroll
    for (int i = 0; i < 32; ++i) v[i] = (sc >= 0) ? sp[(size_t)(2 * i) * j.srcN] : 0.f;
}
__device__ __forceinline__ void conv_store(const ConvJob& j, int tid, const float (&v)[32], float* sm) {
    const int nk = j.K >> 6, tk = j.tile % nk, tn = j.tile / nk, k0 = tk * 64, n0 = tn * 256, tx = tid & 255, ty = tid >> 8;
#pragma unroll
    for (int i = 0; i < 32; ++i) sm[(ty + 2 * i) * 257 + tx] = v[i];
    __syncthreads();
    const int nn = tid >> 1, hf = tid & 1;
    bf16_t* o = j.dst + (size_t)(n0 + nn) * j.K + k0 + hf * 32;
#pragma unroll
    for (int q = 0; q < 4; ++q) { u32x4 w; const float* sp = sm + (hf * 32 + q * 8) * 257 + nn;
        w.x = pk2(sp[0], sp[257]); w.y = pk2(sp[2 * 257], sp[3 * 257]); w.z = pk2(sp[4 * 257], sp[5 * 257]); w.w = pk2(sp[6 * 257], sp[7 * 257]); *(u32x4*)(o + q * 8) = w; }
    __syncthreads();
}
__device__ void phase_convert(const Params& p, int layer, float* sm) {
    const int G = gridDim.x, tid = tidx();
    ConvJob ja, jb; float va[32], vb[32];
    int it = blockIdx.x;
    bool ha = conv_job(p, layer, it, ja);
    if (ha) conv_load(ja, tid, va);
    while (ha) {
        const bool hb = conv_job(p, layer, it + G, jb);
        if (hb) conv_load(jb, tid, vb);
        conv_store(ja, tid, va, sm);
        if (!hb) break;
        ha = conv_job(p, layer, it + 2 * G, ja);
        if (ha) conv_load(ja, tid, va);
        conv_store(jb, tid, vb, sm);
        it += 2 * G;
    }
}
__device__ void phase_rmsnorm(const float* __restrict__ x, const float* __restrict__ gain, bf16_t* __restrict__ hn, float* __restrict__ xcopy) {
    const int wave = tidx() >> 6, lane = tidx() & 63;
    for (int r = blockIdx.x * 8 + wave; r < T_; r += gridDim.x * 8) {
        const f32x4* xr = (const f32x4*)(x + (size_t)r * DM);
        f32x4 v[8]; float ss = 0.f;
#pragma unroll
        for (int i = 0; i < 8; ++i) { v[i] = xr[lane + 64 * i]; ss += v[i][0] * v[i][0] + v[i][1] * v[i][1] + v[i][2] * v[i][2] + v[i][3] * v[i][3]; }
        ss = wave_sum(ss);
        const float rs = rsqrtf(ss * (1.0f / DM) + 1e-6f);
#pragma unroll
        for (int i = 0; i < 8; ++i) { const f32x4 g = ((const f32x4*)gain)[lane + 64 * i]; u32x2 w; w.x = pk2(v[i][0] * rs * g[0], v[i][1] * rs * g[1]); w.y = pk2(v[i][2] * rs * g[2], v[i][3] * rs * g[3]);
            *(u32x2*)(hn + (size_t)r * DM + (lane + 64 * i) * 4) = w; if (xcopy) ((f32x4*)(xcopy + (size_t)r * DM))[lane + 64 * i] = v[i]; }
    }
}

__device__ void nsa_prep_item(const Params& p, int layer, int item, float* sm) {
    unsigned char* ws = p.ws;
    const float* P32 = (const float*)(ws + O_P32);
    bf16_t* qn = (bf16_t*)(ws + O_QN); bf16_t* ksn = (bf16_t*)(ws + O_KSN); bf16_t* kwn = (bf16_t*)(ws + O_KWN);
    const int wave = tidx() >> 6, lane = tidx() & 63, tid = tidx();
    const int t0 = item * 64;
    const float gq = p.in[3][layer * 64 + lane], gks = p.in[5][layer * 64 + lane], gkw = p.in[6][layer * 64 + lane];
    const float inv = powf(500000.0f, -(float)(lane & 7) * 0.125f);
    for (int tt = 0; tt < 8; ++tt) {
        const int t = t0 + wave * 8 + tt;
        float sn, cs; sincosf((float)t * inv, &sn, &cs);
        const float* row = P32 + (size_t)t * 1536;
#pragma unroll
        for (int hv = 0; hv < 12; ++hv) {
            const int col = hv < 8 ? hv * 64 : (hv < 10 ? 768 + (hv - 8) * 64 : 1024 + (hv - 10) * 64);
            const float g = hv < 8 ? gq : (hv < 10 ? gks : gkw);
            const float x = row[col + lane];
            const float ss = wave_sum(x * x);
            float y = x * rsqrtf(ss * (1.0f / 64.0f) + 1e-6f) * g;
            const float yp = __shfl(y, lane ^ 8);
            if (lane < 8) y = y * cs - yp * sn; else if (lane < 16) y = y * cs + yp * sn;
            if (hv < 8) qn[(size_t)t * 512 + hv * 64 + lane] = f2bf(y * 0.18033688011112042f);
            else {
                unsigned char* k8 = (hv < 10 ? ws + O_KSN : ws + O_KWN) + ((size_t)(((hv - 8) & 1) * 256 + (t >> 6)) * 64 + (t & 63)) * 64 + ((lane >> 3) & 3) * 16 + (lane >> 5) * 8 + (lane & 7);
                *k8 = (unsigned char)__builtin_amdgcn_cvt_pk_fp8_f32(y, 0.f, 0, false);
            }
        }
    }
    for (int e = tid; e < 64 * 256; e += 512) { const int tk = e >> 8, c = e & 255; sm[tk * 257 + c] = P32[(size_t)(t0 + tk) * 1536 + (c < 128 ? 896 + c : 1152 + (c - 128))]; }
    __syncthreads();
    unsigned char* vs8 = ws + O_VST; unsigned char* vw8 = ws + O_VWT;
#pragma unroll
    for (int i = 0; i < 4; ++i) {
        const int rowid = (tid >> 3) + 64 * i, ts = tid & 7;
        float f[8];
#pragma unroll
        for (int k = 0; k < 8; ++k) { const int bb = ts * 8 + k, cc = ((bb >> 3) & 1) * 32 + (bb >> 4) * 8 + (bb & 7); f[k] = sm[((cc & 3) * 16 + (cc >> 2)) * 257 + rowid]; }
        u32x2 w; int t;
        t = __builtin_amdgcn_cvt_pk_fp8_f32(f[0], f[1], 0, false); t = __builtin_amdgcn_cvt_pk_fp8_f32(f[2], f[3], t, true); w.x = (unsigned)t;
        t = __builtin_amdgcn_cvt_pk_fp8_f32(f[4], f[5], 0, false); t = __builtin_amdgcn_cvt_pk_fp8_f32(f[6], f[7], t, true); w.y = (unsigned)t;
        const int rr = rowid & 127;
        unsigned char* dst = (rowid < 128 ? vs8 : vw8) + ((size_t)((rr >> 6) * 256 + item) * 64 + (rr & 63)) * 64 + ts * 8;
        *(u32x2*)dst = w;
    }
    __syncthreads();
}

__device__ void cmp1_wave_tile(const Params& p, int layer, int tile) {
    unsigned char* ws = p.ws;
    const float* P32 = (const float*)(ws + O_P32);
    const int lane = tidx() & 63, fr = lane & 15, fq = lane >> 4;
    const int nt = tile & 15, mt = (tile >> 4) & 127, which = tile >> 11;
    const bf16_t* Wt = (const bf16_t*)(ws + (which ? O_WCV : O_WCK)) + (size_t)(nt * 16 + fr) * 2048 + fq * 8;
    const float* pe = p.in[7] + (size_t)layer * 2048;
    const int r = mt * 16 + fr, n = r >> 1, hk = r & 1;
    const bool rv = n < 1023;
    const float* arow = P32 + (size_t)(16 * (rv ? n : 0)) * 1536 + (which ? 640 : 512) + hk * 64 + fq * 8;
    f32x4 acc = {0.f, 0.f, 0.f, 0.f};
#pragma unroll 8
    for (int ks = 0; ks < 64; ++ks) {
        const int l = ks >> 1, d = (ks & 1) * 32;
        const f32x4* ap = (const f32x4*)(arow + (size_t)l * 1536 + d);
        const f32x4* pp = (const f32x4*)(pe + l * 64 + d + fq * 8);
        f32x4 a0 = ap[0] + pp[0], a1 = ap[1] + pp[1];
        if (!rv) { a0 = (f32x4){0.f, 0.f, 0.f, 0.f}; a1 = a0; }
        const bf16x8 af = pack8f(a0, a1);
        const bf16x8 bf = *(const bf16x8*)(Wt + ks * 32);
        acc = MFMA16(af, bf, acc);
    }
    float* H = (float*)(ws + O_HCMP) + (size_t)which * 2048 * 256;
#pragma unroll
    for (int j = 0; j < 4; ++j) H[(size_t)(mt * 16 + fq * 4 + j) * 256 + nt * 16 + fr] = gelu_tanh(acc[j]);
}
__device__ void cmp2_wave_row(const Params& p, int layer, int idx) {
    unsigned char* ws = p.ws;
    const int lane = tidx() & 63;
    const int which = idx >> 11, r = idx & 2047, n = r >> 1, hk = r & 1;
    const float* H = (const float*)(ws + O_HCMP) + ((size_t)which * 2048 + r) * 256;
    const float* w2 = p.in[which ? 11 : 9] + (size_t)layer * 256 * 64;
    float acc = 0.f;
    if (n < 1023) {
        float a4[4] = {0.f, 0.f, 0.f, 0.f};
#pragma unroll 8
        for (int f = 0; f < 256; f += 4) { const f32x4 h4 = *(const f32x4*)(H + f); a4[0] += h4[0] * w2[f * 64 + lane]; a4[1] += h4[1] * w2[(f + 1) * 64 + lane]; a4[2] += h4[2] * w2[(f + 2) * 64 + lane]; a4[3] += h4[3] * w2[(f + 3) * 64 + lane]; }
        acc = (a4[0] + a4[1]) + (a4[2] + a4[3]);
    }
    if (which == 0) {
        const float ss = wave_sum(acc * acc);
        float y = acc * rsqrtf(ss * (1.0f / 64.0f) + 1e-6f) * p.in[4][layer * 64 + lane];
        const float inv = powf(500000.0f, -(float)(lane & 7) * 0.125f);
        float sn, cs; sincosf((float)(16 * n + 16) * inv, &sn, &cs);
        const float yp = __shfl(y, lane ^ 8);
        if (lane < 8) y = y * cs - yp * sn; else if (lane < 16) y = y * cs + yp * sn;
        if (n >= 1023) y = 0.f;
        ((bf16_t*)(ws + O_KC))[((size_t)hk * 1024 + n) * 64 + lane] = f2bf(y);
    } else {
        { const int cc = ((n & 15) << 2) | ((n >> 4) & 3); (ws + O_VCT)[((size_t)(hk * 16 + (n >> 6)) * 64 + lane) * 64 + ((cc >> 3) & 3) * 16 + (cc >> 5) * 8 + (cc & 7)] = (unsigned char)__builtin_amdgcn_cvt_pk_fp8_f32(acc, 0.f, 0, false); }
    }
}

typedef float f32x2 __attribute__((ext_vector_type(2)));
struct S5Coef { float ar, ai; f32x2 bb[16]; };
__device__ __forceinline__ void s5_setup(const Params& p, int layer, int g, int lane, S5Coef& c) {
    const int gp = layer * 2048 + g * 64 + lane;
    const float dt = expf(p.in[15][layer * 32 + g]);
    const float lr = p.in[13][gp], li = p.in[14][gp];
    const float mag = expf(lr * dt); float sn, cs; sincosf(li * dt, &sn, &cs);
    c.ar = mag * cs; c.ai = mag * sn;
    const float den = lr * lr + li * li, nr = c.ar - 1.0f, ni = c.ai;
    const float cr = (nr * lr + ni * li) / den, ci = (ni * lr - nr * li) / den;
    const f32x4* br = (const f32x4*)(p.in[16] + (size_t)gp * 16); const f32x4* bi = (const f32x4*)(p.in[17] + (size_t)gp * 16);
#pragma unroll
    for (int q = 0; q < 4; ++q) { const f32x4 a = br[q], b = bi[q];
#pragma unroll
        for (int e = 0; e < 4; ++e) c.bb[q * 4 + e] = (f32x2){cr * a[e] - ci * b[e], cr * b[e] + ci * a[e]}; }
}
__device__ __forceinline__ void s5_stage_u(const bf16_t* Pu, int tok, int g, float* ul, int lane) {
    const u32x4* s = (const u32x4*)(Pu + (size_t)tok * 512 + g * 16); const u32x4 a = s[0], b = s[1];
    f32x4* o = (f32x4*)(ul + lane * 16);
    o[0] = (f32x4){bflo(a.x), bfhi(a.x), bflo(a.y), bfhi(a.y)}; o[1] = (f32x4){bflo(a.z), bfhi(a.z), bflo(a.w), bfhi(a.w)};
    o[2] = (f32x4){bflo(b.x), bfhi(b.x), bflo(b.y), bfhi(b.y)}; o[3] = (f32x4){bflo(b.z), bfhi(b.z), bflo(b.w), bfhi(b.w)};
    asm volatile("s_waitcnt lgkmcnt(0)" ::: "memory");
}
__device__ __forceinline__ void s5_step(const S5Coef& k, const float* uj, float& xr, float& xi) {
    const f32x4 u0 = ((const f32x4*)uj)[0], u1 = ((const f32x4*)uj)[1], u2 = ((const f32x4*)uj)[2], u3 = ((const f32x4*)uj)[3];
    f32x2 acc0 = {0.f, 0.f}, acc1 = {0.f, 0.f};
#pragma unroll
    for (int e = 0; e < 4; ++e) { acc0 += k.bb[e] * u0[e]; acc1 += k.bb[4 + e] * u1[e]; }
#pragma unroll
    for (int e = 0; e < 4; ++e) { acc0 += k.bb[8 + e] * u2[e]; acc1 += k.bb[12 + e] * u3[e]; }
    const f32x2 bu = acc0 + acc1;
    const float nxr = k.ar * xr - k.ai * xi + bu[0], nxi = k.ar * xi + k.ai * xr + bu[1]; xr = nxr; xi = nxi;
}
__device__ void s5_passA_wave(const Params& p, int layer, int item, float* ul) {
    unsigned char* ws = p.ws; const bf16_t* Pu = (const bf16_t*)(ws + O_PU);
    const int lane = tidx() & 63, c = item >> 5, g = item & 31;
    S5Coef k; s5_setup(p, layer, g, lane, k);
    float xr = 0.f, xi = 0.f;
    for (int sub = 0; sub < 4; ++sub) {
        s5_stage_u(Pu, c * 256 + sub * 64 + lane, g, ul, lane);
#pragma unroll 4
        for (int j = 0; j < 64; ++j) s5_step(k, ul + j * 16, xr, xi);
        asm volatile("s_waitcnt lgkmcnt(0)" ::: "memory");
    }
    float* xe = (float*)(ws + O_XEND) + ((size_t)(c * 32 + g) * 64 + lane) * 2; xe[0] = xr; xe[1] = xi;
}
__device__ void s5_passB_wave(const Params& p, int layer, int item, bf16_t* xl, float* ul) {
    unsigned char* ws = p.ws; const bf16_t* Pu = (const bf16_t*)(ws + O_PU); bf16_t* yg = (bf16_t*)(ws + O_YGELU);
    const int lane = tidx() & 63, fr = lane & 15, fq = lane >> 4, c = item >> 5, g = item & 31;
    S5Coef k; s5_setup(p, layer, g, lane, k);
    float pr = k.ar, pi = k.ai;
#pragma unroll
    for (int s = 0; s < 8; ++s) { const float nr = pr * pr - pi * pi, ni = 2.f * pr * pi; pr = nr; pi = ni; }
    float xr = 0.f, xi = 0.f;
    const float* xe = (const float*)(ws + O_XEND) + ((size_t)g * 64 + lane) * 2;
#pragma unroll 8
    for (int cc = 0; cc < c; ++cc) { const float er = xe[(size_t)cc * 32 * 64 * 2], ei = xe[(size_t)cc * 32 * 64 * 2 + 1]; const float nr = pr * xr - pi * xi + er, ni = pr * xi + pi * xr + ei; xr = nr; xi = ni; }
    bf16x8 cf[4];
    {
        const float* cre = p.in[18] + (size_t)layer * 32 * 16 * 64 + ((size_t)g * 16 + fr) * 64; const float* cim = p.in[19] + (size_t)layer * 32 * 16 * 64 + ((size_t)g * 16 + fr) * 64;
#pragma unroll
        for (int ks = 0; ks < 4; ++ks) { const float* s = (ks < 2 ? cre : cim) + (ks & 1) * 32 + fq * 8; f32x4 a = ((const f32x4*)s)[0], b = ((const f32x4*)s)[1]; if (ks >= 2) { a = -a; b = -b; } cf[ks] = pack8f(a, b); }
    }
    const float dsk = p.in[20][layer * 512 + g * 16 + fr];
    for (int sub = 0; sub < 4; ++sub) {
        const int tb = c * 256 + sub * 64;
        s5_stage_u(Pu, tb + lane, g, ul, lane);
        for (int jb = 0; jb < 4; ++jb) {
#pragma unroll 4
            for (int jj = 0; jj < 16; ++jj) {
                s5_step(k, ul + (jb * 16 + jj) * 16, xr, xi);
                xl[jj * 136 + lane] = f2bf(xr); xl[jj * 136 + 64 + lane] = f2bf(xi);
            }
            asm volatile("s_waitcnt lgkmcnt(0)" ::: "memory");
            f32x4 y = {0.f, 0.f, 0.f, 0.f};
#pragma unroll
            for (int ks = 0; ks < 4; ++ks) { const bf16x8 af = *(const bf16x8*)(xl + fr * 136 + ks * 32 + fq * 8); y = MFMA16(af, cf[ks], y); }
            asm volatile("s_waitcnt lgkmcnt(0)" ::: "memory");
#pragma unroll
            for (int q = 0; q < 4; ++q) { const int tl = jb * 16 + fq * 4 + q; const float u = ul[tl * 16 + fr]; yg[(size_t)(tb + tl) * 512 + g * 16 + fr] = f2bf(gelu_tanh(y[q] + dsk * u)); }
        }
        asm volatile("s_waitcnt lgkmcnt(0)" ::: "memory");
    }
}
__device__ void gdn_prep_item(const Params& p, int layer, int item, unsigned char* lds) {
    unsigned char* ws = p.ws;
    const int tid = tidx(), wave = tid >> 6, lane = tid & 63, fr = lane & 15, fq = lane >> 4;
    const int n = item >> 3, h = item & 7, t0 = n * 64;
    bf16_t* qs = (bf16_t*)(lds); bf16_t* ks = (bf16_t*)(lds + 17408); bf16_t* vbT = (bf16_t*)(lds + 34816); bf16_t* kgT = (bf16_t*)(lds + 53248); bf16_t* kdT = (bf16_t*)(lds + 71680);
    float* Am = (float*)(lds + 90112); bf16_t* Tb = (bf16_t*)(lds + 107520); float* gcs = (float*)(lds + 116736); float* bts = (float*)(lds + 116992);
    const float* P32 = (const float*)(ws + O_P32); const bf16_t* Pqkv = (const bf16_t*)(ws + O_PQKV);
    if (wave == 0) {
        const int t = t0 + lane;
        const float a = P32[(size_t)t * 1536 + 1304 + h], b = P32[(size_t)t * 1536 + 1312 + h];
        const float g = -expf(p.in[24][layer * 8 + h]) * softplusf_(a + p.in[25][layer * 8 + h]);
        float s = g;
#pragma unroll
        for (int off = 1; off < 64; off <<= 1) { const float o = __shfl_up(s, off); if (lane >= off) s += o; }
        gcs[lane] = s; bts[lane] = sigmoidf_(b);
    }
    __syncthreads();
    {
        const int r = tid >> 3, c0 = (tid & 7) * 16;
        const float gcr = gcs[r], btr = bts[r], eg = expf(gcr), ed = expf(gcs[63] - gcr);
        const float* cw = p.in[23] + (size_t)layer * 4 * 3072;
#pragma unroll
        for (int which = 0; which < 3; ++which) {
            const int col = which * 1024 + h * 128 + c0;
            float acc[16];
#pragma unroll
            for (int e = 0; e < 16; ++e) acc[e] = 0.f;
#pragma unroll
            for (int j = 0; j < 4; ++j) {
                const int tr = t0 + r - 3 + j;
                if (tr >= 0) {
                    const u32x4* s = (const u32x4*)(Pqkv + (size_t)tr * 3072 + col); const u32x4 a = s[0], b = s[1];
                    const f32x4* wp = (const f32x4*)(cw + j * 3072 + col); const f32x4 w0 = wp[0], w1 = wp[1], w2 = wp[2], w3 = wp[3];
                    acc[0] += w0[0] * bflo(a.x); acc[1] += w0[1] * bfhi(a.x); acc[2] += w0[2] * bflo(a.y); acc[3] += w0[3] * bfhi(a.y);
                    acc[4] += w1[0] * bflo(a.z); acc[5] += w1[1] * bfhi(a.z); acc[6] += w1[2] * bflo(a.w); acc[7] += w1[3] * bfhi(a.w);
                    acc[8] += w2[0] * bflo(b.x); acc[9] += w2[1] * bfhi(b.x); acc[10] += w2[2] * bflo(b.y); acc[11] += w2[3] * bfhi(b.y);
                    acc[12] += w3[0] * bflo(b.z); acc[13] += w3[1] * bfhi(b.z); acc[14] += w3[2] * bflo(b.w); acc[15] += w3[3] * bfhi(b.w);
                }
            }
            float ss = 0.f;
#pragma unroll
            for (int e = 0; e < 16; ++e) { acc[e] = siluf_(acc[e]); ss += acc[e] * acc[e]; }
            ss += __shfl_xor(ss, 1); ss += __shfl_xor(ss, 2); ss += __shfl_xor(ss, 4);
            const float rn = rsqrtf(ss + 1e-6f);
            if (which == 0) {
                bf16_t* qg = (bf16_t*)(ws + O_GQG) + (size_t)item * 8192 + r * 128 + c0;
                float v[16];
#pragma unroll
                for (int e = 0; e < 16; ++e) v[e] = acc[e] * rn * 0.08838834764831845f;
                u32x4 w0, w1; w0.x = pk2(v[0], v[1]); w0.y = pk2(v[2], v[3]); w0.z = pk2(v[4], v[5]); w0.w = pk2(v[6], v[7]); w1.x = pk2(v[8], v[9]); w1.y = pk2(v[10], v[11]); w1.z = pk2(v[12], v[13]); w1.w = pk2(v[14], v[15]);
                *(u32x4*)(qs + r * 136 + c0) = w0; *(u32x4*)(qs + r * 136 + c0 + 8) = w1;
                u32x4 g0, g1; g0.x = pk2(v[0] * eg, v[1] * eg); g0.y = pk2(v[2] * eg, v[3] * eg); g0.z = pk2(v[4] * eg, v[5] * eg); g0.w = pk2(v[6] * eg, v[7] * eg);
                g1.x = pk2(v[8] * eg, v[9] * eg); g1.y = pk2(v[10] * eg, v[11] * eg); g1.z = pk2(v[12] * eg, v[13] * eg); g1.w = pk2(v[14] * eg, v[15] * eg);
                *(u32x4*)qg = g0; *(u32x4*)(qg + 8) = g1;
            } else if (which == 1) {
                float v[16];
#pragma unroll
                for (int e = 0; e < 16; ++e) v[e] = acc[e] * rn;
                u32x4 w0, w1; w0.x = pk2(v[0], v[1]); w0.y = pk2(v[2], v[3]); w0.z = pk2(v[4], v[5]); w0.w = pk2(v[6], v[7]); w1.x = pk2(v[8], v[9]); w1.y = pk2(v[10], v[11]); w1.z = pk2(v[12], v[13]); w1.w = pk2(v[14], v[15]);
                *(u32x4*)(ks + r * 136 + c0) = w0; *(u32x4*)(ks + r * 136 + c0 + 8) = w1;
#pragma unroll
                for (int e = 0; e < 16; ++e) { kgT[(c0 + e) * 72 + r] = f2bf(v[e] * btr * eg); kdT[(c0 + e) * 72 + r] = f2bf(v[e] * ed); }
            } else {
#pragma unroll
                for (int e = 0; e < 16; ++e) vbT[(c0 + e) * 72 + r] = f2bf(acc[e] * btr);
            }
        }
    }
    __syncthreads();
    {
        const int d = tid >> 2, sg = tid & 3;
        const u32x4 a = *(const u32x4*)(kdT + d * 72 + sg * 16), b = *(const u32x4*)(kdT + d * 72 + sg * 16 + 8);
        bf16_t* dst = (bf16_t*)(ws + O_GKD) + (size_t)item * 8192 + d * 64 + sg * 16; *(u32x4*)dst = a; *(u32x4*)(dst + 8) = b;
    }
    { float* Tmz = (float*)(lds + 117248); for (int e2 = tid; e2 < 64 * 68; e2 += 512) Tmz[e2] = 0.f; }
    {
        const int mi = wave >> 1;
        bf16_t* qko = (bf16_t*)(ws + O_GQK) + (size_t)item * 4096;
#pragma unroll
        for (int q = 0; q < 2; ++q) {
            const int nj = (wave & 1) * 2 + q;
            f32x4 kk = {0.f, 0.f, 0.f, 0.f}, qk = {0.f, 0.f, 0.f, 0.f};
            if (nj <= mi) {
#pragma unroll
                for (int s = 0; s < 4; ++s) {
                    const bf16x8 bk = *(const bf16x8*)(ks + (nj * 16 + fr) * 136 + s * 32 + fq * 8);
                    const bf16x8 ak = *(const bf16x8*)(ks + (mi * 16 + fr) * 136 + s * 32 + fq * 8);
                    const bf16x8 aq = *(const bf16x8*)(qs + (mi * 16 + fr) * 136 + s * 32 + fq * 8);
                    kk = MFMA16(ak, bk, kk); qk = MFMA16(aq, bk, qk);
                }
            }
            const int j = nj * 16 + fr; const float gj = gcs[j];
#pragma unroll
            for (int e = 0; e < 4; ++e) {
                const int i = mi * 16 + fq * 4 + e;
                const float dec = (j <= i) ? expf(gcs[i] - gj) : 0.f;
                Am[i * 68 + j] = (j < i) ? bts[i] * kk[e] * dec : 0.f;
                qko[i * 64 + j] = f2bf((j <= i) ? qk[e] * dec : 0.f);
            }
        }
    }
    __syncthreads();
    {
        float* Tm = (float*)(lds + 117248); float* Ps = (float*)(lds + 134656) + wave * 320;
        if (wave == 0) {
            const int bo = fq * 16; float t[16];
#pragma unroll
            for (int i = 0; i < 16; ++i) {
                float s = (i == fr) ? 1.f : 0.f;
#pragma unroll
                for (int j = 0; j < i; ++j) s -= Am[(bo + i) * 68 + bo + j] * t[j];
                t[i] = s; Tm[(bo + i) * 68 + bo + fr] = s;
            }
        }
        asm volatile("s_waitcnt lgkmcnt(0)" ::: "memory"); __syncthreads();
#pragma unroll
        for (int d = 1; d < 4; ++d) {
            if (wave < 4 - d) {
                const int bi = wave + d, bj = wave;
                f32x4 Q = {0.f, 0.f, 0.f, 0.f};
                for (int kb = bj; kb < bi; ++kb) {
                    const float* X = Am + (bi * 16) * 68 + kb * 16; const float* Y = Tm + (kb * 16) * 68 + bj * 16;
#pragma unroll
                    for (int s = 0; s < 4; ++s) Q = __builtin_amdgcn_mfma_f32_16x16x4f32(X[fr * 68 + 4 * s + fq], Y[(4 * s + fq) * 68 + fr], Q, 0, 0, 0);
                }
#pragma unroll
                for (int e2 = 0; e2 < 4; ++e2) Ps[(fq * 4 + e2) * 20 + fr] = Q[e2];
                asm volatile("s_waitcnt lgkmcnt(0)" ::: "memory");
                f32x4 R = {0.f, 0.f, 0.f, 0.f};
                const float* X = Tm + (bi * 16) * 68 + bi * 16;
#pragma unroll
                for (int s = 0; s < 4; ++s) R = __builtin_amdgcn_mfma_f32_16x16x4f32(X[fr * 68 + 4 * s + fq], Ps[(4 * s + fq) * 20 + fr], R, 0, 0, 0);
#pragma unroll
                for (int e2 = 0; e2 < 4; ++e2) Tm[(bi * 16 + fq * 4 + e2) * 68 + bj * 16 + fr] = -R[e2];
            }
            asm volatile("s_waitcnt lgkmcnt(0)" ::: "memory"); __syncthreads();
        }
        for (int e2 = tid; e2 < 4096; e2 += 512) { const int r = e2 >> 6, c = e2 & 63; Tb[r * 72 + c] = f2bf(Tm[r * 68 + c]); }
    }
    __syncthreads();
    {
        const int mi = wave & 3;
        const bf16x8 a0 = *(const bf16x8*)(Tb + (mi * 16 + fr) * 72 + fq * 8), a1 = *(const bf16x8*)(Tb + (mi * 16 + fr) * 72 + 32 + fq * 8);
        float* vo = (float*)(ws + O_GVAL) + (size_t)item * 8192; bf16_t* ko = (bf16_t*)(ws + O_GKC) + (size_t)item * 8192;
#pragma unroll
        for (int q = 0; q < 4; ++q) {
            const int nt = (wave >> 2) * 4 + q;
            f32x4 v = {0.f, 0.f, 0.f, 0.f}, kc = {0.f, 0.f, 0.f, 0.f};
            v = MFMA16(a0, *(const bf16x8*)(vbT + (nt * 16 + fr) * 72 + fq * 8), v); v = MFMA16(a1, *(const bf16x8*)(vbT + (nt * 16 + fr) * 72 + 32 + fq * 8), v);
            kc = MFMA16(a0, *(const bf16x8*)(kgT + (nt * 16 + fr) * 72 + fq * 8), kc); kc = MFMA16(a1, *(const bf16x8*)(kgT + (nt * 16 + fr) * 72 + 32 + fq * 8), kc);
#pragma unroll
            for (int e = 0; e < 4; ++e) { const int i = mi * 16 + fq * 4 + e, d = nt * 16 + fr; vo[i * 128 + d] = v[e]; ko[i * 128 + d] = f2bf(kc[e]); }
        }
    }
    if (tid == 0) ((float*)(ws + O_GEGL))[item] = expf(gcs[63]);
    __syncthreads();
}

struct GdnUO { bf16x8 kc[4], qg[4], qk[2]; float val[2][4]; };
struct GdnSU { bf16x8 kd[2][2]; float egl; };
__device__ __forceinline__ void gdn_load_uo(const unsigned char* ws, int item, int mt, int fr, int fq, int dvb, GdnUO& f) {
    const bf16_t* kc = (const bf16_t*)(ws + O_GKC) + (size_t)item * 8192 + (mt * 16 + fr) * 128 + fq * 8;
    const bf16_t* qg = (const bf16_t*)(ws + O_GQG) + (size_t)item * 8192 + (mt * 16 + fr) * 128 + fq * 8;
    const bf16_t* qk = (const bf16_t*)(ws + O_GQK) + (size_t)item * 4096 + (mt * 16 + fr) * 64 + fq * 8;
    const float* vl = (const float*)(ws + O_GVAL) + (size_t)item * 8192 + (mt * 16 + fq * 4) * 128 + dvb + fr;
#pragma unroll
    for (int s = 0; s < 4; ++s) { f.kc[s] = *(const bf16x8*)(kc + s * 32); f.qg[s] = *(const bf16x8*)(qg + s * 32); }
#pragma unroll
    for (int s = 0; s < 2; ++s) f.qk[s] = *(const bf16x8*)(qk + s * 32);
#pragma unroll
    for (int nt = 0; nt < 2; ++nt)
#pragma unroll
        for (int e = 0; e < 4; ++e) f.val[nt][e] = vl[e * 128 + nt * 16];
}
__device__ __forceinline__ void gdn_load_su(const unsigned char* ws, int item, int w4, int fr, int fq, GdnSU& f) {
    const bf16_t* kd = (const bf16_t*)(ws + O_GKD) + (size_t)item * 8192 + (2 * w4 * 16 + fr) * 64 + fq * 8;
#pragma unroll
    for (int s = 0; s < 2; ++s) { f.kd[0][s] = *(const bf16x8*)(kd + s * 32); f.kd[1][s] = *(const bf16x8*)(kd + 16 * 64 + s * 32); }
    f.egl = ((const float*)(ws + O_GEGL))[item];
}
#define GDN_BAR() do { asm volatile("s_waitcnt lgkmcnt(0)" ::: "memory"); __builtin_amdgcn_s_barrier(); asm volatile("" ::: "memory"); } while (0)
__device__ __forceinline__ void gdn_step_uo(const GdnUO& c, bf16_t* Sl, bf16_t* vn, float* go, int n, int h, int mt, int fr, int fq, int dvb) {
    bf16x8 Sb[2][4];
#pragma unroll
    for (int nt = 0; nt < 2; ++nt)
#pragma unroll
        for (int s = 0; s < 4; ++s) Sb[nt][s] = *(const bf16x8*)(Sl + nt * (16 * 136) + fr * 136 + s * 32 + fq * 8);
    f32x4 U[2], O[2];
#pragma unroll
    for (int nt = 0; nt < 2; ++nt) { U[nt] = (f32x4){0.f, 0.f, 0.f, 0.f}; O[nt] = (f32x4){0.f, 0.f, 0.f, 0.f};
#pragma unroll
        for (int s = 0; s < 4; ++s) U[nt] = MFMA16(c.kc[s], Sb[nt][s], U[nt]);
        u32x2 w; w.x = pk2(c.val[nt][0] - U[nt][0], c.val[nt][1] - U[nt][1]); w.y = pk2(c.val[nt][2] - U[nt][2], c.val[nt][3] - U[nt][3]);
        *(u32x2*)(vn + nt * (16 * 72) + fr * 72 + mt * 16 + fq * 4) = w; }
#pragma unroll
    for (int nt = 0; nt < 2; ++nt)
#pragma unroll
        for (int s = 0; s < 4; ++s) O[nt] = MFMA16(c.qg[s], Sb[nt][s], O[nt]);
    GDN_BAR();
#pragma unroll
    for (int nt = 0; nt < 2; ++nt) {
        const bf16x8 V0 = *(const bf16x8*)(vn + nt * (16 * 72) + fr * 72 + fq * 8), V1 = *(const bf16x8*)(vn + nt * (16 * 72) + fr * 72 + 32 + fq * 8);
        O[nt] = MFMA16(c.qk[0], V0, O[nt]); O[nt] = MFMA16(c.qk[1], V1, O[nt]);
#pragma unroll
        for (int e = 0; e < 4; ++e) go[(size_t)(n * 64 + mt * 16 + fq * 4 + e) * 1024 + h * 128 + dvb + nt * 16 + fr] = O[nt][e];
    }
    GDN_BAR();
}
__device__ __forceinline__ void gdn_step_su(const GdnSU& c, f32x4 (&St)[2][2], bf16_t* Sl, const bf16_t* vn, int w4, int fr, int fq) {
    GDN_BAR();
#pragma unroll
    for (int nt = 0; nt < 2; ++nt) {
        const bf16x8 V0 = *(const bf16x8*)(vn + nt * (16 * 72) + fr * 72 + fq * 8), V1 = *(const bf16x8*)(vn + nt * (16 * 72) + fr * 72 + 32 + fq * 8);
#pragma unroll
        for (int q = 0; q < 2; ++q) {
            St[nt][q] = St[nt][q] * c.egl;
            St[nt][q] = MFMA16(V0, c.kd[q][0], St[nt][q]); St[nt][q] = MFMA16(V1, c.kd[q][1], St[nt][q]);
#pragma unroll
            for (int e = 0; e < 4; ++e) Sl[nt * (16 * 136) + (fq * 4 + e) * 136 + (2 * w4 + q) * 16 + fr] = f2bf(St[nt][q][e]);
        }
    }
    GDN_BAR();
}
__device__ void gdn_recurrence(const Params& p, int b, unsigned char* lds) {
    const unsigned char* ws = p.ws;
    const int tid = tidx(), wave = tid >> 6, lane = tid & 63, fr = lane & 15, fq = lane >> 4;
    const int h = b >> 2, dvb = (b & 3) * 32;
    bf16_t* Sl = (bf16_t*)lds; bf16_t* vn = (bf16_t*)(lds + 2 * 16 * 136 * 2);
    float* go = (float*)(p.ws + O_PQKV);
    for (int e = tid; e < 2 * 16 * 136; e += 512) Sl[e] = 0;
    __syncthreads();
    if (wave < 4) {
        const int mt = wave;
        GdnUO f0, f1, f2;
        gdn_load_uo(ws, h, mt, fr, fq, dvb, f0); gdn_load_uo(ws, 8 + h, mt, fr, fq, dvb, f1);
        for (int n = 0; n < 255; n += 3) {
            gdn_load_uo(ws, (n + 2) * 8 + h, mt, fr, fq, dvb, f2); gdn_step_uo(f0, Sl, vn, go, n, h, mt, fr, fq, dvb);
            gdn_load_uo(ws, (n + 3) * 8 + h, mt, fr, fq, dvb, f0); gdn_step_uo(f1, Sl, vn, go, n + 1, h, mt, fr, fq, dvb);
            if (n + 4 < 256) gdn_load_uo(ws, (n + 4) * 8 + h, mt, fr, fq, dvb, f1);
            gdn_step_uo(f2, Sl, vn, go, n + 2, h, mt, fr, fq, dvb);
        }
        gdn_step_uo(f0, Sl, vn, go, 255, h, mt, fr, fq, dvb);
    } else {
        const int w4 = wave - 4;
        f32x4 St[2][2];
#pragma unroll
        for (int a = 0; a < 2; ++a)
#pragma unroll
            for (int c = 0; c < 2; ++c) St[a][c] = (f32x4){0.f, 0.f, 0.f, 0.f};
        GdnSU f0, f1, f2;
        gdn_load_su(ws, h, w4, fr, fq, f0); gdn_load_su(ws, 8 + h, w4, fr, fq, f1);
        for (int n = 0; n < 255; n += 3) {
            gdn_load_su(ws, (n + 2) * 8 + h, w4, fr, fq, f2); gdn_step_su(f0, St, Sl, vn, w4, fr, fq);
            gdn_load_su(ws, (n + 3) * 8 + h, w4, fr, fq, f0); gdn_step_su(f1, St, Sl, vn, w4, fr, fq);
            if (n + 4 < 256) gdn_load_su(ws, (n + 4) * 8 + h, w4, fr, fq, f1);
            gdn_step_su(f2, St, Sl, vn, w4, fr, fq);
        }
        gdn_step_su(f0, St, Sl, vn, w4, fr, fq);
    }
}
struct KVF { bf16x8 k[4][2]; };
__device__ __forceinline__ void kv_load(const bf16_t* kp, int ldk, KVF& f) {
#pragma unroll
    for (int s = 0; s < 4; ++s) { f.k[s][0] = *(const bf16x8*)(kp + (size_t)(s * 16) * ldk); f.k[s][1] = *(const bf16x8*)(kp + (size_t)(s * 16) * ldk + 32); }
}
template <int CTRL> __device__ __forceinline__ float dppf(float v) { return __int_as_float(__builtin_amdgcn_update_dpp(0, __float_as_int(v), CTRL, 0xF, 0xF, true)); }
template <int CTRL> __device__ __forceinline__ unsigned dppu(unsigned v) { return (unsigned)__builtin_amdgcn_update_dpp(0, (int)v, CTRL, 0xF, 0xF, true); }
__device__ __forceinline__ float rmax16(float v) { v = vmaxf(v, dppf<0xB1>(v)); v = vmaxf(v, dppf<0x4E>(v)); v = vmaxf(v, dppf<0x124>(v)); v = vmaxf(v, dppf<0x128>(v)); return v; }
__device__ __forceinline__ float rsum16(float v) { v += dppf<0xB1>(v); v += dppf<0x4E>(v); v += dppf<0x124>(v); v += dppf<0x128>(v); return v; }
template <int CTRL> __device__ __forceinline__ unsigned long long dppmax64(unsigned long long b) { const unsigned lo = dppu<CTRL>((unsigned)b), hi = dppu<CTRL>((unsigned)(b >> 32)); const unsigned long long ob = ((unsigned long long)hi << 32) | lo; return ob > b ? ob : b; }
#define MFMA8(a, b, c) __builtin_amdgcn_mfma_f32_16x16x32_fp8_fp8((a), (b), (c), 0, 0, 0)
__device__ __forceinline__ long mk64(unsigned lo, unsigned hi) { return (long)(((unsigned long long)hi << 32) | lo); }
__device__ __forceinline__ long bf8_to_fp8(bf16x8 v) {
    const u32x4 w = __builtin_bit_cast(u32x4, v);
    int a = __builtin_amdgcn_cvt_pk_fp8_f32(bflo(w.x), bfhi(w.x), 0, false); a = __builtin_amdgcn_cvt_pk_fp8_f32(bflo(w.y), bfhi(w.y), a, true);
    int b = __builtin_amdgcn_cvt_pk_fp8_f32(bflo(w.z), bfhi(w.z), 0, false); b = __builtin_amdgcn_cvt_pk_fp8_f32(bflo(w.w), bfhi(w.w), b, true);
    return mk64((unsigned)a, (unsigned)b);
}
struct K8F { u32x4 k[4]; };
__device__ __forceinline__ void k8_load(const unsigned char* kp, K8F& f) {
#pragma unroll
    for (int s = 0; s < 4; ++s) f.k[s] = *(const u32x4*)(kp + s * 1024);
}
__device__ __forceinline__ void softmax_pv(const f32x4 (&S)[4], const u32x4 (&Vw)[4], unsigned vmask, float (&m)[4], float (&l)[4], f32x4 (&O)[4], unsigned char* Pt, int fr, int fq) {
    float mx[4];
#pragma unroll
    for (int j = 0; j < 4; ++j) { float v = -1e30f;
#pragma unroll
        for (int s = 0; s < 4; ++s) v = ((vmask >> s) & 1u) ? vmaxf(v, S[s][j]) : v;
        mx[j] = rmax16(v); }
#pragma unroll
    for (int j = 0; j < 4; ++j) { const float mn = vmaxf(m[j], mx[j]); const float a = __builtin_amdgcn_exp2f(m[j] - mn); m[j] = mn; l[j] *= a;
#pragma unroll
        for (int dt = 0; dt < 4; ++dt) O[dt][j] *= a; }
#pragma unroll
    for (int j = 0; j < 4; ++j) { float pv[4];
#pragma unroll
        for (int s = 0; s < 4; ++s) { pv[s] = ((vmask >> s) & 1u) ? __builtin_amdgcn_exp2f(S[s][j] - m[j]) : 0.f; l[j] += pv[s]; }
        int t = __builtin_amdgcn_cvt_pk_fp8_f32(pv[0] * 256.f, pv[1] * 256.f, 0, false); t = __builtin_amdgcn_cvt_pk_fp8_f32(pv[2] * 256.f, pv[3] * 256.f, t, true);
        *(unsigned*)(Pt + (fq * 4 + j) * 72 + fr * 4) = (unsigned)t; }
    asm volatile("s_waitcnt lgkmcnt(0)" ::: "memory");
    const u32x2 p0 = *(const u32x2*)(Pt + fr * 72 + fq * 8), p1 = *(const u32x2*)(Pt + fr * 72 + 32 + fq * 8);
    asm volatile("s_waitcnt lgkmcnt(0)" ::: "memory");
    const long P0 = mk64(p0.x, p0.y), P1 = mk64(p1.x, p1.y);
#pragma unroll
    for (int dt = 0; dt < 4; ++dt) { O[dt] = MFMA8(P0, mk64(Vw[dt].x, Vw[dt].y), O[dt]); O[dt] = MFMA8(P1, mk64(Vw[dt].z, Vw[dt].w), O[dt]); }
}
__device__ __forceinline__ void flash_compute(const bf16x8 (&Qf)[2], KVF& f, const bf16_t* knext, int ldk, const unsigned char* vp, unsigned vmask, float (&m)[4], float (&l)[4], f32x4 (&O)[4], unsigned char* Pt, int fr, int fq) {
    f32x4 S[4]; u32x4 Vw[4];
#pragma unroll
    for (int dt = 0; dt < 4; ++dt) Vw[dt] = *(const u32x4*)(vp + dt * 1024);
#pragma unroll
    for (int s = 0; s < 4; ++s) { S[s] = (f32x4){0.f, 0.f, 0.f, 0.f}; S[s] = MFMA16(Qf[0], f.k[s][0], S[s]); S[s] = MFMA16(Qf[1], f.k[s][1], S[s]); }
    if (knext) kv_load(knext, ldk, f);
    softmax_pv(S, Vw, vmask, m, l, O, Pt, fr, fq);
}
struct V8F { u32x4 v[4]; };
__device__ __forceinline__ void v8_load(const unsigned char* vp, V8F& f) {
#pragma unroll
    for (int dt = 0; dt < 4; ++dt) f.v[dt] = *(const u32x4*)(vp + dt * 1024);
}
__device__ __forceinline__ void flash_compute8(const long (&Q8)[2], const K8F& f, const V8F& vf, unsigned vmask, float (&m)[4], float (&l)[4], f32x4 (&O)[4], unsigned char* Pt, int fr, int fq) {
    f32x4 S[4];
#pragma unroll
    for (int s = 0; s < 4; ++s) { S[s] = (f32x4){0.f, 0.f, 0.f, 0.f}; S[s] = MFMA8(Q8[0], mk64(f.k[s].x, f.k[s].y), S[s]); S[s] = MFMA8(Q8[1], mk64(f.k[s].z, f.k[s].w), S[s]); }
    softmax_pv(S, vf.v, vmask, m, l, O, Pt, fr, fq);
}
template <int BR> struct BranchIt {
    const bf16_t* kb; const unsigned char* kb8; const unsigned char* vb; const unsigned* flg; int last, trow, fr, fq;
    static constexpr int LDK = 64;
    __device__ __forceinline__ int next(int from) const {
        if (BR == 1) { int jb = from; while (jb <= last && flg[jb] == 0u) ++jb; return jb <= last ? jb : -1; }
        return from <= last ? from : -1;
    }
    __device__ __forceinline__ const unsigned char* vptr(int idx) const { return vb + (size_t)idx * 4096; }
    __device__ __forceinline__ const bf16_t* kptr(int idx) const { return kb + (size_t)(idx * 64) * LDK; }
    __device__ __forceinline__ const unsigned char* kptr8(int idx) const { return kb8 + (size_t)idx * 4096; }
    __device__ __forceinline__ unsigned mask(int idx) const {
        unsigned vm = 0; const int key0 = idx * 64;
        if (BR == 0) {
#pragma unroll
            for (int s = 0; s < 4; ++s) vm |= ((16 * (key0 + s * 16 + fr) + 31 <= trow) ? 1u : 0u) << s;
        } else if (BR == 1) {
            const bool rowsel = (flg[idx] >> fq) & 1u;
#pragma unroll
            for (int s = 0; s < 4; ++s) vm |= ((rowsel && (key0 + s * 16 + fr <= trow)) ? 1u : 0u) << s;
        } else {
#pragma unroll
            for (int s = 0; s < 4; ++s) { const int kpos = key0 + s * 16 + fr; vm |= ((kpos <= trow && kpos > trow - 512) ? 1u : 0u) << s; }
        }
        return vm;
    }
};
template <int BR> __device__ __forceinline__ void run_branch(const BranchIt<BR>& it, int first, const bf16x8 (&Qf)[2], const long (&Q8)[2], float (&m)[4], float (&l)[4], f32x4 (&O)[4], unsigned char* Pt) {
#pragma unroll
    for (int j = 0; j < 4; ++j) { m[j] = -1e30f; l[j] = 0.f; O[j] = (f32x4){0.f, 0.f, 0.f, 0.f}; }
    int ia = it.next(first);
    if (ia < 0) return;
    if (BR == 0) {
        KVF A; kv_load(it.kptr(ia), BranchIt<BR>::LDK, A);
        while (ia >= 0) {
            const int ib = it.next(ia + 1);
            flash_compute(Qf, A, ib >= 0 ? it.kptr(ib) : nullptr, BranchIt<BR>::LDK, it.vptr(ia), it.mask(ia), m, l, O, Pt, it.fr, it.fq);
            ia = ib;
        }
    } else {
        K8F kA, kB; V8F vA, vB; k8_load(it.kptr8(ia), kA); v8_load(it.vptr(ia), vA);
        for (;;) {
            const int ib = it.next(ia + 1), ibc = ib >= 0 ? ib : ia;
            k8_load(it.kptr8(ibc), kB); v8_load(it.vptr(ibc), vB);
            flash_compute8(Q8, kA, vA, it.mask(ia), m, l, O, Pt, it.fr, it.fq);
            if (ib < 0) break;
            const int ic = it.next(ib + 1), icc = ic >= 0 ? ic : ib;
            k8_load(it.kptr8(icc), kA); v8_load(it.vptr(icc), vA);
            flash_compute8(Q8, kB, vB, it.mask(ib), m, l, O, Pt, it.fr, it.fq);
            if (ic < 0) break;
            ia = ic;
        }
    }
}
__device__ __forceinline__ void branch_finish(float (&l)[4], f32x4 (&O)[4], const float* grow, int br, int hk, float* ybp  ) {
#pragma unroll
    for (int j = 0; j < 4; ++j) { const float s = rsum16(l[j]);
        const float g = sigmoidf_(grow[(hk * 4 + j) * 3 + br]) * 0.00390625f / fmaxf(s, 1e-30f);
#pragma unroll
        for (int dt = 0; dt < 4; ++dt) { float* q = ybp + j * 64 + dt * 16; if (br == 0) *q = g * O[dt][j]; else *q += g * O[dt][j]; } }
}
constexpr int NSA_WLDS = 15680;
__device__ void nsa_wave_task(const Params& p, int layer, int t0, int hk, unsigned char* wl) {
    unsigned char* ws = p.ws;
    const int lane = tidx() & 63, fr = lane & 15, fq = lane >> 4;
    float* imp = (float*)wl; unsigned* flg = (unsigned*)(wl + 4160); unsigned char* Pt = wl + 5184; float* yb = (float*)(wl + 7488);
    const bf16_t* qn = (const bf16_t*)(ws + O_QN); const unsigned char* ks8 = ws + O_KSN; const unsigned char* kw8 = ws + O_KWN;
    const unsigned char* vsT = ws + O_VST; const unsigned char* vwT = ws + O_VWT; const bf16_t* kc = (const bf16_t*)(ws + O_KC); const unsigned char* vcT = ws + O_VCT;
    const int trow = t0 + fq;
    const float* grow = (const float*)(ws + O_P32) + (size_t)trow * 1536 + 1280;
    const int tmax = t0 + 3;
    {
        bf16x8 Qf[2];
        { const bf16_t* qp = qn + (size_t)(t0 + (fr >> 2)) * 512 + (hk * 4 + (fr & 3)) * 64 + fq * 8; Qf[0] = *(const bf16x8*)qp; Qf[1] = *(const bf16x8*)(qp + 32); }
        long Q8[2]; Q8[0] = bf8_to_fp8(Qf[0]); Q8[1] = bf8_to_fp8(Qf[1]);
        float* ybp = yb + fq * 256 + fr;
        float m[4], l[4]; f32x4 O[4];
        const int ncmp_t = tmax >= 31 ? ((((tmax - 31) >> 4) >> 6) + 1) : 0;
        const bf16_t* kcb = kc + ((size_t)hk * 1024 + fr) * 64 + fq * 8;
        { BranchIt<0> it{kcb, nullptr, vcT + (size_t)hk * 16 * 4096 + fr * 64 + fq * 16, nullptr, ncmp_t - 1, trow, fr, fq}; run_branch<0>(it, 0, Qf, Q8, m, l, O, Pt); }
        float linv[4];
#pragma unroll
        for (int j = 0; j < 4; ++j) { const float s = rsum16(l[j]); linv[j] = s > 0.f ? 1.0f / s : 0.f; }
        branch_finish(l, O, grow, 0, hk, ybp);
        for (int e = lane; e < 4 * 260; e += 64) imp[e] = 0.f;
        for (int e = lane; e < 256; e += 64) flg[e] = 0u;
        asm volatile("s_waitcnt lgkmcnt(0)" ::: "memory");
        {
            KVF ka;
            if (ncmp_t > 0) kv_load(kcb, 64, ka);
            for (int kt = 0; kt < ncmp_t; ++kt) {
                const int key0 = kt * 64;
                f32x4 S[4];
#pragma unroll
                for (int s = 0; s < 4; ++s) { S[s] = (f32x4){0.f, 0.f, 0.f, 0.f}; S[s] = MFMA16(Qf[0], ka.k[s][0], S[s]); S[s] = MFMA16(Qf[1], ka.k[s][1], S[s]); }
                if (kt + 1 < ncmp_t) kv_load(kcb + (size_t)(key0 + 64) * 64, 64, ka);
#pragma unroll
                for (int s = 0; s < 4; ++s) {
                    const int nn = key0 + s * 16 + fr; const bool valid = 16 * nn + 31 <= trow;
                    float ps = 0.f;
#pragma unroll
                    for (int j = 0; j < 4; ++j) ps += valid ? __builtin_amdgcn_exp2f(S[s][j] - m[j]) * linv[j] : 0.f;
                    float p4 = ps; p4 += dppf<0xB1>(p4); p4 += dppf<0x4E>(p4);
                    if ((fr & 3) == 0) imp[fq * 260 + (nn >> 2)] += p4;
                    asm volatile("s_waitcnt lgkmcnt(0)" ::: "memory");
                    if ((fr & 3) == 3) imp[fq * 260 + (nn >> 2) + 1] += ps;
                    asm volatile("s_waitcnt lgkmcnt(0)" ::: "memory");
                }
            }
        }
#ifdef OLD_TOPK
        for (int tok = 0; tok < 4; ++tok) {
            const int t = t0 + tok, cur = t >> 6, nsel = cur + 1 < 16 ? cur + 1 : 16;
            unsigned long long key[4];
#pragma unroll
            for (int i = 0; i < 4; ++i) { const int j = lane + 64 * i; unsigned long long k = 0ull;
                if (j <= cur) { const bool forced = (j == 0) || (j == cur) || (j == cur - 1); const unsigned vb = forced ? 0x7F800000u : __float_as_uint(imp[tok * 260 + j]); k = ((unsigned long long)vb << 32) | (unsigned)(0xFFFF - j); }
                key[i] = k; }
            for (int it2 = 0; it2 < nsel; ++it2) {
                unsigned long long best = key[0]; best = key[1] > best ? key[1] : best; best = key[2] > best ? key[2] : best; best = key[3] > best ? key[3] : best;
#pragma unroll
                for (int o = 32; o >= 1; o >>= 1) { const unsigned lo = __shfl_xor((unsigned)best, o), hi = __shfl_xor((unsigned)(best >> 32), o); const unsigned long long ob = ((unsigned long long)hi << 32) | lo; best = ob > best ? ob : best; }
                const int jsel = 0xFFFF - (int)(best & 0xFFFFu);
#pragma unroll
                for (int i = 0; i < 4; ++i) if (key[i] == best) key[i] = 0ull;
                if (lane == 0) flg[jsel] |= (1u << tok);
            }
        }
#else
        {
            unsigned long long key[4][4];
#pragma unroll
            for (int tok = 0; tok < 4; ++tok) { const int cur = (t0 + tok) >> 6;
#pragma unroll
                for (int i = 0; i < 4; ++i) { const int j = lane + 64 * i; unsigned long long k = 0ull;
                    if (j <= cur) { const bool forced = (j == 0) || (j == cur) || (j == cur - 1); const unsigned vb = forced ? 0x7F800000u : __float_as_uint(imp[tok * 260 + j]); k = ((unsigned long long)vb << 32) | (unsigned)(0xFFFF - j); }
                    key[tok][i] = k; } }
            for (int itn = 0; itn < 16; ++itn) {
                unsigned long long best[4];
#pragma unroll
                for (int tok = 0; tok < 4; ++tok) { unsigned long long b0 = key[tok][0]; b0 = key[tok][1] > b0 ? key[tok][1] : b0; b0 = key[tok][2] > b0 ? key[tok][2] : b0; b0 = key[tok][3] > b0 ? key[tok][3] : b0; best[tok] = b0; }
#pragma unroll
                for (int tok = 0; tok < 4; ++tok) { best[tok] = dppmax64<0xB1>(best[tok]); best[tok] = dppmax64<0x4E>(best[tok]); best[tok] = dppmax64<0x124>(best[tok]); best[tok] = dppmax64<0x128>(best[tok]); }
#pragma unroll
                for (int o = 16; o <= 32; o <<= 1) {
#pragma unroll
                    for (int tok = 0; tok < 4; ++tok) { const unsigned lo = __shfl_xor((unsigned)best[tok], o), hi = __shfl_xor((unsigned)(best[tok] >> 32), o); const unsigned long long ob = ((unsigned long long)hi << 32) | lo; best[tok] = ob > best[tok] ? ob : best[tok]; }
                }
#pragma unroll
                for (int tok = 0; tok < 4; ++tok) {
                    if (best[tok] != 0ull) {
#pragma unroll
                        for (int i = 0; i < 4; ++i) if (key[tok][i] == best[tok]) key[tok][i] = 0ull;
                        if (lane == 0) flg[0xFFFF - (int)(best[tok] & 0xFFFFu)] |= (1u << tok);
                    }
                }
            }
        }
#endif
        asm volatile("s_waitcnt lgkmcnt(0)" ::: "memory");
        { BranchIt<1> it{nullptr, ks8 + (size_t)hk * 256 * 4096 + fr * 64 + fq * 16, vsT + (size_t)hk * 256 * 4096 + fr * 64 + fq * 16, flg, tmax >> 6, trow, fr, fq}; run_branch<1>(it, 0, Qf, Q8, m, l, O, Pt); }
        branch_finish(l, O, grow, 1, hk, ybp);
        { BranchIt<2> it{nullptr, kw8 + (size_t)hk * 256 * 4096 + fr * 64 + fq * 16, vwT + (size_t)hk * 256 * 4096 + fr * 64 + fq * 16, nullptr, tmax >> 6, trow, fr, fq}; run_branch<2>(it, t0 - 511 > 0 ? ((t0 - 511) >> 6) : 0, Qf, Q8, m, l, O, Pt); }
        branch_finish(l, O, grow, 2, hk, ybp);
    }
    asm volatile("s_waitcnt lgkmcnt(0)" ::: "memory");
    float* ysc = (float*)(ws + O_P32);
#pragma unroll
    for (int tok = 0; tok < 4; ++tok) *(f32x4*)(ysc + (size_t)(t0 + tok) * 1536 + hk * 256 + lane * 4) = *(const f32x4*)(yb + tok * 256 + lane * 4);
    asm volatile("s_waitcnt lgkmcnt(0)" ::: "memory");
}

__device__ void phase_finalize(const Params& p, int layer) {
    unsigned char* ws = p.ws;
    const int wave = tidx() >> 6, lane = tidx() & 63;
    const float* yglu = (const float*)(ws + O_YGLU); const float* go = (const float*)(ws + O_PQKV); const bf16_t* Pz = (const bf16_t*)(ws + O_PZ); bf16_t* mix = (bf16_t*)(ws + O_HN);
    const float* gs = p.in[22] + (size_t)layer * 512 + lane * 8; const float* gg = p.in[26] + (size_t)layer * 128 + (lane & 7) * 16;
    const float* gnsa = p.in[12] + (size_t)layer * 512 + lane * 8; const float* ysc = (const float*)(ws + O_P32);
    for (int t = blockIdx.x * 8 + wave; t < T_; t += gridDim.x * 8) {
        {
            const f32x4 a = *(const f32x4*)(ysc + (size_t)t * 1536 + lane * 8), b = *(const f32x4*)(ysc + (size_t)t * 1536 + lane * 8 + 4);
            float ss = a[0] * a[0] + a[1] * a[1] + a[2] * a[2] + a[3] * a[3] + b[0] * b[0] + b[1] * b[1] + b[2] * b[2] + b[3] * b[3];
            ss = wave_sum(ss); const float rs = rsqrtf(ss * (1.0f / 512.0f) + 1e-6f);
            const f32x4 g0 = *(const f32x4*)gnsa, g1 = *(const f32x4*)(gnsa + 4);
            u32x4 w; w.x = pk2(a[0] * rs * g0[0], a[1] * rs * g0[1]); w.y = pk2(a[2] * rs * g0[2], a[3] * rs * g0[3]); w.z = pk2(b[0] * rs * g1[0], b[1] * rs * g1[1]); w.w = pk2(b[2] * rs * g1[2], b[3] * rs * g1[3]);
            *(u32x4*)(mix + (size_t)t * DM + lane * 8) = w;
        }
        {
            const f32x4 a = *(const f32x4*)(yglu + (size_t)t * 512 + lane * 8), b = *(const f32x4*)(yglu + (size_t)t * 512 + lane * 8 + 4);
            float ss = a[0] * a[0] + a[1] * a[1] + a[2] * a[2] + a[3] * a[3] + b[0] * b[0] + b[1] * b[1] + b[2] * b[2] + b[3] * b[3];
            ss = wave_sum(ss); const float rs = rsqrtf(ss * (1.0f / 512.0f) + 1e-6f);
            const f32x4 g0 = *(const f32x4*)gs, g1 = *(const f32x4*)(gs + 4);
            u32x4 w; w.x = pk2(a[0] * rs * g0[0], a[1] * rs * g0[1]); w.y = pk2(a[2] * rs * g0[2], a[3] * rs * g0[3]); w.z = pk2(b[0] * rs * g1[0], b[1] * rs * g1[1]); w.w = pk2(b[2] * rs * g1[2], b[3] * rs * g1[3]);
            *(u32x4*)(mix + (size_t)t * DM + 512 + lane * 8) = w;
        }
        {
            f32x4 o[4]; float ss = 0.f;
#pragma unroll
            for (int q = 0; q < 4; ++q) { o[q] = *(const f32x4*)(go + (size_t)t * 1024 + lane * 16 + q * 4); ss += o[q][0] * o[q][0] + o[q][1] * o[q][1] + o[q][2] * o[q][2] + o[q][3] * o[q][3]; }
            ss += __shfl_xor(ss, 1); ss += __shfl_xor(ss, 2); ss += __shfl_xor(ss, 4);
            const float rs = rsqrtf(ss * (1.0f / 128.0f) + 1e-6f);
            const u32x4 z0 = *(const u32x4*)(Pz + (size_t)t * 1024 + lane * 16), z1 = *(const u32x4*)(Pz + (size_t)t * 1024 + lane * 16 + 8);
            float zz[16] = {bflo(z0.x), bfhi(z0.x), bflo(z0.y), bfhi(z0.y), bflo(z0.z), bfhi(z0.z), bflo(z0.w), bfhi(z0.w), bflo(z1.x), bfhi(z1.x), bflo(z1.y), bfhi(z1.y), bflo(z1.z), bfhi(z1.z), bflo(z1.w), bfhi(z1.w)};
            float r[16];
#pragma unroll
            for (int q = 0; q < 4; ++q) { const f32x4 g = *(const f32x4*)(gg + q * 4);
#pragma unroll
                for (int e = 0; e < 4; ++e) r[q * 4 + e] = o[q][e] * rs * g[e] * siluf_(zz[q * 4 + e]); }
            u32x4 w0, w1; w0.x = pk2(r[0], r[1]); w0.y = pk2(r[2], r[3]); w0.z = pk2(r[4], r[5]); w0.w = pk2(r[6], r[7]); w1.x = pk2(r[8], r[9]); w1.y = pk2(r[10], r[11]); w1.z = pk2(r[12], r[13]); w1.w = pk2(r[14], r[15]);
            *(u32x4*)(mix + (size_t)t * DM + 1024 + lane * 16) = w0; *(u32x4*)(mix + (size_t)t * DM + 1024 + lane * 16 + 8) = w1;
        }
    }
}

__device__ void phase_ffn_fix(const Params& p, int layer) {
    unsigned char* ws = p.ws;
    const float* hb = (const float*)(ws + O_HF); bf16_t* act = (bf16_t*)(ws + O_ACT);
    const float* cw = p.in[30] + (size_t)layer * 3 * NFF; const float* cb = p.in[31] + (size_t)layer * NFF;
    const int nitems = 256 * DFF;
    for (int it = blockIdx.x * 512 + tidx(); it < nitems; it += gridDim.x * 512) {
        const int grp = it / DFF, g = it - grp * DFF, pcol = 256 * (g >> 7) + (g & 127);
        const float* cur = hb + (size_t)grp * 4 * NFF + pcol; const float* prv = cur - (size_t)4 * NFF;
        const float gm2 = grp ? prv[2 * NFF] : 0.f, gm1 = grp ? prv[3 * NFF] : 0.f, g0v = cur[0], g1v = cur[NFF];
        const float um2 = grp ? prv[2 * NFF + 128] : 0.f, um1 = grp ? prv[3 * NFF + 128] : 0.f, u0v = cur[128], u1v = cur[NFF + 128];
        const float wg0 = cw[g], wg1 = cw[NFF + g], wg2 = cw[2 * NFF + g], bg = cb[g], wu0 = cw[DFF + g], wu1 = cw[NFF + DFF + g], wu2 = cw[2 * NFF + DFF + g], bu = cb[DFF + g];
        const float G0 = bg + wg0 * gm2 + wg1 * gm1 + wg2 * g0v, U0 = bu + wu0 * um2 + wu1 * um1 + wu2 * u0v;
        const float G1 = bg + wg0 * gm1 + wg1 * g0v + wg2 * g1v, U1 = bu + wu0 * um1 + wu1 * u0v + wu2 * u1v;
        act[(size_t)(grp * 64) * DFF + g] = f2bf(siluf_(G0) * U0);
        act[(size_t)(grp * 64 + 1) * DFF + g] = f2bf(siluf_(G1) * U1);
    }
}
#ifdef REPEAT_PHASE
constexpr int NPHT = NPH + 1;
#else
constexpr int NPHT = NPH;
#endif
#ifndef MULTI_LAUNCH
#define MULTI_LAUNCH 0
#endif
__global__ void __launch_bounds__(512) mega(Params p) {
    extern __shared__ __attribute__((aligned(16))) unsigned char smem[];
    cg::grid_group grid = cg::this_grid();
    const int b = blockIdx.x, G = gridDim.x;
    PG8_LAS unsigned char* glds = (PG8_LAS unsigned char*)smem;
    volatile XB_LAS unsigned* xst = (volatile XB_LAS unsigned*)(smem + LDS_BYTES - 32);
    if (threadIdx.x == 0) { xst[0] = 0u; xst[1] = 0u; }
    __syncthreads();
    XcdBarrier xbar; xbar.bar = (unsigned*)(p.ws + O_BAR); xbar.x = 0; xbar.st = xst;
    for (int ph = p.ph_lo; ph < p.ph_hi; ++ph) {

        #ifdef REPEAT_PHASE
        const int layer = ph / (NPH + 1), ki = ph % (NPH + 1), rep = (ki == REPEAT_PHASE + 1) ? 1 : 0; int k = ki <= REPEAT_PHASE ? ki : ki - 1;
#else
        const int layer = ph / NPH, rep = 0; int k = ph % NPH;
#endif
#ifdef DBG_ONLY
        if (k != DBG_ONLY) k = 99;
#endif
        typedef unsigned char __attribute__((address_space(1))) gu8_t;
        gu8_t* wsg = (gu8_t*)p.ws; asm volatile("" : "+s"(wsg));
        unsigned char* ws = (unsigned char*)wsg;
        int tid = threadIdx.x; asm volatile("" : "+v"(tid));
        const int wave = tid >> 6;
        bf16_t* hn = (bf16_t*)(ws + O_HN);
        Params q = p; q.ws = ws;
        if (k == 0) {
            if (ph == 0 && rep == 0 && b == 0) { if (tid < 64) ((unsigned*)(ws + O_CTR))[tid * 16] = 0u; for (int i = tid; i < XCD_BAR_WORDS; i += 512) ((unsigned*)(ws + O_BAR))[i] = 0u; }
            phase_convert(q, layer, (float*)smem);
            phase_rmsnorm(layer == 0 ? p.in[0] : p.out, p.in[1] + (size_t)layer * DM, hn, layer == 0 ? p.out : nullptr);
        } else if (k == 1) {
            pg8::Gemm g{hn, (const bf16_t*)(ws + O_WIN), T_, NIN, DM}; pg8::StaticOrder S; S.init(T_, NIN, G, b);
            EpiProj E{(float*)(ws + O_P32), (bf16_t*)(ws + O_PU), (bf16_t*)(ws + O_PQKV), (bf16_t*)(ws + O_PZ)};
            pg8::gemm_phase<EpiProj, pg8::StaticOrder, false>(glds, g, S, E, nullptr);
        } else if (k == 2) {
            for (int it = b; it < 3072; it += G) {
                if (it < 2048) gdn_prep_item(q, layer, it, smem);
                else if (it < 2304) nsa_prep_item(q, layer, it - 2048, (float*)smem);
                else if (it < 2560) s5_passA_wave(q, layer, (it - 2304) * 8 + wave, (float*)(smem + wave * 4096));
                else cmp1_wave_tile(q, layer, (it - 2560) * 8 + wave);
            }
        } else if (k == 3) {
            for (int idx = b * 8 + wave; idx < 4096; idx += G * 8) cmp2_wave_row(q, layer, idx);
            for (int it = b * 8 + wave; it < 2048; it += G * 8) s5_passB_wave(q, layer, it, (bf16_t*)(smem + wave * 8448), (float*)(smem + wave * 8448 + 4352));
        } else if (k == 4) {
#ifdef REP4_MODE
            const bool do_rec = (rep == 0) || (REP4_MODE == 1), do_glu = (rep == 0), do_nsa = (rep == 0) || (REP4_MODE == 2);
#else
            const bool do_rec = true, do_glu = true, do_nsa = true;
#endif
            if (b < 32) {
#ifndef NO_REC
 if (do_rec) gdn_recurrence(q, b, smem);
#endif
 }
            else if (b < 160 && do_glu) {
#ifndef NO_GLU
                pg8::Gemm g{(const bf16_t*)(ws + O_YGELU), (const bf16_t*)(ws + O_WGLU), T_, 512, 512}; pg8::StaticOrder S; S.init(T_, 512, 128, b - 32);
                EpiGlu E{(const bf16_t*)(ws + O_YGELU), (float*)(ws + O_YGLU)};
                pg8::gemm_phase<EpiGlu, pg8::StaticOrder, false>(glds, g, S, E, nullptr);
#endif
            }
            __syncthreads();
            unsigned* ctr = (unsigned*)(ws + O_CTR) + (layer * 2 + rep) * 16;
            volatile int* sidx = (volatile int*)(smem + LDS_BYTES - 16);
#ifndef NO_NSA
            if (do_nsa) for (;;) {
                if (tid == 0) *sidx = (int)atomicAdd(ctr, 1u);
                __syncthreads();
                const int idx = *sidx;
                __syncthreads();
                if (idx >= 1024) break;
                nsa_wave_task(q, layer, (511 - (idx & 511)) * 32 + wave * 4, idx >> 9, smem + wave * NSA_WLDS);
            }
#endif
        } else if (k == 5) {
            phase_finalize(q, layer);
        } else if (k == 6) {
            pg8::Gemm g{hn, (const bf16_t*)(ws + O_WOUT), T_, DM, DM}; pg8::StaticOrder S; S.init(T_, DM, G, b);
            EpiResid E{p.out, DM};
            pg8::gemm_phase<EpiResid, pg8::StaticOrder, false>(glds, g, S, E, nullptr);
        } else if (k == 7) {
            phase_rmsnorm(p.out, p.in[28] + (size_t)layer * DM, hn, nullptr);
        } else if (k == 8) {
            pg8::Gemm g{hn, (const bf16_t*)(ws + O_WFIN), T_, NFF, DM}; pg8::StaticOrder S; S.init(T_, NFF, G, b);
            EpiFfnAct E{(bf16_t*)(ws + O_ACT), (float*)(ws + O_HF), q.in[30] + (size_t)layer * 3 * NFF, q.in[31] + (size_t)layer * NFF};
            pg8::gemm_phase<EpiFfnAct, pg8::StaticOrder, false>(glds, g, S, E, nullptr);
        } else if (k == 9) {
            phase_ffn_fix(q, layer);
        } else if (k == 10) {
            pg8::Gemm g{(const bf16_t*)(ws + O_ACT), (const bf16_t*)(ws + O_WFOUT), T_, DM, DFF}; pg8::StaticOrder S; S.init(T_, DM, G, b);
            EpiResid E{p.out, DM};
            pg8::gemm_phase<EpiResid, pg8::StaticOrder, false>(glds, g, S, E, nullptr);
        }
        __syncthreads();
        if (ph + 1 < p.ph_hi) {
            if (ph == p.ph_lo) { grid.sync(); xbar = xcd_barrier_post((unsigned*)(p.ws + O_BAR), xst); }
            else xcd_barrier(xbar);
        }
    }
}

extern "C" void kernel_launch(void* const* d_in, const int* in_sizes, int n_in, void* d_out, int out_size, void* d_ws, size_t ws_size, hipStream_t stream) {
    static int grid_blocks = 0;
    if (!grid_blocks) {
        if (n_in != 33 || out_size != T_ * DM || ws_size < WS_NEED) { fprintf(stderr, "kernel_launch: unexpected shapes or workspace (%d inputs, out %d, ws %zu < %zu)\n", n_in, out_size, ws_size, (size_t)WS_NEED); grid_blocks = -1; return; }
        int dev = 0, cus = 0, per_cu = 0;
        hipGetDevice(&dev);
        hipDeviceGetAttribute(&cus, hipDeviceAttributeMultiprocessorCount, dev);
        if (hipFuncSetAttribute((const void*)mega, hipFuncAttributeMaxDynamicSharedMemorySize, LDS_BYTES) != hipSuccess) { fprintf(stderr, "kernel_launch: hipFuncSetAttribute failed\n"); grid_blocks = -1; return; }
        hipOccupancyMaxActiveBlocksPerMultiprocessor(&per_cu, (const void*)mega, 512, LDS_BYTES);
        (void)hipGetLastError();
        if (per_cu < 1) per_cu = 1;
        grid_blocks = cus * per_cu; if (grid_blocks > 256) grid_blocks = 256;
        if (grid_blocks < 160) { fprintf(stderr, "kernel_launch: grid %d too small\n", grid_blocks); grid_blocks = -1; return; }
    }
    if (grid_blocks < 0) return;
    Params p{};
    for (int i = 0; i < 33; ++i) p.in[i] = (const float*)d_in[i];
    p.out = (float*)d_out; p.ws = (unsigned char*)d_ws;
#if MULTI_LAUNCH
    for (int ph = 0; ph < 2 * NPHT; ++ph) { p.ph_lo = ph; p.ph_hi = ph + 1; hipLaunchKernelGGL(mega, dim3(grid_blocks), dim3(512), LDS_BYTES, stream, p); }
#else
    p.ph_lo = 0; p.ph_hi = 2 * NPHT;
    void* args[] = {&p};
    hipError_t e = hipLaunchCooperativeKernel((const void*)mega, dim3(grid_blocks), dim3(512), args, LDS_BYTES, stream);
    if (e != hipSuccess) fprintf(stderr, "cooperative launch failed: %s (grid %d)\n", hipGetErrorString(e), grid_blocks);
#endif
}
```

```cpp
#include <hip/hip_runtime.h>
#include <hip/hip_cooperative_groups.h>
#include <cstdio>
namespace cg = cooperative_groups;
__device__ __forceinline__ int tidx() { int t = threadIdx.x; asm volatile("" : "+v"(t)); return t; }
namespace pg8 {
#define PG8_LAS __attribute__((address_space(3)))
typedef unsigned short bf16_t;
typedef short bf16x8 __attribute__((ext_vector_type(8)));
typedef float f32x4 __attribute__((ext_vector_type(4)));
typedef unsigned u32x4 __attribute__((ext_vector_type(4)));
constexpr int BM = 256, BK = 64, HALF = 128, HTB = HALF * BK * 2  , STAGE_BYTES = 8 * HTB, NXCD = 8, WGM = 8;

__host__ __device__ __forceinline__ int lds_byte(int r, int c) { const int st = (r >> 4) * 2 + (c >> 5), rr = r & 15, cc = c & 31, ob = rr * 64 + cc * 2; return st * 1024 + (ob ^ (((ob >> 9) & 1) << 5)); }
__host__ __device__ __forceinline__ void stage_rc(int b, int& R, int& C) { const int st = b / 1024, sb = b % 1024, swz = sb ^ (((sb >> 9) & 1) << 5); R = (st >> 1) * 16 + swz / 64; C = (st & 1) * 32 + (swz % 64) / 2; }
__host__ __device__ __forceinline__ int perm32(int rho) { const int n = rho >> 4, i = rho & 15; return 8 * (i >> 2) + 4 * n + (i & 3); }

struct Unit { int pm, pn; };
struct Gemm { const bf16_t* A; const bf16_t* Bt; int M, N, K; };

struct StaticOrder {
    int nM, nN, nwg, G, c;
    __host__ __device__ void init(int M, int N, int G_, int c_) { nM = M / BM; nN = N / BM; nwg = nM * nN; G = G_; c = c_; }
    __host__ __device__ bool next(int i, Unit& u) const {
        const long L = (long)i * G + c; if (L >= nwg) return false;
        int wgid = (int)L; { const int q = nwg / NXCD, r = nwg % NXCD, xcd = wgid % NXCD, off = wgid / NXCD; wgid = (xcd < r ? xcd * (q + 1) : r * (q + 1) + (xcd - r) * q) + off; }
        const int nig = WGM * nN, gid = wgid / nig, fm = gid * WGM, gsz = (nM - fm) < WGM ? (nM - fm) : WGM;
        u.pm = fm + ((wgid % nig) % gsz); u.pn = (wgid % nig) / gsz; return true;
    }
    __device__ __forceinline__ void a_ready(const Unit&) const {}
    __device__ __forceinline__ void done(const Unit&) const {}
};
__device__ __forceinline__ unsigned cvt_pk_bf16(float lo, float hi) { unsigned r; asm volatile("v_cvt_pk_bf16_f32 %0, %1, %2" : "=v"(r) : "v"(lo), "v"(hi)); return r; }
template <class Epi, class Sched, bool STAMP = false>
__device__ __forceinline__ void gemm_phase(PG8_LAS unsigned char* lds, const Gemm g, const Sched& S, const Epi& E, unsigned long long* stamps) {
    const int tid = tidx(), wid = __builtin_amdgcn_readfirstlane(tid >> 6), lane = tid & 63, wr = wid >> 2, wc = wid & 3, fr = lane & 15, fq = lane >> 4;
    const int K = g.K, nt = K / BK;
    int ts_lo = 0, ts_hi = 0, nts = 0; const unsigned long long rt_entry = STAMP ? (unsigned long long)wall_clock64() : 0ull;
#define PG8_STAMP() do { if (STAMP && wid == 0 && nts < 64) { const unsigned long long _c = (unsigned long long)clock64(); \
        ts_lo = (lane == nts) ? (int)(unsigned)_c : ts_lo; ts_hi = (lane == nts) ? (int)(unsigned)(_c >> 32) : ts_hi; ++nts; } } while (0)
    PG8_STAMP();
    unsigned voffA[2], voffB[2];
#pragma unroll
    for (int i = 0; i < 2; ++i) { int R, C; stage_rc(tid * 16 + i * 8192, R, C); const int Rb = Epi::PERM ? ((R & ~31) + perm32(R & 31)) : R;
        voffA[i] = (unsigned)(R * K + C) * 2u; voffB[i] = (unsigned)(Rb * K + C) * 2u; }
    const size_t kstep = (size_t)(BK * 2);
    const size_t hstep = (size_t)HALF * K * 2;
    const size_t tstep = 2 * hstep;
    const unsigned ldsw = (unsigned)wid * 1024u;
    const int aoff = lds_byte(wr * 64 + fr, fq * 8), boff = lds_byte(wc * 32 + fr, fq * 8);
#define PG8_SA(b, h) (((b) * 2 + (h)) * HTB)
#define PG8_SB(b, h) ((4 + (b) * 2 + (h)) * HTB)
#define PG8_STAGE(bufoff, gbase, voff) do { _Pragma("unroll") for (int _i = 0; _i < 2; ++_i) \
        __builtin_amdgcn_global_load_lds((const unsigned*)((const char*)(gbase) + (voff)[_i]), (PG8_LAS unsigned*)(lds + (bufoff) + ldsw + _i * 8192), 16, 0, 0); } while (0)
#define PG8_LDA(dst, b, h) do { _Pragma("unroll") for (int m = 0; m < 4; ++m) _Pragma("unroll") for (int k = 0; k < 2; ++k) dst[m][k] = *(const PG8_LAS bf16x8*)(lds + PG8_SA(b, h) + aoff + m * 2048 + k * 1024); } while (0)
#define PG8_LDB(dst, b, h) do { _Pragma("unroll") for (int n = 0; n < 2; ++n) _Pragma("unroll") for (int k = 0; k < 2; ++k) dst[n][k] = *(const PG8_LAS bf16x8*)(lds + PG8_SB(b, h) + boff + n * 2048 + k * 1024); } while (0)
#define PG8_MMA(ai, bj, At, Bt) do { __builtin_amdgcn_s_setprio(1); _Pragma("unroll") for (int m = 0; m < 4; ++m) _Pragma("unroll") for (int n = 0; n < 2; ++n) _Pragma("unroll") for (int k = 0; k < 2; ++k) \
        acc[ai][bj][m][n] = __builtin_amdgcn_mfma_f32_16x16x32_bf16(Bt[n][k], At[m][k], acc[ai][bj][m][n], 0, 0, 0); __builtin_amdgcn_s_setprio(0); } while (0)
#define PG8_WAIT_V(n) asm volatile("s_waitcnt vmcnt(" #n ")" ::: "memory")
#define PG8_WAIT_L(n) asm volatile("s_waitcnt lgkmcnt(" #n ")" ::: "memory")
#define PG8_BAR __builtin_amdgcn_s_barrier()
#define PG8_SCHED __builtin_amdgcn_sched_barrier(0)
    Unit cur, nxt; int ui = 0;
    if (!S.next(0, cur)) return;
    f32x4 acc[2][2][4][2];
#pragma unroll
    for (int a = 0; a < 2; ++a)
#pragma unroll
        for (int b = 0; b < 2; ++b)
#pragma unroll
            for (int m = 0; m < 4; ++m)
#pragma unroll
                for (int n = 0; n < 2; ++n) acc[a][b][m][n] = (f32x4){0.f, 0.f, 0.f, 0.f};
    bf16x8 At[4][2], B0[2][2], B1[2][2];
    const char* cA = (const char*)g.A + (size_t)cur.pm * tstep; const char* cB = (const char*)g.Bt + (size_t)cur.pn * tstep;
    S.a_ready(cur);
    PG8_STAGE(PG8_SB(0, 0), cB, voffB); PG8_STAGE(PG8_SA(0, 0), cA, voffA); PG8_STAGE(PG8_SB(0, 1), cB + hstep, voffB); PG8_STAGE(PG8_SA(0, 1), cA + hstep, voffA);
    if (wr == 1) PG8_BAR;
    PG8_WAIT_V(4); PG8_BAR;
    PG8_STAGE(PG8_SB(1, 0), cB + kstep, voffB); PG8_STAGE(PG8_SA(1, 0), cA + kstep, voffA); PG8_STAGE(PG8_SB(1, 1), cB + hstep + kstep, voffB);
    PG8_WAIT_V(6); PG8_BAR;
    PG8_STAMP();
    for (;;) {
        const bool has_next = S.next(ui + 1, nxt);
        const char* nA = has_next ? (const char*)g.A + (size_t)nxt.pm * tstep : cA; const char* nB = has_next ? (const char*)g.Bt + (size_t)nxt.pn * tstep : cB;
        for (int t = 0; t < nt; t += 2) {
            const bool last = (t == nt - 2);
            const char* a1 = cA + (size_t)(t + 1) * kstep;
            const char* a2 = last ? nA : cA + (size_t)(t + 2) * kstep; const char* b2 = last ? nB : cB + (size_t)(t + 2) * kstep;
            const char* a3 = a2 + kstep; const char* b3 = b2 + kstep;
            if (last && has_next) S.a_ready(nxt);
            PG8_LDB(B0, 0, 0); PG8_SCHED; PG8_LDA(At, 0, 0); PG8_STAGE(PG8_SA(1, 1), a1 + hstep, voffA);
            PG8_WAIT_L(8); PG8_BAR; PG8_WAIT_L(0); PG8_MMA(0, 0, At, B0); PG8_BAR; PG8_SCHED;
            PG8_LDB(B1, 0, 1); PG8_STAGE(PG8_SB(0, 0), b2, voffB);
            PG8_BAR; PG8_WAIT_L(0); PG8_MMA(0, 1, At, B1); PG8_BAR;
            PG8_LDA(At, 0, 1); PG8_STAGE(PG8_SA(0, 0), a2, voffA);
            PG8_BAR; PG8_WAIT_L(0); PG8_MMA(1, 0, At, B0); PG8_BAR; PG8_SCHED;
            PG8_STAGE(PG8_SB(0, 1), b2 + hstep, voffB);
            PG8_WAIT_V(6); PG8_BAR; PG8_MMA(1, 1, At, B1); PG8_BAR;
            PG8_LDB(B0, 1, 0); PG8_SCHED; PG8_LDA(At, 1, 0); PG8_STAGE(PG8_SA(0, 1), a2 + hstep, voffA);
            PG8_WAIT_L(8); PG8_BAR; PG8_WAIT_L(0); PG8_MMA(0, 0, At, B0); PG8_BAR; PG8_SCHED;
            PG8_LDB(B1, 1, 1); PG8_STAGE(PG8_SB(1, 0), b3, voffB);
            PG8_BAR; PG8_WAIT_L(0); PG8_MMA(0, 1, At, B1); PG8_BAR;
            PG8_LDA(At, 1, 1); PG8_STAGE(PG8_SA(1, 0), a3, voffA);
            PG8_BAR; PG8_WAIT_L(0); PG8_MMA(1, 0, At, B0); PG8_BAR; PG8_SCHED;
            PG8_STAGE(PG8_SB(1, 1), b3 + hstep, voffB);
            PG8_WAIT_V(6); PG8_BAR; PG8_MMA(1, 1, At, B1); PG8_BAR;
        }
        PG8_STAMP();
        if constexpr (!Epi::AFTER_DRAIN) { E(acc, cur, wr, wc, fr, fq); S.done(cur); }
        PG8_STAMP();
        if (!has_next) break;
#pragma unroll
        for (int a = 0; a < 2; ++a)
#pragma unroll
            for (int b = 0; b < 2; ++b)
#pragma unroll
                for (int m = 0; m < 4; ++m)
#pragma unroll
                    for (int n = 0; n < 2; ++n) acc[a][b][m][n] = (f32x4){0.f, 0.f, 0.f, 0.f};
        cur = nxt; cA = nA; cB = nB; ++ui;
    }
    PG8_WAIT_V(0);
    if (wr == 0) PG8_BAR;
    PG8_BAR;
    if constexpr (Epi::AFTER_DRAIN) { E.fused(acc, cur, wr, wc, fr, fq, lds, wid, lane); S.done(cur); }
    PG8_STAMP();
    if (STAMP && wid == 0) { stamps[lane] = lane < nts ? (((unsigned long long)(unsigned)ts_hi << 32) | (unsigned)ts_lo) : 0ull;
        if (lane == 62) stamps[62] = rt_entry; if (lane == 63) stamps[63] = (unsigned long long)wall_clock64(); }
#undef PG8_STAMP
#undef PG8_SA
#undef PG8_SB
#undef PG8_STAGE
#undef PG8_LDA
#undef PG8_LDB
#undef PG8_MMA
#undef PG8_WAIT_V
#undef PG8_WAIT_L
#undef PG8_BAR
#undef PG8_SCHED
}
}
#define XB_TMO      128
#define XB_XCNT(j)  (256  + 64 * (j))
#define XB_XSUB(j)  (1280 + 64 * (j))
#define XB_XGEN(j)  (2304 + 64 * (j))
#define XB_TOP      3328
#define XB_TOPGEN   3392
#define XCD_BAR_WORDS 3456
#define XB_SPIN_CAP (1u << 18)
#define XB_LAS __attribute__((address_space(3)))

__device__ __forceinline__ unsigned xb_ld(unsigned* p)              { return __hip_atomic_load(p, __ATOMIC_RELAXED, __HIP_MEMORY_SCOPE_AGENT); }
__device__ __forceinline__ unsigned xb_add(unsigned* p, unsigned v) { return __hip_atomic_fetch_add(p, v, __ATOMIC_RELAXED, __HIP_MEMORY_SCOPE_AGENT); }
__device__ __forceinline__ unsigned xb_xcc_id() { return (unsigned)__builtin_amdgcn_s_getreg((3 << 11) | 20) & 0xFu; }
#define XB_SPIN(cond, bar) do { unsigned _sp = 0; while (cond) { __builtin_amdgcn_s_sleep(1); \
    if ((++_sp & 255u) == 0u) { if (xb_ld(&(bar)[XB_TMO])) break; if (_sp > XB_SPIN_CAP) { atomicAdd(&(bar)[XB_TMO], 1u); break; } } } } while (0)

struct XcdBarrier {
    unsigned* bar; unsigned x;
    volatile XB_LAS unsigned* st;
};

__device__ __forceinline__ XcdBarrier xcd_barrier_post(unsigned* bar, volatile XB_LAS unsigned* st) {
    XcdBarrier b; b.bar = bar; b.x = xb_xcc_id(); b.st = st;
    if (threadIdx.x == 0) (void)xb_add(&bar[XB_XCNT(b.x)], 1u);
    return b;
}
__device__ __forceinline__ void xcd_barrier_complete(unsigned* bar, unsigned x, unsigned& nloc, unsigned& nx) {
    const unsigned G = gridDim.x * gridDim.y * gridDim.z;
    unsigned sum, cnt, mine, sp = 0u;
    for (;;) {
        sum = 0u; cnt = 0u; mine = 0u;
#pragma unroll
        for (unsigned j = 0; j < 16; ++j) { const unsigned c = xb_ld(&bar[XB_XCNT(j)]); sum += c; cnt += (c > 0u) ? 1u : 0u; mine = (j == x) ? c : mine; }
        if (sum == G) break;
        __builtin_amdgcn_s_sleep(1);
        if ((++sp & 255u) == 0u) { if (xb_ld(&bar[XB_TMO])) break; if (sp > XB_SPIN_CAP) { atomicAdd(&bar[XB_TMO], 1u); break; } }
    }
    nloc = mine > 0u ? mine : 1u; nx = cnt > 0u ? cnt : 1u;
}

__device__ __forceinline__ void xcd_barrier(const XcdBarrier& b) {
    asm volatile("s_waitcnt vmcnt(0)" ::: "memory");
    __syncthreads();
    if (threadIdx.x == 0) {
        unsigned* bar = b.bar;
        __builtin_amdgcn_s_waitcnt(0);
        unsigned nloc = b.st[0], nx = b.st[1];
        if (nloc == 0u) { xcd_barrier_complete(bar, b.x, nloc, nx); b.st[0] = nloc; b.st[1] = nx; }
        const unsigned old = xb_add(&bar[XB_XSUB(b.x)], 1u);
        const unsigned gen = old / nloc;
        if (old + 1u == (gen + 1u) * nloc) {
            __builtin_amdgcn_fence(__ATOMIC_RELEASE, "agent");
            asm volatile("s_waitcnt vmcnt(0)" ::: "memory");
            const unsigned og = xb_add(&bar[XB_TOP], 1u);
            const unsigned tg = og / nx;
            if (og + 1u == (tg + 1u) * nx) xb_add(&bar[XB_TOPGEN], 1u);
            else XB_SPIN(xb_ld(&bar[XB_TOPGEN]) == tg, bar);
            __builtin_amdgcn_fence(__ATOMIC_ACQUIRE, "agent");
            xb_add(&bar[XB_XGEN(b.x)], 1u);
            asm volatile("s_waitcnt vmcnt(0)" ::: "memory");
        } else {
            XB_SPIN(xb_ld(&bar[XB_XGEN(b.x)]) == gen, bar);
            __builtin_amdgcn_fence(__ATOMIC_ACQUIRE, "agent");
            asm volatile("s_waitcnt vmcnt(0)" ::: "memory");
        }
    }
    __syncthreads();
}
using pg8::bf16_t; using pg8::bf16x8; using pg8::f32x4; using pg8::u32x4; using pg8::Unit;
typedef unsigned u32x2 __attribute__((ext_vector_type(2)));
#define MFMA16(a, b, c) __builtin_amdgcn_mfma_f32_16x16x32_bf16((a), (b), (c), 0, 0, 0)

constexpr int T_ = 16384, DM = 2048, NIN = 6144, DFF = 5504, NFF = 11008;
constexpr int LDS_BYTES = 144 * 1024;
constexpr int NPH = 11;

constexpr size_t O_CTR   = 0;
constexpr size_t O_BAR   = 4096;
constexpr size_t O_WIN   = 4096 + 16384;
constexpr size_t O_WOUT  = O_WIN   + (size_t)NIN * DM * 2;
constexpr size_t O_WFIN  = O_WOUT  + (size_t)DM * DM * 2;
constexpr size_t O_WFOUT = O_WFIN  + (size_t)NFF * DM * 2;
constexpr size_t O_WCK   = O_WFOUT + (size_t)DM * DFF * 2;
constexpr size_t O_WCV   = O_WCK   + (size_t)256 * 2048 * 2;
constexpr size_t O_WGLU  = O_WCV   + (size_t)256 * 2048 * 2;
constexpr size_t O_HN    = O_WGLU  + (size_t)512 * 512 * 2;
constexpr size_t O_R     = O_HN    + (size_t)T_ * DM * 2;
constexpr size_t O_P32   = O_R;
constexpr size_t O_PU    = O_P32   + (size_t)T_ * 1536 * 4;
constexpr size_t O_PQKV  = O_PU    + (size_t)T_ * 512 * 2;
constexpr size_t O_PZ    = O_PQKV  + (size_t)T_ * 3072 * 2;
constexpr size_t O_QN    = O_PZ    + (size_t)T_ * 1024 * 2;
constexpr size_t O_KSN   = O_QN    + (size_t)T_ * 512 * 2;
constexpr size_t O_KWN   = O_KSN   + (size_t)T_ * 128 * 2;
constexpr size_t O_VST   = O_KWN   + (size_t)T_ * 128 * 2;
constexpr size_t O_VWT   = O_VST   + (size_t)T_ * 128 * 2;
constexpr size_t O_KC    = O_VWT   + (size_t)T_ * 128 * 2;
constexpr size_t O_VCT   = O_KC    + (size_t)2 * 1024 * 64 * 2;
constexpr size_t O_HCMP  = O_VCT   + (size_t)2 * 64 * 1024 * 2;
constexpr size_t O_GKC   = O_HCMP  + (size_t)2 * 2048 * 256 * 4;
constexpr size_t O_GQG   = O_GKC   + (size_t)2048 * 64 * 128 * 2;
constexpr size_t O_GQK   = O_GQG   + (size_t)2048 * 64 * 128 * 2;
constexpr size_t O_GKD   = O_GQK   + (size_t)2048 * 64 * 64 * 2;
constexpr size_t O_GVAL  = O_GKD   + (size_t)2048 * 64 * 128 * 2;
constexpr size_t O_GEGL  = O_GVAL  + (size_t)2048 * 64 * 128 * 4;
constexpr size_t O_XEND  = O_GEGL  + 8192;
constexpr size_t O_YGELU = O_XEND  + (size_t)64 * 32 * 64 * 2 * 4;
constexpr size_t O_YGLU  = O_YGELU + (size_t)T_ * 512 * 2;
constexpr size_t O_ATT_END = O_YGLU + (size_t)T_ * 512 * 4;
constexpr size_t O_HF    = O_R;
constexpr size_t O_ACT   = O_HF    + (size_t)256 * 4 * NFF * 4;
constexpr size_t O_FFN_END = O_ACT + (size_t)T_ * DFF * 2;
constexpr size_t WS_NEED = O_ATT_END > O_FFN_END ? O_ATT_END : O_FFN_END;

struct Params { const float* in[33]; float* out; unsigned char* ws; int ph_lo, ph_hi; };

__device__ __forceinline__ unsigned short f2bf(float f) { unsigned u = __float_as_uint(f); u += 0x7FFFu + ((u >> 16) & 1u); return (unsigned short)(u >> 16); }
__device__ __forceinline__ float bf2f(unsigned short b) { return __uint_as_float(((unsigned)b) << 16); }
__device__ __forceinline__ unsigned pk2(float lo, float hi) { return pg8::cvt_pk_bf16(lo, hi); }
__device__ __forceinline__ float bflo(unsigned w) { return __uint_as_float(w << 16); }
__device__ __forceinline__ float bfhi(unsigned w) { return __uint_as_float(w & 0xFFFF0000u); }
__device__ __forceinline__ float sigmoidf_(float x) { return __builtin_amdgcn_rcpf(1.0f + __expf(-x)); }
__device__ __forceinline__ float siluf_(float x) { return x * __builtin_amdgcn_rcpf(1.0f + __expf(-x)); }
__device__ __forceinline__ float vmaxf(float a, float b) { float r; asm("v_max_f32 %0, %1, %2" : "=v"(r) : "v"(a), "v"(b)); return r; }
__device__ __forceinline__ float gelu_tanh(float x) { const float u = 0.7978845608028654f * (x + 0.044715f * x * x * x); const float th = 1.0f - 2.0f * __builtin_amdgcn_rcpf(__expf(2.0f * u) + 1.0f); return 0.5f * x * (1.0f + th); }
__device__ __forceinline__ float softplusf_(float x) { return x > 20.f ? x : log1pf(expf(x)); }
__device__ __forceinline__ float wave_sum(float v) { for (int o = 32; o >= 1; o >>= 1) v += __shfl_xor(v, o); return v; }
__device__ __forceinline__ bf16x8 pack8f(f32x4 a, f32x4 b) { u32x4 w; w.x = pk2(a[0], a[1]); w.y = pk2(a[2], a[3]); w.z = pk2(b[0], b[1]); w.w = pk2(b[2], b[3]); return __builtin_bit_cast(bf16x8, w); }
__device__ __forceinline__ float rdlane(float v, int l) { return __int_as_float(__builtin_amdgcn_readlane(__float_as_int(v), l)); }

struct EpiProj {
    static constexpr bool PERM = true, AFTER_DRAIN = false;
    float* P32; bf16_t* Pu; bf16_t* Pqkv; bf16_t* Pz;
    static __device__ __forceinline__ void st_bf(const f32x4 (&acc)[2][2][4][2], bf16_t* base, int ld) {
#pragma unroll
        for (int ai = 0; ai < 2; ++ai)
#pragma unroll
            for (int m = 0; m < 4; ++m) { bf16_t* rp = base + (size_t)(ai * 128 + m * 16) * ld;
#pragma unroll
                for (int bj = 0; bj < 2; ++bj) { const f32x4 v0 = acc[ai][bj][m][0], v1 = acc[ai][bj][m][1]; u32x4 w; w.x = pk2(v0[0], v0[1]); w.y = pk2(v0[2], v0[3]); w.z = pk2(v1[0], v1[1]); w.w = pk2(v1[2], v1[3]); *(u32x4*)(rp + bj * 128) = w; } }
    }
    __device__ __forceinline__ void operator()(const f32x4 (&acc)[2][2][4][2], const Unit& u, int wr, int wc, int fr, int fq) const {
        const int row0 = u.pm * 256 + wr * 64 + fr, colt = wc * 32 + 8 * fq;
        if (u.pn < 6) {
            float* base = P32 + (size_t)row0 * 1536 + u.pn * 256 + colt;
#pragma unroll
            for (int ai = 0; ai < 2; ++ai)
#pragma unroll
                for (int m = 0; m < 4; ++m) { float* rp = base + (size_t)(ai * 128 + m * 16) * 1536;
#pragma unroll
                    for (int bj = 0; bj < 2; ++bj) { *(f32x4*)(rp + bj * 128) = acc[ai][bj][m][0]; *(f32x4*)(rp + bj * 128 + 4) = acc[ai][bj][m][1]; } }
        } else if (u.pn < 8)  st_bf(acc, Pu   + (size_t)row0 * 512  + (u.pn - 6)  * 256 + colt, 512);
        else if (u.pn < 20)   st_bf(acc, Pqkv + (size_t)row0 * 3072 + (u.pn - 8)  * 256 + colt, 3072);
        else                  st_bf(acc, Pz   + (size_t)row0 * 1024 + (u.pn - 20) * 256 + colt, 1024);
    }
};
struct EpiResid {
    static constexpr bool PERM = false, AFTER_DRAIN = false;
    float* X; int ld;
    __device__ __forceinline__ void operator()(const f32x4 (&acc)[2][2][4][2], const Unit& u, int wr, int wc, int fr, int fq) const {
        float* base = X + (size_t)(u.pm * 256 + wr * 64 + fr) * ld + u.pn * 256 + wc * 32 + 4 * fq;
#pragma unroll
        for (int ai = 0; ai < 2; ++ai)
#pragma unroll
            for (int m = 0; m < 4; ++m) { float* rp = base + (size_t)(ai * 128 + m * 16) * ld;
#pragma unroll
                for (int bj = 0; bj < 2; ++bj)
#pragma unroll
                    for (int n = 0; n < 2; ++n) { f32x4* q = (f32x4*)(rp + bj * 128 + n * 16); *q = *q + acc[ai][bj][m][n]; } }
    }
};
struct EpiBf {
    static constexpr bool PERM = true, AFTER_DRAIN = false;
    bf16_t* O; int ld;
    __device__ __forceinline__ void operator()(const f32x4 (&acc)[2][2][4][2], const Unit& u, int wr, int wc, int fr, int fq) const {
        bf16_t* base = O + (size_t)(u.pm * 256 + wr * 64 + fr) * ld + u.pn * 256 + wc * 32 + 8 * fq;
#pragma unroll
        for (int ai = 0; ai < 2; ++ai)
#pragma unroll
            for (int m = 0; m < 4; ++m) { bf16_t* rp = base + (size_t)(ai * 128 + m * 16) * ld;
#pragma unroll
                for (int bj = 0; bj < 2; ++bj) { const f32x4 v0 = acc[ai][bj][m][0], v1 = acc[ai][bj][m][1]; u32x4 w; w.x = pk2(v0[0], v0[1]); w.y = pk2(v0[2], v0[3]); w.z = pk2(v1[0], v1[1]); w.w = pk2(v1[2], v1[3]); *(u32x4*)(rp + bj * 128) = w; } }
    }
};
struct EpiGlu {
    static constexpr bool PERM = false, AFTER_DRAIN = false;
    const bf16_t* Y; float* O;
    __device__ __forceinline__ void operator()(const f32x4 (&acc)[2][2][4][2], const Unit& u, int wr, int wc, int fr, int fq) const {
        const size_t off0 = (size_t)(u.pm * 256 + wr * 64 + fr) * 512 + u.pn * 256 + wc * 32 + 4 * fq;
#pragma unroll
        for (int ai = 0; ai < 2; ++ai)
#pragma unroll
            for (int m = 0; m < 4; ++m) { const size_t ro = off0 + (size_t)(ai * 128 + m * 16) * 512;
#pragma unroll
                for (int bj = 0; bj < 2; ++bj)
#pragma unroll
                    for (int n = 0; n < 2; ++n) { const size_t o = ro + bj * 128 + n * 16; const u32x2 yw = *(const u32x2*)(Y + o); const f32x4 a = acc[ai][bj][m][n];
                        f32x4 r; r[0] = bflo(yw.x) * sigmoidf_(a[0]); r[1] = bfhi(yw.x) * sigmoidf_(a[1]); r[2] = bflo(yw.y) * sigmoidf_(a[2]); r[3] = bfhi(yw.y) * sigmoidf_(a[3]); *(f32x4*)(O + o) = r; } }
    }
};

template <int CTRL> __device__ __forceinline__ f32x4 ror4(const f32x4 v) { f32x4 r;
    r[0] = __int_as_float(__builtin_amdgcn_update_dpp(0, __float_as_int(v[0]), CTRL, 0xF, 0xF, true)); r[1] = __int_as_float(__builtin_amdgcn_update_dpp(0, __float_as_int(v[1]), CTRL, 0xF, 0xF, true));
    r[2] = __int_as_float(__builtin_amdgcn_update_dpp(0, __float_as_int(v[2]), CTRL, 0xF, 0xF, true)); r[3] = __int_as_float(__builtin_amdgcn_update_dpp(0, __float_as_int(v[3]), CTRL, 0xF, 0xF, true)); return r; }
struct EpiFfnAct {
    static constexpr bool PERM = true, AFTER_DRAIN = false;
    bf16_t* act; float* hb; const float* cw; const float* cb;
    __device__ __forceinline__ void operator()(const f32x4 (&acc)[2][2][4][2], const Unit& u, int wr, int wc, int fr, int fq) const {
        const int colg = 128 * u.pn + wc * 32 + 8 * fq;
#pragma unroll
        for (int n = 0; n < 2; ++n) {
            const int g0 = colg + 4 * n;
            const f32x4 wg0 = *(const f32x4*)(cw + g0), wg1 = *(const f32x4*)(cw + NFF + g0), wg2 = *(const f32x4*)(cw + 2 * NFF + g0), bg = *(const f32x4*)(cb + g0);
            const f32x4 wu0 = *(const f32x4*)(cw + DFF + g0), wu1 = *(const f32x4*)(cw + NFF + DFF + g0), wu2 = *(const f32x4*)(cw + 2 * NFF + DFF + g0), bu = *(const f32x4*)(cb + DFF + g0);
#pragma unroll
            for (int ai = 0; ai < 2; ++ai) {
                const int grp = 4 * u.pm + 2 * ai + wr;
                float* hbg = hb + (size_t)grp * 4 * NFF + 256 * u.pn + wc * 32 + 8 * fq + 4 * n;
#pragma unroll
                for (int m = 0; m < 4; ++m) {
                    const f32x4 cg = acc[ai][0][m][n], cu = acc[ai][1][m][n];
                    const f32x4 pg = acc[ai][0][m > 0 ? m - 1 : 0][n], pu = acc[ai][1][m > 0 ? m - 1 : 0][n];
                    const f32x4 g1a = ror4<0x121>(cg), g2a = ror4<0x122>(cg), u1a = ror4<0x121>(cu), u2a = ror4<0x122>(cu);
                    const f32x4 g1b = ror4<0x121>(pg), g2b = ror4<0x122>(pg), u1b = ror4<0x121>(pu), u2b = ror4<0x122>(pu);
                    f32x4 g1, g2, u1, u2;
#pragma unroll
                    for (int e = 0; e < 4; ++e) { g1[e] = fr == 0 ? g1b[e] : g1a[e]; g2[e] = fr < 2 ? g2b[e] : g2a[e]; u1[e] = fr == 0 ? u1b[e] : u1a[e]; u2[e] = fr < 2 ? u2b[e] : u2a[e]; }
                    const f32x4 G = bg + wg0 * g2 + wg1 * g1 + wg2 * cg, U = bu + wu0 * u2 + wu1 * u1 + wu2 * cu;
                    u32x2 w; w.x = pk2(siluf_(G[0]) * U[0], siluf_(G[1]) * U[1]); w.y = pk2(siluf_(G[2]) * U[2], siluf_(G[3]) * U[3]);
                    const int row = u.pm * 256 + ai * 128 + wr * 64 + m * 16 + fr;
                    if (m > 0 || fr >= 2) *(u32x2*)(act + (size_t)row * DFF + g0) = w;
                    if (m == 0 && fr < 2)  { *(f32x4*)(hbg + (size_t)fr * NFF) = cg; *(f32x4*)(hbg + (size_t)fr * NFF + 128) = cu; }
                    if (m == 3 && fr >= 14) { *(f32x4*)(hbg + (size_t)(fr - 12) * NFF) = cg; *(f32x4*)(hbg + (size_t)(fr - 12) * NFF + 128) = cu; }
                }
            }
        }
    }
};
__device__ __forceinline__ int map_in_col(int n) { return n < 1304 ? n : (n < 1312 ? 5912 + (n - 1304) : (n < 1320 ? 5920 + (n - 1312) : (n < 1536 ? -1 : 1304 + (n - 1536)))); }
struct ConvJob { const float* src; bf16_t* dst; int srcN, K, tile; int inmap; };
__device__ __forceinline__ bool conv_job(const Params& p, int layer, int it, ConvJob& j) {
    unsigned char* ws = p.ws;
    const int n0 = 32 * 24, n1 = n0 + 32 * 8, n2 = n1 + 32 * 43, n3 = n2 + 86 * 8, n4 = n3 + 32, n5 = n4 + 32, n6 = n5 + 16;
    if (it >= n6) return false;
    j.inmap = 0;
    if (it < n0)      { j.src = p.in[2]  + (size_t)layer * DM * 5928; j.srcN = 5928; j.K = DM; j.dst = (bf16_t*)(ws + O_WIN); j.tile = it; j.inmap = 1; }
    else if (it < n1) { j.src = p.in[27] + (size_t)layer * DM * DM; j.srcN = DM; j.K = DM; j.dst = (bf16_t*)(ws + O_WOUT); j.tile = it - n0; }
    else if (it < n2) { j.src = p.in[29] + (size_t)layer * DM * NFF; j.srcN = NFF; j.K = DM; j.dst = (bf16_t*)(ws + O_WFIN); j.tile = it - n1; j.inmap = 2; }
    else if (it < n3) { j.src = p.in[32] + (size_t)layer * DFF * DM; j.srcN = DM; j.K = DFF; j.dst = (bf16_t*)(ws + O_WFOUT); j.tile = it - n2; }
    else if (it < n4) { j.src = p.in[8]  + (size_t)layer * 2048 * 256; j.srcN = 256; j.K = 2048; j.dst = (bf16_t*)(ws + O_WCK); j.tile = it - n3; }
    else if (it < n5) { j.src = p.in[10] + (size_t)layer * 2048 * 256; j.srcN = 256; j.K = 2048; j.dst = (bf16_t*)(ws + O_WCV); j.tile = it - n4; }
    else              { j.src = p.in[21] + (size_t)layer * 512 * 512; j.srcN = 512; j.K = 512; j.dst = (bf16_t*)(ws + O_WGLU); j.tile = it - n5; }
    return true;
}
__device__ __forceinline__ void conv_load(const ConvJob& j, int tid, float (&v)[32]) {
    const int nk = j.K >> 6, tk = j.tile % nk, tn = j.tile / nk, k0 = tk * 64, n0 = tn * 256, tx = tid & 255, ty = tid >> 8;
    const int n = n0 + tx, sc = j.inmap == 1 ? map_in_col(n) : (j.inmap == 2 ? ((n & 255) < 128 ? 128 * (n >> 8) + (n & 127) : DFF + 128 * (n >> 8) + (n & 127)) : n);
    const float* sp = j.src + (size_t)(k0 + ty) * j.srcN + (sc >= 0 ? sc : 0);
#pragma unroll
    for (int i = 0; i < 32; ++i) v[i] = (sc >= 0) ? sp[(size_t)(2 * i) * j.srcN] : 0.f;
}
__device__ __forceinline__ void conv_store(const ConvJob& j, int tid, const float (&v)[32], float* sm) {
    const int nk = j.K >> 6, tk = j.tile % nk, tn = j.tile / nk, k0 = tk * 64, n0 = tn * 256, tx = tid & 255, ty = tid >> 8;
#pragma unroll
    for (int i = 0; i < 32; ++i) sm[(ty + 2 * i) * 257 + tx] = v[i];
    __syncthreads();
    const int nn = tid >> 1, hf = tid & 1;
    bf16_t* o = j.dst + (size_t)(n0 + nn) * j.K + k0 + hf * 32;
#pragma unroll
    for (int q = 0; q < 4; ++q) { u32x4 w; const float* sp = sm + (hf * 32 + q * 8) * 257 + nn;
        w.x = pk2(sp[0], sp[257]); w.y = pk2(sp[2 * 257], sp[3 * 257]); w.z = pk2(sp[4 * 257], sp[5 * 257]); w.w = pk2(sp[6 * 257], sp[7 * 257]); *(u32x4*)(o + q * 8) = w; }
    __syncthreads();
}
__device__ void phase_convert(const Params& p, int layer, float* sm) {
    const int G = gridDim.x, tid = tidx();
    ConvJob ja, jb; float va[32], vb[32];
    int it = blockIdx.x;
    bool ha = conv_job(p, layer, it, ja);
    if (ha) conv_load(ja, tid, va);
    while (ha) {
        const bool hb = conv_job(p, layer, it + G, jb);
        if (hb) conv_load(jb, tid, vb);
        conv_store(ja, tid, va, sm);
        if (!hb) break;
        ha = conv_job(p, layer, it + 2 * G, ja);
        if (ha) conv_load(ja, tid, va);
        conv_store(jb, tid, vb, sm);
        it += 2 * G;
    }
}
__device__ void phase_rmsnorm(const float* __restrict__ x, const float* __restrict__ gain, bf16_t* __restrict__ hn, float* __restrict__ xcopy) {
    const int wave = tidx() >> 6, lane = tidx() & 63;
    for (int r = blockIdx.x * 8 + wave; r < T_; r += gridDim.x * 8) {
        const f32x4* xr = (const f32x4*)(x + (size_t)r * DM);
        f32x4 v[8]; float ss = 0.f;
#pragma unroll
        for (int i = 0; i < 8; ++i) { v[i] = xr[lane + 64 * i]; ss += v[i][0] * v[i][0] + v[i][1] * v[i][1] + v[i][2] * v[i][2] + v[i][3] * v[i][3]; }
        ss = wave_sum(ss);
        const float rs = rsqrtf(ss * (1.0f / DM) + 1e-6f);
#pragma unroll
        for (int i = 0; i < 8; ++i) { const f32x4 g = ((const f32x4*)gain)[lane + 64 * i]; u32x2 w; w.x = pk2(v[i][0] * rs * g[0], v[i][1] * rs * g[1]); w.y = pk2(v[i][2] * rs * g[2], v[i][3] * rs * g[3]);
            *(u32x2*)(hn + (size_t)r * DM + (lane + 64 * i) * 4) = w; if (xcopy) ((f32x4*)(xcopy + (size_t)r * DM))[lane + 64 * i] = v[i]; }
    }
}

__device__ void nsa_prep_item(const Params& p, int layer, int item, float* sm) {
    unsigned char* ws = p.ws;
    const float* P32 = (const float*)(ws + O_P32);
    bf16_t* qn = (bf16_t*)(ws + O_QN); bf16_t* ksn = (bf16_t*)(ws + O_KSN); bf16_t* kwn = (bf16_t*)(ws + O_KWN);
    const int wave = tidx() >> 6, lane = tidx() & 63, tid = tidx();
    const int t0 = item * 64;
    const float gq = p.in[3][layer * 64 + lane], gks = p.in[5][layer * 64 + lane], gkw = p.in[6][layer * 64 + lane];
    const float inv = powf(500000.0f, -(float)(lane & 7) * 0.125f);
    for (int tt = 0; tt < 8; ++tt) {
        const int t = t0 + wave * 8 + tt;
        float sn, cs; sincosf((float)t * inv, &sn, &cs);
        const float* row = P32 + (size_t)t * 1536;
#pragma unroll
        for (int hv = 0; hv < 12; ++hv) {
            const int col = hv < 8 ? hv * 64 : (hv < 10 ? 768 + (hv - 8) * 64 : 1024 + (hv - 10) * 64);
            const float g = hv < 8 ? gq : (hv < 10 ? gks : gkw);
            const float x = row[col + lane];
            const float ss = wave_sum(x * x);
            float y = x * rsqrtf(ss * (1.0f / 64.0f) + 1e-6f) * g;
            const float yp = __shfl(y, lane ^ 8);
            if (lane < 8) y = y * cs - yp * sn; else if (lane < 16) y = y * cs + yp * sn;
            if (hv < 8) qn[(size_t)t * 512 + hv * 64 + lane] = f2bf(y * 0.18033688011112042f);
            else {
                unsigned char* k8 = (hv < 10 ? ws + O_KSN : ws + O_KWN) + ((size_t)(((hv - 8) & 1) * 256 + (t >> 6)) * 64 + (t & 63)) * 64 + ((lane >> 3) & 3) * 16 + (lane >> 5) * 8 + (lane & 7);
                *k8 = (unsigned char)__builtin_amdgcn_cvt_pk_fp8_f32(y, 0.f, 0, false);
            }
        }
    }
    for (int e = tid; e < 64 * 256; e += 512) { const int tk = e >> 8, c = e & 255; sm[tk * 257 + c] = P32[(size_t)(t0 + tk) * 1536 + (c < 128 ? 896 + c : 1152 + (c - 128))]; }
    __syncthreads();
    unsigned char* vs8 = ws + O_VST; unsigned char* vw8 = ws + O_VWT;
#pragma unroll
    for (int i = 0; i < 4; ++i) {
        const int rowid = (tid >> 3) + 64 * i, ts = tid & 7;
        float f[8];
#pragma unroll
        for (int k = 0; k < 8; ++k) { const int bb = ts * 8 + k, cc = ((bb >> 3) & 1) * 32 + (bb >> 4) * 8 + (bb & 7); f[k] = sm[((cc & 3) * 16 + (cc >> 2)) * 257 + rowid]; }
        u32x2 w; int t;
        t = __builtin_amdgcn_cvt_pk_fp8_f32(f[0], f[1], 0, false); t = __builtin_amdgcn_cvt_pk_fp8_f32(f[2], f[3], t, true); w.x = (unsigned)t;
        t = __builtin_amdgcn_cvt_pk_fp8_f32(f[4], f[5], 0, false); t = __builtin_amdgcn_cvt_pk_fp8_f32(f[6], f[7], t, true); w.y = (unsigned)t;
        const int rr = rowid & 127;
        unsigned char* dst = (rowid < 128 ? vs8 : vw8) + ((size_t)((rr >> 6) * 256 + item) * 64 + (rr & 63)) * 64 + ts * 8;
        *(u32x2*)dst = w;
    }
    __syncthreads();
}

__device__ void cmp1_wave_tile(const Params& p, int layer, int tile) {
    unsigned char* ws = p.ws;
    const float* P32 = (const float*)(ws + O_P32);
    const int lane = tidx() & 63, fr = lane & 15, fq = lane >> 4;
    const int nt = tile & 15, mt = (tile >> 4) & 127, which = tile >> 11;
    const bf16_t* Wt = (const bf16_t*)(ws + (which ? O_WCV : O_WCK)) + (size_t)(nt * 16 + fr) * 2048 + fq * 8;
    const float* pe = p.in[7] + (size_t)layer * 2048;
    const int r = mt * 16 + fr, n = r >> 1, hk = r & 1;
    const bool rv = n < 1023;
    const float* arow = P32 + (size_t)(16 * (rv ? n : 0)) * 1536 + (which ? 640 : 512) + hk * 64 + fq * 8;
    f32x4 acc = {0.f, 0.f, 0.f, 0.f};
#pragma unroll 8
    for (int ks = 0; ks < 64; ++ks) {
        const int l = ks >> 1, d = (ks & 1) * 32;
        const f32x4* ap = (const f32x4*)(arow + (size_t)l * 1536 + d);
        const f32x4* pp = (const f32x4*)(pe + l * 64 + d + fq * 8);
        f32x4 a0 = ap[0] + pp[0], a1 = ap[1] + pp[1];
        if (!rv) { a0 = (f32x4){0.f, 0.f, 0.f, 0.f}; a1 = a0; }
        const bf16x8 af = pack8f(a0, a1);
        const bf16x8 bf = *(const bf16x8*)(Wt + ks * 32);
        acc = MFMA16(af, bf, acc);
    }
    float* H = (float*)(ws + O_HCMP) + (size_t)which * 2048 * 256;
#pragma unroll
    for (int j = 0; j < 4; ++j) H[(size_t)(mt * 16 + fq * 4 + j) * 256 + nt * 16 + fr] = gelu_tanh(acc[j]);
}
__device__ void cmp2_wave_row(const Params& p, int layer, int idx) {
    unsigned char* ws = p.ws;
    const int lane = tidx() & 63;
    const int which = idx >> 11, r = idx & 2047, n = r >> 1, hk = r & 1;
    const float* H = (const float*)(ws + O_HCMP) + ((size_t)which * 2048 + r) * 256;
    const float* w2 = p.in[which ? 11 : 9] + (size_t)layer * 256 * 64;
    float acc = 0.f;
    if (n < 1023) {
        float a4[4] = {0.f, 0.f, 0.f, 0.f};
#pragma unroll 8
        for (int f = 0; f < 256; f += 4) { const f32x4 h4 = *(const f32x4*)(H + f); a4[0] += h4[0] * w2[f * 64 + lane]; a4[1] += h4[1] * w2[(f + 1) * 64 + lane]; a4[2] += h4[2] * w2[(f + 2) * 64 + lane]; a4[3] += h4[3] * w2[(f + 3) * 64 + lane]; }
        acc = (a4[0] + a4[1]) + (a4[2] + a4[3]);
    }
    if (which == 0) {
        const float ss = wave_sum(acc * acc);
        float y = acc * rsqrtf(ss * (1.0f / 64.0f) + 1e-6f) * p.in[4][layer * 64 + lane];
        const float inv = powf(500000.0f, -(float)(lane & 7) * 0.125f);
        float sn, cs; sincosf((float)(16 * n + 16) * inv, &sn, &cs);
        const float yp = __shfl(y, lane ^ 8);
        if (lane < 8) y = y * cs - yp * sn; else if (lane < 16) y = y * cs + yp * sn;
        if (n >= 1023) y = 0.f;
        ((bf16_t*)(ws + O_KC))[((size_t)hk * 1024 + n) * 64 + lane] = f2bf(y);
    } else {
        { const int cc = ((n & 15) << 2) | ((n >> 4) & 3); (ws + O_VCT)[((size_t)(hk * 16 + (n >> 6)) * 64 + lane) * 64 + ((cc >> 3) & 3) * 16 + (cc >> 5) * 8 + (cc & 7)] = (unsigned char)__builtin_amdgcn_cvt_pk_fp8_f32(acc, 0.f, 0, false); }
    }
}

typedef float f32x2 __attribute__((ext_vector_type(2)));
struct S5Coef { float ar, ai; f32x2 bb[16]; };
__device__ __forceinline__ void s5_setup(const Params& p, int layer, int g, int lane, S5Coef& c) {
    const int gp = layer * 2048 + g * 64 + lane;
    const float dt = expf(p.in[15][layer * 32 + g]);
    const float lr = p.in[13][gp], li = p.in[14][gp];
    const float mag = expf(lr * dt); float sn, cs; sincosf(li * dt, &sn, &cs);
    c.ar = mag * cs; c.ai = mag * sn;
    const float den = lr * lr + li * li, nr = c.ar - 1.0f, ni = c.ai;
    const float cr = (nr * lr + ni * li) / den, ci = (ni * lr - nr * li) / den;
    const f32x4* br = (const f32x4*)(p.in[16] + (size_t)gp * 16); const f32x4* bi = (const f32x4*)(p.in[17] + (size_t)gp * 16);
#pragma unroll
    for (int q = 0; q < 4; ++q) { const f32x4 a = br[q], b = bi[q];
#pragma unroll
        for (int e = 0; e < 4; ++e) c.bb[q * 4 + e] = (f32x2){cr * a[e] - ci * b[e], cr * b[e] + ci * a[e]}; }
}
__device__ __forceinline__ void s5_stage_u(const bf16_t* Pu, int tok, int g, float* ul, int lane) {
    const u32x4* s = (const u32x4*)(Pu + (size_t)tok * 512 + g * 16); const u32x4 a = s[0], b = s[1];
    f32x4* o = (f32x4*)(ul + lane * 16);
    o[0] = (f32x4){bflo(a.x), bfhi(a.x), bflo(a.y), bfhi(a.y)}; o[1] = (f32x4){bflo(a.z), bfhi(a.z), bflo(a.w), bfhi(a.w)};
    o[2] = (f32x4){bflo(b.x), bfhi(b.x), bflo(b.y), bfhi(b.y)}; o[3] = (f32x4){bflo(b.z), bfhi(b.z), bflo(b.w), bfhi(b.w)};
    asm volatile("s_waitcnt lgkmcnt(0)" ::: "memory");
}
__device__ __forceinline__ void s5_step(const S5Coef& k, const float* uj, float& xr, float& xi) {
    const f32x4 u0 = ((const f32x4*)uj)[0], u1 = ((const f32x4*)uj)[1], u2 = ((const f32x4*)uj)[2], u3 = ((const f32x4*)uj)[3];
    f32x2 acc0 = {0.f, 0.f}, acc1 = {0.f, 0.f};
#pragma unroll
    for (int e = 0; e < 4; ++e) { acc0 += k.bb[e] * u0[e]; acc1 += k.bb[4 + e] * u1[e]; }
#pragma unroll
    for (int e = 0; e < 4; ++e) { acc0 += k.bb[8 + e] * u2[e]; acc1 += k.bb[12 + e] * u3[e]; }
    const f32x2 bu = acc0 + acc1;
    const float nxr = k.ar * xr - k.ai * xi + bu[0], nxi = k.ar * xi + k.ai * xr + bu[1]; xr = nxr; xi = nxi;
}
__device__ void s5_passA_wave(const Params& p, int layer, int item, float* ul) {
    unsigned char* ws = p.ws; const bf16_t* Pu = (const bf16_t*)(ws + O_PU);
    const int lane = tidx() & 63, c = item >> 5, g = item & 31;
    S5Coef k; s5_setup(p, layer, g, lane, k);
    float xr = 0.f, xi = 0.f;
    for (int sub = 0; sub < 4; ++sub) {
        s5_stage_u(Pu, c * 256 + sub * 64 + lane, g, ul, lane);
#pragma unroll 4
        for (int j = 0; j < 64; ++j) s5_step(k, ul + j * 16, xr, xi);
        asm volatile("s_waitcnt lgkmcnt(0)" ::: "memory");
    }
    float* xe = (float*)(ws + O_XEND) + ((size_t)(c * 32 + g) * 64 + lane) * 2; xe[0] = xr; xe[1] = xi;
}
__device__ void s5_passB_wave(const Params& p, int layer, int item, bf16_t* xl, float* ul) {
    unsigned char* ws = p.ws; const bf16_t* Pu = (const bf16_t*)(ws + O_PU); bf16_t* yg = (bf16_t*)(ws + O_YGELU);
    const int lane = tidx() & 63, fr = lane & 15, fq = lane >> 4, c = item >> 5, g = item & 31;
    S5Coef k; s5_setup(p, layer, g, lane, k);
    float pr = k.ar, pi = k.ai;
#pragma unroll
    for (int s = 0; s < 8; ++s) { const float nr = pr * pr - pi * pi, ni = 2.f * pr * pi; pr = nr; pi = ni; }
    float xr = 0.f, xi = 0.f;
    const float* xe = (const float*)(ws + O_XEND) + ((size_t)g * 64 + lane) * 2;
#pragma unroll 8
    for (int cc = 0; cc < c; ++cc) { const float er = xe[(size_t)cc * 32 * 64 * 2], ei = xe[(size_t)cc * 32 * 64 * 2 + 1]; const float nr = pr * xr - pi * xi + er, ni = pr * xi + pi * xr + ei; xr = nr; xi = ni; }
    bf16x8 cf[4];
    {
        const float* cre = p.in[18] + (size_t)layer * 32 * 16 * 64 + ((size_t)g * 16 + fr) * 64; const float* cim = p.in[19] + (size_t)layer * 32 * 16 * 64 + ((size_t)g * 16 + fr) * 64;
#pragma unroll
        for (int ks = 0; ks < 4; ++ks) { const float* s = (ks < 2 ? cre : cim) + (ks & 1) * 32 + fq * 8; f32x4 a = ((const f32x4*)s)[0], b = ((const f32x4*)s)[1]; if (ks >= 2) { a = -a; b = -b; } cf[ks] = pack8f(a, b); }
    }
    const float dsk = p.in[20][layer * 512 + g * 16 + fr];
    for (int sub = 0; sub < 4; ++sub) {
        const int tb = c * 256 + sub * 64;
        s5_stage_u(Pu, tb + lane, g, ul, lane);
        for (int jb = 0; jb < 4; ++jb) {
#pragma unroll 4
            for (int jj = 0; jj < 16; ++jj) {
                s5_step(k, ul + (jb * 16 + jj) * 16, xr, xi);
                xl[jj * 136 + lane] = f2bf(xr); xl[jj * 136 + 64 + lane] = f2bf(xi);
            }
            asm volatile("s_waitcnt lgkmcnt(0)" ::: "memory");
            f32x4 y = {0.f, 0.f, 0.f, 0.f};
#pragma unroll
            for (int ks = 0; ks < 4; ++ks) { const bf16x8 af = *(const bf16x8*)(xl + fr * 136 + ks * 32 + fq * 8); y = MFMA16(af, cf[ks], y); }
            asm volatile("s_waitcnt lgkmcnt(0)" ::: "memory");
#pragma unroll
            for (int q = 0; q < 4; ++q) { const int tl = jb * 16 + fq * 4 + q; const float u = ul[tl * 16 + fr]; yg[(size_t)(tb + tl) * 512 + g * 16 + fr] = f2bf(gelu_tanh(y[q] + dsk * u)); }
        }
        asm volatile("s_waitcnt lgkmcnt(0)" ::: "memory");
    }
}
__device__ void gdn_prep_item(const Params& p, int layer, int item, unsigned char* lds) {
    unsigned char* ws = p.ws;
    const int tid = tidx(), wave = tid >> 6, lane = tid & 63, fr = lane & 15, fq = lane >> 4;
    const int n = item >> 3, h = item & 7, t0 = n * 64;
    bf16_t* qs = (bf16_t*)(lds); bf16_t* ks = (bf16_t*)(lds + 17408); bf16_t* vbT = (bf16_t*)(lds + 34816); bf16_t* kgT = (bf16_t*)(lds + 53248); bf16_t* kdT = (bf16_t*)(lds + 71680);
    float* Am = (float*)(lds + 90112); bf16_t* Tb = (bf16_t*)(lds + 107520); float* gcs = (float*)(lds + 116736); float* bts = (float*)(lds + 116992);
    const float* P32 = (const float*)(ws + O_P32); const bf16_t* Pqkv = (const bf16_t*)(ws + O_PQKV);
    if (wave == 0) {
        const int t = t0 + lane;
        const float a = P32[(size_t)t * 1536 + 1304 + h], b = P32[(size_t)t * 1536 + 1312 + h];
        const float g = -expf(p.in[24][layer * 8 + h]) * softplusf_(a + p.in[25][layer * 8 + h]);
        float s = g;
#pragma unroll
        for (int off = 1; off < 64; off <<= 1) { const float o = __shfl_up(s, off); if (lane >= off) s += o; }
        gcs[lane] = s; bts[lane] = sigmoidf_(b);
    }
    __syncthreads();
    {
        const int r = tid >> 3, c0 = (tid & 7) * 16;
        const float gcr = gcs[r], btr = bts[r], eg = expf(gcr), ed = expf(gcs[63] - gcr);
        const float* cw = p.in[23] + (size_t)layer * 4 * 3072;
#pragma unroll
        for (int which = 0; which < 3; ++which) {
            const int col = which * 1024 + h * 128 + c0;
            float acc[16];
#pragma unroll
            for (int e = 0; e < 16; ++e) acc[e] = 0.f;
#pragma unroll
            for (int j = 0; j < 4; ++j) {
                const int tr = t0 + r - 3 + j;
                if (tr >= 0) {
                    const u32x4* s = (const u32x4*)(Pqkv + (size_t)tr * 3072 + col); const u32x4 a = s[0], b = s[1];
                    const f32x4* wp = (const f32x4*)(cw + j * 3072 + col); const f32x4 w0 = wp[0], w1 = wp[1], w2 = wp[2], w3 = wp[3];
                    acc[0] += w0[0] * bflo(a.x); acc[1] += w0[1] * bfhi(a.x); acc[2] += w0[2] * bflo(a.y); acc[3] += w0[3] * bfhi(a.y);
                    acc[4] += w1[0] * bflo(a.z); acc[5] += w1[1] * bfhi(a.z); acc[6] += w1[2] * bflo(a.w); acc[7] += w1[3] * bfhi(a.w);
                    acc[8] += w2[0] * bflo(b.x); acc[9] += w2[1] * bfhi(b.x); acc[10] += w2[2] * bflo(b.y); acc[11] += w2[3] * bfhi(b.y);
                    acc[12] += w3[0] * bflo(b.z); acc[13] += w3[1] * bfhi(b.z); acc[14] += w3[2] * bflo(b.w); acc[15] += w3[3] * bfhi(b.w);
                }
            }
            float ss = 0.f;
#pragma unroll
            for (int e = 0; e < 16; ++e) { acc[e] = siluf_(acc[e]); ss += acc[e] * acc[e]; }
            ss += __shfl_xor(ss, 1); ss += __shfl_xor(ss, 2); ss += __shfl_xor(ss, 4);
            const float rn = rsqrtf(ss + 1e-6f);
            if (which == 0) {
                bf16_t* qg = (bf16_t*)(ws + O_GQG) + (size_t)item * 8192 + r * 128 + c0;
                float v[16];
#pragma unroll
                for (int e = 0; e < 16; ++e) v[e] = acc[e] * rn * 0.08838834764831845f;
                u32x4 w0, w1; w0.x = pk2(v[0], v[1]); w0.y = pk2(v[2], v[3]); w0.z = pk2(v[4], v[5]); w0.w = pk2(v[6], v[7]); w1.x = pk2(v[8], v[9]); w1.y = pk2(v[10], v[11]); w1.z = pk2(v[12], v[13]); w1.w = pk2(v[14], v[15]);
                *(u32x4*)(qs + r * 136 + c0) = w0; *(u32x4*)(qs + r * 136 + c0 + 8) = w1;
                u32x4 g0, g1; g0.x = pk2(v[0] * eg, v[1] * eg); g0.y = pk2(v[2] * eg, v[3] * eg); g0.z = pk2(v[4] * eg, v[5] * eg); g0.w = pk2(v[6] * eg, v[7] * eg);
                g1.x = pk2(v[8] * eg, v[9] * eg); g1.y = pk2(v[10] * eg, v[11] * eg); g1.z = pk2(v[12] * eg, v[13] * eg); g1.w = pk2(v[14] * eg, v[15] * eg);
                *(u32x4*)qg = g0; *(u32x4*)(qg + 8) = g1;
            } else if (which == 1) {
                float v[16];
#pragma unroll
                for (int e = 0; e < 16; ++e) v[e] = acc[e] * rn;
                u32x4 w0, w1; w0.x = pk2(v[0], v[1]); w0.y = pk2(v[2], v[3]); w0.z = pk2(v[4], v[5]); w0.w = pk2(v[6], v[7]); w1.x = pk2(v[8], v[9]); w1.y = pk2(v[10], v[11]); w1.z = pk2(v[12], v[13]); w1.w = pk2(v[14], v[15]);
                *(u32x4*)(ks + r * 136 + c0) = w0; *(u32x4*)(ks + r * 136 + c0 + 8) = w1;
#pragma unroll
                for (int e = 0; e < 16; ++e) { kgT[(c0 + e) * 72 + r] = f2bf(v[e] * btr * eg); kdT[(c0 + e) * 72 + r] = f2bf(v[e] * ed); }
            } else {
#pragma unroll
                for (int e = 0; e < 16; ++e) vbT[(c0 + e) * 72 + r] = f2bf(acc[e] * btr);
            }
        }
    }
    __syncthreads();
    {
        const int d = tid >> 2, sg = tid & 3;
        const u32x4 a = *(const u32x4*)(kdT + d * 72 + sg * 16), b = *(const u32x4*)(kdT + d * 72 + sg * 16 + 8);
        bf16_t* dst = (bf16_t*)(ws + O_GKD) + (size_t)item * 8192 + d * 64 + sg * 16; *(u32x4*)dst = a; *(u32x4*)(dst + 8) = b;
    }
    { float* Tmz = (float*)(lds + 117248); for (int e2 = tid; e2 < 64 * 68; e2 += 512) Tmz[e2] = 0.f; }
    {
        const int mi = wave >> 1;
        bf16_t* qko = (bf16_t*)(ws + O_GQK) + (size_t)item * 4096;
#pragma unroll
        for (int q = 0; q < 2; ++q) {
            const int nj = (wave & 1) * 2 + q;
            f32x4 kk = {0.f, 0.f, 0.f, 0.f}, qk = {0.f, 0.f, 0.f, 0.f};
            if (nj <= mi) {
#pragma unroll
                for (int s = 0; s < 4; ++s) {
                    const bf16x8 bk = *(const bf16x8*)(ks + (nj * 16 + fr) * 136 + s * 32 + fq * 8);
                    const bf16x8 ak = *(const bf16x8*)(ks + (mi * 16 + fr) * 136 + s * 32 + fq * 8);
                    const bf16x8 aq = *(const bf16x8*)(qs + (mi * 16 + fr) * 136 + s * 32 + fq * 8);
                    kk = MFMA16(ak, bk, kk); qk = MFMA16(aq, bk, qk);
                }
            }
            const int j = nj * 16 + fr; const float gj = gcs[j];
#pragma unroll
            for (int e = 0; e < 4; ++e) {
                const int i = mi * 16 + fq * 4 + e;
                const float dec = (j <= i) ? expf(gcs[i] - gj) : 0.f;
                Am[i * 68 + j] = (j < i) ? bts[i] * kk[e] * dec : 0.f;
                qko[i * 64 + j] = f2bf((j <= i) ? qk[e] * dec : 0.f);
            }
        }
    }
    __syncthreads();
    {
        float* Tm = (float*)(lds + 117248); float* Ps = (float*)(lds + 134656) + wave * 320;
        if (wave == 0) {
            const int bo = fq * 16; float t[16];
#pragma unroll
            for (int i = 0; i < 16; ++i) {
                float s = (i == fr) ? 1.f : 0.f;
#pragma unroll
                for (int j = 0; j < i; ++j) s -= Am[(bo + i) * 68 + bo + j] * t[j];
                t[i] = s; Tm[(bo + i) * 68 + bo + fr] = s;
            }
        }
        asm volatile("s_waitcnt lgkmcnt(0)" ::: "memory"); __syncthreads();
#pragma unroll
        for (int d = 1; d < 4; ++d) {
            if (wave < 4 - d) {
                const int bi = wave + d, bj = wave;
                f32x4 Q = {0.f, 0.f, 0.f, 0.f};
                for (int kb = bj; kb < bi; ++kb) {
                    const float* X = Am + (bi * 16) * 68 + kb * 16; const float* Y = Tm + (kb * 16) * 68 + bj * 16;
#pragma unroll
                    for (int s = 0; s < 4; ++s) Q = __builtin_amdgcn_mfma_f32_16x16x4f32(X[fr * 68 + 4 * s + fq], Y[(4 * s + fq) * 68 + fr], Q, 0, 0, 0);
                }
#pragma unroll
                for (int e2 = 0; e2 < 4; ++e2) Ps[(fq * 4 + e2) * 20 + fr] = Q[e2];
                asm volatile("s_waitcnt lgkmcnt(0)" ::: "memory");
                f32x4 R = {0.f, 0.f, 0.f, 0.f};
                const float* X = Tm + (bi * 16) * 68 + bi * 16;
#pragma unroll
                for (int s = 0; s < 4; ++s) R = __builtin_amdgcn_mfma_f32_16x16x4f32(X[fr * 68 + 4 * s + fq], Ps[(4 * s + fq) * 20 + fr], R, 0, 0, 0);
#pragma unroll
                for (int e2 = 0; e2 < 4; ++e2) Tm[(bi * 16 + fq * 4 + e2) * 68 + bj * 16 + fr] = -R[e2];
            }
            asm volatile("s_waitcnt lgkmcnt(0)" ::: "memory"); __syncthreads();
        }
        for (int e2 = tid; e2 < 4096; e2 += 512) { const int r = e2 >> 6, c = e2 & 63; Tb[r * 72 + c] = f2bf(Tm[r * 68 + c]); }
    }
    __syncthreads();
    {
        const int mi = wave & 3;
        const bf16x8 a0 = *(const bf16x8*)(Tb + (mi * 16 + fr) * 72 + fq * 8), a1 = *(const bf16x8*)(Tb + (mi * 16 + fr) * 72 + 32 + fq * 8);
        float* vo = (float*)(ws + O_GVAL) + (size_t)item * 8192; bf16_t* ko = (bf16_t*)(ws + O_GKC) + (size_t)item * 8192;
#pragma unroll
        for (int q = 0; q < 4; ++q) {
            const int nt = (wave >> 2) * 4 + q;
            f32x4 v = {0.f, 0.f, 0.f, 0.f}, kc = {0.f, 0.f, 0.f, 0.f};
            v = MFMA16(a0, *(const bf16x8*)(vbT + (nt * 16 + fr) * 72 + fq * 8), v); v = MFMA16(a1, *(const bf16x8*)(vbT + (nt * 16 + fr) * 72 + 32 + fq * 8), v);
            kc = MFMA16(a0, *(const bf16x8*)(kgT + (nt * 16 + fr) * 72 + fq * 8), kc); kc = MFMA16(a1, *(const bf16x8*)(kgT + (nt * 16 + fr) * 72 + 32 + fq * 8), kc);
#pragma unroll
            for (int e = 0; e < 4; ++e) { const int i = mi * 16 + fq * 4 + e, d = nt * 16 + fr; vo[i * 128 + d] = v[e]; ko[i * 128 + d] = f2bf(kc[e]); }
        }
    }
    if (tid == 0) ((float*)(ws + O_GEGL))[item] = expf(gcs[63]);
    __syncthreads();
}

struct GdnUO { bf16x8 kc[4], qg[4], qk[2]; float val[2][4]; };
struct GdnSU { bf16x8 kd[2][2]; float egl; };
__device__ __forceinline__ void gdn_load_uo(const unsigned char* ws, int item, int mt, int fr, int fq, int dvb, GdnUO& f) {
    const bf16_t* kc = (const bf16_t*)(ws + O_GKC) + (size_t)item * 8192 + (mt * 16 + fr) * 128 + fq * 8;
    const bf16_t* qg = (const bf16_t*)(ws + O_GQG) + (size_t)item * 8192 + (mt * 16 + fr) * 128 + fq * 8;
    const bf16_t* qk = (const bf16_t*)(ws + O_GQK) + (size_t)item * 4096 + (mt * 16 + fr) * 64 + fq * 8;
    const float* vl = (const float*)(ws + O_GVAL) + (size_t)item * 8192 + (mt * 16 + fq * 4) * 128 + dvb + fr;
#pragma unroll
    for (int s = 0; s < 4; ++s) { f.kc[s] = *(const bf16x8*)(kc + s * 32); f.qg[s] = *(const bf16x8*)(qg + s * 32); }
#pragma unroll
    for (int s = 0; s < 2; ++s) f.qk[s] = *(const bf16x8*)(qk + s * 32);
#pragma unroll
    for (int nt = 0; nt < 2; ++nt)
#pragma unroll
        for (int e = 0; e < 4; ++e) f.val[nt][e] = vl[e * 128 + nt * 16];
}
__device__ __forceinline__ void gdn_load_su(const unsigned char* ws, int item, int w4, int fr, int fq, GdnSU& f) {
    const bf16_t* kd = (const bf16_t*)(ws + O_GKD) + (size_t)item * 8192 + (2 * w4 * 16 + fr) * 64 + fq * 8;
#pragma unroll
    for (int s = 0; s < 2; ++s) { f.kd[0][s] = *(const bf16x8*)(kd + s * 32); f.kd[1][s] = *(const bf16x8*)(kd + 16 * 64 + s * 32); }
    f.egl = ((const float*)(ws + O_GEGL))[item];
}
#define GDN_BAR() do { asm volatile("s_waitcnt lgkmcnt(0)" ::: "memory"); __builtin_amdgcn_s_barrier(); asm volatile("" ::: "memory"); } while (0)
__device__ __forceinline__ void gdn_step_uo(const GdnUO& c, bf16_t* Sl, bf16_t* vn, float* go, int n, int h, int mt, int fr, int fq, int dvb) {
    bf16x8 Sb[2][4];
#pragma unroll
    for (int nt = 0; nt < 2; ++nt)
#pragma unroll
        for (int s = 0; s < 4; ++s) Sb[nt][s] = *(const bf16x8*)(Sl + nt * (16 * 136) + fr * 136 + s * 32 + fq * 8);
    f32x4 U[2], O[2];
#pragma unroll
    for (int nt = 0; nt < 2; ++nt) { U[nt] = (f32x4){0.f, 0.f, 0.f, 0.f}; O[nt] = (f32x4){0.f, 0.f, 0.f, 0.f};
#pragma unroll
        for (int s = 0; s < 4; ++s) U[nt] = MFMA16(c.kc[s], Sb[nt][s], U[nt]);
        u32x2 w; w.x = pk2(c.val[nt][0] - U[nt][0], c.val[nt][1] - U[nt][1]); w.y = pk2(c.val[nt][2] - U[nt][2], c.val[nt][3] - U[nt][3]);
        *(u32x2*)(vn + nt * (16 * 72) + fr * 72 + mt * 16 + fq * 4) = w; }
#pragma unroll
    for (int nt = 0; nt < 2; ++nt)
#pragma unroll
        for (int s = 0; s < 4; ++s) O[nt] = MFMA16(c.qg[s], Sb[nt][s], O[nt]);
    GDN_BAR();
#pragma unroll
    for (int nt = 0; nt < 2; ++nt) {
        const bf16x8 V0 = *(const bf16x8*)(vn + nt * (16 * 72) + fr * 72 + fq * 8), V1 = *(const bf16x8*)(vn + nt * (16 * 72) + fr * 72 + 32 + fq * 8);
        O[nt] = MFMA16(c.qk[0], V0, O[nt]); O[nt] = MFMA16(c.qk[1], V1, O[nt]);
#pragma unroll
        for (int e = 0; e < 4; ++e) go[(size_t)(n * 64 + mt * 16 + fq * 4 + e) * 1024 + h * 128 + dvb + nt * 16 + fr] = O[nt][e];
    }
    GDN_BAR();
}
__device__ __forceinline__ void gdn_step_su(const GdnSU& c, f32x4 (&St)[2][2], bf16_t* Sl, const bf16_t* vn, int w4, int fr, int fq) {
    GDN_BAR();
#pragma unroll
    for (int nt = 0; nt < 2; ++nt) {
        const bf16x8 V0 = *(const bf16x8*)(vn + nt * (16 * 72) + fr * 72 + fq * 8), V1 = *(const bf16x8*)(vn + nt * (16 * 72) + fr * 72 + 32 + fq * 8);
#pragma unroll
        for (int q = 0; q < 2; ++q) {
            St[nt][q] = St[nt][q] * c.egl;
            St[nt][q] = MFMA16(V0, c.kd[q][0], St[nt][q]); St[nt][q] = MFMA16(V1, c.kd[q][1], St[nt][q]);
#pragma unroll
            for (int e = 0; e < 4; ++e) Sl[nt * (16 * 136) + (fq * 4 + e) * 136 + (2 * w4 + q) * 16 + fr] = f2bf(St[nt][q][e]);
        }
    }
    GDN_BAR();
}
__device__ void gdn_recurrence(const Params& p, int b, unsigned char* lds) {
    const unsigned char* ws = p.ws;
    const int tid = tidx(), wave = tid >> 6, lane = tid & 63, fr = lane & 15, fq = lane >> 4;
    const int h = b >> 2, dvb = (b & 3) * 32;
    bf16_t* Sl = (bf16_t*)lds; bf16_t* vn = (bf16_t*)(lds + 2 * 16 * 136 * 2);
    float* go = (float*)(p.ws + O_PQKV);
    for (int e = tid; e < 2 * 16 * 136; e += 512) Sl[e] = 0;
    __syncthreads();
    if (wave < 4) {
        const int mt = wave;
        GdnUO f0, f1, f2;
        gdn_load_uo(ws, h, mt, fr, fq, dvb, f0); gdn_load_uo(ws, 8 + h, mt, fr, fq, dvb, f1);
        for (int n = 0; n < 255; n += 3) {
            gdn_load_uo(ws, (n + 2) * 8 + h, mt, fr, fq, dvb, f2); gdn_step_uo(f0, Sl, vn, go, n, h, mt, fr, fq, dvb);
            gdn_load_uo(ws, (n + 3) * 8 + h, mt, fr, fq, dvb, f0); gdn_step_uo(f1, Sl, vn, go, n + 1, h, mt, fr, fq, dvb);
            if (n + 4 < 256) gdn_load_uo(ws, (n + 4) * 8 + h, mt, fr, fq, dvb, f1);
            gdn_step_uo(f2, Sl, vn, go, n + 2, h, mt, fr, fq, dvb);
        }
        gdn_step_uo(f0, Sl, vn, go, 255, h, mt, fr, fq, dvb);
    } else {
        const int w4 = wave - 4;
        f32x4 St[2][2];
#pragma unroll
        for (int a = 0; a < 2; ++a)
#pragma unroll
            for (int c = 0; c < 2; ++c) St[a][c] = (f32x4){0.f, 0.f, 0.f, 0.f};
        GdnSU f0, f1, f2;
        gdn_load_su(ws, h, w4, fr, fq, f0); gdn_load_su(ws, 8 + h, w4, fr, fq, f1);
        for (int n = 0; n < 255; n += 3) {
            gdn_load_su(ws, (n + 2) * 8 + h, w4, fr, fq, f2); gdn_step_su(f0, St, Sl, vn, w4, fr, fq);
            gdn_load_su(ws, (n + 3) * 8 + h, w4, fr, fq, f0); gdn_step_su(f1, St, Sl, vn, w4, fr, fq);
            if (n + 4 < 256) gdn_load_su(ws, (n + 4) * 8 + h, w4, fr, fq, f1);
            gdn_step_su(f2, St, Sl, vn, w4, fr, fq);
        }
        gdn_step_su(f0, St, Sl, vn, w4, fr, fq);
    }
}
struct KVF { bf16x8 k[4][2]; };
__device__ __forceinline__ void kv_load(const bf16_t* kp, int ldk, KVF& f) {
#pragma unroll
    for (int s = 0; s < 4; ++s) { f.k[s][0] = *(const bf16x8*)(kp + (size_t)(s * 16) * ldk); f.k[s][1] = *(const bf16x8*)(kp + (size_t)(s * 16) * ldk + 32); }
}
template <int CTRL> __device__ __forceinline__ float dppf(float v) { return __int_as_float(__builtin_amdgcn_update_dpp(0, __float_as_int(v), CTRL, 0xF, 0xF, true)); }
template <int CTRL> __device__ __forceinline__ unsigned dppu(unsigned v) { return (unsigned)__builtin_amdgcn_update_dpp(0, (int)v, CTRL, 0xF, 0xF, true); }
__device__ __forceinline__ float rmax16(float v) { v = vmaxf(v, dppf<0xB1>(v)); v = vmaxf(v, dppf<0x4E>(v)); v = vmaxf(v, dppf<0x124>(v)); v = vmaxf(v, dppf<0x128>(v)); return v; }
__device__ __forceinline__ float rsum16(float v) { v += dppf<0xB1>(v); v += dppf<0x4E>(v); v += dppf<0x124>(v); v += dppf<0x128>(v); return v; }
template <int CTRL> __device__ __forceinline__ unsigned long long dppmax64(unsigned long long b) { const unsigned lo = dppu<CTRL>((unsigned)b), hi = dppu<CTRL>((unsigned)(b >> 32)); const unsigned long long ob = ((unsigned long long)hi << 32) | lo; return ob > b ? ob : b; }
#define MFMA8(a, b, c) __builtin_amdgcn_mfma_f32_16x16x32_fp8_fp8((a), (b), (c), 0, 0, 0)
__device__ __forceinline__ long mk64(unsigned lo, unsigned hi) { return (long)(((unsigned long long)hi << 32) | lo); }
__device__ __forceinline__ long bf8_to_fp8(bf16x8 v) {
    const u32x4 w = __builtin_bit_cast(u32x4, v);
    int a = __builtin_amdgcn_cvt_pk_fp8_f32(bflo(w.x), bfhi(w.x), 0, false); a = __builtin_amdgcn_cvt_pk_fp8_f32(bflo(w.y), bfhi(w.y), a, true);
    int b = __builtin_amdgcn_cvt_pk_fp8_f32(bflo(w.z), bfhi(w.z), 0, false); b = __builtin_amdgcn_cvt_pk_fp8_f32(bflo(w.w), bfhi(w.w), b, true);
    return mk64((unsigned)a, (unsigned)b);
}
struct K8F { u32x4 k[4]; };
__device__ __forceinline__ void k8_load(const unsigned char* kp, K8F& f) {
#pragma unroll
    for (int s = 0; s < 4; ++s) f.k[s] = *(const u32x4*)(kp + s * 1024);
}
__device__ __forceinline__ void softmax_pv(const f32x4 (&S)[4], const u32x4 (&Vw)[4], unsigned vmask, float (&m)[4], float (&l)[4], f32x4 (&O)[4], unsigned char* Pt, int fr, int fq) {
    float mx[4];
#pragma unroll
    for (int j = 0; j < 4; ++j) { float v = -1e30f;
#pragma unroll
        for (int s = 0; s < 4; ++s) v = ((vmask >> s) & 1u) ? vmaxf(v, S[s][j]) : v;
        mx[j] = rmax16(v); }
#pragma unroll
    for (int j = 0; j < 4; ++j) { const float mn = vmaxf(m[j], mx[j]); const float a = __builtin_amdgcn_exp2f(m[j] - mn); m[j] = mn; l[j] *= a;
#pragma unroll
        for (int dt = 0; dt < 4; ++dt) O[dt][j] *= a; }
#pragma unroll
    for (int j = 0; j < 4; ++j) { float pv[4];
#pragma unroll
        for (int s = 0; s < 4; ++s) { pv[s] = ((vmask >> s) & 1u) ? __builtin_amdgcn_exp2f(S[s][j] - m[j]) : 0.f; l[j] += pv[s]; }
        int t = __builtin_amdgcn_cvt_pk_fp8_f32(pv[0] * 256.f, pv[1] * 256.f, 0, false); t = __builtin_amdgcn_cvt_pk_fp8_f32(pv[2] * 256.f, pv[3] * 256.f, t, true);
        *(unsigned*)(Pt + (fq * 4 + j) * 72 + fr * 4) = (unsigned)t; }
    asm volatile("s_waitcnt lgkmcnt(0)" ::: "memory");
    const u32x2 p0 = *(const u32x2*)(Pt + fr * 72 + fq * 8), p1 = *(const u32x2*)(Pt + fr * 72 + 32 + fq * 8);
    asm volatile("s_waitcnt lgkmcnt(0)" ::: "memory");
    const long P0 = mk64(p0.x, p0.y), P1 = mk64(p1.x, p1.y);
#pragma unroll
    for (int dt = 0; dt < 4; ++dt) { O[dt] = MFMA8(P0, mk64(Vw[dt].x, Vw[dt].y), O[dt]); O[dt] = MFMA8(P1, mk64(Vw[dt].z, Vw[dt].w), O[dt]); }
}
__device__ __forceinline__ void flash_compute(const bf16x8 (&Qf)[2], KVF& f, const bf16_t* knext, int ldk, const unsigned char* vp, unsigned vmask, float (&m)[4], float (&l)[4], f32x4 (&O)[4], unsigned char* Pt, int fr, int fq) {
    f32x4 S[4]; u32x4 Vw[4];
#pragma unroll
    for (int dt = 0; dt < 4; ++dt) Vw[dt] = *(const u32x4*)(vp + dt * 1024);
#pragma unroll
    for (int s = 0; s < 4; ++s) { S[s] = (f32x4){0.f, 0.f, 0.f, 0.f}; S[s] = MFMA16(Qf[0], f.k[s][0], S[s]); S[s] = MFMA16(Qf[1], f.k[s][1], S[s]); }
    if (knext) kv_load(knext, ldk, f);
    softmax_pv(S, Vw, vmask, m, l, O, Pt, fr, fq);
}
struct V8F { u32x4 v[4]; };
__device__ __forceinline__ void v8_load(const unsigned char* vp, V8F& f) {
#pragma unroll
    for (int dt = 0; dt < 4; ++dt) f.v[dt] = *(const u32x4*)(vp + dt * 1024);
}
__device__ __forceinline__ void flash_compute8(const long (&Q8)[2], const K8F& f, const V8F& vf, unsigned vmask, float (&m)[4], float (&l)[4], f32x4 (&O)[4], unsigned char* Pt, int fr, int fq) {
    f32x4 S[4];
#pragma unroll
    for (int s = 0; s < 4; ++s) { S[s] = (f32x4){0.f, 0.f, 0.f, 0.f}; S[s] = MFMA8(Q8[0], mk64(f.k[s].x, f.k[s].y), S[s]); S[s] = MFMA8(Q8[1], mk64(f.k[s].z, f.k[s].w), S[s]); }
    softmax_pv(S, vf.v, vmask, m, l, O, Pt, fr, fq);
}
template <int BR> struct BranchIt {
    const bf16_t* kb; const unsigned char* kb8; const unsigned char* vb; const int* ul; int last, trow, fr, fq;
    static constexpr int LDK = 64;
    __device__ __forceinline__ int next(int from) const { return from <= last ? from : -1; }
    __device__ __forceinline__ int entry(int idx) const { return BR == 1 ? __builtin_amdgcn_readfirstlane(ul[idx]) : idx; }
    __device__ __forceinline__ const unsigned char* vptr(int en) const { return vb + (size_t)(en & 0xFFFF) * 4096; }
    __device__ __forceinline__ const bf16_t* kptr(int en) const { return kb + (size_t)((en & 0xFFFF) * 64) * LDK; }
    __device__ __forceinline__ const unsigned char* kptr8(int en) const { return kb8 + (size_t)(en & 0xFFFF) * 4096; }
    __device__ __forceinline__ unsigned mask(int en) const {
        unsigned vm = 0; const int key0 = (en & 0xFFFF) * 64;
        if (BR == 0) {
#pragma unroll
            for (int s = 0; s < 4; ++s) vm |= ((16 * (key0 + s * 16 + fr) + 31 <= trow) ? 1u : 0u) << s;
        } else if (BR == 1) {
            const bool rowsel = (en >> (16 + fq)) & 1;
#pragma unroll
            for (int s = 0; s < 4; ++s) vm |= ((rowsel && (key0 + s * 16 + fr <= trow)) ? 1u : 0u) << s;
        } else {
#pragma unroll
            for (int s = 0; s < 4; ++s) { const int kpos = key0 + s * 16 + fr; vm |= ((kpos <= trow && kpos > trow - 512) ? 1u : 0u) << s; }
        }
        return vm;
    }
};
template <int BR> __device__ __forceinline__ void run_branch(const BranchIt<BR>& it, int first, const bf16x8 (&Qf)[2], const long (&Q8)[2], float (&m)[4], float (&l)[4], f32x4 (&O)[4], unsigned char* Pt) {
#pragma unroll
    for (int j = 0; j < 4; ++j) { m[j] = -1e30f; l[j] = 0.f; O[j] = (f32x4){0.f, 0.f, 0.f, 0.f}; }
    int ia = it.next(first);
    if (ia < 0) return;
    if (BR == 0) {
        KVF A; kv_load(it.kptr(ia), BranchIt<BR>::LDK, A);
        while (ia >= 0) {
            const int ib = it.next(ia + 1);
            flash_compute(Qf, A, ib >= 0 ? it.kptr(ib) : nullptr, BranchIt<BR>::LDK, it.vptr(ia), it.mask(ia), m, l, O, Pt, it.fr, it.fq);
            ia = ib;
        }
    } else {
        K8F kA, kB; V8F vA, vB; int ea = it.entry(ia); k8_load(it.kptr8(ea), kA); v8_load(it.vptr(ea), vA);
        for (;;) {
            const int ib = it.next(ia + 1), eb = it.entry(ib >= 0 ? ib : ia);
            k8_load(it.kptr8(eb), kB); v8_load(it.vptr(eb), vB);
            flash_compute8(Q8, kA, vA, it.mask(ea), m, l, O, Pt, it.fr, it.fq);
            if (ib < 0) break;
            const int ic = it.next(ib + 1); ea = it.entry(ic >= 0 ? ic : ib);
            k8_load(it.kptr8(ea), kA); v8_load(it.vptr(ea), vA);
            flash_compute8(Q8, kB, vB, it.mask(eb), m, l, O, Pt, it.fr, it.fq);
            if (ic < 0) break;
            ia = ic;
        }
    }
}
__device__ __forceinline__ void branch_finish(float (&l)[4], f32x4 (&O)[4], const float* grow, int br, int hk, float* ybp  ) {
#pragma unroll
    for (int j = 0; j < 4; ++j) { const float s = rsum16(l[j]);
        const float g = sigmoidf_(grow[(hk * 4 + j) * 3 + br]) * 0.00390625f / fmaxf(s, 1e-30f);
#pragma unroll
        for (int dt = 0; dt < 4; ++dt) { float* q = ybp + j * 64 + dt * 16; if (br == 0) *q = g * O[dt][j]; else *q += g * O[dt][j]; } }
}
constexpr int NSA_WLDS = 15680;
__device__ void nsa_wave_task(const Params& p, int layer, int t0, int hk, unsigned char* wl) {
    unsigned char* ws = p.ws;
    const int lane = tidx() & 63, fr = lane & 15, fq = lane >> 4;
    float* imp = (float*)wl; unsigned* flg = (unsigned*)(wl + 4160); unsigned char* Pt = wl + 5184; float* yb = (float*)(wl + 7488);
    const bf16_t* qn = (const bf16_t*)(ws + O_QN); const unsigned char* ks8 = ws + O_KSN; const unsigned char* kw8 = ws + O_KWN;
    const unsigned char* vsT = ws + O_VST; const unsigned char* vwT = ws + O_VWT; const bf16_t* kc = (const bf16_t*)(ws + O_KC); const unsigned char* vcT = ws + O_VCT;
    const int trow = t0 + fq;
    const float* grow = (const float*)(ws + O_P32) + (size_t)trow * 1536 + 1280;
    const int tmax = t0 + 3;
    {
        bf16x8 Qf[2];
        { const bf16_t* qp = qn + (size_t)(t0 + (fr >> 2)) * 512 + (hk * 4 + (fr & 3)) * 64 + fq * 8; Qf[0] = *(const bf16x8*)qp; Qf[1] = *(const bf16x8*)(qp + 32); }
        long Q8[2]; Q8[0] = bf8_to_fp8(Qf[0]); Q8[1] = bf8_to_fp8(Qf[1]);
        float* ybp = yb + fq * 256 + fr;
        float m[4], l[4]; f32x4 O[4];
        const int ncmp_t = tmax >= 31 ? ((((tmax - 31) >> 4) >> 6) + 1) : 0;
        const bf16_t* kcb = kc + ((size_t)hk * 1024 + fr) * 64 + fq * 8;
        { BranchIt<0> it{kcb, nullptr, vcT + (size_t)hk * 16 * 4096 + fr * 64 + fq * 16, nullptr, ncmp_t - 1, trow, fr, fq}; run_branch<0>(it, 0, Qf, Q8, m, l, O, Pt); }
        float linv[4];
#pragma unroll
        for (int j = 0; j < 4; ++j) { const float s = rsum16(l[j]); linv[j] = s > 0.f ? 1.0f / s : 0.f; }
        branch_finish(l, O, grow, 0, hk, ybp);
        for (int e = lane; e < 4 * 260; e += 64) imp[e] = 0.f;
        for (int e = lane; e < 256; e += 64) flg[e] = 0u;
        asm volatile("s_waitcnt lgkmcnt(0)" ::: "memory");
        {
            KVF ka;
            if (ncmp_t > 0) kv_load(kcb, 64, ka);
            for (int kt = 0; kt < ncmp_t; ++kt) {
                const int key0 = kt * 64;
                f32x4 S[4];
#pragma unroll
                for (int s = 0; s < 4; ++s) { S[s] = (f32x4){0.f, 0.f, 0.f, 0.f}; S[s] = MFMA16(Qf[0], ka.k[s][0], S[s]); S[s] = MFMA16(Qf[1], ka.k[s][1], S[s]); }
                if (kt + 1 < ncmp_t) kv_load(kcb + (size_t)(key0 + 64) * 64, 64, ka);
#pragma unroll
                for (int s = 0; s < 4; ++s) {
                    const int nn = key0 + s * 16 + fr; const bool valid = 16 * nn + 31 <= trow;
                    float ps = 0.f;
#pragma unroll
                    for (int j = 0; j < 4; ++j) ps += valid ? __builtin_amdgcn_exp2f(S[s][j] - m[j]) * linv[j] : 0.f;
                    float p4 = ps; p4 += dppf<0xB1>(p4); p4 += dppf<0x4E>(p4);
                    if ((fr & 3) == 0) imp[fq * 260 + (nn >> 2)] += p4;
                    asm volatile("s_waitcnt lgkmcnt(0)" ::: "memory");
                    if ((fr & 3) == 3) imp[fq * 260 + (nn >> 2) + 1] += ps;
                    asm volatile("s_waitcnt lgkmcnt(0)" ::: "memory");
                }
            }
        }
#ifdef OLD_TOPK
        for (int tok = 0; tok < 4; ++tok) {
            const int t = t0 + tok, cur = t >> 6, nsel = cur + 1 < 16 ? cur + 1 : 16;
            unsigned long long key[4];
#pragma unroll
            for (int i = 0; i < 4; ++i) { const int j = lane + 64 * i; unsigned long long k = 0ull;
                if (j <= cur) { const bool forced = (j == 0) || (j == cur) || (j == cur - 1); const unsigned vb = forced ? 0x7F800000u : __float_as_uint(imp[tok * 260 + j]); k = ((unsigned long long)vb << 32) | (unsigned)(0xFFFF - j); }
                key[i] = k; }
            for (int it2 = 0; it2 < nsel; ++it2) {
                unsigned long long best = key[0]; best = key[1] > best ? key[1] : best; best = key[2] > best ? key[2] : best; best = key[3] > best ? key[3] : best;
#pragma unroll
                for (int o = 32; o >= 1; o >>= 1) { const unsigned lo = __shfl_xor((unsigned)best, o), hi = __shfl_xor((unsigned)(best >> 32), o); const unsigned long long ob = ((unsigned long long)hi << 32) | lo; best = ob > best ? ob : best; }
                const int jsel = 0xFFFF - (int)(best & 0xFFFFu);
#pragma unroll
                for (int i = 0; i < 4; ++i) if (key[i] == best) key[i] = 0ull;
                if (lane == 0) flg[jsel] |= (1u << tok);
            }
        }
#else
        {
            unsigned long long key[4][4];
#pragma unroll
            for (int tok = 0; tok < 4; ++tok) { const int cur = (t0 + tok) >> 6;
#pragma unroll
                for (int i = 0; i < 4; ++i) { const int j = lane + 64 * i; unsigned long long k = 0ull;
                    if (j <= cur) { const bool forced = (j == 0) || (j == cur) || (j == cur - 1); const unsigned vb = forced ? 0x7F800000u : __float_as_uint(imp[tok * 260 + j]); k = ((unsigned long long)vb << 32) | (unsigned)(0xFFFF - j); }
                    key[tok][i] = k; } }
            for (int itn = 0; itn < 16; ++itn) {
                unsigned long long best[4];
#pragma unroll
                for (int tok = 0; tok < 4; ++tok) { unsigned long long b0 = key[tok][0]; b0 = key[tok][1] > b0 ? key[tok][1] : b0; b0 = key[tok][2] > b0 ? key[tok][2] : b0; b0 = key[tok][3] > b0 ? key[tok][3] : b0; best[tok] = b0; }
#pragma unroll
                for (int tok = 0; tok < 4; ++tok) { best[tok] = dppmax64<0xB1>(best[tok]); best[tok] = dppmax64<0x4E>(best[tok]); best[tok] = dppmax64<0x124>(best[tok]); best[tok] = dppmax64<0x128>(best[tok]); }
#pragma unroll
                for (int o = 16; o <= 32; o <<= 1) {
#pragma unroll
                    for (int tok = 0; tok < 4; ++tok) { const unsigned lo = __shfl_xor((unsigned)best[tok], o), hi = __shfl_xor((unsigned)(best[tok] >> 32), o); const unsigned long long ob = ((unsigned long long)hi << 32) | lo; best[tok] = ob > best[tok] ? ob : best[tok]; }
                }
#pragma unroll
                for (int tok = 0; tok < 4; ++tok) {
                    if (best[tok] != 0ull) {
#pragma unroll
                        for (int i = 0; i < 4; ++i) if (key[tok][i] == best[tok]) key[tok][i] = 0ull;
                        if (lane == 0) flg[0xFFFF - (int)(best[tok] & 0xFFFFu)] |= (1u << tok);
                    }
                }
            }
        }
#endif
        asm volatile("s_waitcnt lgkmcnt(0)" ::: "memory");
        int ucnt = 0; int* ul = (int*)imp;
#pragma unroll
        for (int i = 0; i < 4; ++i) { const int j = i * 64 + lane; const unsigned fw = flg[j]; const bool us = fw != 0u; const unsigned long long bm = __ballot(us);
            const int pos = ucnt + __popcll(bm & ((1ull << lane) - 1ull)); if (us) ul[pos] = j | (int)(fw << 16); ucnt += __popcll(bm); }
        asm volatile("s_waitcnt lgkmcnt(0)" ::: "memory");
        { BranchIt<1> it{nullptr, ks8 + (size_t)hk * 256 * 4096 + fr * 64 + fq * 16, vsT + (size_t)hk * 256 * 4096 + fr * 64 + fq * 16, ul, ucnt - 1, trow, fr, fq}; run_branch<1>(it, 0, Qf, Q8, m, l, O, Pt); }
        branch_finish(l, O, grow, 1, hk, ybp);
        { BranchIt<2> it{nullptr, kw8 + (size_t)hk * 256 * 4096 + fr * 64 + fq * 16, vwT + (size_t)hk * 256 * 4096 + fr * 64 + fq * 16, nullptr, tmax >> 6, trow, fr, fq}; run_branch<2>(it, t0 - 511 > 0 ? ((t0 - 511) >> 6) : 0, Qf, Q8, m, l, O, Pt); }
        branch_finish(l, O, grow, 2, hk, ybp);
    }
    asm volatile("s_waitcnt lgkmcnt(0)" ::: "memory");
    float* ysc = (float*)(ws + O_P32);
#pragma unroll
    for (int tok = 0; tok < 4; ++tok) *(f32x4*)(ysc + (size_t)(t0 + tok) * 1536 + hk * 256 + lane * 4) = *(const f32x4*)(yb + tok * 256 + lane * 4);
    asm volatile("s_waitcnt lgkmcnt(0)" ::: "memory");
}

__device__ void phase_finalize(const Params& p, int layer) {
    unsigned char* ws = p.ws;
    const int wave = tidx() >> 6, lane = tidx() & 63;
    const float* yglu = (const float*)(ws + O_YGLU); const float* go = (const float*)(ws + O_PQKV); const bf16_t* Pz = (const bf16_t*)(ws + O_PZ); bf16_t* mix = (bf16_t*)(ws + O_HN);
    const float* gs = p.in[22] + (size_t)layer * 512 + lane * 8; const float* gg = p.in[26] + (size_t)layer * 128 + (lane & 7) * 16;
    const float* gnsa = p.in[12] + (size_t)layer * 512 + lane * 8; const float* ysc = (const float*)(ws + O_P32);
    for (int t = blockIdx.x * 8 + wave; t < T_; t += gridDim.x * 8) {
        {
            const f32x4 a = *(const f32x4*)(ysc + (size_t)t * 1536 + lane * 8), b = *(const f32x4*)(ysc + (size_t)t * 1536 + lane * 8 + 4);
            float ss = a[0] * a[0] + a[1] * a[1] + a[2] * a[2] + a[3] * a[3] + b[0] * b[0] + b[1] * b[1] + b[2] * b[2] + b[3] * b[3];
            ss = wave_sum(ss); const float rs = rsqrtf(ss * (1.0f / 512.0f) + 1e-6f);
            const f32x4 g0 = *(const f32x4*)gnsa, g1 = *(const f32x4*)(gnsa + 4);
            u32x4 w; w.x = pk2(a[0] * rs * g0[0], a[1] * rs * g0[1]); w.y = pk2(a[2] * rs * g0[2], a[3] * rs * g0[3]); w.z = pk2(b[0] * rs * g1[0], b[1] * rs * g1[1]); w.w = pk2(b[2] * rs * g1[2], b[3] * rs * g1[3]);
            *(u32x4*)(mix + (size_t)t * DM + lane * 8) = w;
        }
        {
            const f32x4 a = *(const f32x4*)(yglu + (size_t)t * 512 + lane * 8), b = *(const f32x4*)(yglu + (size_t)t * 512 + lane * 8 + 4);
            float ss = a[0] * a[0] + a[1] * a[1] + a[2] * a[2] + a[3] * a[3] + b[0] * b[0] + b[1] * b[1] + b[2] * b[2] + b[3] * b[3];
            ss = wave_sum(ss); const float rs = rsqrtf(ss * (1.0f / 512.0f) + 1e-6f);
            const f32x4 g0 = *(const f32x4*)gs, g1 = *(const f32x4*)(gs + 4);
            u32x4 w; w.x = pk2(a[0] * rs * g0[0], a[1] * rs * g0[1]); w.y = pk2(a[2] * rs * g0[2], a[3] * rs * g0[3]); w.z = pk2(b[0] * rs * g1[0], b[1] * rs * g1[1]); w.w = pk2(b[2] * rs * g1[2], b[3] * rs * g1[3]);
            *(u32x4*)(mix + (size_t)t * DM + 512 + lane * 8) = w;
        }
        {
            f32x4 o[4]; float ss = 0.f;
#pragma unroll
            for (int q = 0; q < 4; ++q) { o[q] = *(const f32x4*)(go + (size_t)t * 1024 + lane * 16 + q * 4); ss += o[q][0] * o[q][0] + o[q][1] * o[q][1] + o[q][2] * o[q][2] + o[q][3] * o[q][3]; }
            ss += __shfl_xor(ss, 1); ss += __shfl_xor(ss, 2); ss += __shfl_xor(ss, 4);
            const float rs = rsqrtf(ss * (1.0f / 128.0f) + 1e-6f);
            const u32x4 z0 = *(const u32x4*)(Pz + (size_t)t * 1024 + lane * 16), z1 = *(const u32x4*)(Pz + (size_t)t * 1024 + lane * 16 + 8);
            float zz[16] = {bflo(z0.x), bfhi(z0.x), bflo(z0.y), bfhi(z0.y), bflo(z0.z), bfhi(z0.z), bflo(z0.w), bfhi(z0.w), bflo(z1.x), bfhi(z1.x), bflo(z1.y), bfhi(z1.y), bflo(z1.z), bfhi(z1.z), bflo(z1.w), bfhi(z1.w)};
            float r[16];
#pragma unroll
            for (int q = 0; q < 4; ++q) { const f32x4 g = *(const f32x4*)(gg + q * 4);
#pragma unroll
                for (int e = 0; e < 4; ++e) r[q * 4 + e] = o[q][e] * rs * g[e] * siluf_(zz[q * 4 + e]); }
            u32x4 w0, w1; w0.x = pk2(r[0], r[1]); w0.y = pk2(r[2], r[3]); w0.z = pk2(r[4], r[5]); w0.w = pk2(r[6], r[7]); w1.x = pk2(r[8], r[9]); w1.y = pk2(r[10], r[11]); w1.z = pk2(r[12], r[13]); w1.w = pk2(r[14], r[15]);
            *(u32x4*)(mix + (size_t)t * DM + 1024 + lane * 16) = w0; *(u32x4*)(mix + (size_t)t * DM + 1024 + lane * 16 + 8) = w1;
        }
    }
}

__device__ void phase_ffn_fix(const Params& p, int layer) {
    unsigned char* ws = p.ws;
    const float* hb = (const float*)(ws + O_HF); bf16_t* act = (bf16_t*)(ws + O_ACT);
    const float* cw = p.in[30] + (size_t)layer * 3 * NFF; const float* cb = p.in[31] + (size_t)layer * NFF;
    const int nitems = 256 * DFF;
    for (int it = blockIdx.x * 512 + tidx(); it < nitems; it += gridDim.x * 512) {
        const int grp = it / DFF, g = it - grp * DFF, pcol = 256 * (g >> 7) + (g & 127);
        const float* cur = hb + (size_t)grp * 4 * NFF + pcol; const float* prv = cur - (size_t)4 * NFF;
        const float gm2 = grp ? prv[2 * NFF] : 0.f, gm1 = grp ? prv[3 * NFF] : 0.f, g0v = cur[0], g1v = cur[NFF];
        const float um2 = grp ? prv[2 * NFF + 128] : 0.f, um1 = grp ? prv[3 * NFF + 128] : 0.f, u0v = cur[128], u1v = cur[NFF + 128];
        const float wg0 = cw[g], wg1 = cw[NFF + g], wg2 = cw[2 * NFF + g], bg = cb[g], wu0 = cw[DFF + g], wu1 = cw[NFF + DFF + g], wu2 = cw[2 * NFF + DFF + g], bu = cb[DFF + g];
        const float G0 = bg + wg0 * gm2 + wg1 * gm1 + wg2 * g0v, U0 = bu + wu0 * um2 + wu1 * um1 + wu2 * u0v;
        const float G1 = bg + wg0 * gm1 + wg1 * g0v + wg2 * g1v, U1 = bu + wu0 * um1 + wu1 * u0v + wu2 * u1v;
        act[(size_t)(grp * 64) * DFF + g] = f2bf(siluf_(G0) * U0);
        act[(size_t)(grp * 64 + 1) * DFF + g] = f2bf(siluf_(G1) * U1);
    }
}
#ifdef REPEAT_PHASE
constexpr int NPHT = NPH + 1;
#else
constexpr int NPHT = NPH;
#endif
#ifndef MULTI_LAUNCH
#define MULTI_LAUNCH 0
#endif
__global__ void __launch_bounds__(512) mega(Params p) {
    extern __shared__ __attribute__((aligned(16))) unsigned char smem[];
    cg::grid_group grid = cg::this_grid();
    const int b = blockIdx.x, G = gridDim.x;
    PG8_LAS unsigned char* glds = (PG8_LAS unsigned char*)smem;
    volatile XB_LAS unsigned* xst = (volatile XB_LAS unsigned*)(smem + LDS_BYTES - 32);
    if (threadIdx.x == 0) { xst[0] = 0u; xst[1] = 0u; }
    __syncthreads();
    XcdBarrier xbar; xbar.bar = (unsigned*)(p.ws + O_BAR); xbar.x = 0; xbar.st = xst;
    for (int ph = p.ph_lo; ph < p.ph_hi; ++ph) {

        #ifdef REPEAT_PHASE
        const int layer = ph / (NPH + 1), ki = ph % (NPH + 1), rep = (ki == REPEAT_PHASE + 1) ? 1 : 0; int k = ki <= REPEAT_PHASE ? ki : ki - 1;
#else
        const int layer = ph / NPH, rep = 0; int k = ph % NPH;
#endif
#ifdef DBG_ONLY
        if (k != DBG_ONLY) k = 99;
#endif
        typedef unsigned char __attribute__((address_space(1))) gu8_t;
        gu8_t* wsg = (gu8_t*)p.ws; asm volatile("" : "+s"(wsg));
        unsigned char* ws = (unsigned char*)wsg;
        int tid = threadIdx.x; asm volatile("" : "+v"(tid));
        const int wave = tid >> 6;
        bf16_t* hn = (bf16_t*)(ws + O_HN);
        Params q = p; q.ws = ws;
        if (k == 0) {
            if (ph == 0 && rep == 0 && b == 0) { if (tid < 64) ((unsigned*)(ws + O_CTR))[tid * 16] = 0u; for (int i = tid; i < XCD_BAR_WORDS; i += 512) ((unsigned*)(ws + O_BAR))[i] = 0u; }
            phase_convert(q, layer, (float*)smem);
            phase_rmsnorm(layer == 0 ? p.in[0] : p.out, p.in[1] + (size_t)layer * DM, hn, layer == 0 ? p.out : nullptr);
        } else if (k == 1) {
            pg8::Gemm g{hn, (const bf16_t*)(ws + O_WIN), T_, NIN, DM}; pg8::StaticOrder S; S.init(T_, NIN, G, b);
            EpiProj E{(float*)(ws + O_P32), (bf16_t*)(ws + O_PU), (bf16_t*)(ws + O_PQKV), (bf16_t*)(ws + O_PZ)};
            pg8::gemm_phase<EpiProj, pg8::StaticOrder, false>(glds, g, S, E, nullptr);
        } else if (k == 2) {
            for (int it = b; it < 3072; it += G) {
                if (it < 2048) gdn_prep_item(q, layer, it, smem);
                else if (it < 2304) nsa_prep_item(q, layer, it - 2048, (float*)smem);
                else if (it < 2560) s5_passA_wave(q, layer, (it - 2304) * 8 + wave, (float*)(smem + wave * 4096));
                else cmp1_wave_tile(q, layer, (it - 2560) * 8 + wave);
            }
        } else if (k == 3) {
            for (int idx = b * 8 + wave; idx < 4096; idx += G * 8) cmp2_wave_row(q, layer, idx);
            for (int it = b * 8 + wave; it < 2048; it += G * 8) s5_passB_wave(q, layer, it, (bf16_t*)(smem + wave * 8448), (float*)(smem + wave * 8448 + 4352));
        } else if (k == 4) {
#ifdef REP4_MODE
            const bool do_rec = (rep == 0) || (REP4_MODE == 1), do_glu = (rep == 0), do_nsa = (rep == 0) || (REP4_MODE == 2);
#else
            const bool do_rec = true, do_glu = true, do_nsa = true;
#endif
            if (b < 32) {
#ifndef NO_REC
 if (do_rec) gdn_recurrence(q, b, smem);
#endif
 }
            else if (b < 160 && do_glu) {
#ifndef NO_GLU
                pg8::Gemm g{(const bf16_t*)(ws + O_YGELU), (const bf16_t*)(ws + O_WGLU), T_, 512, 512}; pg8::StaticOrder S; S.init(T_, 512, 128, b - 32);
                EpiGlu E{(const bf16_t*)(ws + O_YGELU), (float*)(ws + O_YGLU)};
                pg8::gemm_phase<EpiGlu, pg8::StaticOrder, false>(glds, g, S, E, nullptr);
#endif
            }
            __syncthreads();
            unsigned* ctr = (unsigned*)(ws + O_CTR) + (layer * 2 + rep) * 16;
            volatile int* sidx = (volatile int*)(smem + LDS_BYTES - 16);
#ifndef NO_NSA
            if (do_nsa) for (;;) {
                if (tid == 0) *sidx = (int)atomicAdd(ctr, 1u);
                __syncthreads();
                const int idx = *sidx;
                __syncthreads();
                if (idx >= 1024) break;
                nsa_wave_task(q, layer, (511 - (idx & 511)) * 32 + wave * 4, idx >> 9, smem + wave * NSA_WLDS);
            }
#endif
        } else if (k == 5) {
            phase_finalize(q, layer);
        } else if (k == 6) {
            pg8::Gemm g{hn, (const bf16_t*)(ws + O_WOUT), T_, DM, DM}; pg8::StaticOrder S; S.init(T_, DM, G, b);
            EpiResid E{p.out, DM};
            pg8::gemm_phase<EpiResid, pg8::StaticOrder, false>(glds, g, S, E, nullptr);
        } else if (k == 7) {
            phase_rmsnorm(p.out, p.in[28] + (size_t)layer * DM, hn, nullptr);
        } else if (k == 8) {
            pg8::Gemm g{hn, (const bf16_t*)(ws + O_WFIN), T_, NFF, DM}; pg8::StaticOrder S; S.init(T_, NFF, G, b);
            EpiFfnAct E{(bf16_t*)(ws + O_ACT), (float*)(ws + O_HF), q.in[30] + (size_t)layer * 3 * NFF, q.in[31] + (size_t)layer * NFF};
            pg8::gemm_phase<EpiFfnAct, pg8::StaticOrder, false>(glds, g, S, E, nullptr);
        } else if (k == 9) {
            phase_ffn_fix(q, layer);
        } else if (k == 10) {
            pg8::Gemm g{(const bf16_t*)(ws + O_ACT), (const bf16_t*)(ws + O_WFOUT), T_, DM, DFF}; pg8::StaticOrder S; S.init(T_, DM, G, b);
            EpiResid E{p.out, DM};
            pg8::gemm_phase<EpiResid, pg8::StaticOrder, false>(glds, g, S, E, nullptr);
        }
        __syncthreads();
        if (ph + 1 < p.ph_hi) {
            if (ph == p.ph_lo) { grid.sync(); xbar = xcd_barrier_post((unsigned*)(p.ws + O_BAR), xst); }
            else xcd_barrier(xbar);
        }
    }
}

extern "C" void kernel_launch(void* const* d_in, const int* in_sizes, int n_in, void* d_out, int out_size, void* d_ws, size_t ws_size, hipStream_t stream) {
    static int grid_blocks = 0;
    if (!grid_blocks) {
        if (n_in != 33 || out_size != T_ * DM || ws_size < WS_NEED) { fprintf(stderr, "kernel_launch: unexpected shapes or workspace (%d inputs, out %d, ws %zu < %zu)\n", n_in, out_size, ws_size, (size_t)WS_NEED); grid_blocks = -1; return; }
        int dev = 0, cus = 0, per_cu = 0;
        hipGetDevice(&dev);
        hipDeviceGetAttribute(&cus, hipDeviceAttributeMultiprocessorCount, dev);
        if (hipFuncSetAttribute((const void*)mega, hipFuncAttributeMaxDynamicSharedMemorySize, LDS_BYTES) != hipSuccess) { fprintf(stderr, "kernel_launch: hipFuncSetAttribute failed\n"); grid_blocks = -1; return; }
        hipOccupancyMaxActiveBlocksPerMultiprocessor(&per_cu, (const void*)mega, 512, LDS_BYTES);
        (void)hipGetLastError();
        if (per_cu < 1) per_cu = 1;
        grid_blocks = cus * per_cu; if (grid_blocks > 256) grid_blocks = 256;
        if (grid_blocks < 160) { fprintf(stderr, "kernel_launch: grid %d too small\n", grid_blocks); grid_blocks = -1; return; }
    }
    if (grid_blocks < 0) return;
    Params p{};
    for (int i = 0; i < 33; ++i) p.in[i] = (const float*)d_in[i];
    p.out = (float*)d_out; p.ws = (unsigned char*)d_ws;
#if MULTI_LAUNCH
    for (int ph = 0; ph < 2 * NPHT; ++ph) { p.ph_lo = ph; p.ph_hi = ph + 1; hipLaunchKernelGGL(mega, dim3(grid_blocks), dim3(512), LDS_BYTES, stream, p); }
#else
    p.ph_lo = 0; p.ph_hi = 2 * NPHT;
    void* args[] = {&p};
    hipError_t e = hipLaunchCooperativeKernel((const void*)mega, dim3(grid_blocks), dim3(512), args, LDS_BYTES, stream);
    if (e != hipSuccess) fprintf(stderr, "cooperative launch failed: %s (grid %d)\n", hipGetErrorString(e), grid_blocks);
#endif
}
```

```cpp
#include <hip/hip_runtime.h>
#include <hip/hip_cooperative_groups.h>
#include <cstdio>
namespace cg = cooperative_groups;
__device__ __forceinline__ int tidx() { int t = threadIdx.x; asm volatile("" : "+v"(t)); return t; }
namespace pg8 {
#define PG8_LAS __attribute__((address_space(3)))
typedef unsigned short bf16_t;
typedef short bf16x8 __attribute__((ext_vector_type(8)));
typedef float f32x4 __attribute__((ext_vector_type(4)));
typedef unsigned u32x4 __attribute__((ext_vector_type(4)));
constexpr int BM = 256, BK = 64, HALF = 128, HTB = HALF * BK * 2  , STAGE_BYTES = 8 * HTB, NXCD = 8, WGM = 8;

__host__ __device__ __forceinline__ int lds_byte(int r, int c) { const int st = (r >> 4) * 2 + (c >> 5), rr = r & 15, cc = c & 31, ob = rr * 64 + cc * 2; return st * 1024 + (ob ^ (((ob >> 9) & 1) << 5)); }
__host__ __device__ __forceinline__ void stage_rc(int b, int& R, int& C) { const int st = b / 1024, sb = b % 1024, swz = sb ^ (((sb >> 9) & 1) << 5); R = (st >> 1) * 16 + swz / 64; C = (st & 1) * 32 + (swz % 64) / 2; }
__host__ __device__ __forceinline__ int perm32(int rho) { const int n = rho >> 4, i = rho & 15; return 8 * (i >> 2) + 4 * n + (i & 3); }

struct Unit { int pm, pn; };
struct Gemm { const bf16_t* A; const bf16_t* Bt; int M, N, K; };

struct StaticOrder {
    int nM, nN, nwg, G, c;
    __host__ __device__ void init(int M, int N, int G_, int c_) { nM = M / BM; nN = N / BM; nwg = nM * nN; G = G_; c = c_; }
    __host__ __device__ bool next(int i, Unit& u) const {
        const long L = (long)i * G + c; if (L >= nwg) return false;
        int wgid = (int)L; { const int q = nwg / NXCD, r = nwg % NXCD, xcd = wgid % NXCD, off = wgid / NXCD; wgid = (xcd < r ? xcd * (q + 1) : r * (q + 1) + (xcd - r) * q) + off; }
        const int nig = WGM * nN, gid = wgid / nig, fm = gid * WGM, gsz = (nM - fm) < WGM ? (nM - fm) : WGM;
        u.pm = fm + ((wgid % nig) % gsz); u.pn = (wgid % nig) / gsz; return true;
    }
    __device__ __forceinline__ void a_ready(const Unit&) const {}
    __device__ __forceinline__ void done(const Unit&) const {}
};
__device__ __forceinline__ unsigned cvt_pk_bf16(float lo, float hi) { unsigned r; asm volatile("v_cvt_pk_bf16_f32 %0, %1, %2" : "=v"(r) : "v"(lo), "v"(hi)); return r; }
template <class Epi, class Sched, bool STAMP = false>
__device__ __forceinline__ void gemm_phase(PG8_LAS unsigned char* lds, const Gemm g, const Sched& S, const Epi& E, unsigned long long* stamps) {
    const int tid = tidx(), wid = __builtin_amdgcn_readfirstlane(tid >> 6), lane = tid & 63, wr = wid >> 2, wc = wid & 3, fr = lane & 15, fq = lane >> 4;
    const int K = g.K, nt = K / BK;
    int ts_lo = 0, ts_hi = 0, nts = 0; const unsigned long long rt_entry = STAMP ? (unsigned long long)wall_clock64() : 0ull;
#define PG8_STAMP() do { if (STAMP && wid == 0 && nts < 64) { const unsigned long long _c = (unsigned long long)clock64(); \
        ts_lo = (lane == nts) ? (int)(unsigned)_c : ts_lo; ts_hi = (lane == nts) ? (int)(unsigned)(_c >> 32) : ts_hi; ++nts; } } while (0)
    PG8_STAMP();
    unsigned voffA[2], voffB[2];
#pragma unroll
    for (int i = 0; i < 2; ++i) { int R, C; stage_rc(tid * 16 + i * 8192, R, C); const int Rb = Epi::PERM ? ((R & ~31) + perm32(R & 31)) : R;
        voffA[i] = (unsigned)(R * K + C) * 2u; voffB[i] = (unsigned)(Rb * K + C) * 2u; }
    const size_t kstep = (size_t)(BK * 2);
    const size_t hstep = (size_t)HALF * K * 2;
    const size_t tstep = 2 * hstep;
    const unsigned ldsw = (unsigned)wid * 1024u;
    const int aoff = lds_byte(wr * 64 + fr, fq * 8), boff = lds_byte(wc * 32 + fr, fq * 8);
#define PG8_SA(b, h) (((b) * 2 + (h)) * HTB)
#define PG8_SB(b, h) ((4 + (b) * 2 + (h)) * HTB)
#define PG8_STAGE(bufoff, gbase, voff) do { _Pragma("unroll") for (int _i = 0; _i < 2; ++_i) \
        __builtin_amdgcn_global_load_lds((const unsigned*)((const char*)(gbase) + (voff)[_i]), (PG8_LAS unsigned*)(lds + (bufoff) + ldsw + _i * 8192), 16, 0, 0); } while (0)
#define PG8_LDA(dst, b, h) do { _Pragma("unroll") for (int m = 0; m < 4; ++m) _Pragma("unroll") for (int k = 0; k < 2; ++k) dst[m][k] = *(const PG8_LAS bf16x8*)(lds + PG8_SA(b, h) + aoff + m * 2048 + k * 1024); } while (0)
#define PG8_LDB(dst, b, h) do { _Pragma("unroll") for (int n = 0; n < 2; ++n) _Pragma("unroll") for (int k = 0; k < 2; ++k) dst[n][k] = *(const PG8_LAS bf16x8*)(lds + PG8_SB(b, h) + boff + n * 2048 + k * 1024); } while (0)
#define PG8_MMA(ai, bj, At, Bt) do { __builtin_amdgcn_s_setprio(1); _Pragma("unroll") for (int m = 0; m < 4; ++m) _Pragma("unroll") for (int n = 0; n < 2; ++n) _Pragma("unroll") for (int k = 0; k < 2; ++k) \
        acc[ai][bj][m][n] = __builtin_amdgcn_mfma_f32_16x16x32_bf16(Bt[n][k], At[m][k], acc[ai][bj][m][n], 0, 0, 0); __builtin_amdgcn_s_setprio(0); } while (0)
#define PG8_WAIT_V(n) asm volatile("s_waitcnt vmcnt(" #n ")" ::: "memory")
#define PG8_WAIT_L(n) asm volatile("s_waitcnt lgkmcnt(" #n ")" ::: "memory")
#define PG8_BAR __builtin_amdgcn_s_barrier()
#define PG8_SCHED __builtin_amdgcn_sched_barrier(0)
    Unit cur, nxt; int ui = 0;
    if (!S.next(0, cur)) return;
    f32x4 acc[2][2][4][2];
#pragma unroll
    for (int a = 0; a < 2; ++a)
#pragma unroll
        for (int b = 0; b < 2; ++b)
#pragma unroll
            for (int m = 0; m < 4; ++m)
#pragma unroll
                for (int n = 0; n < 2; ++n) acc[a][b][m][n] = (f32x4){0.f, 0.f, 0.f, 0.f};
    bf16x8 At[4][2], B0[2][2], B1[2][2];
    const char* cA = (const char*)g.A + (size_t)cur.pm * tstep; const char* cB = (const char*)g.Bt + (size_t)cur.pn * tstep;
    S.a_ready(cur);
    PG8_STAGE(PG8_SB(0, 0), cB, voffB); PG8_STAGE(PG8_SA(0, 0), cA, voffA); PG8_STAGE(PG8_SB(0, 1), cB + hstep, voffB); PG8_STAGE(PG8_SA(0, 1), cA + hstep, voffA);
    if (wr == 1) PG8_BAR;
    PG8_WAIT_V(4); PG8_BAR;
    PG8_STAGE(PG8_SB(1, 0), cB + kstep, voffB); PG8_STAGE(PG8_SA(1, 0), cA + kstep, voffA); PG8_STAGE(PG8_SB(1, 1), cB + hstep + kstep, voffB);
    PG8_WAIT_V(6); PG8_BAR;
    PG8_STAMP();
    for (;;) {
        const bool has_next = S.next(ui + 1, nxt);
        const char* nA = has_next ? (const char*)g.A + (size_t)nxt.pm * tstep : cA; const char* nB = has_next ? (const char*)g.Bt + (size_t)nxt.pn * tstep : cB;
        for (int t = 0; t < nt; t += 2) {
            const bool last = (t == nt - 2);
            const char* a1 = cA + (size_t)(t + 1) * kstep;
            const char* a2 = last ? nA : cA + (size_t)(t + 2) * kstep; const char* b2 = last ? nB : cB + (size_t)(t + 2) * kstep;
            const char* a3 = a2 + kstep; const char* b3 = b2 + kstep;
            if (last && has_next) S.a_ready(nxt);
            PG8_LDB(B0, 0, 0); PG8_SCHED; PG8_LDA(At, 0, 0); PG8_STAGE(PG8_SA(1, 1), a1 + hstep, voffA);
            PG8_WAIT_L(8); PG8_BAR; PG8_WAIT_L(0); PG8_MMA(0, 0, At, B0); PG8_BAR; PG8_SCHED;
            PG8_LDB(B1, 0, 1); PG8_STAGE(PG8_SB(0, 0), b2, voffB);
            PG8_BAR; PG8_WAIT_L(0); PG8_MMA(0, 1, At, B1); PG8_BAR;
            PG8_LDA(At, 0, 1); PG8_STAGE(PG8_SA(0, 0), a2, voffA);
            PG8_BAR; PG8_WAIT_L(0); PG8_MMA(1, 0, At, B0); PG8_BAR; PG8_SCHED;
            PG8_STAGE(PG8_SB(0, 1), b2 + hstep, voffB);
            PG8_WAIT_V(6); PG8_BAR; PG8_MMA(1, 1, At, B1); PG8_BAR;
            PG8_LDB(B0, 1, 0); PG8_SCHED; PG8_LDA(At, 1, 0); PG8_STAGE(PG8_SA(0, 1), a2 + hstep, voffA);
            PG8_WAIT_L(8); PG8_BAR; PG8_WAIT_L(0); PG8_MMA(0, 0, At, B0); PG8_BAR; PG8_SCHED;
            PG8_LDB(B1, 1, 1); PG8_STAGE(PG8_SB(1, 0), b3, voffB);
            PG8_BAR; PG8_WAIT_L(0); PG8_MMA(0, 1, At, B1); PG8_BAR;
            PG8_LDA(At, 1, 1); PG8_STAGE(PG8_SA(1, 0), a3, voffA);
            PG8_BAR; PG8_WAIT_L(0); PG8_MMA(1, 0, At, B0); PG8_BAR; PG8_SCHED;
            PG8_STAGE(PG8_SB(1, 1), b3 + hstep, voffB);
            PG8_WAIT_V(6); PG8_BAR; PG8_MMA(1, 1, At, B1); PG8_BAR;
        }
        PG8_STAMP();
        if constexpr (!Epi::AFTER_DRAIN) { E(acc, cur, wr, wc, fr, fq); S.done(cur); }
        PG8_STAMP();
        if (!has_next) break;
#pragma unroll
        for (int a = 0; a < 2; ++a)
#pragma unroll
            for (int b = 0; b < 2; ++b)
#pragma unroll
                for (int m = 0; m < 4; ++m)
#pragma unroll
                    for (int n = 0; n < 2; ++n) acc[a][b][m][n] = (f32x4){0.f, 0.f, 0.f, 0.f};
        cur = nxt; cA = nA; cB = nB; ++ui;
    }
    PG8_WAIT_V(0);
    if (wr == 0) PG8_BAR;
    PG8_BAR;
    if constexpr (Epi::AFTER_DRAIN) { E.fused(acc, cur, wr, wc, fr, fq, lds, wid, lane); S.done(cur); }
    PG8_STAMP();
    if (STAMP && wid == 0) { stamps[lane] = lane < nts ? (((unsigned long long)(unsigned)ts_hi << 32) | (unsigned)ts_lo) : 0ull;
        if (lane == 62) stamps[62] = rt_entry; if (lane == 63) stamps[63] = (unsigned long long)wall_clock64(); }
#undef PG8_STAMP
#undef PG8_SA
#undef PG8_SB
#undef PG8_STAGE
#undef PG8_LDA
#undef PG8_LDB
#undef PG8_MMA
#undef PG8_WAIT_V
#undef PG8_WAIT_L
#undef PG8_BAR
#undef PG8_SCHED
}
}
#define XB_TMO      128
#define XB_XCNT(j)  (256  + 64 * (j))
#define XB_XSUB(j)  (1280 + 64 * (j))
#define XB_XGEN(j)  (2304 + 64 * (j))
#define XB_TOP      3328
#define XB_TOPGEN   3392
#define XCD_BAR_WORDS 3456
#define XB_SPIN_CAP (1u << 18)
#define XB_LAS __attribute__((address_space(3)))

__device__ __forceinline__ unsigned xb_ld(unsigned* p)              { return __hip_atomic_load(p, __ATOMIC_RELAXED, __HIP_MEMORY_SCOPE_AGENT); }
__device__ __forceinline__ unsigned xb_add(unsigned* p, unsigned v) { return __hip_atomic_fetch_add(p, v, __ATOMIC_RELAXED, __HIP_MEMORY_SCOPE_AGENT); }
__device__ __forceinline__ unsigned xb_xcc_id() { return (unsigned)__builtin_amdgcn_s_getreg((3 << 11) | 20) & 0xFu; }
#define XB_SPIN(cond, bar) do { unsigned _sp = 0; while (cond) { __builtin_amdgcn_s_sleep(1); \
    if ((++_sp & 255u) == 0u) { if (xb_ld(&(bar)[XB_TMO])) break; if (_sp > XB_SPIN_CAP) { atomicAdd(&(bar)[XB_TMO], 1u); break; } } } } while (0)

struct XcdBarrier {
    unsigned* bar; unsigned x;
    volatile XB_LAS unsigned* st;
};

__device__ __forceinline__ XcdBarrier xcd_barrier_post(unsigned* bar, volatile XB_LAS unsigned* st) {
    XcdBarrier b; b.bar = bar; b.x = xb_xcc_id(); b.st = st;
    if (threadIdx.x == 0) (void)xb_add(&bar[XB_XCNT(b.x)], 1u);
    return b;
}
__device__ __forceinline__ void xcd_barrier_complete(unsigned* bar, unsigned x, unsigned& nloc, unsigned& nx) {
    const unsigned G = gridDim.x * gridDim.y * gridDim.z;
    unsigned sum, cnt, mine, sp = 0u;
    for (;;) {
        sum = 0u; cnt = 0u; mine = 0u;
#pragma unroll
        for (unsigned j = 0; j < 16; ++j) { const unsigned c = xb_ld(&bar[XB_XCNT(j)]); sum += c; cnt += (c > 0u) ? 1u : 0u; mine = (j == x) ? c : mine; }
        if (sum == G) break;
        __builtin_amdgcn_s_sleep(1);
        if ((++sp & 255u) == 0u) { if (xb_ld(&bar[XB_TMO])) break; if (sp > XB_SPIN_CAP) { atomicAdd(&bar[XB_TMO], 1u); break; } }
    }
    nloc = mine > 0u ? mine : 1u; nx = cnt > 0u ? cnt : 1u;
}

__device__ __forceinline__ void xcd_barrier(const XcdBarrier& b) {
    asm volatile("s_waitcnt vmcnt(0)" ::: "memory");
    __syncthreads();
    if (threadIdx.x == 0) {
        unsigned* bar = b.bar;
        __builtin_amdgcn_s_waitcnt(0);
        unsigned nloc = b.st[0], nx = b.st[1];
        if (nloc == 0u) { xcd_barrier_complete(bar, b.x, nloc, nx); b.st[0] = nloc; b.st[1] = nx; }
        const unsigned old = xb_add(&bar[XB_XSUB(b.x)], 1u);
        const unsigned gen = old / nloc;
        if (old + 1u == (gen + 1u) * nloc) {
            __builtin_amdgcn_fence(__ATOMIC_RELEASE, "agent");
            asm volatile("s_waitcnt vmcnt(0)" ::: "memory");
            const unsigned og = xb_add(&bar[XB_TOP], 1u);
            const unsigned tg = og / nx;
            if (og + 1u == (tg + 1u) * nx) xb_add(&bar[XB_TOPGEN], 1u);
            else XB_SPIN(xb_ld(&bar[XB_TOPGEN]) == tg, bar);
            __builtin_amdgcn_fence(__ATOMIC_ACQUIRE, "agent");
            xb_add(&bar[XB_XGEN(b.x)], 1u);
            asm volatile("s_waitcnt vmcnt(0)" ::: "memory");
        } else {
            XB_SPIN(xb_ld(&bar[XB_XGEN(b.x)]) == gen, bar);
            __builtin_amdgcn_fence(__ATOMIC_ACQUIRE, "agent");
            asm volatile("s_waitcnt vmcnt(0)" ::: "memory");
        }
    }
    __syncthreads();
}
using pg8::bf16_t; using pg8::bf16x8; using pg8::f32x4; using pg8::u32x4; using pg8::Unit;
typedef unsigned u32x2 __attribute__((ext_vector_type(2)));
#define MFMA16(a, b, c) __builtin_amdgcn_mfma_f32_16x16x32_bf16((a), (b), (c), 0, 0, 0)

constexpr int T_ = 16384, DM = 2048, NIN = 6144, DFF = 5504, NFF = 11008;
constexpr int LDS_BYTES = 144 * 1024;
constexpr int NPH = 11;

constexpr size_t O_CTR   = 0;
constexpr size_t O_BAR   = 4096;
constexpr size_t O_WIN   = 4096 + 16384;
constexpr size_t O_WOUT  = O_WIN   + (size_t)NIN * DM * 2;
constexpr size_t O_WFIN  = O_WOUT  + (size_t)DM * DM * 2;
constexpr size_t O_WFOUT = O_WFIN  + (size_t)NFF * DM * 2;
constexpr size_t O_WCK   = O_WFOUT + (size_t)DM * DFF * 2;
constexpr size_t O_WCV   = O_WCK   + (size_t)256 * 2048 * 2;
constexpr size_t O_WGLU  = O_WCV   + (size_t)256 * 2048 * 2;
constexpr size_t O_HN    = O_WGLU  + (size_t)512 * 512 * 2;
constexpr size_t O_R     = O_HN    + (size_t)T_ * DM * 2;
constexpr size_t O_P32   = O_R;
constexpr size_t O_PU    = O_P32   + (size_t)T_ * 1536 * 4;
constexpr size_t O_PQKV  = O_PU    + (size_t)T_ * 512 * 2;
constexpr size_t O_PZ    = O_PQKV  + (size_t)T_ * 3072 * 2;
constexpr size_t O_QN    = O_PZ    + (size_t)T_ * 1024 * 2;
constexpr size_t O_KSN   = O_QN    + (size_t)T_ * 512 * 2;
constexpr size_t O_KWN   = O_KSN   + (size_t)T_ * 128 * 2;
constexpr size_t O_VST   = O_KWN   + (size_t)T_ * 128 * 2;
constexpr size_t O_VWT   = O_VST   + (size_t)T_ * 128 * 2;
constexpr size_t O_KC    = O_VWT   + (size_t)T_ * 128 * 2;
constexpr size_t O_VCT   = O_KC    + (size_t)2 * 1024 * 64 * 2;
constexpr size_t O_HCMP  = O_VCT   + (size_t)2 * 64 * 1024 * 2;
constexpr size_t O_GKC   = O_HCMP  + (size_t)2 * 2048 * 256 * 4;
constexpr size_t O_GQG   = O_GKC   + (size_t)2048 * 64 * 128 * 2;
constexpr size_t O_GQK   = O_GQG   + (size_t)2048 * 64 * 128 * 2;
constexpr size_t O_GKD   = O_GQK   + (size_t)2048 * 64 * 64 * 2;
constexpr size_t O_GVAL  = O_GKD   + (size_t)2048 * 64 * 128 * 2;
constexpr size_t O_GEGL  = O_GVAL  + (size_t)2048 * 64 * 128 * 4;
constexpr size_t O_XEND  = O_GEGL  + 8192;
constexpr size_t O_YGELU = O_XEND  + (size_t)64 * 32 * 64 * 2 * 4;
constexpr size_t O_YGLU  = O_YGELU + (size_t)T_ * 512 * 2;
constexpr size_t O_ATT_END = O_YGLU + (size_t)T_ * 512 * 4;
constexpr size_t O_HF    = O_R;
constexpr size_t O_ACT   = O_HF    + (size_t)256 * 4 * NFF * 4;
constexpr size_t O_FFN_END = O_ACT + (size_t)T_ * DFF * 2;
constexpr size_t WS_NEED = O_ATT_END > O_FFN_END ? O_ATT_END : O_FFN_END;

struct Params { const float* in[33]; float* out; unsigned char* ws; int ph_lo, ph_hi; };

__device__ __forceinline__ unsigned short f2bf(float f) { unsigned u = __float_as_uint(f); u += 0x7FFFu + ((u >> 16) & 1u); return (unsigned short)(u >> 16); }
__device__ __forceinline__ float bf2f(unsigned short b) { return __uint_as_float(((unsigned)b) << 16); }
__device__ __forceinline__ unsigned pk2(float lo, float hi) { return pg8::cvt_pk_bf16(lo, hi); }
__device__ __forceinline__ float bflo(unsigned w) { return __uint_as_float(w << 16); }
__device__ __forceinline__ float bfhi(unsigned w) { return __uint_as_float(w & 0xFFFF0000u); }
__device__ __forceinline__ float sigmoidf_(float x) { return __builtin_amdgcn_rcpf(1.0f + __expf(-x)); }
__device__ __forceinline__ float siluf_(float x) { return x * __builtin_amdgcn_rcpf(1.0f + __expf(-x)); }
__device__ __forceinline__ float vmaxf(float a, float b) { float r; asm("v_max_f32 %0, %1, %2" : "=v"(r) : "v"(a), "v"(b)); return r; }
__device__ __forceinline__ float gelu_tanh(float x) { const float u = 0.7978845608028654f * (x + 0.044715f * x * x * x); const float th = 1.0f - 2.0f * __builtin_amdgcn_rcpf(__expf(2.0f * u) + 1.0f); return 0.5f * x * (1.0f + th); }
__device__ __forceinline__ float softplusf_(float x) { return x > 20.f ? x : log1pf(expf(x)); }
__device__ __forceinline__ float wave_sum(float v) { for (int o = 32; o >= 1; o >>= 1) v += __shfl_xor(v, o); return v; }
__device__ __forceinline__ bf16x8 pack8f(f32x4 a, f32x4 b) { u32x4 w; w.x = pk2(a[0], a[1]); w.y = pk2(a[2], a[3]); w.z = pk2(b[0], b[1]); w.w = pk2(b[2], b[3]); return __builtin_bit_cast(bf16x8, w); }
__device__ __forceinline__ float rdlane(float v, int l) { return __int_as_float(__builtin_amdgcn_readlane(__float_as_int(v), l)); }

struct EpiProj {
    static constexpr bool PERM = true, AFTER_DRAIN = false;
    float* P32; bf16_t* Pu; bf16_t* Pqkv; bf16_t* Pz;
    static __device__ __forceinline__ void st_bf(const f32x4 (&acc)[2][2][4][2], bf16_t* base, int ld) {
#pragma unroll
        for (int ai = 0; ai < 2; ++ai)
#pragma unroll
            for (int m = 0; m < 4; ++m) { bf16_t* rp = base + (size_t)(ai * 128 + m * 16) * ld;
#pragma unroll
                for (int bj = 0; bj < 2; ++bj) { const f32x4 v0 = acc[ai][bj][m][0], v1 = acc[ai][bj][m][1]; u32x4 w; w.x = pk2(v0[0], v0[1]); w.y = pk2(v0[2], v0[3]); w.z = pk2(v1[0], v1[1]); w.w = pk2(v1[2], v1[3]); *(u32x4*)(rp + bj * 128) = w; } }
    }
    __device__ __forceinline__ void operator()(const f32x4 (&acc)[2][2][4][2], const Unit& u, int wr, int wc, int fr, int fq) const {
        const int row0 = u.pm * 256 + wr * 64 + fr, colt = wc * 32 + 8 * fq;
        if (u.pn < 6) {
            float* base = P32 + (size_t)row0 * 1536 + u.pn * 256 + colt;
#pragma unroll
            for (int ai = 0; ai < 2; ++ai)
#pragma unroll
                for (int m = 0; m < 4; ++m) { float* rp = base + (size_t)(ai * 128 + m * 16) * 1536;
#pragma unroll
                    for (int bj = 0; bj < 2; ++bj) { *(f32x4*)(rp + bj * 128) = acc[ai][bj][m][0]; *(f32x4*)(rp + bj * 128 + 4) = acc[ai][bj][m][1]; } }
        } else if (u.pn < 8)  st_bf(acc, Pu   + (size_t)row0 * 512  + (u.pn - 6)  * 256 + colt, 512);
        else if (u.pn < 20)   st_bf(acc, Pqkv + (size_t)row0 * 3072 + (u.pn - 8)  * 256 + colt, 3072);
        else                  st_bf(acc, Pz   + (size_t)row0 * 1024 + (u.pn - 20) * 256 + colt, 1024);
    }
};
struct EpiResid {
    static constexpr bool PERM = false, AFTER_DRAIN = false;
    float* X; int ld;
    __device__ __forceinline__ void operator()(const f32x4 (&acc)[2][2][4][2], const Unit& u, int wr, int wc, int fr, int fq) const {
        float* base = X + (size_t)(u.pm * 256 + wr * 64 + fr) * ld + u.pn * 256 + wc * 32 + 4 * fq;
#pragma unroll
        for (int ai = 0; ai < 2; ++ai)
#pragma unroll
            for (int m = 0; m < 4; ++m) { float* rp = base + (size_t)(ai * 128 + m * 16) * ld;
#pragma unroll
                for (int bj = 0; bj < 2; ++bj)
#pragma unroll
                    for (int n = 0; n < 2; ++n) { f32x4* q = (f32x4*)(rp + bj * 128 + n * 16); *q = *q + acc[ai][bj][m][n]; } }
    }
};
struct EpiBf {
    static constexpr bool PERM = true, AFTER_DRAIN = false;
    bf16_t* O; int ld;
    __device__ __forceinline__ void operator()(const f32x4 (&acc)[2][2][4][2], const Unit& u, int wr, int wc, int fr, int fq) const {
        bf16_t* base = O + (size_t)(u.pm * 256 + wr * 64 + fr) * ld + u.pn * 256 + wc * 32 + 8 * fq;
#pragma unroll
        for (int ai = 0; ai < 2; ++ai)
#pragma unroll
            for (int m = 0; m < 4; ++m) { bf16_t* rp = base + (size_t)(ai * 128 + m * 16) * ld;
#pragma unroll
                for (int bj = 0; bj < 2; ++bj) { const f32x4 v0 = acc[ai][bj][m][0], v1 = acc[ai][bj][m][1]; u32x4 w; w.x = pk2(v0[0], v0[1]); w.y = pk2(v0[2], v0[3]); w.z = pk2(v1[0], v1[1]); w.w = pk2(v1[2], v1[3]); *(u32x4*)(rp + bj * 128) = w; } }
    }
};
struct EpiGlu {
    static constexpr bool PERM = false, AFTER_DRAIN = false;
    const bf16_t* Y; float* O;
    __device__ __forceinline__ void operator()(const f32x4 (&acc)[2][2][4][2], const Unit& u, int wr, int wc, int fr, int fq) const {
        const size_t off0 = (size_t)(u.pm * 256 + wr * 64 + fr) * 512 + u.pn * 256 + wc * 32 + 4 * fq;
#pragma unroll
        for (int ai = 0; ai < 2; ++ai)
#pragma unroll
            for (int m = 0; m < 4; ++m) { const size_t ro = off0 + (size_t)(ai * 128 + m * 16) * 512;
#pragma unroll
                for (int bj = 0; bj < 2; ++bj)
#pragma unroll
                    for (int n = 0; n < 2; ++n) { const size_t o = ro + bj * 128 + n * 16; const u32x2 yw = *(const u32x2*)(Y + o); const f32x4 a = acc[ai][bj][m][n];
                        f32x4 r; r[0] = bflo(yw.x) * sigmoidf_(a[0]); r[1] = bfhi(yw.x) * sigmoidf_(a[1]); r[2] = bflo(yw.y) * sigmoidf_(a[2]); r[3] = bfhi(yw.y) * sigmoidf_(a[3]); *(f32x4*)(O + o) = r; } }
    }
};

template <int CTRL> __device__ __forceinline__ f32x4 ror4(const f32x4 v) { f32x4 r;
    r[0] = __int_as_float(__builtin_amdgcn_update_dpp(0, __float_as_int(v[0]), CTRL, 0xF, 0xF, true)); r[1] = __int_as_float(__builtin_amdgcn_update_dpp(0, __float_as_int(v[1]), CTRL, 0xF, 0xF, true));
    r[2] = __int_as_float(__builtin_amdgcn_update_dpp(0, __float_as_int(v[2]), CTRL, 0xF, 0xF, true)); r[3] = __int_as_float(__builtin_amdgcn_update_dpp(0, __float_as_int(v[3]), CTRL, 0xF, 0xF, true)); return r; }
struct EpiFfnAct {
    static constexpr bool PERM = true, AFTER_DRAIN = false;
    bf16_t* act; float* hb; const float* cw; const float* cb;
    __device__ __forceinline__ void operator()(const f32x4 (&acc)[2][2][4][2], const Unit& u, int wr, int wc, int fr, int fq) const {
        const int colg = 128 * u.pn + wc * 32 + 8 * fq;
#pragma unroll
        for (int n = 0; n < 2; ++n) {
            const int g0 = colg + 4 * n;
            const f32x4 wg0 = *(const f32x4*)(cw + g0), wg1 = *(const f32x4*)(cw + NFF + g0), wg2 = *(const f32x4*)(cw + 2 * NFF + g0), bg = *(const f32x4*)(cb + g0);
            const f32x4 wu0 = *(const f32x4*)(cw + DFF + g0), wu1 = *(const f32x4*)(cw + NFF + DFF + g0), wu2 = *(const f32x4*)(cw + 2 * NFF + DFF + g0), bu = *(const f32x4*)(cb + DFF + g0);
#pragma unroll
            for (int ai = 0; ai < 2; ++ai) {
                const int grp = 4 * u.pm + 2 * ai + wr;
                float* hbg = hb + (size_t)grp * 4 * NFF + 256 * u.pn + wc * 32 + 8 * fq + 4 * n;
#pragma unroll
                for (int m = 0; m < 4; ++m) {
                    const f32x4 cg = acc[ai][0][m][n], cu = acc[ai][1][m][n];
                    const f32x4 pg = acc[ai][0][m > 0 ? m - 1 : 0][n], pu = acc[ai][1][m > 0 ? m - 1 : 0][n];
                    const f32x4 g1a = ror4<0x121>(cg), g2a = ror4<0x122>(cg), u1a = ror4<0x121>(cu), u2a = ror4<0x122>(cu);
                    const f32x4 g1b = ror4<0x121>(pg), g2b = ror4<0x122>(pg), u1b = ror4<0x121>(pu), u2b = ror4<0x122>(pu);
                    f32x4 g1, g2, u1, u2;
#pragma unroll
                    for (int e = 0; e < 4; ++e) { g1[e] = fr == 0 ? g1b[e] : g1a[e]; g2[e] = fr < 2 ? g2b[e] : g2a[e]; u1[e] = fr == 0 ? u1b[e] : u1a[e]; u2[e] = fr < 2 ? u2b[e] : u2a[e]; }
                    const f32x4 G = bg + wg0 * g2 + wg1 * g1 + wg2 * cg, U = bu + wu0 * u2 + wu1 * u1 + wu2 * cu;
                    u32x2 w; w.x = pk2(siluf_(G[0]) * U[0], siluf_(G[1]) * U[1]); w.y = pk2(siluf_(G[2]) * U[2], siluf_(G[3]) * U[3]);
                    const int row = u.pm * 256 + ai * 128 + wr * 64 + m * 16 + fr;
                    if (m > 0 || fr >= 2) *(u32x2*)(act + (size_t)row * DFF + g0) = w;
                    if (m == 0 && fr < 2)  { *(f32x4*)(hbg + (size_t)fr * NFF) = cg; *(f32x4*)(hbg + (size_t)fr * NFF + 128) = cu; }
                    if (m == 3 && fr >= 14) { *(f32x4*)(hbg + (size_t)(fr - 12) * NFF) = cg; *(f32x4*)(hbg + (size_t)(fr - 12) * NFF + 128) = cu; }
                }
            }
        }
    }
};
__device__ __forceinline__ int map_in_col(int n) { return n < 1304 ? n : (n < 1312 ? 5912 + (n - 1304) : (n < 1320 ? 5920 + (n - 1312) : (n < 1536 ? -1 : 1304 + (n - 1536)))); }
struct ConvJob { const float* src; bf16_t* dst; int srcN, K, tile; int inmap; };
__device__ __forceinline__ bool conv_job(const Params& p, int layer, int it, ConvJob& j) {
    unsigned char* ws = p.ws;
    const int n0 = 32 * 24, n1 = n0 + 32 * 8, n2 = n1 + 32 * 43, n3 = n2 + 86 * 8, n4 = n3 + 32, n5 = n4 + 32, n6 = n5 + 16;
    if (it >= n6) return false;
    j.inmap = 0;
    if (it < n0)      { j.src = p.in[2]  + (size_t)layer * DM * 5928; j.srcN = 5928; j.K = DM; j.dst = (bf16_t*)(ws + O_WIN); j.tile = it; j.inmap = 1; }
    else if (it < n1) { j.src = p.in[27] + (size_t)layer * DM * DM; j.srcN = DM; j.K = DM; j.dst = (bf16_t*)(ws + O_WOUT); j.tile = it - n0; }
    else if (it < n2) { j.src = p.in[29] + (size_t)layer * DM * NFF; j.srcN = NFF; j.K = DM; j.dst = (bf16_t*)(ws + O_WFIN); j.tile = it - n1; j.inmap = 2; }
    else if (it < n3) { j.src = p.in[32] + (size_t)layer * DFF * DM; j.srcN = DM; j.K = DFF; j.dst = (bf16_t*)(ws + O_WFOUT); j.tile = it - n2; }
    else if (it < n4) { j.src = p.in[8]  + (size_t)layer * 2048 * 256; j.srcN = 256; j.K = 2048; j.dst = (bf16_t*)(ws + O_WCK); j.tile = it - n3; }
    else if (it < n5) { j.src = p.in[10] + (size_t)layer * 2048 * 256; j.srcN = 256; j.K = 2048; j.dst = (bf16_t*)(ws + O_WCV); j.tile = it - n4; }
    else              { j.src = p.in[21] + (size_t)layer * 512 * 512; j.srcN = 512; j.K = 512; j.dst = (bf16_t*)(ws + O_WGLU); j.tile = it - n5; }
    return true;
}
__device__ __forceinline__ void conv_load(const ConvJob& j, int tid, float (&v)[32]) {
    const int nk = j.K >> 6, tk = j.tile % nk, tn = j.tile / nk, k0 = tk * 64, n0 = tn * 256, tx = tid & 255, ty = tid >> 8;
    const int n = n0 + tx, sc = j.inmap == 1 ? map_in_col(n) : (j.inmap == 2 ? ((n & 255) < 128 ? 128 * (n >> 8) + (n & 127) : DFF + 128 * (n >> 8) + (n & 127)) : n);
    const float* sp = j.src + (size_t)(k0 + ty) * j.srcN + (sc >= 0 ? sc : 0);
#pragma unroll
    for (int i = 0; i < 32; ++i) v[i] = (sc >= 0) ? sp[(size_t)(2 * i) * j.srcN] : 0.f;
}
__device__ __forceinline__ void conv_store(const ConvJob& j, int tid, const float (&v)[32], float* sm) {
    const int nk = j.K >> 6, tk = j.tile % nk, tn = j.tile / nk, k0 = tk * 64, n0 = tn * 256, tx = tid & 255, ty = tid >> 8;
#pragma unroll
    for (int i = 0; i < 32; ++i) sm[(ty + 2 * i) * 257 + tx] = v[i];
    __syncthreads();
    const int nn = tid >> 1, hf = tid & 1;
    bf16_t* o = j.dst + (size_t)(n0 + nn) * j.K + k0 + hf * 32;
#pragma unroll
    for (int q = 0; q < 4; ++q) { u32x4 w; const float* sp = sm + (hf * 32 + q * 8) * 257 + nn;
        w.x = pk2(sp[0], sp[257]); w.y = pk2(sp[2 * 257], sp[3 * 257]); w.z = pk2(sp[4 * 257], sp[5 * 257]); w.w = pk2(sp[6 * 257], sp[7 * 257]); *(u32x4*)(o + q * 8) = w; }
    __syncthreads();
}
__device__ void phase_convert(const Params& p, int layer, float* sm) {
    const int G = gridDim.x, tid = tidx();
    ConvJob ja, jb; float va[32], vb[32];
    int it = blockIdx.x;
    bool ha = conv_job(p, layer, it, ja);
    if (ha) conv_load(ja, tid, va);
    while (ha) {
        const bool hb = conv_job(p, layer, it + G, jb);
        if (hb) conv_load(jb, tid, vb);
        conv_store(ja, tid, va, sm);
        if (!hb) break;
        ha = conv_job(p, layer, it + 2 * G, ja);
        if (ha) conv_load(ja, tid, va);
        conv_store(jb, tid, vb, sm);
        it += 2 * G;
    }
}
__device__ void phase_rmsnorm(const float* __restrict__ x, const float* __restrict__ gain, bf16_t* __restrict__ hn, float* __restrict__ xcopy) {
    const int wave = tidx() >> 6, lane = tidx() & 63;
    for (int r = blockIdx.x * 8 + wave; r < T_; r += gridDim.x * 8) {
        const f32x4* xr = (const f32x4*)(x + (size_t)r * DM);
        f32x4 v[8]; float ss = 0.f;
#pragma unroll
        for (int i = 0; i < 8; ++i) { v[i] = xr[lane + 64 * i]; ss += v[i][0] * v[i][0] + v[i][1] * v[i][1] + v[i][2] * v[i][2] + v[i][3] * v[i][3]; }
        ss = wave_sum(ss);
        const float rs = rsqrtf(ss * (1.0f / DM) + 1e-6f);
#pragma unroll
        for (int i = 0; i < 8; ++i) { const f32x4 g = ((const f32x4*)gain)[lane + 64 * i]; u32x2 w; w.x = pk2(v[i][0] * rs * g[0], v[i][1] * rs * g[1]); w.y = pk2(v[i][2] * rs * g[2], v[i][3] * rs * g[3]);
            *(u32x2*)(hn + (size_t)r * DM + (lane + 64 * i) * 4) = w; if (xcopy) ((f32x4*)(xcopy + (size_t)r * DM))[lane + 64 * i] = v[i]; }
    }
}

__device__ void nsa_prep_item(const Params& p, int layer, int item, float* sm) {
    unsigned char* ws = p.ws;
    const float* P32 = (const float*)(ws + O_P32);
    bf16_t* qn = (bf16_t*)(ws + O_QN); bf16_t* ksn = (bf16_t*)(ws + O_KSN); bf16_t* kwn = (bf16_t*)(ws + O_KWN);
    const int wave = tidx() >> 6, lane = tidx() & 63, tid = tidx();
    const int t0 = item * 64;
    const float gq = p.in[3][layer * 64 + lane], gks = p.in[5][layer * 64 + lane], gkw = p.in[6][layer * 64 + lane];
    const float inv = powf(500000.0f, -(float)(lane & 7) * 0.125f);
    for (int tt = 0; tt < 8; ++tt) {
        const int t = t0 + wave * 8 + tt;
        float sn, cs; sincosf((float)t * inv, &sn, &cs);
        const float* row = P32 + (size_t)t * 1536;
#pragma unroll
        for (int hv = 0; hv < 12; ++hv) {
            const int col = hv < 8 ? hv * 64 : (hv < 10 ? 768 + (hv - 8) * 64 : 1024 + (hv - 10) * 64);
            const float g = hv < 8 ? gq : (hv < 10 ? gks : gkw);
            const float x = row[col + lane];
            const float ss = wave_sum(x * x);
            float y = x * rsqrtf(ss * (1.0f / 64.0f) + 1e-6f) * g;
            const float yp = __shfl(y, lane ^ 8);
            if (lane < 8) y = y * cs - yp * sn; else if (lane < 16) y = y * cs + yp * sn;
            if (hv < 8) qn[(size_t)t * 512 + hv * 64 + lane] = f2bf(y * 0.18033688011112042f);
            else {
                unsigned char* k8 = (hv < 10 ? ws + O_KSN : ws + O_KWN) + ((size_t)(((hv - 8) & 1) * 256 + (t >> 6)) * 64 + (t & 63)) * 64 + ((lane >> 3) & 3) * 16 + (lane >> 5) * 8 + (lane & 7);
                *k8 = (unsigned char)__builtin_amdgcn_cvt_pk_fp8_f32(y, 0.f, 0, false);
            }
        }
    }
    for (int e = tid; e < 64 * 256; e += 512) { const int tk = e >> 8, c = e & 255; sm[tk * 257 + c] = P32[(size_t)(t0 + tk) * 1536 + (c < 128 ? 896 + c : 1152 + (c - 128))]; }
    __syncthreads();
    unsigned char* vs8 = ws + O_VST; unsigned char* vw8 = ws + O_VWT;
#pragma unroll
    for (int i = 0; i < 4; ++i) {
        const int rowid = (tid >> 3) + 64 * i, ts = tid & 7;
        float f[8];
#pragma unroll
        for (int k = 0; k < 8; ++k) { const int bb = ts * 8 + k, cc = ((bb >> 3) & 1) * 32 + (bb >> 4) * 8 + (bb & 7); f[k] = sm[((cc & 3) * 16 + (cc >> 2)) * 257 + rowid]; }
        u32x2 w; int t;
        t = __builtin_amdgcn_cvt_pk_fp8_f32(f[0], f[1], 0, false); t = __builtin_amdgcn_cvt_pk_fp8_f32(f[2], f[3], t, true); w.x = (unsigned)t;
        t = __builtin_amdgcn_cvt_pk_fp8_f32(f[4], f[5], 0, false); t = __builtin_amdgcn_cvt_pk_fp8_f32(f[6], f[7], t, true); w.y = (unsigned)t;
        const int rr = rowid & 127;
        unsigned char* dst = (rowid < 128 ? vs8 : vw8) + ((size_t)((rr >> 6) * 256 + item) * 64 + (rr & 63)) * 64 + ts * 8;
        *(u32x2*)dst = w;
    }
    __syncthreads();
}

__device__ void cmp1_wave_tile(const Params& p, int layer, int tile) {
    unsigned char* ws = p.ws;
    const float* P32 = (const float*)(ws + O_P32);
    const int lane = tidx() & 63, fr = lane & 15, fq = lane >> 4;
    const int nt = tile & 15, mt = (tile >> 4) & 127, which = tile >> 11;
    const bf16_t* Wt = (const bf16_t*)(ws + (which ? O_WCV : O_WCK)) + (size_t)(nt * 16 + fr) * 2048 + fq * 8;
    const float* pe = p.in[7] + (size_t)layer * 2048;
    const int r = mt * 16 + fr, n = r >> 1, hk = r & 1;
    const bool rv = n < 1023;
    const float* arow = P32 + (size_t)(16 * (rv ? n : 0)) * 1536 + (which ? 640 : 512) + hk * 64 + fq * 8;
    f32x4 acc = {0.f, 0.f, 0.f, 0.f};
#pragma unroll 8
    for (int ks = 0; ks < 64; ++ks) {
        const int l = ks >> 1, d = (ks & 1) * 32;
        const f32x4* ap = (const f32x4*)(arow + (size_t)l * 1536 + d);
        const f32x4* pp = (const f32x4*)(pe + l * 64 + d + fq * 8);
        f32x4 a0 = ap[0] + pp[0], a1 = ap[1] + pp[1];
        if (!rv) { a0 = (f32x4){0.f, 0.f, 0.f, 0.f}; a1 = a0; }
        const bf16x8 af = pack8f(a0, a1);
        const bf16x8 bf = *(const bf16x8*)(Wt + ks * 32);
        acc = MFMA16(af, bf, acc);
    }
    float* H = (float*)(ws + O_HCMP) + (size_t)which * 2048 * 256;
#pragma unroll
    for (int j = 0; j < 4; ++j) H[(size_t)(mt * 16 + fq * 4 + j) * 256 + nt * 16 + fr] = gelu_tanh(acc[j]);
}
__device__ void cmp2_wave_row(const Params& p, int layer, int idx) {
    unsigned char* ws = p.ws;
    const int lane = tidx() & 63;
    const int which = idx >> 11, r = idx & 2047, n = r >> 1, hk = r & 1;
    const float* H = (const float*)(ws + O_HCMP) + ((size_t)which * 2048 + r) * 256;
    const float* w2 = p.in[which ? 11 : 9] + (size_t)layer * 256 * 64;
    float acc = 0.f;
    if (n < 1023) {
        float a4[4] = {0.f, 0.f, 0.f, 0.f};
#pragma unroll 8
        for (int f = 0; f < 256; f += 4) { const f32x4 h4 = *(const f32x4*)(H + f); a4[0] += h4[0] * w2[f * 64 + lane]; a4[1] += h4[1] * w2[(f + 1) * 64 + lane]; a4[2] += h4[2] * w2[(f + 2) * 64 + lane]; a4[3] += h4[3] * w2[(f + 3) * 64 + lane]; }
        acc = (a4[0] + a4[1]) + (a4[2] + a4[3]);
    }
    if (which == 0) {
        const float ss = wave_sum(acc * acc);
        float y = acc * rsqrtf(ss * (1.0f / 64.0f) + 1e-6f) * p.in[4][layer * 64 + lane];
        const float inv = powf(500000.0f, -(float)(lane & 7) * 0.125f);
        float sn, cs; sincosf((float)(16 * n + 16) * inv, &sn, &cs);
        const float yp = __shfl(y, lane ^ 8);
        if (lane < 8) y = y * cs - yp * sn; else if (lane < 16) y = y * cs + yp * sn;
        if (n >= 1023) y = 0.f;
        ((bf16_t*)(ws + O_KC))[((size_t)hk * 1024 + n) * 64 + lane] = f2bf(y);
    } else {
        { const int cc = ((n & 15) << 2) | ((n >> 4) & 3); (ws + O_VCT)[((size_t)(hk * 16 + (n >> 6)) * 64 + lane) * 64 + ((cc >> 3) & 3) * 16 + (cc >> 5) * 8 + (cc & 7)] = (unsigned char)__builtin_amdgcn_cvt_pk_fp8_f32(acc, 0.f, 0, false); }
    }
}

typedef float f32x2 __attribute__((ext_vector_type(2)));
struct S5Coef { float ar, ai; f32x2 bb[16]; };
__device__ __forceinline__ void s5_setup(const Params& p, int layer, int g, int lane, S5Coef& c) {
    const int gp = layer * 2048 + g * 64 + lane;
    const float dt = expf(p.in[15][layer * 32 + g]);
    const float lr = p.in[13][gp], li = p.in[14][gp];
    const float mag = expf(lr * dt); float sn, cs; sincosf(li * dt, &sn, &cs);
    c.ar = mag * cs; c.ai = mag * sn;
    const float den = lr * lr + li * li, nr = c.ar - 1.0f, ni = c.ai;
    const float cr = (nr * lr + ni * li) / den, ci = (ni * lr - nr * li) / den;
    const f32x4* br = (const f32x4*)(p.in[16] + (size_t)gp * 16); const f32x4* bi = (const f32x4*)(p.in[17] + (size_t)gp * 16);
#pragma unroll
    for (int q = 0; q < 4; ++q) { const f32x4 a = br[q], b = bi[q];
#pragma unroll
        for (int e = 0; e < 4; ++e) c.bb[q * 4 + e] = (f32x2){cr * a[e] - ci * b[e], cr * b[e] + ci * a[e]}; }
}
__device__ __forceinline__ void s5_stage_u(const bf16_t* Pu, int tok, int g, float* ul, int lane) {
    const u32x4* s = (const u32x4*)(Pu + (size_t)tok * 512 + g * 16); const u32x4 a = s[0], b = s[1];
    f32x4* o = (f32x4*)(ul + lane * 16);
    o[0] = (f32x4){bflo(a.x), bfhi(a.x), bflo(a.y), bfhi(a.y)}; o[1] = (f32x4){bflo(a.z), bfhi(a.z), bflo(a.w), bfhi(a.w)};
    o[2] = (f32x4){bflo(b.x), bfhi(b.x), bflo(b.y), bfhi(b.y)}; o[3] = (f32x4){bflo(b.z), bfhi(b.z), bflo(b.w), bfhi(b.w)};
    asm volatile("s_waitcnt lgkmcnt(0)" ::: "memory");
}
__device__ __forceinline__ void s5_step(const S5Coef& k, const float* uj, float& xr, float& xi) {
    const f32x4 u0 = ((const f32x4*)uj)[0], u1 = ((const f32x4*)uj)[1], u2 = ((const f32x4*)uj)[2], u3 = ((const f32x4*)uj)[3];
    f32x2 acc0 = {0.f, 0.f}, acc1 = {0.f, 0.f};
#pragma unroll
    for (int e = 0; e < 4; ++e) { acc0 += k.bb[e] * u0[e]; acc1 += k.bb[4 + e] * u1[e]; }
#pragma unroll
    for (int e = 0; e < 4; ++e) { acc0 += k.bb[8 + e] * u2[e]; acc1 += k.bb[12 + e] * u3[e]; }
    const f32x2 bu = acc0 + acc1;
    const float nxr = k.ar * xr - k.ai * xi + bu[0], nxi = k.ar * xi + k.ai * xr + bu[1]; xr = nxr; xi = nxi;
}
__device__ void s5_passA_wave(const Params& p, int layer, int item, float* ul) {
    unsigned char* ws = p.ws; const bf16_t* Pu = (const bf16_t*)(ws + O_PU);
    const int lane = tidx() & 63, c = item >> 5, g = item & 31;
    S5Coef k; s5_setup(p, layer, g, lane, k);
    float xr = 0.f, xi = 0.f;
    for (int sub = 0; sub < 4; ++sub) {
        s5_stage_u(Pu, c * 256 + sub * 64 + lane, g, ul, lane);
#pragma unroll 4
        for (int j = 0; j < 64; ++j) s5_step(k, ul + j * 16, xr, xi);
        asm volatile("s_waitcnt lgkmcnt(0)" ::: "memory");
    }
    float* xe = (float*)(ws + O_XEND) + ((size_t)(c * 32 + g) * 64 + lane) * 2; xe[0] = xr; xe[1] = xi;
}
__device__ void s5_passB_wave(const Params& p, int layer, int item, bf16_t* xl, float* ul) {
    unsigned char* ws = p.ws; const bf16_t* Pu = (const bf16_t*)(ws + O_PU); bf16_t* yg = (bf16_t*)(ws + O_YGELU);
    const int lane = tidx() & 63, fr = lane & 15, fq = lane >> 4, c = item >> 5, g = item & 31;
    S5Coef k; s5_setup(p, layer, g, lane, k);
    float pr = k.ar, pi = k.ai;
#pragma unroll
    for (int s = 0; s < 8; ++s) { const float nr = pr * pr - pi * pi, ni = 2.f * pr * pi; pr = nr; pi = ni; }
    float xr = 0.f, xi = 0.f;
    const float* xe = (const float*)(ws + O_XEND) + ((size_t)g * 64 + lane) * 2;
#pragma unroll 8
    for (int cc = 0; cc < c; ++cc) { const float er = xe[(size_t)cc * 32 * 64 * 2], ei = xe[(size_t)cc * 32 * 64 * 2 + 1]; const float nr = pr * xr - pi * xi + er, ni = pr * xi + pi * xr + ei; xr = nr; xi = ni; }
    bf16x8 cf[4];
    {
        const float* cre = p.in[18] + (size_t)layer * 32 * 16 * 64 + ((size_t)g * 16 + fr) * 64; const float* cim = p.in[19] + (size_t)layer * 32 * 16 * 64 + ((size_t)g * 16 + fr) * 64;
#pragma unroll
        for (int ks = 0; ks < 4; ++ks) { const float* s = (ks < 2 ? cre : cim) + (ks & 1) * 32 + fq * 8; f32x4 a = ((const f32x4*)s)[0], b = ((const f32x4*)s)[1]; if (ks >= 2) { a = -a; b = -b; } cf[ks] = pack8f(a, b); }
    }
    const float dsk = p.in[20][layer * 512 + g * 16 + fr];
    for (int sub = 0; sub < 4; ++sub) {
        const int tb = c * 256 + sub * 64;
        s5_stage_u(Pu, tb + lane, g, ul, lane);
        for (int jb = 0; jb < 4; ++jb) {
#pragma unroll 4
            for (int jj = 0; jj < 16; ++jj) {
                s5_step(k, ul + (jb * 16 + jj) * 16, xr, xi);
                xl[jj * 136 + lane] = f2bf(xr); xl[jj * 136 + 64 + lane] = f2bf(xi);
            }
            asm volatile("s_waitcnt lgkmcnt(0)" ::: "memory");
            f32x4 y = {0.f, 0.f, 0.f, 0.f};
#pragma unroll
            for (int ks = 0; ks < 4; ++ks) { const bf16x8 af = *(const bf16x8*)(xl + fr * 136 + ks * 32 + fq * 8); y = MFMA16(af, cf[ks], y); }
            asm volatile("s_waitcnt lgkmcnt(0)" ::: "memory");
#pragma unroll
            for (int q = 0; q < 4; ++q) { const int tl = jb * 16 + fq * 4 + q; const float u = ul[tl * 16 + fr]; yg[(size_t)(tb + tl) * 512 + g * 16 + fr] = f2bf(gelu_tanh(y[q] + dsk * u)); }
        }
        asm volatile("s_waitcnt lgkmcnt(0)" ::: "memory");
    }
}
__device__ void gdn_prep_item(const Params& p, int layer, int item, unsigned char* lds) {
    unsigned char* ws = p.ws;
    const int tid = tidx(), wave = tid >> 6, lane = tid & 63, fr = lane & 15, fq = lane >> 4;
    const int n = item >> 3, h = item & 7, t0 = n * 64;
    bf16_t* qs = (bf16_t*)(lds); bf16_t* ks = (bf16_t*)(lds + 17408); bf16_t* vbT = (bf16_t*)(lds + 34816); bf16_t* kgT = (bf16_t*)(lds + 53248); bf16_t* kdT = (bf16_t*)(lds + 71680);
    float* Am = (float*)(lds + 90112); bf16_t* Tb = (bf16_t*)(lds + 107520); float* gcs = (float*)(lds + 116736); float* bts = (float*)(lds + 116992);
    const float* P32 = (const float*)(ws + O_P32); const bf16_t* Pqkv = (const bf16_t*)(ws + O_PQKV);
    if (wave == 0) {
        const int t = t0 + lane;
        const float a = P32[(size_t)t * 1536 + 1304 + h], b = P32[(size_t)t * 1536 + 1312 + h];
        const float g = -expf(p.in[24][layer * 8 + h]) * softplusf_(a + p.in[25][layer * 8 + h]);
        float s = g;
#pragma unroll
        for (int off = 1; off < 64; off <<= 1) { const float o = __shfl_up(s, off); if (lane >= off) s += o; }
        gcs[lane] = s; bts[lane] = sigmoidf_(b);
    }
    __syncthreads();
    {
        const int r = tid >> 3, c0 = (tid & 7) * 16;
        const float gcr = gcs[r], btr = bts[r], eg = expf(gcr), ed = expf(gcs[63] - gcr);
        const float* cw = p.in[23] + (size_t)layer * 4 * 3072;
#pragma unroll
        for (int which = 0; which < 3; ++which) {
            const int col = which * 1024 + h * 128 + c0;
            float acc[16];
#pragma unroll
            for (int e = 0; e < 16; ++e) acc[e] = 0.f;
#pragma unroll
            for (int j = 0; j < 4; ++j) {
                const int tr = t0 + r - 3 + j;
                if (tr >= 0) {
                    const u32x4* s = (const u32x4*)(Pqkv + (size_t)tr * 3072 + col); const u32x4 a = s[0], b = s[1];
                    const f32x4* wp = (const f32x4*)(cw + j * 3072 + col); const f32x4 w0 = wp[0], w1 = wp[1], w2 = wp[2], w3 = wp[3];
                    acc[0] += w0[0] * bflo(a.x); acc[1] += w0[1] * bfhi(a.x); acc[2] += w0[2] * bflo(a.y); acc[3] += w0[3] * bfhi(a.y);
                    acc[4] += w1[0] * bflo(a.z); acc[5] += w1[1] * bfhi(a.z); acc[6] += w1[2] * bflo(a.w); acc[7] += w1[3] * bfhi(a.w);
                    acc[8] += w2[0] * bflo(b.x); acc[9] += w2[1] * bfhi(b.x); acc[10] += w2[2] * bflo(b.y); acc[11] += w2[3] * bfhi(b.y);
                    acc[12] += w3[0] * bflo(b.z); acc[13] += w3[1] * bfhi(b.z); acc[14] += w3[2] * bflo(b.w); acc[15] += w3[3] * bfhi(b.w);
                }
            }
            float ss = 0.f;
#pragma unroll
            for (int e = 0; e < 16; ++e) { acc[e] = siluf_(acc[e]); ss += acc[e] * acc[e]; }
            ss += __shfl_xor(ss, 1); ss += __shfl_xor(ss, 2); ss += __shfl_xor(ss, 4);
            const float rn = rsqrtf(ss + 1e-6f);
            if (which == 0) {
                bf16_t* qg = (bf16_t*)(ws + O_GQG) + (size_t)item * 8192 + r * 128 + c0;
                float v[16];
#pragma unroll
                for (int e = 0; e < 16; ++e) v[e] = acc[e] * rn * 0.08838834764831845f;
                u32x4 w0, w1; w0.x = pk2(v[0], v[1]); w0.y = pk2(v[2], v[3]); w0.z = pk2(v[4], v[5]); w0.w = pk2(v[6], v[7]); w1.x = pk2(v[8], v[9]); w1.y = pk2(v[10], v[11]); w1.z = pk2(v[12], v[13]); w1.w = pk2(v[14], v[15]);
                *(u32x4*)(qs + r * 136 + c0) = w0; *(u32x4*)(qs + r * 136 + c0 + 8) = w1;
                u32x4 g0, g1; g0.x = pk2(v[0] * eg, v[1] * eg); g0.y = pk2(v[2] * eg, v[3] * eg); g0.z = pk2(v[4] * eg, v[5] * eg); g0.w = pk2(v[6] * eg, v[7] * eg);
                g1.x = pk2(v[8] * eg, v[9] * eg); g1.y = pk2(v[10] * eg, v[11] * eg); g1.z = pk2(v[12] * eg, v[13] * eg); g1.w = pk2(v[14] * eg, v[15] * eg);
                *(u32x4*)qg = g0; *(u32x4*)(qg + 8) = g1;
            } else if (which == 1) {
                float v[16];
#pragma unroll
                for (int e = 0; e < 16; ++e) v[e] = acc[e] * rn;
                u32x4 w0, w1; w0.x = pk2(v[0], v[1]); w0.y = pk2(v[2], v[3]); w0.z = pk2(v[4], v[5]); w0.w = pk2(v[6], v[7]); w1.x = pk2(v[8], v[9]); w1.y = pk2(v[10], v[11]); w1.z = pk2(v[12], v[13]); w1.w = pk2(v[14], v[15]);
                *(u32x4*)(ks + r * 136 + c0) = w0; *(u32x4*)(ks + r * 136 + c0 + 8) = w1;
#pragma unroll
                for (int e = 0; e < 16; ++e) { kgT[(c0 + e) * 72 + r] = f2bf(v[e] * btr * eg); kdT[(c0 + e) * 72 + r] = f2bf(v[e] * ed); }
            } else {
#pragma unroll
                for (int e = 0; e < 16; ++e) vbT[(c0 + e) * 72 + r] = f2bf(acc[e] * btr);
            }
        }
    }
    __syncthreads();
    {
        const int d = tid >> 2, sg = tid & 3;
        const u32x4 a = *(const u32x4*)(kdT + d * 72 + sg * 16), b = *(const u32x4*)(kdT + d * 72 + sg * 16 + 8);
        bf16_t* dst = (bf16_t*)(ws + O_GKD) + (size_t)item * 8192 + d * 64 + sg * 16; *(u32x4*)dst = a; *(u32x4*)(dst + 8) = b;
    }
    { float* Tmz = (float*)(lds + 117248); for (int e2 = tid; e2 < 64 * 68; e2 += 512) Tmz[e2] = 0.f; }
    {
        const int mi = wave >> 1;
        bf16_t* qko = (bf16_t*)(ws + O_GQK) + (size_t)item * 4096;
#pragma unroll
        for (int q = 0; q < 2; ++q) {
            const int nj = (wave & 1) * 2 + q;
            f32x4 kk = {0.f, 0.f, 0.f, 0.f}, qk = {0.f, 0.f, 0.f, 0.f};
            if (nj <= mi) {
#pragma unroll
                for (int s = 0; s < 4; ++s) {
                    const bf16x8 bk = *(const bf16x8*)(ks + (nj * 16 + fr) * 136 + s * 32 + fq * 8);
                    const bf16x8 ak = *(const bf16x8*)(ks + (mi * 16 + fr) * 136 + s * 32 + fq * 8);
                    const bf16x8 aq = *(const bf16x8*)(qs + (mi * 16 + fr) * 136 + s * 32 + fq * 8);
                    kk = MFMA16(ak, bk, kk); qk = MFMA16(aq, bk, qk);
                }
            }
            const int j = nj * 16 + fr; const float gj = gcs[j];
#pragma unroll
            for (int e = 0; e < 4; ++e) {
                const int i = mi * 16 + fq * 4 + e;
                const float dec = (j <= i) ? expf(gcs[i] - gj) : 0.f;
                Am[i * 68 + j] = (j < i) ? bts[i] * kk[e] * dec : 0.f;
                qko[i * 64 + j] = f2bf((j <= i) ? qk[e] * dec : 0.f);
            }
        }
    }
    __syncthreads();
    {
        float* Tm = (float*)(lds + 117248); float* Ps = (float*)(lds + 134656) + wave * 320;
        if (wave == 0) {
            const int bo = fq * 16; float t[16];
#pragma unroll
            for (int i = 0; i < 16; ++i) {
                float s = (i == fr) ? 1.f : 0.f;
#pragma unroll
                for (int j = 0; j < i; ++j) s -= Am[(bo + i) * 68 + bo + j] * t[j];
                t[i] = s; Tm[(bo + i) * 68 + bo + fr] = s;
            }
        }
        asm volatile("s_waitcnt lgkmcnt(0)" ::: "memory"); __syncthreads();
#pragma unroll
        for (int d = 1; d < 4; ++d) {
            if (wave < 4 - d) {
                const int bi = wave + d, bj = wave;
                f32x4 Q = {0.f, 0.f, 0.f, 0.f};
                for (int kb = bj; kb < bi; ++kb) {
                    const float* X = Am + (bi * 16) * 68 + kb * 16; const float* Y = Tm + (kb * 16) * 68 + bj * 16;
#pragma unroll
                    for (int s = 0; s < 4; ++s) Q = __builtin_amdgcn_mfma_f32_16x16x4f32(X[fr * 68 + 4 * s + fq], Y[(4 * s + fq) * 68 + fr], Q, 0, 0, 0);
                }
#pragma unroll
                for (int e2 = 0; e2 < 4; ++e2) Ps[(fq * 4 + e2) * 20 + fr] = Q[e2];
                asm volatile("s_waitcnt lgkmcnt(0)" ::: "memory");
                f32x4 R = {0.f, 0.f, 0.f, 0.f};
                const float* X = Tm + (bi * 16) * 68 + bi * 16;
#pragma unroll
                for (int s = 0; s < 4; ++s) R = __builtin_amdgcn_mfma_f32_16x16x4f32(X[fr * 68 + 4 * s + fq], Ps[(4 * s + fq) * 20 + fr], R, 0, 0, 0);
#pragma unroll
                for (int e2 = 0; e2 < 4; ++e2) Tm[(bi * 16 + fq * 4 + e2) * 68 + bj * 16 + fr] = -R[e2];
            }
            asm volatile("s_waitcnt lgkmcnt(0)" ::: "memory"); __syncthreads();
        }
        for (int e2 = tid; e2 < 4096; e2 += 512) { const int r = e2 >> 6, c = e2 & 63; Tb[r * 72 + c] = f2bf(Tm[r * 68 + c]); }
    }
    __syncthreads();
    {
        const int mi = wave & 3;
        const bf16x8 a0 = *(const bf16x8*)(Tb + (mi * 16 + fr) * 72 + fq * 8), a1 = *(const bf16x8*)(Tb + (mi * 16 + fr) * 72 + 32 + fq * 8);
        float* vo = (float*)(ws + O_GVAL) + (size_t)item * 8192; bf16_t* ko = (bf16_t*)(ws + O_GKC) + (size_t)item * 8192;
#pragma unroll
        for (int q = 0; q < 4; ++q) {
            const int nt = (wave >> 2) * 4 + q;
            f32x4 v = {0.f, 0.f, 0.f, 0.f}, kc = {0.f, 0.f, 0.f, 0.f};
            v = MFMA16(a0, *(const bf16x8*)(vbT + (nt * 16 + fr) * 72 + fq * 8), v); v = MFMA16(a1, *(const bf16x8*)(vbT + (nt * 16 + fr) * 72 + 32 + fq * 8), v);
            kc = MFMA16(a0, *(const bf16x8*)(kgT + (nt * 16 + fr) * 72 + fq * 8), kc); kc = MFMA16(a1, *(const bf16x8*)(kgT + (nt * 16 + fr) * 72 + 32 + fq * 8), kc);
#pragma unroll
            for (int e = 0; e < 4; ++e) { const int i = mi * 16 + fq * 4 + e, d = nt * 16 + fr; vo[i * 128 + d] = v[e]; ko[i * 128 + d] = f2bf(kc[e]); }
        }
    }
    if (tid == 0) ((float*)(ws + O_GEGL))[item] = expf(gcs[63]);
    __syncthreads();
}

struct GdnUO { bf16x8 kc[4], qg[4], qk[2]; float val[2][4]; };
struct GdnSU { bf16x8 kd[2][2]; float egl; };
__device__ __forceinline__ void gdn_load_uo(const unsigned char* ws, int item, int mt, int fr, int fq, int dvb, GdnUO& f) {
    const bf16_t* kc = (const bf16_t*)(ws + O_GKC) + (size_t)item * 8192 + (mt * 16 + fr) * 128 + fq * 8;
    const bf16_t* qg = (const bf16_t*)(ws + O_GQG) + (size_t)item * 8192 + (mt * 16 + fr) * 128 + fq * 8;
    const bf16_t* qk = (const bf16_t*)(ws + O_GQK) + (size_t)item * 4096 + (mt * 16 + fr) * 64 + fq * 8;
    const float* vl = (const float*)(ws + O_GVAL) + (size_t)item * 8192 + (mt * 16 + fq * 4) * 128 + dvb + fr;
#pragma unroll
    for (int s = 0; s < 4; ++s) { f.kc[s] = *(const bf16x8*)(kc + s * 32); f.qg[s] = *(const bf16x8*)(qg + s * 32); }
#pragma unroll
    for (int s = 0; s < 2; ++s) f.qk[s] = *(const bf16x8*)(qk + s * 32);
#pragma unroll
    for (int nt = 0; nt < 2; ++nt)
#pragma unroll
        for (int e = 0; e < 4; ++e) f.val[nt][e] = vl[e * 128 + nt * 16];
}
__device__ __forceinline__ void gdn_load_su(const unsigned char* ws, int item, int w4, int fr, int fq, GdnSU& f) {
    const bf16_t* kd = (const bf16_t*)(ws + O_GKD) + (size_t)item * 8192 + (2 * w4 * 16 + fr) * 64 + fq * 8;
#pragma unroll
    for (int s = 0; s < 2; ++s) { f.kd[0][s] = *(const bf16x8*)(kd + s * 32); f.kd[1][s] = *(const bf16x8*)(kd + 16 * 64 + s * 32); }
    f.egl = ((const float*)(ws + O_GEGL))[item];
}
#define GDN_BAR() do { asm volatile("s_waitcnt lgkmcnt(0)" ::: "memory"); __builtin_amdgcn_s_barrier(); asm volatile("" ::: "memory"); } while (0)
__device__ __forceinline__ void gdn_step_uo(const GdnUO& c, bf16_t* Sl, bf16_t* vn, float* go, int n, int h, int mt, int fr, int fq, int dvb) {
    bf16x8 Sb[2][4];
#pragma unroll
    for (int nt = 0; nt < 2; ++nt)
#pragma unroll
        for (int s = 0; s < 4; ++s) Sb[nt][s] = *(const bf16x8*)(Sl + nt * (16 * 136) + fr * 136 + s * 32 + fq * 8);
    f32x4 U[2], O[2];
#pragma unroll
    for (int nt = 0; nt < 2; ++nt) { U[nt] = (f32x4){0.f, 0.f, 0.f, 0.f}; O[nt] = (f32x4){0.f, 0.f, 0.f, 0.f};
#pragma unroll
        for (int s = 0; s < 4; ++s) U[nt] = MFMA16(c.kc[s], Sb[nt][s], U[nt]);
        u32x2 w; w.x = pk2(c.val[nt][0] - U[nt][0], c.val[nt][1] - U[nt][1]); w.y = pk2(c.val[nt][2] - U[nt][2], c.val[nt][3] - U[nt][3]);
        *(u32x2*)(vn + nt * (16 * 72) + fr * 72 + mt * 16 + fq * 4) = w; }
#pragma unroll
    for (int nt = 0; nt < 2; ++nt)
#pragma unroll
        for (int s = 0; s < 4; ++s) O[nt] = MFMA16(c.qg[s], Sb[nt][s], O[nt]);
    GDN_BAR();
#pragma unroll
    for (int nt = 0; nt < 2; ++nt) {
        const bf16x8 V0 = *(const bf16x8*)(vn + nt * (16 * 72) + fr * 72 + fq * 8), V1 = *(const bf16x8*)(vn + nt * (16 * 72) + fr * 72 + 32 + fq * 8);
        O[nt] = MFMA16(c.qk[0], V0, O[nt]); O[nt] = MFMA16(c.qk[1], V1, O[nt]);
#pragma unroll
        for (int e = 0; e < 4; ++e) go[(size_t)(n * 64 + mt * 16 + fq * 4 + e) * 1024 + h * 128 + dvb + nt * 16 + fr] = O[nt][e];
    }
    GDN_BAR();
}
__device__ __forceinline__ void gdn_step_su(const GdnSU& c, f32x4 (&St)[2][2], bf16_t* Sl, const bf16_t* vn, int w4, int fr, int fq) {
    GDN_BAR();
#pragma unroll
    for (int nt = 0; nt < 2; ++nt) {
        const bf16x8 V0 = *(const bf16x8*)(vn + nt * (16 * 72) + fr * 72 + fq * 8), V1 = *(const bf16x8*)(vn + nt * (16 * 72) + fr * 72 + 32 + fq * 8);
#pragma unroll
        for (int q = 0; q < 2; ++q) {
            St[nt][q] = St[nt][q] * c.egl;
            St[nt][q] = MFMA16(V0, c.kd[q][0], St[nt][q]); St[nt][q] = MFMA16(V1, c.kd[q][1], St[nt][q]);
#pragma unroll
            for (int e = 0; e < 4; ++e) Sl[nt * (16 * 136) + (fq * 4 + e) * 136 + (2 * w4 + q) * 16 + fr] = f2bf(St[nt][q][e]);
        }
    }
    GDN_BAR();
}
__device__ void gdn_recurrence(const Params& p, int b, unsigned char* lds) {
    const unsigned char* ws = p.ws;
    const int tid = tidx(), wave = tid >> 6, lane = tid & 63, fr = lane & 15, fq = lane >> 4;
    const int h = b >> 2, dvb = (b & 3) * 32;
    bf16_t* Sl = (bf16_t*)lds; bf16_t* vn = (bf16_t*)(lds + 2 * 16 * 136 * 2);
    float* go = (float*)(p.ws + O_PQKV);
    for (int e = tid; e < 2 * 16 * 136; e += 512) Sl[e] = 0;
    __syncthreads();
    if (wave < 4) {
        const int mt = wave;
        GdnUO f0, f1, f2;
        gdn_load_uo(ws, h, mt, fr, fq, dvb, f0); gdn_load_uo(ws, 8 + h, mt, fr, fq, dvb, f1);
        for (int n = 0; n < 255; n += 3) {
            gdn_load_uo(ws, (n + 2) * 8 + h, mt, fr, fq, dvb, f2); gdn_step_uo(f0, Sl, vn, go, n, h, mt, fr, fq, dvb);
            gdn_load_uo(ws, (n + 3) * 8 + h, mt, fr, fq, dvb, f0); gdn_step_uo(f1, Sl, vn, go, n + 1, h, mt, fr, fq, dvb);
            if (n + 4 < 256) gdn_load_uo(ws, (n + 4) * 8 + h, mt, fr, fq, dvb, f1);
            gdn_step_uo(f2, Sl, vn, go, n + 2, h, mt, fr, fq, dvb);
        }
        gdn_step_uo(f0, Sl, vn, go, 255, h, mt, fr, fq, dvb);
    } else {
        const int w4 = wave - 4;
        f32x4 St[2][2];
#pragma unroll
        for (int a = 0; a < 2; ++a)
#pragma unroll
            for (int c = 0; c < 2; ++c) St[a][c] = (f32x4){0.f, 0.f, 0.f, 0.f};
        GdnSU f0, f1, f2;
        gdn_load_su(ws, h, w4, fr, fq, f0); gdn_load_su(ws, 8 + h, w4, fr, fq, f1);
        for (int n = 0; n < 255; n += 3) {
            gdn_load_su(ws, (n + 2) * 8 + h, w4, fr, fq, f2); gdn_step_su(f0, St, Sl, vn, w4, fr, fq);
            gdn_load_su(ws, (n + 3) * 8 + h, w4, fr, fq, f0); gdn_step_su(f1, St, Sl, vn, w4, fr, fq);
            if (n + 4 < 256) gdn_load_su(ws, (n + 4) * 8 + h, w4, fr, fq, f1);
            gdn_step_su(f2, St, Sl, vn, w4, fr, fq);
        }
        gdn_step_su(f0, St, Sl, vn, w4, fr, fq);
    }
}
struct KVF { bf16x8 k[4][2]; };
__device__ __forceinline__ void kv_load(const bf16_t* kp, int ldk, KVF& f) {
#pragma unroll
    for (int s = 0; s < 4; ++s) { f.k[s][0] = *(const bf16x8*)(kp + (size_t)(s * 16) * ldk); f.k[s][1] = *(const bf16x8*)(kp + (size_t)(s * 16) * ldk + 32); }
}
template <int CTRL> __device__ __forceinline__ float dppf(float v) { return __int_as_float(__builtin_amdgcn_update_dpp(0, __float_as_int(v), CTRL, 0xF, 0xF, true)); }
template <int CTRL> __device__ __forceinline__ unsigned dppu(unsigned v) { return (unsigned)__builtin_amdgcn_update_dpp(0, (int)v, CTRL, 0xF, 0xF, true); }
__device__ __forceinline__ float rmax16(float v) { v = vmaxf(v, dppf<0xB1>(v)); v = vmaxf(v, dppf<0x4E>(v)); v = vmaxf(v, dppf<0x124>(v)); v = vmaxf(v, dppf<0x128>(v)); return v; }
__device__ __forceinline__ float rsum16(float v) { v += dppf<0xB1>(v); v += dppf<0x4E>(v); v += dppf<0x124>(v); v += dppf<0x128>(v); return v; }
template <int CTRL> __device__ __forceinline__ unsigned long long dppmax64(unsigned long long b) { const unsigned lo = dppu<CTRL>((unsigned)b), hi = dppu<CTRL>((unsigned)(b >> 32)); const unsigned long long ob = ((unsigned long long)hi << 32) | lo; return ob > b ? ob : b; }
#define MFMA8(a, b, c) __builtin_amdgcn_mfma_f32_16x16x32_fp8_fp8((a), (b), (c), 0, 0, 0)
__device__ __forceinline__ long mk64(unsigned lo, unsigned hi) { return (long)(((unsigned long long)hi << 32) | lo); }
__device__ __forceinline__ long bf8_to_fp8(bf16x8 v) {
    const u32x4 w = __builtin_bit_cast(u32x4, v);
    int a = __builtin_amdgcn_cvt_pk_fp8_f32(bflo(w.x), bfhi(w.x), 0, false); a = __builtin_amdgcn_cvt_pk_fp8_f32(bflo(w.y), bfhi(w.y), a, true);
    int b = __builtin_amdgcn_cvt_pk_fp8_f32(bflo(w.z), bfhi(w.z), 0, false); b = __builtin_amdgcn_cvt_pk_fp8_f32(bflo(w.w), bfhi(w.w), b, true);
    return mk64((unsigned)a, (unsigned)b);
}
struct K8F { u32x4 k[4]; };
__device__ __forceinline__ void k8_load(const unsigned char* kp, K8F& f) {
#pragma unroll
    for (int s = 0; s < 4; ++s) f.k[s] = *(const u32x4*)(kp + s * 1024);
}
__device__ __forceinline__ void softmax_pv(const f32x4 (&S)[4], const u32x4 (&Vw)[4], unsigned vmask, float (&m)[4], float (&l)[4], f32x4 (&O)[4], unsigned char* Pt, int fr, int fq) {
    float mx[4];
#pragma unroll
    for (int j = 0; j < 4; ++j) { float v = -1e30f;
#pragma unroll
        for (int s = 0; s < 4; ++s) v = ((vmask >> s) & 1u) ? vmaxf(v, S[s][j]) : v;
        mx[j] = rmax16(v); }
#pragma unroll
    for (int j = 0; j < 4; ++j) { const float mn = vmaxf(m[j], mx[j]); const float a = __builtin_amdgcn_exp2f(m[j] - mn); m[j] = mn; l[j] *= a;
#pragma unroll
        for (int dt = 0; dt < 4; ++dt) O[dt][j] *= a; }
#pragma unroll
    for (int j = 0; j < 4; ++j) { float pv[4];
#pragma unroll
        for (int s = 0; s < 4; ++s) { pv[s] = ((vmask >> s) & 1u) ? __builtin_amdgcn_exp2f(S[s][j] - m[j]) : 0.f; l[j] += pv[s]; }
        int t = __builtin_amdgcn_cvt_pk_fp8_f32(pv[0] * 256.f, pv[1] * 256.f, 0, false); t = __builtin_amdgcn_cvt_pk_fp8_f32(pv[2] * 256.f, pv[3] * 256.f, t, true);
        *(unsigned*)(Pt + (fq * 4 + j) * 72 + fr * 4) = (unsigned)t; }
    asm volatile("s_waitcnt lgkmcnt(0)" ::: "memory");
    const u32x2 p0 = *(const u32x2*)(Pt + fr * 72 + fq * 8), p1 = *(const u32x2*)(Pt + fr * 72 + 32 + fq * 8);
    asm volatile("s_waitcnt lgkmcnt(0)" ::: "memory");
    const long P0 = mk64(p0.x, p0.y), P1 = mk64(p1.x, p1.y);
#pragma unroll
    for (int dt = 0; dt < 4; ++dt) { O[dt] = MFMA8(P0, mk64(Vw[dt].x, Vw[dt].y), O[dt]); O[dt] = MFMA8(P1, mk64(Vw[dt].z, Vw[dt].w), O[dt]); }
}
__device__ __forceinline__ void flash_compute(const bf16x8 (&Qf)[2], KVF& f, const bf16_t* knext, int ldk, const unsigned char* vp, unsigned vmask, float (&m)[4], float (&l)[4], f32x4 (&O)[4], unsigned char* Pt, int fr, int fq) {
    f32x4 S[4]; u32x4 Vw[4];
#pragma unroll
    for (int dt = 0; dt < 4; ++dt) Vw[dt] = *(const u32x4*)(vp + dt * 1024);
#pragma unroll
    for (int s = 0; s < 4; ++s) { S[s] = (f32x4){0.f, 0.f, 0.f, 0.f}; S[s] = MFMA16(Qf[0], f.k[s][0], S[s]); S[s] = MFMA16(Qf[1], f.k[s][1], S[s]); }
    if (knext) kv_load(knext, ldk, f);
    softmax_pv(S, Vw, vmask, m, l, O, Pt, fr, fq);
}
struct V8F { u32x4 v[4]; };
__device__ __forceinline__ void v8_load(const unsigned char* vp, V8F& f) {
#pragma unroll
    for (int dt = 0; dt < 4; ++dt) f.v[dt] = *(const u32x4*)(vp + dt * 1024);
}
__device__ __forceinline__ void flash_compute8(const long (&Q8)[2], const K8F& f, const V8F& vf, unsigned vmask, float (&m)[4], float (&l)[4], f32x4 (&O)[4], unsigned char* Pt, int fr, int fq) {
    f32x4 S[4];
#pragma unroll
    for (int s = 0; s < 4; ++s) { S[s] = (f32x4){0.f, 0.f, 0.f, 0.f}; S[s] = MFMA8(Q8[0], mk64(f.k[s].x, f.k[s].y), S[s]); S[s] = MFMA8(Q8[1], mk64(f.k[s].z, f.k[s].w), S[s]); }
    softmax_pv(S, vf.v, vmask, m, l, O, Pt, fr, fq);
}
template <int BR> struct BranchIt {
    const bf16_t* kb; const unsigned char* kb8; const unsigned char* vb; const int* ul; int last, trow, fr, fq;
    static constexpr int LDK = 64;
    __device__ __forceinline__ int next(int from) const { return from <= last ? from : -1; }
    __device__ __forceinline__ int entry(int idx) const { return BR == 1 ? __builtin_amdgcn_readfirstlane(ul[idx]) : idx; }
    __device__ __forceinline__ const unsigned char* vptr(int en) const { return vb + (size_t)(en & 0xFFFF) * 4096; }
    __device__ __forceinline__ const bf16_t* kptr(int en) const { return kb + (size_t)((en & 0xFFFF) * 64) * LDK; }
    __device__ __forceinline__ const unsigned char* kptr8(int en) const { return kb8 + (size_t)(en & 0xFFFF) * 4096; }
    __device__ __forceinline__ unsigned mask(int en) const {
        unsigned vm = 0; const int key0 = (en & 0xFFFF) * 64;
        if (BR == 0) {
#pragma unroll
            for (int s = 0; s < 4; ++s) vm |= ((16 * (key0 + s * 16 + fr) + 31 <= trow) ? 1u : 0u) << s;
        } else if (BR == 1) {
            const bool rowsel = (en >> (16 + fq)) & 1;
#pragma unroll
            for (int s = 0; s < 4; ++s) vm |= ((rowsel && (key0 + s * 16 + fr <= trow)) ? 1u : 0u) << s;
        } else {
#pragma unroll
            for (int s = 0; s < 4; ++s) { const int kpos = key0 + s * 16 + fr; vm |= ((kpos <= trow && kpos > trow - 512) ? 1u : 0u) << s; }
        }
        return vm;
    }
};
template <int BR> __device__ __forceinline__ void run_branch(const BranchIt<BR>& it, int first, const bf16x8 (&Qf)[2], const long (&Q8)[2], float (&m)[4], float (&l)[4], f32x4 (&O)[4], unsigned char* Pt) {
#pragma unroll
    for (int j = 0; j < 4; ++j) { m[j] = -1e30f; l[j] = 0.f; O[j] = (f32x4){0.f, 0.f, 0.f, 0.f}; }
    int ia = it.next(first);
    if (ia < 0) return;
    if (BR == 0) {
        KVF A; kv_load(it.kptr(ia), BranchIt<BR>::LDK, A);
        while (ia >= 0) {
            const int ib = it.next(ia + 1);
            flash_compute(Qf, A, ib >= 0 ? it.kptr(ib) : nullptr, BranchIt<BR>::LDK, it.vptr(ia), it.mask(ia), m, l, O, Pt, it.fr, it.fq);
            ia = ib;
        }
    } else {
        K8F kA, kB; V8F vA, vB; int ea = it.entry(ia); k8_load(it.kptr8(ea), kA); v8_load(it.vptr(ea), vA);
        for (;;) {
            const int ib = it.next(ia + 1), eb = it.entry(ib >= 0 ? ib : ia);
            k8_load(it.kptr8(eb), kB); v8_load(it.vptr(eb), vB);
            flash_compute8(Q8, kA, vA, it.mask(ea), m, l, O, Pt, it.fr, it.fq);
            if (ib < 0) break;
            const int ic = it.next(ib + 1); ea = it.entry(ic >= 0 ? ic : ib);
            k8_load(it.kptr8(ea), kA); v8_load(it.vptr(ea), vA);
            flash_compute8(Q8, kB, vB, it.mask(eb), m, l, O, Pt, it.fr, it.fq);
            if (ic < 0) break;
            ia = ic;
        }
    }
}
__device__ __forceinline__ void branch_finish(float (&l)[4], f32x4 (&O)[4], const float* grow, int br, int hk, float* ybp  ) {
#pragma unroll
    for (int j = 0; j < 4; ++j) { const float s = rsum16(l[j]);
        const float g = sigmoidf_(grow[(hk * 4 + j) * 3 + br]) * 0.00390625f / fmaxf(s, 1e-30f);
#pragma unroll
        for (int dt = 0; dt < 4; ++dt) { float* q = ybp + j * 64 + dt * 16; if (br == 0) *q = g * O[dt][j]; else *q += g * O[dt][j]; } }
}
constexpr int NSA_WLDS = 15680;
__device__ void nsa_wave_task(const Params& p, int layer, int t0, int hk, unsigned char* wl) {
    unsigned char* ws = p.ws;
    const int lane = tidx() & 63, fr = lane & 15, fq = lane >> 4;
    float* imp = (float*)wl; unsigned* flg = (unsigned*)(wl + 4160); unsigned char* Pt = wl + 5184; float* yb = (float*)(wl + 7488);
    const bf16_t* qn = (const bf16_t*)(ws + O_QN); const unsigned char* ks8 = ws + O_KSN; const unsigned char* kw8 = ws + O_KWN;
    const unsigned char* vsT = ws + O_VST; const unsigned char* vwT = ws + O_VWT; const bf16_t* kc = (const bf16_t*)(ws + O_KC); const unsigned char* vcT = ws + O_VCT;
    const int trow = t0 + fq;
    const float* grow = (const float*)(ws + O_P32) + (size_t)trow * 1536 + 1280;
    const int tmax = t0 + 3;
    {
        bf16x8 Qf[2];
        { const bf16_t* qp = qn + (size_t)(t0 + (fr >> 2)) * 512 + (hk * 4 + (fr & 3)) * 64 + fq * 8; Qf[0] = *(const bf16x8*)qp; Qf[1] = *(const bf16x8*)(qp + 32); }
        long Q8[2]; Q8[0] = bf8_to_fp8(Qf[0]); Q8[1] = bf8_to_fp8(Qf[1]);
        float* ybp = yb + fq * 256 + fr;
        float m[4], l[4]; f32x4 O[4];
        const int ncmp_t = tmax >= 31 ? ((((tmax - 31) >> 4) >> 6) + 1) : 0;
        const bf16_t* kcb = kc + ((size_t)hk * 1024 + fr) * 64 + fq * 8;
        { BranchIt<0> it{kcb, nullptr, vcT + (size_t)hk * 16 * 4096 + fr * 64 + fq * 16, nullptr, ncmp_t - 1, trow, fr, fq}; run_branch<0>(it, 0, Qf, Q8, m, l, O, Pt); }
        float linv[4];
#pragma unroll
        for (int j = 0; j < 4; ++j) { const float s = rsum16(l[j]); linv[j] = s > 0.f ? 1.0f / s : 0.f; }
        branch_finish(l, O, grow, 0, hk, ybp);
        for (int e = lane; e < 4 * 260; e += 64) imp[e] = 0.f;
        for (int e = lane; e < 256; e += 64) flg[e] = 0u;
        asm volatile("s_waitcnt lgkmcnt(0)" ::: "memory");
        {
            KVF ka;
            if (ncmp_t > 0) kv_load(kcb, 64, ka);
            for (int kt = 0; kt < ncmp_t; ++kt) {
                const int key0 = kt * 64;
                f32x4 S[4];
#pragma unroll
                for (int s = 0; s < 4; ++s) { S[s] = (f32x4){0.f, 0.f, 0.f, 0.f}; S[s] = MFMA16(Qf[0], ka.k[s][0], S[s]); S[s] = MFMA16(Qf[1], ka.k[s][1], S[s]); }
                if (kt + 1 < ncmp_t) kv_load(kcb + (size_t)(key0 + 64) * 64, 64, ka);
#pragma unroll
                for (int s = 0; s < 4; ++s) {
                    const int nn = key0 + s * 16 + fr; const bool valid = 16 * nn + 31 <= trow;
                    float ps = 0.f;
#pragma unroll
                    for (int j = 0; j < 4; ++j) ps += valid ? __builtin_amdgcn_exp2f(S[s][j] - m[j]) * linv[j] : 0.f;
                    float p4 = ps; p4 += dppf<0xB1>(p4); p4 += dppf<0x4E>(p4);
                    if ((fr & 3) == 0) imp[fq * 260 + (nn >> 2)] += p4;
                    asm volatile("s_waitcnt lgkmcnt(0)" ::: "memory");
                    if ((fr & 3) == 3) imp[fq * 260 + (nn >> 2) + 1] += ps;
                    asm volatile("s_waitcnt lgkmcnt(0)" ::: "memory");
                }
            }
        }
#ifdef OLD_TOPK
        for (int tok = 0; tok < 4; ++tok) {
            const int t = t0 + tok, cur = t >> 6, nsel = cur + 1 < 16 ? cur + 1 : 16;
            unsigned long long key[4];
#pragma unroll
            for (int i = 0; i < 4; ++i) { const int j = lane + 64 * i; unsigned long long k = 0ull;
                if (j <= cur) { const bool forced = (j == 0) || (j == cur) || (j == cur - 1); const unsigned vb = forced ? 0x7F800000u : __float_as_uint(imp[tok * 260 + j]); k = ((unsigned long long)vb << 32) | (unsigned)(0xFFFF - j); }
                key[i] = k; }
            for (int it2 = 0; it2 < nsel; ++it2) {
                unsigned long long best = key[0]; best = key[1] > best ? key[1] : best; best = key[2] > best ? key[2] : best; best = key[3] > best ? key[3] : best;
#pragma unroll
                for (int o = 32; o >= 1; o >>= 1) { const unsigned lo = __shfl_xor((unsigned)best, o), hi = __shfl_xor((unsigned)(best >> 32), o); const unsigned long long ob = ((unsigned long long)hi << 32) | lo; best = ob > best ? ob : best; }
                const int jsel = 0xFFFF - (int)(best & 0xFFFFu);
#pragma unroll
                for (int i = 0; i < 4; ++i) if (key[i] == best) key[i] = 0ull;
                if (lane == 0) flg[jsel] |= (1u << tok);
            }
        }
#else
        {
            unsigned long long key[4][4];
#pragma unroll
            for (int tok = 0; tok < 4; ++tok) { const int cur = (t0 + tok) >> 6;
#pragma unroll
                for (int i = 0; i < 4; ++i) { const int j = lane + 64 * i; unsigned long long k = 0ull;
                    if (j <= cur) { const bool forced = (j == 0) || (j == cur) || (j == cur - 1); const unsigned vb = forced ? 0x7F800000u : __float_as_uint(imp[tok * 260 + j]); k = ((unsigned long long)vb << 32) | (unsigned)(0xFFFF - j); }
                    key[tok][i] = k; } }
            for (int itn = 0; itn < 16; ++itn) {
                unsigned long long best[4];
#pragma unroll
                for (int tok = 0; tok < 4; ++tok) { unsigned long long b0 = key[tok][0]; b0 = key[tok][1] > b0 ? key[tok][1] : b0; b0 = key[tok][2] > b0 ? key[tok][2] : b0; b0 = key[tok][3] > b0 ? key[tok][3] : b0; best[tok] = b0; }
#pragma unroll
                for (int tok = 0; tok < 4; ++tok) { best[tok] = dppmax64<0xB1>(best[tok]); best[tok] = dppmax64<0x4E>(best[tok]); best[tok] = dppmax64<0x124>(best[tok]); best[tok] = dppmax64<0x128>(best[tok]); }
#pragma unroll
                for (int o = 16; o <= 32; o <<= 1) {
#pragma unroll
                    for (int tok = 0; tok < 4; ++tok) { const unsigned lo = __shfl_xor((unsigned)best[tok], o), hi = __shfl_xor((unsigned)(best[tok] >> 32), o); const unsigned long long ob = ((unsigned long long)hi << 32) | lo; best[tok] = ob > best[tok] ? ob : best[tok]; }
                }
#pragma unroll
                for (int tok = 0; tok < 4; ++tok) {
                    if (best[tok] != 0ull) {
#pragma unroll
                        for (int i = 0; i < 4; ++i) if (key[tok][i] == best[tok]) key[tok][i] = 0ull;
                        if (lane == 0) flg[0xFFFF - (int)(best[tok] & 0xFFFFu)] |= (1u << tok);
                    }
                }
            }
        }
#endif
        asm volatile("s_waitcnt lgkmcnt(0)" ::: "memory");
        int ucnt = 0; int* ul = (int*)imp;
#pragma unroll
        for (int i = 0; i < 4; ++i) { const int j = i * 64 + lane; const unsigned fw = flg[j]; const bool us = fw != 0u; const unsigned long long bm = __ballot(us);
            const int pos = ucnt + __popcll(bm & ((1ull << lane) - 1ull)); if (us) ul[pos] = j | (int)(fw << 16); ucnt += __popcll(bm); }
        asm volatile("s_waitcnt lgkmcnt(0)" ::: "memory");
        { BranchIt<1> it{nullptr, ks8 + (size_t)hk * 256 * 4096 + fr * 64 + fq * 16, vsT + (size_t)hk * 256 * 4096 + fr * 64 + fq * 16, ul, ucnt - 1, trow, fr, fq}; run_branch<1>(it, 0, Qf, Q8, m, l, O, Pt); }
        branch_finish(l, O, grow, 1, hk, ybp);
        { BranchIt<2> it{nullptr, kw8 + (size_t)hk * 256 * 4096 + fr * 64 + fq * 16, vwT + (size_t)hk * 256 * 4096 + fr * 64 + fq * 16, nullptr, tmax >> 6, trow, fr, fq}; run_branch<2>(it, t0 - 511 > 0 ? ((t0 - 511) >> 6) : 0, Qf, Q8, m, l, O, Pt); }
        branch_finish(l, O, grow, 2, hk, ybp);
    }
    asm volatile("s_waitcnt lgkmcnt(0)" ::: "memory");
    float* ysc = (float*)(ws + O_P32);
#pragma unroll
    for (int tok = 0; tok < 4; ++tok) *(f32x4*)(ysc + (size_t)(t0 + tok) * 1536 + hk * 256 + lane * 4) = *(const f32x4*)(yb + tok * 256 + lane * 4);
    asm volatile("s_waitcnt lgkmcnt(0)" ::: "memory");
}

__device__ void phase_finalize(const Params& p, int layer) {
    unsigned char* ws = p.ws;
    const int wave = tidx() >> 6, lane = tidx() & 63;
    const float* yglu = (const float*)(ws + O_YGLU); const float* go = (const float*)(ws + O_PQKV); const bf16_t* Pz = (const bf16_t*)(ws + O_PZ); bf16_t* mix = (bf16_t*)(ws + O_HN);
    const float* gs = p.in[22] + (size_t)layer * 512 + lane * 8; const float* gg = p.in[26] + (size_t)layer * 128 + (lane & 7) * 16;
    const float* gnsa = p.in[12] + (size_t)layer * 512 + lane * 8; const float* ysc = (const float*)(ws + O_P32);
    for (int t = blockIdx.x * 8 + wave; t < T_; t += gridDim.x * 8) {
        {
            const f32x4 a = *(const f32x4*)(ysc + (size_t)t * 1536 + lane * 8), b = *(const f32x4*)(ysc + (size_t)t * 1536 + lane * 8 + 4);
            float ss = a[0] * a[0] + a[1] * a[1] + a[2] * a[2] + a[3] * a[3] + b[0] * b[0] + b[1] * b[1] + b[2] * b[2] + b[3] * b[3];
            ss = wave_sum(ss); const float rs = rsqrtf(ss * (1.0f / 512.0f) + 1e-6f);
            const f32x4 g0 = *(const f32x4*)gnsa, g1 = *(const f32x4*)(gnsa + 4);
            u32x4 w; w.x = pk2(a[0] * rs * g0[0], a[1] * rs * g0[1]); w.y = pk2(a[2] * rs * g0[2], a[3] * rs * g0[3]); w.z = pk2(b[0] * rs * g1[0], b[1] * rs * g1[1]); w.w = pk2(b[2] * rs * g1[2], b[3] * rs * g1[3]);
            *(u32x4*)(mix + (size_t)t * DM + lane * 8) = w;
        }
        {
            const f32x4 a = *(const f32x4*)(yglu + (size_t)t * 512 + lane * 8), b = *(const f32x4*)(yglu + (size_t)t * 512 + lane * 8 + 4);
            float ss = a[0] * a[0] + a[1] * a[1] + a[2] * a[2] + a[3] * a[3] + b[0] * b[0] + b[1] * b[1] + b[2] * b[2] + b[3] * b[3];
            ss = wave_sum(ss); const float rs = rsqrtf(ss * (1.0f / 512.0f) + 1e-6f);
            const f32x4 g0 = *(const f32x4*)gs, g1 = *(const f32x4*)(gs + 4);
            u32x4 w; w.x = pk2(a[0] * rs * g0[0], a[1] * rs * g0[1]); w.y = pk2(a[2] * rs * g0[2], a[3] * rs * g0[3]); w.z = pk2(b[0] * rs * g1[0], b[1] * rs * g1[1]); w.w = pk2(b[2] * rs * g1[2], b[3] * rs * g1[3]);
            *(u32x4*)(mix + (size_t)t * DM + 512 + lane * 8) = w;
        }
        {
            f32x4 o[4]; float ss = 0.f;
#pragma unroll
            for (int q = 0; q < 4; ++q) { o[q] = *(const f32x4*)(go + (size_t)t * 1024 + lane * 16 + q * 4); ss += o[q][0] * o[q][0] + o[q][1] * o[q][1] + o[q][2] * o[q][2] + o[q][3] * o[q][3]; }
            ss += __shfl_xor(ss, 1); ss += __shfl_xor(ss, 2); ss += __shfl_xor(ss, 4);
            const float rs = rsqrtf(ss * (1.0f / 128.0f) + 1e-6f);
            const u32x4 z0 = *(const u32x4*)(Pz + (size_t)t * 1024 + lane * 16), z1 = *(const u32x4*)(Pz + (size_t)t * 1024 + lane * 16 + 8);
            float zz[16] = {bflo(z0.x), bfhi(z0.x), bflo(z0.y), bfhi(z0.y), bflo(z0.z), bfhi(z0.z), bflo(z0.w), bfhi(z0.w), bflo(z1.x), bfhi(z1.x), bflo(z1.y), bfhi(z1.y), bflo(z1.z), bfhi(z1.z), bflo(z1.w), bfhi(z1.w)};
            float r[16];
#pragma unroll
            for (int q = 0; q < 4; ++q) { const f32x4 g = *(const f32x4*)(gg + q * 4);
#pragma unroll
                for (int e = 0; e < 4; ++e) r[q * 4 + e] = o[q][e] * rs * g[e] * siluf_(zz[q * 4 + e]); }
            u32x4 w0, w1; w0.x = pk2(r[0], r[1]); w0.y = pk2(r[2], r[3]); w0.z = pk2(r[4], r[5]); w0.w = pk2(r[6], r[7]); w1.x = pk2(r[8], r[9]); w1.y = pk2(r[10], r[11]); w1.z = pk2(r[12], r[13]); w1.w = pk2(r[14], r[15]);
            *(u32x4*)(mix + (size_t)t * DM + 1024 + lane * 16) = w0; *(u32x4*)(mix + (size_t)t * DM + 1024 + lane * 16 + 8) = w1;
        }
    }
}

__device__ void phase_ffn_fix(const Params& p, int layer) {
    unsigned char* ws = p.ws;
    const float* hb = (const float*)(ws + O_HF); bf16_t* act = (bf16_t*)(ws + O_ACT);
    const float* cw = p.in[30] + (size_t)layer * 3 * NFF; const float* cb = p.in[31] + (size_t)layer * NFF;
    const int nitems = 256 * DFF;
    for (int it = blockIdx.x * 512 + tidx(); it < nitems; it += gridDim.x * 512) {
        const int grp = it / DFF, g = it - grp * DFF, pcol = 256 * (g >> 7) + (g & 127);
        const float* cur = hb + (size_t)grp * 4 * NFF + pcol; const float* prv = cur - (size_t)4 * NFF;
        const float gm2 = grp ? prv[2 * NFF] : 0.f, gm1 = grp ? prv[3 * NFF] : 0.f, g0v = cur[0], g1v = cur[NFF];
        const float um2 = grp ? prv[2 * NFF + 128] : 0.f, um1 = grp ? prv[3 * NFF + 128] : 0.f, u0v = cur[128], u1v = cur[NFF + 128];
        const float wg0 = cw[g], wg1 = cw[NFF + g], wg2 = cw[2 * NFF + g], bg = cb[g], wu0 = cw[DFF + g], wu1 = cw[NFF + DFF + g], wu2 = cw[2 * NFF + DFF + g], bu = cb[DFF + g];
        const float G0 = bg + wg0 * gm2 + wg1 * gm1 + wg2 * g0v, U0 = bu + wu0 * um2 + wu1 * um1 + wu2 * u0v;
        const float G1 = bg + wg0 * gm1 + wg1 * g0v + wg2 * g1v, U1 = bu + wu0 * um1 + wu1 * u0v + wu2 * u1v;
        act[(size_t)(grp * 64) * DFF + g] = f2bf(siluf_(G0) * U0);
        act[(size_t)(grp * 64 + 1) * DFF + g] = f2bf(siluf_(G1) * U1);
    }
}
#ifdef REPEAT_PHASE
constexpr int NPHT = NPH + 1;
#else
constexpr int NPHT = NPH;
#endif
#ifndef MULTI_LAUNCH
#define MULTI_LAUNCH 0
#endif
__global__ void __launch_bounds__(512) mega(Params p) {
    extern __shared__ __attribute__((aligned(16))) unsigned char smem[];
    cg::grid_group grid = cg::this_grid();
    const int b = blockIdx.x, G = gridDim.x;
    PG8_LAS unsigned char* glds = (PG8_LAS unsigned char*)smem;
    volatile XB_LAS unsigned* xst = (volatile XB_LAS unsigned*)(smem + LDS_BYTES - 32);
    if (threadIdx.x == 0) { xst[0] = 0u; xst[1] = 0u; }
    __syncthreads();
    XcdBarrier xbar; xbar.bar = (unsigned*)(p.ws + O_BAR); xbar.x = 0; xbar.st = xst;
    for (int ph = p.ph_lo; ph < p.ph_hi; ++ph) {

        #ifdef REPEAT_PHASE
        const int layer = ph / (NPH + 1), ki = ph % (NPH + 1), rep = (ki == REPEAT_PHASE + 1) ? 1 : 0; int k = ki <= REPEAT_PHASE ? ki : ki - 1;
#else
        const int layer = ph / NPH, rep = 0; int k = ph % NPH;
#endif
#ifdef DBG_ONLY
        if (k != DBG_ONLY) k = 99;
#endif
        typedef unsigned char __attribute__((address_space(1))) gu8_t;
        gu8_t* wsg = (gu8_t*)p.ws; asm volatile("" : "+s"(wsg));
        unsigned char* ws = (unsigned char*)wsg;
        int tid = threadIdx.x; asm volatile("" : "+v"(tid));
        const int wave = tid >> 6;
        bf16_t* hn = (bf16_t*)(ws + O_HN);
        Params q = p; q.ws = ws;
        if (k == 0) {
            if (ph == 0 && rep == 0 && b == 0) { if (tid < 64) ((unsigned*)(ws + O_CTR))[tid * 16] = 0u; for (int i = tid; i < XCD_BAR_WORDS; i += 512) ((unsigned*)(ws + O_BAR))[i] = 0u; }
            phase_convert(q, layer, (float*)smem);
            phase_rmsnorm(layer == 0 ? p.in[0] : p.out, p.in[1] + (size_t)layer * DM, hn, layer == 0 ? p.out : nullptr);
        } else if (k == 1) {
            pg8::Gemm g{hn, (const bf16_t*)(ws + O_WIN), T_, NIN, DM}; pg8::StaticOrder S; S.init(T_, NIN, G, b);
            EpiProj E{(float*)(ws + O_P32), (bf16_t*)(ws + O_PU), (bf16_t*)(ws + O_PQKV), (bf16_t*)(ws + O_PZ)};
            pg8::gemm_phase<EpiProj, pg8::StaticOrder, false>(glds, g, S, E, nullptr);
        } else if (k == 2) {
            for (int it = b; it < 3072; it += G) {
                if (it < 2048) gdn_prep_item(q, layer, it, smem);
                else if (it < 2304) nsa_prep_item(q, layer, it - 2048, (float*)smem);
                else if (it < 2560) s5_passA_wave(q, layer, (it - 2304) * 8 + wave, (float*)(smem + wave * 4096));
                else cmp1_wave_tile(q, layer, (it - 2560) * 8 + wave);
            }
        } else if (k == 3) {
            for (int idx = b * 8 + wave; idx < 4096; idx += G * 8) cmp2_wave_row(q, layer, idx);
            for (int it = b * 8 + wave; it < 2048; it += G * 8) s5_passB_wave(q, layer, it, (bf16_t*)(smem + wave * 8448), (float*)(smem + wave * 8448 + 4352));
        } else if (k == 4) {
#ifdef REP4_MODE
            const bool do_rec = (rep == 0) || (REP4_MODE == 1), do_glu = (rep == 0), do_nsa = (rep == 0) || (REP4_MODE == 2);
#else
            const bool do_rec = true, do_glu = true, do_nsa = true;
#endif
            if (b < 32) {
#ifndef NO_REC
 if (do_rec) gdn_recurrence(q, b, smem);
#endif
 }
            else if (b < 160 && do_glu) {
#ifndef NO_GLU
                pg8::Gemm g{(const bf16_t*)(ws + O_YGELU), (const bf16_t*)(ws + O_WGLU), T_, 512, 512}; pg8::StaticOrder S; S.init(T_, 512, 128, b - 32);
                EpiGlu E{(const bf16_t*)(ws + O_YGELU), (float*)(ws + O_YGLU)};
                pg8::gemm_phase<EpiGlu, pg8::StaticOrder, false>(glds, g, S, E, nullptr);
#endif
            }
            __syncthreads();
            unsigned* ctr = (unsigned*)(ws + O_CTR) + (layer * 2 + rep) * 16;
#ifndef NO_NSA
            if (do_nsa) for (;;) {
                int idx = 0;
                if ((tid & 63) == 0) idx = (int)atomicAdd(ctr, 1u);
                idx = __builtin_amdgcn_readfirstlane(idx);
                if (idx >= 8192) break;
                nsa_wave_task(q, layer, (4095 - (idx & 4095)) * 4, idx >> 12, smem + wave * NSA_WLDS);
            }
#endif
        } else if (k == 5) {
            phase_finalize(q, layer);
        } else if (k == 6) {
            pg8::Gemm g{hn, (const bf16_t*)(ws + O_WOUT), T_, DM, DM}; pg8::StaticOrder S; S.init(T_, DM, G, b);
            EpiResid E{p.out, DM};
            pg8::gemm_phase<EpiResid, pg8::StaticOrder, false>(glds, g, S, E, nullptr);
        } else if (k == 7) {
            phase_rmsnorm(p.out, p.in[28] + (size_t)layer * DM, hn, nullptr);
        } else if (k == 8) {
            pg8::Gemm g{hn, (const bf16_t*)(ws + O_WFIN), T_, NFF, DM}; pg8::StaticOrder S; S.init(T_, NFF, G, b);
            EpiFfnAct E{(bf16_t*)(ws + O_ACT), (float*)(ws + O_HF), q.in[30] + (size_t)layer * 3 * NFF, q.in[31] + (size_t)layer * NFF};
            pg8::gemm_phase<EpiFfnAct, pg8::StaticOrder, false>(glds, g, S, E, nullptr);
        } else if (k == 9) {
            phase_ffn_fix(q, layer);
        } else if (k == 10) {
            pg8::Gemm g{(const bf16_t*)(ws + O_ACT), (const bf16_t*)(ws + O_WFOUT), T_, DM, DFF}; pg8::StaticOrder S; S.init(T_, DM, G, b);
            EpiResid E{p.out, DM};
            pg8::gemm_phase<EpiResid, pg8::StaticOrder, false>(glds, g, S, E, nullptr);
        }
        __syncthreads();
        if (ph + 1 < p.ph_hi) {
            if (ph == p.ph_lo) { grid.sync(); xbar = xcd_barrier_post((unsigned*)(p.ws + O_BAR), xst); }
            else xcd_barrier(xbar);
        }
    }
}

extern "C" void kernel_launch(void* const* d_in, const int* in_sizes, int n_in, void* d_out, int out_size, void* d_ws, size_t ws_size, hipStream_t stream) {
    static int grid_blocks = 0;
    if (!grid_blocks) {
        if (n_in != 33 || out_size != T_ * DM || ws_size < WS_NEED) { fprintf(stderr, "kernel_launch: unexpected shapes or workspace (%d inputs, out %d, ws %zu < %zu)\n", n_in, out_size, ws_size, (size_t)WS_NEED); grid_blocks = -1; return; }
        int dev = 0, cus = 0, per_cu = 0;
        hipGetDevice(&dev);
        hipDeviceGetAttribute(&cus, hipDeviceAttributeMultiprocessorCount, dev);
        if (hipFuncSetAttribute((const void*)mega, hipFuncAttributeMaxDynamicSharedMemorySize, LDS_BYTES) != hipSuccess) { fprintf(stderr, "kernel_launch: hipFuncSetAttribute failed\n"); grid_blocks = -1; return; }
        hipOccupancyMaxActiveBlocksPerMultiprocessor(&per_cu, (const void*)mega, 512, LDS_BYTES);
        (void)hipGetLastError();
        if (per_cu < 1) per_cu = 1;
        grid_blocks = cus * per_cu; if (grid_blocks > 256) grid_blocks = 256;
        if (grid_blocks < 160) { fprintf(stderr, "kernel_launch: grid %d too small\n", grid_blocks); grid_blocks = -1; return; }
    }
    if (grid_blocks < 0) return;
    Params p{};
    for (int i = 0; i < 33; ++i) p.in[i] = (const float*)d_in[i];
    p.out = (float*)d_out; p.ws = (unsigned char*)d_ws;
#if MULTI_LAUNCH
    for (int ph = 0; ph < 2 * NPHT; ++ph) { p.ph_lo = ph; p.ph_hi = ph + 1; hipLaunchKernelGGL(mega, dim3(grid_blocks), dim3(512), LDS_BYTES, stream, p); }
#else
    p.ph_lo = 0; p.ph_hi = 2 * NPHT;
    void* args[] = {&p};
    hipError_t e = hipLaunchCooperativeKernel((const void*)mega, dim3(grid_blocks), dim3(512), args, LDS_BYTES, stream);
    if (e != hipSuccess) fprintf(stderr, "cooperative launch failed: %s (grid %d)\n", hipGetErrorString(e), grid_blocks);
#endif
}
```

```cpp
#include <hip/hip_runtime.h>
#include <hip/hip_cooperative_groups.h>
#include <cstdio>
namespace cg = cooperative_groups;
__device__ __forceinline__ int tidx() { int t = threadIdx.x; asm volatile("" : "+v"(t)); return t; }
namespace pg8 {
#define PG8_LAS __attribute__((address_space(3)))
typedef unsigned short bf16_t;
typedef short bf16x8 __attribute__((ext_vector_type(8)));
typedef float f32x4 __attribute__((ext_vector_type(4)));
typedef unsigned u32x4 __attribute__((ext_vector_type(4)));
constexpr int BM = 256, BK = 64, HALF = 128, HTB = HALF * BK * 2  , STAGE_BYTES = 8 * HTB, NXCD = 8, WGM = 8;

__host__ __device__ __forceinline__ int lds_byte(int r, int c) { const int st = (r >> 4) * 2 + (c >> 5), rr = r & 15, cc = c & 31, ob = rr * 64 + cc * 2; return st * 1024 + (ob ^ (((ob >> 9) & 1) << 5)); }
__host__ __device__ __forceinline__ void stage_rc(int b, int& R, int& C) { const int st = b / 1024, sb = b % 1024, swz = sb ^ (((sb >> 9) & 1) << 5); R = (st >> 1) * 16 + swz / 64; C = (st & 1) * 32 + (swz % 64) / 2; }
__host__ __device__ __forceinline__ int perm32(int rho) { const int n = rho >> 4, i = rho & 15; return 8 * (i >> 2) + 4 * n + (i & 3); }

struct Unit { int pm, pn; };
struct Gemm { const bf16_t* A; const bf16_t* Bt; int M, N, K; };

struct StaticOrder {
    int nM, nN, nwg, G, c;
    __host__ __device__ void init(int M, int N, int G_, int c_) { nM = M / BM; nN = N / BM; nwg = nM * nN; G = G_; c = c_; }
    __host__ __device__ bool next(int i, Unit& u) const {
        const long L = (long)i * G + c; if (L >= nwg) return false;
        int wgid = (int)L; { const int q = nwg / NXCD, r = nwg % NXCD, xcd = wgid % NXCD, off = wgid / NXCD; wgid = (xcd < r ? xcd * (q + 1) : r * (q + 1) + (xcd - r) * q) + off; }
        const int nig = WGM * nN, gid = wgid / nig, fm = gid * WGM, gsz = (nM - fm) < WGM ? (nM - fm) : WGM;
        u.pm = fm + ((wgid % nig) % gsz); u.pn = (wgid % nig) / gsz; return true;
    }
    __device__ __forceinline__ void a_ready(const Unit&) const {}
    __device__ __forceinline__ void done(const Unit&) const {}
};
__device__ __forceinline__ unsigned cvt_pk_bf16(float lo, float hi) { unsigned r; asm volatile("v_cvt_pk_bf16_f32 %0, %1, %2" : "=v"(r) : "v"(lo), "v"(hi)); return r; }
template <class Epi, class Sched, bool STAMP = false>
__device__ __forceinline__ void gemm_phase(PG8_LAS unsigned char* lds, const Gemm g, const Sched& S, const Epi& E, unsigned long long* stamps) {
    const int tid = tidx(), wid = __builtin_amdgcn_readfirstlane(tid >> 6), lane = tid & 63, wr = wid >> 2, wc = wid & 3, fr = lane & 15, fq = lane >> 4;
    const int K = g.K, nt = K / BK;
    int ts_lo = 0, ts_hi = 0, nts = 0; const unsigned long long rt_entry = STAMP ? (unsigned long long)wall_clock64() : 0ull;
#define PG8_STAMP() do { if (STAMP && wid == 0 && nts < 64) { const unsigned long long _c = (unsigned long long)clock64(); \
        ts_lo = (lane == nts) ? (int)(unsigned)_c : ts_lo; ts_hi = (lane == nts) ? (int)(unsigned)(_c >> 32) : ts_hi; ++nts; } } while (0)
    PG8_STAMP();
    unsigned voffA[2], voffB[2];
#pragma unroll
    for (int i = 0; i < 2; ++i) { int R, C; stage_rc(tid * 16 + i * 8192, R, C); const int Rb = Epi::PERM ? ((R & ~31) + perm32(R & 31)) : R;
        voffA[i] = (unsigned)(R * K + C) * 2u; voffB[i] = (unsigned)(Rb * K + C) * 2u; }
    const size_t kstep = (size_t)(BK * 2);
    const size_t hstep = (size_t)HALF * K * 2;
    const size_t tstep = 2 * hstep;
    const unsigned ldsw = (unsigned)wid * 1024u;
    const int aoff = lds_byte(wr * 64 + fr, fq * 8), boff = lds_byte(wc * 32 + fr, fq * 8);
#define PG8_SA(b, h) (((b) * 2 + (h)) * HTB)
#define PG8_SB(b, h) ((4 + (b) * 2 + (h)) * HTB)
#define PG8_STAGE(bufoff, gbase, voff) do { _Pragma("unroll") for (int _i = 0; _i < 2; ++_i) \
        __builtin_amdgcn_global_load_lds((const unsigned*)((const char*)(gbase) + (voff)[_i]), (PG8_LAS unsigned*)(lds + (bufoff) + ldsw + _i * 8192), 16, 0, 0); } while (0)
#define PG8_LDA(dst, b, h) do { _Pragma("unroll") for (int m = 0; m < 4; ++m) _Pragma("unroll") for (int k = 0; k < 2; ++k) dst[m][k] = *(const PG8_LAS bf16x8*)(lds + PG8_SA(b, h) + aoff + m * 2048 + k * 1024); } while (0)
#define PG8_LDB(dst, b, h) do { _Pragma("unroll") for (int n = 0; n < 2; ++n) _Pragma("unroll") for (int k = 0; k < 2; ++k) dst[n][k] = *(const PG8_LAS bf16x8*)(lds + PG8_SB(b, h) + boff + n * 2048 + k * 1024); } while (0)
#define PG8_MMA(ai, bj, At, Bt) do { __builtin_amdgcn_s_setprio(1); _Pragma("unroll") for (int m = 0; m < 4; ++m) _Pragma("unroll") for (int n = 0; n < 2; ++n) _Pragma("unroll") for (int k = 0; k < 2; ++k) \
        acc[ai][bj][m][n] = __builtin_amdgcn_mfma_f32_16x16x32_bf16(Bt[n][k], At[m][k], acc[ai][bj][m][n], 0, 0, 0); __builtin_amdgcn_s_setprio(0); } while (0)
#define PG8_WAIT_V(n) asm volatile("s_waitcnt vmcnt(" #n ")" ::: "memory")
#define PG8_WAIT_L(n) asm volatile("s_waitcnt lgkmcnt(" #n ")" ::: "memory")
#define PG8_BAR __builtin_amdgcn_s_barrier()
#define PG8_SCHED __builtin_amdgcn_sched_barrier(0)
    Unit cur, nxt; int ui = 0;
    if (!S.next(0, cur)) return;
    f32x4 acc[2][2][4][2];
#pragma unroll
    for (int a = 0; a < 2; ++a)
#pragma unroll
        for (int b = 0; b < 2; ++b)
#pragma unroll
            for (int m = 0; m < 4; ++m)
#pragma unroll
                for (int n = 0; n < 2; ++n) acc[a][b][m][n] = (f32x4){0.f, 0.f, 0.f, 0.f};
    bf16x8 At[4][2], B0[2][2], B1[2][2];
    const char* cA = (const char*)g.A + (size_t)cur.pm * tstep; const char* cB = (const char*)g.Bt + (size_t)cur.pn * tstep;
    S.a_ready(cur);
    PG8_STAGE(PG8_SB(0, 0), cB, voffB); PG8_STAGE(PG8_SA(0, 0), cA, voffA); PG8_STAGE(PG8_SB(0, 1), cB + hstep, voffB); PG8_STAGE(PG8_SA(0, 1), cA + hstep, voffA);
    if (wr == 1) PG8_BAR;
    PG8_WAIT_V(4); PG8_BAR;
    PG8_STAGE(PG8_SB(1, 0), cB + kstep, voffB); PG8_STAGE(PG8_SA(1, 0), cA + kstep, voffA); PG8_STAGE(PG8_SB(1, 1), cB + hstep + kstep, voffB);
    PG8_WAIT_V(6); PG8_BAR;
    PG8_STAMP();
    for (;;) {
        const bool has_next = S.next(ui + 1, nxt);
        const char* nA = has_next ? (const char*)g.A + (size_t)nxt.pm * tstep : cA; const char* nB = has_next ? (const char*)g.Bt + (size_t)nxt.pn * tstep : cB;
        for (int t = 0; t < nt; t += 2) {
            const bool last = (t == nt - 2);
            const char* a1 = cA + (size_t)(t + 1) * kstep;
            const char* a2 = last ? nA : cA + (size_t)(t + 2) * kstep; const char* b2 = last ? nB : cB + (size_t)(t + 2) * kstep;
            const char* a3 = a2 + kstep; const char* b3 = b2 + kstep;
            if (last && has_next) S.a_ready(nxt);
            PG8_LDB(B0, 0, 0); PG8_SCHED; PG8_LDA(At, 0, 0); PG8_STAGE(PG8_SA(1, 1), a1 + hstep, voffA);
            PG8_WAIT_L(8); PG8_BAR; PG8_WAIT_L(0); PG8_MMA(0, 0, At, B0); PG8_BAR; PG8_SCHED;
            PG8_LDB(B1, 0, 1); PG8_STAGE(PG8_SB(0, 0), b2, voffB);
            PG8_BAR; PG8_WAIT_L(0); PG8_MMA(0, 1, At, B1); PG8_BAR;
            PG8_LDA(At, 0, 1); PG8_STAGE(PG8_SA(0, 0), a2, voffA);
            PG8_BAR; PG8_WAIT_L(0); PG8_MMA(1, 0, At, B0); PG8_BAR; PG8_SCHED;
            PG8_STAGE(PG8_SB(0, 1), b2 + hstep, voffB);
            PG8_WAIT_V(6); PG8_BAR; PG8_MMA(1, 1, At, B1); PG8_BAR;
            PG8_LDB(B0, 1, 0); PG8_SCHED; PG8_LDA(At, 1, 0); PG8_STAGE(PG8_SA(0, 1), a2 + hstep, voffA);
            PG8_WAIT_L(8); PG8_BAR; PG8_WAIT_L(0); PG8_MMA(0, 0, At, B0); PG8_BAR; PG8_SCHED;
            PG8_LDB(B1, 1, 1); PG8_STAGE(PG8_SB(1, 0), b3, voffB);
            PG8_BAR; PG8_WAIT_L(0); PG8_MMA(0, 1, At, B1); PG8_BAR;
            PG8_LDA(At, 1, 1); PG8_STAGE(PG8_SA(1, 0), a3, voffA);
            PG8_BAR; PG8_WAIT_L(0); PG8_MMA(1, 0, At, B0); PG8_BAR; PG8_SCHED;
            PG8_STAGE(PG8_SB(1, 1), b3 + hstep, voffB);
            PG8_WAIT_V(6); PG8_BAR; PG8_MMA(1, 1, At, B1); PG8_BAR;
        }
        PG8_STAMP();
        if constexpr (!Epi::AFTER_DRAIN) { E(acc, cur, wr, wc, fr, fq); S.done(cur); }
        PG8_STAMP();
        if (!has_next) break;
#pragma unroll
        for (int a = 0; a < 2; ++a)
#pragma unroll
            for (int b = 0; b < 2; ++b)
#pragma unroll
                for (int m = 0; m < 4; ++m)
#pragma unroll
                    for (int n = 0; n < 2; ++n) acc[a][b][m][n] = (f32x4){0.f, 0.f, 0.f, 0.f};
        cur = nxt; cA = nA; cB = nB; ++ui;
    }
    PG8_WAIT_V(0);
    if (wr == 0) PG8_BAR;
    PG8_BAR;
    if constexpr (Epi::AFTER_DRAIN) { E.fused(acc, cur, wr, wc, fr, fq, lds, wid, lane); S.done(cur); }
    PG8_STAMP();
    if (STAMP && wid == 0) { stamps[lane] = lane < nts ? (((unsigned long long)(unsigned)ts_hi << 32) | (unsigned)ts_lo) : 0ull;
        if (lane == 62) stamps[62] = rt_entry; if (lane == 63) stamps[63] = (unsigned long long)wall_clock64(); }
#undef PG8_STAMP
#undef PG8_SA
#undef PG8_SB
#undef PG8_STAGE
#undef PG8_LDA
#undef PG8_LDB
#undef PG8_MMA
#undef PG8_WAIT_V
#undef PG8_WAIT_L
#undef PG8_BAR
#undef PG8_SCHED
}
}
#define XB_TMO      128
#define XB_XCNT(j)  (256  + 64 * (j))
#define XB_XSUB(j)  (1280 + 64 * (j))
#define XB_XGEN(j)  (2304 + 64 * (j))
#define XB_TOP      3328
#define XB_TOPGEN   3392
#define XCD_BAR_WORDS 3456
#define XB_SPIN_CAP (1u << 18)
#define XB_LAS __attribute__((address_space(3)))

__device__ __forceinline__ unsigned xb_ld(unsigned* p)              { return __hip_atomic_load(p, __ATOMIC_RELAXED, __HIP_MEMORY_SCOPE_AGENT); }
__device__ __forceinline__ unsigned xb_add(unsigned* p, unsigned v) { return __hip_atomic_fetch_add(p, v, __ATOMIC_RELAXED, __HIP_MEMORY_SCOPE_AGENT); }
__device__ __forceinline__ unsigned xb_xcc_id() { return (unsigned)__builtin_amdgcn_s_getreg((3 << 11) | 20) & 0xFu; }
#define XB_SPIN(cond, bar) do { unsigned _sp = 0; while (cond) { __builtin_amdgcn_s_sleep(1); \
    if ((++_sp & 255u) == 0u) { if (xb_ld(&(bar)[XB_TMO])) break; if (_sp > XB_SPIN_CAP) { atomicAdd(&(bar)[XB_TMO], 1u); break; } } } } while (0)

struct XcdBarrier {
    unsigned* bar; unsigned x;
    volatile XB_LAS unsigned* st;
};

__device__ __forceinline__ XcdBarrier xcd_barrier_post(unsigned* bar, volatile XB_LAS unsigned* st) {
    XcdBarrier b; b.bar = bar; b.x = xb_xcc_id(); b.st = st;
    if (threadIdx.x == 0) (void)xb_add(&bar[XB_XCNT(b.x)], 1u);
    return b;
}
__device__ __forceinline__ void xcd_barrier_complete(unsigned* bar, unsigned x, unsigned& nloc, unsigned& nx) {
    const unsigned G = gridDim.x * gridDim.y * gridDim.z;
    unsigned sum, cnt, mine, sp = 0u;
    for (;;) {
        sum = 0u; cnt = 0u; mine = 0u;
#pragma unroll
        for (unsigned j = 0; j < 16; ++j) { const unsigned c = xb_ld(&bar[XB_XCNT(j)]); sum += c; cnt += (c > 0u) ? 1u : 0u; mine = (j == x) ? c : mine; }
        if (sum == G) break;
        __builtin_amdgcn_s_sleep(1);
        if ((++sp & 255u) == 0u) { if (xb_ld(&bar[XB_TMO])) break; if (sp > XB_SPIN_CAP) { atomicAdd(&bar[XB_TMO], 1u); break; } }
    }
    nloc = mine > 0u ? mine : 1u; nx = cnt > 0u ? cnt : 1u;
}

__device__ __forceinline__ void xcd_barrier(const XcdBarrier& b) {
    asm volatile("s_waitcnt vmcnt(0)" ::: "memory");
    __syncthreads();
    if (threadIdx.x == 0) {
        unsigned* bar = b.bar;
        __builtin_amdgcn_s_waitcnt(0);
        unsigned nloc = b.st[0], nx = b.st[1];
        if (nloc == 0u) { xcd_barrier_complete(bar, b.x, nloc, nx); b.st[0] = nloc; b.st[1] = nx; }
        const unsigned old = xb_add(&bar[XB_XSUB(b.x)], 1u);
        const unsigned gen = old / nloc;
        if (old + 1u == (gen + 1u) * nloc) {
            __builtin_amdgcn_fence(__ATOMIC_RELEASE, "agent");
            asm volatile("s_waitcnt vmcnt(0)" ::: "memory");
            const unsigned og = xb_add(&bar[XB_TOP], 1u);
            const unsigned tg = og / nx;
            if (og + 1u == (tg + 1u) * nx) xb_add(&bar[XB_TOPGEN], 1u);
            else XB_SPIN(xb_ld(&bar[XB_TOPGEN]) == tg, bar);
            __builtin_amdgcn_fence(__ATOMIC_ACQUIRE, "agent");
            xb_add(&bar[XB_XGEN(b.x)], 1u);
            asm volatile("s_waitcnt vmcnt(0)" ::: "memory");
        } else {
            XB_SPIN(xb_ld(&bar[XB_XGEN(b.x)]) == gen, bar);
            __builtin_amdgcn_fence(__ATOMIC_ACQUIRE, "agent");
            asm volatile("s_waitcnt vmcnt(0)" ::: "memory");
        }
    }
    __syncthreads();
}
using pg8::bf16_t; using pg8::bf16x8; using pg8::f32x4; using pg8::u32x4; using pg8::Unit;
typedef unsigned u32x2 __attribute__((ext_vector_type(2)));
#define MFMA16(a, b, c) __builtin_amdgcn_mfma_f32_16x16x32_bf16((a), (b), (c), 0, 0, 0)

constexpr int T_ = 16384, DM = 2048, NIN = 6144, DFF = 5504, NFF = 11008;
constexpr int LDS_BYTES = 144 * 1024;
constexpr int NPH = 11;

constexpr size_t O_CTR   = 0;
constexpr size_t O_BAR   = 4096;
constexpr size_t O_WIN   = 4096 + 16384;
constexpr size_t O_WOUT  = O_WIN   + (size_t)NIN * DM * 2;
constexpr size_t O_WFIN  = O_WOUT  + (size_t)DM * DM * 2;
constexpr size_t O_WFOUT = O_WFIN  + (size_t)NFF * DM * 2;
constexpr size_t O_WCK   = O_WFOUT + (size_t)DM * DFF * 2;
constexpr size_t O_WCV   = O_WCK   + (size_t)256 * 2048 * 2;
constexpr size_t O_WGLU  = O_WCV   + (size_t)256 * 2048 * 2;
constexpr size_t O_HN    = O_WGLU  + (size_t)512 * 512 * 2;
constexpr size_t O_R     = O_HN    + (size_t)T_ * DM * 2;
constexpr size_t O_P32   = O_R;
constexpr size_t O_PU    = O_P32   + (size_t)T_ * 1536 * 4;
constexpr size_t O_PQKV  = O_PU    + (size_t)T_ * 512 * 2;
constexpr size_t O_PZ    = O_PQKV  + (size_t)T_ * 3072 * 2;
constexpr size_t O_QN    = O_PZ    + (size_t)T_ * 1024 * 2;
constexpr size_t O_KSN   = O_QN    + (size_t)T_ * 512 * 2;
constexpr size_t O_KWN   = O_KSN   + (size_t)T_ * 128 * 2;
constexpr size_t O_VST   = O_KWN   + (size_t)T_ * 128 * 2;
constexpr size_t O_VWT   = O_VST   + (size_t)T_ * 128 * 2;
constexpr size_t O_KC    = O_VWT   + (size_t)T_ * 128 * 2;
constexpr size_t O_VCT   = O_KC    + (size_t)2 * 1024 * 64 * 2;
constexpr size_t O_HCMP  = O_VCT   + (size_t)2 * 64 * 1024 * 2;
constexpr size_t O_GKC   = O_HCMP  + (size_t)2 * 2048 * 256 * 4;
constexpr size_t O_GQG   = O_GKC   + (size_t)2048 * 64 * 128 * 2;
constexpr size_t O_GQK   = O_GQG   + (size_t)2048 * 64 * 128 * 2;
constexpr size_t O_GKD   = O_GQK   + (size_t)2048 * 64 * 64 * 2;
constexpr size_t O_GVAL  = O_GKD   + (size_t)2048 * 64 * 128 * 2;
constexpr size_t O_GEGL  = O_GVAL  + (size_t)2048 * 64 * 128 * 4;
constexpr size_t O_XEND  = O_GEGL  + 8192;
constexpr size_t O_YGELU = O_XEND  + (size_t)64 * 32 * 64 * 2 * 4;
constexpr size_t O_YGLU  = O_YGELU + (size_t)T_ * 512 * 2;
constexpr size_t O_ATT_END = O_YGLU + (size_t)T_ * 512 * 4;
constexpr size_t O_HF    = O_R;
constexpr size_t O_ACT   = O_HF    + (size_t)256 * 4 * NFF * 4;
constexpr size_t O_FFN_END = O_ACT + (size_t)T_ * DFF * 2;
constexpr size_t WS_NEED = O_ATT_END > O_FFN_END ? O_ATT_END : O_FFN_END;

struct Params { const float* in[33]; float* out; unsigned char* ws; int ph_lo, ph_hi; };

__device__ __forceinline__ unsigned short f2bf(float f) { unsigned u = __float_as_uint(f); u += 0x7FFFu + ((u >> 16) & 1u); return (unsigned short)(u >> 16); }
__device__ __forceinline__ float bf2f(unsigned short b) { return __uint_as_float(((unsigned)b) << 16); }
__device__ __forceinline__ unsigned pk2(float lo, float hi) { return pg8::cvt_pk_bf16(lo, hi); }
__device__ __forceinline__ float bflo(unsigned w) { return __uint_as_float(w << 16); }
__device__ __forceinline__ float bfhi(unsigned w) { return __uint_as_float(w & 0xFFFF0000u); }
__device__ __forceinline__ float sigmoidf_(float x) { return __builtin_amdgcn_rcpf(1.0f + __expf(-x)); }
__device__ __forceinline__ float siluf_(float x) { return x * __builtin_amdgcn_rcpf(1.0f + __expf(-x)); }
__device__ __forceinline__ float vmaxf(float a, float b) { float r; asm("v_max_f32 %0, %1, %2" : "=v"(r) : "v"(a), "v"(b)); return r; }
__device__ __forceinline__ float gelu_tanh(float x) { const float u = 0.7978845608028654f * (x + 0.044715f * x * x * x); const float th = 1.0f - 2.0f * __builtin_amdgcn_rcpf(__expf(2.0f * u) + 1.0f); return 0.5f * x * (1.0f + th); }
__device__ __forceinline__ float softplusf_(float x) { return x > 20.f ? x : log1pf(expf(x)); }
__device__ __forceinline__ float wave_sum(float v) { for (int o = 32; o >= 1; o >>= 1) v += __shfl_xor(v, o); return v; }
__device__ __forceinline__ bf16x8 pack8f(f32x4 a, f32x4 b) { u32x4 w; w.x = pk2(a[0], a[1]); w.y = pk2(a[2], a[3]); w.z = pk2(b[0], b[1]); w.w = pk2(b[2], b[3]); return __builtin_bit_cast(bf16x8, w); }
__device__ __forceinline__ float rdlane(float v, int l) { return __int_as_float(__builtin_amdgcn_readlane(__float_as_int(v), l)); }

struct EpiProj {
    static constexpr bool PERM = true, AFTER_DRAIN = false;
    float* P32; bf16_t* Pu; bf16_t* Pqkv; bf16_t* Pz;
    static __device__ __forceinline__ void st_bf(const f32x4 (&acc)[2][2][4][2], bf16_t* base, int ld) {
#pragma unroll
        for (int ai = 0; ai < 2; ++ai)
#pragma unroll
            for (int m = 0; m < 4; ++m) { bf16_t* rp = base + (size_t)(ai * 128 + m * 16) * ld;
#pragma unroll
                for (int bj = 0; bj < 2; ++bj) { const f32x4 v0 = acc[ai][bj][m][0], v1 = acc[ai][bj][m][1]; u32x4 w; w.x = pk2(v0[0], v0[1]); w.y = pk2(v0[2], v0[3]); w.z = pk2(v1[0], v1[1]); w.w = pk2(v1[2], v1[3]); *(u32x4*)(rp + bj * 128) = w; } }
    }
    __device__ __forceinline__ void operator()(const f32x4 (&acc)[2][2][4][2], const Unit& u, int wr, int wc, int fr, int fq) const {
        const int row0 = u.pm * 256 + wr * 64 + fr, colt = wc * 32 + 8 * fq;
        if (u.pn < 6) {
            float* base = P32 + (size_t)row0 * 1536 + u.pn * 256 + colt;
#pragma unroll
            for (int ai = 0; ai < 2; ++ai)
#pragma unroll
                for (int m = 0; m < 4; ++m) { float* rp = base + (size_t)(ai * 128 + m * 16) * 1536;
#pragma unroll
                    for (int bj = 0; bj < 2; ++bj) { *(f32x4*)(rp + bj * 128) = acc[ai][bj][m][0]; *(f32x4*)(rp + bj * 128 + 4) = acc[ai][bj][m][1]; } }
        } else if (u.pn < 8)  st_bf(acc, Pu   + (size_t)row0 * 512  + (u.pn - 6)  * 256 + colt, 512);
        else if (u.pn < 20)   st_bf(acc, Pqkv + (size_t)row0 * 3072 + (u.pn - 8)  * 256 + colt, 3072);
        else                  st_bf(acc, Pz   + (size_t)row0 * 1024 + (u.pn - 20) * 256 + colt, 1024);
    }
};
struct EpiResid {
    static constexpr bool PERM = false, AFTER_DRAIN = false;
    const float* Xin; float* Xout; int ld;
    __device__ __forceinline__ void operator()(const f32x4 (&acc)[2][2][4][2], const Unit& u, int wr, int wc, int fr, int fq) const {
        const size_t off0 = (size_t)(u.pm * 256 + wr * 64 + fr) * ld + u.pn * 256 + wc * 32 + 4 * fq;
#pragma unroll
        for (int ai = 0; ai < 2; ++ai)
#pragma unroll
            for (int m = 0; m < 4; ++m) { const size_t ro = off0 + (size_t)(ai * 128 + m * 16) * ld;
#pragma unroll
                for (int bj = 0; bj < 2; ++bj)
#pragma unroll
                    for (int n = 0; n < 2; ++n) { const size_t o = ro + bj * 128 + n * 16; *(f32x4*)(Xout + o) = *(const f32x4*)(Xin + o) + acc[ai][bj][m][n]; } }
    }
};
struct EpiBf {
    static constexpr bool PERM = true, AFTER_DRAIN = false;
    bf16_t* O; int ld;
    __device__ __forceinline__ void operator()(const f32x4 (&acc)[2][2][4][2], const Unit& u, int wr, int wc, int fr, int fq) const {
        bf16_t* base = O + (size_t)(u.pm * 256 + wr * 64 + fr) * ld + u.pn * 256 + wc * 32 + 8 * fq;
#pragma unroll
        for (int ai = 0; ai < 2; ++ai)
#pragma unroll
            for (int m = 0; m < 4; ++m) { bf16_t* rp = base + (size_t)(ai * 128 + m * 16) * ld;
#pragma unroll
                for (int bj = 0; bj < 2; ++bj) { const f32x4 v0 = acc[ai][bj][m][0], v1 = acc[ai][bj][m][1]; u32x4 w; w.x = pk2(v0[0], v0[1]); w.y = pk2(v0[2], v0[3]); w.z = pk2(v1[0], v1[1]); w.w = pk2(v1[2], v1[3]); *(u32x4*)(rp + bj * 128) = w; } }
    }
};
struct EpiGlu {
    static constexpr bool PERM = false, AFTER_DRAIN = false;
    const bf16_t* Y; float* O;
    __device__ __forceinline__ void operator()(const f32x4 (&acc)[2][2][4][2], const Unit& u, int wr, int wc, int fr, int fq) const {
        const size_t off0 = (size_t)(u.pm * 256 + wr * 64 + fr) * 512 + u.pn * 256 + wc * 32 + 4 * fq;
#pragma unroll
        for (int ai = 0; ai < 2; ++ai)
#pragma unroll
            for (int m = 0; m < 4; ++m) { const size_t ro = off0 + (size_t)(ai * 128 + m * 16) * 512;
#pragma unroll
                for (int bj = 0; bj < 2; ++bj)
#pragma unroll
                    for (int n = 0; n < 2; ++n) { const size_t o = ro + bj * 128 + n * 16; const u32x2 yw = *(const u32x2*)(Y + o); const f32x4 a = acc[ai][bj][m][n];
                        f32x4 r; r[0] = bflo(yw.x) * sigmoidf_(a[0]); r[1] = bfhi(yw.x) * sigmoidf_(a[1]); r[2] = bflo(yw.y) * sigmoidf_(a[2]); r[3] = bfhi(yw.y) * sigmoidf_(a[3]); *(f32x4*)(O + o) = r; } }
    }
};

template <int CTRL> __device__ __forceinline__ f32x4 ror4(const f32x4 v) { f32x4 r;
    r[0] = __int_as_float(__builtin_amdgcn_update_dpp(0, __float_as_int(v[0]), CTRL, 0xF, 0xF, true)); r[1] = __int_as_float(__builtin_amdgcn_update_dpp(0, __float_as_int(v[1]), CTRL, 0xF, 0xF, true));
    r[2] = __int_as_float(__builtin_amdgcn_update_dpp(0, __float_as_int(v[2]), CTRL, 0xF, 0xF, true)); r[3] = __int_as_float(__builtin_amdgcn_update_dpp(0, __float_as_int(v[3]), CTRL, 0xF, 0xF, true)); return r; }
struct EpiFfnAct {
    static constexpr bool PERM = true, AFTER_DRAIN = false;
    bf16_t* act; float* hb; const float* cw; const float* cb;
    __device__ __forceinline__ void operator()(const f32x4 (&acc)[2][2][4][2], const Unit& u, int wr, int wc, int fr, int fq) const {
        const int colg = 128 * u.pn + wc * 32 + 8 * fq;
#pragma unroll
        for (int n = 0; n < 2; ++n) {
            const int g0 = colg + 4 * n;
            const f32x4 wg0 = *(const f32x4*)(cw + g0), wg1 = *(const f32x4*)(cw + NFF + g0), wg2 = *(const f32x4*)(cw + 2 * NFF + g0), bg = *(const f32x4*)(cb + g0);
            const f32x4 wu0 = *(const f32x4*)(cw + DFF + g0), wu1 = *(const f32x4*)(cw + NFF + DFF + g0), wu2 = *(const f32x4*)(cw + 2 * NFF + DFF + g0), bu = *(const f32x4*)(cb + DFF + g0);
#pragma unroll
            for (int ai = 0; ai < 2; ++ai) {
                const int grp = 4 * u.pm + 2 * ai + wr;
                float* hbg = hb + (size_t)grp * 4 * NFF + 256 * u.pn + wc * 32 + 8 * fq + 4 * n;
#pragma unroll
                for (int m = 0; m < 4; ++m) {
                    const f32x4 cg = acc[ai][0][m][n], cu = acc[ai][1][m][n];
                    const f32x4 pg = acc[ai][0][m > 0 ? m - 1 : 0][n], pu = acc[ai][1][m > 0 ? m - 1 : 0][n];
                    const f32x4 g1a = ror4<0x121>(cg), g2a = ror4<0x122>(cg), u1a = ror4<0x121>(cu), u2a = ror4<0x122>(cu);
                    const f32x4 g1b = ror4<0x121>(pg), g2b = ror4<0x122>(pg), u1b = ror4<0x121>(pu), u2b = ror4<0x122>(pu);
                    f32x4 g1, g2, u1, u2;
#pragma unroll
                    for (int e = 0; e < 4; ++e) { g1[e] = fr == 0 ? g1b[e] : g1a[e]; g2[e] = fr < 2 ? g2b[e] : g2a[e]; u1[e] = fr == 0 ? u1b[e] : u1a[e]; u2[e] = fr < 2 ? u2b[e] : u2a[e]; }
                    const f32x4 G = bg + wg0 * g2 + wg1 * g1 + wg2 * cg, U = bu + wu0 * u2 + wu1 * u1 + wu2 * cu;
                    u32x2 w; w.x = pk2(siluf_(G[0]) * U[0], siluf_(G[1]) * U[1]); w.y = pk2(siluf_(G[2]) * U[2], siluf_(G[3]) * U[3]);
                    const int row = u.pm * 256 + ai * 128 + wr * 64 + m * 16 + fr;
                    if (m > 0 || fr >= 2) *(u32x2*)(act + (size_t)row * DFF + g0) = w;
                    if (m == 0 && fr < 2)  { *(f32x4*)(hbg + (size_t)fr * NFF) = cg; *(f32x4*)(hbg + (size_t)fr * NFF + 128) = cu; }
                    if (m == 3 && fr >= 14) { *(f32x4*)(hbg + (size_t)(fr - 12) * NFF) = cg; *(f32x4*)(hbg + (size_t)(fr - 12) * NFF + 128) = cu; }
                }
            }
        }
    }
};
__device__ __forceinline__ int map_in_col(int n) { return n < 1304 ? n : (n < 1312 ? 5912 + (n - 1304) : (n < 1320 ? 5920 + (n - 1312) : (n < 1536 ? -1 : 1304 + (n - 1536)))); }
struct ConvJob { const float* src; bf16_t* dst; int srcN, K, tile; int inmap; };
__device__ __forceinline__ bool conv_job(const Params& p, int layer, int it, ConvJob& j) {
    unsigned char* ws = p.ws;
    const int n0 = 32 * 24, n1 = n0 + 32 * 8, n2 = n1 + 32 * 43, n3 = n2 + 86 * 8, n4 = n3 + 32, n5 = n4 + 32, n6 = n5 + 16;
    if (it >= n6) return false;
    j.inmap = 0;
    if (it < n0)      { j.src = p.in[2]  + (size_t)layer * DM * 5928; j.srcN = 5928; j.K = DM; j.dst = (bf16_t*)(ws + O_WIN); j.tile = it; j.inmap = 1; }
    else if (it < n1) { j.src = p.in[27] + (size_t)layer * DM * DM; j.srcN = DM; j.K = DM; j.dst = (bf16_t*)(ws + O_WOUT); j.tile = it - n0; }
    else if (it < n2) { j.src = p.in[29] + (size_t)layer * DM * NFF; j.srcN = NFF; j.K = DM; j.dst = (bf16_t*)(ws + O_WFIN); j.tile = it - n1; j.inmap = 2; }
    else if (it < n3) { j.src = p.in[32] + (size_t)layer * DFF * DM; j.srcN = DM; j.K = DFF; j.dst = (bf16_t*)(ws + O_WFOUT); j.tile = it - n2; }
    else if (it < n4) { j.src = p.in[8]  + (size_t)layer * 2048 * 256; j.srcN = 256; j.K = 2048; j.dst = (bf16_t*)(ws + O_WCK); j.tile = it - n3; }
    else if (it < n5) { j.src = p.in[10] + (size_t)layer * 2048 * 256; j.srcN = 256; j.K = 2048; j.dst = (bf16_t*)(ws + O_WCV); j.tile = it - n4; }
    else              { j.src = p.in[21] + (size_t)layer * 512 * 512; j.srcN = 512; j.K = 512; j.dst = (bf16_t*)(ws + O_WGLU); j.tile = it - n5; }
    return true;
}
__device__ __forceinline__ void conv_load(const ConvJob& j, int tid, float (&v)[32]) {
    const int nk = j.K >> 6, tk = j.tile % nk, tn = j.tile / nk, k0 = tk * 64, n0 = tn * 256, tx = tid & 255, ty = tid >> 8;
    const int n = n0 + tx, sc = j.inmap == 1 ? map_in_col(n) : (j.inmap == 2 ? ((n & 255) < 128 ? 128 * (n >> 8) + (n & 127) : DFF + 128 * (n >> 8) + (n & 127)) : n);
    const float* sp = j.src + (size_t)(k0 + ty) * j.srcN + (sc >= 0 ? sc : 0);
#pragma unroll
    for (int i = 0; i < 32; ++i) v[i] = (sc >= 0) ? sp[(size_t)(2 * i) * j.srcN] : 0.f;
}
__device__ __forceinline__ void conv_store(const ConvJob& j, int tid, const float (&v)[32], float* sm) {
    const int nk = j.K >> 6, tk = j.tile % nk, tn = j.tile / nk, k0 = tk * 64, n0 = tn * 256, tx = tid & 255, ty = tid >> 8;
#pragma unroll
    for (int i = 0; i < 32; ++i) sm[(ty + 2 * i) * 257 + tx] = v[i];
    __syncthreads();
    const int nn = tid >> 1, hf = tid & 1;
    bf16_t* o = j.dst + (size_t)(n0 + nn) * j.K + k0 + hf * 32;
#pragma unroll
    for (int q = 0; q < 4; ++q) { u32x4 w; const float* sp = sm + (hf * 32 + q * 8) * 257 + nn;
        w.x = pk2(sp[0], sp[257]); w.y = pk2(sp[2 * 257], sp[3 * 257]); w.z = pk2(sp[4 * 257], sp[5 * 257]); w.w = pk2(sp[6 * 257], sp[7 * 257]); *(u32x4*)(o + q * 8) = w; }
    __syncthreads();
}
__device__ void phase_convert(const Params& p, int layer, float* sm) {
    const int G = gridDim.x, tid = tidx();
    ConvJob ja, jb; float va[32], vb[32];
    int it = blockIdx.x;
    bool ha = conv_job(p, layer, it, ja);
    if (ha) conv_load(ja, tid, va);
    while (ha) {
        const bool hb = conv_job(p, layer, it + G, jb);
        if (hb) conv_load(jb, tid, vb);
        conv_store(ja, tid, va, sm);
        if (!hb) break;
        ha = conv_job(p, layer, it + 2 * G, ja);
        if (ha) conv_load(ja, tid, va);
        conv_store(jb, tid, vb, sm);
        it += 2 * G;
    }
}
__device__ void phase_rmsnorm(const float* __restrict__ x, const float* __restrict__ gain, bf16_t* __restrict__ hn, float* __restrict__ xcopy) {
    const int wave = tidx() >> 6, lane = tidx() & 63;
    for (int r = blockIdx.x * 8 + wave; r < T_; r += gridDim.x * 8) {
        const f32x4* xr = (const f32x4*)(x + (size_t)r * DM);
        f32x4 v[8]; float ss = 0.f;
#pragma unroll
        for (int i = 0; i < 8; ++i) { v[i] = xr[lane + 64 * i]; ss += v[i][0] * v[i][0] + v[i][1] * v[i][1] + v[i][2] * v[i][2] + v[i][3] * v[i][3]; }
        ss = wave_sum(ss);
        const float rs = rsqrtf(ss * (1.0f / DM) + 1e-6f);
#pragma unroll
        for (int i = 0; i < 8; ++i) { const f32x4 g = ((const f32x4*)gain)[lane + 64 * i]; u32x2 w; w.x = pk2(v[i][0] * rs * g[0], v[i][1] * rs * g[1]); w.y = pk2(v[i][2] * rs * g[2], v[i][3] * rs * g[3]);
            *(u32x2*)(hn + (size_t)r * DM + (lane + 64 * i) * 4) = w; if (xcopy) ((f32x4*)(xcopy + (size_t)r * DM))[lane + 64 * i] = v[i]; }
    }
}

__device__ void nsa_prep_item(const Params& p, int layer, int item, float* sm) {
    unsigned char* ws = p.ws;
    const float* P32 = (const float*)(ws + O_P32);
    bf16_t* qn = (bf16_t*)(ws + O_QN); bf16_t* ksn = (bf16_t*)(ws + O_KSN); bf16_t* kwn = (bf16_t*)(ws + O_KWN);
    const int wave = tidx() >> 6, lane = tidx() & 63, tid = tidx();
    const int t0 = item * 64;
    const float gq = p.in[3][layer * 64 + lane], gks = p.in[5][layer * 64 + lane], gkw = p.in[6][layer * 64 + lane];
    const float inv = powf(500000.0f, -(float)(lane & 7) * 0.125f);
    for (int tt = 0; tt < 8; ++tt) {
        const int t = t0 + wave * 8 + tt;
        float sn, cs; sincosf((float)t * inv, &sn, &cs);
        const float* row = P32 + (size_t)t * 1536;
#pragma unroll
        for (int hv = 0; hv < 12; ++hv) {
            const int col = hv < 8 ? hv * 64 : (hv < 10 ? 768 + (hv - 8) * 64 : 1024 + (hv - 10) * 64);
            const float g = hv < 8 ? gq : (hv < 10 ? gks : gkw);
            const float x = row[col + lane];
            const float ss = wave_sum(x * x);
            float y = x * rsqrtf(ss * (1.0f / 64.0f) + 1e-6f) * g;
            const float yp = __shfl(y, lane ^ 8);
            if (lane < 8) y = y * cs - yp * sn; else if (lane < 16) y = y * cs + yp * sn;
            if (hv < 8) qn[(size_t)t * 512 + hv * 64 + lane] = f2bf(y * 0.18033688011112042f);
            else {
                unsigned char* k8 = (hv < 10 ? ws + O_KSN : ws + O_KWN) + ((size_t)(((hv - 8) & 1) * 256 + (t >> 6)) * 64 + (t & 63)) * 64 + ((lane >> 3) & 3) * 16 + (lane >> 5) * 8 + (lane & 7);
                *k8 = (unsigned char)__builtin_amdgcn_cvt_pk_fp8_f32(y, 0.f, 0, false);
            }
        }
    }
    for (int e = tid; e < 64 * 256; e += 512) { const int tk = e >> 8, c = e & 255; sm[tk * 257 + c] = P32[(size_t)(t0 + tk) * 1536 + (c < 128 ? 896 + c : 1152 + (c - 128))]; }
    __syncthreads();
    unsigned char* vs8 = ws + O_VST; unsigned char* vw8 = ws + O_VWT;
#pragma unroll
    for (int i = 0; i < 4; ++i) {
        const int rowid = (tid >> 3) + 64 * i, ts = tid & 7;
        float f[8];
#pragma unroll
        for (int k = 0; k < 8; ++k) { const int bb = ts * 8 + k, cc = ((bb >> 3) & 1) * 32 + (bb >> 4) * 8 + (bb & 7); f[k] = sm[((cc & 3) * 16 + (cc >> 2)) * 257 + rowid]; }
        u32x2 w; int t;
        t = __builtin_amdgcn_cvt_pk_fp8_f32(f[0], f[1], 0, false); t = __builtin_amdgcn_cvt_pk_fp8_f32(f[2], f[3], t, true); w.x = (unsigned)t;
        t = __builtin_amdgcn_cvt_pk_fp8_f32(f[4], f[5], 0, false); t = __builtin_amdgcn_cvt_pk_fp8_f32(f[6], f[7], t, true); w.y = (unsigned)t;
        const int rr = rowid & 127;
        unsigned char* dst = (rowid < 128 ? vs8 : vw8) + ((size_t)((rr >> 6) * 256 + item) * 64 + (rr & 63)) * 64 + ts * 8;
        *(u32x2*)dst = w;
    }
    __syncthreads();
}

__device__ void cmp1_wave_tile(const Params& p, int layer, int tile) {
    unsigned char* ws = p.ws;
    const float* P32 = (const float*)(ws + O_P32);
    const int lane = tidx() & 63, fr = lane & 15, fq = lane >> 4;
    const int nt = tile & 15, mt = (tile >> 4) & 127, which = tile >> 11;
    const bf16_t* Wt = (const bf16_t*)(ws + (which ? O_WCV : O_WCK)) + (size_t)(nt * 16 + fr) * 2048 + fq * 8;
    const float* pe = p.in[7] + (size_t)layer * 2048;
    const int r = mt * 16 + fr, n = r >> 1, hk = r & 1;
    const bool rv = n < 1023;
    const float* arow = P32 + (size_t)(16 * (rv ? n : 0)) * 1536 + (which ? 640 : 512) + hk * 64 + fq * 8;
    f32x4 acc = {0.f, 0.f, 0.f, 0.f};
#pragma unroll 8
    for (int ks = 0; ks < 64; ++ks) {
        const int l = ks >> 1, d = (ks & 1) * 32;
        const f32x4* ap = (const f32x4*)(arow + (size_t)l * 1536 + d);
        const f32x4* pp = (const f32x4*)(pe + l * 64 + d + fq * 8);
        f32x4 a0 = ap[0] + pp[0], a1 = ap[1] + pp[1];
        if (!rv) { a0 = (f32x4){0.f, 0.f, 0.f, 0.f}; a1 = a0; }
        const bf16x8 af = pack8f(a0, a1);
        const bf16x8 bf = *(const bf16x8*)(Wt + ks * 32);
        acc = MFMA16(af, bf, acc);
    }
    float* H = (float*)(ws + O_HCMP) + (size_t)which * 2048 * 256;
#pragma unroll
    for (int j = 0; j < 4; ++j) H[(size_t)(mt * 16 + fq * 4 + j) * 256 + nt * 16 + fr] = gelu_tanh(acc[j]);
}
__device__ void cmp2_wave_row(const Params& p, int layer, int idx) {
    unsigned char* ws = p.ws;
    const int lane = tidx() & 63;
    const int which = idx >> 11, r = idx & 2047, n = r >> 1, hk = r & 1;
    const float* H = (const float*)(ws + O_HCMP) + ((size_t)which * 2048 + r) * 256;
    const float* w2 = p.in[which ? 11 : 9] + (size_t)layer * 256 * 64;
    float acc = 0.f;
    if (n < 1023) {
        float a4[4] = {0.f, 0.f, 0.f, 0.f};
#pragma unroll 8
        for (int f = 0; f < 256; f += 4) { const f32x4 h4 = *(const f32x4*)(H + f); a4[0] += h4[0] * w2[f * 64 + lane]; a4[1] += h4[1] * w2[(f + 1) * 64 + lane]; a4[2] += h4[2] * w2[(f + 2) * 64 + lane]; a4[3] += h4[3] * w2[(f + 3) * 64 + lane]; }
        acc = (a4[0] + a4[1]) + (a4[2] + a4[3]);
    }
    if (which == 0) {
        const float ss = wave_sum(acc * acc);
        float y = acc * rsqrtf(ss * (1.0f / 64.0f) + 1e-6f) * p.in[4][layer * 64 + lane];
        const float inv = powf(500000.0f, -(float)(lane & 7) * 0.125f);
        float sn, cs; sincosf((float)(16 * n + 16) * inv, &sn, &cs);
        const float yp = __shfl(y, lane ^ 8);
        if (lane < 8) y = y * cs - yp * sn; else if (lane < 16) y = y * cs + yp * sn;
        if (n >= 1023) y = 0.f;
        ((bf16_t*)(ws + O_KC))[((size_t)hk * 1024 + n) * 64 + lane] = f2bf(y);
    } else {
        { const int cc = ((n & 15) << 2) | ((n >> 4) & 3); (ws + O_VCT)[((size_t)(hk * 16 + (n >> 6)) * 64 + lane) * 64 + ((cc >> 3) & 3) * 16 + (cc >> 5) * 8 + (cc & 7)] = (unsigned char)__builtin_amdgcn_cvt_pk_fp8_f32(acc, 0.f, 0, false); }
    }
}

typedef float f32x2 __attribute__((ext_vector_type(2)));
struct S5Coef { float ar, ai; f32x2 bb[16]; };
__device__ __forceinline__ void s5_setup(const Params& p, int layer, int g, int lane, S5Coef& c) {
    const int gp = layer * 2048 + g * 64 + lane;
    const float dt = expf(p.in[15][layer * 32 + g]);
    const float lr = p.in[13][gp], li = p.in[14][gp];
    const float mag = expf(lr * dt); float sn, cs; sincosf(li * dt, &sn, &cs);
    c.ar = mag * cs; c.ai = mag * sn;
    const float den = lr * lr + li * li, nr = c.ar - 1.0f, ni = c.ai;
    const float cr = (nr * lr + ni * li) / den, ci = (ni * lr - nr * li) / den;
    const f32x4* br = (const f32x4*)(p.in[16] + (size_t)gp * 16); const f32x4* bi = (const f32x4*)(p.in[17] + (size_t)gp * 16);
#pragma unroll
    for (int q = 0; q < 4; ++q) { const f32x4 a = br[q], b = bi[q];
#pragma unroll
        for (int e = 0; e < 4; ++e) c.bb[q * 4 + e] = (f32x2){cr * a[e] - ci * b[e], cr * b[e] + ci * a[e]}; }
}
__device__ __forceinline__ void s5_stage_u(const bf16_t* Pu, int tok, int g, float* ul, int lane) {
    const u32x4* s = (const u32x4*)(Pu + (size_t)tok * 512 + g * 16); const u32x4 a = s[0], b = s[1];
    f32x4* o = (f32x4*)(ul + lane * 16);
    o[0] = (f32x4){bflo(a.x), bfhi(a.x), bflo(a.y), bfhi(a.y)}; o[1] = (f32x4){bflo(a.z), bfhi(a.z), bflo(a.w), bfhi(a.w)};
    o[2] = (f32x4){bflo(b.x), bfhi(b.x), bflo(b.y), bfhi(b.y)}; o[3] = (f32x4){bflo(b.z), bfhi(b.z), bflo(b.w), bfhi(b.w)};
    asm volatile("s_waitcnt lgkmcnt(0)" ::: "memory");
}
__device__ __forceinline__ void s5_step(const S5Coef& k, const float* uj, float& xr, float& xi) {
    const f32x4 u0 = ((const f32x4*)uj)[0], u1 = ((const f32x4*)uj)[1], u2 = ((const f32x4*)uj)[2], u3 = ((const f32x4*)uj)[3];
    f32x2 acc0 = {0.f, 0.f}, acc1 = {0.f, 0.f};
#pragma unroll
    for (int e = 0; e < 4; ++e) { acc0 += k.bb[e] * u0[e]; acc1 += k.bb[4 + e] * u1[e]; }
#pragma unroll
    for (int e = 0; e < 4; ++e) { acc0 += k.bb[8 + e] * u2[e]; acc1 += k.bb[12 + e] * u3[e]; }
    const f32x2 bu = acc0 + acc1;
    const float nxr = k.ar * xr - k.ai * xi + bu[0], nxi = k.ar * xi + k.ai * xr + bu[1]; xr = nxr; xi = nxi;
}
__device__ void s5_passA_wave(const Params& p, int layer, int item, float* ul) {
    unsigned char* ws = p.ws; const bf16_t* Pu = (const bf16_t*)(ws + O_PU);
    const int lane = tidx() & 63, c = item >> 5, g = item & 31;
    S5Coef k; s5_setup(p, layer, g, lane, k);
    float xr = 0.f, xi = 0.f;
    for (int sub = 0; sub < 4; ++sub) {
        s5_stage_u(Pu, c * 256 + sub * 64 + lane, g, ul, lane);
#pragma unroll 4
        for (int j = 0; j < 64; ++j) s5_step(k, ul + j * 16, xr, xi);
        asm volatile("s_waitcnt lgkmcnt(0)" ::: "memory");
    }
    float* xe = (float*)(ws + O_XEND) + ((size_t)(c * 32 + g) * 64 + lane) * 2; xe[0] = xr; xe[1] = xi;
}
__device__ void s5_passB_wave(const Params& p, int layer, int item, bf16_t* xl, float* ul) {
    unsigned char* ws = p.ws; const bf16_t* Pu = (const bf16_t*)(ws + O_PU); bf16_t* yg = (bf16_t*)(ws + O_YGELU);
    const int lane = tidx() & 63, fr = lane & 15, fq = lane >> 4, c = item >> 5, g = item & 31;
    S5Coef k; s5_setup(p, layer, g, lane, k);
    float pr = k.ar, pi = k.ai;
#pragma unroll
    for (int s = 0; s < 8; ++s) { const float nr = pr * pr - pi * pi, ni = 2.f * pr * pi; pr = nr; pi = ni; }
    float xr = 0.f, xi = 0.f;
    const float* xe = (const float*)(ws + O_XEND) + ((size_t)g * 64 + lane) * 2;
#pragma unroll 8
    for (int cc = 0; cc < c; ++cc) { const float er = xe[(size_t)cc * 32 * 64 * 2], ei = xe[(size_t)cc * 32 * 64 * 2 + 1]; const float nr = pr * xr - pi * xi + er, ni = pr * xi + pi * xr + ei; xr = nr; xi = ni; }
    bf16x8 cf[4];
    {
        const float* cre = p.in[18] + (size_t)layer * 32 * 16 * 64 + ((size_t)g * 16 + fr) * 64; const float* cim = p.in[19] + (size_t)layer * 32 * 16 * 64 + ((size_t)g * 16 + fr) * 64;
#pragma unroll
        for (int ks = 0; ks < 4; ++ks) { const float* s = (ks < 2 ? cre : cim) + (ks & 1) * 32 + fq * 8; f32x4 a = ((const f32x4*)s)[0], b = ((const f32x4*)s)[1]; if (ks >= 2) { a = -a; b = -b; } cf[ks] = pack8f(a, b); }
    }
    const float dsk = p.in[20][layer * 512 + g * 16 + fr];
    for (int sub = 0; sub < 4; ++sub) {
        const int tb = c * 256 + sub * 64;
        s5_stage_u(Pu, tb + lane, g, ul, lane);
        for (int jb = 0; jb < 4; ++jb) {
#pragma unroll 4
            for (int jj = 0; jj < 16; ++jj) {
                s5_step(k, ul + (jb * 16 + jj) * 16, xr, xi);
                xl[jj * 136 + lane] = f2bf(xr); xl[jj * 136 + 64 + lane] = f2bf(xi);
            }
            asm volatile("s_waitcnt lgkmcnt(0)" ::: "memory");
            f32x4 y = {0.f, 0.f, 0.f, 0.f};
#pragma unroll
            for (int ks = 0; ks < 4; ++ks) { const bf16x8 af = *(const bf16x8*)(xl + fr * 136 + ks * 32 + fq * 8); y = MFMA16(af, cf[ks], y); }
            asm volatile("s_waitcnt lgkmcnt(0)" ::: "memory");
#pragma unroll
            for (int q = 0; q < 4; ++q) { const int tl = jb * 16 + fq * 4 + q; const float u = ul[tl * 16 + fr]; yg[(size_t)(tb + tl) * 512 + g * 16 + fr] = f2bf(gelu_tanh(y[q] + dsk * u)); }
        }
        asm volatile("s_waitcnt lgkmcnt(0)" ::: "memory");
    }
}
__device__ void gdn_prep_item(const Params& p, int layer, int item, unsigned char* lds) {
    unsigned char* ws = p.ws;
    const int tid = tidx(), wave = tid >> 6, lane = tid & 63, fr = lane & 15, fq = lane >> 4;
    const int n = item >> 3, h = item & 7, t0 = n * 64;
    bf16_t* qs = (bf16_t*)(lds); bf16_t* ks = (bf16_t*)(lds + 17408); bf16_t* vbT = (bf16_t*)(lds + 34816); bf16_t* kgT = (bf16_t*)(lds + 53248); bf16_t* kdT = (bf16_t*)(lds + 71680);
    float* Am = (float*)(lds + 90112); bf16_t* Tb = (bf16_t*)(lds + 107520); float* gcs = (float*)(lds + 116736); float* bts = (float*)(lds + 116992);
    const float* P32 = (const float*)(ws + O_P32); const bf16_t* Pqkv = (const bf16_t*)(ws + O_PQKV);
    if (wave == 0) {
        const int t = t0 + lane;
        const float a = P32[(size_t)t * 1536 + 1304 + h], b = P32[(size_t)t * 1536 + 1312 + h];
        const float g = -expf(p.in[24][layer * 8 + h]) * softplusf_(a + p.in[25][layer * 8 + h]);
        float s = g;
#pragma unroll
        for (int off = 1; off < 64; off <<= 1) { const float o = __shfl_up(s, off); if (lane >= off) s += o; }
        gcs[lane] = s; bts[lane] = sigmoidf_(b);
    }
    __syncthreads();
    {
        const int r = tid >> 3, c0 = (tid & 7) * 16;
        const float gcr = gcs[r], btr = bts[r], eg = expf(gcr), ed = expf(gcs[63] - gcr);
        const float* cw = p.in[23] + (size_t)layer * 4 * 3072;
#pragma unroll
        for (int which = 0; which < 3; ++which) {
            const int col = which * 1024 + h * 128 + c0;
            float acc[16];
#pragma unroll
            for (int e = 0; e < 16; ++e) acc[e] = 0.f;
#pragma unroll
            for (int j = 0; j < 4; ++j) {
                const int tr = t0 + r - 3 + j;
                if (tr >= 0) {
                    const u32x4* s = (const u32x4*)(Pqkv + (size_t)tr * 3072 + col); const u32x4 a = s[0], b = s[1];
                    const f32x4* wp = (const f32x4*)(cw + j * 3072 + col); const f32x4 w0 = wp[0], w1 = wp[1], w2 = wp[2], w3 = wp[3];
                    acc[0] += w0[0] * bflo(a.x); acc[1] += w0[1] * bfhi(a.x); acc[2] += w0[2] * bflo(a.y); acc[3] += w0[3] * bfhi(a.y);
                    acc[4] += w1[0] * bflo(a.z); acc[5] += w1[1] * bfhi(a.z); acc[6] += w1[2] * bflo(a.w); acc[7] += w1[3] * bfhi(a.w);
                    acc[8] += w2[0] * bflo(b.x); acc[9] += w2[1] * bfhi(b.x); acc[10] += w2[2] * bflo(b.y); acc[11] += w2[3] * bfhi(b.y);
                    acc[12] += w3[0] * bflo(b.z); acc[13] += w3[1] * bfhi(b.z); acc[14] += w3[2] * bflo(b.w); acc[15] += w3[3] * bfhi(b.w);
                }
            }
            float ss = 0.f;
#pragma unroll
            for (int e = 0; e < 16; ++e) { acc[e] = siluf_(acc[e]); ss += acc[e] * acc[e]; }
            ss += __shfl_xor(ss, 1); ss += __shfl_xor(ss, 2); ss += __shfl_xor(ss, 4);
            const float rn = rsqrtf(ss + 1e-6f);
            if (which == 0) {
                bf16_t* qg = (bf16_t*)(ws + O_GQG) + (size_t)item * 8192 + r * 128 + c0;
                float v[16];
#pragma unroll
                for (int e = 0; e < 16; ++e) v[e] = acc[e] * rn * 0.08838834764831845f;
                u32x4 w0, w1; w0.x = pk2(v[0], v[1]); w0.y = pk2(v[2], v[3]); w0.z = pk2(v[4], v[5]); w0.w = pk2(v[6], v[7]); w1.x = pk2(v[8], v[9]); w1.y = pk2(v[10], v[11]); w1.z = pk2(v[12], v[13]); w1.w = pk2(v[14], v[15]);
                *(u32x4*)(qs + r * 136 + c0) = w0; *(u32x4*)(qs + r * 136 + c0 + 8) = w1;
                u32x4 g0, g1; g0.x = pk2(v[0] * eg, v[1] * eg); g0.y = pk2(v[2] * eg, v[3] * eg); g0.z = pk2(v[4] * eg, v[5] * eg); g0.w = pk2(v[6] * eg, v[7] * eg);
                g1.x = pk2(v[8] * eg, v[9] * eg); g1.y = pk2(v[10] * eg, v[11] * eg); g1.z = pk2(v[12] * eg, v[13] * eg); g1.w = pk2(v[14] * eg, v[15] * eg);
                *(u32x4*)qg = g0; *(u32x4*)(qg + 8) = g1;
            } else if (which == 1) {
                float v[16];
#pragma unroll
                for (int e = 0; e < 16; ++e) v[e] = acc[e] * rn;
                u32x4 w0, w1; w0.x = pk2(v[0], v[1]); w0.y = pk2(v[2], v[3]); w0.z = pk2(v[4], v[5]); w0.w = pk2(v[6], v[7]); w1.x = pk2(v[8], v[9]); w1.y = pk2(v[10], v[11]); w1.z = pk2(v[12], v[13]); w1.w = pk2(v[14], v[15]);
                *(u32x4*)(ks + r * 136 + c0) = w0; *(u32x4*)(ks + r * 136 + c0 + 8) = w1;
#pragma unroll
                for (int e = 0; e < 16; ++e) { kgT[(c0 + e) * 72 + r] = f2bf(v[e] * btr * eg); kdT[(c0 + e) * 72 + r] = f2bf(v[e] * ed); }
            } else {
#pragma unroll
                for (int e = 0; e < 16; ++e) vbT[(c0 + e) * 72 + r] = f2bf(acc[e] * btr);
            }
        }
    }
    __syncthreads();
    {
        const int d = tid >> 2, sg = tid & 3;
        const u32x4 a = *(const u32x4*)(kdT + d * 72 + sg * 16), b = *(const u32x4*)(kdT + d * 72 + sg * 16 + 8);
        bf16_t* dst = (bf16_t*)(ws + O_GKD) + (size_t)item * 8192 + d * 64 + sg * 16; *(u32x4*)dst = a; *(u32x4*)(dst + 8) = b;
    }
    { float* Tmz = (float*)(lds + 117248); for (int e2 = tid; e2 < 64 * 68; e2 += 512) Tmz[e2] = 0.f; }
    {
        const int mi = wave >> 1;
        bf16_t* qko = (bf16_t*)(ws + O_GQK) + (size_t)item * 4096;
#pragma unroll
        for (int q = 0; q < 2; ++q) {
            const int nj = (wave & 1) * 2 + q;
            f32x4 kk = {0.f, 0.f, 0.f, 0.f}, qk = {0.f, 0.f, 0.f, 0.f};
            if (nj <= mi) {
#pragma unroll
                for (int s = 0; s < 4; ++s) {
                    const bf16x8 bk = *(const bf16x8*)(ks + (nj * 16 + fr) * 136 + s * 32 + fq * 8);
                    const bf16x8 ak = *(const bf16x8*)(ks + (mi * 16 + fr) * 136 + s * 32 + fq * 8);
                    const bf16x8 aq = *(const bf16x8*)(qs + (mi * 16 + fr) * 136 + s * 32 + fq * 8);
                    kk = MFMA16(ak, bk, kk); qk = MFMA16(aq, bk, qk);
                }
            }
            const int j = nj * 16 + fr; const float gj = gcs[j];
#pragma unroll
            for (int e = 0; e < 4; ++e) {
                const int i = mi * 16 + fq * 4 + e;
                const float dec = (j <= i) ? expf(gcs[i] - gj) : 0.f;
                Am[i * 68 + j] = (j < i) ? bts[i] * kk[e] * dec : 0.f;
                qko[i * 64 + j] = f2bf((j <= i) ? qk[e] * dec : 0.f);
            }
        }
    }
    __syncthreads();
    {
        float* Tm = (float*)(lds + 117248); float* Ps = (float*)(lds + 134656) + wave * 320;
        if (wave == 0) {
            const int bo = fq * 16; float t[16];
#pragma unroll
            for (int i = 0; i < 16; ++i) {
                float s = (i == fr) ? 1.f : 0.f;
#pragma unroll
                for (int j = 0; j < i; ++j) s -= Am[(bo + i) * 68 + bo + j] * t[j];
                t[i] = s; Tm[(bo + i) * 68 + bo + fr] = s;
            }
        }
        asm volatile("s_waitcnt lgkmcnt(0)" ::: "memory"); __syncthreads();
#pragma unroll
        for (int d = 1; d < 4; ++d) {
            if (wave < 4 - d) {
                const int bi = wave + d, bj = wave;
                f32x4 Q = {0.f, 0.f, 0.f, 0.f};
                for (int kb = bj; kb < bi; ++kb) {
                    const float* X = Am + (bi * 16) * 68 + kb * 16; const float* Y = Tm + (kb * 16) * 68 + bj * 16;
#pragma unroll
                    for (int s = 0; s < 4; ++s) Q = __builtin_amdgcn_mfma_f32_16x16x4f32(X[fr * 68 + 4 * s + fq], Y[(4 * s + fq) * 68 + fr], Q, 0, 0, 0);
                }
#pragma unroll
                for (int e2 = 0; e2 < 4; ++e2) Ps[(fq * 4 + e2) * 20 + fr] = Q[e2];
                asm volatile("s_waitcnt lgkmcnt(0)" ::: "memory");
                f32x4 R = {0.f, 0.f, 0.f, 0.f};
                const float* X = Tm + (bi * 16) * 68 + bi * 16;
#pragma unroll
                for (int s = 0; s < 4; ++s) R = __builtin_amdgcn_mfma_f32_16x16x4f32(X[fr * 68 + 4 * s + fq], Ps[(4 * s + fq) * 20 + fr], R, 0, 0, 0);
#pragma unroll
                for (int e2 = 0; e2 < 4; ++e2) Tm[(bi * 16 + fq * 4 + e2) * 68 + bj * 16 + fr] = -R[e2];
            }
            asm volatile("s_waitcnt lgkmcnt(0)" ::: "memory"); __syncthreads();
        }
        for (int e2 = tid; e2 < 4096; e2 += 512) { const int r = e2 >> 6, c = e2 & 63; Tb[r * 72 + c] = f2bf(Tm[r * 68 + c]); }
    }
    __syncthreads();
    {
        const int mi = wave & 3;
        const bf16x8 a0 = *(const bf16x8*)(Tb + (mi * 16 + fr) * 72 + fq * 8), a1 = *(const bf16x8*)(Tb + (mi * 16 + fr) * 72 + 32 + fq * 8);
        float* vo = (float*)(ws + O_GVAL) + (size_t)item * 8192; bf16_t* ko = (bf16_t*)(ws + O_GKC) + (size_t)item * 8192;
#pragma unroll
        for (int q = 0; q < 4; ++q) {
            const int nt = (wave >> 2) * 4 + q;
            f32x4 v = {0.f, 0.f, 0.f, 0.f}, kc = {0.f, 0.f, 0.f, 0.f};
            v = MFMA16(a0, *(const bf16x8*)(vbT + (nt * 16 + fr) * 72 + fq * 8), v); v = MFMA16(a1, *(const bf16x8*)(vbT + (nt * 16 + fr) * 72 + 32 + fq * 8), v);
            kc = MFMA16(a0, *(const bf16x8*)(kgT + (nt * 16 + fr) * 72 + fq * 8), kc); kc = MFMA16(a1, *(const bf16x8*)(kgT + (nt * 16 + fr) * 72 + 32 + fq * 8), kc);
#pragma unroll
            for (int e = 0; e < 4; ++e) { const int i = mi * 16 + fq * 4 + e, d = nt * 16 + fr; vo[i * 128 + d] = v[e]; ko[i * 128 + d] = f2bf(kc[e]); }
        }
    }
    if (tid == 0) ((float*)(ws + O_GEGL))[item] = expf(gcs[63]);
    __syncthreads();
}

struct GdnUO { bf16x8 kc[4], qg[4], qk[2]; float val[2][4]; };
struct GdnSU { bf16x8 kd[2][2]; float egl; };
__device__ __forceinline__ void gdn_load_uo(const unsigned char* ws, int item, int mt, int fr, int fq, int dvb, GdnUO& f) {
    const bf16_t* kc = (const bf16_t*)(ws + O_GKC) + (size_t)item * 8192 + (mt * 16 + fr) * 128 + fq * 8;
    const bf16_t* qg = (const bf16_t*)(ws + O_GQG) + (size_t)item * 8192 + (mt * 16 + fr) * 128 + fq * 8;
    const bf16_t* qk = (const bf16_t*)(ws + O_GQK) + (size_t)item * 4096 + (mt * 16 + fr) * 64 + fq * 8;
    const float* vl = (const float*)(ws + O_GVAL) + (size_t)item * 8192 + (mt * 16 + fq * 4) * 128 + dvb + fr;
#pragma unroll
    for (int s = 0; s < 4; ++s) { f.kc[s] = *(const bf16x8*)(kc + s * 32); f.qg[s] = *(const bf16x8*)(qg + s * 32); }
#pragma unroll
    for (int s = 0; s < 2; ++s) f.qk[s] = *(const bf16x8*)(qk + s * 32);
#pragma unroll
    for (int nt = 0; nt < 2; ++nt)
#pragma unroll
        for (int e = 0; e < 4; ++e) f.val[nt][e] = vl[e * 128 + nt * 16];
}
__device__ __forceinline__ void gdn_load_su(const unsigned char* ws, int item, int w4, int fr, int fq, GdnSU& f) {
    const bf16_t* kd = (const bf16_t*)(ws + O_GKD) + (size_t)item * 8192 + (2 * w4 * 16 + fr) * 64 + fq * 8;
#pragma unroll
    for (int s = 0; s < 2; ++s) { f.kd[0][s] = *(const bf16x8*)(kd + s * 32); f.kd[1][s] = *(const bf16x8*)(kd + 16 * 64 + s * 32); }
    f.egl = ((const float*)(ws + O_GEGL))[item];
}
#define GDN_BAR() do { asm volatile("s_waitcnt lgkmcnt(0)" ::: "memory"); __builtin_amdgcn_s_barrier(); asm volatile("" ::: "memory"); } while (0)
__device__ __forceinline__ void gdn_step_uo(const GdnUO& c, bf16_t* Sl, bf16_t* vn, float* go, int n, int h, int mt, int fr, int fq, int dvb) {
    bf16x8 Sb[2][4];
#pragma unroll
    for (int nt = 0; nt < 2; ++nt)
#pragma unroll
        for (int s = 0; s < 4; ++s) Sb[nt][s] = *(const bf16x8*)(Sl + nt * (16 * 136) + fr * 136 + s * 32 + fq * 8);
    f32x4 U[2], O[2];
#pragma unroll
    for (int nt = 0; nt < 2; ++nt) { U[nt] = (f32x4){0.f, 0.f, 0.f, 0.f}; O[nt] = (f32x4){0.f, 0.f, 0.f, 0.f};
#pragma unroll
        for (int s = 0; s < 4; ++s) U[nt] = MFMA16(c.kc[s], Sb[nt][s], U[nt]);
        u32x2 w; w.x = pk2(c.val[nt][0] - U[nt][0], c.val[nt][1] - U[nt][1]); w.y = pk2(c.val[nt][2] - U[nt][2], c.val[nt][3] - U[nt][3]);
        *(u32x2*)(vn + nt * (16 * 72) + fr * 72 + mt * 16 + fq * 4) = w; }
#pragma unroll
    for (int nt = 0; nt < 2; ++nt)
#pragma unroll
        for (int s = 0; s < 4; ++s) O[nt] = MFMA16(c.qg[s], Sb[nt][s], O[nt]);
    GDN_BAR();
#pragma unroll
    for (int nt = 0; nt < 2; ++nt) {
        const bf16x8 V0 = *(const bf16x8*)(vn + nt * (16 * 72) + fr * 72 + fq * 8), V1 = *(const bf16x8*)(vn + nt * (16 * 72) + fr * 72 + 32 + fq * 8);
        O[nt] = MFMA16(c.qk[0], V0, O[nt]); O[nt] = MFMA16(c.qk[1], V1, O[nt]);
#pragma unroll
        for (int e = 0; e < 4; ++e) go[(size_t)(n * 64 + mt * 16 + fq * 4 + e) * 1024 + h * 128 + dvb + nt * 16 + fr] = O[nt][e];
    }
    GDN_BAR();
}
__device__ __forceinline__ void gdn_step_su(const GdnSU& c, f32x4 (&St)[2][2], bf16_t* Sl, const bf16_t* vn, int w4, int fr, int fq) {
    GDN_BAR();
#pragma unroll
    for (int nt = 0; nt < 2; ++nt) {
        const bf16x8 V0 = *(const bf16x8*)(vn + nt * (16 * 72) + fr * 72 + fq * 8), V1 = *(const bf16x8*)(vn + nt * (16 * 72) + fr * 72 + 32 + fq * 8);
#pragma unroll
        for (int q = 0; q < 2; ++q) {
            St[nt][q] = St[nt][q] * c.egl;
            St[nt][q] = MFMA16(V0, c.kd[q][0], St[nt][q]); St[nt][q] = MFMA16(V1, c.kd[q][1], St[nt][q]);
#pragma unroll
            for (int e = 0; e < 4; ++e) Sl[nt * (16 * 136) + (fq * 4 + e) * 136 + (2 * w4 + q) * 16 + fr] = f2bf(St[nt][q][e]);
        }
    }
    GDN_BAR();
}
__device__ void gdn_recurrence(const Params& p, int b, unsigned char* lds) {
    const unsigned char* ws = p.ws;
    const int tid = tidx(), wave = tid >> 6, lane = tid & 63, fr = lane & 15, fq = lane >> 4;
    const int h = b >> 2, dvb = (b & 3) * 32;
    bf16_t* Sl = (bf16_t*)lds; bf16_t* vn = (bf16_t*)(lds + 2 * 16 * 136 * 2);
    float* go = (float*)(p.ws + O_PQKV);
    for (int e = tid; e < 2 * 16 * 136; e += 512) Sl[e] = 0;
    __syncthreads();
    if (wave < 4) {
        const int mt = wave;
        GdnUO f0, f1, f2;
        gdn_load_uo(ws, h, mt, fr, fq, dvb, f0); gdn_load_uo(ws, 8 + h, mt, fr, fq, dvb, f1);
        for (int n = 0; n < 255; n += 3) {
            gdn_load_uo(ws, (n + 2) * 8 + h, mt, fr, fq, dvb, f2); gdn_step_uo(f0, Sl, vn, go, n, h, mt, fr, fq, dvb);
            gdn_load_uo(ws, (n + 3) * 8 + h, mt, fr, fq, dvb, f0); gdn_step_uo(f1, Sl, vn, go, n + 1, h, mt, fr, fq, dvb);
            if (n + 4 < 256) gdn_load_uo(ws, (n + 4) * 8 + h, mt, fr, fq, dvb, f1);
            gdn_step_uo(f2, Sl, vn, go, n + 2, h, mt, fr, fq, dvb);
        }
        gdn_step_uo(f0, Sl, vn, go, 255, h, mt, fr, fq, dvb);
    } else {
        const int w4 = wave - 4;
        f32x4 St[2][2];
#pragma unroll
        for (int a = 0; a < 2; ++a)
#pragma unroll
            for (int c = 0; c < 2; ++c) St[a][c] = (f32x4){0.f, 0.f, 0.f, 0.f};
        GdnSU f0, f1, f2;
        gdn_load_su(ws, h, w4, fr, fq, f0); gdn_load_su(ws, 8 + h, w4, fr, fq, f1);
        for (int n = 0; n < 255; n += 3) {
            gdn_load_su(ws, (n + 2) * 8 + h, w4, fr, fq, f2); gdn_step_su(f0, St, Sl, vn, w4, fr, fq);
            gdn_load_su(ws, (n + 3) * 8 + h, w4, fr, fq, f0); gdn_step_su(f1, St, Sl, vn, w4, fr, fq);
            if (n + 4 < 256) gdn_load_su(ws, (n + 4) * 8 + h, w4, fr, fq, f1);
            gdn_step_su(f2, St, Sl, vn, w4, fr, fq);
        }
        gdn_step_su(f0, St, Sl, vn, w4, fr, fq);
    }
}
struct KVF { bf16x8 k[4][2]; };
__device__ __forceinline__ void kv_load(const bf16_t* kp, int ldk, KVF& f) {
#pragma unroll
    for (int s = 0; s < 4; ++s) { f.k[s][0] = *(const bf16x8*)(kp + (size_t)(s * 16) * ldk); f.k[s][1] = *(const bf16x8*)(kp + (size_t)(s * 16) * ldk + 32); }
}
template <int CTRL> __device__ __forceinline__ float dppf(float v) { return __int_as_float(__builtin_amdgcn_update_dpp(0, __float_as_int(v), CTRL, 0xF, 0xF, true)); }
template <int CTRL> __device__ __forceinline__ unsigned dppu(unsigned v) { return (unsigned)__builtin_amdgcn_update_dpp(0, (int)v, CTRL, 0xF, 0xF, true); }
__device__ __forceinline__ float rmax16(float v) { v = vmaxf(v, dppf<0xB1>(v)); v = vmaxf(v, dppf<0x4E>(v)); v = vmaxf(v, dppf<0x124>(v)); v = vmaxf(v, dppf<0x128>(v)); return v; }
__device__ __forceinline__ float rsum16(float v) { v += dppf<0xB1>(v); v += dppf<0x4E>(v); v += dppf<0x124>(v); v += dppf<0x128>(v); return v; }
template <int CTRL> __device__ __forceinline__ unsigned long long dppmax64(unsigned long long b) { const unsigned lo = dppu<CTRL>((unsigned)b), hi = dppu<CTRL>((unsigned)(b >> 32)); const unsigned long long ob = ((unsigned long long)hi << 32) | lo; return ob > b ? ob : b; }
#define MFMA8(a, b, c) __builtin_amdgcn_mfma_f32_16x16x32_fp8_fp8((a), (b), (c), 0, 0, 0)
__device__ __forceinline__ long mk64(unsigned lo, unsigned hi) { return (long)(((unsigned long long)hi << 32) | lo); }
__device__ __forceinline__ long bf8_to_fp8(bf16x8 v) {
    const u32x4 w = __builtin_bit_cast(u32x4, v);
    int a = __builtin_amdgcn_cvt_pk_fp8_f32(bflo(w.x), bfhi(w.x), 0, false); a = __builtin_amdgcn_cvt_pk_fp8_f32(bflo(w.y), bfhi(w.y), a, true);
    int b = __builtin_amdgcn_cvt_pk_fp8_f32(bflo(w.z), bfhi(w.z), 0, false); b = __builtin_amdgcn_cvt_pk_fp8_f32(bflo(w.w), bfhi(w.w), b, true);
    return mk64((unsigned)a, (unsigned)b);
}
struct K8F { u32x4 k[4]; };
__device__ __forceinline__ void k8_load(const unsigned char* kp, K8F& f) {
#pragma unroll
    for (int s = 0; s < 4; ++s) f.k[s] = *(const u32x4*)(kp + s * 1024);
}
__device__ __forceinline__ void softmax_pv(const f32x4 (&S)[4], const u32x4 (&Vw)[4], unsigned vmask, float (&m)[4], float (&l)[4], f32x4 (&O)[4], unsigned char* Pt, int fr, int fq) {
    float mx[4];
#pragma unroll
    for (int j = 0; j < 4; ++j) { float v = -1e30f;
#pragma unroll
        for (int s = 0; s < 4; ++s) v = ((vmask >> s) & 1u) ? vmaxf(v, S[s][j]) : v;
        mx[j] = rmax16(v); }
#pragma unroll
    for (int j = 0; j < 4; ++j) { const float mn = vmaxf(m[j], mx[j]); const float a = __builtin_amdgcn_exp2f(m[j] - mn); m[j] = mn; l[j] *= a;
#pragma unroll
        for (int dt = 0; dt < 4; ++dt) O[dt][j] *= a; }
#pragma unroll
    for (int j = 0; j < 4; ++j) { float pv[4];
#pragma unroll
        for (int s = 0; s < 4; ++s) { pv[s] = ((vmask >> s) & 1u) ? __builtin_amdgcn_exp2f(S[s][j] - m[j]) : 0.f; l[j] += pv[s]; }
        int t = __builtin_amdgcn_cvt_pk_fp8_f32(pv[0] * 256.f, pv[1] * 256.f, 0, false); t = __builtin_amdgcn_cvt_pk_fp8_f32(pv[2] * 256.f, pv[3] * 256.f, t, true);
        *(unsigned*)(Pt + (fq * 4 + j) * 72 + fr * 4) = (unsigned)t; }
    asm volatile("s_waitcnt lgkmcnt(0)" ::: "memory");
    const u32x2 p0 = *(const u32x2*)(Pt + fr * 72 + fq * 8), p1 = *(const u32x2*)(Pt + fr * 72 + 32 + fq * 8);
    asm volatile("s_waitcnt lgkmcnt(0)" ::: "memory");
    const long P0 = mk64(p0.x, p0.y), P1 = mk64(p1.x, p1.y);
#pragma unroll
    for (int dt = 0; dt < 4; ++dt) { O[dt] = MFMA8(P0, mk64(Vw[dt].x, Vw[dt].y), O[dt]); O[dt] = MFMA8(P1, mk64(Vw[dt].z, Vw[dt].w), O[dt]); }
}
__device__ __forceinline__ void flash_compute(const bf16x8 (&Qf)[2], KVF& f, const bf16_t* knext, int ldk, const unsigned char* vp, unsigned vmask, float (&m)[4], float (&l)[4], f32x4 (&O)[4], unsigned char* Pt, int fr, int fq) {
    f32x4 S[4]; u32x4 Vw[4];
#pragma unroll
    for (int dt = 0; dt < 4; ++dt) Vw[dt] = *(const u32x4*)(vp + dt * 1024);
#pragma unroll
    for (int s = 0; s < 4; ++s) { S[s] = (f32x4){0.f, 0.f, 0.f, 0.f}; S[s] = MFMA16(Qf[0], f.k[s][0], S[s]); S[s] = MFMA16(Qf[1], f.k[s][1], S[s]); }
    if (knext) kv_load(knext, ldk, f);
    softmax_pv(S, Vw, vmask, m, l, O, Pt, fr, fq);
}
struct V8F { u32x4 v[4]; };
__device__ __forceinline__ void v8_load(const unsigned char* vp, V8F& f) {
#pragma unroll
    for (int dt = 0; dt < 4; ++dt) f.v[dt] = *(const u32x4*)(vp + dt * 1024);
}
__device__ __forceinline__ void flash_compute8(const long (&Q8)[2], const K8F& f, const V8F& vf, unsigned vmask, float (&m)[4], float (&l)[4], f32x4 (&O)[4], unsigned char* Pt, int fr, int fq) {
    f32x4 S[4];
#pragma unroll
    for (int s = 0; s < 4; ++s) { S[s] = (f32x4){0.f, 0.f, 0.f, 0.f}; S[s] = MFMA8(Q8[0], mk64(f.k[s].x, f.k[s].y), S[s]); S[s] = MFMA8(Q8[1], mk64(f.k[s].z, f.k[s].w), S[s]); }
    softmax_pv(S, vf.v, vmask, m, l, O, Pt, fr, fq);
}
template <int BR> struct BranchIt {
    const bf16_t* kb; const unsigned char* kb8; const unsigned char* vb; const int* ul; int last, trow, fr, fq;
    static constexpr int LDK = 64;
    __device__ __forceinline__ int next(int from) const { return from <= last ? from : -1; }
    __device__ __forceinline__ int entry(int idx) const { return BR == 1 ? __builtin_amdgcn_readfirstlane(ul[idx]) : idx; }
    __device__ __forceinline__ const unsigned char* vptr(int en) const { return vb + (size_t)(en & 0xFFFF) * 4096; }
    __device__ __forceinline__ const bf16_t* kptr(int en) const { return kb + (size_t)((en & 0xFFFF) * 64) * LDK; }
    __device__ __forceinline__ const unsigned char* kptr8(int en) const { return kb8 + (size_t)(en & 0xFFFF) * 4096; }
    __device__ __forceinline__ unsigned mask(int en) const {
        unsigned vm = 0; const int key0 = (en & 0xFFFF) * 64;
        if (BR == 0) {
#pragma unroll
            for (int s = 0; s < 4; ++s) vm |= ((16 * (key0 + s * 16 + fr) + 31 <= trow) ? 1u : 0u) << s;
        } else if (BR == 1) {
            const bool rowsel = (en >> (16 + fq)) & 1;
#pragma unroll
            for (int s = 0; s < 4; ++s) vm |= ((rowsel && (key0 + s * 16 + fr <= trow)) ? 1u : 0u) << s;
        } else {
#pragma unroll
            for (int s = 0; s < 4; ++s) { const int kpos = key0 + s * 16 + fr; vm |= ((kpos <= trow && kpos > trow - 512) ? 1u : 0u) << s; }
        }
        return vm;
    }
};
template <int BR> __device__ __forceinline__ void run_branch(const BranchIt<BR>& it, int first, const bf16x8 (&Qf)[2], const long (&Q8)[2], float (&m)[4], float (&l)[4], f32x4 (&O)[4], unsigned char* Pt) {
#pragma unroll
    for (int j = 0; j < 4; ++j) { m[j] = -1e30f; l[j] = 0.f; O[j] = (f32x4){0.f, 0.f, 0.f, 0.f}; }
    int ia = it.next(first);
    if (ia < 0) return;
    if (BR == 0) {
        KVF A; kv_load(it.kptr(ia), BranchIt<BR>::LDK, A);
        while (ia >= 0) {
            const int ib = it.next(ia + 1);
            flash_compute(Qf, A, ib >= 0 ? it.kptr(ib) : nullptr, BranchIt<BR>::LDK, it.vptr(ia), it.mask(ia), m, l, O, Pt, it.fr, it.fq);
            ia = ib;
        }
    } else {
        K8F kA, kB; V8F vA, vB; int ea = it.entry(ia); k8_load(it.kptr8(ea), kA); v8_load(it.vptr(ea), vA);
        for (;;) {
            const int ib = it.next(ia + 1), eb = it.entry(ib >= 0 ? ib : ia);
            k8_load(it.kptr8(eb), kB); v8_load(it.vptr(eb), vB);
            flash_compute8(Q8, kA, vA, it.mask(ea), m, l, O, Pt, it.fr, it.fq);
            if (ib < 0) break;
            const int ic = it.next(ib + 1); ea = it.entry(ic >= 0 ? ic : ib);
            k8_load(it.kptr8(ea), kA); v8_load(it.vptr(ea), vA);
            flash_compute8(Q8, kB, vB, it.mask(eb), m, l, O, Pt, it.fr, it.fq);
            if (ic < 0) break;
            ia = ic;
        }
    }
}
__device__ __forceinline__ void branch_finish(float (&l)[4], f32x4 (&O)[4], const float* grow, int br, int hk, float* ybp  ) {
#pragma unroll
    for (int j = 0; j < 4; ++j) { const float s = rsum16(l[j]);
        const float g = sigmoidf_(grow[(hk * 4 + j) * 3 + br]) * 0.00390625f / fmaxf(s, 1e-30f);
#pragma unroll
        for (int dt = 0; dt < 4; ++dt) { float* q = ybp + j * 64 + dt * 16; if (br == 0) *q = g * O[dt][j]; else *q += g * O[dt][j]; } }
}
constexpr int NSA_WLDS = 15680;
__device__ void nsa_wave_task(const Params& p, int layer, int t0, int hk, unsigned char* wl) {
    unsigned char* ws = p.ws;
    const int lane = tidx() & 63, fr = lane & 15, fq = lane >> 4;
    float* imp = (float*)wl; unsigned* flg = (unsigned*)(wl + 4160); unsigned char* Pt = wl + 5184; float* yb = (float*)(wl + 7488);
    const bf16_t* qn = (const bf16_t*)(ws + O_QN); const unsigned char* ks8 = ws + O_KSN; const unsigned char* kw8 = ws + O_KWN;
    const unsigned char* vsT = ws + O_VST; const unsigned char* vwT = ws + O_VWT; const bf16_t* kc = (const bf16_t*)(ws + O_KC); const unsigned char* vcT = ws + O_VCT;
    const int trow = t0 + fq;
    const float* grow = (const float*)(ws + O_P32) + (size_t)trow * 1536 + 1280;
    const int tmax = t0 + 3;
    {
        bf16x8 Qf[2];
        { const bf16_t* qp = qn + (size_t)(t0 + (fr >> 2)) * 512 + (hk * 4 + (fr & 3)) * 64 + fq * 8; Qf[0] = *(const bf16x8*)qp; Qf[1] = *(const bf16x8*)(qp + 32); }
        long Q8[2]; Q8[0] = bf8_to_fp8(Qf[0]); Q8[1] = bf8_to_fp8(Qf[1]);
        float* ybp = yb + fq * 256 + fr;
        float m[4], l[4]; f32x4 O[4];
        const int ncmp_t = tmax >= 31 ? ((((tmax - 31) >> 4) >> 6) + 1) : 0;
        const bf16_t* kcb = kc + ((size_t)hk * 1024 + fr) * 64 + fq * 8;
        { BranchIt<0> it{kcb, nullptr, vcT + (size_t)hk * 16 * 4096 + fr * 64 + fq * 16, nullptr, ncmp_t - 1, trow, fr, fq}; run_branch<0>(it, 0, Qf, Q8, m, l, O, Pt); }
        float linv[4];
#pragma unroll
        for (int j = 0; j < 4; ++j) { const float s = rsum16(l[j]); linv[j] = s > 0.f ? 1.0f / s : 0.f; }
        branch_finish(l, O, grow, 0, hk, ybp);
        for (int e = lane; e < 4 * 260; e += 64) imp[e] = 0.f;
        for (int e = lane; e < 256; e += 64) flg[e] = 0u;
        asm volatile("s_waitcnt lgkmcnt(0)" ::: "memory");
        {
            KVF ka;
            if (ncmp_t > 0) kv_load(kcb, 64, ka);
            for (int kt = 0; kt < ncmp_t; ++kt) {
                const int key0 = kt * 64;
                f32x4 S[4];
#pragma unroll
                for (int s = 0; s < 4; ++s) { S[s] = (f32x4){0.f, 0.f, 0.f, 0.f}; S[s] = MFMA16(Qf[0], ka.k[s][0], S[s]); S[s] = MFMA16(Qf[1], ka.k[s][1], S[s]); }
                if (kt + 1 < ncmp_t) kv_load(kcb + (size_t)(key0 + 64) * 64, 64, ka);
#pragma unroll
                for (int s = 0; s < 4; ++s) {
                    const int nn = key0 + s * 16 + fr; const bool valid = 16 * nn + 31 <= trow;
                    float ps = 0.f;
#pragma unroll
                    for (int j = 0; j < 4; ++j) ps += valid ? __builtin_amdgcn_exp2f(S[s][j] - m[j]) * linv[j] : 0.f;
                    float p4 = ps; p4 += dppf<0xB1>(p4); p4 += dppf<0x4E>(p4);
                    if ((fr & 3) == 0) imp[fq * 260 + (nn >> 2)] += p4;
                    asm volatile("s_waitcnt lgkmcnt(0)" ::: "memory");
                    if ((fr & 3) == 3) imp[fq * 260 + (nn >> 2) + 1] += ps;
                    asm volatile("s_waitcnt lgkmcnt(0)" ::: "memory");
                }
            }
        }
#ifdef OLD_TOPK
        for (int tok = 0; tok < 4; ++tok) {
            const int t = t0 + tok, cur = t >> 6, nsel = cur + 1 < 16 ? cur + 1 : 16;
            unsigned long long key[4];
#pragma unroll
            for (int i = 0; i < 4; ++i) { const int j = lane + 64 * i; unsigned long long k = 0ull;
                if (j <= cur) { const bool forced = (j == 0) || (j == cur) || (j == cur - 1); const unsigned vb = forced ? 0x7F800000u : __float_as_uint(imp[tok * 260 + j]); k = ((unsigned long long)vb << 32) | (unsigned)(0xFFFF - j); }
                key[i] = k; }
            for (int it2 = 0; it2 < nsel; ++it2) {
                unsigned long long best = key[0]; best = key[1] > best ? key[1] : best; best = key[2] > best ? key[2] : best; best = key[3] > best ? key[3] : best;
#pragma unroll
                for (int o = 32; o >= 1; o >>= 1) { const unsigned lo = __shfl_xor((unsigned)best, o), hi = __shfl_xor((unsigned)(best >> 32), o); const unsigned long long ob = ((unsigned long long)hi << 32) | lo; best = ob > best ? ob : best; }
                const int jsel = 0xFFFF - (int)(best & 0xFFFFu);
#pragma unroll
                for (int i = 0; i < 4; ++i) if (key[i] == best) key[i] = 0ull;
                if (lane == 0) flg[jsel] |= (1u << tok);
            }
        }
#else
        {
            unsigned long long key[4][4];
#pragma unroll
            for (int tok = 0; tok < 4; ++tok) { const int cur = (t0 + tok) >> 6;
#pragma unroll
                for (int i = 0; i < 4; ++i) { const int j = lane + 64 * i; unsigned long long k = 0ull;
                    if (j <= cur) { const bool forced = (j == 0) || (j == cur) || (j == cur - 1); const unsigned vb = forced ? 0x7F800000u : __float_as_uint(imp[tok * 260 + j]); k = ((unsigned long long)vb << 32) | (unsigned)(0xFFFF - j); }
                    key[tok][i] = k; } }
            for (int itn = 0; itn < 16; ++itn) {
                unsigned long long best[4];
#pragma unroll
                for (int tok = 0; tok < 4; ++tok) { unsigned long long b0 = key[tok][0]; b0 = key[tok][1] > b0 ? key[tok][1] : b0; b0 = key[tok][2] > b0 ? key[tok][2] : b0; b0 = key[tok][3] > b0 ? key[tok][3] : b0; best[tok] = b0; }
#pragma unroll
                for (int tok = 0; tok < 4; ++tok) { best[tok] = dppmax64<0xB1>(best[tok]); best[tok] = dppmax64<0x4E>(best[tok]); best[tok] = dppmax64<0x124>(best[tok]); best[tok] = dppmax64<0x128>(best[tok]); }
#pragma unroll
                for (int o = 16; o <= 32; o <<= 1) {
#pragma unroll
                    for (int tok = 0; tok < 4; ++tok) { const unsigned lo = __shfl_xor((unsigned)best[tok], o), hi = __shfl_xor((unsigned)(best[tok] >> 32), o); const unsigned long long ob = ((unsigned long long)hi << 32) | lo; best[tok] = ob > best[tok] ? ob : best[tok]; }
                }
#pragma unroll
                for (int tok = 0; tok < 4; ++tok) {
                    if (best[tok] != 0ull) {
#pragma unroll
                        for (int i = 0; i < 4; ++i) if (key[tok][i] == best[tok]) key[tok][i] = 0ull;
                        if (lane == 0) flg[0xFFFF - (int)(best[tok] & 0xFFFFu)] |= (1u << tok);
                    }
                }
            }
        }
#endif
        asm volatile("s_waitcnt lgkmcnt(0)" ::: "memory");
        int ucnt = 0; int* ul = (int*)imp;
#pragma unroll
        for (int i = 0; i < 4; ++i) { const int j = i * 64 + lane; const unsigned fw = flg[j]; const bool us = fw != 0u; const unsigned long long bm = __ballot(us);
            const int pos = ucnt + __popcll(bm & ((1ull << lane) - 1ull)); if (us) ul[pos] = j | (int)(fw << 16); ucnt += __popcll(bm); }
        asm volatile("s_waitcnt lgkmcnt(0)" ::: "memory");
        { BranchIt<1> it{nullptr, ks8 + (size_t)hk * 256 * 4096 + fr * 64 + fq * 16, vsT + (size_t)hk * 256 * 4096 + fr * 64 + fq * 16, ul, ucnt - 1, trow, fr, fq}; run_branch<1>(it, 0, Qf, Q8, m, l, O, Pt); }
        branch_finish(l, O, grow, 1, hk, ybp);
        { BranchIt<2> it{nullptr, kw8 + (size_t)hk * 256 * 4096 + fr * 64 + fq * 16, vwT + (size_t)hk * 256 * 4096 + fr * 64 + fq * 16, nullptr, tmax >> 6, trow, fr, fq}; run_branch<2>(it, t0 - 511 > 0 ? ((t0 - 511) >> 6) : 0, Qf, Q8, m, l, O, Pt); }
        branch_finish(l, O, grow, 2, hk, ybp);
    }
    asm volatile("s_waitcnt lgkmcnt(0)" ::: "memory");
    float* ysc = (float*)(ws + O_P32);
#pragma unroll
    for (int tok = 0; tok < 4; ++tok) *(f32x4*)(ysc + (size_t)(t0 + tok) * 1536 + hk * 256 + lane * 4) = *(const f32x4*)(yb + tok * 256 + lane * 4);
    asm volatile("s_waitcnt lgkmcnt(0)" ::: "memory");
}

__device__ void phase_finalize(const Params& p, int layer) {
    unsigned char* ws = p.ws;
    const int wave = tidx() >> 6, lane = tidx() & 63;
    const float* yglu = (const float*)(ws + O_YGLU); const float* go = (const float*)(ws + O_PQKV); const bf16_t* Pz = (const bf16_t*)(ws + O_PZ); bf16_t* mix = (bf16_t*)(ws + O_HN);
    const float* gs = p.in[22] + (size_t)layer * 512 + lane * 8; const float* gg = p.in[26] + (size_t)layer * 128 + (lane & 7) * 16;
    const float* gnsa = p.in[12] + (size_t)layer * 512 + lane * 8; const float* ysc = (const float*)(ws + O_P32);
    for (int t = blockIdx.x * 8 + wave; t < T_; t += gridDim.x * 8) {
        {
            const f32x4 a = *(const f32x4*)(ysc + (size_t)t * 1536 + lane * 8), b = *(const f32x4*)(ysc + (size_t)t * 1536 + lane * 8 + 4);
            float ss = a[0] * a[0] + a[1] * a[1] + a[2] * a[2] + a[3] * a[3] + b[0] * b[0] + b[1] * b[1] + b[2] * b[2] + b[3] * b[3];
            ss = wave_sum(ss); const float rs = rsqrtf(ss * (1.0f / 512.0f) + 1e-6f);
            const f32x4 g0 = *(const f32x4*)gnsa, g1 = *(const f32x4*)(gnsa + 4);
            u32x4 w; w.x = pk2(a[0] * rs * g0[0], a[1] * rs * g0[1]); w.y = pk2(a[2] * rs * g0[2], a[3] * rs * g0[3]); w.z = pk2(b[0] * rs * g1[0], b[1] * rs * g1[1]); w.w = pk2(b[2] * rs * g1[2], b[3] * rs * g1[3]);
            *(u32x4*)(mix + (size_t)t * DM + lane * 8) = w;
        }
        {
            const f32x4 a = *(const f32x4*)(yglu + (size_t)t * 512 + lane * 8), b = *(const f32x4*)(yglu + (size_t)t * 512 + lane * 8 + 4);
            float ss = a[0] * a[0] + a[1] * a[1] + a[2] * a[2] + a[3] * a[3] + b[0] * b[0] + b[1] * b[1] + b[2] * b[2] + b[3] * b[3];
            ss = wave_sum(ss); const float rs = rsqrtf(ss * (1.0f / 512.0f) + 1e-6f);
            const f32x4 g0 = *(const f32x4*)gs, g1 = *(const f32x4*)(gs + 4);
            u32x4 w; w.x = pk2(a[0] * rs * g0[0], a[1] * rs * g0[1]); w.y = pk2(a[2] * rs * g0[2], a[3] * rs * g0[3]); w.z = pk2(b[0] * rs * g1[0], b[1] * rs * g1[1]); w.w = pk2(b[2] * rs * g1[2], b[3] * rs * g1[3]);
            *(u32x4*)(mix + (size_t)t * DM + 512 + lane * 8) = w;
        }
        {
            f32x4 o[4]; float ss = 0.f;
#pragma unroll
            for (int q = 0; q < 4; ++q) { o[q] = *(const f32x4*)(go + (size_t)t * 1024 + lane * 16 + q * 4); ss += o[q][0] * o[q][0] + o[q][1] * o[q][1] + o[q][2] * o[q][2] + o[q][3] * o[q][3]; }
            ss += __shfl_xor(ss, 1); ss += __shfl_xor(ss, 2); ss += __shfl_xor(ss, 4);
            const float rs = rsqrtf(ss * (1.0f / 128.0f) + 1e-6f);
            const u32x4 z0 = *(const u32x4*)(Pz + (size_t)t * 1024 + lane * 16), z1 = *(const u32x4*)(Pz + (size_t)t * 1024 + lane * 16 + 8);
            float zz[16] = {bflo(z0.x), bfhi(z0.x), bflo(z0.y), bfhi(z0.y), bflo(z0.z), bfhi(z0.z), bflo(z0.w), bfhi(z0.w), bflo(z1.x), bfhi(z1.x), bflo(z1.y), bfhi(z1.y), bflo(z1.z), bfhi(z1.z), bflo(z1.w), bfhi(z1.w)};
            float r[16];
#pragma unroll
            for (int q = 0; q < 4; ++q) { const f32x4 g = *(const f32x4*)(gg + q * 4);
#pragma unroll
                for (int e = 0; e < 4; ++e) r[q * 4 + e] = o[q][e] * rs * g[e] * siluf_(zz[q * 4 + e]); }
            u32x4 w0, w1; w0.x = pk2(r[0], r[1]); w0.y = pk2(r[2], r[3]); w0.z = pk2(r[4], r[5]); w0.w = pk2(r[6], r[7]); w1.x = pk2(r[8], r[9]); w1.y = pk2(r[10], r[11]); w1.z = pk2(r[12], r[13]); w1.w = pk2(r[14], r[15]);
            *(u32x4*)(mix + (size_t)t * DM + 1024 + lane * 16) = w0; *(u32x4*)(mix + (size_t)t * DM + 1024 + lane * 16 + 8) = w1;
        }
    }
}

__device__ void phase_ffn_fix(const Params& p, int layer) {
    unsigned char* ws = p.ws;
    const float* hb = (const float*)(ws + O_HF); bf16_t* act = (bf16_t*)(ws + O_ACT);
    const float* cw = p.in[30] + (size_t)layer * 3 * NFF; const float* cb = p.in[31] + (size_t)layer * NFF;
    const int nitems = 256 * DFF;
    for (int it = blockIdx.x * 512 + tidx(); it < nitems; it += gridDim.x * 512) {
        const int grp = it / DFF, g = it - grp * DFF, pcol = 256 * (g >> 7) + (g & 127);
        const float* cur = hb + (size_t)grp * 4 * NFF + pcol; const float* prv = cur - (size_t)4 * NFF;
        const float gm2 = grp ? prv[2 * NFF] : 0.f, gm1 = grp ? prv[3 * NFF] : 0.f, g0v = cur[0], g1v = cur[NFF];
        const float um2 = grp ? prv[2 * NFF + 128] : 0.f, um1 = grp ? prv[3 * NFF + 128] : 0.f, u0v = cur[128], u1v = cur[NFF + 128];
        const float wg0 = cw[g], wg1 = cw[NFF + g], wg2 = cw[2 * NFF + g], bg = cb[g], wu0 = cw[DFF + g], wu1 = cw[NFF + DFF + g], wu2 = cw[2 * NFF + DFF + g], bu = cb[DFF + g];
        const float G0 = bg + wg0 * gm2 + wg1 * gm1 + wg2 * g0v, U0 = bu + wu0 * um2 + wu1 * um1 + wu2 * u0v;
        const float G1 = bg + wg0 * gm1 + wg1 * g0v + wg2 * g1v, U1 = bu + wu0 * um1 + wu1 * u0v + wu2 * u1v;
        act[(size_t)(grp * 64) * DFF + g] = f2bf(siluf_(G0) * U0);
        act[(size_t)(grp * 64 + 1) * DFF + g] = f2bf(siluf_(G1) * U1);
    }
}
#ifdef REPEAT_PHASE
constexpr int NPHT = NPH + 1;
#else
constexpr int NPHT = NPH;
#endif
#ifndef MULTI_LAUNCH
#define MULTI_LAUNCH 0
#endif
__global__ void __launch_bounds__(512) mega(Params p) {
    extern __shared__ __attribute__((aligned(16))) unsigned char smem[];
    cg::grid_group grid = cg::this_grid();
    const int b = blockIdx.x, G = gridDim.x;
    PG8_LAS unsigned char* glds = (PG8_LAS unsigned char*)smem;
    volatile XB_LAS unsigned* xst = (volatile XB_LAS unsigned*)(smem + LDS_BYTES - 32);
    if (threadIdx.x == 0) { xst[0] = 0u; xst[1] = 0u; }
    __syncthreads();
    XcdBarrier xbar; xbar.bar = (unsigned*)(p.ws + O_BAR); xbar.x = 0; xbar.st = xst;
    for (int ph = p.ph_lo; ph < p.ph_hi; ++ph) {

        #ifdef REPEAT_PHASE
        const int layer = ph / (NPH + 1), ki = ph % (NPH + 1), rep = (ki == REPEAT_PHASE + 1) ? 1 : 0; int k = ki <= REPEAT_PHASE ? ki : ki - 1;
#else
        const int layer = ph / NPH, rep = 0; int k = ph % NPH;
#endif
#ifdef DBG_ONLY
        if (k != DBG_ONLY) k = 99;
#endif
        typedef unsigned char __attribute__((address_space(1))) gu8_t;
        gu8_t* wsg = (gu8_t*)p.ws; asm volatile("" : "+s"(wsg));
        unsigned char* ws = (unsigned char*)wsg;
        int tid = threadIdx.x; asm volatile("" : "+v"(tid));
        const int wave = tid >> 6;
        bf16_t* hn = (bf16_t*)(ws + O_HN);
        Params q = p; q.ws = ws;
        if (k == 0) {
            if (ph == 0 && rep == 0 && b == 0) { if (tid < 64) ((unsigned*)(ws + O_CTR))[tid * 16] = 0u; for (int i = tid; i < XCD_BAR_WORDS; i += 512) ((unsigned*)(ws + O_BAR))[i] = 0u; }
            phase_convert(q, layer, (float*)smem);
            phase_rmsnorm(layer == 0 ? p.in[0] : p.out, p.in[1] + (size_t)layer * DM, hn, nullptr);
        } else if (k == 1) {
            pg8::Gemm g{hn, (const bf16_t*)(ws + O_WIN), T_, NIN, DM}; pg8::StaticOrder S; S.init(T_, NIN, G, b);
            EpiProj E{(float*)(ws + O_P32), (bf16_t*)(ws + O_PU), (bf16_t*)(ws + O_PQKV), (bf16_t*)(ws + O_PZ)};
            pg8::gemm_phase<EpiProj, pg8::StaticOrder, false>(glds, g, S, E, nullptr);
        } else if (k == 2) {
            for (int it = b; it < 3072; it += G) {
                if (it < 2048) gdn_prep_item(q, layer, it, smem);
                else if (it < 2304) nsa_prep_item(q, layer, it - 2048, (float*)smem);
                else if (it < 2560) s5_passA_wave(q, layer, (it - 2304) * 8 + wave, (float*)(smem + wave * 4096));
                else cmp1_wave_tile(q, layer, (it - 2560) * 8 + wave);
            }
        } else if (k == 3) {
            for (int idx = b * 8 + wave; idx < 4096; idx += G * 8) cmp2_wave_row(q, layer, idx);
            for (int it = b * 8 + wave; it < 2048; it += G * 8) s5_passB_wave(q, layer, it, (bf16_t*)(smem + wave * 8448), (float*)(smem + wave * 8448 + 4352));
        } else if (k == 4) {
#ifdef REP4_MODE
            const bool do_rec = (rep == 0) || (REP4_MODE == 1), do_glu = (rep == 0), do_nsa = (rep == 0) || (REP4_MODE == 2);
#else
            const bool do_rec = true, do_glu = true, do_nsa = true;
#endif
            if (b < 32) {
#ifndef NO_REC
 if (do_rec) gdn_recurrence(q, b, smem);
#endif
 }
            else if (b < 160 && do_glu) {
#ifndef NO_GLU
                pg8::Gemm g{(const bf16_t*)(ws + O_YGELU), (const bf16_t*)(ws + O_WGLU), T_, 512, 512}; pg8::StaticOrder S; S.init(T_, 512, 128, b - 32);
                EpiGlu E{(const bf16_t*)(ws + O_YGELU), (float*)(ws + O_YGLU)};
                pg8::gemm_phase<EpiGlu, pg8::StaticOrder, false>(glds, g, S, E, nullptr);
#endif
            }
            __syncthreads();
            unsigned* ctr = (unsigned*)(ws + O_CTR) + (layer * 2 + rep) * 16;
#ifndef NO_NSA
            if (do_nsa) for (;;) {
                int idx = 0;
                if ((tid & 63) == 0) idx = (int)atomicAdd(ctr, 1u);
                idx = __builtin_amdgcn_readfirstlane(idx);
                if (idx >= 8192) break;
                nsa_wave_task(q, layer, (4095 - (idx & 4095)) * 4, idx >> 12, smem + wave * NSA_WLDS);
            }
#endif
        } else if (k == 5) {
            phase_finalize(q, layer);
        } else if (k == 6) {
            pg8::Gemm g{hn, (const bf16_t*)(ws + O_WOUT), T_, DM, DM}; pg8::StaticOrder S; S.init(T_, DM, G, b);
            EpiResid E{layer == 0 ? p.in[0] : p.out, p.out, DM};
            pg8::gemm_phase<EpiResid, pg8::StaticOrder, false>(glds, g, S, E, nullptr);
        } else if (k == 7) {
            phase_rmsnorm(p.out, p.in[28] + (size_t)layer * DM, hn, nullptr);
        } else if (k == 8) {
            pg8::Gemm g{hn, (const bf16_t*)(ws + O_WFIN), T_, NFF, DM}; pg8::StaticOrder S; S.init(T_, NFF, G, b);
            EpiFfnAct E{(bf16_t*)(ws + O_ACT), (float*)(ws + O_HF), q.in[30] + (size_t)layer * 3 * NFF, q.in[31] + (size_t)layer * NFF};
            pg8::gemm_phase<EpiFfnAct, pg8::StaticOrder, false>(glds, g, S, E, nullptr);
        } else if (k == 9) {
            phase_ffn_fix(q, layer);
        } else if (k == 10) {
            pg8::Gemm g{(const bf16_t*)(ws + O_ACT), (const bf16_t*)(ws + O_WFOUT), T_, DM, DFF}; pg8::StaticOrder S; S.init(T_, DM, G, b);
            EpiResid E{p.out, p.out, DM};
            pg8::gemm_phase<EpiResid, pg8::StaticOrder, false>(glds, g, S, E, nullptr);
        }
        __syncthreads();
        if (ph + 1 < p.ph_hi) {
            if (ph == p.ph_lo) { grid.sync(); xbar = xcd_barrier_post((unsigned*)(p.ws + O_BAR), xst); }
            else xcd_barrier(xbar);
        }
    }
}

extern "C" void kernel_launch(void* const* d_in, const int* in_sizes, int n_in, void* d_out, int out_size, void* d_ws, size_t ws_size, hipStream_t stream) {
    static int grid_blocks = 0;
    if (!grid_blocks) {
        if (n_in != 33 || out_size != T_ * DM || ws_size < WS_NEED) { fprintf(stderr, "kernel_launch: unexpected shapes or workspace (%d inputs, out %d, ws %zu < %zu)\n", n_in, out_size, ws_size, (size_t)WS_NEED); grid_blocks = -1; return; }
        int dev = 0, cus = 0, per_cu = 0;
        hipGetDevice(&dev);
        hipDeviceGetAttribute(&cus, hipDeviceAttributeMultiprocessorCount, dev);
        if (hipFuncSetAttribute((const void*)mega, hipFuncAttributeMaxDynamicSharedMemorySize, LDS_BYTES) != hipSuccess) { fprintf(stderr, "kernel_launch: hipFuncSetAttribute failed\n"); grid_blocks = -1; return; }
        hipOccupancyMaxActiveBlocksPerMultiprocessor(&per_cu, (const void*)mega, 512, LDS_BYTES);
        (void)hipGetLastError();
        if (per_cu < 1) per_cu = 1;
        grid_blocks = cus * per_cu; if (grid_blocks > 256) grid_blocks = 256;
        if (grid_blocks < 160) { fprintf(stderr, "kernel_launch: grid %d too small\n", grid_blocks); grid_blocks = -1; return; }
    }
    if (grid_blocks < 0) return;
    Params p{};
    for (int i = 0; i < 33; ++i) p.in[i] = (const float*)d_in[i];
    p.out = (float*)d_out; p.ws = (unsigned char*)d_ws;
#if MULTI_LAUNCH
    for (int ph = 0; ph < 2 * NPHT; ++ph) { p.ph_lo = ph; p.ph_hi = ph + 1; hipLaunchKernelGGL(mega, dim3(grid_blocks), dim3(512), LDS_BYTES, stream, p); }
#else
    p.ph_lo = 0; p.ph_hi = 2 * NPHT;
    void* args[] = {&p};
    hipError_t e = hipLaunchCooperativeKernel((const void*)mega, dim3(grid_blocks), dim3(512), args, LDS_BYTES, stream);
    if (e != hipSuccess) fprintf(stderr, "cooperative launch failed: %s (grid %d)\n", hipGetErrorString(e), grid_blocks);
#endif
}
```
